# Optimizing an MI355X kernel written in HIP

```python
import math
import jax, jax.numpy as jnp
from jax import lax
import numpy as np

D_MODEL = 1024
BATCH = 2
SEQ = 8192
DEPTH = 2

CTX_LEN = 256
GRID_W = 64
EPS = 1e-6

DN_HEADS = 4
DN_HEAD_DIM = 128
DN_WIDTH = DN_HEADS * DN_HEAD_DIM
SHORT_CONV = 4
DN_CHUNK = 64

POOL_WINDOWS = (2, 4, 8, 16)
POOL_GROUPS = 4
POOL_WIDTH = D_MODEL // 2
POOL_GW = POOL_WIDTH // POOL_GROUPS

IN_SIZES = (3 * DN_WIDTH, DN_WIDTH, POOL_WIDTH, 2 * DN_HEADS, 2 * DN_HEADS, D_MODEL, D_MODEL)
IN_COLS = 3 * DN_WIDTH + DN_WIDTH + POOL_WIDTH + 4 * DN_HEADS + 2 * D_MODEL

PEER_HEADS = 8
N_KEYS = 128
N_EXPERTS = N_KEYS * N_KEYS
PEER_TOPK = 16
PEER_QDIM = 256
PEER_HALF = PEER_QDIM // 2
PEER_BLOCK = 128

kernel_name = 'hybrid_deltanet_pool_peer_diffusion'


def rmsnorm(x, w):
    xf = x.astype(jnp.float32)
    y = xf * lax.rsqrt(jnp.mean(xf * xf, axis=-1, keepdims=True) + EPS) * w.astype(jnp.float32)
    return y.astype(x.dtype)


def modulate(h, shift, scale):
    return h * (1 + scale) + shift


def l2norm(x):
    return x * lax.rsqrt(jnp.sum(x * x, axis=-1, keepdims=True) + EPS)


def split_columns(p):
    return jnp.split(p, np.cumsum(IN_SIZES)[:-1].tolist(), axis=-1)


def short_conv_silu(x, w):
    T = x.shape[1]
    left = SHORT_CONV // 2
    xp = jnp.pad(x, ((0, 0), (left, SHORT_CONV - 1 - left), (0, 0)))
    y = xp[:, 0:T, :] * w[0]
    for j in range(1, SHORT_CONV):
        y = y + xp[:, j:j + T, :] * w[j]
    return jax.nn.silu(y)


def dn_inputs(qkv, b_raw, a_raw, conv_w, a_log, dt_bias):
    Bn, T, _ = qkv.shape
    qkv = short_conv_silu(qkv, conv_w).astype(jnp.float32)
    q, k, v = jnp.split(qkv, 3, axis=-1)
    heads = lambda t: t.reshape(Bn, T, DN_HEADS, DN_HEAD_DIM).transpose(0, 2, 1, 3)
    q, k, v = l2norm(heads(q)), l2norm(heads(k)), heads(v)
    dirs = lambda t: t.astype(jnp.float32).reshape(Bn, T, 2, DN_HEADS).transpose(2, 0, 3, 1)
    beta = jax.nn.sigmoid(dirs(b_raw))
    a_f = a_log.astype(jnp.float32)[:, None, :, None]
    dtb = dt_bias.astype(jnp.float32)[:, None, :, None]
    g = -jnp.exp(a_f) * jax.nn.softplus(dirs(a_raw) + dtb)
    return (q, k, v, beta, g)


def gated_delta_rule(q, k, v, beta, g, state):
    Bn, Hn, T, DK = q.shape
    DV = v.shape[-1]
    C = DN_CHUNK
    n = T // C
    q = q * (DK ** -0.5)
    chunks = lambda t: t.reshape((Bn, Hn, n, C) + t.shape[3:])
    qc, kc, vc, bc = chunks(q), chunks(k), chunks(v), chunks(beta)
    gcum = jnp.cumsum(chunks(g), axis=-1)
    incl = jnp.tril(jnp.ones((C, C), bool))
    strict = jnp.tril(jnp.ones((C, C), bool), -1)
    decay = jnp.exp(jnp.where(incl, gcum[..., :, None] - gcum[..., None, :], -jnp.inf))
    kb = kc * bc[..., None]
    lower = jnp.where(strict, jnp.einsum('bhnid,bhnjd->bhnij', kb, kc) * decay, 0.0)
    eye = jnp.eye(C, dtype=jnp.float32)
    tinv = lax.linalg.triangular_solve(eye + lower, jnp.broadcast_to(eye, lower.shape),
                                       left_side=True, lower=True, unit_diagonal=True)
    w = tinv @ (kb * jnp.exp(gcum)[..., None])
    u = tinv @ (vc * bc[..., None])
    qg = qc * jnp.exp(gcum)[..., None]
    intra = jnp.einsum('bhnid,bhnjd->bhnij', qc, kc) * decay
    g_last = gcum[..., -1]
    kdec = kc * jnp.exp(g_last[..., None] - gcum)[..., None]

    def step(S, xs):
        w_i, u_i, qg_i, intra_i, kdec_i, gl_i = xs
        v_new = u_i - w_i @ S
        o_i = qg_i @ S + intra_i @ v_new
        S = S * jnp.exp(gl_i)[..., None, None] + jnp.swapaxes(kdec_i, -1, -2) @ v_new
        return S, o_i

    mv = lambda t: jnp.moveaxis(t, 2, 0)
    S, o = lax.scan(step, state, (mv(w), mv(u), mv(qg), mv(intra), mv(kdec), mv(g_last)))
    o = jnp.moveaxis(o, 0, 2).reshape(Bn, Hn, T, DV)
    return o, S


def bidirectional_delta(lat, ctx):
    ql, kl, vl, bl, gl = lat
    qc, kc, vc, bc, g_c = ctx
    s0 = jnp.zeros(qc.shape[:2] + (DN_HEAD_DIM, DN_HEAD_DIM), jnp.float32)
    rev = lambda t: jnp.flip(t, axis=2)
    oc_f, sc_f = gated_delta_rule(qc, kc, vc, bc[0], g_c[0], s0)
    ol_f, _ = gated_delta_rule(ql, kl, vl, bl[0], gl[0], sc_f)
    oc_b, sc_b = gated_delta_rule(rev(qc), rev(kc), rev(vc), rev(bc[1]), rev(g_c[1]), s0)
    ol_b, _ = gated_delta_rule(rev(ql), rev(kl), rev(vl), rev(bl[1]), rev(gl[1]), sc_b)
    return ol_f + rev(ol_b), oc_f + rev(oc_b)


def dn_output(o, z, onorm):
    Bn, Hn, T, DV = o.shape
    o = jnp.swapaxes(o, 1, 2)
    zf = z.astype(jnp.float32).reshape(Bn, T, Hn, DV)
    y = o * lax.rsqrt(jnp.mean(o * o, axis=-1, keepdims=True) + EPS) * onorm.astype(jnp.float32) * jax.nn.silu(zf)
    return y.reshape(Bn, T, Hn * DV).astype(z.dtype)


def pool_minus_self(x, window):
    L = x.shape[-2]
    xf = x.astype(jnp.float32)
    cs = jnp.cumsum(xf, axis=-2)
    P = jnp.concatenate([jnp.zeros_like(cs[..., :1, :]), cs], axis=-2)
    t = jnp.arange(L)
    lo = jnp.clip(t - window // 2, 0, L)
    hi = jnp.clip(t + window - window // 2, 0, L)
    s = jnp.take(P, hi, axis=-2) - jnp.take(P, lo, axis=-2)
    cnt = (hi - lo).astype(jnp.float32)[:, None]
    return s / cnt - xf


def multiscale_pool(p, pool_w, pool_scale, rows):
    Bn, T, _ = p.shape
    if rows is None:
        pg = p.reshape(Bn, T, POOL_GROUPS, POOL_GW)
    else:
        pg = p.reshape(Bn, rows, GRID_W, POOL_GROUPS, POOL_GW)
    y = jnp.stack([pool_minus_self(pg[..., gi, :], win) for gi, win in enumerate(POOL_WINDOWS)], axis=-2)
    y = y.reshape(Bn, T, POOL_GROUPS, POOL_GW)
    y = jnp.einsum('btgc,gcd->btgd', y, pool_w).reshape(Bn, T, POOL_WIDTH)
    return (y * pool_scale).astype(p.dtype)


def merge_branches(y_dn, y_pool, gate_dn, gate_pool, w_up_dn, w_up_pool, w_out):
    m = jax.nn.sigmoid(gate_dn) * (y_dn @ w_up_dn) + jax.nn.sigmoid(gate_pool) * (y_pool @ w_up_pool)
    return m @ w_out


def peer_ffn(h, wq, keys, u_tab, v_tab):
    Bn, T, D = h.shape
    tok = h.reshape(-1, PEER_BLOCK, D)

    def block(hb):
        q = (hb @ wq).reshape(PEER_BLOCK, PEER_HEADS, 2, PEER_HALF)
        s = jnp.einsum('nhpd,hpkd->nhpk', q, keys)
        s1, i1 = lax.top_k(s[:, :, 0], PEER_TOPK)
        s2, i2 = lax.top_k(s[:, :, 1], PEER_TOPK)
        cand_s = (s1[..., :, None] + s2[..., None, :]).reshape(PEER_BLOCK, PEER_HEADS, PEER_TOPK * PEER_TOPK)
        cand_i = (i1[..., :, None] * N_KEYS + i2[..., None, :]).reshape(PEER_BLOCK, PEER_HEADS, PEER_TOPK * PEER_TOPK)
        top_s, pos = lax.top_k(cand_s, PEER_TOPK)
        e = jnp.take_along_axis(cand_i, pos, axis=-1)
        gsc = jax.nn.softmax(top_s.astype(jnp.float32), axis=-1)
        a = jnp.einsum('nhkd,nd->nhk', u_tab[e], hb)
        act = (gsc * jax.nn.gelu(a.astype(jnp.float32), approximate=False)).astype(hb.dtype)
        return jnp.einsum('nhk,nhkd->nd', act, v_tab[e])

    return lax.map(block, tok).reshape(Bn, T, D)


def hybrid_layer(x, xc, mod, modc, w_in, conv_w, a_log, dt_bias, dn_out_norm, pool_w, pool_scale,
                 w_up_dn, w_up_pool, w_out, norm_mix, norm_ffn, peer_wq, peer_keys, peer_u, peer_v, update_ctx):
    rows = x.shape[1] // GRID_W
    sh1, sc1, gt1, sh2, sc2, gt2 = jnp.split(mod, 6, axis=-1)
    csh1, csc1, cgt1, csh2, csc2, cgt2 = jnp.split(modc, 6, axis=-1)
    qkv, z, pin, b_raw, a_raw, gd, gp = split_columns(modulate(rmsnorm(x, norm_mix), sh1, sc1) @ w_in)
    qkv_c, z_c, pin_c, b_raw_c, a_raw_c, gd_c, gp_c = split_columns(modulate(rmsnorm(xc, norm_mix), csh1, csc1) @ w_in)
    o_lat, o_ctx = bidirectional_delta(dn_inputs(qkv, b_raw, a_raw, conv_w, a_log, dt_bias),
                                       dn_inputs(qkv_c, b_raw_c, a_raw_c, conv_w, a_log, dt_bias))
    y_dn = dn_output(o_lat, z, dn_out_norm)
    y_pool = multiscale_pool(pin, pool_w, pool_scale, rows)
    x = x + gt1 * merge_branches(y_dn, y_pool, gd, gp, w_up_dn, w_up_pool, w_out)
    x = x + gt2 * peer_ffn(modulate(rmsnorm(x, norm_ffn), sh2, sc2), peer_wq, peer_keys, peer_u, peer_v)
    if update_ctx:
        y_dn_c = dn_output(o_ctx, z_c, dn_out_norm)
        y_pool_c = multiscale_pool(pin_c, pool_w, pool_scale, None)
        xc = xc + cgt1 * merge_branches(y_dn_c, y_pool_c, gd_c, gp_c, w_up_dn, w_up_pool, w_out)
        xc = xc + cgt2 * peer_ffn(modulate(rmsnorm(xc, norm_ffn), csh2, csc2), peer_wq, peer_keys, peer_u, peer_v)
    return x, xc


def setup_inputs(seed: int = 0) -> dict:
    key = jax.random.key(seed)
    ks = jax.random.split(key, 24)
    f32 = jnp.float32
    nrm = lambda k, shape, scale: jax.random.normal(k, shape, f32) * scale
    gain = lambda k, shape: 1.0 + 0.02 * jax.random.normal(k, shape, f32)
    dt = jnp.exp(jax.random.uniform(ks[10], (DEPTH, 2, DN_HEADS), f32, math.log(1e-3), math.log(1e-1)))
    return {
        'x': nrm(ks[0], (BATCH, SEQ, D_MODEL), 1.0),
        'c': nrm(ks[1], (BATCH, D_MODEL), 1.0),
        'ctx': nrm(ks[2], (BATCH, CTX_LEN, D_MODEL), 1.0),
        'c_ctx': nrm(ks[3], (D_MODEL,), 1.0),
        'w_mod': nrm(ks[4], (DEPTH, D_MODEL, 6 * D_MODEL), 0.5 * D_MODEL ** -0.5),
        'b_mod': nrm(ks[5], (DEPTH, 6 * D_MODEL), 0.02),
        'norm_mix': gain(ks[6], (DEPTH, D_MODEL)),
        'w_in': nrm(ks[7], (DEPTH, D_MODEL, IN_COLS), D_MODEL ** -0.5),
        'conv_w': nrm(ks[8], (DEPTH, SHORT_CONV, 3 * DN_WIDTH), SHORT_CONV ** -0.5),
        'a_log': jnp.log(jax.random.uniform(ks[9], (DEPTH, 2, DN_HEADS), f32, 1.0, 16.0)),
        'dt_bias': dt + jnp.log(-jnp.expm1(-dt)),
        'dn_out_norm': gain(ks[11], (DEPTH, DN_HEAD_DIM)),
        'pool_w': nrm(ks[12], (DEPTH, POOL_GROUPS, POOL_GW, POOL_GW), POOL_GW ** -0.5),
        'pool_scale': gain(ks[13], (DEPTH, POOL_WIDTH)),
        'w_up_dn': nrm(ks[14], (DEPTH, DN_WIDTH, D_MODEL), DN_WIDTH ** -0.5),
        'w_up_pool': nrm(ks[15], (DEPTH, POOL_WIDTH, D_MODEL), POOL_WIDTH ** -0.5),
        'w_out': nrm(ks[16], (DEPTH, D_MODEL, D_MODEL), D_MODEL ** -0.5),
        'norm_ffn': gain(ks[17], (DEPTH, D_MODEL)),
        'peer_wq': nrm(ks[18], (DEPTH, D_MODEL, PEER_HEADS * PEER_QDIM), D_MODEL ** -0.5),
        'peer_keys': nrm(ks[19], (DEPTH, PEER_HEADS, 2, N_KEYS, PEER_HALF), PEER_HALF ** -0.5),
        'peer_u': nrm(ks[20], (DEPTH, N_EXPERTS, D_MODEL), D_MODEL ** -0.5),
        'peer_v': nrm(ks[21], (DEPTH, N_EXPERTS, D_MODEL), 1.0),
        'final_norm': gain(ks[22], (D_MODEL,)),
    }


def reference(x, c, ctx, c_ctx, w_mod, b_mod, norm_mix, w_in, conv_w, a_log, dt_bias, dn_out_norm,
              pool_w, pool_scale, w_up_dn, w_up_pool, w_out, norm_ffn, peer_wq, peer_keys, peer_u, peer_v,
              final_norm):
    xc = ctx
    for i in range(DEPTH):
        mod = (jax.nn.silu(c) @ w_mod[i] + b_mod[i])[:, None, :].astype(x.dtype)
        modc = (jax.nn.silu(c_ctx) @ w_mod[i] + b_mod[i])[None, None, :].astype(x.dtype)
        x, xc = hybrid_layer(x, xc, mod, modc, w_in[i], conv_w[i], a_log[i], dt_bias[i], dn_out_norm[i],
                             pool_w[i], pool_scale[i], w_up_dn[i], w_up_pool[i], w_out[i], norm_mix[i],
                             norm_ffn[i], peer_wq[i], peer_keys[i], peer_u[i], peer_v[i], i < DEPTH - 1)
    return rmsnorm(x, final_norm)
```

```cpp
#include <hip/hip_runtime.h>
#include <hip/hip_cooperative_groups.h>
#include <stdint.h>
#include <stdio.h>

typedef unsigned short u16;
typedef __attribute__((ext_vector_type(8))) short bf16x8;
typedef __attribute__((ext_vector_type(4))) float f32x4;
typedef __attribute__((ext_vector_type(2))) float f32x2;
typedef __attribute__((ext_vector_type(2))) __bf16 bf16x2_t;

#define DEV __device__ __forceinline__

constexpr int D = 1024;
constexpr int BATCH = 2;
constexpr int SEQ = 8192;
constexpr int DEPTH = 2;
constexpr int CTX = 256;
constexpr int NLAT = BATCH * SEQ;
constexpr int NCTX = BATCH * CTX;
constexpr int R = NLAT + NCTX;
constexpr int DNH = 4;
constexpr int DK = 128;
constexpr int DNW = 512;
constexpr int INC = 4624;
constexpr int NPAD = 4736;
constexpr int NEXP = 16384;
constexpr float EPS = 1e-6f;
constexpr int NTHR = 256;
constexpr int LDK1 = 1088;
constexpr int LDK5 = 576;
constexpr int SMEM_BYTES = 73728;

struct Params {
  const float *x, *c, *ctx, *c_ctx, *w_mod, *b_mod, *norm_mix, *w_in, *conv_w, *a_log, *dt_bias, *dn_out_norm,
      *pool_w, *pool_scale, *w_up_dn, *w_up_pool, *w_out, *norm_ffn, *peer_wq, *peer_keys, *peer_u, *peer_v, *final_norm;
  float* out;
  unsigned char *tab8U, *tab8V;
  float *scU, *scV;
  u16 *WinT, *WdT, *WpT, *WoT, *WkT, *PwT;
  float *mod, *xc;
  u16 *h, *qkv_pre, *z, *pin, *sgd, *sgp;
  float* ba;
  u16* qkvn;
  float* bg;
  u16 *Wfrag, *KdT, *Ufrag, *Sfrag, *Vfrag;
  float *gc, *glast;
  u16 *ydn, *ypool, *m;
  float* topS;
  int* topI;
  unsigned* bar;
};

typedef const __attribute__((address_space(4))) Params* KP;
DEV KP get_params() {
  KP k = (KP)__builtin_amdgcn_kernarg_segment_ptr();
  asm volatile("" : "+s"(k));
  return k;
}
DEV int TID() { int t = __builtin_amdgcn_workitem_id_x(); asm volatile("" : "+v"(t)); return t; }
DEV int BID() { int t = __builtin_amdgcn_workgroup_id_x(); asm volatile("" : "+s"(t)); return t; }
DEV unsigned pack_bf16(float a, float b) {
  f32x2 v = {a, b};
  bf16x2_t r = __builtin_convertvector(v, bf16x2_t);
  return *(unsigned*)&r;
}
DEV u16 f2bf(float a) { return (u16)(pack_bf16(a, 0.f) & 0xffffu); }
DEV float bf_lo(unsigned u) { return __uint_as_float(u << 16); }
DEV float bf_hi(unsigned u) { return __uint_as_float(u & 0xffff0000u); }
DEV float bf2f(u16 h) { return __uint_as_float(((unsigned)h) << 16); }
DEV void unpack8(const uint4& v, float* f) {
  f[0] = bf_lo(v.x); f[1] = bf_hi(v.x); f[2] = bf_lo(v.y); f[3] = bf_hi(v.y);
  f[4] = bf_lo(v.z); f[5] = bf_hi(v.z); f[6] = bf_lo(v.w); f[7] = bf_hi(v.w);
}
DEV uint4 pack8(const float* f) {
  uint4 v;
  v.x = pack_bf16(f[0], f[1]); v.y = pack_bf16(f[2], f[3]); v.z = pack_bf16(f[4], f[5]); v.w = pack_bf16(f[6], f[7]);
  return v;
}
template <int O> DEV float swz_xor(float v) {
  return __builtin_bit_cast(float, __builtin_amdgcn_ds_swizzle(__builtin_bit_cast(int, v), (O << 10) | 0x1F));
}
template <int O> DEV unsigned swz_xor_u(unsigned v) {
  return (unsigned)__builtin_amdgcn_ds_swizzle((int)v, (O << 10) | 0x1F);
}
DEV float xor32_f(float v) {
  const int a = ((TID() & 63) ^ 32) << 2;
  return __builtin_bit_cast(float, __builtin_amdgcn_ds_bpermute(a, __builtin_bit_cast(int, v)));
}
DEV float wave_sum(float v) {
  v += xor32_f(v);
  v += swz_xor<16>(v); v += swz_xor<8>(v); v += swz_xor<4>(v); v += swz_xor<2>(v); v += swz_xor<1>(v);
  return v;
}
DEV float wave_max(float v) {
  v = fmaxf(v, xor32_f(v));
  v = fmaxf(v, swz_xor<16>(v)); v = fmaxf(v, swz_xor<8>(v)); v = fmaxf(v, swz_xor<4>(v));
  v = fmaxf(v, swz_xor<2>(v)); v = fmaxf(v, swz_xor<1>(v));
  return v;
}
DEV float group16_sum(float v) {
  v += swz_xor<8>(v); v += swz_xor<4>(v); v += swz_xor<2>(v); v += swz_xor<1>(v);
  return v;
}
DEV float sigmoidf_(float x) { return 1.f / (1.f + __expf(-x)); }
DEV float siluf_(float x) { return x / (1.f + __expf(-x)); }
DEV int modsel(int r) { return r < NLAT ? (r >> 13) : 2; }

DEV void transpose_tile(const float* __restrict__ src, int Nsrc, int ldd, u16* __restrict__ dst, int kt, int nt, int mode,
                        float* tile) {
  const int tid = TID();
  const int cl = tid & 63, rg = tid >> 6;
  const int nd = nt * 64 + cl;
  int ns = nd;
  bool valid = true;
  if (mode & 1) {
    if (nd < 2560) ns = nd;
    else if (nd < 4608) ns = nd + 16;
    else if (nd < 4624) ns = nd - 4608 + 2560;
    else { valid = false; ns = 0; }
  }
#pragma unroll
  for (int i = 0; i < 16; ++i) {
    const int kr = i * 4 + rg;
    float v = valid ? src[(size_t)(kt * 64 + kr) * Nsrc + ns] : 0.f;
    tile[kr * 65 + cl] = v;
  }
  __syncthreads();
  const int nr = tid >> 2, kc = (tid & 3) * 16;
  if (mode & 2) {
    int q4[4];
#pragma unroll
    for (int q = 0; q < 4; ++q) {
      int pk = __builtin_amdgcn_cvt_pk_fp8_f32(32.f * tile[(kc + 4 * q) * 65 + nr], 32.f * tile[(kc + 4 * q + 1) * 65 + nr], 0, false);
      q4[q] = __builtin_amdgcn_cvt_pk_fp8_f32(32.f * tile[(kc + 4 * q + 2) * 65 + nr], 32.f * tile[(kc + 4 * q + 3) * 65 + nr], pk, true);
    }
    *(int4*)((char*)dst + (size_t)(nt * 64 + nr) * ldd + kt * 64 + kc) = make_int4(q4[0], q4[1], q4[2], q4[3]);
    __syncthreads();
    return;
  }
  unsigned w[8];
#pragma unroll
  for (int q = 0; q < 8; ++q) w[q] = pack_bf16(tile[(kc + 2 * q) * 65 + nr], tile[(kc + 2 * q + 1) * 65 + nr]);
  uint4* d = (uint4*)(dst + (size_t)(nt * 64 + nr) * ldd + kt * 64 + kc);
  d[0] = make_uint4(w[0], w[1], w[2], w[3]);
  d[1] = make_uint4(w[4], w[5], w[6], w[7]);
  __syncthreads();
}

__device__ __forceinline__ void phase_init(char* smem) {
  const KP PP = get_params();
  const int tid = TID(), nb = gridDim.x, bid = BID();
  float* fs = (float*)smem;
  for (int u = bid; u < 192; u += nb) {
    const int layer = u / 96, col0 = (u % 96) * 64;
    float* sv = fs;
    float* red = fs + 3072;
    for (int i = tid; i < 3072; i += NTHR) {
      const int v = i >> 10, k = i & 1023;
      const float cv = (v < 2) ? PP->c[v * 1024 + k] : PP->c_ctx[k];
      sv[i] = siluf_(cv);
    }
    __syncthreads();
    const int cq = tid & 15, ks = tid >> 4;
    float acc[3][4];
#pragma unroll
    for (int v = 0; v < 3; ++v)
#pragma unroll
      for (int i = 0; i < 4; ++i) acc[v][i] = 0.f;
    const float* wb = PP->w_mod + ((size_t)layer * 1024 + ks * 64) * 6144 + col0 + cq * 4;
#pragma unroll 8
    for (int kk = 0; kk < 64; ++kk) {
      const float4 w4 = *(const float4*)(wb + (size_t)kk * 6144);
      const int k = ks * 64 + kk;
#pragma unroll
      for (int v = 0; v < 3; ++v) {
        const float s = sv[v * 1024 + k];
        acc[v][0] += s * w4.x; acc[v][1] += s * w4.y; acc[v][2] += s * w4.z; acc[v][3] += s * w4.w;
      }
    }
#pragma unroll
    for (int v = 0; v < 3; ++v)
#pragma unroll
      for (int i = 0; i < 4; ++i) red[(ks * 3 + v) * 64 + cq * 4 + i] = acc[v][i];
    __syncthreads();
    if (tid < 192) {
      const int v = tid >> 6, cc = tid & 63;
      float s = PP->b_mod[layer * 6144 + col0 + cc];
#pragma unroll
      for (int k2 = 0; k2 < 16; ++k2) s += red[(k2 * 3 + v) * 64 + cc];
      PP->mod[(size_t)(layer * 3 + v) * 6144 + col0 + cc] = s;
    }
    __syncthreads();
  }
  constexpr int NTL = 1184 + 128 + 128 + 256 + 16;
  for (int j = bid; j < NTL * DEPTH; j += nb) {
    const int layer = j / NTL;
    int jj = j % NTL;
    if (jj < 1184) {
      transpose_tile(PP->w_in + (size_t)layer * 1024 * INC, INC, LDK1, PP->WinT + (size_t)layer * NPAD * LDK1, jj / 74, jj % 74, 3, fs);
    } else if ((jj -= 1184) < 128) {
      transpose_tile(PP->w_up_dn + (size_t)layer * 512 * 1024, 1024, LDK5, PP->WdT + (size_t)layer * 1024 * LDK5, jj / 16, jj % 16, 2, fs);
    } else if ((jj -= 128) < 128) {
      transpose_tile(PP->w_up_pool + (size_t)layer * 512 * 1024, 1024, LDK5, PP->WpT + (size_t)layer * 1024 * LDK5, jj / 16, jj % 16, 2, fs);
    } else if ((jj -= 128) < 256) {
      transpose_tile(PP->w_out + (size_t)layer * 1024 * 1024, 1024, LDK1, PP->WoT + (size_t)layer * 1024 * LDK1, jj / 16, jj % 16, 2, fs);
    } else {
      jj -= 256;
      const int g = jj >> 2;
      transpose_tile(PP->pool_w + (size_t)(layer * 4 + g) * 128 * 128, 128, 128, PP->PwT + (size_t)(layer * 4 + g) * 128 * 128,
                     (jj & 3) >> 1, jj & 1, 0, fs);
    }
  }
  {
    const int tid2 = TID();
    const int l = tid2 & 63, w = tid2 >> 6, lr = l & 15, lg = l >> 4;
    char* Ks = smem;
    char* Ws = smem + 32768;
    for (int item = bid; item < DEPTH * 256; item += nb) {
      const int layer = item >> 8, hp = (item >> 4) & 15, ct = item & 15;
      __syncthreads();
      const float* ksrc = PP->peer_keys + (size_t)(layer * 16 + hp) * 128 * 128;
      for (int idx = tid2; idx < 128 * 16; idx += NTHR) {
        const int row = idx >> 4, ch = idx & 15;
        const float4 a = *(const float4*)(ksrc + row * 128 + ch * 8);
        const float4 c4 = *(const float4*)(ksrc + row * 128 + ch * 8 + 4);
        *(uint4*)(Ks + row * 256 + ((ch ^ (row & 15)) << 4)) =
            make_uint4(pack_bf16(a.x, a.y), pack_bf16(a.z, a.w), pack_bf16(c4.x, c4.y), pack_bf16(c4.z, c4.w));
      }
      const float* wsrc = PP->peer_wq + (size_t)layer * 1024 * 2048 + (size_t)(ct * 64) * 2048 + hp * 128;
      for (int idx = tid2; idx < 64 * 16; idx += NTHR) {
        const int row = idx >> 4, ch = idx & 15;
        const float4 a = *(const float4*)(wsrc + (size_t)row * 2048 + ch * 8);
        const float4 c4 = *(const float4*)(wsrc + (size_t)row * 2048 + ch * 8 + 4);
        *(uint4*)(Ws + row * 256 + ((ch ^ (row & 15)) << 4)) =
            make_uint4(pack_bf16(a.x, a.y), pack_bf16(a.z, a.w), pack_bf16(c4.x, c4.y), pack_bf16(c4.z, c4.w));
      }
      __syncthreads();
      f32x4 acc[2][4];
#pragma unroll
      for (int mi = 0; mi < 2; ++mi)
#pragma unroll
        for (int ni = 0; ni < 4; ++ni) acc[mi][ni] = (f32x4){0.f, 0.f, 0.f, 0.f};
#pragma unroll
      for (int ks = 0; ks < 4; ++ks) {
        const int ch = ks * 4 + lg;
        bf16x8 a[2], bb[4];
#pragma unroll
        for (int mi = 0; mi < 2; ++mi) a[mi] = *(const bf16x8*)(Ks + ((2 * w + mi) * 16 + lr) * 256 + ((ch ^ lr) << 4));
#pragma unroll
        for (int ni = 0; ni < 4; ++ni) bb[ni] = *(const bf16x8*)(Ws + (ni * 16 + lr) * 256 + ((ch ^ lr) << 4));
#pragma unroll
        for (int mi = 0; mi < 2; ++mi)
#pragma unroll
          for (int ni = 0; ni < 4; ++ni) acc[mi][ni] = __builtin_amdgcn_mfma_f32_16x16x32_bf16(a[mi], bb[ni], acc[mi][ni], 0, 0, 0);
      }
      u16* dst = PP->WkT + ((size_t)layer * 2048 + hp * 128) * LDK1 + ct * 64;
#pragma unroll
      for (int mi = 0; mi < 2; ++mi)
#pragma unroll
        for (int ni = 0; ni < 4; ++ni)
#pragma unroll
          for (int r = 0; r < 4; ++r) dst[(size_t)((2 * w + mi) * 16 + 4 * lg + r) * LDK1 + ni * 16 + lr] = f2bf(acc[mi][ni][r]);
    }
  }
}

DEV unsigned enc_e2m3(float x) {
  const float a = fabsf(x);
  float c;
  if (a < 2.f) c = a * 8.f;
  else if (a < 4.f) c = 16.f + (a - 2.f) * 4.f;
  else c = 24.f + (a - 4.f) * 2.f;
  unsigned code = (unsigned)__builtin_rintf(c);
  code = code > 31u ? 31u : code;
  return code | (x < 0.f ? 32u : 0u);
}
struct __attribute__((packed, aligned(4))) U3 { unsigned a, b, c; };
constexpr int TROW = 768;
typedef float f32x32_t __attribute__((ext_vector_type(32)));
typedef unsigned u32x6_t __attribute__((ext_vector_type(6)));

__device__ __forceinline__ void phase_tables(int layer, int vbid, int vnb) {
  const KP PP = get_params();
  const int tid = TID(), lane = tid & 63;
  const int gw = vbid * 4 + (tid >> 6), nw = vnb * 4;
  const float* su = PP->peer_u + (size_t)layer * NEXP * 1024;
  const float* sv = PP->peer_v + (size_t)layer * NEXP * 1024;
  for (int r0 = gw * 2; r0 < 2 * NEXP; r0 += nw * 2) {
    float4 v[2][4];
#pragma unroll
    for (int q = 0; q < 2; ++q) {
      const int r = r0 + q;
      const float* src = (r < NEXP ? su + (size_t)r * 1024 : sv + (size_t)(r - NEXP) * 1024);
#pragma unroll
      for (int i = 0; i < 4; ++i) v[q][i] = *(const float4*)(src + (lane + 64 * i) * 4);
    }
#pragma unroll
    for (int q = 0; q < 2; ++q) {
      const int r = r0 + q;
      float am = 0.f;
#pragma unroll
      for (int i = 0; i < 4; ++i)
        am = fmaxf(am, fmaxf(fmaxf(fabsf(v[q][i].x), fabsf(v[q][i].y)), fmaxf(fabsf(v[q][i].z), fabsf(v[q][i].w))));
      am = wave_max(am);
      const float scale = fmaxf(am, 1e-30f) * (1.f / 7.5f);
      const float inv = 1.f / scale;
      unsigned long long lo = 0ull;
      unsigned hi = 0u;
#pragma unroll
      for (int i = 0; i < 4; ++i) {
        const float vv[4] = {v[q][i].x * inv, v[q][i].y * inv, v[q][i].z * inv, v[q][i].w * inv};
#pragma unroll
        for (int j = 0; j < 4; ++j) {
          const int k = 4 * i + j;
          const unsigned cde = enc_e2m3(vv[j]);
          if (k < 10) lo |= (unsigned long long)cde << (6 * k);
          else if (k == 10) { lo |= (unsigned long long)cde << 60; hi |= cde >> 4; }
          else hi |= cde << (6 * k - 64);
        }
      }
      unsigned char* dst = (r < NEXP ? PP->tab8U + (size_t)r * TROW : PP->tab8V + (size_t)(r - NEXP) * TROW);
      U3 pk3;
      pk3.a = (unsigned)lo; pk3.b = (unsigned)(lo >> 32); pk3.c = hi;
      *(U3*)(dst + lane * 12) = pk3;
      if (lane == 0) { if (r < NEXP) PP->scU[r] = scale; else PP->scV[r - NEXP] = scale; }
    }
  }
}

__device__ __forceinline__ void phase_norm(int layer, int which) {
  const KP PP = get_params();
  const int lane = TID() & 63;
  const int gw = BID() * 4 + (TID() >> 6), nw = gridDim.x * 4;
  const float* nwt = (which == 1 ? PP->norm_mix : PP->norm_ffn) + layer * 1024;
  const int rlim = (which == 2 && layer == DEPTH - 1) ? NLAT : R;
  for (int r = gw; r < rlim; r += nw) {
    const float* xr;
    if (r < NLAT) xr = ((which == 1 && layer == 0) ? PP->x : PP->out) + (size_t)r * 1024;
    else xr = ((which == 1 && layer == 0) ? PP->ctx : PP->xc) + (size_t)(r - NLAT) * 1024;
    const float* md = PP->mod + (size_t)(layer * 3 + modsel(r)) * 6144 + (which == 1 ? 0 : 3072);
    float4 v[4];
    float ss = 0.f;
#pragma unroll
    for (int i = 0; i < 4; ++i) {
      v[i] = *(const float4*)(xr + (lane + 64 * i) * 4);
      ss += v[i].x * v[i].x + v[i].y * v[i].y + v[i].z * v[i].z + v[i].w * v[i].w;
    }
    ss = wave_sum(ss);
    const float rs = rsqrtf(ss * (1.f / 1024.f) + EPS);
#pragma unroll
    for (int i = 0; i < 4; ++i) {
      const int col = (lane + 64 * i) * 4;
      const float4 w = *(const float4*)(nwt + col);
      const float4 sh = *(const float4*)(md + col);
      const float4 sc = *(const float4*)(md + 1024 + col);
      const float y0 = v[i].x * rs * w.x * (1.f + sc.x) + sh.x;
      const float y1 = v[i].y * rs * w.y * (1.f + sc.y) + sh.y;
      const float y2 = v[i].z * rs * w.z * (1.f + sc.z) + sh.z;
      const float y3 = v[i].w * rs * w.w * (1.f + sc.w) + sh.w;
      if (which == 1) {
        int pk = __builtin_amdgcn_cvt_pk_fp8_f32(y0, y1, 0, false);
        pk = __builtin_amdgcn_cvt_pk_fp8_f32(y2, y3, pk, true);
        *(int*)((char*)PP->h + (size_t)r * (LDK1 * 2) + col) = pk;
      } else {
        *(uint2*)(PP->h + (size_t)r * LDK1 + col) = make_uint2(pack_bf16(y0, y1), pack_bf16(y2, y3));
      }
    }
  }
}

template <bool PRIO>
DEV void gemm_mainloop_t(const u16* __restrict__ A, int lda, const u16* __restrict__ B, int ldb, int K, int m0, int n0,
                         char* smem, f32x4 (&acc)[4][4]) {
  const int tid = TID();
  const int l = tid & 63, w = tid >> 6, wm = w >> 1, wn = w & 1, lr = l & 15, lg = l >> 4;
  uint4 ga0[4], gb0[4], ga1[4], gb1[4];
#pragma unroll
  for (int i = 0; i < 4; ++i) { ga0[i] = make_uint4(0u, 0u, 0u, 0u); gb0[i] = ga0[i]; ga1[i] = ga0[i]; gb1[i] = ga0[i]; }
  const int KT = K >> 6;
#define GLOAD(GA, GB, KT_)                                                                     \
  _Pragma("unroll") for (int i = 0; i < 4; ++i) {                                              \
    const int id = tid + 256 * i, row = id >> 3, c = id & 7;                                   \
    GA[i] = *(const uint4*)(A + (size_t)(m0 + row) * lda + (KT_) * 64 + c * 8);                \
    GB[i] = *(const uint4*)(B + (size_t)(n0 + row) * ldb + (KT_) * 64 + c * 8);                \
  }
#define LSTORE(GA, GB, BUF)                                                                    \
  {                                                                                            \
    char* as_ = smem + (BUF) * 32768;                                                          \
    char* bs_ = as_ + 16384;                                                                   \
    _Pragma("unroll") for (int i = 0; i < 4; ++i) {                                            \
      const int id = tid + 256 * i, row = id >> 3, c = id & 7;                                 \
      const int off = row * 128 + ((c ^ (row & 7)) << 4);                                      \
      *(uint4*)(as_ + off) = GA[i];                                                            \
      *(uint4*)(bs_ + off) = GB[i];                                                            \
    }                                                                                          \
  }
#define COMPUTE(BUF)                                                                                                      \
  {                                                                                                                       \
    const char* as_ = smem + (BUF) * 32768;                                                                               \
    const char* bs_ = as_ + 16384;                                                                                        \
    if (PRIO) __builtin_amdgcn_s_setprio(1);      \
    _Pragma("unroll") for (int ks = 0; ks < 2; ++ks) {                                                                    \
      bf16x8 a[4], b[4];                                                                                                  \
      const int c = ks * 4 + lg;                                                                                          \
      const int sw = ((c ^ (lr & 7)) << 4);                                                                               \
      _Pragma("unroll") for (int mi = 0; mi < 4; ++mi) a[mi] = *(const bf16x8*)(as_ + (wm * 64 + mi * 16 + lr) * 128 + sw); \
      _Pragma("unroll") for (int ni = 0; ni < 4; ++ni) b[ni] = *(const bf16x8*)(bs_ + (wn * 64 + ni * 16 + lr) * 128 + sw); \
      _Pragma("unroll") for (int mi = 0; mi < 4; ++mi)                                                                    \
        _Pragma("unroll") for (int ni = 0; ni < 4; ++ni)                                                                  \
          acc[mi][ni] = __builtin_amdgcn_mfma_f32_16x16x32_bf16(a[mi], b[ni], acc[mi][ni], 0, 0, 0);                      \
    }                                                                                                                     \
    if (PRIO) __builtin_amdgcn_s_setprio(0);                                                                              \
  }
  __syncthreads();
  GLOAD(ga0, gb0, 0);
  GLOAD(ga1, gb1, 1);
  LSTORE(ga0, gb0, 0);
  __syncthreads();
  for (int kt = 0; kt < KT; kt += 2) {
    if (kt + 2 < KT) { GLOAD(ga0, gb0, kt + 2); }
    COMPUTE(0);
    LSTORE(ga1, gb1, 1);
    __syncthreads();
    if (kt + 3 < KT) { GLOAD(ga1, gb1, kt + 3); }
    COMPUTE(1);
    if (kt + 2 < KT) { LSTORE(ga0, gb0, 0); }
    __syncthreads();
  }
#undef GLOAD
#undef LSTORE
#undef COMPUTE
}

DEV void gemm_mainloop(const u16* __restrict__ A, int lda, const u16* __restrict__ B, int ldb, int K, int m0, int n0,
                       char* smem, f32x4 (&acc)[4][4]) {
  gemm_mainloop_t<false>(A, lda, B, ldb, K, m0, n0, smem, acc);
}
DEV void gemm_mainloop1(const u16* __restrict__ A, int lda, const u16* __restrict__ B, int ldb, int K, int m0, int n0,
                       char* smem, f32x4 (&acc)[4][4]) {
  const int tid = TID();
  const int l = tid & 63, w = tid >> 6, wm = w >> 1, wn = w & 1, lr = l & 15, lg = l >> 4;
  uint4 ga[4], gb[4];
  const int KT = K >> 6;
  auto gload = [&](int kt) {
#pragma unroll
    for (int i = 0; i < 4; ++i) {
      const int id = tid + 256 * i, row = id >> 3, c = id & 7;
      ga[i] = *(const uint4*)(A + (size_t)(m0 + row) * lda + kt * 64 + c * 8);
      gb[i] = *(const uint4*)(B + (size_t)(n0 + row) * ldb + kt * 64 + c * 8);
    }
  };
  auto lstore = [&](int buf) {
    char* as = smem + buf * 32768;
    char* bs = as + 16384;
#pragma unroll
    for (int i = 0; i < 4; ++i) {
      const int id = tid + 256 * i, row = id >> 3, c = id & 7;
      const int off = row * 128 + ((c ^ (row & 7)) << 4);
      *(uint4*)(as + off) = ga[i];
      *(uint4*)(bs + off) = gb[i];
    }
  };
  __syncthreads();
  gload(0);
  lstore(0);
  __syncthreads();
  for (int kt = 0; kt < KT; ++kt) {
    if (kt + 1 < KT) gload(kt + 1);
    const char* as = smem + (kt & 1) * 32768;
    const char* bs = as + 16384;
#pragma unroll
    for (int ks = 0; ks < 2; ++ks) {
      bf16x8 a[4], b[4];
      const int c = ks * 4 + lg;
      const int sw = ((c ^ (lr & 7)) << 4);
#pragma unroll
      for (int mi = 0; mi < 4; ++mi) a[mi] = *(const bf16x8*)(as + (wm * 64 + mi * 16 + lr) * 128 + sw);
#pragma unroll
      for (int ni = 0; ni < 4; ++ni) b[ni] = *(const bf16x8*)(bs + (wn * 64 + ni * 16 + lr) * 128 + sw);
#pragma unroll
      for (int mi = 0; mi < 4; ++mi)
#pragma unroll
        for (int ni = 0; ni < 4; ++ni) acc[mi][ni] = __builtin_amdgcn_mfma_f32_16x16x32_bf16(a[mi], b[ni], acc[mi][ni], 0, 0, 0);
    }
    if (kt + 1 < KT) lstore((kt + 1) & 1);
    __syncthreads();
  }
}

DEV void zero_acc(f32x4 (&acc)[4][4]) {
#pragma unroll
  for (int i = 0; i < 4; ++i)
#pragma unroll
    for (int j = 0; j < 4; ++j) acc[i][j] = (f32x4){0.f, 0.f, 0.f, 0.f};
}

DEV void stage_half(const f32x4 (&acc)[4][4], int hsel, char* smem, float4 (&v)[8]) {
  const int tid = TID();
  const int l = tid & 63, w = tid >> 6, wm = w >> 1, wn = w & 1, lr = l & 15, lg = l >> 4;
  float* Cs = (float*)smem;
  __syncthreads();
  if (wm == hsel) {
#pragma unroll
    for (int mi = 0; mi < 4; ++mi)
#pragma unroll
      for (int ni = 0; ni < 4; ++ni)
#pragma unroll
        for (int r = 0; r < 4; ++r) Cs[(mi * 16 + lg * 4 + r) * 132 + wn * 64 + ni * 16 + lr] = acc[mi][ni][r];
  }
  __syncthreads();
#pragma unroll
  for (int j = 0; j < 8; ++j) {
    const int idx = tid + 256 * j, row = idx >> 5, c4 = idx & 31;
    v[j] = *(const float4*)&Cs[row * 132 + c4 * 4];
  }
}

DEV bool tile_map(int it, int MT, int NTl, int& mt, int& nt) {
  const int nb = gridDim.x, bid = BID();
  const int x = bid & 7, vl = bid >> 3, per = nb >> 3;
  const int T = MT * NTl;
  const int g_begin = (int)(((long long)x * T) >> 3), g_end = (int)(((long long)(x + 1) * T) >> 3);
  const int g = g_begin + vl + it * per;
  if (g >= g_end) return false;
  const int full = MT >> 3;
  const int sr = g / (8 * NTl);
  const int srow = sr < full ? sr : full;
  const int rows_in_sr = sr < full ? 8 : (MT & 7);
  const int tt = g - srow * 8 * NTl;
  nt = tt / rows_in_sr;
  mt = srow * 8 + tt % rows_in_sr;
  return true;
}

#define SG_LOCALS                                                                              \
  const int tid = TID();                                                                       \
  const int l = tid & 63, w = tid >> 6, wm = w >> 1, wn = w & 1, lr = l & 15, lg = l >> 4;     \
  uint4 ga0[4], gb0[4], ga1[4], gb1[4];                                                        \
  _Pragma("unroll") for (int i = 0; i < 4; ++i) {                                              \
    ga0[i] = make_uint4(0u, 0u, 0u, 0u); gb0[i] = ga0[i]; ga1[i] = ga0[i]; gb1[i] = ga0[i];    \
  }                                                                                            \
  const int r0 = tid >> 3, c0 = tid & 7;                                                       \
  const int pr0 = 8 * ((r0 & 15) >> 2) + 4 * (r0 >> 4) + (r0 & 3);
#define SG_LOAD(GA, GB, AP, BP, LD, M0_, N0_, KT_)                                             \
  _Pragma("unroll") for (int i = 0; i < 4; ++i) {                                              \
    GA[i] = *(const uint4*)((AP) + (size_t)((M0_) + 32 * i + r0) * (LD) + c0 * 8 + (KT_) * 64);  \
    GB[i] = *(const uint4*)((BP) + (size_t)((N0_) + 32 * i + pr0) * (LD) + c0 * 8 + (KT_) * 64); \
  }
#define SG_LSTORE(GA, GB, BUF)                                                                 \
  {                                                                                            \
    char* as_ = smem + (BUF) * 32768;                                                          \
    char* bs_ = as_ + 16384;                                                                   \
    _Pragma("unroll") for (int i = 0; i < 4; ++i) {                                            \
      const int id = tid + 256 * i, row = id >> 3, c = id & 7;                                 \
      const int off = row * 128 + ((c ^ (row & 7)) << 4);                                      \
      *(uint4*)(as_ + off) = GA[i];                                                            \
      *(uint4*)(bs_ + off) = GB[i];                                                            \
    }                                                                                          \
  }
#define SG_COMPUTE(ACC, BUF, PRIO)                                                                                        \
  {                                                                                                                       \
    const char* as_ = smem + (BUF) * 32768;                                                                               \
    const char* bs_ = as_ + 16384;                                                                                        \
    if (PRIO) __builtin_amdgcn_s_setprio(1);                                                                              \
    _Pragma("unroll") for (int ks = 0; ks < 2; ++ks) {                                                                    \
      bf16x8 a[4], b[4];                                                                                                  \
      const int c = ks * 4 + lg;                                                                                          \
      const int sw = ((c ^ (lr & 7)) << 4);                                                                               \
      _Pragma("unroll") for (int mi = 0; mi < 4; ++mi) a[mi] = *(const bf16x8*)(as_ + (wm * 64 + mi * 16 + lr) * 128 + sw); \
      _Pragma("unroll") for (int ni = 0; ni < 4; ++ni) b[ni] = *(const bf16x8*)(bs_ + (wn * 64 + ni * 16 + lr) * 128 + sw); \
      _Pragma("unroll") for (int mi = 0; mi < 4; ++mi)                                                                    \
        _Pragma("unroll") for (int ni = 0; ni < 4; ++ni)                                                                  \
          ACC[mi][ni] = __builtin_amdgcn_mfma_f32_16x16x32_bf16(b[ni], a[mi], ACC[mi][ni], 0, 0, 0);                      \
    }                                                                                                                     \
    if (PRIO) __builtin_amdgcn_s_setprio(0);                                                                              \
  }

typedef int i32x8 __attribute__((ext_vector_type(8)));
typedef int i32x4 __attribute__((ext_vector_type(4)));
#define F8_LOCALS                                                                              \
  const int tid = TID();                                                                       \
  const int l = tid & 63, w = tid >> 6, wm = w >> 1, wn = w & 1, lr = l & 15, lg = l >> 4;     \
  uint4 ga0[4], gb0[4], ga1[4], gb1[4];                                                        \
  _Pragma("unroll") for (int i = 0; i < 4; ++i) {                                              \
    ga0[i] = make_uint4(0u, 0u, 0u, 0u); gb0[i] = ga0[i]; ga1[i] = ga0[i]; gb1[i] = ga0[i];    \
  }                                                                                            \
  const int r0 = tid >> 3, c0 = tid & 7;                                                       \
  const int pr0 = 8 * ((r0 & 15) >> 2) + 4 * (r0 >> 4) + (r0 & 3);
#define F8_GLOAD(GA, GB, AP, LDA, BP, LDB, M0_, N0_, KT_)                                      \
  _Pragma("unroll") for (int i = 0; i < 4; ++i) {                                              \
    GA[i] = *(const uint4*)((AP) + (size_t)((M0_) + 32 * i + r0) * (LDA) + c0 * 16 + (KT_) * 128);   \
    GB[i] = *(const uint4*)((BP) + (size_t)((N0_) + 32 * i + pr0) * (LDB) + c0 * 16 + (KT_) * 128);  \
  }
#define F8_LSTORE(GA, GB, BUF)                                                                 \
  {                                                                                            \
    char* as_ = smem + (BUF) * 32768;                                                          \
    char* bs_ = as_ + 16384;                                                                   \
    _Pragma("unroll") for (int i = 0; i < 4; ++i) {                                            \
      const int id = tid + 256 * i, row = id >> 3, c = id & 7;                                 \
      const int off = row * 128 + ((c ^ (row & 7)) << 4);                                      \
      *(uint4*)(as_ + off) = GA[i];                                                            \
      *(uint4*)(bs_ + off) = GB[i];                                                            \
    }                                                                                          \
  }
#define F8_COMPUTE(BUF)                                                                                                   \
  {                                                                                                                       \
    const char* as_ = smem + (BUF) * 32768;                                                                               \
    const char* bs_ = as_ + 16384;                                                                                        \
    i32x8 a[4], b[4];                                                                                                     \
    const int sw0 = ((lg ^ (lr & 7)) << 4), sw1 = (((4 + lg) ^ (lr & 7)) << 4);                                           \
    _Pragma("unroll") for (int mi = 0; mi < 4; ++mi) {                                                                    \
      const char* p_ = as_ + (wm * 64 + mi * 16 + lr) * 128;                                                              \
      const i32x4 lo_ = *(const i32x4*)(p_ + sw0), hi_ = *(const i32x4*)(p_ + sw1);                                       \
      a[mi] = __builtin_shufflevector(lo_, hi_, 0, 1, 2, 3, 4, 5, 6, 7);                                                  \
    }                                                                                                                     \
    _Pragma("unroll") for (int ni = 0; ni < 4; ++ni) {                                                                    \
      const char* p_ = bs_ + (wn * 64 + ni * 16 + lr) * 128;                                                              \
      const i32x4 lo_ = *(const i32x4*)(p_ + sw0), hi_ = *(const i32x4*)(p_ + sw1);                                       \
      b[ni] = __builtin_shufflevector(lo_, hi_, 0, 1, 2, 3, 4, 5, 6, 7);                                                  \
    }                                                                                                                     \
    __builtin_amdgcn_s_setprio(1);                                                                                        \
    _Pragma("unroll") for (int mi = 0; mi < 4; ++mi)                                                                      \
      _Pragma("unroll") for (int ni = 0; ni < 4; ++ni)                                                                    \
        acc[mi][ni] = __builtin_amdgcn_mfma_scale_f32_16x16x128_f8f6f4(b[ni], a[mi], acc[mi][ni], 0, 0, 0, 0, 0, 0);      \
    __builtin_amdgcn_s_setprio(0);                                                                                        \
  }
#define F8_KLOOP(AP, LDA, BP, LDB, KT_)                                                        \
  for (int kt = 0; kt < (KT_); kt += 2) {                                                      \
    const bool wrap = (kt + 2 >= (KT_));                                                       \
    const int ml = wrap ? m0n : m0, nl = wrap ? n0n : n0, kl = wrap ? kt + 2 - (KT_) : kt + 2; \
    if (!wrap || hasn) { F8_GLOAD(ga0, gb0, AP, LDA, BP, LDB, ml, nl, kl); }                   \
    F8_COMPUTE(0);                                                                             \
    F8_LSTORE(ga1, gb1, 1);                                                                    \
    __syncthreads();                                                                           \
    if (!wrap || hasn) { F8_GLOAD(ga1, gb1, AP, LDA, BP, LDB, ml, nl, kl + 1); }               \
    F8_COMPUTE(1);                                                                             \
    if (!wrap || hasn) { F8_LSTORE(ga0, gb0, 0); }                                             \
    __syncthreads();                                                                           \
  }
#define F8_PROLOGUE(AP, LDA, BP, LDB)                                                          \
  __syncthreads();                           \
  F8_GLOAD(ga0, gb0, AP, LDA, BP, LDB, m0, n0, 0);                                             \
  F8_GLOAD(ga1, gb1, AP, LDA, BP, LDB, m0, n0, 1);                                             \
  F8_LSTORE(ga0, gb0, 0);                                                                      \
  __syncthreads();

__device__ __forceinline__ void phase_gemm_win(int layer, char* smem) {
  const KP PP = get_params();
  const char* Bt = (const char*)(PP->WinT + (size_t)layer * NPAD * LDK1);
  const char* A = (const char*)PP->h;
  F8_LOCALS
  int it = 0, mt, nt;
  if (!tile_map(it, R / 128, NPAD / 128, mt, nt)) return;
  int m0 = mt * 128, n0 = nt * 128;
  F8_PROLOGUE(A, LDK1 * 2, Bt, LDK1)
  for (;;) {
    int mtn = 0, ntn = 0;
    const bool hasn = tile_map(it + 1, R / 128, NPAD / 128, mtn, ntn);
    const int m0n = mtn * 128, n0n = ntn * 128;
    f32x4 acc[4][4];
    zero_acc(acc);
    F8_KLOOP(A, LDK1 * 2, Bt, LDK1, 8)
#pragma unroll
    for (int mi = 0; mi < 4; ++mi) {
      const size_t gr = (size_t)(m0 + wm * 64 + mi * 16 + lr);
#pragma unroll
      for (int g = 0; g < 2; ++g) {
        const int gc = n0 + wn * 64 + g * 32 + 8 * lg;
        const f32x4 t0 = acc[mi][2 * g] * (1.f / 32.f), t1 = acc[mi][2 * g + 1] * (1.f / 32.f);
        if (n0 < 1536) {
          int p0 = __builtin_amdgcn_cvt_pk_fp8_f32(t0[0], t0[1], 0, false);
          p0 = __builtin_amdgcn_cvt_pk_fp8_f32(t0[2], t0[3], p0, true);
          int p1 = __builtin_amdgcn_cvt_pk_fp8_f32(t1[0], t1[1], 0, false);
          p1 = __builtin_amdgcn_cvt_pk_fp8_f32(t1[2], t1[3], p1, true);
          *(int2*)((char*)PP->qkv_pre + gr * 1536 + gc) = make_int2(p0, p1);
        } else if (n0 < 2048) {
          *(uint4*)(PP->z + gr * 512 + (gc - 1536)) =
              make_uint4(pack_bf16(t0[0], t0[1]), pack_bf16(t0[2], t0[3]), pack_bf16(t1[0], t1[1]), pack_bf16(t1[2], t1[3]));
        } else if (n0 < 2560) {
          *(uint4*)(PP->pin + gr * 512 + (gc - 2048)) =
              make_uint4(pack_bf16(t0[0], t0[1]), pack_bf16(t0[2], t0[3]), pack_bf16(t1[0], t1[1]), pack_bf16(t1[2], t1[3]));
        } else if (n0 < 4608) {
          unsigned q0 = 0u, q1 = 0u;
#pragma unroll
          for (int e = 0; e < 4; ++e) {
            q0 = __builtin_amdgcn_cvt_pk_u8_f32(sigmoidf_(t0[e]) * 255.f, e, q0);
            q1 = __builtin_amdgcn_cvt_pk_u8_f32(sigmoidf_(t1[e]) * 255.f, e, q1);
          }
          unsigned char* gdst = (n0 < 3584) ? (unsigned char*)PP->sgd + gr * 1024 + (gc - 2560)
                                            : (unsigned char*)PP->sgp + gr * 1024 + (gc - 3584);
          *(uint2*)gdst = make_uint2(q0, q1);
        } else {
          if (gc - 4608 < 16) {
            *(float4*)(PP->ba + gr * 16 + (gc - 4608)) = make_float4(t0[0], t0[1], t0[2], t0[3]);
            *(float4*)(PP->ba + gr * 16 + (gc - 4608) + 4) = make_float4(t1[0], t1[1], t1[2], t1[3]);
          }
        }
      }
    }
    if (!hasn) break;
    m0 = m0n; n0 = n0n; ++it;
  }
}

__device__ __forceinline__ void phase_conv(int layer) {
  const KP PP = get_params();
  const int lane = TID() & 63;
  const int gw = BID() * 4 + (TID() >> 6), nw = gridDim.x * 4;
  const float* cw = PP->conv_w + (size_t)layer * 4 * 1536;
  float wr[3][4][8];
#pragma unroll
  for (int part = 0; part < 3; ++part)
#pragma unroll
    for (int j = 0; j < 4; ++j) {
      const float4 w0 = *(const float4*)(cw + j * 1536 + part * 512 + lane * 8);
      const float4 w1 = *(const float4*)(cw + j * 1536 + part * 512 + lane * 8 + 4);
      wr[part][j][0] = w0.x; wr[part][j][1] = w0.y; wr[part][j][2] = w0.z; wr[part][j][3] = w0.w;
      wr[part][j][4] = w1.x; wr[part][j][5] = w1.y; wr[part][j][6] = w1.z; wr[part][j][7] = w1.w;
    }
  for (int r = gw; r < R; r += nw) {
    int t, T;
    if (r < NLAT) { t = r & (SEQ - 1); T = SEQ; } else { t = (r - NLAT) & (CTX - 1); T = CTX; }
    const int base = r - t;
    uint2 xv[3][4];
#pragma unroll
    for (int j = 0; j < 4; ++j) {
      const int tt = t + j - 2;
      const bool ok = (tt >= 0 && tt < T);
      const unsigned char* src = (const unsigned char*)PP->qkv_pre + (size_t)(base + (ok ? tt : t)) * 1536 + lane * 8;
#pragma unroll
      for (int part = 0; part < 3; ++part) {
        xv[part][j] = *(const uint2*)(src + part * 512);
        if (!ok) xv[part][j] = make_uint2(0u, 0u);
      }
    }
#pragma unroll
    for (int part = 0; part < 3; ++part) {
      const int ch0 = part * 512 + lane * 8;
      float y[8];
#pragma unroll
      for (int e = 0; e < 8; ++e) y[e] = 0.f;
#pragma unroll
      for (int j = 0; j < 4; ++j) {
        float xf[8];
        {
          const f32x2 a0 = __builtin_amdgcn_cvt_pk_f32_fp8(xv[part][j].x, false), a1 = __builtin_amdgcn_cvt_pk_f32_fp8(xv[part][j].x, true);
          const f32x2 a2 = __builtin_amdgcn_cvt_pk_f32_fp8(xv[part][j].y, false), a3 = __builtin_amdgcn_cvt_pk_f32_fp8(xv[part][j].y, true);
          xf[0] = a0[0]; xf[1] = a0[1]; xf[2] = a1[0]; xf[3] = a1[1]; xf[4] = a2[0]; xf[5] = a2[1]; xf[6] = a3[0]; xf[7] = a3[1];
        }
#pragma unroll
        for (int e = 0; e < 8; ++e) y[e] += wr[part][j][e] * xf[e];
      }
      float ss = 0.f;
#pragma unroll
      for (int e = 0; e < 8; ++e) { y[e] = siluf_(y[e]); ss += y[e] * y[e]; }
      if (part < 2) {
        ss = group16_sum(ss);
        const float sc = rsqrtf(ss + EPS) * (part == 0 ? 0.08838834764831845f : 1.f);
#pragma unroll
        for (int e = 0; e < 8; ++e) y[e] *= sc;
      }
      *(uint4*)(PP->qkvn + (size_t)r * 1536 + ch0) = pack8(y);
    }
    if (lane < 16) {
      const float raw = PP->ba[(size_t)r * 16 + lane];
      float o;
      if (lane < 8) {
        o = sigmoidf_(raw);
      } else {
        const int jj = lane - 8;
        const float xx = raw + PP->dt_bias[layer * 8 + jj];
        const float ee = __expf(xx);
        const float sp = xx > 20.f ? xx : (ee < 0.03125f ? ee * (1.f - ee * (0.5f - ee * (0.33333334f - 0.25f * ee))) : __logf(1.f + ee));
        o = -__expf(PP->a_log[layer * 8 + jj]) * sp;
      }
      PP->bg[(size_t)r * 16 + lane] = o;
    }
  }
}

DEV int seq_row(int b, int dir, int pos) {
  if (dir == 0) return pos < CTX ? NLAT + b * CTX + pos : b * SEQ + (pos - CTX);
  return pos < CTX ? NLAT + b * CTX + (CTX - 1 - pos) : b * SEQ + (SEQ - 1 - (pos - CTX));
}
constexpr int NCHUNK = (CTX + SEQ) / 64;
constexpr int NUNIT = BATCH * DNH * 2 * NCHUNK;

DEV int kperm(int s, int g, int e) { return 32 * s + 16 * (e >> 2) + 4 * g + (e & 3); }

DEV uint4 pack_tiles(const f32x4& a, const f32x4& b) {
  return make_uint4(pack_bf16(a[0], a[1]), pack_bf16(a[2], a[3]), pack_bf16(b[0], b[1]), pack_bf16(b[2], b[3]));
}
DEV bf16x8 as_frag(const uint4& v) { return *(const bf16x8*)&v; }

DEV void conv8_silu(const unsigned char* __restrict__ qkv_pre8, const float* __restrict__ cw, int r, int ch0, float (&y)[8]) {
  int t, T;
  if (r < NLAT) { t = r & (SEQ - 1); T = SEQ; } else { t = (r - NLAT) & (CTX - 1); T = CTX; }
  const int base = r - t;
  uint2 xv[4];
#pragma unroll
  for (int j = 0; j < 4; ++j) {
    const int tt = t + j - 2;
    const bool ok = (tt >= 0 && tt < T);
    xv[j] = *(const uint2*)(qkv_pre8 + (size_t)(base + (ok ? tt : t)) * 1536 + ch0);
    if (!ok) xv[j] = make_uint2(0u, 0u);
  }
#pragma unroll
  for (int e = 0; e < 8; ++e) y[e] = 0.f;
#pragma unroll
  for (int j = 0; j < 4; ++j) {
    const float4 w0 = *(const float4*)(cw + j * 1536 + ch0), w1 = *(const float4*)(cw + j * 1536 + ch0 + 4);
    const f32x2 a0 = __builtin_amdgcn_cvt_pk_f32_fp8(xv[j].x, false), a1 = __builtin_amdgcn_cvt_pk_f32_fp8(xv[j].x, true);
    const f32x2 a2 = __builtin_amdgcn_cvt_pk_f32_fp8(xv[j].y, false), a3 = __builtin_amdgcn_cvt_pk_f32_fp8(xv[j].y, true);
    y[0] += w0.x * a0[0]; y[1] += w0.y * a0[1]; y[2] += w0.z * a1[0]; y[3] += w0.w * a1[1];
    y[4] += w1.x * a2[0]; y[5] += w1.y * a2[1]; y[6] += w1.z * a3[0]; y[7] += w1.w * a3[1];
  }
#pragma unroll
  for (int e = 0; e < 8; ++e) y[e] = siluf_(y[e]);
}

__device__ __forceinline__ void phase_prep(int layer, char* smem) {
  const KP PP = get_params();
  const int tid0 = TID();
  const int w = __builtin_amdgcn_readfirstlane(tid0 >> 6);
  char* Kt = smem;
  char* Vt = smem + 16384;
  float* Ld = (float*)(smem + 32768);
  u16* LN = (u16*)(smem + 32768 + 5120);
  float* gcs = (float*)(smem + 32768 + 5120 + 9216);
  float* bts = gcs + 64;
  char* wpriv = smem + 32768 + 5120 + 9216 + 512 + w * 6144;
  float* Tt = (float*)wpriv;
  u16* Xb = (u16*)(wpriv + 4096);
  for (int j_ = BID() >> 3; j_ < 2 * NCHUNK; j_ += (gridDim.x >> 3)) {
    const int c = NCHUNK - 1 - (j_ >> 1), u16i = (BID() & 7) * 2 + (j_ & 1);
    const int unit = u16i * NCHUNK + c;
    const int dir = u16i & 1, hd = (u16i >> 1) & 3, b = u16i >> 3;
    int tid = tid0;
    asm volatile("" : "+v"(tid));
    const int l = tid & 63, lr = l & 15, lg = l >> 4;
    __syncthreads();
    if (tid < 64) {
      const int rr = seq_row(b, dir, c * 64 + tid);
      const int jj = dir * 4 + hd;
      bts[tid] = sigmoidf_(PP->ba[(size_t)rr * 16 + jj]);
      float g;
      {
        const float xx = PP->ba[(size_t)rr * 16 + 8 + jj] + PP->dt_bias[layer * 8 + jj];
        const float ee = __expf(xx);
        const float sp = xx > 20.f ? xx : (ee < 0.03125f ? ee * (1.f - ee * (0.5f - ee * (0.33333334f - 0.25f * ee))) : __logf(1.f + ee));
        g = -__expf(PP->a_log[layer * 8 + jj]) * sp;
      }
#pragma unroll
      for (int o = 1; o < 64; o <<= 1) {
        const float t = __builtin_bit_cast(float, __builtin_amdgcn_ds_bpermute(((tid - o) & 63) << 2, __builtin_bit_cast(int, g)));
        if (tid >= o) g += t;
      }
      gcs[tid] = g;
      PP->gc[(size_t)unit * 64 + tid] = g;
    }
    {
      const unsigned char* pre8 = (const unsigned char*)PP->qkv_pre;
      const float* cw = PP->conv_w + (size_t)layer * 4 * 1536;
      const int ch = tid & 15, rg = tid >> 4;
      const int r_first = seq_row(b, dir, c * 64 + 4 * rg);
      int t0, T;
      if (r_first < NLAT) { t0 = r_first & (SEQ - 1); T = SEQ; } else { t0 = (r_first - NLAT) & (CTX - 1); T = CTX; }
      const int base = r_first - t0;
      const int tl = dir ? t0 - 3 : t0;
      const int nparts = dir == 0 ? 3 : 2;
      for (int part = 0; part < nparts; ++part) {
        const int chofs = (part == 0 ? 512 : (part == 1 ? 1024 : 0)) + hd * 128 + ch * 8;
        float wv[4][8];
#pragma unroll
        for (int j = 0; j < 4; ++j) {
          const float4 w0 = *(const float4*)(cw + j * 1536 + chofs), w1 = *(const float4*)(cw + j * 1536 + chofs + 4);
          wv[j][0] = w0.x; wv[j][1] = w0.y; wv[j][2] = w0.z; wv[j][3] = w0.w;
          wv[j][4] = w1.x; wv[j][5] = w1.y; wv[j][6] = w1.z; wv[j][7] = w1.w;
        }
        uint2 xr[7];
#pragma unroll
        for (int m = 0; m < 7; ++m) {
          const int tt = tl - 2 + m;
          const bool ok = (tt >= 0 && tt < T);
          xr[m] = *(const uint2*)(pre8 + (size_t)(base + (ok ? tt : t0)) * 1536 + chofs);
          if (!ok) xr[m] = make_uint2(0u, 0u);
        }
        float xf[7][8];
#pragma unroll
        for (int m = 0; m < 7; ++m) {
          const f32x2 a0 = __builtin_amdgcn_cvt_pk_f32_fp8(xr[m].x, false), a1 = __builtin_amdgcn_cvt_pk_f32_fp8(xr[m].x, true);
          const f32x2 a2 = __builtin_amdgcn_cvt_pk_f32_fp8(xr[m].y, false), a3 = __builtin_amdgcn_cvt_pk_f32_fp8(xr[m].y, true);
          xf[m][0] = a0[0]; xf[m][1] = a0[1]; xf[m][2] = a1[0]; xf[m][3] = a1[1];
          xf[m][4] = a2[0]; xf[m][5] = a2[1]; xf[m][6] = a3[0]; xf[m][7] = a3[1];
        }
#pragma unroll
        for (int s4 = 0; s4 < 4; ++s4) {
          const int m0_ = dir ? 3 - s4 : s4;
          float y[8];
          float ss = 0.f;
#pragma unroll
          for (int e2 = 0; e2 < 8; ++e2) {
            float a = 0.f;
#pragma unroll
            for (int j = 0; j < 4; ++j) a += wv[j][e2] * (dir ? xf[3 - s4 + j][e2] : xf[s4 + j][e2]);
            a = siluf_(a);
            y[e2] = a;
            ss += a * a;
          }
          if (part != 1) {
            ss = group16_sum(ss);
            const float sc = rsqrtf(ss + EPS) * (part == 2 ? 0.08838834764831845f : 1.f);
#pragma unroll
            for (int e2 = 0; e2 < 8; ++e2) y[e2] *= sc;
          }
          const uint4 pk = pack8(y);
          const int i = 4 * rg + s4;
          if (part < 2) *(uint4*)((part == 0 ? Kt : Vt) + i * 256 + ((ch ^ (i & 15)) << 4)) = pk;
          if (dir == 0 && part != 1) *(uint4*)(PP->qkvn + (size_t)(base + tl + m0_) * 1536 + chofs) = pk;
        }
      }
    }
    __syncthreads();
    {
      f32x4 acc[4];
#pragma unroll
      for (int nt = 0; nt < 4; ++nt) acc[nt] = (f32x4){0.f, 0.f, 0.f, 0.f};
#pragma unroll
      for (int s = 0; s < 4; ++s) {
        const int ch = s * 4 + lg;
        const bf16x8 a = *(const bf16x8*)(Kt + (16 * w + lr) * 256 + ((ch ^ lr) << 4));
#pragma unroll
        for (int nt = 0; nt < 4; ++nt) {
          const bf16x8 bb = *(const bf16x8*)(Kt + (16 * nt + lr) * 256 + ((ch ^ lr) << 4));
          acc[nt] = __builtin_amdgcn_mfma_f32_16x16x32_bf16(a, bb, acc[nt], 0, 0, 0);
        }
      }
#pragma unroll
      for (int nt = 0; nt < 4; ++nt)
#pragma unroll
        for (int r = 0; r < 4; ++r) {
          const int i = 16 * w + 4 * lg + r, j = 16 * nt + lr;
          const float val = (j < i) ? bts[i] * acc[nt][r] * __expf(fminf(gcs[i] - gcs[j], 0.f)) : 0.f;
          LN[i * 72 + j] = f2bf(-val);
          if (nt == w) Ld[(w * 16 + lr) * 20 + 4 * lg + r] = val;
        }
    }
    {
      const float glast = gcs[63];
      if (tid == 0) PP->glast[unit] = glast;
#pragma unroll
      for (int q4 = 0; q4 < 4; ++q4) {
        const int fid = tid + 256 * q4;
        const int mt = fid >> 7, s2 = (fid >> 6) & 1, ln = fid & 63, llr = ln & 15, llg = ln >> 4;
        const int d = 16 * mt + llr;
        float f[8];
#pragma unroll
        for (int e = 0; e < 8; ++e) {
          const int pos = kperm(s2, llg, e);
          const float kv = bf2f(*(const u16*)(Kt + pos * 256 + (((d >> 3) ^ (pos & 15)) << 4) + (d & 7) * 2));
          f[e] = kv * __expf(glast - gcs[pos]);
        }
        *(uint4*)(PP->KdT + ((size_t)unit * 1024 + fid) * 8) = pack8(f);
      }
    }
    f32x4 X[4][4];
    {
      const bool isU = w >= 2;
      const char* tile = isU ? Vt : Kt;
#pragma unroll
      for (int mt = 0; mt < 4; ++mt)
#pragma unroll
        for (int nt = 0; nt < 4; ++nt)
#pragma unroll
          for (int r = 0; r < 4; ++r) {
            const int i = 16 * mt + 4 * lg + r, cc = 64 * (w & 1) + 16 * nt + lr;
            const float val = bf2f(*(const u16*)(tile + i * 256 + (((cc >> 3) ^ (i & 15)) << 4) + (cc & 7) * 2));
            X[mt][nt][r] = bts[i] * val * (isU ? 1.f : __expf(gcs[i]));
          }
    }
    __syncthreads();
    u16* Wst = (u16*)smem;
    u16* Ust = (u16*)(smem + 16384);
#pragma unroll
    for (int bk = 0; bk < 4; ++bk) {
#pragma unroll
      for (int nt = 0; nt < 4; ++nt)
#pragma unroll
        for (int r = 0; r < 4; ++r) Tt[(4 * lg + r) * 64 + 16 * nt + lr] = X[bk][nt][r];
      __builtin_amdgcn_wave_barrier();
      asm volatile("s_waitcnt lgkmcnt(0)" ::: "memory");
      float xb[16];
#pragma unroll
      for (int i = 0; i < 16; ++i) xb[i] = Tt[i * 64 + l];
#pragma unroll
      for (int j = 0; j < 15; ++j) {
        const float xj = xb[j];
#pragma unroll
        for (int i4 = (j + 1) / 4; i4 < 4; ++i4) {
          const float4 lv = *(const float4*)&Ld[(bk * 16 + j) * 20 + i4 * 4];
          if (i4 * 4 + 0 > j) xb[i4 * 4 + 0] -= lv.x * xj;
          if (i4 * 4 + 1 > j) xb[i4 * 4 + 1] -= lv.y * xj;
          if (i4 * 4 + 2 > j) xb[i4 * 4 + 2] -= lv.z * xj;
          if (i4 * 4 + 3 > j) xb[i4 * 4 + 3] -= lv.w * xj;
        }
      }
      {
        const int cc = 64 * (w & 1) + l;
        if (w < 2) {
          const int d = cc, s = d >> 5, e = ((d >> 4) & 1) * 4 + (d & 3), g = (d >> 2) & 3;
#pragma unroll
          for (int ii = 0; ii < 16; ++ii) Wst[(((bk * 4 + s) * 64 + g * 16 + ii) << 3) + e] = f2bf(-xb[ii]);
        } else {
          const int slice = cc >> 4, lr_ = cc & 15;
#pragma unroll
          for (int ii = 0; ii < 16; ++ii) Ust[(((slice * 4 + bk) * 64 + ((ii >> 2) & 3) * 16 + lr_) << 2) + (ii & 3)] = f2bf(xb[ii]);
        }
        if (bk < 3) {
          *(uint4*)(Xb + l * 16) = pack8(xb);
          *(uint4*)(Xb + l * 16 + 8) = pack8(xb + 8);
        }
      }
      if (bk < 3) {
        __builtin_amdgcn_wave_barrier();
        asm volatile("s_waitcnt lgkmcnt(0)" ::: "memory");
        uint4 bfr[4];
#pragma unroll
        for (int nt = 0; nt < 4; ++nt)
          bfr[nt] = (lg < 2) ? *(const uint4*)(Xb + (16 * nt + lr) * 16 + 8 * lg) : make_uint4(0u, 0u, 0u, 0u);
#pragma unroll
        for (int mt = bk + 1; mt < 4; ++mt) {
          const uint4 afr = (lg < 2) ? *(const uint4*)(LN + (16 * mt + lr) * 72 + 16 * bk + 8 * lg) : make_uint4(0u, 0u, 0u, 0u);
#pragma unroll
          for (int nt = 0; nt < 4; ++nt)
            X[mt][nt] = __builtin_amdgcn_mfma_f32_16x16x32_bf16(as_frag(afr), as_frag(bfr[nt]), X[mt][nt], 0, 0, 0);
        }
        __builtin_amdgcn_wave_barrier();
      }
    }
    __syncthreads();
#pragma unroll
    for (int q = 0; q < 4; ++q) {
      const int id = tid + 256 * q;
      *(uint4*)(PP->Wfrag + ((size_t)unit * 1024 + id) * 8) = *(const uint4*)(smem + id * 16);
      *(uint4*)(PP->Ufrag + ((size_t)unit * 1024 + id) * 8) = *(const uint4*)(smem + 16384 + id * 16);
    }
  }
}


__device__ __forceinline__ void phase_scan(char* smem) {
  const KP PP = get_params();
  const int tid = TID(), lane = tid & 63, wv = tid >> 6;
  __builtin_amdgcn_s_setprio(3);
  for (int item = BID(); item < 128; item += gridDim.x) {
    const int u16i = (item & 7) * 2 + (item >> 6), slice = (item >> 3) & 7;
    const size_t ubase = (size_t)u16i * NCHUNK;
    const uint4* Wg = (const uint4*)PP->Wfrag;
    const uint4* Kg = (const uint4*)PP->KdT;
    __syncthreads();
    if (wv != 0) {
      const int j0 = wv - 1;
      uint4 st0[11], st1[11], st2[11];
#pragma unroll
      for (int i = 0; i < 11; ++i) { st0[i] = make_uint4(0u, 0u, 0u, 0u); st1[i] = st0[i]; st2[i] = st0[i]; }
#define LLOAD(ST, UNIT)                                                                                      \
  _Pragma("unroll") for (int i = 0; i < 11; ++i) {                                                           \
    const int q = (j0 + 3 * i) < 32 ? (j0 + 3 * i) : 31;                                                     \
    ST[i] = *((q < 16 ? Wg + (UNIT) * 1024 + q * 64 : Kg + (UNIT) * 1024 + (q - 16) * 64) + lane);           \
  }
#define LWRITE(ST, SLOT)                                                                                     \
  _Pragma("unroll") for (int i = 0; i < 11; ++i) {                                                           \
    const int q = (j0 + 3 * i) < 32 ? (j0 + 3 * i) : 31;                                                     \
    *(uint4*)((SLOT) + q * 1024 + lane * 16) = ST[i];                                                        \
  }
      LLOAD(st0, ubase);
      LLOAD(st1, ubase + 1);
      LLOAD(st2, ubase + 2);
      LWRITE(st0, smem);
      LLOAD(st0, ubase + 3);
      __syncthreads();
#define LSTEP(ST, C)                                                                   \
  {                                                                                    \
    LWRITE(ST, smem + (((C) + 1) & 1) * 32768);                                        \
    LLOAD(ST, ubase + (size_t)(((C) + 4 < NCHUNK) ? (C) + 4 : NCHUNK - 1));            \
    __syncthreads();                                                                   \
  }
      for (int c0 = 0; c0 < NCHUNK; c0 += 3) {
        LSTEP(st1, c0);
        LSTEP(st2, c0 + 1);
        LSTEP(st0, c0 + 2);
      }
#undef LSTEP
#undef LLOAD
#undef LWRITE
    } else {
      f32x4 S[8];
#pragma unroll
      for (int t = 0; t < 8; ++t) S[t] = (f32x4){0.f, 0.f, 0.f, 0.f};
      uint2 uf0[5], uf1[5], uf2[5];
#pragma unroll
      for (int i = 0; i < 5; ++i) { uf0[i] = make_uint2(0u, 0u); uf1[i] = uf0[i]; uf2[i] = uf0[i]; }
      const uint2* Ug = (const uint2*)PP->Ufrag + lane;
      const float* Gl = PP->glast;
#define ULOAD(UF, UNIT) { _Pragma("unroll") for (int i = 0; i < 4; ++i) UF[i] = Ug[((UNIT) * 8 + slice) * 256 + i * 64]; UF[4].x = __float_as_uint(Gl[UNIT]); }
      ULOAD(uf0, ubase);
      ULOAD(uf1, ubase + 1);
      ULOAD(uf2, ubase + 2);
#define CSTEP(UF, C)                                                                                                   \
  {                                                                                                                    \
    const int c = (C);                                                                                                 \
    const size_t unit = ubase + c;                                                                                     \
    const char* slot = smem + (c & 1) * 32768;                                                                         \
    const float el = __expf(__uint_as_float(UF[4].x));                                                                 \
    uint4 sb[4];                                                                                                       \
    _Pragma("unroll") for (int s2 = 0; s2 < 4; ++s2) sb[s2] = pack_tiles(S[2 * s2], S[2 * s2 + 1]);                    \
    {                                                                                                                  \
      uint4* sp = (uint4*)PP->Sfrag + (unit * 8 + slice) * 256 + lane;                                                 \
      _Pragma("unroll") for (int s2 = 0; s2 < 4; ++s2) sp[s2 * 64] = sb[s2];                                           \
    }                                                                                                                  \
    f32x4 vn[4];                                                                                                       \
    _Pragma("unroll") for (int mt = 0; mt < 4; ++mt) {                                                                 \
      vn[mt] = (f32x4){bf_lo(UF[mt].x), bf_hi(UF[mt].x), bf_lo(UF[mt].y), bf_hi(UF[mt].y)};                            \
      _Pragma("unroll") for (int s2 = 0; s2 < 4; ++s2) {                                                               \
        const uint4 wfr = *(const uint4*)(slot + (mt * 4 + s2) * 1024 + lane * 16);                                    \
        vn[mt] = __builtin_amdgcn_mfma_f32_16x16x32_bf16(as_frag(wfr), as_frag(sb[s2]), vn[mt], 0, 0, 0);              \
      }                                                                                                                \
    }                                                                                                                  \
    ULOAD(UF, ubase + (size_t)((c + 3 < NCHUNK) ? c + 3 : NCHUNK - 1));                                                \
    uint4 vb[2];                                                                                                       \
    vb[0] = pack_tiles(vn[0], vn[1]);                                                                                  \
    vb[1] = pack_tiles(vn[2], vn[3]);                                                                                  \
    {                                                                                                                  \
      uint4* vp = (uint4*)PP->Vfrag + (unit * 8 + slice) * 128 + lane;                                                 \
      vp[0] = vb[0];                                                                                                   \
      vp[64] = vb[1];                                                                                                  \
    }                                                                                                                  \
    _Pragma("unroll") for (int t = 0; t < 8; ++t) {                                                                    \
      S[t] *= el;                                                                                                      \
      const uint4 k0 = *(const uint4*)(slot + 16384 + (t * 2 + 0) * 1024 + lane * 16);                                 \
      const uint4 k1 = *(const uint4*)(slot + 16384 + (t * 2 + 1) * 1024 + lane * 16);                                 \
      S[t] = __builtin_amdgcn_mfma_f32_16x16x32_bf16(as_frag(k0), as_frag(vb[0]), S[t], 0, 0, 0);                      \
      S[t] = __builtin_amdgcn_mfma_f32_16x16x32_bf16(as_frag(k1), as_frag(vb[1]), S[t], 0, 0, 0);                      \
    }                                                                                                                  \
    __syncthreads();                                                                                                   \
  }
      __syncthreads();
      for (int c0 = 0; c0 < NCHUNK; c0 += 3) {
        CSTEP(uf0, c0);
        CSTEP(uf1, c0 + 1);
        CSTEP(uf2, c0 + 2);
      }
#undef CSTEP
#undef ULOAD
    }
  }
  __builtin_amdgcn_s_setprio(0);
}

__device__ __forceinline__ void phase_o(int layer, char* smem) {
  const KP PP = get_params();
  const int tid = TID(), l = tid & 63, w = tid >> 6, lr = l & 15, lg = l >> 4;
  char* Qt = smem;
  char* Kt = smem + 16384;
  u16* If = (u16*)(smem + 32768);
  u16* Ib = (u16*)(smem + 41984);
  float* gcf = (float*)(smem + 51200);
  float* gcb = gcf + 64;
  float* rowss = gcb + 64;
  float* Os = (float*)smem;
  const int nper = (layer == DEPTH - 1) ? 128 : 132;
  const int xq = BID() & 7, vl0 = BID() >> 3, vstep = gridDim.x >> 3;
  for (int vi = vl0; vi < nper; vi += vstep) {
    int b = xq >> 2, hd = xq & 3, tok0, cf, cb;
    if (vi < 128) {
      const int n = vi;
      tok0 = b * SEQ + 64 * n; cf = 4 + n; cb = 4 + 127 - n;
    } else {
      const int n = vi - 128;
      tok0 = NLAT + b * CTX + 64 * n; cf = n; cb = 3 - n;
    }
    const size_t unit_f = (size_t)((b * 4 + hd) * 2 + 0) * NCHUNK + cf;
    const size_t unit_b = (size_t)((b * 4 + hd) * 2 + 1) * NCHUNK + cb;
    uint4 pSF[4][2], pSB[4][2], pVF[2][2], pVB[2][2];
#pragma unroll
    for (int q = 0; q < 2; ++q) {
      const int sl = 2 * w + q;
#pragma unroll
      for (int s = 0; s < 4; ++s) {
        pSF[s][q] = *((const uint4*)PP->Sfrag + ((unit_f * 8 + sl) * 4 + s) * 64 + l);
        pSB[s][q] = *((const uint4*)PP->Sfrag + ((unit_b * 8 + sl) * 4 + s) * 64 + l);
      }
#pragma unroll
      for (int s2 = 0; s2 < 2; ++s2) {
        pVF[s2][q] = *((const uint4*)PP->Vfrag + ((unit_f * 8 + sl) * 2 + s2) * 64 + l);
        pVB[s2][q] = *((const uint4*)PP->Vfrag + ((unit_b * 8 + sl) * 2 + s2) * 64 + l);
      }
    }
    __syncthreads();
    for (int idx = tid; idx < 2048; idx += NTHR) {
      const int arr = idx >> 10, i = (idx >> 4) & 63, ch = idx & 15;
      const uint4 v = *(const uint4*)(PP->qkvn + (size_t)(tok0 + i) * 1536 + (arr == 0 ? 0 : 512) + hd * 128 + ch * 8);
      *(uint4*)((arr == 0 ? Qt : Kt) + i * 256 + ((ch ^ (i & 15)) << 4)) = v;
    }
    if (tid < 64) gcf[tid] = PP->gc[unit_f * 64 + tid];
    else if (tid < 128) gcb[tid - 64] = PP->gc[unit_b * 64 + (tid - 64)];
    __syncthreads();
    {
      f32x4 acc[4];
#pragma unroll
      for (int nt = 0; nt < 4; ++nt) acc[nt] = (f32x4){0.f, 0.f, 0.f, 0.f};
#pragma unroll
      for (int s = 0; s < 4; ++s) {
        const int ch = s * 4 + lg;
        const bf16x8 a = *(const bf16x8*)(Qt + (16 * w + lr) * 256 + ((ch ^ lr) << 4));
#pragma unroll
        for (int nt = 0; nt < 4; ++nt) {
          const bf16x8 bb = *(const bf16x8*)(Kt + (16 * nt + lr) * 256 + ((ch ^ lr) << 4));
          acc[nt] = __builtin_amdgcn_mfma_f32_16x16x32_bf16(a, bb, acc[nt], 0, 0, 0);
        }
      }
#pragma unroll
      for (int nt = 0; nt < 4; ++nt)
#pragma unroll
        for (int r = 0; r < 4; ++r) {
          const int i = 16 * w + 4 * lg + r, j = 16 * nt + lr;
          const float vf = (j <= i) ? acc[nt][r] * __expf(fminf(gcf[i] - gcf[j], 0.f)) : 0.f;
          const float vb = (j >= i) ? acc[nt][r] * __expf(fminf(gcb[63 - i] - gcb[63 - j], 0.f)) : 0.f;
          If[i * 72 + j] = f2bf(vf);
          Ib[i * 72 + (63 - j)] = f2bf(vb);
        }
    }
    __syncthreads();
    f32x4 accF[4][2], accB[4][2], accI[4][2];
#pragma unroll
    for (int mt = 0; mt < 4; ++mt)
#pragma unroll
      for (int q = 0; q < 2; ++q) {
        accF[mt][q] = (f32x4){0.f, 0.f, 0.f, 0.f};
        accB[mt][q] = (f32x4){0.f, 0.f, 0.f, 0.f};
        accI[mt][q] = (f32x4){0.f, 0.f, 0.f, 0.f};
      }
#pragma unroll
    for (int s = 0; s < 4; ++s) {
      bf16x8 qa[4];
#pragma unroll
      for (int mt = 0; mt < 4; ++mt) {
        const int row = 16 * mt + lr;
        const int c0 = 4 * s + (lg >> 1), c1 = c0 + 2;
        const uint2 lo = *(const uint2*)(Qt + row * 256 + ((c0 ^ lr) << 4) + (lg & 1) * 8);
        const uint2 hi = *(const uint2*)(Qt + row * 256 + ((c1 ^ lr) << 4) + (lg & 1) * 8);
        const uint4 t = make_uint4(lo.x, lo.y, hi.x, hi.y);
        qa[mt] = as_frag(t);
      }
#pragma unroll
      for (int q = 0; q < 2; ++q) {
        const int sl = 2 * w + q;
        const uint4 bF = pSF[s][q], bB = pSB[s][q];
#pragma unroll
        for (int mt = 0; mt < 4; ++mt) {
          accF[mt][q] = __builtin_amdgcn_mfma_f32_16x16x32_bf16(qa[mt], as_frag(bF), accF[mt][q], 0, 0, 0);
          accB[mt][q] = __builtin_amdgcn_mfma_f32_16x16x32_bf16(qa[mt], as_frag(bB), accB[mt][q], 0, 0, 0);
        }
      }
    }
#pragma unroll
    for (int s2 = 0; s2 < 2; ++s2) {
      bf16x8 ia[4], ib[4];
#pragma unroll
      for (int mt = 0; mt < 4; ++mt) {
        const int row = 16 * mt + lr;
        const int col = 32 * s2 + 4 * lg;
        const uint2 flo = *(const uint2*)(If + row * 72 + col);
        const uint2 fhi = *(const uint2*)(If + row * 72 + col + 16);
        const uint2 blo = *(const uint2*)(Ib + row * 72 + col);
        const uint2 bhi = *(const uint2*)(Ib + row * 72 + col + 16);
        const uint4 tf = make_uint4(flo.x, flo.y, fhi.x, fhi.y);
        const uint4 tb = make_uint4(blo.x, blo.y, bhi.x, bhi.y);
        ia[mt] = as_frag(tf);
        ib[mt] = as_frag(tb);
      }
#pragma unroll
      for (int q = 0; q < 2; ++q) {
        const int sl = 2 * w + q;
        const uint4 vF = pVF[s2][q], vB = pVB[s2][q];
#pragma unroll
        for (int mt = 0; mt < 4; ++mt) {
          accI[mt][q] = __builtin_amdgcn_mfma_f32_16x16x32_bf16(ia[mt], as_frag(vF), accI[mt][q], 0, 0, 0);
          accI[mt][q] = __builtin_amdgcn_mfma_f32_16x16x32_bf16(ib[mt], as_frag(vB), accI[mt][q], 0, 0, 0);
        }
      }
    }
    float o[4][2][4];
#pragma unroll
    for (int mt = 0; mt < 4; ++mt)
#pragma unroll
      for (int r = 0; r < 4; ++r) {
        const int i = 16 * mt + 4 * lg + r;
        const float ef = __expf(gcf[i]), eb = __expf(gcb[63 - i]);
        float ss = 0.f;
#pragma unroll
        for (int q = 0; q < 2; ++q) {
          const float v = ef * accF[mt][q][r] + eb * accB[mt][q][r] + accI[mt][q][r];
          o[mt][q][r] = v;
          ss += v * v;
        }
        ss = group16_sum(ss);
        if (lr == 0) rowss[w * 64 + i] = ss;
      }
    __syncthreads();
#pragma unroll
    for (int mt = 0; mt < 4; ++mt)
#pragma unroll
      for (int q = 0; q < 2; ++q)
#pragma unroll
        for (int r = 0; r < 4; ++r) Os[(16 * mt + 4 * lg + r) * 132 + 16 * (2 * w + q) + lr] = o[mt][q][r];
    __syncthreads();
#pragma unroll
    for (int q4 = 0; q4 < 4; ++q4) {
      const int idx = tid + 256 * q4, i = idx >> 4, ch = idx & 15;
      const float ss = rowss[i] + rowss[64 + i] + rowss[128 + i] + rowss[192 + i];
      const float rs = rsqrtf(ss * (1.f / 128.f) + EPS);
      const float4 o0 = *(const float4*)&Os[i * 132 + ch * 8];
      const float4 o1 = *(const float4*)&Os[i * 132 + ch * 8 + 4];
      const float4 n0 = *(const float4*)(PP->dn_out_norm + layer * 128 + ch * 8);
      const float4 n1 = *(const float4*)(PP->dn_out_norm + layer * 128 + ch * 8 + 4);
      float zf[8];
      unpack8(*(const uint4*)(PP->z + (size_t)(tok0 + i) * 512 + hd * 128 + ch * 8), zf);
      float y[8];
      y[0] = o0.x * rs * n0.x * siluf_(zf[0]); y[1] = o0.y * rs * n0.y * siluf_(zf[1]);
      y[2] = o0.z * rs * n0.z * siluf_(zf[2]); y[3] = o0.w * rs * n0.w * siluf_(zf[3]);
      y[4] = o1.x * rs * n1.x * siluf_(zf[4]); y[5] = o1.y * rs * n1.y * siluf_(zf[5]);
      y[6] = o1.z * rs * n1.z * siluf_(zf[6]); y[7] = o1.w * rs * n1.w * siluf_(zf[7]);
      {
        int p0 = __builtin_amdgcn_cvt_pk_fp8_f32(y[0], y[1], 0, false);
        p0 = __builtin_amdgcn_cvt_pk_fp8_f32(y[2], y[3], p0, true);
        int p1 = __builtin_amdgcn_cvt_pk_fp8_f32(y[4], y[5], 0, false);
        p1 = __builtin_amdgcn_cvt_pk_fp8_f32(y[6], y[7], p1, true);
        *(int2*)((char*)PP->ydn + (size_t)(tok0 + i) * (LDK5 * 2) + hd * 128 + ch * 8) = make_int2(p0, p1);
      }
    }
  }
}

template <int HALF>
DEV void pool_window(const u16* xin, char* Ap, int t0, int L, int tid) {
#pragma unroll
  for (int q = 0; q < 4; ++q) {
    const int idx = tid + 256 * q, i = idx >> 4, c = idx & 15;
    const int t = t0 + i;
    const int lo = (t - HALF) > 0 ? (t - HALF) : 0;
    const int hi = (t + HALF) < L ? (t + HALF) : L;
    float s[8];
#pragma unroll
    for (int e = 0; e < 8; ++e) s[e] = 0.f;
#pragma unroll
    for (int k = 0; k < 2 * HALF; ++k) {
      float f[8];
      unpack8(*(const uint4*)(xin + (i + 8 - HALF + k) * 128 + c * 8), f);
#pragma unroll
      for (int e = 0; e < 8; ++e) s[e] += f[e];
    }
    float xs[8];
    unpack8(*(const uint4*)(xin + (i + 8) * 128 + c * 8), xs);
    const float inv = 1.f / (float)(hi - lo);
#pragma unroll
    for (int e = 0; e < 8; ++e) s[e] = s[e] * inv - xs[e];
    *(uint4*)(Ap + i * 256 + ((c ^ (i & 15)) << 4)) = pack8(s);
  }
}

__device__ __forceinline__ void phase_pool(int layer, char* smem, int vbid, int vnb) {
  const KP PP = get_params();
  const int tid = TID(), l = tid & 63, w = tid >> 6, lr = l & 15, lg = l >> 4;
  u16* xin = (u16*)smem;
  char* Ap = smem + 20480;
  char* Bs = smem + 36864;
  const int ntile = (layer == DEPTH - 1) ? NLAT / 64 : R / 64;
  for (int it = vbid; it < ntile * 4; it += vnb) {
    const int ti = it >> 2, g = it & 3;
    int L, t0, rowbase;
    if (ti < NLAT / 64) { L = 64; t0 = 0; rowbase = ti * 64; }
    else { const int ci = ti - NLAT / 64; L = CTX; t0 = (ci & 3) * 64; rowbase = NLAT + (ci >> 2) * CTX; }
    const int r0 = rowbase + t0;
    __syncthreads();
#pragma unroll
    for (int q = 0; q < 5; ++q) {
      const int idx = tid + 256 * q, i = idx >> 4, c = idx & 15;
      const int pos = t0 - 8 + i;
      uint4 v = make_uint4(0, 0, 0, 0);
      if (pos >= 0 && pos < L) v = *(const uint4*)(PP->pin + (size_t)(rowbase + pos) * 512 + g * 128 + c * 8);
      *(uint4*)(xin + i * 128 + c * 8) = v;
    }
    {
      const u16* Bw = PP->PwT + (size_t)(layer * 4 + g) * 128 * 128;
#pragma unroll
      for (int q = 0; q < 8; ++q) {
        const int idx = tid + 256 * q, n = idx >> 4, c = idx & 15;
        *(uint4*)(Bs + n * 256 + ((c ^ (n & 15)) << 4)) = *(const uint4*)(Bw + (size_t)n * 128 + c * 8);
      }
    }
    __syncthreads();
    if (g == 0) pool_window<1>(xin, Ap, t0, L, tid);
    else if (g == 1) pool_window<2>(xin, Ap, t0, L, tid);
    else if (g == 2) pool_window<4>(xin, Ap, t0, L, tid);
    else pool_window<8>(xin, Ap, t0, L, tid);
    __syncthreads();
    f32x4 acc[8];
#pragma unroll
    for (int ni = 0; ni < 8; ++ni) acc[ni] = (f32x4){0.f, 0.f, 0.f, 0.f};
#pragma unroll
    for (int ks = 0; ks < 4; ++ks) {
      const int row = w * 16 + lr, c = ks * 4 + lg;
      const bf16x8 a = *(const bf16x8*)(Ap + row * 256 + ((c ^ lr) << 4));
#pragma unroll
      for (int ni = 0; ni < 8; ++ni) {
        const bf16x8 bb = *(const bf16x8*)(Bs + (ni * 16 + lr) * 256 + ((c ^ lr) << 4));
        acc[ni] = __builtin_amdgcn_mfma_f32_16x16x32_bf16(bb, a, acc[ni], 0, 0, 0);
      }
    }
    unsigned char* ot = (unsigned char*)smem;
#pragma unroll
    for (int ni = 0; ni < 8; ++ni) {
      const int dcol = ni * 16 + 4 * lg;
      const float4 psc = *(const float4*)(PP->pool_scale + layer * 512 + g * 128 + dcol);
      int pk = __builtin_amdgcn_cvt_pk_fp8_f32(acc[ni][0] * psc.x, acc[ni][1] * psc.y, 0, false);
      pk = __builtin_amdgcn_cvt_pk_fp8_f32(acc[ni][2] * psc.z, acc[ni][3] * psc.w, pk, true);
      *(int*)(ot + (w * 16 + lr) * 128 + dcol) = pk;
    }
    __syncthreads();
    {
      const int row = tid >> 2, seg = tid & 3;
      const uint4 o0 = *(const uint4*)(ot + row * 128 + seg * 32), o1 = *(const uint4*)(ot + row * 128 + seg * 32 + 16);
      unsigned char* dst = (unsigned char*)PP->ypool + (size_t)(r0 + row) * (LDK5 * 2) + g * 128 + seg * 32;
      *(uint4*)dst = o0;
      *(uint4*)(dst + 16) = o1;
    }
  }
}

__device__ __forceinline__ void phase_merge(int layer, char* smem) {
  const KP PP = get_params();
  const char* Bd = (const char*)(PP->WdT + (size_t)layer * 1024 * LDK5);
  const char* Bp = (const char*)(PP->WpT + (size_t)layer * 1024 * LDK5);
  const char* Ad = (const char*)PP->ydn;
  const char* Ap = (const char*)PP->ypool;
  const int tid = TID();
  const int l = tid & 63, w = tid >> 6, wm = w >> 1, wn = w & 1, lr = l & 15, lg = l >> 4;
  uint4 ga[4], gb[4];
#pragma unroll
  for (int i = 0; i < 4; ++i) { ga[i] = make_uint4(0u, 0u, 0u, 0u); gb[i] = ga[i]; }
  const int r0 = tid >> 3, c0 = tid & 7;
#define MG_GLOAD(AP, BP, KT_)                                                                  \
  _Pragma("unroll") for (int i = 0; i < 4; ++i) {                                              \
    ga[i] = *(const uint4*)((AP) + (size_t)(m0 + 32 * i + r0) * (LDK5 * 2) + c0 * 16 + (KT_) * 128);  \
    gb[i] = *(const uint4*)((BP) + (size_t)(n0 + 32 * i + r0) * LDK5 + c0 * 16 + (KT_) * 128);        \
  }
#define MG_LSTORE(BUF)                                                                         \
  {                                                                                            \
    char* as_ = smem + (BUF) * 32768;                                                          \
    char* bs_ = as_ + 16384;                                                                   \
    _Pragma("unroll") for (int i = 0; i < 4; ++i) {                                            \
      const int id = tid + 256 * i, row = id >> 3, c = id & 7;                                 \
      const int off = row * 128 + ((c ^ (row & 7)) << 4);                                      \
      *(uint4*)(as_ + off) = ga[i];                                                            \
      *(uint4*)(bs_ + off) = gb[i];                                                            \
    }                                                                                          \
  }
#define MG_COMPUTE(ACC, BUF)                                                                                              \
  {                                                                                                                       \
    const char* as_ = smem + (BUF) * 32768;                                                                               \
    const char* bs_ = as_ + 16384;                                                                                        \
    i32x8 a[4], b[4];                                                                                                     \
    const int sw0 = ((lg ^ (lr & 7)) << 4), sw1 = (((4 + lg) ^ (lr & 7)) << 4);                                           \
    _Pragma("unroll") for (int mi = 0; mi < 4; ++mi) {                                                                    \
      const char* p_ = as_ + (wm * 64 + mi * 16 + lr) * 128;                                                              \
      const i32x4 lo_ = *(const i32x4*)(p_ + sw0), hi_ = *(const i32x4*)(p_ + sw1);                                       \
      a[mi] = __builtin_shufflevector(lo_, hi_, 0, 1, 2, 3, 4, 5, 6, 7);                                                  \
    }                                                                                                                     \
    _Pragma("unroll") for (int ni = 0; ni < 4; ++ni) {                                                                    \
      const char* p_ = bs_ + (wn * 64 + ni * 16 + lr) * 128;                                                              \
      const i32x4 lo_ = *(const i32x4*)(p_ + sw0), hi_ = *(const i32x4*)(p_ + sw1);                                       \
      b[ni] = __builtin_shufflevector(lo_, hi_, 0, 1, 2, 3, 4, 5, 6, 7);                                                  \
    }                                                                                                                     \
    _Pragma("unroll") for (int mi = 0; mi < 4; ++mi)                                                                      \
      _Pragma("unroll") for (int ni = 0; ni < 4; ++ni)                                                                    \
        ACC[mi][ni] = __builtin_amdgcn_mfma_scale_f32_16x16x128_f8f6f4(a[mi], b[ni], ACC[mi][ni], 0, 0, 0, 0, 0, 0);      \
  }
  const int MT = (layer == DEPTH - 1) ? NLAT / 128 : R / 128;
  for (int it = 0;; ++it) {
    int mt, nt;
    if (!tile_map(it, MT, 8, mt, nt)) break;
    const int m0 = mt * 128, n0 = nt * 128;
    f32x4 acc[4][4];
    zero_acc(acc);
    __syncthreads();
    MG_GLOAD(Ad, Bd, 0);
    MG_LSTORE(0);
    __syncthreads();
#pragma unroll
    for (int kt = 0; kt < 4; ++kt) {
      if (kt + 1 < 4) { MG_GLOAD(Ad, Bd, kt + 1); } else { MG_GLOAD(Ap, Bp, 0); }
      MG_COMPUTE(acc, kt & 1);
      MG_LSTORE((kt + 1) & 1);
      __syncthreads();
    }
    uint2 tq[2][8];
#pragma unroll
    for (int hs = 0; hs < 2; ++hs)
#pragma unroll
      for (int j = 0; j < 8; ++j) tq[hs][j] = make_uint2(0u, 0u);
#pragma unroll
    for (int hs = 0; hs < 2; ++hs) {
      float4 v1[8];
      stage_half(acc, hs, smem + 32768, v1);
#pragma unroll
      for (int j = 0; j < 8; ++j) tq[hs][j] = make_uint2(pack_bf16(v1[j].x, v1[j].y), pack_bf16(v1[j].z, v1[j].w));
    }
    __builtin_amdgcn_sched_barrier(0);
    zero_acc(acc);
    __syncthreads();
#pragma unroll
    for (int kt = 0; kt < 4; ++kt) {
      if (kt + 1 < 4) { MG_GLOAD(Ap, Bp, kt + 1); }
      MG_COMPUTE(acc, kt & 1);
      if (kt + 1 < 4) { MG_LSTORE((kt + 1) & 1); }
      __syncthreads();
    }
#pragma unroll
    for (int hs = 0; hs < 2; ++hs) {
      float4 v2[8];
      stage_half(acc, hs, smem, v2);
      const int tid2 = TID();
#pragma unroll
      for (int j = 0; j < 8; ++j) {
        const int idx = tid2 + 256 * j, row = idx >> 5, c4 = idx & 31;
        const size_t gr = (size_t)(m0 + hs * 64 + row);
        const int gc = n0 + c4 * 4;
        const unsigned gd = *(const unsigned*)((const unsigned char*)PP->sgd + gr * 1024 + gc);
        const unsigned gp = *(const unsigned*)((const unsigned char*)PP->sgp + gr * 1024 + gc);
        const uint2 t = tq[hs][j];
        constexpr float GS = 1.f / (255.f * 32.f);
        const float o0 = ((float)(gd & 0xffu) * bf_lo(t.x) + (float)(gp & 0xffu) * v2[j].x) * GS;
        const float o1 = ((float)((gd >> 8) & 0xffu) * bf_hi(t.x) + (float)((gp >> 8) & 0xffu) * v2[j].y) * GS;
        const float o2 = ((float)((gd >> 16) & 0xffu) * bf_lo(t.y) + (float)((gp >> 16) & 0xffu) * v2[j].z) * GS;
        const float o3 = ((float)(gd >> 24) * bf_hi(t.y) + (float)(gp >> 24) * v2[j].w) * GS;
        int pk = __builtin_amdgcn_cvt_pk_fp8_f32(o0, o1, 0, false);
        pk = __builtin_amdgcn_cvt_pk_fp8_f32(o2, o3, pk, true);
        *(int*)((char*)PP->m + gr * (LDK1 * 2) + gc) = pk;
        if ((j & 1) == 1) __builtin_amdgcn_sched_barrier(0);
      }
    }
  }
#undef MG_GLOAD
#undef MG_LSTORE
#undef MG_COMPUTE
}

__device__ __forceinline__ void phase_outproj(int layer, char* smem) {
  const KP PP = get_params();
  const char* Bt = (const char*)(PP->WoT + (size_t)layer * 1024 * LDK1);
  const char* A = (const char*)PP->m;
  F8_LOCALS
  const int MT = (layer == DEPTH - 1) ? NLAT / 128 : R / 128;
  int it = 0, mt, nt;
  if (!tile_map(it, MT, 8, mt, nt)) return;
  int m0 = mt * 128, n0 = nt * 128;
  F8_PROLOGUE(A, LDK1 * 2, Bt, LDK1)
  for (;;) {
    int mtn = 0, ntn = 0;
    const bool hasn = tile_map(it + 1, MT, 8, mtn, ntn);
    const int m0n = mtn * 128, n0n = ntn * 128;
    f32x4 acc[4][4];
    zero_acc(acc);
    F8_KLOOP(A, LDK1 * 2, Bt, LDK1, 8)
#pragma unroll
    for (int mi = 0; mi < 4; ++mi) {
      const int gr = m0 + wm * 64 + mi * 16 + lr;
      const float* modp = PP->mod + (size_t)(layer * 3 + modsel(gr)) * 6144 + 2048;
      const float* xin;
      float* xo;
      if (gr < NLAT) {
        xin = (layer == 0 ? PP->x : PP->out) + (size_t)gr * 1024;
        xo = PP->out + (size_t)gr * 1024;
      } else {
        xin = (layer == 0 ? PP->ctx : PP->xc) + (size_t)(gr - NLAT) * 1024;
        xo = PP->xc + (size_t)(gr - NLAT) * 1024;
      }
#pragma unroll
      for (int g = 0; g < 2; ++g) {
        const int gc = n0 + wn * 64 + g * 32 + 8 * lg;
#pragma unroll
        for (int n = 0; n < 2; ++n) {
          const f32x4 t = acc[mi][2 * g + n] * (1.f / 32.f);
          const float4 gt = *(const float4*)(modp + gc + 4 * n);
          const float4 xi = *(const float4*)(xin + gc + 4 * n);
          *(float4*)(xo + gc + 4 * n) = make_float4(xi.x + gt.x * t[0], xi.y + gt.y * t[1], xi.z + gt.z * t[2], xi.w + gt.w * t[3]);
        }
      }
    }
    if (!hasn) break;
    m0 = m0n; n0 = n0n; ++it;
  }
}

__device__ __forceinline__ void phase_peerq(int layer, char* smem) {
  const KP PP = get_params();
  const u16* Bt = PP->WkT + (size_t)layer * 2048 * LDK1;
  const int tid = TID();
  const int l = tid & 63, w = tid >> 6, wm = w >> 1, wn = w & 1, lr = l & 15, lg = l >> 4;
  const int MT = (layer == DEPTH - 1) ? NLAT / 128 : R / 128;
  for (int it = 0;; ++it) {
    int mt, nt;
    if (!tile_map(it, MT, 16, mt, nt)) break;
    const int m0 = mt * 128, n0 = nt * 128;
    f32x4 sc[4][4];
    zero_acc(sc);
    gemm_mainloop1(PP->h, LDK1, Bt, LDK1, 1024, m0, n0, smem, sc);
    __syncthreads();
    float* Sc = (float*)smem;
#pragma unroll
    for (int mi = 0; mi < 4; ++mi)
#pragma unroll
      for (int ni = 0; ni < 4; ++ni)
#pragma unroll
        for (int r = 0; r < 4; ++r) Sc[(wm * 64 + mi * 16 + lg * 4 + r) * 129 + wn * 64 + ni * 16 + lr] = sc[mi][ni][r];
    __syncthreads();
    {
      const int row = tid >> 1, half = tid & 1;
      const float* rowp = Sc + row * 129;
      unsigned key[64];
#pragma unroll
      for (int i = 0; i < 64; ++i) {
        unsigned u = __float_as_uint(rowp[half * 64 + i]);
        u = (u & 0x80000000u) ? ~u : (u | 0x80000000u);
        key[i] = (u & ~127u) | (unsigned)(127 - (half * 64 + i));
      }
#define CMPX(X, Y, DESC) { const unsigned hi_ = (X) > (Y) ? (X) : (Y), lo_ = (X) > (Y) ? (Y) : (X); X = (DESC) ? hi_ : lo_; Y = (DESC) ? lo_ : hi_; }
#pragma unroll
      for (int g0 = 0; g0 < 64; g0 += 16) {
#pragma unroll
        for (int k = 2; k <= 16; k <<= 1)
#pragma unroll
          for (int j = k >> 1; j > 0; j >>= 1)
#pragma unroll
            for (int i = 0; i < 16; ++i) {
              const int l2 = i ^ j;
              if (l2 > i) CMPX(key[g0 + i], key[g0 + l2], ((i & k) == 0));
            }
      }
#define TOPMERGE(AOFF, BOFF)                                                                         \
  {                                                                                                  \
    _Pragma("unroll") for (int i = 0; i < 16; ++i)                                                   \
      key[(AOFF) + i] = key[(AOFF) + i] > key[(BOFF) + 15 - i] ? key[(AOFF) + i] : key[(BOFF) + 15 - i]; \
    _Pragma("unroll") for (int j = 8; j > 0; j >>= 1)                                                \
      _Pragma("unroll") for (int i = 0; i < 16; ++i) {                                               \
        const int l2 = i ^ j;                                                                        \
        if (l2 > i) CMPX(key[(AOFF) + i], key[(AOFF) + l2], true);                                   \
      }                                                                                              \
  }
      TOPMERGE(0, 16);
      TOPMERGE(32, 48);
      TOPMERGE(0, 32);
      {
        unsigned oth[16];
#pragma unroll
        for (int i = 0; i < 16; ++i) oth[i] = swz_xor_u<1>(key[i]);
#pragma unroll
        for (int i = 0; i < 16; ++i) key[i] = key[i] > oth[15 - i] ? key[i] : oth[15 - i];
#pragma unroll
        for (int j = 8; j > 0; j >>= 1)
#pragma unroll
          for (int i = 0; i < 16; ++i) {
            const int l2 = i ^ j;
            if (l2 > i) CMPX(key[i], key[l2], true);
          }
      }
#undef TOPMERGE
#undef CMPX
      unsigned res[16];
#pragma unroll
      for (int j = 0; j < 16; ++j) {
        const int idx = 127 - (int)(key[j] & 127u);
        res[j] = half ? (unsigned)idx : __float_as_uint(rowp[idx]);
      }
      const size_t ob = ((size_t)(m0 + row) * 16 + nt) * 16;
      uint4* dst = half ? (uint4*)(PP->topI + ob) : (uint4*)(PP->topS + ob);
      dst[0] = make_uint4(res[0], res[1], res[2], res[3]);
      dst[1] = make_uint4(res[4], res[5], res[6], res[7]);
      dst[2] = make_uint4(res[8], res[9], res[10], res[11]);
      dst[3] = make_uint4(res[12], res[13], res[14], res[15]);
    }
  }
}

DEV void pair_of_lane(int l, int& a, int& b) {
  if (l < 16) { a = 0; b = l; }
  else if (l < 24) { a = 1; b = l - 16; }
  else if (l < 29) { a = 2; b = l - 24; }
  else if (l < 33) { a = 3; b = l - 29; }
  else if (l < 36) { a = 4; b = l - 33; }
  else if (l < 38) { a = 5; b = l - 36; }
  else if (l < 40) { a = 6; b = l - 38; }
  else if (l < 42) { a = 7; b = l - 40; }
  else if (l < 50) { a = l - 34; b = 0; }
  else { a = 0; b = 0; }
}

DEV float peer_butterfly(const float (&part)[8], int lane) {
  const bool h32 = (lane & 32) != 0, h16 = (lane & 16) != 0, h8 = (lane & 8) != 0;
  const int a32 = (lane ^ 32) << 2;
  float q4[4], q2[2];
#pragma unroll
  for (int i = 0; i < 4; ++i) {
    const float keep = h32 ? part[i + 4] : part[i], send = h32 ? part[i] : part[i + 4];
    q4[i] = keep + __builtin_bit_cast(float, __builtin_amdgcn_ds_bpermute(a32, __builtin_bit_cast(int, send)));
  }
#pragma unroll
  for (int i = 0; i < 2; ++i) {
    const float keep = h16 ? q4[i + 2] : q4[i], send = h16 ? q4[i] : q4[i + 2];
    q2[i] = keep + swz_xor<16>(send);
  }
  const float keep = h8 ? q2[1] : q2[0], send = h8 ? q2[0] : q2[1];
  float q1 = keep + swz_xor<8>(send);
  q1 += swz_xor<4>(q1);
  q1 += swz_xor<2>(q1);
  q1 += swz_xor<1>(q1);
  return q1;
}

__device__ __forceinline__ void phase_peer(int layer, char* smem) {
  const KP PP = get_params();
  const int tid = TID(), lane = tid & 63, wv = tid >> 6;
  const int gw = BID() * 4 + wv, nw = gridDim.x * 4;
  int* elist = (int*)(smem + wv * 2048);
  float* glist = (float*)(elist + 128);
  const bool last = (layer == DEPTH - 1);
  const int rlim = last ? NLAT : R;
  int pa, pb;
  pair_of_lane(lane, pa, pb);
  for (int r = gw; r < rlim; r += nw) {
    f32x2 hp[8];
#pragma unroll
    for (int i = 0; i < 4; ++i) {
      const uint2 hv = *(const uint2*)(PP->h + (size_t)r * LDK1 + 4 * lane + 256 * i);
      hp[2 * i] = (f32x2){bf_lo(hv.x), bf_hi(hv.x)};
      hp[2 * i + 1] = (f32x2){bf_lo(hv.y), bf_hi(hv.y)};
    }
#ifndef PEER_REP
#define PEER_REP 1
#endif
    f32x2 out[8];
#pragma unroll
    for (int i = 0; i < 8; ++i) out[i] = (f32x2){0.f, 0.f};
#pragma nounroll
    for (int rep_ = 0; rep_ < PEER_REP; ++rep_) {
    float sreg[8];
    int ireg[8];
#pragma unroll
    for (int hh = 0; hh < 8; ++hh) {
      const size_t o = (size_t)r * 256 + hh * 32 + (lane & 31);
      sreg[hh] = PP->topS[o];
      ireg[hh] = PP->topI[o];
    }
#pragma unroll 2
    for (int hh = 0; hh < 8; ++hh) {
      float cs = __builtin_bit_cast(float, __builtin_amdgcn_ds_bpermute(pa << 2, __builtin_bit_cast(int, sreg[hh]))) +
                 __builtin_bit_cast(float, __builtin_amdgcn_ds_bpermute((16 + pb) << 2, __builtin_bit_cast(int, sreg[hh])));
      const int e = __builtin_amdgcn_ds_bpermute(pa << 2, ireg[hh]) * 128 + __builtin_amdgcn_ds_bpermute((16 + pb) << 2, ireg[hh]);
      if (lane >= 50) cs = -__builtin_inff();
      unsigned ku = __float_as_uint(cs);
      ku = (ku & 0x80000000u) ? ~ku : (ku | 0x80000000u);
      ku = (ku & ~63u) | (unsigned)(63 - lane);
      int rank = 0;
#pragma unroll
      for (int l2 = 0; l2 < 50; ++l2) {
        const unsigned kv = (unsigned)__builtin_amdgcn_readlane((int)ku, l2);
        rank += (kv > ku) ? 1 : 0;
      }
      const bool sel = (lane < 50) && (rank < 16);
      const float mx = __builtin_bit_cast(float, __builtin_amdgcn_readlane(__builtin_bit_cast(int, cs), 0));
      const float ex = sel ? __expf(cs - mx) : 0.f;
      const float sum = wave_sum(ex);
      const unsigned long long mask = __ballot(sel);
      if (sel) {
        const int pos = __builtin_popcountll(mask & ((1ull << lane) - 1ull));
        elist[hh * 16 + pos] = e;
        glist[hh * 16 + pos] = ex / sum;
      }
    }
    __builtin_amdgcn_wave_barrier();
    asm volatile("s_waitcnt lgkmcnt(0)" ::: "memory");
    for (int k0 = 0; k0 < 128; k0 += 8) {
      U3 ua[8], va[8];
#pragma unroll
      for (int b = 0; b < 8; ++b) {
        const int ek = __builtin_amdgcn_readfirstlane(elist[k0 + b]);
        ua[b] = *(const U3*)(PP->tab8U + (size_t)ek * TROW + lane * 12);
        va[b] = *(const U3*)(PP->tab8V + (size_t)ek * TROW + lane * 12);
      }
      const int eb = elist[k0 + (lane >> 3)];
      const float scu = PP->scU[eb], scv = PP->scV[eb];
      float part[8];
#pragma unroll
      for (int b = 0; b < 8; b += 2) {
        const u32x6_t s6 = {ua[b].a, ua[b].b, ua[b].c, ua[b + 1].a, ua[b + 1].b, ua[b + 1].c};
        const f32x32_t uf = __builtin_amdgcn_cvt_scalef32_pk32_f32_fp6(s6, 1.0f);
        f32x2 d0 = (f32x2){uf[0], uf[1]} * hp[0];
        f32x2 d1 = (f32x2){uf[16], uf[17]} * hp[0];
#pragma unroll
        for (int p = 1; p < 8; ++p) {
          d0 += (f32x2){uf[2 * p], uf[2 * p + 1]} * hp[p];
          d1 += (f32x2){uf[16 + 2 * p], uf[17 + 2 * p]} * hp[p];
        }
        part[b] = d0[0] + d0[1];
        part[b + 1] = d1[0] + d1[1];
      }
      float q1 = peer_butterfly(part, lane);
      q1 *= scu;
      const float act = scv * glist[k0 + (lane >> 3)] * 0.5f * q1 * (1.f + erff(q1 * 0.7071067811865475f));
#pragma unroll
      for (int b = 0; b < 8; b += 2) {
        const float ab0 = __builtin_bit_cast(float, __builtin_amdgcn_readlane(__builtin_bit_cast(int, act), b * 8));
        const float ab1 = __builtin_bit_cast(float, __builtin_amdgcn_readlane(__builtin_bit_cast(int, act), b * 8 + 8));
        const f32x2 a0 = {ab0, ab0}, a1 = {ab1, ab1};
        const u32x6_t s6 = {va[b].a, va[b].b, va[b].c, va[b + 1].a, va[b + 1].b, va[b + 1].c};
        const f32x32_t vf = __builtin_amdgcn_cvt_scalef32_pk32_f32_fp6(s6, 1.0f);
#pragma unroll
        for (int p = 0; p < 8; ++p) {
          out[p] += a0 * (f32x2){vf[2 * p], vf[2 * p + 1]};
          out[p] += a1 * (f32x2){vf[16 + 2 * p], vf[17 + 2 * p]};
        }
      }
    }
    __builtin_amdgcn_wave_barrier();
    }
    if (PEER_REP > 1) {
#pragma unroll
      for (int i = 0; i < 8; ++i) out[i] *= (1.f / PEER_REP);
    }
    const float* md = PP->mod + (size_t)(layer * 3 + modsel(r)) * 6144 + 5 * 1024;
    float* xr = (r < NLAT) ? PP->out + (size_t)r * 1024 : PP->xc + (size_t)(r - NLAT) * 1024;
    float4 x2[4];
    float ss = 0.f;
#pragma unroll
    for (int i = 0; i < 4; ++i) {
      const int col = 4 * lane + 256 * i;
      const float4 xa = *(const float4*)(xr + col);
      const float4 ga = *(const float4*)(md + col);
      x2[i] = make_float4(xa.x + ga.x * out[2 * i][0], xa.y + ga.y * out[2 * i][1], xa.z + ga.z * out[2 * i + 1][0],
                          xa.w + ga.w * out[2 * i + 1][1]);
      ss += x2[i].x * x2[i].x + x2[i].y * x2[i].y + x2[i].z * x2[i].z + x2[i].w * x2[i].w;
    }
    if (last) {
      ss = wave_sum(ss);
      const float rs = rsqrtf(ss * (1.f / 1024.f) + EPS);
#pragma unroll
      for (int i = 0; i < 4; ++i) {
        const float4 fa = *(const float4*)(PP->final_norm + 4 * lane + 256 * i);
        x2[i] = make_float4(x2[i].x * rs * fa.x, x2[i].y * rs * fa.y, x2[i].z * rs * fa.z, x2[i].w * rs * fa.w);
      }
    }
#pragma unroll
    for (int i = 0; i < 4; ++i) *(float4*)(xr + 4 * lane + 256 * i) = x2[i];
    if (!last) {
      ss = wave_sum(ss);
      const float rs = rsqrtf(ss * (1.f / 1024.f) + EPS);
      const float* nwt = PP->norm_mix + (layer + 1) * 1024;
      const float* md1 = PP->mod + (size_t)((layer + 1) * 3 + modsel(r)) * 6144;
#pragma unroll
      for (int i = 0; i < 4; ++i) {
        const int col = 4 * lane + 256 * i;
        const float4 wv = *(const float4*)(nwt + col);
        const float4 sh = *(const float4*)(md1 + col);
        const float4 sc = *(const float4*)(md1 + 1024 + col);
        const float y0 = x2[i].x * rs * wv.x * (1.f + sc.x) + sh.x;
        const float y1 = x2[i].y * rs * wv.y * (1.f + sc.y) + sh.y;
        const float y2 = x2[i].z * rs * wv.z * (1.f + sc.z) + sh.z;
        const float y3 = x2[i].w * rs * wv.w * (1.f + sc.w) + sh.w;
        int pk = __builtin_amdgcn_cvt_pk_fp8_f32(y0, y1, 0, false);
        pk = __builtin_amdgcn_cvt_pk_fp8_f32(y2, y3, pk, true);
        *(int*)((char*)PP->h + (size_t)r * (LDK1 * 2) + col) = pk;
      }
    }
  }
}

namespace cg = cooperative_groups;

#define XB_TMO      128
#define XB_XCNT(j)  (256  + 64 * (j))
#define XB_XSUB(j)  (1280 + 64 * (j))
#define XB_XGEN(j)  (2304 + 64 * (j))
#define XB_TOP      3328
#define XB_TOPGEN   3392
#define XCD_BAR_WORDS 3456
#define XB_SPIN_CAP (1u << 22)
#define LAS __attribute__((address_space(3)))
DEV unsigned xb_ld(unsigned* q) { return __hip_atomic_load(q, __ATOMIC_RELAXED, __HIP_MEMORY_SCOPE_AGENT); }
DEV unsigned xb_add(unsigned* q, unsigned v) { return __hip_atomic_fetch_add(q, v, __ATOMIC_RELAXED, __HIP_MEMORY_SCOPE_AGENT); }
DEV unsigned xb_xcc_id() { return (unsigned)__builtin_amdgcn_s_getreg((3 << 11) | 20) & 0xFu; }
#define XB_SPIN(cond, bar) do { unsigned _sp = 0; while (cond) { __builtin_amdgcn_s_sleep(1); \
    if ((++_sp & 255u) == 0u) { if (xb_ld(&(bar)[XB_TMO])) break; if (_sp > XB_SPIN_CAP) { atomicAdd(&(bar)[XB_TMO], 1u); break; } } } } while (0)
struct XcdBarrier { unsigned* bar; unsigned x; volatile LAS unsigned* st; };
DEV XcdBarrier xcd_barrier_post(unsigned* bar, volatile LAS unsigned* st) {
  XcdBarrier b; b.bar = bar; b.x = xb_xcc_id(); b.st = st;
  if (__builtin_amdgcn_workitem_id_x() == 0) (void)xb_add(&bar[XB_XCNT(b.x)], 1u);
  return b;
}
DEV void xcd_barrier_complete(unsigned* bar, unsigned x, unsigned& nloc, unsigned& nx) {
  const unsigned G = gridDim.x * gridDim.y * gridDim.z;
  unsigned sum, cnt, mine, sp = 0u;
  for (;;) {
    sum = 0u; cnt = 0u; mine = 0u;
#pragma unroll
    for (unsigned j = 0; j < 16; ++j) { const unsigned c = xb_ld(&bar[XB_XCNT(j)]); sum += c; cnt += (c > 0u) ? 1u : 0u; mine = (j == x) ? c : mine; }
    if (sum == G) break;
    __builtin_amdgcn_s_sleep(1);
    if ((++sp & 255u) == 0u) { if (xb_ld(&bar[XB_TMO])) break; if (sp > XB_SPIN_CAP) { atomicAdd(&bar[XB_TMO], 1u); break; } }
  }
  nloc = mine > 0u ? mine : 1u; nx = cnt > 0u ? cnt : 1u;
}
DEV void xcd_barrier(const XcdBarrier& b) {
  asm volatile("s_waitcnt vmcnt(0)" ::: "memory");
  __syncthreads();
  if (__builtin_amdgcn_workitem_id_x() == 0) {
    unsigned* bar = b.bar;
    __builtin_amdgcn_s_waitcnt(0);
    unsigned nloc = b.st[0], nx = b.st[1];
    if (nloc == 0u) { xcd_barrier_complete(bar, b.x, nloc, nx); b.st[0] = nloc; b.st[1] = nx; }
    const unsigned old = xb_add(&bar[XB_XSUB(b.x)], 1u);
    const unsigned gen = old / nloc;
    if (old + 1u == (gen + 1u) * nloc) {
      __builtin_amdgcn_fence(__ATOMIC_RELEASE, "agent");
      asm volatile("s_waitcnt vmcnt(0)" ::: "memory");
      const unsigned og = xb_add(&bar[XB_TOP], 1u);
      const unsigned tg = og / nx;
      if (og + 1u == (tg + 1u) * nx) xb_add(&bar[XB_TOPGEN], 1u);
      else XB_SPIN(xb_ld(&bar[XB_TOPGEN]) == tg, bar);
      __builtin_amdgcn_fence(__ATOMIC_ACQUIRE, "agent");
      xb_add(&bar[XB_XGEN(b.x)], 1u);
      asm volatile("s_waitcnt vmcnt(0)" ::: "memory");
    } else {
      XB_SPIN(xb_ld(&bar[XB_XGEN(b.x)]) == gen, bar);
      __builtin_amdgcn_fence(__ATOMIC_ACQUIRE, "agent");
      asm volatile("s_waitcnt vmcnt(0)" ::: "memory");
    }
  }
  __syncthreads();
}

#define GRID_SYNC() do { XcdBarrier xb_; xb_.bar = get_params()->bar; xb_.x = xb_xcc_id(); xb_.st = (volatile LAS unsigned*)&xb_words; xcd_barrier(xb_); } while (0)

__global__ void __launch_bounds__(NTHR, 2) megakernel(Params p) {
  __shared__ __attribute__((aligned(16))) char smem[SMEM_BYTES];
  __shared__ uint4 xb_words;
  if (__builtin_amdgcn_workitem_id_x() == 0) xb_words = make_uint4(0u, 0u, 0u, 0u);
  __syncthreads();
  (void)xcd_barrier_post(get_params()->bar, (volatile LAS unsigned*)&xb_words);
#ifndef PM
#define PM 0xFFFF
#endif
#ifndef DUP
#define DUP 0
#endif
  if (PM & 1) phase_init(smem);
  if (DUP & 1) phase_init(smem);
  GRID_SYNC();
  for (int layer = 0; layer < DEPTH; ++layer) {
    if (layer == 0) {
      if (PM & 2) phase_norm(layer, 1);
      if (DUP & 2) phase_norm(layer, 1);
      GRID_SYNC();
    }
    if (PM & 4) phase_gemm_win(layer, smem);
    if (DUP & 4) phase_gemm_win(layer, smem);
    GRID_SYNC();
#ifndef PREP_REP
#define PREP_REP 1
#endif
#pragma nounroll
    for (int rep_ = 0; rep_ < PREP_REP; ++rep_) phase_prep(layer, smem);
    GRID_SYNC();
    {
      const int nb_ = gridDim.x;
      if (BID() < 128) { if (PM & 64) phase_scan(smem); }
      else {
        if (PM & 16) phase_pool(layer, smem, BID() - 128, nb_ - 128);
        if (PM & 256) phase_tables(layer, BID() - 128, nb_ - 128);
      }
    }
    GRID_SYNC();
    if (PM & 128) phase_o(layer, smem);
    if (DUP & 128) phase_o(layer, smem);
    GRID_SYNC();
    if (PM & 512) phase_merge(layer, smem);
    if (DUP & 512) phase_merge(layer, smem);
    GRID_SYNC();
    if (PM & 1024) phase_outproj(layer, smem);
    GRID_SYNC();
    if (PM & 2048) phase_norm(layer, 2);
    if (DUP & 2048) phase_norm(layer, 2);
    GRID_SYNC();
    if (PM & 4096) phase_peerq(layer, smem);
    if (DUP & 4096) phase_peerq(layer, smem);
    GRID_SYNC();
    if (PM & 8192) phase_peer(layer, smem);
    if (layer + 1 < DEPTH) GRID_SYNC();
  }
}

static inline size_t align_up(size_t v, size_t a) { return (v + a - 1) / a * a; }

extern "C" void kernel_launch(void* const* d_in, const int* in_sizes, int n_in, void* d_out, int out_size, void* d_ws,
                              size_t ws_size, hipStream_t stream) {
  Params p{};
  p.x = (const float*)d_in[0]; p.c = (const float*)d_in[1]; p.ctx = (const float*)d_in[2]; p.c_ctx = (const float*)d_in[3];
  p.w_mod = (const float*)d_in[4]; p.b_mod = (const float*)d_in[5]; p.norm_mix = (const float*)d_in[6]; p.w_in = (const float*)d_in[7];
  p.conv_w = (const float*)d_in[8]; p.a_log = (const float*)d_in[9]; p.dt_bias = (const float*)d_in[10];
  p.dn_out_norm = (const float*)d_in[11]; p.pool_w = (const float*)d_in[12]; p.pool_scale = (const float*)d_in[13];
  p.w_up_dn = (const float*)d_in[14]; p.w_up_pool = (const float*)d_in[15]; p.w_out = (const float*)d_in[16];
  p.norm_ffn = (const float*)d_in[17]; p.peer_wq = (const float*)d_in[18]; p.peer_keys = (const float*)d_in[19];
  p.peer_u = (const float*)d_in[20]; p.peer_v = (const float*)d_in[21]; p.final_norm = (const float*)d_in[22];
  p.out = (float*)d_out;

  char* ws = (char*)d_ws;
  size_t off = 0;
  auto take = [&](size_t bytes) { char* q = ws + off; off = align_up(off + bytes, 256); return q; };
  p.tab8U = (unsigned char*)take((size_t)NEXP * 1024);
  p.tab8V = (unsigned char*)take((size_t)NEXP * 1024);
  p.scU = (float*)take((size_t)NEXP * 4);
  p.scV = (float*)take((size_t)NEXP * 4);
  p.WinT = (u16*)take((size_t)DEPTH * NPAD * LDK1 * 2);
  p.WdT = (u16*)take((size_t)DEPTH * 1024 * LDK5 * 2);
  p.WpT = (u16*)take((size_t)DEPTH * 1024 * LDK5 * 2);
  p.WoT = (u16*)take((size_t)DEPTH * 1024 * LDK1 * 2);
  p.WkT = (u16*)take((size_t)DEPTH * 2048 * LDK1 * 2);
  p.PwT = (u16*)take((size_t)DEPTH * 4 * 128 * 128 * 2);
  p.mod = (float*)take((size_t)DEPTH * 3 * 6144 * 4);
  p.xc = (float*)take((size_t)NCTX * 1024 * 4);
  p.h = (u16*)take((size_t)R * LDK1 * 2);
  p.m = p.h;
  p.qkv_pre = (u16*)take((size_t)R * 1536 * 2);
  p.Vfrag = p.qkv_pre;
  p.z = (u16*)take((size_t)R * 512 * 2);
  p.pin = (u16*)take((size_t)R * 512 * 2);
  p.sgd = (u16*)take((size_t)R * 1024 * 2);
  p.sgp = (u16*)take((size_t)R * 1024 * 2);
  p.ba = (float*)take((size_t)R * 16 * 4);
  p.qkvn = (u16*)take((size_t)R * 1536 * 2);
  p.bg = (float*)take((size_t)R * 16 * 4);
  p.Wfrag = (u16*)take((size_t)NUNIT * 16384);
  p.KdT = (u16*)take((size_t)NUNIT * 16384);
  p.Ufrag = (u16*)take((size_t)NUNIT * 16384);
  p.ydn = p.Ufrag;
  p.Sfrag = (u16*)take((size_t)NUNIT * 32768);
  p.gc = (float*)take((size_t)NUNIT * 64 * 4);
  p.glast = (float*)take((size_t)NUNIT * 4);
  p.ypool = (u16*)take((size_t)R * LDK5 * 2);
  p.bar = (unsigned*)take((size_t)XCD_BAR_WORDS * 4);
  p.topS = (float*)p.qkvn;
  p.topI = (int*)((char*)p.qkvn + (size_t)R * 256 * 4);
  const bool alias_ok = ((size_t)R * 256 * 8 <= (size_t)R * 1536 * 2) && ((size_t)NUNIT * 16384 <= (size_t)R * 1536 * 2) &&
                        ((size_t)R * LDK5 * 2 <= (size_t)NUNIT * 16384);
  if (off > ws_size || !alias_ok) {
    fprintf(stderr, "workspace too small: need %zu have %zu (alias_ok=%d)\n", off, ws_size, (int)alias_ok);
    return;
  }
  static int grid_blocks = 0;
  if (!grid_blocks) {
    int dev = 0, cus = 0, per_cu = 0;
    (void)hipGetDevice(&dev);
    (void)hipDeviceGetAttribute(&cus, hipDeviceAttributeMultiprocessorCount, dev);
    (void)hipOccupancyMaxActiveBlocksPerMultiprocessor(&per_cu, megakernel, NTHR, 0);
    if (per_cu > 2) per_cu = 2;
    if (per_cu < 1) per_cu = 1;
    grid_blocks = cus * per_cu;
    grid_blocks -= grid_blocks % 8;
  }
  if (grid_blocks < 8) { fprintf(stderr, "bad grid %d\n", grid_blocks); return; }
  (void)hipMemsetAsync(p.bar, 0, (size_t)XCD_BAR_WORDS * 4, stream);
  void* args[] = {&p};
  hipError_t e = hipLaunchCooperativeKernel((void*)megakernel, dim3(grid_blocks), dim3(NTHR), args, 0, stream);
  if (e != hipSuccess) fprintf(stderr, "cooperative launch failed: %s (grid %d)\n", hipGetErrorString(e), grid_blocks);
}
```

```cpp
#include <hip/hip_runtime.h>
#include <hip/hip_cooperative_groups.h>
#include <stdint.h>
#include <stdio.h>

typedef unsigned short u16;
typedef __attribute__((ext_vector_type(8))) short bf16x8;
typedef __attribute__((ext_vector_type(4))) float f32x4;
typedef __attribute__((ext_vector_type(2))) float f32x2;
typedef __attribute__((ext_vector_type(2))) __bf16 bf16x2_t;

#define DEV __device__ __forceinline__

constexpr int D = 1024;
constexpr int BATCH = 2;
constexpr int SEQ = 8192;
constexpr int DEPTH = 2;
constexpr int CTX = 256;
constexpr int NLAT = BATCH * SEQ;
constexpr int NCTX = BATCH * CTX;
constexpr int R = NLAT + NCTX;
constexpr int DNH = 4;
constexpr int DK = 128;
constexpr int DNW = 512;
constexpr int INC = 4624;
constexpr int NPAD = 4736;
constexpr int NEXP = 16384;
constexpr float EPS = 1e-6f;
constexpr int NTHR = 256;
constexpr int LDK1 = 1088;
constexpr int LDK5 = 576;
constexpr int SMEM_BYTES = 73728;

struct Params {
  const float *x, *c, *ctx, *c_ctx, *w_mod, *b_mod, *norm_mix, *w_in, *conv_w, *a_log, *dt_bias, *dn_out_norm,
      *pool_w, *pool_scale, *w_up_dn, *w_up_pool, *w_out, *norm_ffn, *peer_wq, *peer_keys, *peer_u, *peer_v, *final_norm;
  float* out;
  unsigned char *tab8U, *tab8V;
  float *scU, *scV;
  u16 *WinT, *WdT, *WpT, *WoT, *WkT, *PwT;
  float *mod, *xc;
  u16 *h, *qkv_pre, *z, *pin, *sgd, *sgp;
  unsigned char* h8;
  float* ba;
  u16* qkvn;
  float* bg;
  u16 *Wfrag, *KdT, *Ufrag, *Sfrag, *Vfrag;
  float *gc, *glast;
  u16 *ydn, *ypool, *m;
  float* topS;
  int* topI;
  unsigned* bar;
};

typedef const __attribute__((address_space(4))) Params* KP;
DEV KP get_params() {
  KP k = (KP)__builtin_amdgcn_kernarg_segment_ptr();
  asm volatile("" : "+s"(k));
  return k;
}
DEV int TID() { int t = __builtin_amdgcn_workitem_id_x(); asm volatile("" : "+v"(t)); return t; }
DEV int BID() { int t = __builtin_amdgcn_workgroup_id_x(); asm volatile("" : "+s"(t)); return t; }
DEV unsigned pack_bf16(float a, float b) {
  f32x2 v = {a, b};
  bf16x2_t r = __builtin_convertvector(v, bf16x2_t);
  return *(unsigned*)&r;
}
DEV u16 f2bf(float a) { return (u16)(pack_bf16(a, 0.f) & 0xffffu); }
DEV float bf_lo(unsigned u) { return __uint_as_float(u << 16); }
DEV float bf_hi(unsigned u) { return __uint_as_float(u & 0xffff0000u); }
DEV float bf2f(u16 h) { return __uint_as_float(((unsigned)h) << 16); }
DEV void unpack8(const uint4& v, float* f) {
  f[0] = bf_lo(v.x); f[1] = bf_hi(v.x); f[2] = bf_lo(v.y); f[3] = bf_hi(v.y);
  f[4] = bf_lo(v.z); f[5] = bf_hi(v.z); f[6] = bf_lo(v.w); f[7] = bf_hi(v.w);
}
DEV uint4 pack8(const float* f) {
  uint4 v;
  v.x = pack_bf16(f[0], f[1]); v.y = pack_bf16(f[2], f[3]); v.z = pack_bf16(f[4], f[5]); v.w = pack_bf16(f[6], f[7]);
  return v;
}
template <int O> DEV float swz_xor(float v) {
  return __builtin_bit_cast(float, __builtin_amdgcn_ds_swizzle(__builtin_bit_cast(int, v), (O << 10) | 0x1F));
}
template <int O> DEV unsigned swz_xor_u(unsigned v) {
  return (unsigned)__builtin_amdgcn_ds_swizzle((int)v, (O << 10) | 0x1F);
}
DEV float xor32_f(float v) {
  const int a = ((TID() & 63) ^ 32) << 2;
  return __builtin_bit_cast(float, __builtin_amdgcn_ds_bpermute(a, __builtin_bit_cast(int, v)));
}
DEV float wave_sum(float v) {
  v += xor32_f(v);
  v += swz_xor<16>(v); v += swz_xor<8>(v); v += swz_xor<4>(v); v += swz_xor<2>(v); v += swz_xor<1>(v);
  return v;
}
DEV float wave_max(float v) {
  v = fmaxf(v, xor32_f(v));
  v = fmaxf(v, swz_xor<16>(v)); v = fmaxf(v, swz_xor<8>(v)); v = fmaxf(v, swz_xor<4>(v));
  v = fmaxf(v, swz_xor<2>(v)); v = fmaxf(v, swz_xor<1>(v));
  return v;
}
DEV float group16_sum(float v) {
  v += swz_xor<8>(v); v += swz_xor<4>(v); v += swz_xor<2>(v); v += swz_xor<1>(v);
  return v;
}
DEV float sigmoidf_(float x) { return 1.f / (1.f + __expf(-x)); }
DEV float siluf_(float x) { return x / (1.f + __expf(-x)); }
DEV int modsel(int r) { return r < NLAT ? (r >> 13) : 2; }

DEV void transpose_tile(const float* __restrict__ src, int Nsrc, int ldd, u16* __restrict__ dst, int kt, int nt, int mode,
                        float* tile) {
  const int tid = TID();
  const int cl = tid & 63, rg = tid >> 6;
  const int nd = nt * 64 + cl;
  int ns = nd;
  bool valid = true;
  if (mode & 1) {
    if (nd < 2560) ns = nd;
    else if (nd < 4608) ns = nd + 16;
    else if (nd < 4624) ns = nd - 4608 + 2560;
    else { valid = false; ns = 0; }
  }
#pragma unroll
  for (int i = 0; i < 16; ++i) {
    const int kr = i * 4 + rg;
    float v = valid ? src[(size_t)(kt * 64 + kr) * Nsrc + ns] : 0.f;
    tile[kr * 65 + cl] = v;
  }
  __syncthreads();
  const int nr = tid >> 2, kc = (tid & 3) * 16;
  if (mode & 2) {
    int q4[4];
#pragma unroll
    for (int q = 0; q < 4; ++q) {
      int pk = __builtin_amdgcn_cvt_pk_fp8_f32(32.f * tile[(kc + 4 * q) * 65 + nr], 32.f * tile[(kc + 4 * q + 1) * 65 + nr], 0, false);
      q4[q] = __builtin_amdgcn_cvt_pk_fp8_f32(32.f * tile[(kc + 4 * q + 2) * 65 + nr], 32.f * tile[(kc + 4 * q + 3) * 65 + nr], pk, true);
    }
    *(int4*)((char*)dst + (size_t)(nt * 64 + nr) * ldd + kt * 64 + kc) = make_int4(q4[0], q4[1], q4[2], q4[3]);
    __syncthreads();
    return;
  }
  unsigned w[8];
#pragma unroll
  for (int q = 0; q < 8; ++q) w[q] = pack_bf16(tile[(kc + 2 * q) * 65 + nr], tile[(kc + 2 * q + 1) * 65 + nr]);
  uint4* d = (uint4*)(dst + (size_t)(nt * 64 + nr) * ldd + kt * 64 + kc);
  d[0] = make_uint4(w[0], w[1], w[2], w[3]);
  d[1] = make_uint4(w[4], w[5], w[6], w[7]);
  __syncthreads();
}

__device__ __forceinline__ void phase_init(char* smem) {
  const KP PP = get_params();
  const int tid = TID(), nb = gridDim.x, bid = BID();
  float* fs = (float*)smem;
  for (int u = bid; u < 192; u += nb) {
    const int layer = u / 96, col0 = (u % 96) * 64;
    float* sv = fs;
    float* red = fs + 3072;
    for (int i = tid; i < 3072; i += NTHR) {
      const int v = i >> 10, k = i & 1023;
      const float cv = (v < 2) ? PP->c[v * 1024 + k] : PP->c_ctx[k];
      sv[i] = siluf_(cv);
    }
    __syncthreads();
    const int cq = tid & 15, ks = tid >> 4;
    float acc[3][4];
#pragma unroll
    for (int v = 0; v < 3; ++v)
#pragma unroll
      for (int i = 0; i < 4; ++i) acc[v][i] = 0.f;
    const float* wb = PP->w_mod + ((size_t)layer * 1024 + ks * 64) * 6144 + col0 + cq * 4;
#pragma unroll 8
    for (int kk = 0; kk < 64; ++kk) {
      const float4 w4 = *(const float4*)(wb + (size_t)kk * 6144);
      const int k = ks * 64 + kk;
#pragma unroll
      for (int v = 0; v < 3; ++v) {
        const float s = sv[v * 1024 + k];
        acc[v][0] += s * w4.x; acc[v][1] += s * w4.y; acc[v][2] += s * w4.z; acc[v][3] += s * w4.w;
      }
    }
#pragma unroll
    for (int v = 0; v < 3; ++v)
#pragma unroll
      for (int i = 0; i < 4; ++i) red[(ks * 3 + v) * 64 + cq * 4 + i] = acc[v][i];
    __syncthreads();
    if (tid < 192) {
      const int v = tid >> 6, cc = tid & 63;
      float s = PP->b_mod[layer * 6144 + col0 + cc];
#pragma unroll
      for (int k2 = 0; k2 < 16; ++k2) s += red[(k2 * 3 + v) * 64 + cc];
      PP->mod[(size_t)(layer * 3 + v) * 6144 + col0 + cc] = s;
    }
    __syncthreads();
  }
  constexpr int NTL = 1184 + 128 + 128 + 256 + 16;
  for (int j = bid; j < NTL * DEPTH; j += nb) {
    const int layer = j / NTL;
    int jj = j % NTL;
    if (jj < 1184) {
      transpose_tile(PP->w_in + (size_t)layer * 1024 * INC, INC, LDK1, PP->WinT + (size_t)layer * NPAD * LDK1, jj / 74, jj % 74, 3, fs);
    } else if ((jj -= 1184) < 128) {
      transpose_tile(PP->w_up_dn + (size_t)layer * 512 * 1024, 1024, LDK5, PP->WdT + (size_t)layer * 1024 * LDK5, jj / 16, jj % 16, 2, fs);
    } else if ((jj -= 128) < 128) {
      transpose_tile(PP->w_up_pool + (size_t)layer * 512 * 1024, 1024, LDK5, PP->WpT + (size_t)layer * 1024 * LDK5, jj / 16, jj % 16, 2, fs);
    } else if ((jj -= 128) < 256) {
      transpose_tile(PP->w_out + (size_t)layer * 1024 * 1024, 1024, LDK1, PP->WoT + (size_t)layer * 1024 * LDK1, jj / 16, jj % 16, 2, fs);
    } else {
      jj -= 256;
      const int g = jj >> 2;
      transpose_tile(PP->pool_w + (size_t)(layer * 4 + g) * 128 * 128, 128, 128, PP->PwT + (size_t)(layer * 4 + g) * 128 * 128,
                     (jj & 3) >> 1, jj & 1, 0, fs);
    }
  }
  {
    const int tid2 = TID();
    const int l = tid2 & 63, w = tid2 >> 6, lr = l & 15, lg = l >> 4;
    char* Ks = smem;
    char* Ws = smem + 32768;
    for (int item = bid; item < DEPTH * 256; item += nb) {
      const int layer = item >> 8, hp = (item >> 4) & 15, ct = item & 15;
      __syncthreads();
      const float* ksrc = PP->peer_keys + (size_t)(layer * 16 + hp) * 128 * 128;
      for (int idx = tid2; idx < 128 * 16; idx += NTHR) {
        const int row = idx >> 4, ch = idx & 15;
        const float4 a = *(const float4*)(ksrc + row * 128 + ch * 8);
        const float4 c4 = *(const float4*)(ksrc + row * 128 + ch * 8 + 4);
        *(uint4*)(Ks + row * 256 + ((ch ^ (row & 15)) << 4)) =
            make_uint4(pack_bf16(a.x, a.y), pack_bf16(a.z, a.w), pack_bf16(c4.x, c4.y), pack_bf16(c4.z, c4.w));
      }
      const float* wsrc = PP->peer_wq + (size_t)layer * 1024 * 2048 + (size_t)(ct * 64) * 2048 + hp * 128;
      for (int idx = tid2; idx < 64 * 16; idx += NTHR) {
        const int row = idx >> 4, ch = idx & 15;
        const float4 a = *(const float4*)(wsrc + (size_t)row * 2048 + ch * 8);
        const float4 c4 = *(const float4*)(wsrc + (size_t)row * 2048 + ch * 8 + 4);
        *(uint4*)(Ws + row * 256 + ((ch ^ (row & 15)) << 4)) =
            make_uint4(pack_bf16(a.x, a.y), pack_bf16(a.z, a.w), pack_bf16(c4.x, c4.y), pack_bf16(c4.z, c4.w));
      }
      __syncthreads();
      f32x4 acc[2][4];
#pragma unroll
      for (int mi = 0; mi < 2; ++mi)
#pragma unroll
        for (int ni = 0; ni < 4; ++ni) acc[mi][ni] = (f32x4){0.f, 0.f, 0.f, 0.f};
#pragma unroll
      for (int ks = 0; ks < 4; ++ks) {
        const int ch = ks * 4 + lg;
        bf16x8 a[2], bb[4];
#pragma unroll
        for (int mi = 0; mi < 2; ++mi) a[mi] = *(const bf16x8*)(Ks + ((2 * w + mi) * 16 + lr) * 256 + ((ch ^ lr) << 4));
#pragma unroll
        for (int ni = 0; ni < 4; ++ni) bb[ni] = *(const bf16x8*)(Ws + (ni * 16 + lr) * 256 + ((ch ^ lr) << 4));
#pragma unroll
        for (int mi = 0; mi < 2; ++mi)
#pragma unroll
          for (int ni = 0; ni < 4; ++ni) acc[mi][ni] = __builtin_amdgcn_mfma_f32_16x16x32_bf16(a[mi], bb[ni], acc[mi][ni], 0, 0, 0);
      }
      unsigned char* dst = (unsigned char*)PP->WkT + ((size_t)layer * 2048 + hp * 128) * LDK1 + ct * 64;
#pragma unroll
      for (int mi = 0; mi < 2; ++mi)
#pragma unroll
        for (int ni = 0; ni < 4; ++ni)
#pragma unroll
          for (int r = 0; r < 4; ++r) {
            const float v32 = 32.f * acc[mi][ni][r];
            dst[(size_t)((2 * w + mi) * 16 + 4 * lg + r) * LDK1 + ni * 16 + lr] = (unsigned char)(__builtin_amdgcn_cvt_pk_fp8_f32(v32, v32, 0, false) & 0xff);
          }
    }
  }
}

DEV unsigned enc_e2m3(float x) {
  const float a = fabsf(x);
  float c;
  if (a < 2.f) c = a * 8.f;
  else if (a < 4.f) c = 16.f + (a - 2.f) * 4.f;
  else c = 24.f + (a - 4.f) * 2.f;
  unsigned code = (unsigned)__builtin_rintf(c);
  code = code > 31u ? 31u : code;
  return code | (x < 0.f ? 32u : 0u);
}
struct __attribute__((packed, aligned(4))) U3 { unsigned a, b, c; };
constexpr int TROW = 768;
typedef float f32x32_t __attribute__((ext_vector_type(32)));
typedef unsigned u32x6_t __attribute__((ext_vector_type(6)));

__device__ __forceinline__ void phase_tables(int layer, int vbid, int vnb) {
  const KP PP = get_params();
  const int tid = TID(), lane = tid & 63;
  const int gw = vbid * 4 + (tid >> 6), nw = vnb * 4;
  const float* su = PP->peer_u + (size_t)layer * NEXP * 1024;
  const float* sv = PP->peer_v + (size_t)layer * NEXP * 1024;
  for (int r0 = gw * 2; r0 < 2 * NEXP; r0 += nw * 2) {
    float4 v[2][4];
#pragma unroll
    for (int q = 0; q < 2; ++q) {
      const int r = r0 + q;
      const float* src = (r < NEXP ? su + (size_t)r * 1024 : sv + (size_t)(r - NEXP) * 1024);
#pragma unroll
      for (int i = 0; i < 4; ++i) v[q][i] = *(const float4*)(src + (lane + 64 * i) * 4);
    }
#pragma unroll
    for (int q = 0; q < 2; ++q) {
      const int r = r0 + q;
      float am = 0.f;
#pragma unroll
      for (int i = 0; i < 4; ++i)
        am = fmaxf(am, fmaxf(fmaxf(fabsf(v[q][i].x), fabsf(v[q][i].y)), fmaxf(fabsf(v[q][i].z), fabsf(v[q][i].w))));
      am = wave_max(am);
      const float scale = fmaxf(am, 1e-30f) * (1.f / 7.5f);
      const float inv = 1.f / scale;
      unsigned long long lo = 0ull;
      unsigned hi = 0u;
#pragma unroll
      for (int i = 0; i < 4; ++i) {
        const float vv[4] = {v[q][i].x * inv, v[q][i].y * inv, v[q][i].z * inv, v[q][i].w * inv};
#pragma unroll
        for (int j = 0; j < 4; ++j) {
          const int k = 4 * i + j;
          const unsigned cde = enc_e2m3(vv[j]);
          if (k < 10) lo |= (unsigned long long)cde << (6 * k);
          else if (k == 10) { lo |= (unsigned long long)cde << 60; hi |= cde >> 4; }
          else hi |= cde << (6 * k - 64);
        }
      }
      unsigned char* dst = (r < NEXP ? PP->tab8U + (size_t)r * TROW : PP->tab8V + (size_t)(r - NEXP) * TROW);
      U3 pk3;
      pk3.a = (unsigned)lo; pk3.b = (unsigned)(lo >> 32); pk3.c = hi;
      *(U3*)(dst + lane * 12) = pk3;
      if (lane == 0) { if (r < NEXP) PP->scU[r] = scale; else PP->scV[r - NEXP] = scale; }
    }
  }
}

__device__ __forceinline__ void phase_norm(int layer, int which) {
  const KP PP = get_params();
  const int lane = TID() & 63;
  const int gw = BID() * 4 + (TID() >> 6), nw = gridDim.x * 4;
  const float* nwt = (which == 1 ? PP->norm_mix : PP->norm_ffn) + layer * 1024;
  const int rlim = (which == 2 && layer == DEPTH - 1) ? NLAT : R;
  for (int r = gw; r < rlim; r += nw) {
    const float* xr;
    if (r < NLAT) xr = ((which == 1 && layer == 0) ? PP->x : PP->out) + (size_t)r * 1024;
    else xr = ((which == 1 && layer == 0) ? PP->ctx : PP->xc) + (size_t)(r - NLAT) * 1024;
    const float* md = PP->mod + (size_t)(layer * 3 + modsel(r)) * 6144 + (which == 1 ? 0 : 3072);
    float4 v[4];
    float ss = 0.f;
#pragma unroll
    for (int i = 0; i < 4; ++i) {
      v[i] = *(const float4*)(xr + (lane + 64 * i) * 4);
      ss += v[i].x * v[i].x + v[i].y * v[i].y + v[i].z * v[i].z + v[i].w * v[i].w;
    }
    ss = wave_sum(ss);
    const float rs = rsqrtf(ss * (1.f / 1024.f) + EPS);
#pragma unroll
    for (int i = 0; i < 4; ++i) {
      const int col = (lane + 64 * i) * 4;
      const float4 w = *(const float4*)(nwt + col);
      const float4 sh = *(const float4*)(md + col);
      const float4 sc = *(const float4*)(md + 1024 + col);
      const float y0 = v[i].x * rs * w.x * (1.f + sc.x) + sh.x;
      const float y1 = v[i].y * rs * w.y * (1.f + sc.y) + sh.y;
      const float y2 = v[i].z * rs * w.z * (1.f + sc.z) + sh.z;
      const float y3 = v[i].w * rs * w.w * (1.f + sc.w) + sh.w;
      if (which == 1) {
        int pk = __builtin_amdgcn_cvt_pk_fp8_f32(y0, y1, 0, false);
        pk = __builtin_amdgcn_cvt_pk_fp8_f32(y2, y3, pk, true);
        *(int*)((char*)PP->h + (size_t)r * (LDK1 * 2) + col) = pk;
      } else {
        *(uint2*)(PP->h + (size_t)r * LDK1 + col) = make_uint2(pack_bf16(y0, y1), pack_bf16(y2, y3));
        int pk = __builtin_amdgcn_cvt_pk_fp8_f32(y0, y1, 0, false);
        pk = __builtin_amdgcn_cvt_pk_fp8_f32(y2, y3, pk, true);
        *(int*)(PP->h8 + (size_t)r * LDK1 + col) = pk;
      }
    }
  }
}

template <bool PRIO>
DEV void gemm_mainloop_t(const u16* __restrict__ A, int lda, const u16* __restrict__ B, int ldb, int K, int m0, int n0,
                         char* smem, f32x4 (&acc)[4][4]) {
  const int tid = TID();
  const int l = tid & 63, w = tid >> 6, wm = w >> 1, wn = w & 1, lr = l & 15, lg = l >> 4;
  uint4 ga0[4], gb0[4], ga1[4], gb1[4];
#pragma unroll
  for (int i = 0; i < 4; ++i) { ga0[i] = make_uint4(0u, 0u, 0u, 0u); gb0[i] = ga0[i]; ga1[i] = ga0[i]; gb1[i] = ga0[i]; }
  const int KT = K >> 6;
#define GLOAD(GA, GB, KT_)                                                                     \
  _Pragma("unroll") for (int i = 0; i < 4; ++i) {                                              \
    const int id = tid + 256 * i, row = id >> 3, c = id & 7;                                   \
    GA[i] = *(const uint4*)(A + (size_t)(m0 + row) * lda + (KT_) * 64 + c * 8);                \
    GB[i] = *(const uint4*)(B + (size_t)(n0 + row) * ldb + (KT_) * 64 + c * 8);                \
  }
#define LSTORE(GA, GB, BUF)                                                                    \
  {                                                                                            \
    char* as_ = smem + (BUF) * 32768;                                                          \
    char* bs_ = as_ + 16384;                                                                   \
    _Pragma("unroll") for (int i = 0; i < 4; ++i) {                                            \
      const int id = tid + 256 * i, row = id >> 3, c = id & 7;                                 \
      const int off = row * 128 + ((c ^ (row & 7)) << 4);                                      \
      *(uint4*)(as_ + off) = GA[i];                                                            \
      *(uint4*)(bs_ + off) = GB[i];                                                            \
    }                                                                                          \
  }
#define COMPUTE(BUF)                                                                                                      \
  {                                                                                                                       \
    const char* as_ = smem + (BUF) * 32768;                                                                               \
    const char* bs_ = as_ + 16384;                                                                                        \
    if (PRIO) __builtin_amdgcn_s_setprio(1);      \
    _Pragma("unroll") for (int ks = 0; ks < 2; ++ks) {                                                                    \
      bf16x8 a[4], b[4];                                                                                                  \
      const int c = ks * 4 + lg;                                                                                          \
      const int sw = ((c ^ (lr & 7)) << 4);                                                                               \
      _Pragma("unroll") for (int mi = 0; mi < 4; ++mi) a[mi] = *(const bf16x8*)(as_ + (wm * 64 + mi * 16 + lr) * 128 + sw); \
      _Pragma("unroll") for (int ni = 0; ni < 4; ++ni) b[ni] = *(const bf16x8*)(bs_ + (wn * 64 + ni * 16 + lr) * 128 + sw); \
      _Pragma("unroll") for (int mi = 0; mi < 4; ++mi)                                                                    \
        _Pragma("unroll") for (int ni = 0; ni < 4; ++ni)                                                                  \
          acc[mi][ni] = __builtin_amdgcn_mfma_f32_16x16x32_bf16(a[mi], b[ni], acc[mi][ni], 0, 0, 0);                      \
    }                                                                                                                     \
    if (PRIO) __builtin_amdgcn_s_setprio(0);                                                                              \
  }
  __syncthreads();
  GLOAD(ga0, gb0, 0);
  GLOAD(ga1, gb1, 1);
  LSTORE(ga0, gb0, 0);
  __syncthreads();
  for (int kt = 0; kt < KT; kt += 2) {
    if (kt + 2 < KT) { GLOAD(ga0, gb0, kt + 2); }
    COMPUTE(0);
    LSTORE(ga1, gb1, 1);
    __syncthreads();
    if (kt + 3 < KT) { GLOAD(ga1, gb1, kt + 3); }
    COMPUTE(1);
    if (kt + 2 < KT) { LSTORE(ga0, gb0, 0); }
    __syncthreads();
  }
#undef GLOAD
#undef LSTORE
#undef COMPUTE
}

DEV void gemm_mainloop(const u16* __restrict__ A, int lda, const u16* __restrict__ B, int ldb, int K, int m0, int n0,
                       char* smem, f32x4 (&acc)[4][4]) {
  gemm_mainloop_t<false>(A, lda, B, ldb, K, m0, n0, smem, acc);
}
DEV void gemm_mainloop1(const u16* __restrict__ A, int lda, const u16* __restrict__ B, int ldb, int K, int m0, int n0,
                       char* smem, f32x4 (&acc)[4][4]) {
  const int tid = TID();
  const int l = tid & 63, w = tid >> 6, wm = w >> 1, wn = w & 1, lr = l & 15, lg = l >> 4;
  uint4 ga[4], gb[4];
  const int KT = K >> 6;
  auto gload = [&](int kt) {
#pragma unroll
    for (int i = 0; i < 4; ++i) {
      const int id = tid + 256 * i, row = id >> 3, c = id & 7;
      ga[i] = *(const uint4*)(A + (size_t)(m0 + row) * lda + kt * 64 + c * 8);
      gb[i] = *(const uint4*)(B + (size_t)(n0 + row) * ldb + kt * 64 + c * 8);
    }
  };
  auto lstore = [&](int buf) {
    char* as = smem + buf * 32768;
    char* bs = as + 16384;
#pragma unroll
    for (int i = 0; i < 4; ++i) {
      const int id = tid + 256 * i, row = id >> 3, c = id & 7;
      const int off = row * 128 + ((c ^ (row & 7)) << 4);
      *(uint4*)(as + off) = ga[i];
      *(uint4*)(bs + off) = gb[i];
    }
  };
  __syncthreads();
  gload(0);
  lstore(0);
  __syncthreads();
  for (int kt = 0; kt < KT; ++kt) {
    if (kt + 1 < KT) gload(kt + 1);
    const char* as = smem + (kt & 1) * 32768;
    const char* bs = as + 16384;
#pragma unroll
    for (int ks = 0; ks < 2; ++ks) {
      bf16x8 a[4], b[4];
      const int c = ks * 4 + lg;
      const int sw = ((c ^ (lr & 7)) << 4);
#pragma unroll
      for (int mi = 0; mi < 4; ++mi) a[mi] = *(const bf16x8*)(as + (wm * 64 + mi * 16 + lr) * 128 + sw);
#pragma unroll
      for (int ni = 0; ni < 4; ++ni) b[ni] = *(const bf16x8*)(bs + (wn * 64 + ni * 16 + lr) * 128 + sw);
#pragma unroll
      for (int mi = 0; mi < 4; ++mi)
#pragma unroll
        for (int ni = 0; ni < 4; ++ni) acc[mi][ni] = __builtin_amdgcn_mfma_f32_16x16x32_bf16(a[mi], b[ni], acc[mi][ni], 0, 0, 0);
    }
    if (kt + 1 < KT) lstore((kt + 1) & 1);
    __syncthreads();
  }
}

DEV void zero_acc(f32x4 (&acc)[4][4]) {
#pragma unroll
  for (int i = 0; i < 4; ++i)
#pragma unroll
    for (int j = 0; j < 4; ++j) acc[i][j] = (f32x4){0.f, 0.f, 0.f, 0.f};
}

DEV void stage_half(const f32x4 (&acc)[4][4], int hsel, char* smem, float4 (&v)[8]) {
  const int tid = TID();
  const int l = tid & 63, w = tid >> 6, wm = w >> 1, wn = w & 1, lr = l & 15, lg = l >> 4;
  float* Cs = (float*)smem;
  __syncthreads();
  if (wm == hsel) {
#pragma unroll
    for (int mi = 0; mi < 4; ++mi)
#pragma unroll
      for (int ni = 0; ni < 4; ++ni)
#pragma unroll
        for (int r = 0; r < 4; ++r) Cs[(mi * 16 + lg * 4 + r) * 132 + wn * 64 + ni * 16 + lr] = acc[mi][ni][r];
  }
  __syncthreads();
#pragma unroll
  for (int j = 0; j < 8; ++j) {
    const int idx = tid + 256 * j, row = idx >> 5, c4 = idx & 31;
    v[j] = *(const float4*)&Cs[row * 132 + c4 * 4];
  }
}

DEV bool tile_map(int it, int MT, int NTl, int& mt, int& nt) {
  const int nb = gridDim.x, bid = BID();
  const int x = bid & 7, vl = bid >> 3, per = nb >> 3;
  const int T = MT * NTl;
  const int g_begin = (int)(((long long)x * T) >> 3), g_end = (int)(((long long)(x + 1) * T) >> 3);
  const int g = g_begin + vl + it * per;
  if (g >= g_end) return false;
  const int full = MT >> 3;
  const int sr = g / (8 * NTl);
  const int srow = sr < full ? sr : full;
  const int rows_in_sr = sr < full ? 8 : (MT & 7);
  const int tt = g - srow * 8 * NTl;
  nt = tt / rows_in_sr;
  mt = srow * 8 + tt % rows_in_sr;
  return true;
}

#define SG_LOCALS                                                                              \
  const int tid = TID();                                                                       \
  const int l = tid & 63, w = tid >> 6, wm = w >> 1, wn = w & 1, lr = l & 15, lg = l >> 4;     \
  uint4 ga0[4], gb0[4], ga1[4], gb1[4];                                                        \
  _Pragma("unroll") for (int i = 0; i < 4; ++i) {                                              \
    ga0[i] = make_uint4(0u, 0u, 0u, 0u); gb0[i] = ga0[i]; ga1[i] = ga0[i]; gb1[i] = ga0[i];    \
  }                                                                                            \
  const int r0 = tid >> 3, c0 = tid & 7;                                                       \
  const int pr0 = 8 * ((r0 & 15) >> 2) + 4 * (r0 >> 4) + (r0 & 3);
#define SG_LOAD(GA, GB, AP, BP, LD, M0_, N0_, KT_)                                             \
  _Pragma("unroll") for (int i = 0; i < 4; ++i) {                                              \
    GA[i] = *(const uint4*)((AP) + (size_t)((M0_) + 32 * i + r0) * (LD) + c0 * 8 + (KT_) * 64);  \
    GB[i] = *(const uint4*)((BP) + (size_t)((N0_) + 32 * i + pr0) * (LD) + c0 * 8 + (KT_) * 64); \
  }
#define SG_LSTORE(GA, GB, BUF)                                                                 \
  {                                                                                            \
    char* as_ = smem + (BUF) * 32768;                                                          \
    char* bs_ = as_ + 16384;                                                                   \
    _Pragma("unroll") for (int i = 0; i < 4; ++i) {                                            \
      const int id = tid + 256 * i, row = id >> 3, c = id & 7;                                 \
      const int off = row * 128 + ((c ^ (row & 7)) << 4);                                      \
      *(uint4*)(as_ + off) = GA[i];                                                            \
      *(uint4*)(bs_ + off) = GB[i];                                                            \
    }                                                                                          \
  }
#define SG_COMPUTE(ACC, BUF, PRIO)                                                                                        \
  {                                                                                                                       \
    const char* as_ = smem + (BUF) * 32768;                                                                               \
    const char* bs_ = as_ + 16384;                                                                                        \
    if (PRIO) __builtin_amdgcn_s_setprio(1);                                                                              \
    _Pragma("unroll") for (int ks = 0; ks < 2; ++ks) {                                                                    \
      bf16x8 a[4], b[4];                                                                                                  \
      const int c = ks * 4 + lg;                                                                                          \
      const int sw = ((c ^ (lr & 7)) << 4);                                                                               \
      _Pragma("unroll") for (int mi = 0; mi < 4; ++mi) a[mi] = *(const bf16x8*)(as_ + (wm * 64 + mi * 16 + lr) * 128 + sw); \
      _Pragma("unroll") for (int ni = 0; ni < 4; ++ni) b[ni] = *(const bf16x8*)(bs_ + (wn * 64 + ni * 16 + lr) * 128 + sw); \
      _Pragma("unroll") for (int mi = 0; mi < 4; ++mi)                                                                    \
        _Pragma("unroll") for (int ni = 0; ni < 4; ++ni)                                                                  \
          ACC[mi][ni] = __builtin_amdgcn_mfma_f32_16x16x32_bf16(b[ni], a[mi], ACC[mi][ni], 0, 0, 0);                      \
    }                                                                                                                     \
    if (PRIO) __builtin_amdgcn_s_setprio(0);                                                                              \
  }

typedef int i32x8 __attribute__((ext_vector_type(8)));
typedef int i32x4 __attribute__((ext_vector_type(4)));
#define F8_LOCALS                                                                              \
  const int tid = TID();                                                                       \
  const int l = tid & 63, w = tid >> 6, wm = w >> 1, wn = w & 1, lr = l & 15, lg = l >> 4;     \
  uint4 ga0[4], gb0[4], ga1[4], gb1[4];                                                        \
  _Pragma("unroll") for (int i = 0; i < 4; ++i) {                                              \
    ga0[i] = make_uint4(0u, 0u, 0u, 0u); gb0[i] = ga0[i]; ga1[i] = ga0[i]; gb1[i] = ga0[i];    \
  }                                                                                            \
  const int r0 = tid >> 3, c0 = tid & 7;                                                       \
  const int pr0 = 8 * ((r0 & 15) >> 2) + 4 * (r0 >> 4) + (r0 & 3);
#define F8_GLOAD(GA, GB, AP, LDA, BP, LDB, M0_, N0_, KT_)                                      \
  _Pragma("unroll") for (int i = 0; i < 4; ++i) {                                              \
    GA[i] = *(const uint4*)((AP) + (size_t)((M0_) + 32 * i + r0) * (LDA) + c0 * 16 + (KT_) * 128);   \
    GB[i] = *(const uint4*)((BP) + (size_t)((N0_) + 32 * i + pr0) * (LDB) + c0 * 16 + (KT_) * 128);  \
  }
#define F8_LSTORE(GA, GB, BUF)                                                                 \
  {                                                                                            \
    char* as_ = smem + (BUF) * 32768;                                                          \
    char* bs_ = as_ + 16384;                                                                   \
    _Pragma("unroll") for (int i = 0; i < 4; ++i) {                                            \
      const int id = tid + 256 * i, row = id >> 3, c = id & 7;                                 \
      const int off = row * 128 + ((c ^ (row & 7)) << 4);                                      \
      *(uint4*)(as_ + off) = GA[i];                                                            \
      *(uint4*)(bs_ + off) = GB[i];                                                            \
    }                                                                                          \
  }
#define F8_COMPUTE(BUF)                                                                                                   \
  {                                                                                                                       \
    const char* as_ = smem + (BUF) * 32768;                                                                               \
    const char* bs_ = as_ + 16384;                                                                                        \
    i32x8 a[4], b[4];                                                                                                     \
    const int sw0 = ((lg ^ (lr & 7)) << 4), sw1 = (((4 + lg) ^ (lr & 7)) << 4);                                           \
    _Pragma("unroll") for (int mi = 0; mi < 4; ++mi) {                                                                    \
      const char* p_ = as_ + (wm * 64 + mi * 16 + lr) * 128;                                                              \
      const i32x4 lo_ = *(const i32x4*)(p_ + sw0), hi_ = *(const i32x4*)(p_ + sw1);                                       \
      a[mi] = __builtin_shufflevector(lo_, hi_, 0, 1, 2, 3, 4, 5, 6, 7);                                                  \
    }                                                                                                                     \
    _Pragma("unroll") for (int ni = 0; ni < 4; ++ni) {                                                                    \
      const char* p_ = bs_ + (wn * 64 + ni * 16 + lr) * 128;                                                              \
      const i32x4 lo_ = *(const i32x4*)(p_ + sw0), hi_ = *(const i32x4*)(p_ + sw1);                                       \
      b[ni] = __builtin_shufflevector(lo_, hi_, 0, 1, 2, 3, 4, 5, 6, 7);                                                  \
    }                                                                                                                     \
    __builtin_amdgcn_s_setprio(1);                                                                                        \
    _Pragma("unroll") for (int mi = 0; mi < 4; ++mi)                                                                      \
      _Pragma("unroll") for (int ni = 0; ni < 4; ++ni)                                                                    \
        acc[mi][ni] = __builtin_amdgcn_mfma_scale_f32_16x16x128_f8f6f4(b[ni], a[mi], acc[mi][ni], 0, 0, 0, 0, 0, 0);      \
    __builtin_amdgcn_s_setprio(0);                                                                                        \
  }
#define F8_KLOOP(AP, LDA, BP, LDB, KT_)                                                        \
  for (int kt = 0; kt < (KT_); kt += 2) {                                                      \
    const bool wrap = (kt + 2 >= (KT_));                                                       \
    const int ml = wrap ? m0n : m0, nl = wrap ? n0n : n0, kl = wrap ? kt + 2 - (KT_) : kt + 2; \
    if (!wrap || hasn) { F8_GLOAD(ga0, gb0, AP, LDA, BP, LDB, ml, nl, kl); }                   \
    F8_COMPUTE(0);                                                                             \
    F8_LSTORE(ga1, gb1, 1);                                                                    \
    __syncthreads();                                                                           \
    if (!wrap || hasn) { F8_GLOAD(ga1, gb1, AP, LDA, BP, LDB, ml, nl, kl + 1); }               \
    F8_COMPUTE(1);                                                                             \
    if (!wrap || hasn) { F8_LSTORE(ga0, gb0, 0); }                                             \
    __syncthreads();                                                                           \
  }
#define F8_PROLOGUE(AP, LDA, BP, LDB)                                                          \
  __syncthreads();                           \
  F8_GLOAD(ga0, gb0, AP, LDA, BP, LDB, m0, n0, 0);                                             \
  F8_GLOAD(ga1, gb1, AP, LDA, BP, LDB, m0, n0, 1);                                             \
  F8_LSTORE(ga0, gb0, 0);                                                                      \
  __syncthreads();

__device__ __forceinline__ void phase_gemm_win(int layer, char* smem) {
  const KP PP = get_params();
  const char* Bt = (const char*)(PP->WinT + (size_t)layer * NPAD * LDK1);
  const char* A = (const char*)PP->h;
  F8_LOCALS
  int it = 0, mt, nt;
  if (!tile_map(it, R / 128, NPAD / 128, mt, nt)) return;
  int m0 = mt * 128, n0 = nt * 128;
  F8_PROLOGUE(A, LDK1 * 2, Bt, LDK1)
  for (;;) {
    int mtn = 0, ntn = 0;
    const bool hasn = tile_map(it + 1, R / 128, NPAD / 128, mtn, ntn);
    const int m0n = mtn * 128, n0n = ntn * 128;
    f32x4 acc[4][4];
    zero_acc(acc);
    F8_KLOOP(A, LDK1 * 2, Bt, LDK1, 8)
#pragma unroll
    for (int mi = 0; mi < 4; ++mi) {
      const size_t gr = (size_t)(m0 + wm * 64 + mi * 16 + lr);
#pragma unroll
      for (int g = 0; g < 2; ++g) {
        const int gc = n0 + wn * 64 + g * 32 + 8 * lg;
        const f32x4 t0 = acc[mi][2 * g] * (1.f / 32.f), t1 = acc[mi][2 * g + 1] * (1.f / 32.f);
        if (n0 < 1536) {
          int p0 = __builtin_amdgcn_cvt_pk_fp8_f32(t0[0], t0[1], 0, false);
          p0 = __builtin_amdgcn_cvt_pk_fp8_f32(t0[2], t0[3], p0, true);
          int p1 = __builtin_amdgcn_cvt_pk_fp8_f32(t1[0], t1[1], 0, false);
          p1 = __builtin_amdgcn_cvt_pk_fp8_f32(t1[2], t1[3], p1, true);
          *(int2*)((char*)PP->qkv_pre + gr * 1536 + gc) = make_int2(p0, p1);
        } else if (n0 < 2048) {
          *(uint4*)(PP->z + gr * 512 + (gc - 1536)) =
              make_uint4(pack_bf16(t0[0], t0[1]), pack_bf16(t0[2], t0[3]), pack_bf16(t1[0], t1[1]), pack_bf16(t1[2], t1[3]));
        } else if (n0 < 2560) {
          *(uint4*)(PP->pin + gr * 512 + (gc - 2048)) =
              make_uint4(pack_bf16(t0[0], t0[1]), pack_bf16(t0[2], t0[3]), pack_bf16(t1[0], t1[1]), pack_bf16(t1[2], t1[3]));
        } else if (n0 < 4608) {
          unsigned q0 = 0u, q1 = 0u;
#pragma unroll
          for (int e = 0; e < 4; ++e) {
            q0 = __builtin_amdgcn_cvt_pk_u8_f32(sigmoidf_(t0[e]) * 255.f, e, q0);
            q1 = __builtin_amdgcn_cvt_pk_u8_f32(sigmoidf_(t1[e]) * 255.f, e, q1);
          }
          unsigned char* gdst = (n0 < 3584) ? (unsigned char*)PP->sgd + gr * 1024 + (gc - 2560)
                                            : (unsigned char*)PP->sgp + gr * 1024 + (gc - 3584);
          *(uint2*)gdst = make_uint2(q0, q1);
        } else {
          if (gc - 4608 < 16) {
            *(float4*)(PP->ba + gr * 16 + (gc - 4608)) = make_float4(t0[0], t0[1], t0[2], t0[3]);
            *(float4*)(PP->ba + gr * 16 + (gc - 4608) + 4) = make_float4(t1[0], t1[1], t1[2], t1[3]);
          }
        }
      }
    }
    if (!hasn) break;
    m0 = m0n; n0 = n0n; ++it;
  }
}

__device__ __forceinline__ void phase_conv(int layer) {
  const KP PP = get_params();
  const int lane = TID() & 63;
  const int gw = BID() * 4 + (TID() >> 6), nw = gridDim.x * 4;
  const float* cw = PP->conv_w + (size_t)layer * 4 * 1536;
  float wr[3][4][8];
#pragma unroll
  for (int part = 0; part < 3; ++part)
#pragma unroll
    for (int j = 0; j < 4; ++j) {
      const float4 w0 = *(const float4*)(cw + j * 1536 + part * 512 + lane * 8);
      const float4 w1 = *(const float4*)(cw + j * 1536 + part * 512 + lane * 8 + 4);
      wr[part][j][0] = w0.x; wr[part][j][1] = w0.y; wr[part][j][2] = w0.z; wr[part][j][3] = w0.w;
      wr[part][j][4] = w1.x; wr[part][j][5] = w1.y; wr[part][j][6] = w1.z; wr[part][j][7] = w1.w;
    }
  for (int r = gw; r < R; r += nw) {
    int t, T;
    if (r < NLAT) { t = r & (SEQ - 1); T = SEQ; } else { t = (r - NLAT) & (CTX - 1); T = CTX; }
    const int base = r - t;
    uint2 xv[3][4];
#pragma unroll
    for (int j = 0; j < 4; ++j) {
      const int tt = t + j - 2;
      const bool ok = (tt >= 0 && tt < T);
      const unsigned char* src = (const unsigned char*)PP->qkv_pre + (size_t)(base + (ok ? tt : t)) * 1536 + lane * 8;
#pragma unroll
      for (int part = 0; part < 3; ++part) {
        xv[part][j] = *(const uint2*)(src + part * 512);
        if (!ok) xv[part][j] = make_uint2(0u, 0u);
      }
    }
#pragma unroll
    for (int part = 0; part < 3; ++part) {
      const int ch0 = part * 512 + lane * 8;
      float y[8];
#pragma unroll
      for (int e = 0; e < 8; ++e) y[e] = 0.f;
#pragma unroll
      for (int j = 0; j < 4; ++j) {
        float xf[8];
        {
          const f32x2 a0 = __builtin_amdgcn_cvt_pk_f32_fp8(xv[part][j].x, false), a1 = __builtin_amdgcn_cvt_pk_f32_fp8(xv[part][j].x, true);
          const f32x2 a2 = __builtin_amdgcn_cvt_pk_f32_fp8(xv[part][j].y, false), a3 = __builtin_amdgcn_cvt_pk_f32_fp8(xv[part][j].y, true);
          xf[0] = a0[0]; xf[1] = a0[1]; xf[2] = a1[0]; xf[3] = a1[1]; xf[4] = a2[0]; xf[5] = a2[1]; xf[6] = a3[0]; xf[7] = a3[1];
        }
#pragma unroll
        for (int e = 0; e < 8; ++e) y[e] += wr[part][j][e] * xf[e];
      }
      float ss = 0.f;
#pragma unroll
      for (int e = 0; e < 8; ++e) { y[e] = siluf_(y[e]); ss += y[e] * y[e]; }
      if (part < 2) {
        ss = group16_sum(ss);
        const float sc = rsqrtf(ss + EPS) * (part == 0 ? 0.08838834764831845f : 1.f);
#pragma unroll
        for (int e = 0; e < 8; ++e) y[e] *= sc;
      }
      *(uint4*)(PP->qkvn + (size_t)r * 1536 + ch0) = pack8(y);
    }
    if (lane < 16) {
      const float raw = PP->ba[(size_t)r * 16 + lane];
      float o;
      if (lane < 8) {
        o = sigmoidf_(raw);
      } else {
        const int jj = lane - 8;
        const float xx = raw + PP->dt_bias[layer * 8 + jj];
        const float ee = __expf(xx);
        const float sp = xx > 20.f ? xx : (ee < 0.03125f ? ee * (1.f - ee * (0.5f - ee * (0.33333334f - 0.25f * ee))) : __logf(1.f + ee));
        o = -__expf(PP->a_log[layer * 8 + jj]) * sp;
      }
      PP->bg[(size_t)r * 16 + lane] = o;
    }
  }
}

DEV int seq_row(int b, int dir, int pos) {
  if (dir == 0) return pos < CTX ? NLAT + b * CTX + pos : b * SEQ + (pos - CTX);
  return pos < CTX ? NLAT + b * CTX + (CTX - 1 - pos) : b * SEQ + (SEQ - 1 - (pos - CTX));
}
constexpr int NCHUNK = (CTX + SEQ) / 64;
constexpr int NUNIT = BATCH * DNH * 2 * NCHUNK;

DEV int kperm(int s, int g, int e) { return 32 * s + 16 * (e >> 2) + 4 * g + (e & 3); }

DEV uint4 pack_tiles(const f32x4& a, const f32x4& b) {
  return make_uint4(pack_bf16(a[0], a[1]), pack_bf16(a[2], a[3]), pack_bf16(b[0], b[1]), pack_bf16(b[2], b[3]));
}
DEV bf16x8 as_frag(const uint4& v) { return *(const bf16x8*)&v; }

DEV void conv8_silu(const unsigned char* __restrict__ qkv_pre8, const float* __restrict__ cw, int r, int ch0, float (&y)[8]) {
  int t, T;
  if (r < NLAT) { t = r & (SEQ - 1); T = SEQ; } else { t = (r - NLAT) & (CTX - 1); T = CTX; }
  const int base = r - t;
  uint2 xv[4];
#pragma unroll
  for (int j = 0; j < 4; ++j) {
    const int tt = t + j - 2;
    const bool ok = (tt >= 0 && tt < T);
    xv[j] = *(const uint2*)(qkv_pre8 + (size_t)(base + (ok ? tt : t)) * 1536 + ch0);
    if (!ok) xv[j] = make_uint2(0u, 0u);
  }
#pragma unroll
  for (int e = 0; e < 8; ++e) y[e] = 0.f;
#pragma unroll
  for (int j = 0; j < 4; ++j) {
    const float4 w0 = *(const float4*)(cw + j * 1536 + ch0), w1 = *(const float4*)(cw + j * 1536 + ch0 + 4);
    const f32x2 a0 = __builtin_amdgcn_cvt_pk_f32_fp8(xv[j].x, false), a1 = __builtin_amdgcn_cvt_pk_f32_fp8(xv[j].x, true);
    const f32x2 a2 = __builtin_amdgcn_cvt_pk_f32_fp8(xv[j].y, false), a3 = __builtin_amdgcn_cvt_pk_f32_fp8(xv[j].y, true);
    y[0] += w0.x * a0[0]; y[1] += w0.y * a0[1]; y[2] += w0.z * a1[0]; y[3] += w0.w * a1[1];
    y[4] += w1.x * a2[0]; y[5] += w1.y * a2[1]; y[6] += w1.z * a3[0]; y[7] += w1.w * a3[1];
  }
#pragma unroll
  for (int e = 0; e < 8; ++e) y[e] = siluf_(y[e]);
}

__device__ __forceinline__ void phase_prep(int layer, char* smem) {
  const KP PP = get_params();
  const int tid0 = TID();
  const int w = __builtin_amdgcn_readfirstlane(tid0 >> 6);
  char* Kt = smem;
  char* Vt = smem + 16384;
  float* Ld = (float*)(smem + 32768);
  u16* LN = (u16*)(smem + 32768 + 5120);
  float* gcs = (float*)(smem + 32768 + 5120 + 9216);
  float* bts = gcs + 64;
  char* wpriv = smem + 32768 + 5120 + 9216 + 512 + w * 6144;
  float* Tt = (float*)wpriv;
  u16* Xb = (u16*)(wpriv + 4096);
  for (int j_ = BID() >> 3; j_ < 2 * NCHUNK; j_ += (gridDim.x >> 3)) {
    const int c = NCHUNK - 1 - (j_ >> 1), u16i = (BID() & 7) * 2 + (j_ & 1);
    const int unit = u16i * NCHUNK + c;
    const int dir = u16i & 1, hd = (u16i >> 1) & 3, b = u16i >> 3;
    int tid = tid0;
    asm volatile("" : "+v"(tid));
    const int l = tid & 63, lr = l & 15, lg = l >> 4;
    __syncthreads();
    if (tid < 64) {
      const int rr = seq_row(b, dir, c * 64 + tid);
      const int jj = dir * 4 + hd;
      bts[tid] = sigmoidf_(PP->ba[(size_t)rr * 16 + jj]);
      float g;
      {
        const float xx = PP->ba[(size_t)rr * 16 + 8 + jj] + PP->dt_bias[layer * 8 + jj];
        const float ee = __expf(xx);
        const float sp = xx > 20.f ? xx : (ee < 0.03125f ? ee * (1.f - ee * (0.5f - ee * (0.33333334f - 0.25f * ee))) : __logf(1.f + ee));
        g = -__expf(PP->a_log[layer * 8 + jj]) * sp;
      }
#pragma unroll
      for (int o = 1; o < 64; o <<= 1) {
        const float t = __builtin_bit_cast(float, __builtin_amdgcn_ds_bpermute(((tid - o) & 63) << 2, __builtin_bit_cast(int, g)));
        if (tid >= o) g += t;
      }
      gcs[tid] = g;
      PP->gc[(size_t)unit * 64 + tid] = g;
    }
    {
      const unsigned char* pre8 = (const unsigned char*)PP->qkv_pre;
      const float* cw = PP->conv_w + (size_t)layer * 4 * 1536;
      const int ch = tid & 15, rg = tid >> 4;
      const int r_first = seq_row(b, dir, c * 64 + 4 * rg);
      int t0, T;
      if (r_first < NLAT) { t0 = r_first & (SEQ - 1); T = SEQ; } else { t0 = (r_first - NLAT) & (CTX - 1); T = CTX; }
      const int base = r_first - t0;
      const int tl = dir ? t0 - 3 : t0;
      const int nparts = dir == 0 ? 3 : 2;
      for (int part = 0; part < nparts; ++part) {
        const int chofs = (part == 0 ? 512 : (part == 1 ? 1024 : 0)) + hd * 128 + ch * 8;
        float wv[4][8];
#pragma unroll
        for (int j = 0; j < 4; ++j) {
          const float4 w0 = *(const float4*)(cw + j * 1536 + chofs), w1 = *(const float4*)(cw + j * 1536 + chofs + 4);
          wv[j][0] = w0.x; wv[j][1] = w0.y; wv[j][2] = w0.z; wv[j][3] = w0.w;
          wv[j][4] = w1.x; wv[j][5] = w1.y; wv[j][6] = w1.z; wv[j][7] = w1.w;
        }
        uint2 xr[7];
#pragma unroll
        for (int m = 0; m < 7; ++m) {
          const int tt = tl - 2 + m;
          const bool ok = (tt >= 0 && tt < T);
          xr[m] = *(const uint2*)(pre8 + (size_t)(base + (ok ? tt : t0)) * 1536 + chofs);
          if (!ok) xr[m] = make_uint2(0u, 0u);
        }
        float xf[7][8];
#pragma unroll
        for (int m = 0; m < 7; ++m) {
          const f32x2 a0 = __builtin_amdgcn_cvt_pk_f32_fp8(xr[m].x, false), a1 = __builtin_amdgcn_cvt_pk_f32_fp8(xr[m].x, true);
          const f32x2 a2 = __builtin_amdgcn_cvt_pk_f32_fp8(xr[m].y, false), a3 = __builtin_amdgcn_cvt_pk_f32_fp8(xr[m].y, true);
          xf[m][0] = a0[0]; xf[m][1] = a0[1]; xf[m][2] = a1[0]; xf[m][3] = a1[1];
          xf[m][4] = a2[0]; xf[m][5] = a2[1]; xf[m][6] = a3[0]; xf[m][7] = a3[1];
        }
#pragma unroll
        for (int s4 = 0; s4 < 4; ++s4) {
          const int m0_ = dir ? 3 - s4 : s4;
          float y[8];
          float ss = 0.f;
#pragma unroll
          for (int e2 = 0; e2 < 8; ++e2) {
            float a = 0.f;
#pragma unroll
            for (int j = 0; j < 4; ++j) a += wv[j][e2] * (dir ? xf[3 - s4 + j][e2] : xf[s4 + j][e2]);
            a = siluf_(a);
            y[e2] = a;
            ss += a * a;
          }
          if (part != 1) {
            ss = group16_sum(ss);
            const float sc = rsqrtf(ss + EPS) * (part == 2 ? 0.08838834764831845f : 1.f);
#pragma unroll
            for (int e2 = 0; e2 < 8; ++e2) y[e2] *= sc;
          }
          const uint4 pk = pack8(y);
          const int i = 4 * rg + s4;
          if (part < 2) *(uint4*)((part == 0 ? Kt : Vt) + i * 256 + ((ch ^ (i & 15)) << 4)) = pk;
          if (dir == 0 && part != 1) *(uint4*)(PP->qkvn + (size_t)(base + tl + m0_) * 1536 + chofs) = pk;
        }
      }
    }
    __syncthreads();
    {
      f32x4 acc[4];
#pragma unroll
      for (int nt = 0; nt < 4; ++nt) acc[nt] = (f32x4){0.f, 0.f, 0.f, 0.f};
#pragma unroll
      for (int s = 0; s < 4; ++s) {
        const int ch = s * 4 + lg;
        const bf16x8 a = *(const bf16x8*)(Kt + (16 * w + lr) * 256 + ((ch ^ lr) << 4));
#pragma unroll
        for (int nt = 0; nt < 4; ++nt) {
          const bf16x8 bb = *(const bf16x8*)(Kt + (16 * nt + lr) * 256 + ((ch ^ lr) << 4));
          acc[nt] = __builtin_amdgcn_mfma_f32_16x16x32_bf16(a, bb, acc[nt], 0, 0, 0);
        }
      }
#pragma unroll
      for (int nt = 0; nt < 4; ++nt)
#pragma unroll
        for (int r = 0; r < 4; ++r) {
          const int i = 16 * w + 4 * lg + r, j = 16 * nt + lr;
          const float val = (j < i) ? bts[i] * acc[nt][r] * __expf(fminf(gcs[i] - gcs[j], 0.f)) : 0.f;
          LN[i * 72 + j] = f2bf(-val);
          if (nt == w) Ld[(w * 16 + lr) * 20 + 4 * lg + r] = val;
        }
    }
    {
      const float glast = gcs[63];
      if (tid == 0) PP->glast[unit] = glast;
#pragma unroll
      for (int q4 = 0; q4 < 4; ++q4) {
        const int fid = tid + 256 * q4;
        const int mt = fid >> 7, s2 = (fid >> 6) & 1, ln = fid & 63, llr = ln & 15, llg = ln >> 4;
        const int d = 16 * mt + llr;
        float f[8];
#pragma unroll
        for (int e = 0; e < 8; ++e) {
          const int pos = kperm(s2, llg, e);
          const float kv = bf2f(*(const u16*)(Kt + pos * 256 + (((d >> 3) ^ (pos & 15)) << 4) + (d & 7) * 2));
          f[e] = kv * __expf(glast - gcs[pos]);
        }
        *(uint4*)(PP->KdT + ((size_t)unit * 1024 + fid) * 8) = pack8(f);
      }
    }
    f32x4 X[4][4];
    {
      const bool isU = w >= 2;
      const char* tile = isU ? Vt : Kt;
#pragma unroll
      for (int mt = 0; mt < 4; ++mt)
#pragma unroll
        for (int nt = 0; nt < 4; ++nt)
#pragma unroll
          for (int r = 0; r < 4; ++r) {
            const int i = 16 * mt + 4 * lg + r, cc = 64 * (w & 1) + 16 * nt + lr;
            const float val = bf2f(*(const u16*)(tile + i * 256 + (((cc >> 3) ^ (i & 15)) << 4) + (cc & 7) * 2));
            X[mt][nt][r] = bts[i] * val * (isU ? 1.f : __expf(gcs[i]));
          }
    }
    __syncthreads();
    u16* Wst = (u16*)smem;
    u16* Ust = (u16*)(smem + 16384);
#pragma unroll
    for (int bk = 0; bk < 4; ++bk) {
#pragma unroll
      for (int nt = 0; nt < 4; ++nt)
#pragma unroll
        for (int r = 0; r < 4; ++r) Tt[(4 * lg + r) * 64 + 16 * nt + lr] = X[bk][nt][r];
      __builtin_amdgcn_wave_barrier();
      asm volatile("s_waitcnt lgkmcnt(0)" ::: "memory");
      float xb[16];
#pragma unroll
      for (int i = 0; i < 16; ++i) xb[i] = Tt[i * 64 + l];
#pragma unroll
      for (int j = 0; j < 15; ++j) {
        const float xj = xb[j];
#pragma unroll
        for (int i4 = (j + 1) / 4; i4 < 4; ++i4) {
          const float4 lv = *(const float4*)&Ld[(bk * 16 + j) * 20 + i4 * 4];
          if (i4 * 4 + 0 > j) xb[i4 * 4 + 0] -= lv.x * xj;
          if (i4 * 4 + 1 > j) xb[i4 * 4 + 1] -= lv.y * xj;
          if (i4 * 4 + 2 > j) xb[i4 * 4 + 2] -= lv.z * xj;
          if (i4 * 4 + 3 > j) xb[i4 * 4 + 3] -= lv.w * xj;
        }
      }
      {
        const int cc = 64 * (w & 1) + l;
        if (w < 2) {
          const int d = cc, s = d >> 5, e = ((d >> 4) & 1) * 4 + (d & 3), g = (d >> 2) & 3;
#pragma unroll
          for (int ii = 0; ii < 16; ++ii) Wst[(((bk * 4 + s) * 64 + g * 16 + ii) << 3) + e] = f2bf(-xb[ii]);
        } else {
          const int slice = cc >> 4, lr_ = cc & 15;
#pragma unroll
          for (int ii = 0; ii < 16; ++ii) Ust[(((slice * 4 + bk) * 64 + ((ii >> 2) & 3) * 16 + lr_) << 2) + (ii & 3)] = f2bf(xb[ii]);
        }
        if (bk < 3) {
          *(uint4*)(Xb + l * 16) = pack8(xb);
          *(uint4*)(Xb + l * 16 + 8) = pack8(xb + 8);
        }
      }
      if (bk < 3) {
        __builtin_amdgcn_wave_barrier();
        asm volatile("s_waitcnt lgkmcnt(0)" ::: "memory");
        uint4 bfr[4];
#pragma unroll
        for (int nt = 0; nt < 4; ++nt)
          bfr[nt] = (lg < 2) ? *(const uint4*)(Xb + (16 * nt + lr) * 16 + 8 * lg) : make_uint4(0u, 0u, 0u, 0u);
#pragma unroll
        for (int mt = bk + 1; mt < 4; ++mt) {
          const uint4 afr = (lg < 2) ? *(const uint4*)(LN + (16 * mt + lr) * 72 + 16 * bk + 8 * lg) : make_uint4(0u, 0u, 0u, 0u);
#pragma unroll
          for (int nt = 0; nt < 4; ++nt)
            X[mt][nt] = __builtin_amdgcn_mfma_f32_16x16x32_bf16(as_frag(afr), as_frag(bfr[nt]), X[mt][nt], 0, 0, 0);
        }
        __builtin_amdgcn_wave_barrier();
      }
    }
    __syncthreads();
#pragma unroll
    for (int q = 0; q < 4; ++q) {
      const int id = tid + 256 * q;
      *(uint4*)(PP->Wfrag + ((size_t)unit * 1024 + id) * 8) = *(const uint4*)(smem + id * 16);
      *(uint4*)(PP->Ufrag + ((size_t)unit * 1024 + id) * 8) = *(const uint4*)(smem + 16384 + id * 16);
    }
  }
}


__device__ __forceinline__ void phase_scan(char* smem) {
  const KP PP = get_params();
  const int tid = TID(), lane = tid & 63, wv = tid >> 6;
  __builtin_amdgcn_s_setprio(3);
  for (int item = BID(); item < 128; item += gridDim.x) {
    const int u16i = (item & 7) * 2 + (item >> 6), slice = (item >> 3) & 7;
    const size_t ubase = (size_t)u16i * NCHUNK;
    const uint4* Wg = (const uint4*)PP->Wfrag;
    const uint4* Kg = (const uint4*)PP->KdT;
    __syncthreads();
    if (wv != 0) {
      const int j0 = wv - 1;
      uint4 st0[11], st1[11], st2[11];
#pragma unroll
      for (int i = 0; i < 11; ++i) { st0[i] = make_uint4(0u, 0u, 0u, 0u); st1[i] = st0[i]; st2[i] = st0[i]; }
#define LLOAD(ST, UNIT)                                                                                      \
  _Pragma("unroll") for (int i = 0; i < 11; ++i) {                                                           \
    const int q = (j0 + 3 * i) < 32 ? (j0 + 3 * i) : 31;                                                     \
    ST[i] = *((q < 16 ? Wg + (UNIT) * 1024 + q * 64 : Kg + (UNIT) * 1024 + (q - 16) * 64) + lane);           \
  }
#define LWRITE(ST, SLOT)                                                                                     \
  _Pragma("unroll") for (int i = 0; i < 11; ++i) {                                                           \
    const int q = (j0 + 3 * i) < 32 ? (j0 + 3 * i) : 31;                                                     \
    *(uint4*)((SLOT) + q * 1024 + lane * 16) = ST[i];                                                        \
  }
      LLOAD(st0, ubase);
      LLOAD(st1, ubase + 1);
      LLOAD(st2, ubase + 2);
      LWRITE(st0, smem);
      LLOAD(st0, ubase + 3);
      __syncthreads();
#define LSTEP(ST, C)                                                                   \
  {                                                                                    \
    LWRITE(ST, smem + (((C) + 1) & 1) * 32768);                                        \
    LLOAD(ST, ubase + (size_t)(((C) + 4 < NCHUNK) ? (C) + 4 : NCHUNK - 1));            \
    __syncthreads();                                                                   \
  }
      for (int c0 = 0; c0 < NCHUNK; c0 += 3) {
        LSTEP(st1, c0);
        LSTEP(st2, c0 + 1);
        LSTEP(st0, c0 + 2);
      }
#undef LSTEP
#undef LLOAD
#undef LWRITE
    } else {
      f32x4 S[8];
#pragma unroll
      for (int t = 0; t < 8; ++t) S[t] = (f32x4){0.f, 0.f, 0.f, 0.f};
      uint2 uf0[5], uf1[5], uf2[5];
#pragma unroll
      for (int i = 0; i < 5; ++i) { uf0[i] = make_uint2(0u, 0u); uf1[i] = uf0[i]; uf2[i] = uf0[i]; }
      const uint2* Ug = (const uint2*)PP->Ufrag + lane;
      const float* Gl = PP->glast;
#define ULOAD(UF, UNIT) { _Pragma("unroll") for (int i = 0; i < 4; ++i) UF[i] = Ug[((UNIT) * 8 + slice) * 256 + i * 64]; UF[4].x = __float_as_uint(Gl[UNIT]); }
      ULOAD(uf0, ubase);
      ULOAD(uf1, ubase + 1);
      ULOAD(uf2, ubase + 2);
#define CSTEP(UF, C)                                                                                                   \
  {                                                                                                                    \
    const int c = (C);                                                                                                 \
    const size_t unit = ubase + c;                                                                                     \
    const char* slot = smem + (c & 1) * 32768;                                                                         \
    const float el = __expf(__uint_as_float(UF[4].x));                                                                 \
    uint4 sb[4];                                                                                                       \
    _Pragma("unroll") for (int s2 = 0; s2 < 4; ++s2) sb[s2] = pack_tiles(S[2 * s2], S[2 * s2 + 1]);                    \
    {                                                                                                                  \
      uint4* sp = (uint4*)PP->Sfrag + (unit * 8 + slice) * 256 + lane;                                                 \
      _Pragma("unroll") for (int s2 = 0; s2 < 4; ++s2) sp[s2 * 64] = sb[s2];                                           \
    }                                                                                                                  \
    f32x4 vn[4];                                                                                                       \
    _Pragma("unroll") for (int mt = 0; mt < 4; ++mt) {                                                                 \
      vn[mt] = (f32x4){bf_lo(UF[mt].x), bf_hi(UF[mt].x), bf_lo(UF[mt].y), bf_hi(UF[mt].y)};                            \
      _Pragma("unroll") for (int s2 = 0; s2 < 4; ++s2) {                                                               \
        const uint4 wfr = *(const uint4*)(slot + (mt * 4 + s2) * 1024 + lane * 16);                                    \
        vn[mt] = __builtin_amdgcn_mfma_f32_16x16x32_bf16(as_frag(wfr), as_frag(sb[s2]), vn[mt], 0, 0, 0);              \
      }                                                                                                                \
    }                                                                                                                  \
    ULOAD(UF, ubase + (size_t)((c + 3 < NCHUNK) ? c + 3 : NCHUNK - 1));                                                \
    uint4 vb[2];                                                                                                       \
    vb[0] = pack_tiles(vn[0], vn[1]);                                                                                  \
    vb[1] = pack_tiles(vn[2], vn[3]);                                                                                  \
    {                                                                                                                  \
      uint4* vp = (uint4*)PP->Vfrag + (unit * 8 + slice) * 128 + lane;                                                 \
      vp[0] = vb[0];                                                                                                   \
      vp[64] = vb[1];                                                                                                  \
    }                                                                                                                  \
    _Pragma("unroll") for (int t = 0; t < 8; ++t) {                                                                    \
      S[t] *= el;                                                                                                      \
      const uint4 k0 = *(const uint4*)(slot + 16384 + (t * 2 + 0) * 1024 + lane * 16);                                 \
      const uint4 k1 = *(const uint4*)(slot + 16384 + (t * 2 + 1) * 1024 + lane * 16);                                 \
      S[t] = __builtin_amdgcn_mfma_f32_16x16x32_bf16(as_frag(k0), as_frag(vb[0]), S[t], 0, 0, 0);                      \
      S[t] = __builtin_amdgcn_mfma_f32_16x16x32_bf16(as_frag(k1), as_frag(vb[1]), S[t], 0, 0, 0);                      \
    }                                                                                                                  \
    __syncthreads();                                                                                                   \
  }
      __syncthreads();
      for (int c0 = 0; c0 < NCHUNK; c0 += 3) {
        CSTEP(uf0, c0);
        CSTEP(uf1, c0 + 1);
        CSTEP(uf2, c0 + 2);
      }
#undef CSTEP
#undef ULOAD
    }
  }
  __builtin_amdgcn_s_setprio(0);
}

__device__ __forceinline__ void phase_o(int layer, char* smem) {
  const KP PP = get_params();
  const int tid = TID(), l = tid & 63, w = tid >> 6, lr = l & 15, lg = l >> 4;
  char* Qt = smem;
  char* Kt = smem + 16384;
  u16* If = (u16*)(smem + 32768);
  u16* Ib = (u16*)(smem + 41984);
  float* gcf = (float*)(smem + 51200);
  float* gcb = gcf + 64;
  float* rowss = gcb + 64;
  float* Os = (float*)smem;
  const int nper = (layer == DEPTH - 1) ? 128 : 132;
  const int xq = BID() & 7, vl0 = BID() >> 3, vstep = gridDim.x >> 3;
  for (int vi = vl0; vi < nper; vi += vstep) {
    int b = xq >> 2, hd = xq & 3, tok0, cf, cb;
    if (vi < 128) {
      const int n = vi;
      tok0 = b * SEQ + 64 * n; cf = 4 + n; cb = 4 + 127 - n;
    } else {
      const int n = vi - 128;
      tok0 = NLAT + b * CTX + 64 * n; cf = n; cb = 3 - n;
    }
    const size_t unit_f = (size_t)((b * 4 + hd) * 2 + 0) * NCHUNK + cf;
    const size_t unit_b = (size_t)((b * 4 + hd) * 2 + 1) * NCHUNK + cb;
    uint4 pSF[4][2], pSB[4][2], pVF[2][2], pVB[2][2];
#pragma unroll
    for (int q = 0; q < 2; ++q) {
      const int sl = 2 * w + q;
#pragma unroll
      for (int s = 0; s < 4; ++s) {
        pSF[s][q] = *((const uint4*)PP->Sfrag + ((unit_f * 8 + sl) * 4 + s) * 64 + l);
        pSB[s][q] = *((const uint4*)PP->Sfrag + ((unit_b * 8 + sl) * 4 + s) * 64 + l);
      }
#pragma unroll
      for (int s2 = 0; s2 < 2; ++s2) {
        pVF[s2][q] = *((const uint4*)PP->Vfrag + ((unit_f * 8 + sl) * 2 + s2) * 64 + l);
        pVB[s2][q] = *((const uint4*)PP->Vfrag + ((unit_b * 8 + sl) * 2 + s2) * 64 + l);
      }
    }
    __syncthreads();
    for (int idx = tid; idx < 2048; idx += NTHR) {
      const int arr = idx >> 10, i = (idx >> 4) & 63, ch = idx & 15;
      const uint4 v = *(const uint4*)(PP->qkvn + (size_t)(tok0 + i) * 1536 + (arr == 0 ? 0 : 512) + hd * 128 + ch * 8);
      *(uint4*)((arr == 0 ? Qt : Kt) + i * 256 + ((ch ^ (i & 15)) << 4)) = v;
    }
    if (tid < 64) gcf[tid] = PP->gc[unit_f * 64 + tid];
    else if (tid < 128) gcb[tid - 64] = PP->gc[unit_b * 64 + (tid - 64)];
    __syncthreads();
    {
      f32x4 acc[4];
#pragma unroll
      for (int nt = 0; nt < 4; ++nt) acc[nt] = (f32x4){0.f, 0.f, 0.f, 0.f};
#pragma unroll
      for (int s = 0; s < 4; ++s) {
        const int ch = s * 4 + lg;
        const bf16x8 a = *(const bf16x8*)(Qt + (16 * w + lr) * 256 + ((ch ^ lr) << 4));
#pragma unroll
        for (int nt = 0; nt < 4; ++nt) {
          const bf16x8 bb = *(const bf16x8*)(Kt + (16 * nt + lr) * 256 + ((ch ^ lr) << 4));
          acc[nt] = __builtin_amdgcn_mfma_f32_16x16x32_bf16(a, bb, acc[nt], 0, 0, 0);
        }
      }
#pragma unroll
      for (int nt = 0; nt < 4; ++nt)
#pragma unroll
        for (int r = 0; r < 4; ++r) {
          const int i = 16 * w + 4 * lg + r, j = 16 * nt + lr;
          const float vf = (j <= i) ? acc[nt][r] * __expf(fminf(gcf[i] - gcf[j], 0.f)) : 0.f;
          const float vb = (j >= i) ? acc[nt][r] * __expf(fminf(gcb[63 - i] - gcb[63 - j], 0.f)) : 0.f;
          If[i * 72 + j] = f2bf(vf);
          Ib[i * 72 + (63 - j)] = f2bf(vb);
        }
    }
    __syncthreads();
    f32x4 accF[4][2], accB[4][2], accI[4][2];
#pragma unroll
    for (int mt = 0; mt < 4; ++mt)
#pragma unroll
      for (int q = 0; q < 2; ++q) {
        accF[mt][q] = (f32x4){0.f, 0.f, 0.f, 0.f};
        accB[mt][q] = (f32x4){0.f, 0.f, 0.f, 0.f};
        accI[mt][q] = (f32x4){0.f, 0.f, 0.f, 0.f};
      }
#pragma unroll
    for (int s = 0; s < 4; ++s) {
      bf16x8 qa[4];
#pragma unroll
      for (int mt = 0; mt < 4; ++mt) {
        const int row = 16 * mt + lr;
        const int c0 = 4 * s + (lg >> 1), c1 = c0 + 2;
        const uint2 lo = *(const uint2*)(Qt + row * 256 + ((c0 ^ lr) << 4) + (lg & 1) * 8);
        const uint2 hi = *(const uint2*)(Qt + row * 256 + ((c1 ^ lr) << 4) + (lg & 1) * 8);
        const uint4 t = make_uint4(lo.x, lo.y, hi.x, hi.y);
        qa[mt] = as_frag(t);
      }
#pragma unroll
      for (int q = 0; q < 2; ++q) {
        const int sl = 2 * w + q;
        const uint4 bF = pSF[s][q], bB = pSB[s][q];
#pragma unroll
        for (int mt = 0; mt < 4; ++mt) {
          accF[mt][q] = __builtin_amdgcn_mfma_f32_16x16x32_bf16(qa[mt], as_frag(bF), accF[mt][q], 0, 0, 0);
          accB[mt][q] = __builtin_amdgcn_mfma_f32_16x16x32_bf16(qa[mt], as_frag(bB), accB[mt][q], 0, 0, 0);
        }
      }
    }
#pragma unroll
    for (int s2 = 0; s2 < 2; ++s2) {
      bf16x8 ia[4], ib[4];
#pragma unroll
      for (int mt = 0; mt < 4; ++mt) {
        const int row = 16 * mt + lr;
        const int col = 32 * s2 + 4 * lg;
        const uint2 flo = *(const uint2*)(If + row * 72 + col);
        const uint2 fhi = *(const uint2*)(If + row * 72 + col + 16);
        const uint2 blo = *(const uint2*)(Ib + row * 72 + col);
        const uint2 bhi = *(const uint2*)(Ib + row * 72 + col + 16);
        const uint4 tf = make_uint4(flo.x, flo.y, fhi.x, fhi.y);
        const uint4 tb = make_uint4(blo.x, blo.y, bhi.x, bhi.y);
        ia[mt] = as_frag(tf);
        ib[mt] = as_frag(tb);
      }
#pragma unroll
      for (int q = 0; q < 2; ++q) {
        const int sl = 2 * w + q;
        const uint4 vF = pVF[s2][q], vB = pVB[s2][q];
#pragma unroll
        for (int mt = 0; mt < 4; ++mt) {
          accI[mt][q] = __builtin_amdgcn_mfma_f32_16x16x32_bf16(ia[mt], as_frag(vF), accI[mt][q], 0, 0, 0);
          accI[mt][q] = __builtin_amdgcn_mfma_f32_16x16x32_bf16(ib[mt], as_frag(vB), accI[mt][q], 0, 0, 0);
        }
      }
    }
    float o[4][2][4];
#pragma unroll
    for (int mt = 0; mt < 4; ++mt)
#pragma unroll
      for (int r = 0; r < 4; ++r) {
        const int i = 16 * mt + 4 * lg + r;
        const float ef = __expf(gcf[i]), eb = __expf(gcb[63 - i]);
        float ss = 0.f;
#pragma unroll
        for (int q = 0; q < 2; ++q) {
          const float v = ef * accF[mt][q][r] + eb * accB[mt][q][r] + accI[mt][q][r];
          o[mt][q][r] = v;
          ss += v * v;
        }
        ss = group16_sum(ss);
        if (lr == 0) rowss[w * 64 + i] = ss;
      }
    __syncthreads();
#pragma unroll
    for (int mt = 0; mt < 4; ++mt)
#pragma unroll
      for (int q = 0; q < 2; ++q)
#pragma unroll
        for (int r = 0; r < 4; ++r) Os[(16 * mt + 4 * lg + r) * 132 + 16 * (2 * w + q) + lr] = o[mt][q][r];
    __syncthreads();
#pragma unroll
    for (int q4 = 0; q4 < 4; ++q4) {
      const int idx = tid + 256 * q4, i = idx >> 4, ch = idx & 15;
      const float ss = rowss[i] + rowss[64 + i] + rowss[128 + i] + rowss[192 + i];
      const float rs = rsqrtf(ss * (1.f / 128.f) + EPS);
      const float4 o0 = *(const float4*)&Os[i * 132 + ch * 8];
      const float4 o1 = *(const float4*)&Os[i * 132 + ch * 8 + 4];
      const float4 n0 = *(const float4*)(PP->dn_out_norm + layer * 128 + ch * 8);
      const float4 n1 = *(const float4*)(PP->dn_out_norm + layer * 128 + ch * 8 + 4);
      float zf[8];
      unpack8(*(const uint4*)(PP->z + (size_t)(tok0 + i) * 512 + hd * 128 + ch * 8), zf);
      float y[8];
      y[0] = o0.x * rs * n0.x * siluf_(zf[0]); y[1] = o0.y * rs * n0.y * siluf_(zf[1]);
      y[2] = o0.z * rs * n0.z * siluf_(zf[2]); y[3] = o0.w * rs * n0.w * siluf_(zf[3]);
      y[4] = o1.x * rs * n1.x * siluf_(zf[4]); y[5] = o1.y * rs * n1.y * siluf_(zf[5]);
      y[6] = o1.z * rs * n1.z * siluf_(zf[6]); y[7] = o1.w * rs * n1.w * siluf_(zf[7]);
      {
        int p0 = __builtin_amdgcn_cvt_pk_fp8_f32(y[0], y[1], 0, false);
        p0 = __builtin_amdgcn_cvt_pk_fp8_f32(y[2], y[3], p0, true);
        int p1 = __builtin_amdgcn_cvt_pk_fp8_f32(y[4], y[5], 0, false);
        p1 = __builtin_amdgcn_cvt_pk_fp8_f32(y[6], y[7], p1, true);
        *(int2*)((char*)PP->ydn + (size_t)(tok0 + i) * (LDK5 * 2) + hd * 128 + ch * 8) = make_int2(p0, p1);
      }
    }
  }
}

template <int HALF>
DEV void pool_window(const u16* xin, char* Ap, int t0, int L, int tid) {
#pragma unroll
  for (int q = 0; q < 4; ++q) {
    const int idx = tid + 256 * q, i = idx >> 4, c = idx & 15;
    const int t = t0 + i;
    const int lo = (t - HALF) > 0 ? (t - HALF) : 0;
    const int hi = (t + HALF) < L ? (t + HALF) : L;
    float s[8];
#pragma unroll
    for (int e = 0; e < 8; ++e) s[e] = 0.f;
#pragma unroll
    for (int k = 0; k < 2 * HALF; ++k) {
      float f[8];
      unpack8(*(const uint4*)(xin + (i + 8 - HALF + k) * 128 + c * 8), f);
#pragma unroll
      for (int e = 0; e < 8; ++e) s[e] += f[e];
    }
    float xs[8];
    unpack8(*(const uint4*)(xin + (i + 8) * 128 + c * 8), xs);
    const float inv = 1.f / (float)(hi - lo);
#pragma unroll
    for (int e = 0; e < 8; ++e) s[e] = s[e] * inv - xs[e];
    *(uint4*)(Ap + i * 256 + ((c ^ (i & 15)) << 4)) = pack8(s);
  }
}

__device__ __forceinline__ void phase_pool(int layer, char* smem, int vbid, int vnb) {
  const KP PP = get_params();
  const int tid = TID(), l = tid & 63, w = tid >> 6, lr = l & 15, lg = l >> 4;
  u16* xin = (u16*)smem;
  char* Ap = smem + 20480;
  char* Bs = smem + 36864;
  const int ntile = (layer == DEPTH - 1) ? NLAT / 64 : R / 64;
  for (int it = vbid; it < ntile * 4; it += vnb) {
    const int ti = it >> 2, g = it & 3;
    int L, t0, rowbase;
    if (ti < NLAT / 64) { L = 64; t0 = 0; rowbase = ti * 64; }
    else { const int ci = ti - NLAT / 64; L = CTX; t0 = (ci & 3) * 64; rowbase = NLAT + (ci >> 2) * CTX; }
    const int r0 = rowbase + t0;
    __syncthreads();
#pragma unroll
    for (int q = 0; q < 5; ++q) {
      const int idx = tid + 256 * q, i = idx >> 4, c = idx & 15;
      const int pos = t0 - 8 + i;
      uint4 v = make_uint4(0, 0, 0, 0);
      if (pos >= 0 && pos < L) v = *(const uint4*)(PP->pin + (size_t)(rowbase + pos) * 512 + g * 128 + c * 8);
      *(uint4*)(xin + i * 128 + c * 8) = v;
    }
    {
      const u16* Bw = PP->PwT + (size_t)(layer * 4 + g) * 128 * 128;
#pragma unroll
      for (int q = 0; q < 8; ++q) {
        const int idx = tid + 256 * q, n = idx >> 4, c = idx & 15;
        *(uint4*)(Bs + n * 256 + ((c ^ (n & 15)) << 4)) = *(const uint4*)(Bw + (size_t)n * 128 + c * 8);
      }
    }
    __syncthreads();
    if (g == 0) pool_window<1>(xin, Ap, t0, L, tid);
    else if (g == 1) pool_window<2>(xin, Ap, t0, L, tid);
    else if (g == 2) pool_window<4>(xin, Ap, t0, L, tid);
    else pool_window<8>(xin, Ap, t0, L, tid);
    __syncthreads();
    f32x4 acc[8];
#pragma unroll
    for (int ni = 0; ni < 8; ++ni) acc[ni] = (f32x4){0.f, 0.f, 0.f, 0.f};
#pragma unroll
    for (int ks = 0; ks < 4; ++ks) {
      const int row = w * 16 + lr, c = ks * 4 + lg;
      const bf16x8 a = *(const bf16x8*)(Ap + row * 256 + ((c ^ lr) << 4));
#pragma unroll
      for (int ni = 0; ni < 8; ++ni) {
        const bf16x8 bb = *(const bf16x8*)(Bs + (ni * 16 + lr) * 256 + ((c ^ lr) << 4));
        acc[ni] = __builtin_amdgcn_mfma_f32_16x16x32_bf16(bb, a, acc[ni], 0, 0, 0);
      }
    }
    unsigned char* ot = (unsigned char*)smem;
#pragma unroll
    for (int ni = 0; ni < 8; ++ni) {
      const int dcol = ni * 16 + 4 * lg;
      const float4 psc = *(const float4*)(PP->pool_scale + layer * 512 + g * 128 + dcol);
      int pk = __builtin_amdgcn_cvt_pk_fp8_f32(acc[ni][0] * psc.x, acc[ni][1] * psc.y, 0, false);
      pk = __builtin_amdgcn_cvt_pk_fp8_f32(acc[ni][2] * psc.z, acc[ni][3] * psc.w, pk, true);
      *(int*)(ot + (w * 16 + lr) * 128 + dcol) = pk;
    }
    __syncthreads();
    {
      const int row = tid >> 2, seg = tid & 3;
      const uint4 o0 = *(const uint4*)(ot + row * 128 + seg * 32), o1 = *(const uint4*)(ot + row * 128 + seg * 32 + 16);
      unsigned char* dst = (unsigned char*)PP->ypool + (size_t)(r0 + row) * (LDK5 * 2) + g * 128 + seg * 32;
      *(uint4*)dst = o0;
      *(uint4*)(dst + 16) = o1;
    }
  }
}

__device__ __forceinline__ void phase_merge(int layer, char* smem) {
  const KP PP = get_params();
  const char* Bd = (const char*)(PP->WdT + (size_t)layer * 1024 * LDK5);
  const char* Bp = (const char*)(PP->WpT + (size_t)layer * 1024 * LDK5);
  const char* Ad = (const char*)PP->ydn;
  const char* Ap = (const char*)PP->ypool;
  const int tid = TID();
  const int l = tid & 63, w = tid >> 6, wm = w >> 1, wn = w & 1, lr = l & 15, lg = l >> 4;
  uint4 ga[4], gb[4];
#pragma unroll
  for (int i = 0; i < 4; ++i) { ga[i] = make_uint4(0u, 0u, 0u, 0u); gb[i] = ga[i]; }
  const int r0 = tid >> 3, c0 = tid & 7;
#define MG_GLOAD(AP, BP, KT_)                                                                  \
  _Pragma("unroll") for (int i = 0; i < 4; ++i) {                                              \
    ga[i] = *(const uint4*)((AP) + (size_t)(m0 + 32 * i + r0) * (LDK5 * 2) + c0 * 16 + (KT_) * 128);  \
    gb[i] = *(const uint4*)((BP) + (size_t)(n0 + 32 * i + r0) * LDK5 + c0 * 16 + (KT_) * 128);        \
  }
#define MG_LSTORE(BUF)                                                                         \
  {                                                                                            \
    char* as_ = smem + (BUF) * 32768;                                                          \
    char* bs_ = as_ + 16384;                                                                   \
    _Pragma("unroll") for (int i = 0; i < 4; ++i) {                                            \
      const int id = tid + 256 * i, row = id >> 3, c = id & 7;                                 \
      const int off = row * 128 + ((c ^ (row & 7)) << 4);                                      \
      *(uint4*)(as_ + off) = ga[i];                                                            \
      *(uint4*)(bs_ + off) = gb[i];                                                            \
    }                                                                                          \
  }
#define MG_COMPUTE(ACC, BUF)                                                                                              \
  {                                                                                                                       \
    const char* as_ = smem + (BUF) * 32768;                                                                               \
    const char* bs_ = as_ + 16384;                                                                                        \
    i32x8 a[4], b[4];                                                                                                     \
    const int sw0 = ((lg ^ (lr & 7)) << 4), sw1 = (((4 + lg) ^ (lr & 7)) << 4);                                           \
    _Pragma("unroll") for (int mi = 0; mi < 4; ++mi) {                                                                    \
      const char* p_ = as_ + (wm * 64 + mi * 16 + lr) * 128;                                                              \
      const i32x4 lo_ = *(const i32x4*)(p_ + sw0), hi_ = *(const i32x4*)(p_ + sw1);                                       \
      a[mi] = __builtin_shufflevector(lo_, hi_, 0, 1, 2, 3, 4, 5, 6, 7);                                                  \
    }                                                                                                                     \
    _Pragma("unroll") for (int ni = 0; ni < 4; ++ni) {                                                                    \
      const char* p_ = bs_ + (wn * 64 + ni * 16 + lr) * 128;                                                              \
      const i32x4 lo_ = *(const i32x4*)(p_ + sw0), hi_ = *(const i32x4*)(p_ + sw1);                                       \
      b[ni] = __builtin_shufflevector(lo_, hi_, 0, 1, 2, 3, 4, 5, 6, 7);                                                  \
    }                                                                                                                     \
    _Pragma("unroll") for (int mi = 0; mi < 4; ++mi)                                                                      \
      _Pragma("unroll") for (int ni = 0; ni < 4; ++ni)                                                                    \
        ACC[mi][ni] = __builtin_amdgcn_mfma_scale_f32_16x16x128_f8f6f4(a[mi], b[ni], ACC[mi][ni], 0, 0, 0, 0, 0, 0);      \
  }
  const int MT = (layer == DEPTH - 1) ? NLAT / 128 : R / 128;
  for (int it = 0;; ++it) {
    int mt, nt;
    if (!tile_map(it, MT, 8, mt, nt)) break;
    const int m0 = mt * 128, n0 = nt * 128;
    f32x4 acc[4][4];
    zero_acc(acc);
    __syncthreads();
    MG_GLOAD(Ad, Bd, 0);
    MG_LSTORE(0);
    __syncthreads();
#pragma unroll
    for (int kt = 0; kt < 4; ++kt) {
      if (kt + 1 < 4) { MG_GLOAD(Ad, Bd, kt + 1); } else { MG_GLOAD(Ap, Bp, 0); }
      MG_COMPUTE(acc, kt & 1);
      MG_LSTORE((kt + 1) & 1);
      __syncthreads();
    }
    uint2 tq[2][8];
#pragma unroll
    for (int hs = 0; hs < 2; ++hs)
#pragma unroll
      for (int j = 0; j < 8; ++j) tq[hs][j] = make_uint2(0u, 0u);
#pragma unroll
    for (int hs = 0; hs < 2; ++hs) {
      float4 v1[8];
      stage_half(acc, hs, smem + 32768, v1);
#pragma unroll
      for (int j = 0; j < 8; ++j) tq[hs][j] = make_uint2(pack_bf16(v1[j].x, v1[j].y), pack_bf16(v1[j].z, v1[j].w));
    }
    __builtin_amdgcn_sched_barrier(0);
    zero_acc(acc);
    __syncthreads();
#pragma unroll
    for (int kt = 0; kt < 4; ++kt) {
      if (kt + 1 < 4) { MG_GLOAD(Ap, Bp, kt + 1); }
      MG_COMPUTE(acc, kt & 1);
      if (kt + 1 < 4) { MG_LSTORE((kt + 1) & 1); }
      __syncthreads();
    }
#pragma unroll
    for (int hs = 0; hs < 2; ++hs) {
      float4 v2[8];
      stage_half(acc, hs, smem, v2);
      const int tid2 = TID();
#pragma unroll
      for (int j = 0; j < 8; ++j) {
        const int idx = tid2 + 256 * j, row = idx >> 5, c4 = idx & 31;
        const size_t gr = (size_t)(m0 + hs * 64 + row);
        const int gc = n0 + c4 * 4;
        const unsigned gd = *(const unsigned*)((const unsigned char*)PP->sgd + gr * 1024 + gc);
        const unsigned gp = *(const unsigned*)((const unsigned char*)PP->sgp + gr * 1024 + gc);
        const uint2 t = tq[hs][j];
        constexpr float GS = 1.f / (255.f * 32.f);
        const float o0 = ((float)(gd & 0xffu) * bf_lo(t.x) + (float)(gp & 0xffu) * v2[j].x) * GS;
        const float o1 = ((float)((gd >> 8) & 0xffu) * bf_hi(t.x) + (float)((gp >> 8) & 0xffu) * v2[j].y) * GS;
        const float o2 = ((float)((gd >> 16) & 0xffu) * bf_lo(t.y) + (float)((gp >> 16) & 0xffu) * v2[j].z) * GS;
        const float o3 = ((float)(gd >> 24) * bf_hi(t.y) + (float)(gp >> 24) * v2[j].w) * GS;
        int pk = __builtin_amdgcn_cvt_pk_fp8_f32(o0, o1, 0, false);
        pk = __builtin_amdgcn_cvt_pk_fp8_f32(o2, o3, pk, true);
        *(int*)((char*)PP->m + gr * (LDK1 * 2) + gc) = pk;
        if ((j & 1) == 1) __builtin_amdgcn_sched_barrier(0);
      }
    }
  }
#undef MG_GLOAD
#undef MG_LSTORE
#undef MG_COMPUTE
}

__device__ __forceinline__ void phase_outproj(int layer, char* smem) {
  const KP PP = get_params();
  const char* Bt = (const char*)(PP->WoT + (size_t)layer * 1024 * LDK1);
  const char* A = (const char*)PP->m;
  F8_LOCALS
  const int MT = (layer == DEPTH - 1) ? NLAT / 128 : R / 128;
  int it = 0, mt, nt;
  if (!tile_map(it, MT, 8, mt, nt)) return;
  int m0 = mt * 128, n0 = nt * 128;
  F8_PROLOGUE(A, LDK1 * 2, Bt, LDK1)
  for (;;) {
    int mtn = 0, ntn = 0;
    const bool hasn = tile_map(it + 1, MT, 8, mtn, ntn);
    const int m0n = mtn * 128, n0n = ntn * 128;
    f32x4 acc[4][4];
    zero_acc(acc);
    F8_KLOOP(A, LDK1 * 2, Bt, LDK1, 8)
#pragma unroll
    for (int mi = 0; mi < 4; ++mi) {
      const int gr = m0 + wm * 64 + mi * 16 + lr;
      const float* modp = PP->mod + (size_t)(layer * 3 + modsel(gr)) * 6144 + 2048;
      const float* xin;
      float* xo;
      if (gr < NLAT) {
        xin = (layer == 0 ? PP->x : PP->out) + (size_t)gr * 1024;
        xo = PP->out + (size_t)gr * 1024;
      } else {
        xin = (layer == 0 ? PP->ctx : PP->xc) + (size_t)(gr - NLAT) * 1024;
        xo = PP->xc + (size_t)(gr - NLAT) * 1024;
      }
#pragma unroll
      for (int g = 0; g < 2; ++g) {
        const int gc = n0 + wn * 64 + g * 32 + 8 * lg;
#pragma unroll
        for (int n = 0; n < 2; ++n) {
          const f32x4 t = acc[mi][2 * g + n] * (1.f / 32.f);
          const float4 gt = *(const float4*)(modp + gc + 4 * n);
          const float4 xi = *(const float4*)(xin + gc + 4 * n);
          *(float4*)(xo + gc + 4 * n) = make_float4(xi.x + gt.x * t[0], xi.y + gt.y * t[1], xi.z + gt.z * t[2], xi.w + gt.w * t[3]);
        }
      }
    }
    if (!hasn) break;
    m0 = m0n; n0 = n0n; ++it;
  }
}

DEV void gemm_mainloop_f8(const char* __restrict__ A, int lda, const char* __restrict__ B, int ldb, int KT, int m0, int n0,
                          char* smem, f32x4 (&acc)[4][4]) {
  const int tid = TID();
  const int l = tid & 63, w = tid >> 6, wm = w >> 1, wn = w & 1, lr = l & 15, lg = l >> 4;
  uint4 ga[4], gb[4];
#pragma unroll
  for (int i = 0; i < 4; ++i) { ga[i] = make_uint4(0u, 0u, 0u, 0u); gb[i] = ga[i]; }
  const int r0 = tid >> 3, c0 = tid & 7;
#define Q8_GLOAD(KT_)                                                                          \
  _Pragma("unroll") for (int i = 0; i < 4; ++i) {                                              \
    ga[i] = *(const uint4*)(A + (size_t)(m0 + 32 * i + r0) * lda + c0 * 16 + (KT_) * 128);     \
    gb[i] = *(const uint4*)(B + (size_t)(n0 + 32 * i + r0) * ldb + c0 * 16 + (KT_) * 128);     \
  }
#define Q8_LSTORE(BUF)                                                                         \
  {                                                                                            \
    char* as_ = smem + (BUF) * 32768;                                                          \
    char* bs_ = as_ + 16384;                                                                   \
    _Pragma("unroll") for (int i = 0; i < 4; ++i) {                                            \
      const int id = tid + 256 * i, row = id >> 3, c = id & 7;                                 \
      const int off = row * 128 + ((c ^ (row & 7)) << 4);                                      \
      *(uint4*)(as_ + off) = ga[i];                                                            \
      *(uint4*)(bs_ + off) = gb[i];                                                            \
    }                                                                                          \
  }
  __syncthreads();
  Q8_GLOAD(0);
  Q8_LSTORE(0);
  __syncthreads();
  for (int kt = 0; kt < KT; ++kt) {
    if (kt + 1 < KT) { Q8_GLOAD(kt + 1); }
    const char* as_ = smem + (kt & 1) * 32768;
    const char* bs_ = as_ + 16384;
    i32x8 a[4], b[4];
    const int sw0 = ((lg ^ (lr & 7)) << 4), sw1 = (((4 + lg) ^ (lr & 7)) << 4);
#pragma unroll
    for (int mi = 0; mi < 4; ++mi) {
      const char* p_ = as_ + (wm * 64 + mi * 16 + lr) * 128;
      const i32x4 lo_ = *(const i32x4*)(p_ + sw0), hi_ = *(const i32x4*)(p_ + sw1);
      a[mi] = __builtin_shufflevector(lo_, hi_, 0, 1, 2, 3, 4, 5, 6, 7);
    }
#pragma unroll
    for (int ni = 0; ni < 4; ++ni) {
      const char* p_ = bs_ + (wn * 64 + ni * 16 + lr) * 128;
      const i32x4 lo_ = *(const i32x4*)(p_ + sw0), hi_ = *(const i32x4*)(p_ + sw1);
      b[ni] = __builtin_shufflevector(lo_, hi_, 0, 1, 2, 3, 4, 5, 6, 7);
    }
#pragma unroll
    for (int mi = 0; mi < 4; ++mi)
#pragma unroll
      for (int ni = 0; ni < 4; ++ni)
        acc[mi][ni] = __builtin_amdgcn_mfma_scale_f32_16x16x128_f8f6f4(a[mi], b[ni], acc[mi][ni], 0, 0, 0, 0, 0, 0);
    if (kt + 1 < KT) { Q8_LSTORE((kt + 1) & 1); }
    __syncthreads();
  }
#undef Q8_GLOAD
#undef Q8_LSTORE
}

__device__ __forceinline__ void phase_peerq(int layer, char* smem) {
  const KP PP = get_params();
  const char* Bt = (const char*)PP->WkT + (size_t)layer * 2048 * LDK1;
  const int tid = TID();
  const int l = tid & 63, w = tid >> 6, wm = w >> 1, wn = w & 1, lr = l & 15, lg = l >> 4;
  const int MT = (layer == DEPTH - 1) ? NLAT / 128 : R / 128;
  for (int it = 0;; ++it) {
    int mt, nt;
    if (!tile_map(it, MT, 16, mt, nt)) break;
    const int m0 = mt * 128, n0 = nt * 128;
    f32x4 sc[4][4];
    zero_acc(sc);
    gemm_mainloop_f8((const char*)PP->h8, LDK1, Bt, LDK1, 8, m0, n0, smem, sc);
    __syncthreads();
    float* Sc = (float*)smem;
#pragma unroll
    for (int mi = 0; mi < 4; ++mi)
#pragma unroll
      for (int ni = 0; ni < 4; ++ni)
#pragma unroll
        for (int r = 0; r < 4; ++r) Sc[(wm * 64 + mi * 16 + lg * 4 + r) * 129 + wn * 64 + ni * 16 + lr] = sc[mi][ni][r] * (1.f / 32.f);
    __syncthreads();
    {
      const int row = tid >> 1, half = tid & 1;
      const float* rowp = Sc + row * 129;
      unsigned key[64];
#pragma unroll
      for (int i = 0; i < 64; ++i) {
        unsigned u = __float_as_uint(rowp[half * 64 + i]);
        u = (u & 0x80000000u) ? ~u : (u | 0x80000000u);
        key[i] = (u & ~127u) | (unsigned)(127 - (half * 64 + i));
      }
#define CMPX(X, Y, DESC) { const unsigned hi_ = (X) > (Y) ? (X) : (Y), lo_ = (X) > (Y) ? (Y) : (X); X = (DESC) ? hi_ : lo_; Y = (DESC) ? lo_ : hi_; }
#pragma unroll
      for (int g0 = 0; g0 < 64; g0 += 16) {
#pragma unroll
        for (int k = 2; k <= 16; k <<= 1)
#pragma unroll
          for (int j = k >> 1; j > 0; j >>= 1)
#pragma unroll
            for (int i = 0; i < 16; ++i) {
              const int l2 = i ^ j;
              if (l2 > i) CMPX(key[g0 + i], key[g0 + l2], ((i & k) == 0));
            }
      }
#define TOPMERGE(AOFF, BOFF)                                                                         \
  {                                                                                                  \
    _Pragma("unroll") for (int i = 0; i < 16; ++i)                                                   \
      key[(AOFF) + i] = key[(AOFF) + i] > key[(BOFF) + 15 - i] ? key[(AOFF) + i] : key[(BOFF) + 15 - i]; \
    _Pragma("unroll") for (int j = 8; j > 0; j >>= 1)                                                \
      _Pragma("unroll") for (int i = 0; i < 16; ++i) {                                               \
        const int l2 = i ^ j;                                                                        \
        if (l2 > i) CMPX(key[(AOFF) + i], key[(AOFF) + l2], true);                                   \
      }                                                                                              \
  }
      TOPMERGE(0, 16);
      TOPMERGE(32, 48);
      TOPMERGE(0, 32);
      {
        unsigned oth[16];
#pragma unroll
        for (int i = 0; i < 16; ++i) oth[i] = swz_xor_u<1>(key[i]);
#pragma unroll
        for (int i = 0; i < 16; ++i) key[i] = key[i] > oth[15 - i] ? key[i] : oth[15 - i];
#pragma unroll
        for (int j = 8; j > 0; j >>= 1)
#pragma unroll
          for (int i = 0; i < 16; ++i) {
            const int l2 = i ^ j;
            if (l2 > i) CMPX(key[i], key[l2], true);
          }
      }
#undef TOPMERGE
#undef CMPX
      unsigned res[16];
#pragma unroll
      for (int j = 0; j < 16; ++j) {
        const int idx = 127 - (int)(key[j] & 127u);
        res[j] = half ? (unsigned)idx : __float_as_uint(rowp[idx]);
      }
      const size_t ob = ((size_t)(m0 + row) * 16 + nt) * 16;
      uint4* dst = half ? (uint4*)(PP->topI + ob) : (uint4*)(PP->topS + ob);
      dst[0] = make_uint4(res[0], res[1], res[2], res[3]);
      dst[1] = make_uint4(res[4], res[5], res[6], res[7]);
      dst[2] = make_uint4(res[8], res[9], res[10], res[11]);
      dst[3] = make_uint4(res[12], res[13], res[14], res[15]);
    }
  }
}

DEV void pair_of_lane(int l, int& a, int& b) {
  if (l < 16) { a = 0; b = l; }
  else if (l < 24) { a = 1; b = l - 16; }
  else if (l < 29) { a = 2; b = l - 24; }
  else if (l < 33) { a = 3; b = l - 29; }
  else if (l < 36) { a = 4; b = l - 33; }
  else if (l < 38) { a = 5; b = l - 36; }
  else if (l < 40) { a = 6; b = l - 38; }
  else if (l < 42) { a = 7; b = l - 40; }
  else if (l < 50) { a = l - 34; b = 0; }
  else { a = 0; b = 0; }
}

DEV float peer_butterfly(const float (&part)[8], int lane) {
  const bool h32 = (lane & 32) != 0, h16 = (lane & 16) != 0, h8 = (lane & 8) != 0;
  const int a32 = (lane ^ 32) << 2;
  float q4[4], q2[2];
#pragma unroll
  for (int i = 0; i < 4; ++i) {
    const float keep = h32 ? part[i + 4] : part[i], send = h32 ? part[i] : part[i + 4];
    q4[i] = keep + __builtin_bit_cast(float, __builtin_amdgcn_ds_bpermute(a32, __builtin_bit_cast(int, send)));
  }
#pragma unroll
  for (int i = 0; i < 2; ++i) {
    const float keep = h16 ? q4[i + 2] : q4[i], send = h16 ? q4[i] : q4[i + 2];
    q2[i] = keep + swz_xor<16>(send);
  }
  const float keep = h8 ? q2[1] : q2[0], send = h8 ? q2[0] : q2[1];
  float q1 = keep + swz_xor<8>(send);
  q1 += swz_xor<4>(q1);
  q1 += swz_xor<2>(q1);
  q1 += swz_xor<1>(q1);
  return q1;
}

__device__ __forceinline__ void phase_peer(int layer, char* smem) {
  const KP PP = get_params();
  const int tid = TID(), lane = tid & 63, wv = tid >> 6;
  const int gw = BID() * 4 + wv, nw = gridDim.x * 4;
  int* elist = (int*)(smem + wv * 2048);
  float* glist = (float*)(elist + 128);
  const bool last = (layer == DEPTH - 1);
  const int rlim = last ? NLAT : R;
  int pa, pb;
  pair_of_lane(lane, pa, pb);
  for (int r = gw; r < rlim; r += nw) {
    f32x2 hp[8];
#pragma unroll
    for (int i = 0; i < 4; ++i) {
      const uint2 hv = *(const uint2*)(PP->h + (size_t)r * LDK1 + 4 * lane + 256 * i);
      hp[2 * i] = (f32x2){bf_lo(hv.x), bf_hi(hv.x)};
      hp[2 * i + 1] = (f32x2){bf_lo(hv.y), bf_hi(hv.y)};
    }
#ifndef PEER_REP
#define PEER_REP 1
#endif
    f32x2 out[8];
#pragma unroll
    for (int i = 0; i < 8; ++i) out[i] = (f32x2){0.f, 0.f};
#pragma nounroll
    for (int rep_ = 0; rep_ < PEER_REP; ++rep_) {
    float sreg[8];
    int ireg[8];
#pragma unroll
    for (int hh = 0; hh < 8; ++hh) {
      const size_t o = (size_t)r * 256 + hh * 32 + (lane & 31);
      sreg[hh] = PP->topS[o];
      ireg[hh] = PP->topI[o];
    }
#pragma unroll 2
    for (int hh = 0; hh < 8; ++hh) {
      float cs = __builtin_bit_cast(float, __builtin_amdgcn_ds_bpermute(pa << 2, __builtin_bit_cast(int, sreg[hh]))) +
                 __builtin_bit_cast(float, __builtin_amdgcn_ds_bpermute((16 + pb) << 2, __builtin_bit_cast(int, sreg[hh])));
      const int e = __builtin_amdgcn_ds_bpermute(pa << 2, ireg[hh]) * 128 + __builtin_amdgcn_ds_bpermute((16 + pb) << 2, ireg[hh]);
      if (lane >= 50) cs = -__builtin_inff();
      unsigned ku = __float_as_uint(cs);
      ku = (ku & 0x80000000u) ? ~ku : (ku | 0x80000000u);
      ku = (ku & ~63u) | (unsigned)(63 - lane);
      int rank = 0;
#pragma unroll
      for (int l2 = 0; l2 < 50; ++l2) {
        const unsigned kv = (unsigned)__builtin_amdgcn_readlane((int)ku, l2);
        rank += (kv > ku) ? 1 : 0;
      }
      const bool sel = (lane < 50) && (rank < 16);
      const float mx = __builtin_bit_cast(float, __builtin_amdgcn_readlane(__builtin_bit_cast(int, cs), 0));
      const float ex = sel ? __expf(cs - mx) : 0.f;
      const float sum = wave_sum(ex);
      const unsigned long long mask = __ballot(sel);
      if (sel) {
        const int pos = __builtin_popcountll(mask & ((1ull << lane) - 1ull));
        elist[hh * 16 + pos] = e;
        glist[hh * 16 + pos] = ex / sum;
      }
    }
    __builtin_amdgcn_wave_barrier();
    asm volatile("s_waitcnt lgkmcnt(0)" ::: "memory");
    for (int k0 = 0; k0 < 128; k0 += 8) {
      U3 ua[8], va[8];
#pragma unroll
      for (int b = 0; b < 8; ++b) {
        const int ek = __builtin_amdgcn_readfirstlane(elist[k0 + b]);
        ua[b] = *(const U3*)(PP->tab8U + (size_t)ek * TROW + lane * 12);
        va[b] = *(const U3*)(PP->tab8V + (size_t)ek * TROW + lane * 12);
      }
      const int eb = elist[k0 + (lane >> 3)];
      const float scu = PP->scU[eb], scv = PP->scV[eb];
      float part[8];
#pragma unroll
      for (int b = 0; b < 8; b += 2) {
        const u32x6_t s6 = {ua[b].a, ua[b].b, ua[b].c, ua[b + 1].a, ua[b + 1].b, ua[b + 1].c};
        const f32x32_t uf = __builtin_amdgcn_cvt_scalef32_pk32_f32_fp6(s6, 1.0f);
        f32x2 d0 = (f32x2){uf[0], uf[1]} * hp[0];
        f32x2 d1 = (f32x2){uf[16], uf[17]} * hp[0];
#pragma unroll
        for (int p = 1; p < 8; ++p) {
          d0 += (f32x2){uf[2 * p], uf[2 * p + 1]} * hp[p];
          d1 += (f32x2){uf[16 + 2 * p], uf[17 + 2 * p]} * hp[p];
        }
        part[b] = d0[0] + d0[1];
        part[b + 1] = d1[0] + d1[1];
      }
      float q1 = peer_butterfly(part, lane);
      q1 *= scu;
      const float act = scv * glist[k0 + (lane >> 3)] * 0.5f * q1 * (1.f + erff(q1 * 0.7071067811865475f));
#pragma unroll
      for (int b = 0; b < 8; b += 2) {
        const float ab0 = __builtin_bit_cast(float, __builtin_amdgcn_readlane(__builtin_bit_cast(int, act), b * 8));
        const float ab1 = __builtin_bit_cast(float, __builtin_amdgcn_readlane(__builtin_bit_cast(int, act), b * 8 + 8));
        const f32x2 a0 = {ab0, ab0}, a1 = {ab1, ab1};
        const u32x6_t s6 = {va[b].a, va[b].b, va[b].c, va[b + 1].a, va[b + 1].b, va[b + 1].c};
        const f32x32_t vf = __builtin_amdgcn_cvt_scalef32_pk32_f32_fp6(s6, 1.0f);
#pragma unroll
        for (int p = 0; p < 8; ++p) {
          out[p] += a0 * (f32x2){vf[2 * p], vf[2 * p + 1]};
          out[p] += a1 * (f32x2){vf[16 + 2 * p], vf[17 + 2 * p]};
        }
      }
    }
    __builtin_amdgcn_wave_barrier();
    }
    if (PEER_REP > 1) {
#pragma unroll
      for (int i = 0; i < 8; ++i) out[i] *= (1.f / PEER_REP);
    }
    const float* md = PP->mod + (size_t)(layer * 3 + modsel(r)) * 6144 + 5 * 1024;
    float* xr = (r < NLAT) ? PP->out + (size_t)r * 1024 : PP->xc + (size_t)(r - NLAT) * 1024;
    float4 x2[4];
    float ss = 0.f;
#pragma unroll
    for (int i = 0; i < 4; ++i) {
      const int col = 4 * lane + 256 * i;
      const float4 xa = *(const float4*)(xr + col);
      const float4 ga = *(const float4*)(md + col);
      x2[i] = make_float4(xa.x + ga.x * out[2 * i][0], xa.y + ga.y * out[2 * i][1], xa.z + ga.z * out[2 * i + 1][0],
                          xa.w + ga.w * out[2 * i + 1][1]);
      ss += x2[i].x * x2[i].x + x2[i].y * x2[i].y + x2[i].z * x2[i].z + x2[i].w * x2[i].w;
    }
    if (last) {
      ss = wave_sum(ss);
      const float rs = rsqrtf(ss * (1.f / 1024.f) + EPS);
#pragma unroll
      for (int i = 0; i < 4; ++i) {
        const float4 fa = *(const float4*)(PP->final_norm + 4 * lane + 256 * i);
        x2[i] = make_float4(x2[i].x * rs * fa.x, x2[i].y * rs * fa.y, x2[i].z * rs * fa.z, x2[i].w * rs * fa.w);
      }
    }
#pragma unroll
    for (int i = 0; i < 4; ++i) *(float4*)(xr + 4 * lane + 256 * i) = x2[i];
    if (!last) {
      ss = wave_sum(ss);
      const float rs = rsqrtf(ss * (1.f / 1024.f) + EPS);
      const float* nwt = PP->norm_mix + (layer + 1) * 1024;
      const float* md1 = PP->mod + (size_t)((layer + 1) * 3 + modsel(r)) * 6144;
#pragma unroll
      for (int i = 0; i < 4; ++i) {
        const int col = 4 * lane + 256 * i;
        const float4 wv = *(const float4*)(nwt + col);
        const float4 sh = *(const float4*)(md1 + col);
        const float4 sc = *(const float4*)(md1 + 1024 + col);
        const float y0 = x2[i].x * rs * wv.x * (1.f + sc.x) + sh.x;
        const float y1 = x2[i].y * rs * wv.y * (1.f + sc.y) + sh.y;
        const float y2 = x2[i].z * rs * wv.z * (1.f + sc.z) + sh.z;
        const float y3 = x2[i].w * rs * wv.w * (1.f + sc.w) + sh.w;
        int pk = __builtin_amdgcn_cvt_pk_fp8_f32(y0, y1, 0, false);
        pk = __builtin_amdgcn_cvt_pk_fp8_f32(y2, y3, pk, true);
        *(int*)((char*)PP->h + (size_t)r * (LDK1 * 2) + col) = pk;
      }
    }
  }
}

namespace cg = cooperative_groups;

#define XB_TMO      128
#define XB_XCNT(j)  (256  + 64 * (j))
#define XB_XSUB(j)  (1280 + 64 * (j))
#define XB_XGEN(j)  (2304 + 64 * (j))
#define XB_TOP      3328
#define XB_TOPGEN   3392
#define XCD_BAR_WORDS 3456
#define XB_SPIN_CAP (1u << 22)
#define LAS __attribute__((address_space(3)))
DEV unsigned xb_ld(unsigned* q) { return __hip_atomic_load(q, __ATOMIC_RELAXED, __HIP_MEMORY_SCOPE_AGENT); }
DEV unsigned xb_add(unsigned* q, unsigned v) { return __hip_atomic_fetch_add(q, v, __ATOMIC_RELAXED, __HIP_MEMORY_SCOPE_AGENT); }
DEV unsigned xb_xcc_id() { return (unsigned)__builtin_amdgcn_s_getreg((3 << 11) | 20) & 0xFu; }
#define XB_SPIN(cond, bar) do { unsigned _sp = 0; while (cond) { __builtin_amdgcn_s_sleep(1); \
    if ((++_sp & 255u) == 0u) { if (xb_ld(&(bar)[XB_TMO])) break; if (_sp > XB_SPIN_CAP) { atomicAdd(&(bar)[XB_TMO], 1u); break; } } } } while (0)
struct XcdBarrier { unsigned* bar; unsigned x; volatile LAS unsigned* st; };
DEV XcdBarrier xcd_barrier_post(unsigned* bar, volatile LAS unsigned* st) {
  XcdBarrier b; b.bar = bar; b.x = xb_xcc_id(); b.st = st;
  if (__builtin_amdgcn_workitem_id_x() == 0) (void)xb_add(&bar[XB_XCNT(b.x)], 1u);
  return b;
}
DEV void xcd_barrier_complete(unsigned* bar, unsigned x, unsigned& nloc, unsigned& nx) {
  const unsigned G = gridDim.x * gridDim.y * gridDim.z;
  unsigned sum, cnt, mine, sp = 0u;
  for (;;) {
    sum = 0u; cnt = 0u; mine = 0u;
#pragma unroll
    for (unsigned j = 0; j < 16; ++j) { const unsigned c = xb_ld(&bar[XB_XCNT(j)]); sum += c; cnt += (c > 0u) ? 1u : 0u; mine = (j == x) ? c : mine; }
    if (sum == G) break;
    __builtin_amdgcn_s_sleep(1);
    if ((++sp & 255u) == 0u) { if (xb_ld(&bar[XB_TMO])) break; if (sp > XB_SPIN_CAP) { atomicAdd(&bar[XB_TMO], 1u); break; } }
  }
  nloc = mine > 0u ? mine : 1u; nx = cnt > 0u ? cnt : 1u;
}
DEV void xcd_barrier(const XcdBarrier& b) {
  asm volatile("s_waitcnt vmcnt(0)" ::: "memory");
  __syncthreads();
  if (__builtin_amdgcn_workitem_id_x() == 0) {
    unsigned* bar = b.bar;
    __builtin_amdgcn_s_waitcnt(0);
    unsigned nloc = b.st[0], nx = b.st[1];
    if (nloc == 0u) { xcd_barrier_complete(bar, b.x, nloc, nx); b.st[0] = nloc; b.st[1] = nx; }
    const unsigned old = xb_add(&bar[XB_XSUB(b.x)], 1u);
    const unsigned gen = old / nloc;
    if (old + 1u == (gen + 1u) * nloc) {
      __builtin_amdgcn_fence(__ATOMIC_RELEASE, "agent");
      asm volatile("s_waitcnt vmcnt(0)" ::: "memory");
      const unsigned og = xb_add(&bar[XB_TOP], 1u);
      const unsigned tg = og / nx;
      if (og + 1u == (tg + 1u) * nx) xb_add(&bar[XB_TOPGEN], 1u);
      else XB_SPIN(xb_ld(&bar[XB_TOPGEN]) == tg, bar);
      __builtin_amdgcn_fence(__ATOMIC_ACQUIRE, "agent");
      xb_add(&bar[XB_XGEN(b.x)], 1u);
      asm volatile("s_waitcnt vmcnt(0)" ::: "memory");
    } else {
      XB_SPIN(xb_ld(&bar[XB_XGEN(b.x)]) == gen, bar);
      __builtin_amdgcn_fence(__ATOMIC_ACQUIRE, "agent");
      asm volatile("s_waitcnt vmcnt(0)" ::: "memory");
    }
  }
  __syncthreads();
}

#define GRID_SYNC() do { XcdBarrier xb_; xb_.bar = get_params()->bar; xb_.x = xb_xcc_id(); xb_.st = (volatile LAS unsigned*)&xb_words; xcd_barrier(xb_); } while (0)

__global__ void __launch_bounds__(NTHR, 2) megakernel(Params p) {
  __shared__ __attribute__((aligned(16))) char smem[SMEM_BYTES];
  __shared__ uint4 xb_words;
  if (__builtin_amdgcn_workitem_id_x() == 0) xb_words = make_uint4(0u, 0u, 0u, 0u);
  __syncthreads();
  (void)xcd_barrier_post(get_params()->bar, (volatile LAS unsigned*)&xb_words);
#ifndef PM
#define PM 0xFFFF
#endif
#ifndef DUP
#define DUP 0
#endif
  if (PM & 1) phase_init(smem);
  if (DUP & 1) phase_init(smem);
  GRID_SYNC();
  for (int layer = 0; layer < DEPTH; ++layer) {
    if (layer == 0) {
      if (PM & 2) phase_norm(layer, 1);
      if (DUP & 2) phase_norm(layer, 1);
      GRID_SYNC();
    }
    if (PM & 4) phase_gemm_win(layer, smem);
    if (DUP & 4) phase_gemm_win(layer, smem);
    GRID_SYNC();
#ifndef PREP_REP
#define PREP_REP 1
#endif
#pragma nounroll
    for (int rep_ = 0; rep_ < PREP_REP; ++rep_) phase_prep(layer, smem);
    GRID_SYNC();
    {
      const int nb_ = gridDim.x;
      if (BID() < 128) { if (PM & 64) phase_scan(smem); }
      else {
        if (PM & 16) phase_pool(layer, smem, BID() - 128, nb_ - 128);
        if (PM & 256) phase_tables(layer, BID() - 128, nb_ - 128);
      }
    }
    GRID_SYNC();
    if (PM & 128) phase_o(layer, smem);
    if (DUP & 128) phase_o(layer, smem);
    GRID_SYNC();
    if (PM & 512) phase_merge(layer, smem);
    if (DUP & 512) phase_merge(layer, smem);
    GRID_SYNC();
    if (PM & 1024) phase_outproj(layer, smem);
    GRID_SYNC();
    if (PM & 2048) phase_norm(layer, 2);
    if (DUP & 2048) phase_norm(layer, 2);
    GRID_SYNC();
    if (PM & 4096) phase_peerq(layer, smem);
    if (DUP & 4096) phase_peerq(layer, smem);
    GRID_SYNC();
    if (PM & 8192) phase_peer(layer, smem);
    if (layer + 1 < DEPTH) GRID_SYNC();
  }
}

static inline size_t align_up(size_t v, size_t a) { return (v + a - 1) / a * a; }

extern "C" void kernel_launch(void* const* d_in, const int* in_sizes, int n_in, void* d_out, int out_size, void* d_ws,
                              size_t ws_size, hipStream_t stream) {
  Params p{};
  p.x = (const float*)d_in[0]; p.c = (const float*)d_in[1]; p.ctx = (const float*)d_in[2]; p.c_ctx = (const float*)d_in[3];
  p.w_mod = (const float*)d_in[4]; p.b_mod = (const float*)d_in[5]; p.norm_mix = (const float*)d_in[6]; p.w_in = (const float*)d_in[7];
  p.conv_w = (const float*)d_in[8]; p.a_log = (const float*)d_in[9]; p.dt_bias = (const float*)d_in[10];
  p.dn_out_norm = (const float*)d_in[11]; p.pool_w = (const float*)d_in[12]; p.pool_scale = (const float*)d_in[13];
  p.w_up_dn = (const float*)d_in[14]; p.w_up_pool = (const float*)d_in[15]; p.w_out = (const float*)d_in[16];
  p.norm_ffn = (const float*)d_in[17]; p.peer_wq = (const float*)d_in[18]; p.peer_keys = (const float*)d_in[19];
  p.peer_u = (const float*)d_in[20]; p.peer_v = (const float*)d_in[21]; p.final_norm = (const float*)d_in[22];
  p.out = (float*)d_out;

  char* ws = (char*)d_ws;
  size_t off = 0;
  auto take = [&](size_t bytes) { char* q = ws + off; off = align_up(off + bytes, 256); return q; };
  p.tab8U = (unsigned char*)take((size_t)NEXP * 1024);
  p.tab8V = (unsigned char*)take((size_t)NEXP * 1024);
  p.scU = (float*)take((size_t)NEXP * 4);
  p.scV = (float*)take((size_t)NEXP * 4);
  p.WinT = (u16*)take((size_t)DEPTH * NPAD * LDK1 * 2);
  p.WdT = (u16*)take((size_t)DEPTH * 1024 * LDK5 * 2);
  p.WpT = (u16*)take((size_t)DEPTH * 1024 * LDK5 * 2);
  p.WoT = (u16*)take((size_t)DEPTH * 1024 * LDK1 * 2);
  p.WkT = (u16*)take((size_t)DEPTH * 2048 * LDK1 * 2);
  p.PwT = (u16*)take((size_t)DEPTH * 4 * 128 * 128 * 2);
  p.mod = (float*)take((size_t)DEPTH * 3 * 6144 * 4);
  p.xc = (float*)take((size_t)NCTX * 1024 * 4);
  p.h = (u16*)take((size_t)R * LDK1 * 2);
  p.h8 = (unsigned char*)take((size_t)R * LDK1);
  p.m = p.h;
  p.qkv_pre = (u16*)take((size_t)R * 1536 * 2);
  p.Vfrag = p.qkv_pre;
  p.z = (u16*)take((size_t)R * 512 * 2);
  p.pin = (u16*)take((size_t)R * 512 * 2);
  p.sgd = (u16*)take((size_t)R * 1024 * 2);
  p.sgp = (u16*)take((size_t)R * 1024 * 2);
  p.ba = (float*)take((size_t)R * 16 * 4);
  p.qkvn = (u16*)take((size_t)R * 1536 * 2);
  p.bg = (float*)take((size_t)R * 16 * 4);
  p.Wfrag = (u16*)take((size_t)NUNIT * 16384);
  p.KdT = (u16*)take((size_t)NUNIT * 16384);
  p.Ufrag = (u16*)take((size_t)NUNIT * 16384);
  p.ydn = p.Ufrag;
  p.Sfrag = (u16*)take((size_t)NUNIT * 32768);
  p.gc = (float*)take((size_t)NUNIT * 64 * 4);
  p.glast = (float*)take((size_t)NUNIT * 4);
  p.ypool = (u16*)take((size_t)R * LDK5 * 2);
  p.bar = (unsigned*)take((size_t)XCD_BAR_WORDS * 4);
  p.topS = (float*)p.qkvn;
  p.topI = (int*)((char*)p.qkvn + (size_t)R * 256 * 4);
  const bool alias_ok = ((size_t)R * 256 * 8 <= (size_t)R * 1536 * 2) && ((size_t)NUNIT * 16384 <= (size_t)R * 1536 * 2) &&
                        ((size_t)R * LDK5 * 2 <= (size_t)NUNIT * 16384);
  if (off > ws_size || !alias_ok) {
    fprintf(stderr, "workspace too small: need %zu have %zu (alias_ok=%d)\n", off, ws_size, (int)alias_ok);
    return;
  }
  static int grid_blocks = 0;
  if (!grid_blocks) {
    int dev = 0, cus = 0, per_cu = 0;
    (void)hipGetDevice(&dev);
    (void)hipDeviceGetAttribute(&cus, hipDeviceAttributeMultiprocessorCount, dev);
    (void)hipOccupancyMaxActiveBlocksPerMultiprocessor(&per_cu, megakernel, NTHR, 0);
    if (per_cu > 2) per_cu = 2;
    if (per_cu < 1) per_cu = 1;
    grid_blocks = cus * per_cu;
    grid_blocks -= grid_blocks % 8;
  }
  if (grid_blocks < 8) { fprintf(stderr, "bad grid %d\n", grid_blocks); return; }
  (void)hipMemsetAsync(p.bar, 0, (size_t)XCD_BAR_WORDS * 4, stream);
  void* args[] = {&p};
  hipError_t e = hipLaunchCooperativeKernel((void*)megakernel, dim3(grid_blocks), dim3(NTHR), args, 0, stream);
  if (e != hipSuccess) fprintf(stderr, "cooperative launch failed: %s (grid %d)\n", hipGetErrorString(e), grid_blocks);
}
```

```cpp
#include <hip/hip_runtime.h>
#include <hip/hip_cooperative_groups.h>
#include <stdint.h>
#include <stdio.h>

typedef unsigned short u16;
typedef __attribute__((ext_vector_type(8))) short bf16x8;
typedef __attribute__((ext_vector_type(4))) float f32x4;
typedef __attribute__((ext_vector_type(2))) float f32x2;
typedef __attribute__((ext_vector_type(2))) __bf16 bf16x2_t;

#define DEV __device__ __forceinline__

constexpr int D = 1024;
constexpr int BATCH = 2;
constexpr int SEQ = 8192;
constexpr int DEPTH = 2;
constexpr int CTX = 256;
constexpr int NLAT = BATCH * SEQ;
constexpr int NCTX = BATCH * CTX;
constexpr int R = NLAT + NCTX;
constexpr int DNH = 4;
constexpr int DK = 128;
constexpr int DNW = 512;
constexpr int INC = 4624;
constexpr int NPAD = 4736;
constexpr int NEXP = 16384;
constexpr float EPS = 1e-6f;
constexpr int NTHR = 256;
constexpr int LDK1 = 1088;
constexpr int LDK5 = 576;
constexpr int SMEM_BYTES = 73728;

struct Params {
  const float *x, *c, *ctx, *c_ctx, *w_mod, *b_mod, *norm_mix, *w_in, *conv_w, *a_log, *dt_bias, *dn_out_norm,
      *pool_w, *pool_scale, *w_up_dn, *w_up_pool, *w_out, *norm_ffn, *peer_wq, *peer_keys, *peer_u, *peer_v, *final_norm;
  float* out;
  unsigned char *tab8U, *tab8V;
  float *scU, *scV;
  u16 *WinT, *WdT, *WpT, *WoT, *WkT, *PwT;
  float *mod, *xc;
  u16 *h, *qkv_pre, *z, *pin, *sgd, *sgp;
  unsigned char* h8;
  float* ba;
  u16* qkvn;
  float* bg;
  u16 *Wfrag, *KdT, *Ufrag, *Sfrag, *Vfrag;
  float *gc, *glast;
  u16 *ydn, *ypool, *m;
  float* topS;
  int* topI;
  unsigned* bar;
};

typedef const __attribute__((address_space(4))) Params* KP;
DEV KP get_params() {
  KP k = (KP)__builtin_amdgcn_kernarg_segment_ptr();
  asm volatile("" : "+s"(k));
  return k;
}
DEV int TID() { int t = __builtin_amdgcn_workitem_id_x(); asm volatile("" : "+v"(t)); return t; }
DEV int BID() { int t = __builtin_amdgcn_workgroup_id_x(); asm volatile("" : "+s"(t)); return t; }
DEV unsigned pack_bf16(float a, float b) {
  f32x2 v = {a, b};
  bf16x2_t r = __builtin_convertvector(v, bf16x2_t);
  return *(unsigned*)&r;
}
DEV u16 f2bf(float a) { return (u16)(pack_bf16(a, 0.f) & 0xffffu); }
DEV float bf_lo(unsigned u) { return __uint_as_float(u << 16); }
DEV float bf_hi(unsigned u) { return __uint_as_float(u & 0xffff0000u); }
DEV float bf2f(u16 h) { return __uint_as_float(((unsigned)h) << 16); }
DEV void unpack8(const uint4& v, float* f) {
  f[0] = bf_lo(v.x); f[1] = bf_hi(v.x); f[2] = bf_lo(v.y); f[3] = bf_hi(v.y);
  f[4] = bf_lo(v.z); f[5] = bf_hi(v.z); f[6] = bf_lo(v.w); f[7] = bf_hi(v.w);
}
DEV uint4 pack8(const float* f) {
  uint4 v;
  v.x = pack_bf16(f[0], f[1]); v.y = pack_bf16(f[2], f[3]); v.z = pack_bf16(f[4], f[5]); v.w = pack_bf16(f[6], f[7]);
  return v;
}
template <int O> DEV float swz_xor(float v) {
  return __builtin_bit_cast(float, __builtin_amdgcn_ds_swizzle(__builtin_bit_cast(int, v), (O << 10) | 0x1F));
}
template <int O> DEV unsigned swz_xor_u(unsigned v) {
  return (unsigned)__builtin_amdgcn_ds_swizzle((int)v, (O << 10) | 0x1F);
}
DEV float xor32_f(float v) {
  const int a = ((TID() & 63) ^ 32) << 2;
  return __builtin_bit_cast(float, __builtin_amdgcn_ds_bpermute(a, __builtin_bit_cast(int, v)));
}
DEV float wave_sum(float v) {
  v += xor32_f(v);
  v += swz_xor<16>(v); v += swz_xor<8>(v); v += swz_xor<4>(v); v += swz_xor<2>(v); v += swz_xor<1>(v);
  return v;
}
DEV float wave_max(float v) {
  v = fmaxf(v, xor32_f(v));
  v = fmaxf(v, swz_xor<16>(v)); v = fmaxf(v, swz_xor<8>(v)); v = fmaxf(v, swz_xor<4>(v));
  v = fmaxf(v, swz_xor<2>(v)); v = fmaxf(v, swz_xor<1>(v));
  return v;
}
DEV float group16_sum(float v) {
  v += swz_xor<8>(v); v += swz_xor<4>(v); v += swz_xor<2>(v); v += swz_xor<1>(v);
  return v;
}
DEV float sigmoidf_(float x) { return 1.f / (1.f + __expf(-x)); }
DEV float siluf_(float x) { return x / (1.f + __expf(-x)); }
DEV int modsel(int r) { return r < NLAT ? (r >> 13) : 2; }

DEV void transpose_tile(const float* __restrict__ src, int Nsrc, int ldd, u16* __restrict__ dst, int kt, int nt, int mode,
                        float* tile) {
  const int tid = TID();
  const int cl = tid & 63, rg = tid >> 6;
  const int nd = nt * 64 + cl;
  int ns = nd;
  bool valid = true;
  if (mode & 1) {
    if (nd < 2560) ns = nd;
    else if (nd < 4608) ns = nd + 16;
    else if (nd < 4624) ns = nd - 4608 + 2560;
    else { valid = false; ns = 0; }
  }
#pragma unroll
  for (int i = 0; i < 16; ++i) {
    const int kr = i * 4 + rg;
    float v = valid ? src[(size_t)(kt * 64 + kr) * Nsrc + ns] : 0.f;
    tile[kr * 65 + cl] = v;
  }
  __syncthreads();
  const int nr = tid >> 2, kc = (tid & 3) * 16;
  if (mode & 2) {
    int q4[4];
#pragma unroll
    for (int q = 0; q < 4; ++q) {
      int pk = __builtin_amdgcn_cvt_pk_fp8_f32(32.f * tile[(kc + 4 * q) * 65 + nr], 32.f * tile[(kc + 4 * q + 1) * 65 + nr], 0, false);
      q4[q] = __builtin_amdgcn_cvt_pk_fp8_f32(32.f * tile[(kc + 4 * q + 2) * 65 + nr], 32.f * tile[(kc + 4 * q + 3) * 65 + nr], pk, true);
    }
    *(int4*)((char*)dst + (size_t)(nt * 64 + nr) * ldd + kt * 64 + kc) = make_int4(q4[0], q4[1], q4[2], q4[3]);
    __syncthreads();
    return;
  }
  unsigned w[8];
#pragma unroll
  for (int q = 0; q < 8; ++q) w[q] = pack_bf16(tile[(kc + 2 * q) * 65 + nr], tile[(kc + 2 * q + 1) * 65 + nr]);
  uint4* d = (uint4*)(dst + (size_t)(nt * 64 + nr) * ldd + kt * 64 + kc);
  d[0] = make_uint4(w[0], w[1], w[2], w[3]);
  d[1] = make_uint4(w[4], w[5], w[6], w[7]);
  __syncthreads();
}

__device__ __forceinline__ void phase_init(char* smem) {
  const KP PP = get_params();
  const int tid = TID(), nb = gridDim.x, bid = BID();
  float* fs = (float*)smem;
  for (int u = bid; u < 192; u += nb) {
    const int layer = u / 96, col0 = (u % 96) * 64;
    float* sv = fs;
    float* red = fs + 3072;
    for (int i = tid; i < 3072; i += NTHR) {
      const int v = i >> 10, k = i & 1023;
      const float cv = (v < 2) ? PP->c[v * 1024 + k] : PP->c_ctx[k];
      sv[i] = siluf_(cv);
    }
    __syncthreads();
    const int cq = tid & 15, ks = tid >> 4;
    float acc[3][4];
#pragma unroll
    for (int v = 0; v < 3; ++v)
#pragma unroll
      for (int i = 0; i < 4; ++i) acc[v][i] = 0.f;
    const float* wb = PP->w_mod + ((size_t)layer * 1024 + ks * 64) * 6144 + col0 + cq * 4;
#pragma unroll 8
    for (int kk = 0; kk < 64; ++kk) {
      const float4 w4 = *(const float4*)(wb + (size_t)kk * 6144);
      const int k = ks * 64 + kk;
#pragma unroll
      for (int v = 0; v < 3; ++v) {
        const float s = sv[v * 1024 + k];
        acc[v][0] += s * w4.x; acc[v][1] += s * w4.y; acc[v][2] += s * w4.z; acc[v][3] += s * w4.w;
      }
    }
#pragma unroll
    for (int v = 0; v < 3; ++v)
#pragma unroll
      for (int i = 0; i < 4; ++i) red[(ks * 3 + v) * 64 + cq * 4 + i] = acc[v][i];
    __syncthreads();
    if (tid < 192) {
      const int v = tid >> 6, cc = tid & 63;
      float s = PP->b_mod[layer * 6144 + col0 + cc];
#pragma unroll
      for (int k2 = 0; k2 < 16; ++k2) s += red[(k2 * 3 + v) * 64 + cc];
      PP->mod[(size_t)(layer * 3 + v) * 6144 + col0 + cc] = s;
    }
    __syncthreads();
  }
  constexpr int NTL = 1184 + 128 + 128 + 256 + 16;
  for (int j = bid; j < NTL * DEPTH; j += nb) {
    const int layer = j / NTL;
    int jj = j % NTL;
    if (jj < 1184) {
      transpose_tile(PP->w_in + (size_t)layer * 1024 * INC, INC, LDK1, PP->WinT + (size_t)layer * NPAD * LDK1, jj / 74, jj % 74, 3, fs);
    } else if ((jj -= 1184) < 128) {
      transpose_tile(PP->w_up_dn + (size_t)layer * 512 * 1024, 1024, LDK5, PP->WdT + (size_t)layer * 1024 * LDK5, jj / 16, jj % 16, 2, fs);
    } else if ((jj -= 128) < 128) {
      transpose_tile(PP->w_up_pool + (size_t)layer * 512 * 1024, 1024, LDK5, PP->WpT + (size_t)layer * 1024 * LDK5, jj / 16, jj % 16, 2, fs);
    } else if ((jj -= 128) < 256) {
      transpose_tile(PP->w_out + (size_t)layer * 1024 * 1024, 1024, LDK1, PP->WoT + (size_t)layer * 1024 * LDK1, jj / 16, jj % 16, 2, fs);
    } else {
      jj -= 256;
      const int g = jj >> 2;
      transpose_tile(PP->pool_w + (size_t)(layer * 4 + g) * 128 * 128, 128, 128, PP->PwT + (size_t)(layer * 4 + g) * 128 * 128,
                     (jj & 3) >> 1, jj & 1, 0, fs);
    }
  }
  {
    const int tid2 = TID();
    const int l = tid2 & 63, w = tid2 >> 6, lr = l & 15, lg = l >> 4;
    char* Ks = smem;
    char* Ws = smem + 32768;
    for (int item = bid; item < DEPTH * 256; item += nb) {
      const int layer = item >> 8, hp = (item >> 4) & 15, ct = item & 15;
      __syncthreads();
      const float* ksrc = PP->peer_keys + (size_t)(layer * 16 + hp) * 128 * 128;
      for (int idx = tid2; idx < 128 * 16; idx += NTHR) {
        const int row = idx >> 4, ch = idx & 15;
        const float4 a = *(const float4*)(ksrc + row * 128 + ch * 8);
        const float4 c4 = *(const float4*)(ksrc + row * 128 + ch * 8 + 4);
        *(uint4*)(Ks + row * 256 + ((ch ^ (row & 15)) << 4)) =
            make_uint4(pack_bf16(a.x, a.y), pack_bf16(a.z, a.w), pack_bf16(c4.x, c4.y), pack_bf16(c4.z, c4.w));
      }
      const float* wsrc = PP->peer_wq + (size_t)layer * 1024 * 2048 + (size_t)(ct * 64) * 2048 + hp * 128;
      for (int idx = tid2; idx < 64 * 16; idx += NTHR) {
        const int row = idx >> 4, ch = idx & 15;
        const float4 a = *(const float4*)(wsrc + (size_t)row * 2048 + ch * 8);
        const float4 c4 = *(const float4*)(wsrc + (size_t)row * 2048 + ch * 8 + 4);
        *(uint4*)(Ws + row * 256 + ((ch ^ (row & 15)) << 4)) =
            make_uint4(pack_bf16(a.x, a.y), pack_bf16(a.z, a.w), pack_bf16(c4.x, c4.y), pack_bf16(c4.z, c4.w));
      }
      __syncthreads();
      f32x4 acc[2][4];
#pragma unroll
      for (int mi = 0; mi < 2; ++mi)
#pragma unroll
        for (int ni = 0; ni < 4; ++ni) acc[mi][ni] = (f32x4){0.f, 0.f, 0.f, 0.f};
#pragma unroll
      for (int ks = 0; ks < 4; ++ks) {
        const int ch = ks * 4 + lg;
        bf16x8 a[2], bb[4];
#pragma unroll
        for (int mi = 0; mi < 2; ++mi) a[mi] = *(const bf16x8*)(Ks + ((2 * w + mi) * 16 + lr) * 256 + ((ch ^ lr) << 4));
#pragma unroll
        for (int ni = 0; ni < 4; ++ni) bb[ni] = *(const bf16x8*)(Ws + (ni * 16 + lr) * 256 + ((ch ^ lr) << 4));
#pragma unroll
        for (int mi = 0; mi < 2; ++mi)
#pragma unroll
          for (int ni = 0; ni < 4; ++ni) acc[mi][ni] = __builtin_amdgcn_mfma_f32_16x16x32_bf16(a[mi], bb[ni], acc[mi][ni], 0, 0, 0);
      }
      unsigned char* dst = (unsigned char*)PP->WkT + ((size_t)layer * 2048 + hp * 128) * LDK1 + ct * 64;
#pragma unroll
      for (int mi = 0; mi < 2; ++mi)
#pragma unroll
        for (int ni = 0; ni < 4; ++ni)
#pragma unroll
          for (int r = 0; r < 4; ++r) {
            const float v32 = 32.f * acc[mi][ni][r];
            dst[(size_t)((2 * w + mi) * 16 + 4 * lg + r) * LDK1 + ni * 16 + lr] = (unsigned char)(__builtin_amdgcn_cvt_pk_fp8_f32(v32, v32, 0, false) & 0xff);
          }
    }
  }
}

DEV unsigned enc_e2m3(float x) {
  const float a = fabsf(x);
  float c;
  if (a < 2.f) c = a * 8.f;
  else if (a < 4.f) c = 16.f + (a - 2.f) * 4.f;
  else c = 24.f + (a - 4.f) * 2.f;
  unsigned code = (unsigned)__builtin_rintf(c);
  code = code > 31u ? 31u : code;
  return code | (x < 0.f ? 32u : 0u);
}
struct __attribute__((packed, aligned(4))) U3 { unsigned a, b, c; };
constexpr int TROW = 768;
typedef float f32x32_t __attribute__((ext_vector_type(32)));
typedef unsigned u32x6_t __attribute__((ext_vector_type(6)));

__device__ __forceinline__ void phase_tables(int layer, int vbid, int vnb) {
  const KP PP = get_params();
  const int tid = TID(), lane = tid & 63;
  const int gw = vbid * 4 + (tid >> 6), nw = vnb * 4;
  const float* su = PP->peer_u + (size_t)layer * NEXP * 1024;
  const float* sv = PP->peer_v + (size_t)layer * NEXP * 1024;
  for (int r0 = gw * 2; r0 < 2 * NEXP; r0 += nw * 2) {
    float4 v[2][4];
#pragma unroll
    for (int q = 0; q < 2; ++q) {
      const int r = r0 + q;
      const float* src = (r < NEXP ? su + (size_t)r * 1024 : sv + (size_t)(r - NEXP) * 1024);
#pragma unroll
      for (int i = 0; i < 4; ++i) v[q][i] = *(const float4*)(src + (lane + 64 * i) * 4);
    }
#pragma unroll
    for (int q = 0; q < 2; ++q) {
      const int r = r0 + q;
      float am = 0.f;
#pragma unroll
      for (int i = 0; i < 4; ++i)
        am = fmaxf(am, fmaxf(fmaxf(fabsf(v[q][i].x), fabsf(v[q][i].y)), fmaxf(fabsf(v[q][i].z), fabsf(v[q][i].w))));
      am = wave_max(am);
      const float scale = fmaxf(am, 1e-30f) * (1.f / 7.5f);
      const float inv = 1.f / scale;
      unsigned long long lo = 0ull;
      unsigned hi = 0u;
#pragma unroll
      for (int i = 0; i < 4; ++i) {
        const float vv[4] = {v[q][i].x * inv, v[q][i].y * inv, v[q][i].z * inv, v[q][i].w * inv};
#pragma unroll
        for (int j = 0; j < 4; ++j) {
          const int k = 4 * i + j;
          const unsigned cde = enc_e2m3(vv[j]);
          if (k < 10) lo |= (unsigned long long)cde << (6 * k);
          else if (k == 10) { lo |= (unsigned long long)cde << 60; hi |= cde >> 4; }
          else hi |= cde << (6 * k - 64);
        }
      }
      unsigned char* dst = (r < NEXP ? PP->tab8U + (size_t)r * TROW : PP->tab8V + (size_t)(r - NEXP) * TROW);
      U3 pk3;
      pk3.a = (unsigned)lo; pk3.b = (unsigned)(lo >> 32); pk3.c = hi;
      *(U3*)(dst + lane * 12) = pk3;
      if (lane == 0) { if (r < NEXP) PP->scU[r] = scale; else PP->scV[r - NEXP] = scale; }
    }
  }
}

__device__ __forceinline__ void phase_norm(int layer, int which) {
  const KP PP = get_params();
  const int lane = TID() & 63;
  const int gw = BID() * 4 + (TID() >> 6), nw = gridDim.x * 4;
  const float* nwt = (which == 1 ? PP->norm_mix : PP->norm_ffn) + layer * 1024;
  const int rlim = (which == 2 && layer == DEPTH - 1) ? NLAT : R;
  for (int r = gw; r < rlim; r += nw) {
    const float* xr;
    if (r < NLAT) xr = ((which == 1 && layer == 0) ? PP->x : PP->out) + (size_t)r * 1024;
    else xr = ((which == 1 && layer == 0) ? PP->ctx : PP->xc) + (size_t)(r - NLAT) * 1024;
    const float* md = PP->mod + (size_t)(layer * 3 + modsel(r)) * 6144 + (which == 1 ? 0 : 3072);
    float4 v[4];
    float ss = 0.f;
#pragma unroll
    for (int i = 0; i < 4; ++i) {
      v[i] = *(const float4*)(xr + (lane + 64 * i) * 4);
      ss += v[i].x * v[i].x + v[i].y * v[i].y + v[i].z * v[i].z + v[i].w * v[i].w;
    }
    ss = wave_sum(ss);
    const float rs = rsqrtf(ss * (1.f / 1024.f) + EPS);
#pragma unroll
    for (int i = 0; i < 4; ++i) {
      const int col = (lane + 64 * i) * 4;
      const float4 w = *(const float4*)(nwt + col);
      const float4 sh = *(const float4*)(md + col);
      const float4 sc = *(const float4*)(md + 1024 + col);
      const float y0 = v[i].x * rs * w.x * (1.f + sc.x) + sh.x;
      const float y1 = v[i].y * rs * w.y * (1.f + sc.y) + sh.y;
      const float y2 = v[i].z * rs * w.z * (1.f + sc.z) + sh.z;
      const float y3 = v[i].w * rs * w.w * (1.f + sc.w) + sh.w;
      if (which == 1) {
        int pk = __builtin_amdgcn_cvt_pk_fp8_f32(y0, y1, 0, false);
        pk = __builtin_amdgcn_cvt_pk_fp8_f32(y2, y3, pk, true);
        *(int*)((char*)PP->h + (size_t)r * (LDK1 * 2) + col) = pk;
      } else {
        *(uint2*)(PP->h + (size_t)r * LDK1 + col) = make_uint2(pack_bf16(y0, y1), pack_bf16(y2, y3));
        int pk = __builtin_amdgcn_cvt_pk_fp8_f32(y0, y1, 0, false);
        pk = __builtin_amdgcn_cvt_pk_fp8_f32(y2, y3, pk, true);
        *(int*)(PP->h8 + (size_t)r * LDK1 + col) = pk;
      }
    }
  }
}

template <bool PRIO>
DEV void gemm_mainloop_t(const u16* __restrict__ A, int lda, const u16* __restrict__ B, int ldb, int K, int m0, int n0,
                         char* smem, f32x4 (&acc)[4][4]) {
  const int tid = TID();
  const int l = tid & 63, w = tid >> 6, wm = w >> 1, wn = w & 1, lr = l & 15, lg = l >> 4;
  uint4 ga0[4], gb0[4], ga1[4], gb1[4];
#pragma unroll
  for (int i = 0; i < 4; ++i) { ga0[i] = make_uint4(0u, 0u, 0u, 0u); gb0[i] = ga0[i]; ga1[i] = ga0[i]; gb1[i] = ga0[i]; }
  const int KT = K >> 6;
#define GLOAD(GA, GB, KT_)                                                                     \
  _Pragma("unroll") for (int i = 0; i < 4; ++i) {                                              \
    const int id = tid + 256 * i, row = id >> 3, c = id & 7;                                   \
    GA[i] = *(const uint4*)(A + (size_t)(m0 + row) * lda + (KT_) * 64 + c * 8);                \
    GB[i] = *(const uint4*)(B + (size_t)(n0 + row) * ldb + (KT_) * 64 + c * 8);                \
  }
#define LSTORE(GA, GB, BUF)                                                                    \
  {                                                                                            \
    char* as_ = smem + (BUF) * 32768;                                                          \
    char* bs_ = as_ + 16384;                                                                   \
    _Pragma("unroll") for (int i = 0; i < 4; ++i) {                                            \
      const int id = tid + 256 * i, row = id >> 3, c = id & 7;                                 \
      const int off = row * 128 + ((c ^ (row & 7)) << 4);                                      \
      *(uint4*)(as_ + off) = GA[i];                                                            \
      *(uint4*)(bs_ + off) = GB[i];                                                            \
    }                                                                                          \
  }
#define COMPUTE(BUF)                                                                                                      \
  {                                                                                                                       \
    const char* as_ = smem + (BUF) * 32768;                                                                               \
    const char* bs_ = as_ + 16384;                                                                                        \
    if (PRIO) __builtin_amdgcn_s_setprio(1);      \
    _Pragma("unroll") for (int ks = 0; ks < 2; ++ks) {                                                                    \
      bf16x8 a[4], b[4];                                                                                                  \
      const int c = ks * 4 + lg;                                                                                          \
      const int sw = ((c ^ (lr & 7)) << 4);                                                                               \
      _Pragma("unroll") for (int mi = 0; mi < 4; ++mi) a[mi] = *(const bf16x8*)(as_ + (wm * 64 + mi * 16 + lr) * 128 + sw); \
      _Pragma("unroll") for (int ni = 0; ni < 4; ++ni) b[ni] = *(const bf16x8*)(bs_ + (wn * 64 + ni * 16 + lr) * 128 + sw); \
      _Pragma("unroll") for (int mi = 0; mi < 4; ++mi)                                                                    \
        _Pragma("unroll") for (int ni = 0; ni < 4; ++ni)                                                                  \
          acc[mi][ni] = __builtin_amdgcn_mfma_f32_16x16x32_bf16(a[mi], b[ni], acc[mi][ni], 0, 0, 0);                      \
    }                                                                                                                     \
    if (PRIO) __builtin_amdgcn_s_setprio(0);                                                                              \
  }
  __syncthreads();
  GLOAD(ga0, gb0, 0);
  GLOAD(ga1, gb1, 1);
  LSTORE(ga0, gb0, 0);
  __syncthreads();
  for (int kt = 0; kt < KT; kt += 2) {
    if (kt + 2 < KT) { GLOAD(ga0, gb0, kt + 2); }
    COMPUTE(0);
    LSTORE(ga1, gb1, 1);
    __syncthreads();
    if (kt + 3 < KT) { GLOAD(ga1, gb1, kt + 3); }
    COMPUTE(1);
    if (kt + 2 < KT) { LSTORE(ga0, gb0, 0); }
    __syncthreads();
  }
#undef GLOAD
#undef LSTORE
#undef COMPUTE
}

DEV void gemm_mainloop(const u16* __restrict__ A, int lda, const u16* __restrict__ B, int ldb, int K, int m0, int n0,
                       char* smem, f32x4 (&acc)[4][4]) {
  gemm_mainloop_t<false>(A, lda, B, ldb, K, m0, n0, smem, acc);
}
DEV void gemm_mainloop1(const u16* __restrict__ A, int lda, const u16* __restrict__ B, int ldb, int K, int m0, int n0,
                       char* smem, f32x4 (&acc)[4][4]) {
  const int tid = TID();
  const int l = tid & 63, w = tid >> 6, wm = w >> 1, wn = w & 1, lr = l & 15, lg = l >> 4;
  uint4 ga[4], gb[4];
  const int KT = K >> 6;
  auto gload = [&](int kt) {
#pragma unroll
    for (int i = 0; i < 4; ++i) {
      const int id = tid + 256 * i, row = id >> 3, c = id & 7;
      ga[i] = *(const uint4*)(A + (size_t)(m0 + row) * lda + kt * 64 + c * 8);
      gb[i] = *(const uint4*)(B + (size_t)(n0 + row) * ldb + kt * 64 + c * 8);
    }
  };
  auto lstore = [&](int buf) {
    char* as = smem + buf * 32768;
    char* bs = as + 16384;
#pragma unroll
    for (int i = 0; i < 4; ++i) {
      const int id = tid + 256 * i, row = id >> 3, c = id & 7;
      const int off = row * 128 + ((c ^ (row & 7)) << 4);
      *(uint4*)(as + off) = ga[i];
      *(uint4*)(bs + off) = gb[i];
    }
  };
  __syncthreads();
  gload(0);
  lstore(0);
  __syncthreads();
  for (int kt = 0; kt < KT; ++kt) {
    if (kt + 1 < KT) gload(kt + 1);
    const char* as = smem + (kt & 1) * 32768;
    const char* bs = as + 16384;
#pragma unroll
    for (int ks = 0; ks < 2; ++ks) {
      bf16x8 a[4], b[4];
      const int c = ks * 4 + lg;
      const int sw = ((c ^ (lr & 7)) << 4);
#pragma unroll
      for (int mi = 0; mi < 4; ++mi) a[mi] = *(const bf16x8*)(as + (wm * 64 + mi * 16 + lr) * 128 + sw);
#pragma unroll
      for (int ni = 0; ni < 4; ++ni) b[ni] = *(const bf16x8*)(bs + (wn * 64 + ni * 16 + lr) * 128 + sw);
#pragma unroll
      for (int mi = 0; mi < 4; ++mi)
#pragma unroll
        for (int ni = 0; ni < 4; ++ni) acc[mi][ni] = __builtin_amdgcn_mfma_f32_16x16x32_bf16(a[mi], b[ni], acc[mi][ni], 0, 0, 0);
    }
    if (kt + 1 < KT) lstore((kt + 1) & 1);
    __syncthreads();
  }
}

DEV void zero_acc(f32x4 (&acc)[4][4]) {
#pragma unroll
  for (int i = 0; i < 4; ++i)
#pragma unroll
    for (int j = 0; j < 4; ++j) acc[i][j] = (f32x4){0.f, 0.f, 0.f, 0.f};
}

DEV void stage_half(const f32x4 (&acc)[4][4], int hsel, char* smem, float4 (&v)[8]) {
  const int tid = TID();
  const int l = tid & 63, w = tid >> 6, wm = w >> 1, wn = w & 1, lr = l & 15, lg = l >> 4;
  float* Cs = (float*)smem;
  __syncthreads();
  if (wm == hsel) {
#pragma unroll
    for (int mi = 0; mi < 4; ++mi)
#pragma unroll
      for (int ni = 0; ni < 4; ++ni)
#pragma unroll
        for (int r = 0; r < 4; ++r) Cs[(mi * 16 + lg * 4 + r) * 132 + wn * 64 + ni * 16 + lr] = acc[mi][ni][r];
  }
  __syncthreads();
#pragma unroll
  for (int j = 0; j < 8; ++j) {
    const int idx = tid + 256 * j, row = idx >> 5, c4 = idx & 31;
    v[j] = *(const float4*)&Cs[row * 132 + c4 * 4];
  }
}

DEV bool tile_map(int it, int MT, int NTl, int& mt, int& nt) {
  const int nb = gridDim.x, bid = BID();
  const int x = bid & 7, vl = bid >> 3, per = nb >> 3;
  const int T = MT * NTl;
  const int g_begin = (int)(((long long)x * T) >> 3), g_end = (int)(((long long)(x + 1) * T) >> 3);
  const int g = g_begin + vl + it * per;
  if (g >= g_end) return false;
  const int full = MT >> 3;
  const int sr = g / (8 * NTl);
  const int srow = sr < full ? sr : full;
  const int rows_in_sr = sr < full ? 8 : (MT & 7);
  const int tt = g - srow * 8 * NTl;
  nt = tt / rows_in_sr;
  mt = srow * 8 + tt % rows_in_sr;
  return true;
}

#define SG_LOCALS                                                                              \
  const int tid = TID();                                                                       \
  const int l = tid & 63, w = tid >> 6, wm = w >> 1, wn = w & 1, lr = l & 15, lg = l >> 4;     \
  uint4 ga0[4], gb0[4], ga1[4], gb1[4];                                                        \
  _Pragma("unroll") for (int i = 0; i < 4; ++i) {                                              \
    ga0[i] = make_uint4(0u, 0u, 0u, 0u); gb0[i] = ga0[i]; ga1[i] = ga0[i]; gb1[i] = ga0[i];    \
  }                                                                                            \
  const int r0 = tid >> 3, c0 = tid & 7;                                                       \
  const int pr0 = 8 * ((r0 & 15) >> 2) + 4 * (r0 >> 4) + (r0 & 3);
#define SG_LOAD(GA, GB, AP, BP, LD, M0_, N0_, KT_)                                             \
  _Pragma("unroll") for (int i = 0; i < 4; ++i) {                                              \
    GA[i] = *(const uint4*)((AP) + (size_t)((M0_) + 32 * i + r0) * (LD) + c0 * 8 + (KT_) * 64);  \
    GB[i] = *(const uint4*)((BP) + (size_t)((N0_) + 32 * i + pr0) * (LD) + c0 * 8 + (KT_) * 64); \
  }
#define SG_LSTORE(GA, GB, BUF)                                                                 \
  {                                                                                            \
    char* as_ = smem + (BUF) * 32768;                                                          \
    char* bs_ = as_ + 16384;                                                                   \
    _Pragma("unroll") for (int i = 0; i < 4; ++i) {                                            \
      const int id = tid + 256 * i, row = id >> 3, c = id & 7;                                 \
      const int off = row * 128 + ((c ^ (row & 7)) << 4);                                      \
      *(uint4*)(as_ + off) = GA[i];                                                            \
      *(uint4*)(bs_ + off) = GB[i];                                                            \
    }                                                                                          \
  }
#define SG_COMPUTE(ACC, BUF, PRIO)                                                                                        \
  {                                                                                                                       \
    const char* as_ = smem + (BUF) * 32768;                                                                               \
    const char* bs_ = as_ + 16384;                                                                                        \
    if (PRIO) __builtin_amdgcn_s_setprio(1);                                                                              \
    _Pragma("unroll") for (int ks = 0; ks < 2; ++ks) {                                                                    \
      bf16x8 a[4], b[4];                                                                                                  \
      const int c = ks * 4 + lg;                                                                                          \
      const int sw = ((c ^ (lr & 7)) << 4);                                                                               \
      _Pragma("unroll") for (int mi = 0; mi < 4; ++mi) a[mi] = *(const bf16x8*)(as_ + (wm * 64 + mi * 16 + lr) * 128 + sw); \
      _Pragma("unroll") for (int ni = 0; ni < 4; ++ni) b[ni] = *(const bf16x8*)(bs_ + (wn * 64 + ni * 16 + lr) * 128 + sw); \
      _Pragma("unroll") for (int mi = 0; mi < 4; ++mi)                                                                    \
        _Pragma("unroll") for (int ni = 0; ni < 4; ++ni)                                                                  \
          ACC[mi][ni] = __builtin_amdgcn_mfma_f32_16x16x32_bf16(b[ni], a[mi], ACC[mi][ni], 0, 0, 0);                      \
    }                                                                                                                     \
    if (PRIO) __builtin_amdgcn_s_setprio(0);                                                                              \
  }

typedef int i32x8 __attribute__((ext_vector_type(8)));
typedef int i32x4 __attribute__((ext_vector_type(4)));
#define F8_LOCALS                                                                              \
  const int tid = TID();                                                                       \
  const int l = tid & 63, w = tid >> 6, wm = w >> 1, wn = w & 1, lr = l & 15, lg = l >> 4;     \
  uint4 ga0[4], gb0[4], ga1[4], gb1[4];                                                        \
  _Pragma("unroll") for (int i = 0; i < 4; ++i) {                                              \
    ga0[i] = make_uint4(0u, 0u, 0u, 0u); gb0[i] = ga0[i]; ga1[i] = ga0[i]; gb1[i] = ga0[i];    \
  }                                                                                            \
  const int r0 = tid >> 3, c0 = tid & 7;                                                       \
  const int pr0 = 8 * ((r0 & 15) >> 2) + 4 * (r0 >> 4) + (r0 & 3);
#define F8_GLOAD(GA, GB, AP, LDA, BP, LDB, M0_, N0_, KT_)                                      \
  _Pragma("unroll") for (int i = 0; i < 4; ++i) {                                              \
    GA[i] = *(const uint4*)((AP) + (size_t)((M0_) + 32 * i + r0) * (LDA) + c0 * 16 + (KT_) * 128);   \
    GB[i] = *(const uint4*)((BP) + (size_t)((N0_) + 32 * i + pr0) * (LDB) + c0 * 16 + (KT_) * 128);  \
  }
#define F8_LSTORE(GA, GB, BUF)                                                                 \
  {                                                                                            \
    char* as_ = smem + (BUF) * 32768;                                                          \
    char* bs_ = as_ + 16384;                                                                   \
    _Pragma("unroll") for (int i = 0; i < 4; ++i) {                                            \
      const int id = tid + 256 * i, row = id >> 3, c = id & 7;                                 \
      const int off = row * 128 + ((c ^ (row & 7)) << 4);                                      \
      *(uint4*)(as_ + off) = GA[i];                                                            \
      *(uint4*)(bs_ + off) = GB[i];                                                            \
    }                                                                                          \
  }
#define F8_COMPUTE(BUF)                                                                                                   \
  {                                                                                                                       \
    const char* as_ = smem + (BUF) * 32768;                                                                               \
    const char* bs_ = as_ + 16384;                                                                                        \
    i32x8 a[4], b[4];                                                                                                     \
    const int sw0 = ((lg ^ (lr & 7)) << 4), sw1 = (((4 + lg) ^ (lr & 7)) << 4);                                           \
    _Pragma("unroll") for (int mi = 0; mi < 4; ++mi) {                                                                    \
      const char* p_ = as_ + (wm * 64 + mi * 16 + lr) * 128;                                                              \
      const i32x4 lo_ = *(const i32x4*)(p_ + sw0), hi_ = *(const i32x4*)(p_ + sw1);                                       \
      a[mi] = __builtin_shufflevector(lo_, hi_, 0, 1, 2, 3, 4, 5, 6, 7);                                                  \
    }                                                                                                                     \
    _Pragma("unroll") for (int ni = 0; ni < 4; ++ni) {                                                                    \
      const char* p_ = bs_ + (wn * 64 + ni * 16 + lr) * 128;                                                              \
      const i32x4 lo_ = *(const i32x4*)(p_ + sw0), hi_ = *(const i32x4*)(p_ + sw1);                                       \
      b[ni] = __builtin_shufflevector(lo_, hi_, 0, 1, 2, 3, 4, 5, 6, 7);                                                  \
    }                                                                                                                     \
    __builtin_amdgcn_s_setprio(1);                                                                                        \
    _Pragma("unroll") for (int mi = 0; mi < 4; ++mi)                                                                      \
      _Pragma("unroll") for (int ni = 0; ni < 4; ++ni)                                                                    \
        acc[mi][ni] = __builtin_amdgcn_mfma_scale_f32_16x16x128_f8f6f4(b[ni], a[mi], acc[mi][ni], 0, 0, 0, 0, 0, 0);      \
    __builtin_amdgcn_s_setprio(0);                                                                                        \
  }
#define F8_KLOOP(AP, LDA, BP, LDB, KT_)                                                        \
  for (int kt = 0; kt < (KT_); kt += 2) {                                                      \
    const bool wrap = (kt + 2 >= (KT_));                                                       \
    const int ml = wrap ? m0n : m0, nl = wrap ? n0n : n0, kl = wrap ? kt + 2 - (KT_) : kt + 2; \
    if (!wrap || hasn) { F8_GLOAD(ga0, gb0, AP, LDA, BP, LDB, ml, nl, kl); }                   \
    F8_COMPUTE(0);                                                                             \
    F8_LSTORE(ga1, gb1, 1);                                                                    \
    __syncthreads();                                                                           \
    if (!wrap || hasn) { F8_GLOAD(ga1, gb1, AP, LDA, BP, LDB, ml, nl, kl + 1); }               \
    F8_COMPUTE(1);                                                                             \
    if (!wrap || hasn) { F8_LSTORE(ga0, gb0, 0); }                                             \
    __syncthreads();                                                                           \
  }
#define F8_PROLOGUE(AP, LDA, BP, LDB)                                                          \
  __syncthreads();                           \
  F8_GLOAD(ga0, gb0, AP, LDA, BP, LDB, m0, n0, 0);                                             \
  F8_GLOAD(ga1, gb1, AP, LDA, BP, LDB, m0, n0, 1);                                             \
  F8_LSTORE(ga0, gb0, 0);                                                                      \
  __syncthreads();

__device__ __forceinline__ void phase_gemm_win(int layer, char* smem) {
  const KP PP = get_params();
  const char* Bt = (const char*)(PP->WinT + (size_t)layer * NPAD * LDK1);
  const char* A = (const char*)PP->h;
  F8_LOCALS
  int it = 0, mt, nt;
  if (!tile_map(it, R / 128, NPAD / 128, mt, nt)) return;
  int m0 = mt * 128, n0 = nt * 128;
  F8_PROLOGUE(A, LDK1 * 2, Bt, LDK1)
  for (;;) {
    int mtn = 0, ntn = 0;
    const bool hasn = tile_map(it + 1, R / 128, NPAD / 128, mtn, ntn);
    const int m0n = mtn * 128, n0n = ntn * 128;
    f32x4 acc[4][4];
    zero_acc(acc);
    F8_KLOOP(A, LDK1 * 2, Bt, LDK1, 8)
#pragma unroll
    for (int mi = 0; mi < 4; ++mi) {
      const size_t gr = (size_t)(m0 + wm * 64 + mi * 16 + lr);
#pragma unroll
      for (int g = 0; g < 2; ++g) {
        const int gc = n0 + wn * 64 + g * 32 + 8 * lg;
        const f32x4 t0 = acc[mi][2 * g] * (1.f / 32.f), t1 = acc[mi][2 * g + 1] * (1.f / 32.f);
        if (n0 < 1536) {
          int p0 = __builtin_amdgcn_cvt_pk_fp8_f32(t0[0], t0[1], 0, false);
          p0 = __builtin_amdgcn_cvt_pk_fp8_f32(t0[2], t0[3], p0, true);
          int p1 = __builtin_amdgcn_cvt_pk_fp8_f32(t1[0], t1[1], 0, false);
          p1 = __builtin_amdgcn_cvt_pk_fp8_f32(t1[2], t1[3], p1, true);
          *(int2*)((char*)PP->qkv_pre + gr * 1536 + gc) = make_int2(p0, p1);
        } else if (n0 < 2048) {
          *(uint4*)(PP->z + gr * 512 + (gc - 1536)) =
              make_uint4(pack_bf16(t0[0], t0[1]), pack_bf16(t0[2], t0[3]), pack_bf16(t1[0], t1[1]), pack_bf16(t1[2], t1[3]));
        } else if (n0 < 2560) {
          *(uint4*)(PP->pin + gr * 512 + (gc - 2048)) =
              make_uint4(pack_bf16(t0[0], t0[1]), pack_bf16(t0[2], t0[3]), pack_bf16(t1[0], t1[1]), pack_bf16(t1[2], t1[3]));
        } else if (n0 < 4608) {
          unsigned q0 = 0u, q1 = 0u;
#pragma unroll
          for (int e = 0; e < 4; ++e) {
            q0 = __builtin_amdgcn_cvt_pk_u8_f32(sigmoidf_(t0[e]) * 255.f, e, q0);
            q1 = __builtin_amdgcn_cvt_pk_u8_f32(sigmoidf_(t1[e]) * 255.f, e, q1);
          }
          unsigned char* gdst = (n0 < 3584) ? (unsigned char*)PP->sgd + gr * 1024 + (gc - 2560)
                                            : (unsigned char*)PP->sgp + gr * 1024 + (gc - 3584);
          *(uint2*)gdst = make_uint2(q0, q1);
        } else {
          if (gc - 4608 < 16) {
            *(float4*)(PP->ba + gr * 16 + (gc - 4608)) = make_float4(t0[0], t0[1], t0[2], t0[3]);
            *(float4*)(PP->ba + gr * 16 + (gc - 4608) + 4) = make_float4(t1[0], t1[1], t1[2], t1[3]);
          }
        }
      }
    }
    if (!hasn) break;
    m0 = m0n; n0 = n0n; ++it;
  }
}

__device__ __forceinline__ void phase_conv(int layer) {
  const KP PP = get_params();
  const int lane = TID() & 63;
  const int gw = BID() * 4 + (TID() >> 6), nw = gridDim.x * 4;
  const float* cw = PP->conv_w + (size_t)layer * 4 * 1536;
  float wr[3][4][8];
#pragma unroll
  for (int part = 0; part < 3; ++part)
#pragma unroll
    for (int j = 0; j < 4; ++j) {
      const float4 w0 = *(const float4*)(cw + j * 1536 + part * 512 + lane * 8);
      const float4 w1 = *(const float4*)(cw + j * 1536 + part * 512 + lane * 8 + 4);
      wr[part][j][0] = w0.x; wr[part][j][1] = w0.y; wr[part][j][2] = w0.z; wr[part][j][3] = w0.w;
      wr[part][j][4] = w1.x; wr[part][j][5] = w1.y; wr[part][j][6] = w1.z; wr[part][j][7] = w1.w;
    }
  for (int r = gw; r < R; r += nw) {
    int t, T;
    if (r < NLAT) { t = r & (SEQ - 1); T = SEQ; } else { t = (r - NLAT) & (CTX - 1); T = CTX; }
    const int base = r - t;
    uint2 xv[3][4];
#pragma unroll
    for (int j = 0; j < 4; ++j) {
      const int tt = t + j - 2;
      const bool ok = (tt >= 0 && tt < T);
      const unsigned char* src = (const unsigned char*)PP->qkv_pre + (size_t)(base + (ok ? tt : t)) * 1536 + lane * 8;
#pragma unroll
      for (int part = 0; part < 3; ++part) {
        xv[part][j] = *(const uint2*)(src + part * 512);
        if (!ok) xv[part][j] = make_uint2(0u, 0u);
      }
    }
#pragma unroll
    for (int part = 0; part < 3; ++part) {
      const int ch0 = part * 512 + lane * 8;
      float y[8];
#pragma unroll
      for (int e = 0; e < 8; ++e) y[e] = 0.f;
#pragma unroll
      for (int j = 0; j < 4; ++j) {
        float xf[8];
        {
          const f32x2 a0 = __builtin_amdgcn_cvt_pk_f32_fp8(xv[part][j].x, false), a1 = __builtin_amdgcn_cvt_pk_f32_fp8(xv[part][j].x, true);
          const f32x2 a2 = __builtin_amdgcn_cvt_pk_f32_fp8(xv[part][j].y, false), a3 = __builtin_amdgcn_cvt_pk_f32_fp8(xv[part][j].y, true);
          xf[0] = a0[0]; xf[1] = a0[1]; xf[2] = a1[0]; xf[3] = a1[1]; xf[4] = a2[0]; xf[5] = a2[1]; xf[6] = a3[0]; xf[7] = a3[1];
        }
#pragma unroll
        for (int e = 0; e < 8; ++e) y[e] += wr[part][j][e] * xf[e];
      }
      float ss = 0.f;
#pragma unroll
      for (int e = 0; e < 8; ++e) { y[e] = siluf_(y[e]); ss += y[e] * y[e]; }
      if (part < 2) {
        ss = group16_sum(ss);
        const float sc = rsqrtf(ss + EPS) * (part == 0 ? 0.08838834764831845f : 1.f);
#pragma unroll
        for (int e = 0; e < 8; ++e) y[e] *= sc;
      }
      *(uint4*)(PP->qkvn + (size_t)r * 1536 + ch0) = pack8(y);
    }
    if (lane < 16) {
      const float raw = PP->ba[(size_t)r * 16 + lane];
      float o;
      if (lane < 8) {
        o = sigmoidf_(raw);
      } else {
        const int jj = lane - 8;
        const float xx = raw + PP->dt_bias[layer * 8 + jj];
        const float ee = __expf(xx);
        const float sp = xx > 20.f ? xx : (ee < 0.03125f ? ee * (1.f - ee * (0.5f - ee * (0.33333334f - 0.25f * ee))) : __logf(1.f + ee));
        o = -__expf(PP->a_log[layer * 8 + jj]) * sp;
      }
      PP->bg[(size_t)r * 16 + lane] = o;
    }
  }
}

DEV int seq_row(int b, int dir, int pos) {
  if (dir == 0) return pos < CTX ? NLAT + b * CTX + pos : b * SEQ + (pos - CTX);
  return pos < CTX ? NLAT + b * CTX + (CTX - 1 - pos) : b * SEQ + (SEQ - 1 - (pos - CTX));
}
constexpr int NCHUNK = (CTX + SEQ) / 64;
constexpr int NUNIT = BATCH * DNH * 2 * NCHUNK;

DEV int kperm(int s, int g, int e) { return 32 * s + 16 * (e >> 2) + 4 * g + (e & 3); }

DEV uint4 pack_tiles(const f32x4& a, const f32x4& b) {
  return make_uint4(pack_bf16(a[0], a[1]), pack_bf16(a[2], a[3]), pack_bf16(b[0], b[1]), pack_bf16(b[2], b[3]));
}
DEV bf16x8 as_frag(const uint4& v) { return *(const bf16x8*)&v; }

DEV void conv8_silu(const unsigned char* __restrict__ qkv_pre8, const float* __restrict__ cw, int r, int ch0, float (&y)[8]) {
  int t, T;
  if (r < NLAT) { t = r & (SEQ - 1); T = SEQ; } else { t = (r - NLAT) & (CTX - 1); T = CTX; }
  const int base = r - t;
  uint2 xv[4];
#pragma unroll
  for (int j = 0; j < 4; ++j) {
    const int tt = t + j - 2;
    const bool ok = (tt >= 0 && tt < T);
    xv[j] = *(const uint2*)(qkv_pre8 + (size_t)(base + (ok ? tt : t)) * 1536 + ch0);
    if (!ok) xv[j] = make_uint2(0u, 0u);
  }
#pragma unroll
  for (int e = 0; e < 8; ++e) y[e] = 0.f;
#pragma unroll
  for (int j = 0; j < 4; ++j) {
    const float4 w0 = *(const float4*)(cw + j * 1536 + ch0), w1 = *(const float4*)(cw + j * 1536 + ch0 + 4);
    const f32x2 a0 = __builtin_amdgcn_cvt_pk_f32_fp8(xv[j].x, false), a1 = __builtin_amdgcn_cvt_pk_f32_fp8(xv[j].x, true);
    const f32x2 a2 = __builtin_amdgcn_cvt_pk_f32_fp8(xv[j].y, false), a3 = __builtin_amdgcn_cvt_pk_f32_fp8(xv[j].y, true);
    y[0] += w0.x * a0[0]; y[1] += w0.y * a0[1]; y[2] += w0.z * a1[0]; y[3] += w0.w * a1[1];
    y[4] += w1.x * a2[0]; y[5] += w1.y * a2[1]; y[6] += w1.z * a3[0]; y[7] += w1.w * a3[1];
  }
#pragma unroll
  for (int e = 0; e < 8; ++e) y[e] = siluf_(y[e]);
}

__device__ __forceinline__ void phase_prep(int layer, char* smem) {
  const KP PP = get_params();
  const int tid0 = TID();
  const int w = __builtin_amdgcn_readfirstlane(tid0 >> 6);
  char* Kt = smem;
  char* Vt = smem + 16384;
  float* Ld = (float*)(smem + 32768);
  u16* LN = (u16*)(smem + 32768 + 5120);
  float* gcs = (float*)(smem + 32768 + 5120 + 9216);
  float* bts = gcs + 64;
  char* wpriv = smem + 32768 + 5120 + 9216 + 512 + w * 6144;
  float* Tt = (float*)wpriv;
  u16* Xb = (u16*)(wpriv + 4096);
  for (int j_ = BID() >> 3; j_ < 2 * NCHUNK; j_ += (gridDim.x >> 3)) {
    const int c = NCHUNK - 1 - (j_ >> 1), u16i = (BID() & 7) * 2 + (j_ & 1);
    const int unit = u16i * NCHUNK + c;
    const int dir = u16i & 1, hd = (u16i >> 1) & 3, b = u16i >> 3;
    int tid = tid0;
    asm volatile("" : "+v"(tid));
    const int l = tid & 63, lr = l & 15, lg = l >> 4;
    __syncthreads();
    if (tid < 64) {
      const int rr = seq_row(b, dir, c * 64 + tid);
      const int jj = dir * 4 + hd;
      bts[tid] = sigmoidf_(PP->ba[(size_t)rr * 16 + jj]);
      float g;
      {
        const float xx = PP->ba[(size_t)rr * 16 + 8 + jj] + PP->dt_bias[layer * 8 + jj];
        const float ee = __expf(xx);
        const float sp = xx > 20.f ? xx : (ee < 0.03125f ? ee * (1.f - ee * (0.5f - ee * (0.33333334f - 0.25f * ee))) : __logf(1.f + ee));
        g = -__expf(PP->a_log[layer * 8 + jj]) * sp;
      }
#pragma unroll
      for (int o = 1; o < 64; o <<= 1) {
        const float t = __builtin_bit_cast(float, __builtin_amdgcn_ds_bpermute(((tid - o) & 63) << 2, __builtin_bit_cast(int, g)));
        if (tid >= o) g += t;
      }
      gcs[tid] = g;
      PP->gc[(size_t)unit * 64 + tid] = g;
    }
    {
      const unsigned char* pre8 = (const unsigned char*)PP->qkv_pre;
      const float* cw = PP->conv_w + (size_t)layer * 4 * 1536;
      const int ch = tid & 15, rg = tid >> 4;
      const int r_first = seq_row(b, dir, c * 64 + 4 * rg);
      int t0, T;
      if (r_first < NLAT) { t0 = r_first & (SEQ - 1); T = SEQ; } else { t0 = (r_first - NLAT) & (CTX - 1); T = CTX; }
      const int base = r_first - t0;
      const int tl = dir ? t0 - 3 : t0;
      const int nparts = dir == 0 ? 3 : 2;
      for (int part = 0; part < nparts; ++part) {
        const int chofs = (part == 0 ? 512 : (part == 1 ? 1024 : 0)) + hd * 128 + ch * 8;
        float wv[4][8];
#pragma unroll
        for (int j = 0; j < 4; ++j) {
          const float4 w0 = *(const float4*)(cw + j * 1536 + chofs), w1 = *(const float4*)(cw + j * 1536 + chofs + 4);
          wv[j][0] = w0.x; wv[j][1] = w0.y; wv[j][2] = w0.z; wv[j][3] = w0.w;
          wv[j][4] = w1.x; wv[j][5] = w1.y; wv[j][6] = w1.z; wv[j][7] = w1.w;
        }
        uint2 xr[7];
#pragma unroll
        for (int m = 0; m < 7; ++m) {
          const int tt = tl - 2 + m;
          const bool ok = (tt >= 0 && tt < T);
          xr[m] = *(const uint2*)(pre8 + (size_t)(base + (ok ? tt : t0)) * 1536 + chofs);
          if (!ok) xr[m] = make_uint2(0u, 0u);
        }
        float xf[7][8];
#pragma unroll
        for (int m = 0; m < 7; ++m) {
          const f32x2 a0 = __builtin_amdgcn_cvt_pk_f32_fp8(xr[m].x, false), a1 = __builtin_amdgcn_cvt_pk_f32_fp8(xr[m].x, true);
          const f32x2 a2 = __builtin_amdgcn_cvt_pk_f32_fp8(xr[m].y, false), a3 = __builtin_amdgcn_cvt_pk_f32_fp8(xr[m].y, true);
          xf[m][0] = a0[0]; xf[m][1] = a0[1]; xf[m][2] = a1[0]; xf[m][3] = a1[1];
          xf[m][4] = a2[0]; xf[m][5] = a2[1]; xf[m][6] = a3[0]; xf[m][7] = a3[1];
        }
#pragma unroll
        for (int s4 = 0; s4 < 4; ++s4) {
          const int m0_ = dir ? 3 - s4 : s4;
          float y[8];
          float ss = 0.f;
#pragma unroll
          for (int e2 = 0; e2 < 8; ++e2) {
            float a = 0.f;
#pragma unroll
            for (int j = 0; j < 4; ++j) a += wv[j][e2] * (dir ? xf[3 - s4 + j][e2] : xf[s4 + j][e2]);
            a = siluf_(a);
            y[e2] = a;
            ss += a * a;
          }
          if (part != 1) {
            ss = group16_sum(ss);
            const float sc = rsqrtf(ss + EPS) * (part == 2 ? 0.08838834764831845f : 1.f);
#pragma unroll
            for (int e2 = 0; e2 < 8; ++e2) y[e2] *= sc;
          }
          const uint4 pk = pack8(y);
          const int i = 4 * rg + s4;
          if (part < 2) *(uint4*)((part == 0 ? Kt : Vt) + i * 256 + ((ch ^ (i & 15)) << 4)) = pk;
          if (dir == 0 && part != 1) *(uint4*)(PP->qkvn + (size_t)(base + tl + m0_) * 1536 + chofs) = pk;
        }
      }
    }
    __syncthreads();
    {
      f32x4 acc[4];
#pragma unroll
      for (int nt = 0; nt < 4; ++nt) acc[nt] = (f32x4){0.f, 0.f, 0.f, 0.f};
#pragma unroll
      for (int s = 0; s < 4; ++s) {
        const int ch = s * 4 + lg;
        const bf16x8 a = *(const bf16x8*)(Kt + (16 * w + lr) * 256 + ((ch ^ lr) << 4));
#pragma unroll
        for (int nt = 0; nt < 4; ++nt) {
          const bf16x8 bb = *(const bf16x8*)(Kt + (16 * nt + lr) * 256 + ((ch ^ lr) << 4));
          acc[nt] = __builtin_amdgcn_mfma_f32_16x16x32_bf16(a, bb, acc[nt], 0, 0, 0);
        }
      }
#pragma unroll
      for (int nt = 0; nt < 4; ++nt)
#pragma unroll
        for (int r = 0; r < 4; ++r) {
          const int i = 16 * w + 4 * lg + r, j = 16 * nt + lr;
          const float val = (j < i) ? bts[i] * acc[nt][r] * __expf(fminf(gcs[i] - gcs[j], 0.f)) : 0.f;
          LN[i * 72 + j] = f2bf(-val);
          if (nt == w) Ld[(w * 16 + lr) * 20 + 4 * lg + r] = val;
        }
    }
    {
      const float glast = gcs[63];
      if (tid == 0) PP->glast[unit] = glast;
#pragma unroll
      for (int q4 = 0; q4 < 4; ++q4) {
        const int fid = tid + 256 * q4;
        const int mt = fid >> 7, s2 = (fid >> 6) & 1, ln = fid & 63, llr = ln & 15, llg = ln >> 4;
        const int d = 16 * mt + llr;
        float f[8];
#pragma unroll
        for (int e = 0; e < 8; ++e) {
          const int pos = kperm(s2, llg, e);
          const float kv = bf2f(*(const u16*)(Kt + pos * 256 + (((d >> 3) ^ (pos & 15)) << 4) + (d & 7) * 2));
          f[e] = kv * __expf(glast - gcs[pos]);
        }
        *(uint4*)(PP->KdT + ((size_t)unit * 1024 + fid) * 8) = pack8(f);
      }
    }
    f32x4 X[4][4];
    {
      const bool isU = w >= 2;
      const char* tile = isU ? Vt : Kt;
#pragma unroll
      for (int mt = 0; mt < 4; ++mt)
#pragma unroll
        for (int nt = 0; nt < 4; ++nt)
#pragma unroll
          for (int r = 0; r < 4; ++r) {
            const int i = 16 * mt + 4 * lg + r, cc = 64 * (w & 1) + 16 * nt + lr;
            const float val = bf2f(*(const u16*)(tile + i * 256 + (((cc >> 3) ^ (i & 15)) << 4) + (cc & 7) * 2));
            X[mt][nt][r] = bts[i] * val * (isU ? 1.f : __expf(gcs[i]));
          }
    }
    __syncthreads();
    u16* Wst = (u16*)smem;
    u16* Ust = (u16*)(smem + 16384);
#pragma unroll
    for (int bk = 0; bk < 4; ++bk) {
#pragma unroll
      for (int nt = 0; nt < 4; ++nt)
#pragma unroll
        for (int r = 0; r < 4; ++r) Tt[(4 * lg + r) * 64 + 16 * nt + lr] = X[bk][nt][r];
      __builtin_amdgcn_wave_barrier();
      asm volatile("s_waitcnt lgkmcnt(0)" ::: "memory");
      float xb[16];
#pragma unroll
      for (int i = 0; i < 16; ++i) xb[i] = Tt[i * 64 + l];
#pragma unroll
      for (int j = 0; j < 15; ++j) {
        const float xj = xb[j];
#pragma unroll
        for (int i4 = (j + 1) / 4; i4 < 4; ++i4) {
          const float4 lv = *(const float4*)&Ld[(bk * 16 + j) * 20 + i4 * 4];
          if (i4 * 4 + 0 > j) xb[i4 * 4 + 0] -= lv.x * xj;
          if (i4 * 4 + 1 > j) xb[i4 * 4 + 1] -= lv.y * xj;
          if (i4 * 4 + 2 > j) xb[i4 * 4 + 2] -= lv.z * xj;
          if (i4 * 4 + 3 > j) xb[i4 * 4 + 3] -= lv.w * xj;
        }
      }
      {
        const int cc = 64 * (w & 1) + l;
        if (w < 2) {
          const int d = cc, s = d >> 5, e = ((d >> 4) & 1) * 4 + (d & 3), g = (d >> 2) & 3;
#pragma unroll
          for (int ii = 0; ii < 16; ++ii) Wst[(((bk * 4 + s) * 64 + g * 16 + ii) << 3) + e] = f2bf(-xb[ii]);
        } else {
          const int slice = cc >> 4, lr_ = cc & 15;
#pragma unroll
          for (int ii = 0; ii < 16; ++ii) Ust[(((slice * 4 + bk) * 64 + ((ii >> 2) & 3) * 16 + lr_) << 2) + (ii & 3)] = f2bf(xb[ii]);
        }
        if (bk < 3) {
          *(uint4*)(Xb + l * 16) = pack8(xb);
          *(uint4*)(Xb + l * 16 + 8) = pack8(xb + 8);
        }
      }
      if (bk < 3) {
        __builtin_amdgcn_wave_barrier();
        asm volatile("s_waitcnt lgkmcnt(0)" ::: "memory");
        uint4 bfr[4];
#pragma unroll
        for (int nt = 0; nt < 4; ++nt)
          bfr[nt] = (lg < 2) ? *(const uint4*)(Xb + (16 * nt + lr) * 16 + 8 * lg) : make_uint4(0u, 0u, 0u, 0u);
#pragma unroll
        for (int mt = bk + 1; mt < 4; ++mt) {
          const uint4 afr = (lg < 2) ? *(const uint4*)(LN + (16 * mt + lr) * 72 + 16 * bk + 8 * lg) : make_uint4(0u, 0u, 0u, 0u);
#pragma unroll
          for (int nt = 0; nt < 4; ++nt)
            X[mt][nt] = __builtin_amdgcn_mfma_f32_16x16x32_bf16(as_frag(afr), as_frag(bfr[nt]), X[mt][nt], 0, 0, 0);
        }
        __builtin_amdgcn_wave_barrier();
      }
    }
    __syncthreads();
#pragma unroll
    for (int q = 0; q < 4; ++q) {
      const int id = tid + 256 * q;
      *(uint4*)(PP->Wfrag + ((size_t)unit * 1024 + id) * 8) = *(const uint4*)(smem + id * 16);
      *(uint4*)(PP->Ufrag + ((size_t)unit * 1024 + id) * 8) = *(const uint4*)(smem + 16384 + id * 16);
    }
  }
}


__device__ __forceinline__ void phase_scan(char* smem) {
  const KP PP = get_params();
  const int tid = TID(), lane = tid & 63, wv = tid >> 6;
  __builtin_amdgcn_s_setprio(3);
  for (int item = BID(); item < 128; item += gridDim.x) {
    const int u16i = (item & 7) * 2 + (item >> 6), slice = (item >> 3) & 7;
    const size_t ubase = (size_t)u16i * NCHUNK;
    const uint4* Wg = (const uint4*)PP->Wfrag;
    const uint4* Kg = (const uint4*)PP->KdT;
    __syncthreads();
    if (wv != 0) {
      const int j0 = wv - 1;
      uint4 st0[11], st1[11], st2[11];
#pragma unroll
      for (int i = 0; i < 11; ++i) { st0[i] = make_uint4(0u, 0u, 0u, 0u); st1[i] = st0[i]; st2[i] = st0[i]; }
#define LLOAD(ST, UNIT)                                                                                      \
  _Pragma("unroll") for (int i = 0; i < 11; ++i) {                                                           \
    const int q = (j0 + 3 * i) < 32 ? (j0 + 3 * i) : 31;                                                     \
    ST[i] = *((q < 16 ? Wg + (UNIT) * 1024 + q * 64 : Kg + (UNIT) * 1024 + (q - 16) * 64) + lane);           \
  }
#define LWRITE(ST, SLOT)                                                                                     \
  _Pragma("unroll") for (int i = 0; i < 11; ++i) {                                                           \
    const int q = (j0 + 3 * i) < 32 ? (j0 + 3 * i) : 31;                                                     \
    *(uint4*)((SLOT) + q * 1024 + lane * 16) = ST[i];                                                        \
  }
      LLOAD(st0, ubase);
      LLOAD(st1, ubase + 1);
      LLOAD(st2, ubase + 2);
      LWRITE(st0, smem);
      LLOAD(st0, ubase + 3);
      __syncthreads();
#define LSTEP(ST, C)                                                                   \
  {                                                                                    \
    LWRITE(ST, smem + (((C) + 1) & 1) * 32768);                                        \
    LLOAD(ST, ubase + (size_t)(((C) + 4 < NCHUNK) ? (C) + 4 : NCHUNK - 1));            \
    __syncthreads();                                                                   \
  }
      for (int c0 = 0; c0 < NCHUNK; c0 += 3) {
        LSTEP(st1, c0);
        LSTEP(st2, c0 + 1);
        LSTEP(st0, c0 + 2);
      }
#undef LSTEP
#undef LLOAD
#undef LWRITE
    } else {
      f32x4 S[8];
#pragma unroll
      for (int t = 0; t < 8; ++t) S[t] = (f32x4){0.f, 0.f, 0.f, 0.f};
      uint2 uf0[5], uf1[5], uf2[5];
#pragma unroll
      for (int i = 0; i < 5; ++i) { uf0[i] = make_uint2(0u, 0u); uf1[i] = uf0[i]; uf2[i] = uf0[i]; }
      const uint2* Ug = (const uint2*)PP->Ufrag + lane;
      const float* Gl = PP->glast;
#define ULOAD(UF, UNIT) { _Pragma("unroll") for (int i = 0; i < 4; ++i) UF[i] = Ug[((UNIT) * 8 + slice) * 256 + i * 64]; UF[4].x = __float_as_uint(Gl[UNIT]); }
      ULOAD(uf0, ubase);
      ULOAD(uf1, ubase + 1);
      ULOAD(uf2, ubase + 2);
#define CSTEP(UF, C)                                                                                                   \
  {                                                                                                                    \
    const int c = (C);                                                                                                 \
    const size_t unit = ubase + c;                                                                                     \
    const char* slot = smem + (c & 1) * 32768;                                                                         \
    const float el = __expf(__uint_as_float(UF[4].x));                                                                 \
    uint4 sb[4];                                                                                                       \
    _Pragma("unroll") for (int s2 = 0; s2 < 4; ++s2) sb[s2] = pack_tiles(S[2 * s2], S[2 * s2 + 1]);                    \
    {                                                                                                                  \
      uint4* sp = (uint4*)PP->Sfrag + (unit * 8 + slice) * 256 + lane;                                                 \
      _Pragma("unroll") for (int s2 = 0; s2 < 4; ++s2) sp[s2 * 64] = sb[s2];                                           \
    }                                                                                                                  \
    f32x4 vn[4];                                                                                                       \
    _Pragma("unroll") for (int mt = 0; mt < 4; ++mt) {                                                                 \
      vn[mt] = (f32x4){bf_lo(UF[mt].x), bf_hi(UF[mt].x), bf_lo(UF[mt].y), bf_hi(UF[mt].y)};                            \
      _Pragma("unroll") for (int s2 = 0; s2 < 4; ++s2) {                                                               \
        const uint4 wfr = *(const uint4*)(slot + (mt * 4 + s2) * 1024 + lane * 16);                                    \
        vn[mt] = __builtin_amdgcn_mfma_f32_16x16x32_bf16(as_frag(wfr), as_frag(sb[s2]), vn[mt], 0, 0, 0);              \
      }                                                                                                                \
    }                                                                                                                  \
    ULOAD(UF, ubase + (size_t)((c + 3 < NCHUNK) ? c + 3 : NCHUNK - 1));                                                \
    uint4 vb[2];                                                                                                       \
    vb[0] = pack_tiles(vn[0], vn[1]);                                                                                  \
    vb[1] = pack_tiles(vn[2], vn[3]);                                                                                  \
    {                                                                                                                  \
      uint4* vp = (uint4*)PP->Vfrag + (unit * 8 + slice) * 128 + lane;                                                 \
      vp[0] = vb[0];                                                                                                   \
      vp[64] = vb[1];                                                                                                  \
    }                                                                                                                  \
    _Pragma("unroll") for (int t = 0; t < 8; ++t) {                                                                    \
      S[t] *= el;                                                                                                      \
      const uint4 k0 = *(const uint4*)(slot + 16384 + (t * 2 + 0) * 1024 + lane * 16);                                 \
      const uint4 k1 = *(const uint4*)(slot + 16384 + (t * 2 + 1) * 1024 + lane * 16);                                 \
      S[t] = __builtin_amdgcn_mfma_f32_16x16x32_bf16(as_frag(k0), as_frag(vb[0]), S[t], 0, 0, 0);                      \
      S[t] = __builtin_amdgcn_mfma_f32_16x16x32_bf16(as_frag(k1), as_frag(vb[1]), S[t], 0, 0, 0);                      \
    }                                                                                                                  \
    __syncthreads();                                                                                                   \
  }
      __syncthreads();
      for (int c0 = 0; c0 < NCHUNK; c0 += 3) {
        CSTEP(uf0, c0);
        CSTEP(uf1, c0 + 1);
        CSTEP(uf2, c0 + 2);
      }
#undef CSTEP
#undef ULOAD
    }
  }
  __builtin_amdgcn_s_setprio(0);
}

__device__ __forceinline__ void phase_o(int layer, char* smem) {
  const KP PP = get_params();
  const int tid = TID(), l = tid & 63, w = tid >> 6, lr = l & 15, lg = l >> 4;
  char* Qt = smem;
  char* Kt = smem + 16384;
  u16* If = (u16*)(smem + 32768);
  u16* Ib = (u16*)(smem + 41984);
  float* gcf = (float*)(smem + 51200);
  float* gcb = gcf + 64;
  float* rowss = gcb + 64;
  float* Os = (float*)smem;
  const int nper = (layer == DEPTH - 1) ? 128 : 132;
  const int xq = BID() & 7, vl0 = BID() >> 3, vstep = gridDim.x >> 3;
  for (int vi = vl0; vi < nper; vi += vstep) {
    int b = xq >> 2, hd = xq & 3, tok0, cf, cb;
    if (vi < 128) {
      const int n = vi;
      tok0 = b * SEQ + 64 * n; cf = 4 + n; cb = 4 + 127 - n;
    } else {
      const int n = vi - 128;
      tok0 = NLAT + b * CTX + 64 * n; cf = n; cb = 3 - n;
    }
    const size_t unit_f = (size_t)((b * 4 + hd) * 2 + 0) * NCHUNK + cf;
    const size_t unit_b = (size_t)((b * 4 + hd) * 2 + 1) * NCHUNK + cb;
    uint4 pSF[4][2], pSB[4][2], pVF[2][2], pVB[2][2];
#pragma unroll
    for (int q = 0; q < 2; ++q) {
      const int sl = 2 * w + q;
#pragma unroll
      for (int s = 0; s < 4; ++s) {
        pSF[s][q] = *((const uint4*)PP->Sfrag + ((unit_f * 8 + sl) * 4 + s) * 64 + l);
        pSB[s][q] = *((const uint4*)PP->Sfrag + ((unit_b * 8 + sl) * 4 + s) * 64 + l);
      }
#pragma unroll
      for (int s2 = 0; s2 < 2; ++s2) {
        pVF[s2][q] = *((const uint4*)PP->Vfrag + ((unit_f * 8 + sl) * 2 + s2) * 64 + l);
        pVB[s2][q] = *((const uint4*)PP->Vfrag + ((unit_b * 8 + sl) * 2 + s2) * 64 + l);
      }
    }
    __syncthreads();
    for (int idx = tid; idx < 2048; idx += NTHR) {
      const int arr = idx >> 10, i = (idx >> 4) & 63, ch = idx & 15;
      const uint4 v = *(const uint4*)(PP->qkvn + (size_t)(tok0 + i) * 1536 + (arr == 0 ? 0 : 512) + hd * 128 + ch * 8);
      *(uint4*)((arr == 0 ? Qt : Kt) + i * 256 + ((ch ^ (i & 15)) << 4)) = v;
    }
    if (tid < 64) gcf[tid] = PP->gc[unit_f * 64 + tid];
    else if (tid < 128) gcb[tid - 64] = PP->gc[unit_b * 64 + (tid - 64)];
    __syncthreads();
    {
      f32x4 acc[4];
#pragma unroll
      for (int nt = 0; nt < 4; ++nt) acc[nt] = (f32x4){0.f, 0.f, 0.f, 0.f};
#pragma unroll
      for (int s = 0; s < 4; ++s) {
        const int ch = s * 4 + lg;
        const bf16x8 a = *(const bf16x8*)(Qt + (16 * w + lr) * 256 + ((ch ^ lr) << 4));
#pragma unroll
        for (int nt = 0; nt < 4; ++nt) {
          const bf16x8 bb = *(const bf16x8*)(Kt + (16 * nt + lr) * 256 + ((ch ^ lr) << 4));
          acc[nt] = __builtin_amdgcn_mfma_f32_16x16x32_bf16(a, bb, acc[nt], 0, 0, 0);
        }
      }
#pragma unroll
      for (int nt = 0; nt < 4; ++nt)
#pragma unroll
        for (int r = 0; r < 4; ++r) {
          const int i = 16 * w + 4 * lg + r, j = 16 * nt + lr;
          const float vf = (j <= i) ? acc[nt][r] * __expf(fminf(gcf[i] - gcf[j], 0.f)) : 0.f;
          const float vb = (j >= i) ? acc[nt][r] * __expf(fminf(gcb[63 - i] - gcb[63 - j], 0.f)) : 0.f;
          If[i * 72 + j] = f2bf(vf);
          Ib[i * 72 + (63 - j)] = f2bf(vb);
        }
    }
    __syncthreads();
    f32x4 accF[4][2], accB[4][2], accI[4][2];
#pragma unroll
    for (int mt = 0; mt < 4; ++mt)
#pragma unroll
      for (int q = 0; q < 2; ++q) {
        accF[mt][q] = (f32x4){0.f, 0.f, 0.f, 0.f};
        accB[mt][q] = (f32x4){0.f, 0.f, 0.f, 0.f};
        accI[mt][q] = (f32x4){0.f, 0.f, 0.f, 0.f};
      }
#pragma unroll
    for (int s = 0; s < 4; ++s) {
      bf16x8 qa[4];
#pragma unroll
      for (int mt = 0; mt < 4; ++mt) {
        const int row = 16 * mt + lr;
        const int c0 = 4 * s + (lg >> 1), c1 = c0 + 2;
        const uint2 lo = *(const uint2*)(Qt + row * 256 + ((c0 ^ lr) << 4) + (lg & 1) * 8);
        const uint2 hi = *(const uint2*)(Qt + row * 256 + ((c1 ^ lr) << 4) + (lg & 1) * 8);
        const uint4 t = make_uint4(lo.x, lo.y, hi.x, hi.y);
        qa[mt] = as_frag(t);
      }
#pragma unroll
      for (int q = 0; q < 2; ++q) {
        const int sl = 2 * w + q;
        const uint4 bF = pSF[s][q], bB = pSB[s][q];
#pragma unroll
        for (int mt = 0; mt < 4; ++mt) {
          accF[mt][q] = __builtin_amdgcn_mfma_f32_16x16x32_bf16(qa[mt], as_frag(bF), accF[mt][q], 0, 0, 0);
          accB[mt][q] = __builtin_amdgcn_mfma_f32_16x16x32_bf16(qa[mt], as_frag(bB), accB[mt][q], 0, 0, 0);
        }
      }
    }
#pragma unroll
    for (int s2 = 0; s2 < 2; ++s2) {
      bf16x8 ia[4], ib[4];
#pragma unroll
      for (int mt = 0; mt < 4; ++mt) {
        const int row = 16 * mt + lr;
        const int col = 32 * s2 + 4 * lg;
        const uint2 flo = *(const uint2*)(If + row * 72 + col);
        const uint2 fhi = *(const uint2*)(If + row * 72 + col + 16);
        const uint2 blo = *(const uint2*)(Ib + row * 72 + col);
        const uint2 bhi = *(const uint2*)(Ib + row * 72 + col + 16);
        const uint4 tf = make_uint4(flo.x, flo.y, fhi.x, fhi.y);
        const uint4 tb = make_uint4(blo.x, blo.y, bhi.x, bhi.y);
        ia[mt] = as_frag(tf);
        ib[mt] = as_frag(tb);
      }
#pragma unroll
      for (int q = 0; q < 2; ++q) {
        const int sl = 2 * w + q;
        const uint4 vF = pVF[s2][q], vB = pVB[s2][q];
#pragma unroll
        for (int mt = 0; mt < 4; ++mt) {
          accI[mt][q] = __builtin_amdgcn_mfma_f32_16x16x32_bf16(ia[mt], as_frag(vF), accI[mt][q], 0, 0, 0);
          accI[mt][q] = __builtin_amdgcn_mfma_f32_16x16x32_bf16(ib[mt], as_frag(vB), accI[mt][q], 0, 0, 0);
        }
      }
    }
    float o[4][2][4];
#pragma unroll
    for (int mt = 0; mt < 4; ++mt)
#pragma unroll
      for (int r = 0; r < 4; ++r) {
        const int i = 16 * mt + 4 * lg + r;
        const float ef = __expf(gcf[i]), eb = __expf(gcb[63 - i]);
        float ss = 0.f;
#pragma unroll
        for (int q = 0; q < 2; ++q) {
          const float v = ef * accF[mt][q][r] + eb * accB[mt][q][r] + accI[mt][q][r];
          o[mt][q][r] = v;
          ss += v * v;
        }
        ss = group16_sum(ss);
        if (lr == 0) rowss[w * 64 + i] = ss;
      }
    __syncthreads();
#pragma unroll
    for (int mt = 0; mt < 4; ++mt)
#pragma unroll
      for (int q = 0; q < 2; ++q)
#pragma unroll
        for (int r = 0; r < 4; ++r) Os[(16 * mt + 4 * lg + r) * 132 + 16 * (2 * w + q) + lr] = o[mt][q][r];
    __syncthreads();
#pragma unroll
    for (int q4 = 0; q4 < 4; ++q4) {
      const int idx = tid + 256 * q4, i = idx >> 4, ch = idx & 15;
      const float ss = rowss[i] + rowss[64 + i] + rowss[128 + i] + rowss[192 + i];
      const float rs = rsqrtf(ss * (1.f / 128.f) + EPS);
      const float4 o0 = *(const float4*)&Os[i * 132 + ch * 8];
      const float4 o1 = *(const float4*)&Os[i * 132 + ch * 8 + 4];
      const float4 n0 = *(const float4*)(PP->dn_out_norm + layer * 128 + ch * 8);
      const float4 n1 = *(const float4*)(PP->dn_out_norm + layer * 128 + ch * 8 + 4);
      float zf[8];
      unpack8(*(const uint4*)(PP->z + (size_t)(tok0 + i) * 512 + hd * 128 + ch * 8), zf);
      float y[8];
      y[0] = o0.x * rs * n0.x * siluf_(zf[0]); y[1] = o0.y * rs * n0.y * siluf_(zf[1]);
      y[2] = o0.z * rs * n0.z * siluf_(zf[2]); y[3] = o0.w * rs * n0.w * siluf_(zf[3]);
      y[4] = o1.x * rs * n1.x * siluf_(zf[4]); y[5] = o1.y * rs * n1.y * siluf_(zf[5]);
      y[6] = o1.z * rs * n1.z * siluf_(zf[6]); y[7] = o1.w * rs * n1.w * siluf_(zf[7]);
      {
        int p0 = __builtin_amdgcn_cvt_pk_fp8_f32(y[0], y[1], 0, false);
        p0 = __builtin_amdgcn_cvt_pk_fp8_f32(y[2], y[3], p0, true);
        int p1 = __builtin_amdgcn_cvt_pk_fp8_f32(y[4], y[5], 0, false);
        p1 = __builtin_amdgcn_cvt_pk_fp8_f32(y[6], y[7], p1, true);
        *(int2*)((char*)PP->ydn + (size_t)(tok0 + i) * (LDK5 * 2) + hd * 128 + ch * 8) = make_int2(p0, p1);
      }
    }
  }
}

template <int HALF>
DEV void pool_window(const u16* xin, char* Ap, int t0, int L, int tid) {
#pragma unroll
  for (int q = 0; q < 4; ++q) {
    const int idx = tid + 256 * q, i = idx >> 4, c = idx & 15;
    const int t = t0 + i;
    const int lo = (t - HALF) > 0 ? (t - HALF) : 0;
    const int hi = (t + HALF) < L ? (t + HALF) : L;
    float s[8];
#pragma unroll
    for (int e = 0; e < 8; ++e) s[e] = 0.f;
#pragma unroll
    for (int k = 0; k < 2 * HALF; ++k) {
      float f[8];
      unpack8(*(const uint4*)(xin + (i + 8 - HALF + k) * 128 + c * 8), f);
#pragma unroll
      for (int e = 0; e < 8; ++e) s[e] += f[e];
    }
    float xs[8];
    unpack8(*(const uint4*)(xin + (i + 8) * 128 + c * 8), xs);
    const float inv = 1.f / (float)(hi - lo);
#pragma unroll
    for (int e = 0; e < 8; ++e) s[e] = s[e] * inv - xs[e];
    *(uint4*)(Ap + i * 256 + ((c ^ (i & 15)) << 4)) = pack8(s);
  }
}

__device__ __forceinline__ void phase_pool(int layer, char* smem, int vbid, int vnb) {
  const KP PP = get_params();
  const int tid = TID(), l = tid & 63, w = tid >> 6, lr = l & 15, lg = l >> 4;
  u16* xin = (u16*)smem;
  char* Ap = smem + 20480;
  char* Bs = smem + 36864;
  const int ntile = (layer == DEPTH - 1) ? NLAT / 64 : R / 64;
  for (int it = vbid; it < ntile * 4; it += vnb) {
    const int ti = it >> 2, g = it & 3;
    int L, t0, rowbase;
    if (ti < NLAT / 64) { L = 64; t0 = 0; rowbase = ti * 64; }
    else { const int ci = ti - NLAT / 64; L = CTX; t0 = (ci & 3) * 64; rowbase = NLAT + (ci >> 2) * CTX; }
    const int r0 = rowbase + t0;
    __syncthreads();
#pragma unroll
    for (int q = 0; q < 5; ++q) {
      const int idx = tid + 256 * q, i = idx >> 4, c = idx & 15;
      const int pos = t0 - 8 + i;
      uint4 v = make_uint4(0, 0, 0, 0);
      if (pos >= 0 && pos < L) v = *(const uint4*)(PP->pin + (size_t)(rowbase + pos) * 512 + g * 128 + c * 8);
      *(uint4*)(xin + i * 128 + c * 8) = v;
    }
    {
      const u16* Bw = PP->PwT + (size_t)(layer * 4 + g) * 128 * 128;
#pragma unroll
      for (int q = 0; q < 8; ++q) {
        const int idx = tid + 256 * q, n = idx >> 4, c = idx & 15;
        *(uint4*)(Bs + n * 256 + ((c ^ (n & 15)) << 4)) = *(const uint4*)(Bw + (size_t)n * 128 + c * 8);
      }
    }
    __syncthreads();
    if (g == 0) pool_window<1>(xin, Ap, t0, L, tid);
    else if (g == 1) pool_window<2>(xin, Ap, t0, L, tid);
    else if (g == 2) pool_window<4>(xin, Ap, t0, L, tid);
    else pool_window<8>(xin, Ap, t0, L, tid);
    __syncthreads();
    f32x4 acc[8];
#pragma unroll
    for (int ni = 0; ni < 8; ++ni) acc[ni] = (f32x4){0.f, 0.f, 0.f, 0.f};
#pragma unroll
    for (int ks = 0; ks < 4; ++ks) {
      const int row = w * 16 + lr, c = ks * 4 + lg;
      const bf16x8 a = *(const bf16x8*)(Ap + row * 256 + ((c ^ lr) << 4));
#pragma unroll
      for (int ni = 0; ni < 8; ++ni) {
        const bf16x8 bb = *(const bf16x8*)(Bs + (ni * 16 + lr) * 256 + ((c ^ lr) << 4));
        acc[ni] = __builtin_amdgcn_mfma_f32_16x16x32_bf16(bb, a, acc[ni], 0, 0, 0);
      }
    }
    unsigned char* ot = (unsigned char*)smem;
#pragma unroll
    for (int ni = 0; ni < 8; ++ni) {
      const int dcol = ni * 16 + 4 * lg;
      const float4 psc = *(const float4*)(PP->pool_scale + layer * 512 + g * 128 + dcol);
      int pk = __builtin_amdgcn_cvt_pk_fp8_f32(acc[ni][0] * psc.x, acc[ni][1] * psc.y, 0, false);
      pk = __builtin_amdgcn_cvt_pk_fp8_f32(acc[ni][2] * psc.z, acc[ni][3] * psc.w, pk, true);
      *(int*)(ot + (w * 16 + lr) * 128 + dcol) = pk;
    }
    __syncthreads();
    {
      const int row = tid >> 2, seg = tid & 3;
      const uint4 o0 = *(const uint4*)(ot + row * 128 + seg * 32), o1 = *(const uint4*)(ot + row * 128 + seg * 32 + 16);
      unsigned char* dst = (unsigned char*)PP->ypool + (size_t)(r0 + row) * (LDK5 * 2) + g * 128 + seg * 32;
      *(uint4*)dst = o0;
      *(uint4*)(dst + 16) = o1;
    }
  }
}

__device__ __forceinline__ void phase_merge(int layer, char* smem) {
  const KP PP = get_params();
  const char* Bd = (const char*)(PP->WdT + (size_t)layer * 1024 * LDK5);
  const char* Bp = (const char*)(PP->WpT + (size_t)layer * 1024 * LDK5);
  const char* Ad = (const char*)PP->ydn;
  const char* Ap = (const char*)PP->ypool;
  const int tid = TID();
  const int l = tid & 63, w = tid >> 6, wm = w >> 1, wn = w & 1, lr = l & 15, lg = l >> 4;
  uint4 ga[4], gb[4];
#pragma unroll
  for (int i = 0; i < 4; ++i) { ga[i] = make_uint4(0u, 0u, 0u, 0u); gb[i] = ga[i]; }
  const int r0 = tid >> 3, c0 = tid & 7;
#define MG_GLOAD(AP, BP, KT_)                                                                  \
  _Pragma("unroll") for (int i = 0; i < 4; ++i) {                                              \
    ga[i] = *(const uint4*)((AP) + (size_t)(m0 + 32 * i + r0) * (LDK5 * 2) + c0 * 16 + (KT_) * 128);  \
    gb[i] = *(const uint4*)((BP) + (size_t)(n0 + 32 * i + r0) * LDK5 + c0 * 16 + (KT_) * 128);        \
  }
#define MG_LSTORE(BUF)                                                                         \
  {                                                                                            \
    char* as_ = smem + (BUF) * 32768;                                                          \
    char* bs_ = as_ + 16384;                                                                   \
    _Pragma("unroll") for (int i = 0; i < 4; ++i) {                                            \
      const int id = tid + 256 * i, row = id >> 3, c = id & 7;                                 \
      const int off = row * 128 + ((c ^ (row & 7)) << 4);                                      \
      *(uint4*)(as_ + off) = ga[i];                                                            \
      *(uint4*)(bs_ + off) = gb[i];                                                            \
    }                                                                                          \
  }
#define MG_COMPUTE(ACC, BUF)                                                                                              \
  {                                                                                                                       \
    const char* as_ = smem + (BUF) * 32768;                                                                               \
    const char* bs_ = as_ + 16384;                                                                                        \
    i32x8 a[4], b[4];                                                                                                     \
    const int sw0 = ((lg ^ (lr & 7)) << 4), sw1 = (((4 + lg) ^ (lr & 7)) << 4);                                           \
    _Pragma("unroll") for (int mi = 0; mi < 4; ++mi) {                                                                    \
      const char* p_ = as_ + (wm * 64 + mi * 16 + lr) * 128;                                                              \
      const i32x4 lo_ = *(const i32x4*)(p_ + sw0), hi_ = *(const i32x4*)(p_ + sw1);                                       \
      a[mi] = __builtin_shufflevector(lo_, hi_, 0, 1, 2, 3, 4, 5, 6, 7);                                                  \
    }                                                                                                                     \
    _Pragma("unroll") for (int ni = 0; ni < 4; ++ni) {                                                                    \
      const char* p_ = bs_ + (wn * 64 + ni * 16 + lr) * 128;                                                              \
      const i32x4 lo_ = *(const i32x4*)(p_ + sw0), hi_ = *(const i32x4*)(p_ + sw1);                                       \
      b[ni] = __builtin_shufflevector(lo_, hi_, 0, 1, 2, 3, 4, 5, 6, 7);                                                  \
    }                                                                                                                     \
    _Pragma("unroll") for (int mi = 0; mi < 4; ++mi)                                                                      \
      _Pragma("unroll") for (int ni = 0; ni < 4; ++ni)                                                                    \
        ACC[mi][ni] = __builtin_amdgcn_mfma_scale_f32_16x16x128_f8f6f4(a[mi], b[ni], ACC[mi][ni], 0, 0, 0, 0, 0, 0);      \
  }
  const int MT = (layer == DEPTH - 1) ? NLAT / 128 : R / 128;
  for (int it = 0;; ++it) {
    int mt, nt;
    if (!tile_map(it, MT, 8, mt, nt)) break;
    const int m0 = mt * 128, n0 = nt * 128;
    f32x4 acc[4][4];
    zero_acc(acc);
    __syncthreads();
    MG_GLOAD(Ad, Bd, 0);
    MG_LSTORE(0);
    __syncthreads();
#pragma unroll
    for (int kt = 0; kt < 4; ++kt) {
      if (kt + 1 < 4) { MG_GLOAD(Ad, Bd, kt + 1); } else { MG_GLOAD(Ap, Bp, 0); }
      MG_COMPUTE(acc, kt & 1);
      MG_LSTORE((kt + 1) & 1);
      __syncthreads();
    }
    uint2 tq[2][8];
#pragma unroll
    for (int hs = 0; hs < 2; ++hs)
#pragma unroll
      for (int j = 0; j < 8; ++j) tq[hs][j] = make_uint2(0u, 0u);
#pragma unroll
    for (int hs = 0; hs < 2; ++hs) {
      float4 v1[8];
      stage_half(acc, hs, smem + 32768, v1);
#pragma unroll
      for (int j = 0; j < 8; ++j) tq[hs][j] = make_uint2(pack_bf16(v1[j].x, v1[j].y), pack_bf16(v1[j].z, v1[j].w));
    }
    __builtin_amdgcn_sched_barrier(0);
    zero_acc(acc);
    __syncthreads();
#pragma unroll
    for (int kt = 0; kt < 4; ++kt) {
      if (kt + 1 < 4) { MG_GLOAD(Ap, Bp, kt + 1); }
      MG_COMPUTE(acc, kt & 1);
      if (kt + 1 < 4) { MG_LSTORE((kt + 1) & 1); }
      __syncthreads();
    }
#pragma unroll
    for (int hs = 0; hs < 2; ++hs) {
      float4 v2[8];
      stage_half(acc, hs, smem, v2);
      const int tid2 = TID();
#pragma unroll
      for (int j = 0; j < 8; ++j) {
        const int idx = tid2 + 256 * j, row = idx >> 5, c4 = idx & 31;
        const size_t gr = (size_t)(m0 + hs * 64 + row);
        const int gc = n0 + c4 * 4;
        const unsigned gd = *(const unsigned*)((const unsigned char*)PP->sgd + gr * 1024 + gc);
        const unsigned gp = *(const unsigned*)((const unsigned char*)PP->sgp + gr * 1024 + gc);
        const uint2 t = tq[hs][j];
        constexpr float GS = 1.f / (255.f * 32.f);
        const float o0 = ((float)(gd & 0xffu) * bf_lo(t.x) + (float)(gp & 0xffu) * v2[j].x) * GS;
        const float o1 = ((float)((gd >> 8) & 0xffu) * bf_hi(t.x) + (float)((gp >> 8) & 0xffu) * v2[j].y) * GS;
        const float o2 = ((float)((gd >> 16) & 0xffu) * bf_lo(t.y) + (float)((gp >> 16) & 0xffu) * v2[j].z) * GS;
        const float o3 = ((float)(gd >> 24) * bf_hi(t.y) + (float)(gp >> 24) * v2[j].w) * GS;
        int pk = __builtin_amdgcn_cvt_pk_fp8_f32(o0, o1, 0, false);
        pk = __builtin_amdgcn_cvt_pk_fp8_f32(o2, o3, pk, true);
        *(int*)((char*)PP->m + gr * (LDK1 * 2) + gc) = pk;
        if ((j & 1) == 1) __builtin_amdgcn_sched_barrier(0);
      }
    }
  }
#undef MG_GLOAD
#undef MG_LSTORE
#undef MG_COMPUTE
}

__device__ __forceinline__ void phase_outproj(int layer, char* smem) {
  const KP PP = get_params();
  const char* Bt = (const char*)(PP->WoT + (size_t)layer * 1024 * LDK1);
  const char* A = (const char*)PP->m;
  F8_LOCALS
  const int MT = (layer == DEPTH - 1) ? NLAT / 128 : R / 128;
  int it = 0, mt, nt;
  if (!tile_map(it, MT, 8, mt, nt)) return;
  int m0 = mt * 128, n0 = nt * 128;
  F8_PROLOGUE(A, LDK1 * 2, Bt, LDK1)
  for (;;) {
    int mtn = 0, ntn = 0;
    const bool hasn = tile_map(it + 1, MT, 8, mtn, ntn);
    const int m0n = mtn * 128, n0n = ntn * 128;
    f32x4 acc[4][4];
    zero_acc(acc);
    F8_KLOOP(A, LDK1 * 2, Bt, LDK1, 8)
#pragma unroll
    for (int mi = 0; mi < 4; ++mi) {
      const int gr = m0 + wm * 64 + mi * 16 + lr;
      const float* modp = PP->mod + (size_t)(layer * 3 + modsel(gr)) * 6144 + 2048;
      const float* xin;
      float* xo;
      if (gr < NLAT) {
        xin = (layer == 0 ? PP->x : PP->out) + (size_t)gr * 1024;
        xo = PP->out + (size_t)gr * 1024;
      } else {
        xin = (layer == 0 ? PP->ctx : PP->xc) + (size_t)(gr - NLAT) * 1024;
        xo = PP->xc + (size_t)(gr - NLAT) * 1024;
      }
#pragma unroll
      for (int g = 0; g < 2; ++g) {
        const int gc = n0 + wn * 64 + g * 32 + 8 * lg;
#pragma unroll
        for (int n = 0; n < 2; ++n) {
          const f32x4 t = acc[mi][2 * g + n] * (1.f / 32.f);
          const float4 gt = *(const float4*)(modp + gc + 4 * n);
          const float4 xi = *(const float4*)(xin + gc + 4 * n);
          *(float4*)(xo + gc + 4 * n) = make_float4(xi.x + gt.x * t[0], xi.y + gt.y * t[1], xi.z + gt.z * t[2], xi.w + gt.w * t[3]);
        }
      }
    }
    if (!hasn) break;
    m0 = m0n; n0 = n0n; ++it;
  }
}

DEV void gemm_mainloop_f8(const char* __restrict__ A, int lda, const char* __restrict__ B, int ldb, int KT, int m0, int n0,
                          char* smem, f32x4 (&acc)[4][4]) {
  const int tid = TID();
  const int l = tid & 63, w = tid >> 6, wm = w >> 1, wn = w & 1, lr = l & 15, lg = l >> 4;
  uint4 ga0[4], gb0[4], ga1[4], gb1[4];
#pragma unroll
  for (int i = 0; i < 4; ++i) { ga0[i] = make_uint4(0u, 0u, 0u, 0u); gb0[i] = ga0[i]; ga1[i] = ga0[i]; gb1[i] = ga0[i]; }
  const int r0 = tid >> 3, c0 = tid & 7;
#define Q8_GLOAD(GA, GB, KT_)                                                                  \
  _Pragma("unroll") for (int i = 0; i < 4; ++i) {                                              \
    GA[i] = *(const uint4*)(A + (size_t)(m0 + 32 * i + r0) * lda + c0 * 16 + (KT_) * 128);     \
    GB[i] = *(const uint4*)(B + (size_t)(n0 + 32 * i + r0) * ldb + c0 * 16 + (KT_) * 128);     \
  }
#define Q8_LSTORE(GA, GB, BUF)                                                                 \
  {                                                                                            \
    char* as_ = smem + (BUF) * 32768;                                                          \
    char* bs_ = as_ + 16384;                                                                   \
    _Pragma("unroll") for (int i = 0; i < 4; ++i) {                                            \
      const int id = tid + 256 * i, row = id >> 3, c = id & 7;                                 \
      const int off = row * 128 + ((c ^ (row & 7)) << 4);                                      \
      *(uint4*)(as_ + off) = GA[i];                                                            \
      *(uint4*)(bs_ + off) = GB[i];                                                            \
    }                                                                                          \
  }
#define Q8_COMPUTE(BUF)                                                                                                   \
  {                                                                                                                       \
    const char* as_ = smem + (BUF) * 32768;                                                                               \
    const char* bs_ = as_ + 16384;                                                                                        \
    i32x8 a[4], b[4];                                                                                                     \
    const int sw0 = ((lg ^ (lr & 7)) << 4), sw1 = (((4 + lg) ^ (lr & 7)) << 4);                                           \
    _Pragma("unroll") for (int mi = 0; mi < 4; ++mi) {                                                                    \
      const char* p_ = as_ + (wm * 64 + mi * 16 + lr) * 128;                                                              \
      const i32x4 lo_ = *(const i32x4*)(p_ + sw0), hi_ = *(const i32x4*)(p_ + sw1);                                       \
      a[mi] = __builtin_shufflevector(lo_, hi_, 0, 1, 2, 3, 4, 5, 6, 7);                                                  \
    }                                                                                                                     \
    _Pragma("unroll") for (int ni = 0; ni < 4; ++ni) {                                                                    \
      const char* p_ = bs_ + (wn * 64 + ni * 16 + lr) * 128;                                                              \
      const i32x4 lo_ = *(const i32x4*)(p_ + sw0), hi_ = *(const i32x4*)(p_ + sw1);                                       \
      b[ni] = __builtin_shufflevector(lo_, hi_, 0, 1, 2, 3, 4, 5, 6, 7);                                                  \
    }                                                                                                                     \
    _Pragma("unroll") for (int mi = 0; mi < 4; ++mi)                                                                      \
      _Pragma("unroll") for (int ni = 0; ni < 4; ++ni)                                                                    \
        acc[mi][ni] = __builtin_amdgcn_mfma_scale_f32_16x16x128_f8f6f4(a[mi], b[ni], acc[mi][ni], 0, 0, 0, 0, 0, 0);      \
  }
  __syncthreads();
  Q8_GLOAD(ga0, gb0, 0);
  Q8_GLOAD(ga1, gb1, 1);
  Q8_LSTORE(ga0, gb0, 0);
  __syncthreads();
  for (int kt = 0; kt < KT; kt += 2) {
    if (kt + 2 < KT) { Q8_GLOAD(ga0, gb0, kt + 2); }
    Q8_COMPUTE(0);
    Q8_LSTORE(ga1, gb1, 1);
    __syncthreads();
    if (kt + 3 < KT) { Q8_GLOAD(ga1, gb1, kt + 3); }
    Q8_COMPUTE(1);
    if (kt + 2 < KT) { Q8_LSTORE(ga0, gb0, 0); }
    __syncthreads();
  }
#undef Q8_GLOAD
#undef Q8_LSTORE
#undef Q8_COMPUTE
}

__device__ __forceinline__ void phase_peerq(int layer, char* smem) {
  const KP PP = get_params();
  const char* Bt = (const char*)PP->WkT + (size_t)layer * 2048 * LDK1;
  const int tid = TID();
  const int l = tid & 63, w = tid >> 6, wm = w >> 1, wn = w & 1, lr = l & 15, lg = l >> 4;
  const int MT = (layer == DEPTH - 1) ? NLAT / 128 : R / 128;
  for (int it = 0;; ++it) {
    int mt, nt;
    if (!tile_map(it, MT, 16, mt, nt)) break;
    const int m0 = mt * 128, n0 = nt * 128;
    f32x4 sc[4][4];
    zero_acc(sc);
    gemm_mainloop_f8((const char*)PP->h8, LDK1, Bt, LDK1, 8, m0, n0, smem, sc);
    __syncthreads();
    float* Sc = (float*)smem;
#pragma unroll
    for (int mi = 0; mi < 4; ++mi)
#pragma unroll
      for (int ni = 0; ni < 4; ++ni)
#pragma unroll
        for (int r = 0; r < 4; ++r) Sc[(wm * 64 + mi * 16 + lg * 4 + r) * 129 + wn * 64 + ni * 16 + lr] = sc[mi][ni][r] * (1.f / 32.f);
    __syncthreads();
    {
      const int row = tid >> 1, half = tid & 1;
      const float* rowp = Sc + row * 129;
      unsigned key[64];
#pragma unroll
      for (int i = 0; i < 64; ++i) {
        unsigned u = __float_as_uint(rowp[half * 64 + i]);
        u = (u & 0x80000000u) ? ~u : (u | 0x80000000u);
        key[i] = (u & ~127u) | (unsigned)(127 - (half * 64 + i));
      }
#define CMPX(X, Y, DESC) { const unsigned hi_ = (X) > (Y) ? (X) : (Y), lo_ = (X) > (Y) ? (Y) : (X); X = (DESC) ? hi_ : lo_; Y = (DESC) ? lo_ : hi_; }
#pragma unroll
      for (int g0 = 0; g0 < 64; g0 += 16) {
#pragma unroll
        for (int k = 2; k <= 16; k <<= 1)
#pragma unroll
          for (int j = k >> 1; j > 0; j >>= 1)
#pragma unroll
            for (int i = 0; i < 16; ++i) {
              const int l2 = i ^ j;
              if (l2 > i) CMPX(key[g0 + i], key[g0 + l2], ((i & k) == 0));
            }
      }
#define TOPMERGE(AOFF, BOFF)                                                                         \
  {                                                                                                  \
    _Pragma("unroll") for (int i = 0; i < 16; ++i)                                                   \
      key[(AOFF) + i] = key[(AOFF) + i] > key[(BOFF) + 15 - i] ? key[(AOFF) + i] : key[(BOFF) + 15 - i]; \
    _Pragma("unroll") for (int j = 8; j > 0; j >>= 1)                                                \
      _Pragma("unroll") for (int i = 0; i < 16; ++i) {                                               \
        const int l2 = i ^ j;                                                                        \
        if (l2 > i) CMPX(key[(AOFF) + i], key[(AOFF) + l2], true);                                   \
      }                                                                                              \
  }
      TOPMERGE(0, 16);
      TOPMERGE(32, 48);
      TOPMERGE(0, 32);
      {
        unsigned oth[16];
#pragma unroll
        for (int i = 0; i < 16; ++i) oth[i] = swz_xor_u<1>(key[i]);
#pragma unroll
        for (int i = 0; i < 16; ++i) key[i] = key[i] > oth[15 - i] ? key[i] : oth[15 - i];
#pragma unroll
        for (int j = 8; j > 0; j >>= 1)
#pragma unroll
          for (int i = 0; i < 16; ++i) {
            const int l2 = i ^ j;
            if (l2 > i) CMPX(key[i], key[l2], true);
          }
      }
#undef TOPMERGE
#undef CMPX
      unsigned res[16];
#pragma unroll
      for (int j = 0; j < 16; ++j) {
        const int idx = 127 - (int)(key[j] & 127u);
        res[j] = half ? (unsigned)idx : __float_as_uint(rowp[idx]);
      }
      const size_t ob = ((size_t)(m0 + row) * 16 + nt) * 16;
      uint4* dst = half ? (uint4*)(PP->topI + ob) : (uint4*)(PP->topS + ob);
      dst[0] = make_uint4(res[0], res[1], res[2], res[3]);
      dst[1] = make_uint4(res[4], res[5], res[6], res[7]);
      dst[2] = make_uint4(res[8], res[9], res[10], res[11]);
      dst[3] = make_uint4(res[12], res[13], res[14], res[15]);
    }
  }
}

DEV void pair_of_lane(int l, int& a, int& b) {
  if (l < 16) { a = 0; b = l; }
  else if (l < 24) { a = 1; b = l - 16; }
  else if (l < 29) { a = 2; b = l - 24; }
  else if (l < 33) { a = 3; b = l - 29; }
  else if (l < 36) { a = 4; b = l - 33; }
  else if (l < 38) { a = 5; b = l - 36; }
  else if (l < 40) { a = 6; b = l - 38; }
  else if (l < 42) { a = 7; b = l - 40; }
  else if (l < 50) { a = l - 34; b = 0; }
  else { a = 0; b = 0; }
}

DEV float peer_butterfly(const float (&part)[8], int lane) {
  const bool h32 = (lane & 32) != 0, h16 = (lane & 16) != 0, h8 = (lane & 8) != 0;
  const int a32 = (lane ^ 32) << 2;
  float q4[4], q2[2];
#pragma unroll
  for (int i = 0; i < 4; ++i) {
    const float keep = h32 ? part[i + 4] : part[i], send = h32 ? part[i] : part[i + 4];
    q4[i] = keep + __builtin_bit_cast(float, __builtin_amdgcn_ds_bpermute(a32, __builtin_bit_cast(int, send)));
  }
#pragma unroll
  for (int i = 0; i < 2; ++i) {
    const float keep = h16 ? q4[i + 2] : q4[i], send = h16 ? q4[i] : q4[i + 2];
    q2[i] = keep + swz_xor<16>(send);
  }
  const float keep = h8 ? q2[1] : q2[0], send = h8 ? q2[0] : q2[1];
  float q1 = keep + swz_xor<8>(send);
  q1 += swz_xor<4>(q1);
  q1 += swz_xor<2>(q1);
  q1 += swz_xor<1>(q1);
  return q1;
}

__device__ __forceinline__ void phase_peer(int layer, char* smem) {
  const KP PP = get_params();
  const int tid = TID(), lane = tid & 63, wv = tid >> 6;
  const int gw = BID() * 4 + wv, nw = gridDim.x * 4;
  int* elist = (int*)(smem + wv * 2048);
  float* glist = (float*)(elist + 128);
  const bool last = (layer == DEPTH - 1);
  const int rlim = last ? NLAT : R;
  int pa, pb;
  pair_of_lane(lane, pa, pb);
  for (int r = gw; r < rlim; r += nw) {
    f32x2 hp[8];
#pragma unroll
    for (int i = 0; i < 4; ++i) {
      const uint2 hv = *(const uint2*)(PP->h + (size_t)r * LDK1 + 4 * lane + 256 * i);
      hp[2 * i] = (f32x2){bf_lo(hv.x), bf_hi(hv.x)};
      hp[2 * i + 1] = (f32x2){bf_lo(hv.y), bf_hi(hv.y)};
    }
#ifndef PEER_REP
#define PEER_REP 1
#endif
    f32x2 out[8];
#pragma unroll
    for (int i = 0; i < 8; ++i) out[i] = (f32x2){0.f, 0.f};
#pragma nounroll
    for (int rep_ = 0; rep_ < PEER_REP; ++rep_) {
    float sreg[8];
    int ireg[8];
#pragma unroll
    for (int hh = 0; hh < 8; ++hh) {
      const size_t o = (size_t)r * 256 + hh * 32 + (lane & 31);
      sreg[hh] = PP->topS[o];
      ireg[hh] = PP->topI[o];
    }
#pragma unroll 2
    for (int hh = 0; hh < 8; ++hh) {
      float cs = __builtin_bit_cast(float, __builtin_amdgcn_ds_bpermute(pa << 2, __builtin_bit_cast(int, sreg[hh]))) +
                 __builtin_bit_cast(float, __builtin_amdgcn_ds_bpermute((16 + pb) << 2, __builtin_bit_cast(int, sreg[hh])));
      const int e = __builtin_amdgcn_ds_bpermute(pa << 2, ireg[hh]) * 128 + __builtin_amdgcn_ds_bpermute((16 + pb) << 2, ireg[hh]);
      if (lane >= 50) cs = -__builtin_inff();
      unsigned ku = __float_as_uint(cs);
      ku = (ku & 0x80000000u) ? ~ku : (ku | 0x80000000u);
      ku = (ku & ~63u) | (unsigned)(63 - lane);
      int rank = 0;
#pragma unroll
      for (int l2 = 0; l2 < 50; ++l2) {
        const unsigned kv = (unsigned)__builtin_amdgcn_readlane((int)ku, l2);
        rank += (kv > ku) ? 1 : 0;
      }
      const bool sel = (lane < 50) && (rank < 16);
      const float mx = __builtin_bit_cast(float, __builtin_amdgcn_readlane(__builtin_bit_cast(int, cs), 0));
      const float ex = sel ? __expf(cs - mx) : 0.f;
      const float sum = wave_sum(ex);
      const unsigned long long mask = __ballot(sel);
      if (sel) {
        const int pos = __builtin_popcountll(mask & ((1ull << lane) - 1ull));
        elist[hh * 16 + pos] = e;
        glist[hh * 16 + pos] = ex / sum;
      }
    }
    __builtin_amdgcn_wave_barrier();
    asm volatile("s_waitcnt lgkmcnt(0)" ::: "memory");
    for (int k0 = 0; k0 < 128; k0 += 8) {
      U3 ua[8], va[8];
#pragma unroll
      for (int b = 0; b < 8; ++b) {
        const int ek = __builtin_amdgcn_readfirstlane(elist[k0 + b]);
        ua[b] = *(const U3*)(PP->tab8U + (size_t)ek * TROW + lane * 12);
        va[b] = *(const U3*)(PP->tab8V + (size_t)ek * TROW + lane * 12);
      }
      const int eb = elist[k0 + (lane >> 3)];
      const float scu = PP->scU[eb], scv = PP->scV[eb];
      float part[8];
#pragma unroll
      for (int b = 0; b < 8; b += 2) {
        const u32x6_t s6 = {ua[b].a, ua[b].b, ua[b].c, ua[b + 1].a, ua[b + 1].b, ua[b + 1].c};
        const f32x32_t uf = __builtin_amdgcn_cvt_scalef32_pk32_f32_fp6(s6, 1.0f);
        f32x2 d0 = (f32x2){uf[0], uf[1]} * hp[0];
        f32x2 d1 = (f32x2){uf[16], uf[17]} * hp[0];
#pragma unroll
        for (int p = 1; p < 8; ++p) {
          d0 += (f32x2){uf[2 * p], uf[2 * p + 1]} * hp[p];
          d1 += (f32x2){uf[16 + 2 * p], uf[17 + 2 * p]} * hp[p];
        }
        part[b] = d0[0] + d0[1];
        part[b + 1] = d1[0] + d1[1];
      }
      float q1 = peer_butterfly(part, lane);
      q1 *= scu;
      const float act = scv * glist[k0 + (lane >> 3)] * 0.5f * q1 * (1.f + erff(q1 * 0.7071067811865475f));
#pragma unroll
      for (int b = 0; b < 8; b += 2) {
        const float ab0 = __builtin_bit_cast(float, __builtin_amdgcn_readlane(__builtin_bit_cast(int, act), b * 8));
        const float ab1 = __builtin_bit_cast(float, __builtin_amdgcn_readlane(__builtin_bit_cast(int, act), b * 8 + 8));
        const f32x2 a0 = {ab0, ab0}, a1 = {ab1, ab1};
        const u32x6_t s6 = {va[b].a, va[b].b, va[b].c, va[b + 1].a, va[b + 1].b, va[b + 1].c};
        const f32x32_t vf = __builtin_amdgcn_cvt_scalef32_pk32_f32_fp6(s6, 1.0f);
#pragma unroll
        for (int p = 0; p < 8; ++p) {
          out[p] += a0 * (f32x2){vf[2 * p], vf[2 * p + 1]};
          out[p] += a1 * (f32x2){vf[16 + 2 * p], vf[17 + 2 * p]};
        }
      }
    }
    __builtin_amdgcn_wave_barrier();
    }
    if (PEER_REP > 1) {
#pragma unroll
      for (int i = 0; i < 8; ++i) out[i] *= (1.f / PEER_REP);
    }
    const float* md = PP->mod + (size_t)(layer * 3 + modsel(r)) * 6144 + 5 * 1024;
    float* xr = (r < NLAT) ? PP->out + (size_t)r * 1024 : PP->xc + (size_t)(r - NLAT) * 1024;
    float4 x2[4];
    float ss = 0.f;
#pragma unroll
    for (int i = 0; i < 4; ++i) {
      const int col = 4 * lane + 256 * i;
      const float4 xa = *(const float4*)(xr + col);
      const float4 ga = *(const float4*)(md + col);
      x2[i] = make_float4(xa.x + ga.x * out[2 * i][0], xa.y + ga.y * out[2 * i][1], xa.z + ga.z * out[2 * i + 1][0],
                          xa.w + ga.w * out[2 * i + 1][1]);
      ss += x2[i].x * x2[i].x + x2[i].y * x2[i].y + x2[i].z * x2[i].z + x2[i].w * x2[i].w;
    }
    if (last) {
      ss = wave_sum(ss);
      const float rs = rsqrtf(ss * (1.f / 1024.f) + EPS);
#pragma unroll
      for (int i = 0; i < 4; ++i) {
        const float4 fa = *(const float4*)(PP->final_norm + 4 * lane + 256 * i);
        x2[i] = make_float4(x2[i].x * rs * fa.x, x2[i].y * rs * fa.y, x2[i].z * rs * fa.z, x2[i].w * rs * fa.w);
      }
    }
#pragma unroll
    for (int i = 0; i < 4; ++i) *(float4*)(xr + 4 * lane + 256 * i) = x2[i];
    if (!last) {
      ss = wave_sum(ss);
      const float rs = rsqrtf(ss * (1.f / 1024.f) + EPS);
      const float* nwt = PP->norm_mix + (layer + 1) * 1024;
      const float* md1 = PP->mod + (size_t)((layer + 1) * 3 + modsel(r)) * 6144;
#pragma unroll
      for (int i = 0; i < 4; ++i) {
        const int col = 4 * lane + 256 * i;
        const float4 wv = *(const float4*)(nwt + col);
        const float4 sh = *(const float4*)(md1 + col);
        const float4 sc = *(const float4*)(md1 + 1024 + col);
        const float y0 = x2[i].x * rs * wv.x * (1.f + sc.x) + sh.x;
        const float y1 = x2[i].y * rs * wv.y * (1.f + sc.y) + sh.y;
        const float y2 = x2[i].z * rs * wv.z * (1.f + sc.z) + sh.z;
        const float y3 = x2[i].w * rs * wv.w * (1.f + sc.w) + sh.w;
        int pk = __builtin_amdgcn_cvt_pk_fp8_f32(y0, y1, 0, false);
        pk = __builtin_amdgcn_cvt_pk_fp8_f32(y2, y3, pk, true);
        *(int*)((char*)PP->h + (size_t)r * (LDK1 * 2) + col) = pk;
      }
    }
  }
}

namespace cg = cooperative_groups;

#define XB_TMO      128
#define XB_XCNT(j)  (256  + 64 * (j))
#define XB_XSUB(j)  (1280 + 64 * (j))
#define XB_XGEN(j)  (2304 + 64 * (j))
#define XB_TOP      3328
#define XB_TOPGEN   3392
#define XCD_BAR_WORDS 3456
#define XB_SPIN_CAP (1u << 22)
#define LAS __attribute__((address_space(3)))
DEV unsigned xb_ld(unsigned* q) { return __hip_atomic_load(q, __ATOMIC_RELAXED, __HIP_MEMORY_SCOPE_AGENT); }
DEV unsigned xb_add(unsigned* q, unsigned v) { return __hip_atomic_fetch_add(q, v, __ATOMIC_RELAXED, __HIP_MEMORY_SCOPE_AGENT); }
DEV unsigned xb_xcc_id() { return (unsigned)__builtin_amdgcn_s_getreg((3 << 11) | 20) & 0xFu; }
#define XB_SPIN(cond, bar) do { unsigned _sp = 0; while (cond) { __builtin_amdgcn_s_sleep(1); \
    if ((++_sp & 255u) == 0u) { if (xb_ld(&(bar)[XB_TMO])) break; if (_sp > XB_SPIN_CAP) { atomicAdd(&(bar)[XB_TMO], 1u); break; } } } } while (0)
struct XcdBarrier { unsigned* bar; unsigned x; volatile LAS unsigned* st; };
DEV XcdBarrier xcd_barrier_post(unsigned* bar, volatile LAS unsigned* st) {
  XcdBarrier b; b.bar = bar; b.x = xb_xcc_id(); b.st = st;
  if (__builtin_amdgcn_workitem_id_x() == 0) (void)xb_add(&bar[XB_XCNT(b.x)], 1u);
  return b;
}
DEV void xcd_barrier_complete(unsigned* bar, unsigned x, unsigned& nloc, unsigned& nx) {
  const unsigned G = gridDim.x * gridDim.y * gridDim.z;
  unsigned sum, cnt, mine, sp = 0u;
  for (;;) {
    sum = 0u; cnt = 0u; mine = 0u;
#pragma unroll
    for (unsigned j = 0; j < 16; ++j) { const unsigned c = xb_ld(&bar[XB_XCNT(j)]); sum += c; cnt += (c > 0u) ? 1u : 0u; mine = (j == x) ? c : mine; }
    if (sum == G) break;
    __builtin_amdgcn_s_sleep(1);
    if ((++sp & 255u) == 0u) { if (xb_ld(&bar[XB_TMO])) break; if (sp > XB_SPIN_CAP) { atomicAdd(&bar[XB_TMO], 1u); break; } }
  }
  nloc = mine > 0u ? mine : 1u; nx = cnt > 0u ? cnt : 1u;
}
DEV void xcd_barrier(const XcdBarrier& b) {
  asm volatile("s_waitcnt vmcnt(0)" ::: "memory");
  __syncthreads();
  if (__builtin_amdgcn_workitem_id_x() == 0) {
    unsigned* bar = b.bar;
    __builtin_amdgcn_s_waitcnt(0);
    unsigned nloc = b.st[0], nx = b.st[1];
    if (nloc == 0u) { xcd_barrier_complete(bar, b.x, nloc, nx); b.st[0] = nloc; b.st[1] = nx; }
    const unsigned old = xb_add(&bar[XB_XSUB(b.x)], 1u);
    const unsigned gen = old / nloc;
    if (old + 1u == (gen + 1u) * nloc) {
      __builtin_amdgcn_fence(__ATOMIC_RELEASE, "agent");
      asm volatile("s_waitcnt vmcnt(0)" ::: "memory");
      const unsigned og = xb_add(&bar[XB_TOP], 1u);
      const unsigned tg = og / nx;
      if (og + 1u == (tg + 1u) * nx) xb_add(&bar[XB_TOPGEN], 1u);
      else XB_SPIN(xb_ld(&bar[XB_TOPGEN]) == tg, bar);
      __builtin_amdgcn_fence(__ATOMIC_ACQUIRE, "agent");
      xb_add(&bar[XB_XGEN(b.x)], 1u);
      asm volatile("s_waitcnt vmcnt(0)" ::: "memory");
    } else {
      XB_SPIN(xb_ld(&bar[XB_XGEN(b.x)]) == gen, bar);
      __builtin_amdgcn_fence(__ATOMIC_ACQUIRE, "agent");
      asm volatile("s_waitcnt vmcnt(0)" ::: "memory");
    }
  }
  __syncthreads();
}

#define GRID_SYNC() do { XcdBarrier xb_; xb_.bar = get_params()->bar; xb_.x = xb_xcc_id(); xb_.st = (volatile LAS unsigned*)&xb_words; xcd_barrier(xb_); } while (0)

__global__ void __launch_bounds__(NTHR, 2) megakernel(Params p) {
  __shared__ __attribute__((aligned(16))) char smem[SMEM_BYTES];
  __shared__ uint4 xb_words;
  if (__builtin_amdgcn_workitem_id_x() == 0) xb_words = make_uint4(0u, 0u, 0u, 0u);
  __syncthreads();
  (void)xcd_barrier_post(get_params()->bar, (volatile LAS unsigned*)&xb_words);
#ifndef PM
#define PM 0xFFFF
#endif
#ifndef DUP
#define DUP 0
#endif
  if (PM & 1) phase_init(smem);
  if (DUP & 1) phase_init(smem);
  GRID_SYNC();
  for (int layer = 0; layer < DEPTH; ++layer) {
    if (layer == 0) {
      if (PM & 2) phase_norm(layer, 1);
      if (DUP & 2) phase_norm(layer, 1);
      GRID_SYNC();
    }
    if (PM & 4) phase_gemm_win(layer, smem);
    if (DUP & 4) phase_gemm_win(layer, smem);
    GRID_SYNC();
#ifndef PREP_REP
#define PREP_REP 1
#endif
#pragma nounroll
    for (int rep_ = 0; rep_ < PREP_REP; ++rep_) phase_prep(layer, smem);
    GRID_SYNC();
    {
      const int nb_ = gridDim.x;
      if (BID() < 128) { if (PM & 64) phase_scan(smem); }
      else {
        if (PM & 16) phase_pool(layer, smem, BID() - 128, nb_ - 128);
        if (PM & 256) phase_tables(layer, BID() - 128, nb_ - 128);
      }
    }
    GRID_SYNC();
    if (PM & 128) phase_o(layer, smem);
    if (DUP & 128) phase_o(layer, smem);
    GRID_SYNC();
    if (PM & 512) phase_merge(layer, smem);
    if (DUP & 512) phase_merge(layer, smem);
    GRID_SYNC();
    if (PM & 1024) phase_outproj(layer, smem);
    GRID_SYNC();
    if (PM & 2048) phase_norm(layer, 2);
    if (DUP & 2048) phase_norm(layer, 2);
    GRID_SYNC();
    if (PM & 4096) phase_peerq(layer, smem);
    if (DUP & 4096) phase_peerq(layer, smem);
    GRID_SYNC();
    if (PM & 8192) phase_peer(layer, smem);
    if (layer + 1 < DEPTH) GRID_SYNC();
  }
}

static inline size_t align_up(size_t v, size_t a) { return (v + a - 1) / a * a; }

extern "C" void kernel_launch(void* const* d_in, const int* in_sizes, int n_in, void* d_out, int out_size, void* d_ws,
                              size_t ws_size, hipStream_t stream) {
  Params p{};
  p.x = (const float*)d_in[0]; p.c = (const float*)d_in[1]; p.ctx = (const float*)d_in[2]; p.c_ctx = (const float*)d_in[3];
  p.w_mod = (const float*)d_in[4]; p.b_mod = (const float*)d_in[5]; p.norm_mix = (const float*)d_in[6]; p.w_in = (const float*)d_in[7];
  p.conv_w = (const float*)d_in[8]; p.a_log = (const float*)d_in[9]; p.dt_bias = (const float*)d_in[10];
  p.dn_out_norm = (const float*)d_in[11]; p.pool_w = (const float*)d_in[12]; p.pool_scale = (const float*)d_in[13];
  p.w_up_dn = (const float*)d_in[14]; p.w_up_pool = (const float*)d_in[15]; p.w_out = (const float*)d_in[16];
  p.norm_ffn = (const float*)d_in[17]; p.peer_wq = (const float*)d_in[18]; p.peer_keys = (const float*)d_in[19];
  p.peer_u = (const float*)d_in[20]; p.peer_v = (const float*)d_in[21]; p.final_norm = (const float*)d_in[22];
  p.out = (float*)d_out;

  char* ws = (char*)d_ws;
  size_t off = 0;
  auto take = [&](size_t bytes) { char* q = ws + off; off = align_up(off + bytes, 256); return q; };
  p.tab8U = (unsigned char*)take((size_t)NEXP * 1024);
  p.tab8V = (unsigned char*)take((size_t)NEXP * 1024);
  p.scU = (float*)take((size_t)NEXP * 4);
  p.scV = (float*)take((size_t)NEXP * 4);
  p.WinT = (u16*)take((size_t)DEPTH * NPAD * LDK1 * 2);
  p.WdT = (u16*)take((size_t)DEPTH * 1024 * LDK5 * 2);
  p.WpT = (u16*)take((size_t)DEPTH * 1024 * LDK5 * 2);
  p.WoT = (u16*)take((size_t)DEPTH * 1024 * LDK1 * 2);
  p.WkT = (u16*)take((size_t)DEPTH * 2048 * LDK1 * 2);
  p.PwT = (u16*)take((size_t)DEPTH * 4 * 128 * 128 * 2);
  p.mod = (float*)take((size_t)DEPTH * 3 * 6144 * 4);
  p.xc = (float*)take((size_t)NCTX * 1024 * 4);
  p.h = (u16*)take((size_t)R * LDK1 * 2);
  p.h8 = (unsigned char*)take((size_t)R * LDK1);
  p.m = p.h;
  p.qkv_pre = (u16*)take((size_t)R * 1536 * 2);
  p.Vfrag = p.qkv_pre;
  p.z = (u16*)take((size_t)R * 512 * 2);
  p.pin = (u16*)take((size_t)R * 512 * 2);
  p.sgd = (u16*)take((size_t)R * 1024 * 2);
  p.sgp = (u16*)take((size_t)R * 1024 * 2);
  p.ba = (float*)take((size_t)R * 16 * 4);
  p.qkvn = (u16*)take((size_t)R * 1536 * 2);
  p.bg = (float*)take((size_t)R * 16 * 4);
  p.Wfrag = (u16*)take((size_t)NUNIT * 16384);
  p.KdT = (u16*)take((size_t)NUNIT * 16384);
  p.Ufrag = (u16*)take((size_t)NUNIT * 16384);
  p.ydn = p.Ufrag;
  p.Sfrag = (u16*)take((size_t)NUNIT * 32768);
  p.gc = (float*)take((size_t)NUNIT * 64 * 4);
  p.glast = (float*)take((size_t)NUNIT * 4);
  p.ypool = (u16*)take((size_t)R * LDK5 * 2);
  p.bar = (unsigned*)take((size_t)XCD_BAR_WORDS * 4);
  p.topS = (float*)p.qkvn;
  p.topI = (int*)((char*)p.qkvn + (size_t)R * 256 * 4);
  const bool alias_ok = ((size_t)R * 256 * 8 <= (size_t)R * 1536 * 2) && ((size_t)NUNIT * 16384 <= (size_t)R * 1536 * 2) &&
                        ((size_t)R * LDK5 * 2 <= (size_t)NUNIT * 16384);
  if (off > ws_size || !alias_ok) {
    fprintf(stderr, "workspace too small: need %zu have %zu (alias_ok=%d)\n", off, ws_size, (int)alias_ok);
    return;
  }
  static int grid_blocks = 0;
  if (!grid_blocks) {
    int dev = 0, cus = 0, per_cu = 0;
    (void)hipGetDevice(&dev);
    (void)hipDeviceGetAttribute(&cus, hipDeviceAttributeMultiprocessorCount, dev);
    (void)hipOccupancyMaxActiveBlocksPerMultiprocessor(&per_cu, megakernel, NTHR, 0);
    if (per_cu > 2) per_cu = 2;
    if (per_cu < 1) per_cu = 1;
    grid_blocks = cus * per_cu;
    grid_blocks -= grid_blocks % 8;
  }
  if (grid_blocks < 8) { fprintf(stderr, "bad grid %d\n", grid_blocks); return; }
  (void)hipMemsetAsync(p.bar, 0, (size_t)XCD_BAR_WORDS * 4, stream);
  void* args[] = {&p};
  hipError_t e = hipLaunchCooperativeKernel((void*)megakernel, dim3(grid_blocks), dim3(NTHR), args, 0, stream);
  if (e != hipSuccess) fprintf(stderr, "cooperative launch failed: %s (grid %d)\n", hipGetErrorString(e), grid_blocks);
}
```

```cpp
#include <hip/hip_runtime.h>
#include <hip/hip_cooperative_groups.h>
#include <stdint.h>
#include <stdio.h>

typedef unsigned short u16;
typedef __attribute__((ext_vector_type(8))) short bf16x8;
typedef __attribute__((ext_vector_type(4))) float f32x4;
typedef __attribute__((ext_vector_type(2))) float f32x2;
typedef __attribute__((ext_vector_type(2))) __bf16 bf16x2_t;

#define DEV __device__ __forceinline__

constexpr int D = 1024;
constexpr int BATCH = 2;
constexpr int SEQ = 8192;
constexpr int DEPTH = 2;
constexpr int CTX = 256;
constexpr int NLAT = BATCH * SEQ;
constexpr int NCTX = BATCH * CTX;
constexpr int R = NLAT + NCTX;
constexpr int DNH = 4;
constexpr int DK = 128;
constexpr int DNW = 512;
constexpr int INC = 4624;
constexpr int NPAD = 4736;
constexpr int NEXP = 16384;
constexpr float EPS = 1e-6f;
constexpr int NTHR = 256;
constexpr int LDK1 = 1088;
constexpr int LDK5 = 576;
constexpr int SMEM_BYTES = 73728;

struct Params {
  const float *x, *c, *ctx, *c_ctx, *w_mod, *b_mod, *norm_mix, *w_in, *conv_w, *a_log, *dt_bias, *dn_out_norm,
      *pool_w, *pool_scale, *w_up_dn, *w_up_pool, *w_out, *norm_ffn, *peer_wq, *peer_keys, *peer_u, *peer_v, *final_norm;
  float* out;
  unsigned char *tab8U, *tab8V;
  float *scU, *scV;
  u16 *WinT, *WdT, *WpT, *WoT, *WkT, *PwT;
  float *mod, *xc;
  u16 *h, *qkv_pre, *z, *pin, *sgd, *sgp;
  unsigned char* h8;
  float* ba;
  u16* qkvn;
  float* bg;
  u16 *Wfrag, *KdT, *Ufrag, *Sfrag, *Vfrag;
  float *gc, *glast;
  u16 *ydn, *ypool, *m;
  float* topS;
  int* topI;
  unsigned* bar;
};

typedef const __attribute__((address_space(4))) Params* KP;
DEV KP get_params() {
  KP k = (KP)__builtin_amdgcn_kernarg_segment_ptr();
  asm volatile("" : "+s"(k));
  return k;
}
DEV int TID() { int t = __builtin_amdgcn_workitem_id_x(); asm volatile("" : "+v"(t)); return t; }
DEV int BID() { int t = __builtin_amdgcn_workgroup_id_x(); asm volatile("" : "+s"(t)); return t; }
DEV unsigned pack_bf16(float a, float b) {
  f32x2 v = {a, b};
  bf16x2_t r = __builtin_convertvector(v, bf16x2_t);
  return *(unsigned*)&r;
}
DEV u16 f2bf(float a) { return (u16)(pack_bf16(a, 0.f) & 0xffffu); }
DEV float bf_lo(unsigned u) { return __uint_as_float(u << 16); }
DEV float bf_hi(unsigned u) { return __uint_as_float(u & 0xffff0000u); }
DEV float bf2f(u16 h) { return __uint_as_float(((unsigned)h) << 16); }
DEV void unpack8(const uint4& v, float* f) {
  f[0] = bf_lo(v.x); f[1] = bf_hi(v.x); f[2] = bf_lo(v.y); f[3] = bf_hi(v.y);
  f[4] = bf_lo(v.z); f[5] = bf_hi(v.z); f[6] = bf_lo(v.w); f[7] = bf_hi(v.w);
}
DEV uint4 pack8(const float* f) {
  uint4 v;
  v.x = pack_bf16(f[0], f[1]); v.y = pack_bf16(f[2], f[3]); v.z = pack_bf16(f[4], f[5]); v.w = pack_bf16(f[6], f[7]);
  return v;
}
template <int O> DEV float swz_xor(float v) {
  return __builtin_bit_cast(float, __builtin_amdgcn_ds_swizzle(__builtin_bit_cast(int, v), (O << 10) | 0x1F));
}
template <int O> DEV unsigned swz_xor_u(unsigned v) {
  return (unsigned)__builtin_amdgcn_ds_swizzle((int)v, (O << 10) | 0x1F);
}
DEV float xor32_f(float v) {
  const int a = ((TID() & 63) ^ 32) << 2;
  return __builtin_bit_cast(float, __builtin_amdgcn_ds_bpermute(a, __builtin_bit_cast(int, v)));
}
DEV float wave_sum(float v) {
  v += xor32_f(v);
  v += swz_xor<16>(v); v += swz_xor<8>(v); v += swz_xor<4>(v); v += swz_xor<2>(v); v += swz_xor<1>(v);
  return v;
}
DEV float wave_max(float v) {
  v = fmaxf(v, xor32_f(v));
  v = fmaxf(v, swz_xor<16>(v)); v = fmaxf(v, swz_xor<8>(v)); v = fmaxf(v, swz_xor<4>(v));
  v = fmaxf(v, swz_xor<2>(v)); v = fmaxf(v, swz_xor<1>(v));
  return v;
}
DEV float group16_sum(float v) {
  v += swz_xor<8>(v); v += swz_xor<4>(v); v += swz_xor<2>(v); v += swz_xor<1>(v);
  return v;
}
DEV float sigmoidf_(float x) { return 1.f / (1.f + __expf(-x)); }
DEV float siluf_(float x) { return x / (1.f + __expf(-x)); }
DEV int modsel(int r) { return r < NLAT ? (r >> 13) : 2; }

DEV void transpose_tile(const float* __restrict__ src, int Nsrc, int ldd, u16* __restrict__ dst, int kt, int nt, int mode,
                        float* tile) {
  const int tid = TID();
  const int cl = tid & 63, rg = tid >> 6;
  const int nd = nt * 64 + cl;
  int ns = nd;
  bool valid = true;
  if (mode & 1) {
    if (nd < 2560) ns = nd;
    else if (nd < 4608) ns = nd + 16;
    else if (nd < 4624) ns = nd - 4608 + 2560;
    else { valid = false; ns = 0; }
  }
#pragma unroll
  for (int i = 0; i < 16; ++i) {
    const int kr = i * 4 + rg;
    float v = valid ? src[(size_t)(kt * 64 + kr) * Nsrc + ns] : 0.f;
    tile[kr * 65 + cl] = v;
  }
  __syncthreads();
  const int nr = tid >> 2, kc = (tid & 3) * 16;
  if (mode & 2) {
    int q4[4];
#pragma unroll
    for (int q = 0; q < 4; ++q) {
      int pk = __builtin_amdgcn_cvt_pk_fp8_f32(32.f * tile[(kc + 4 * q) * 65 + nr], 32.f * tile[(kc + 4 * q + 1) * 65 + nr], 0, false);
      q4[q] = __builtin_amdgcn_cvt_pk_fp8_f32(32.f * tile[(kc + 4 * q + 2) * 65 + nr], 32.f * tile[(kc + 4 * q + 3) * 65 + nr], pk, true);
    }
    *(int4*)((char*)dst + (size_t)(nt * 64 + nr) * ldd + kt * 64 + kc) = make_int4(q4[0], q4[1], q4[2], q4[3]);
    __syncthreads();
    return;
  }
  unsigned w[8];
#pragma unroll
  for (int q = 0; q < 8; ++q) w[q] = pack_bf16(tile[(kc + 2 * q) * 65 + nr], tile[(kc + 2 * q + 1) * 65 + nr]);
  uint4* d = (uint4*)(dst + (size_t)(nt * 64 + nr) * ldd + kt * 64 + kc);
  d[0] = make_uint4(w[0], w[1], w[2], w[3]);
  d[1] = make_uint4(w[4], w[5], w[6], w[7]);
  __syncthreads();
}

__device__ __forceinline__ void phase_init(char* smem) {
  const KP PP = get_params();
  const int tid = TID(), nb = gridDim.x, bid = BID();
  float* fs = (float*)smem;
  for (int u = bid; u < 192; u += nb) {
    const int layer = u / 96, col0 = (u % 96) * 64;
    float* sv = fs;
    float* red = fs + 3072;
    for (int i = tid; i < 3072; i += NTHR) {
      const int v = i >> 10, k = i & 1023;
      const float cv = (v < 2) ? PP->c[v * 1024 + k] : PP->c_ctx[k];
      sv[i] = siluf_(cv);
    }
    __syncthreads();
    const int cq = tid & 15, ks = tid >> 4;
    float acc[3][4];
#pragma unroll
    for (int v = 0; v < 3; ++v)
#pragma unroll
      for (int i = 0; i < 4; ++i) acc[v][i] = 0.f;
    const float* wb = PP->w_mod + ((size_t)layer * 1024 + ks * 64) * 6144 + col0 + cq * 4;
#pragma unroll 8
    for (int kk = 0; kk < 64; ++kk) {
      const float4 w4 = *(const float4*)(wb + (size_t)kk * 6144);
      const int k = ks * 64 + kk;
#pragma unroll
      for (int v = 0; v < 3; ++v) {
        const float s = sv[v * 1024 + k];
        acc[v][0] += s * w4.x; acc[v][1] += s * w4.y; acc[v][2] += s * w4.z; acc[v][3] += s * w4.w;
      }
    }
#pragma unroll
    for (int v = 0; v < 3; ++v)
#pragma unroll
      for (int i = 0; i < 4; ++i) red[(ks * 3 + v) * 64 + cq * 4 + i] = acc[v][i];
    __syncthreads();
    if (tid < 192) {
      const int v = tid >> 6, cc = tid & 63;
      float s = PP->b_mod[layer * 6144 + col0 + cc];
#pragma unroll
      for (int k2 = 0; k2 < 16; ++k2) s += red[(k2 * 3 + v) * 64 + cc];
      PP->mod[(size_t)(layer * 3 + v) * 6144 + col0 + cc] = s;
    }
    __syncthreads();
  }
  constexpr int NTL = 1184 + 128 + 128 + 256 + 16;
  for (int j = bid; j < NTL * DEPTH; j += nb) {
    const int layer = j / NTL;
    int jj = j % NTL;
    if (jj < 1184) {
      transpose_tile(PP->w_in + (size_t)layer * 1024 * INC, INC, LDK1, PP->WinT + (size_t)layer * NPAD * LDK1, jj / 74, jj % 74, 3, fs);
    } else if ((jj -= 1184) < 128) {
      transpose_tile(PP->w_up_dn + (size_t)layer * 512 * 1024, 1024, LDK5, PP->WdT + (size_t)layer * 1024 * LDK5, jj / 16, jj % 16, 2, fs);
    } else if ((jj -= 128) < 128) {
      transpose_tile(PP->w_up_pool + (size_t)layer * 512 * 1024, 1024, LDK5, PP->WpT + (size_t)layer * 1024 * LDK5, jj / 16, jj % 16, 2, fs);
    } else if ((jj -= 128) < 256) {
      transpose_tile(PP->w_out + (size_t)layer * 1024 * 1024, 1024, LDK1, PP->WoT + (size_t)layer * 1024 * LDK1, jj / 16, jj % 16, 2, fs);
    } else {
      jj -= 256;
      const int g = jj >> 2;
      transpose_tile(PP->pool_w + (size_t)(layer * 4 + g) * 128 * 128, 128, 128, PP->PwT + (size_t)(layer * 4 + g) * 128 * 128,
                     (jj & 3) >> 1, jj & 1, 0, fs);
    }
  }
  {
    const int tid2 = TID();
    const int l = tid2 & 63, w = tid2 >> 6, lr = l & 15, lg = l >> 4;
    char* Ks = smem;
    char* Ws = smem + 32768;
    for (int item = bid; item < DEPTH * 256; item += nb) {
      const int layer = item >> 8, hp = (item >> 4) & 15, ct = item & 15;
      __syncthreads();
      const float* ksrc = PP->peer_keys + (size_t)(layer * 16 + hp) * 128 * 128;
      for (int idx = tid2; idx < 128 * 16; idx += NTHR) {
        const int row = idx >> 4, ch = idx & 15;
        const float4 a = *(const float4*)(ksrc + row * 128 + ch * 8);
        const float4 c4 = *(const float4*)(ksrc + row * 128 + ch * 8 + 4);
        *(uint4*)(Ks + row * 256 + ((ch ^ (row & 15)) << 4)) =
            make_uint4(pack_bf16(a.x, a.y), pack_bf16(a.z, a.w), pack_bf16(c4.x, c4.y), pack_bf16(c4.z, c4.w));
      }
      const float* wsrc = PP->peer_wq + (size_t)layer * 1024 * 2048 + (size_t)(ct * 64) * 2048 + hp * 128;
      for (int idx = tid2; idx < 64 * 16; idx += NTHR) {
        const int row = idx >> 4, ch = idx & 15;
        const float4 a = *(const float4*)(wsrc + (size_t)row * 2048 + ch * 8);
        const float4 c4 = *(const float4*)(wsrc + (size_t)row * 2048 + ch * 8 + 4);
        *(uint4*)(Ws + row * 256 + ((ch ^ (row & 15)) << 4)) =
            make_uint4(pack_bf16(a.x, a.y), pack_bf16(a.z, a.w), pack_bf16(c4.x, c4.y), pack_bf16(c4.z, c4.w));
      }
      __syncthreads();
      f32x4 acc[2][4];
#pragma unroll
      for (int mi = 0; mi < 2; ++mi)
#pragma unroll
        for (int ni = 0; ni < 4; ++ni) acc[mi][ni] = (f32x4){0.f, 0.f, 0.f, 0.f};
#pragma unroll
      for (int ks = 0; ks < 4; ++ks) {
        const int ch = ks * 4 + lg;
        bf16x8 a[2], bb[4];
#pragma unroll
        for (int mi = 0; mi < 2; ++mi) a[mi] = *(const bf16x8*)(Ks + ((2 * w + mi) * 16 + lr) * 256 + ((ch ^ lr) << 4));
#pragma unroll
        for (int ni = 0; ni < 4; ++ni) bb[ni] = *(const bf16x8*)(Ws + (ni * 16 + lr) * 256 + ((ch ^ lr) << 4));
#pragma unroll
        for (int mi = 0; mi < 2; ++mi)
#pragma unroll
          for (int ni = 0; ni < 4; ++ni) acc[mi][ni] = __builtin_amdgcn_mfma_f32_16x16x32_bf16(a[mi], bb[ni], acc[mi][ni], 0, 0, 0);
      }
      unsigned char* dst = (unsigned char*)PP->WkT + ((size_t)layer * 2048 + hp * 128) * LDK1 + ct * 64;
#pragma unroll
      for (int mi = 0; mi < 2; ++mi)
#pragma unroll
        for (int ni = 0; ni < 4; ++ni)
#pragma unroll
          for (int r = 0; r < 4; ++r) {
            const float v32 = 32.f * acc[mi][ni][r];
            dst[(size_t)((2 * w + mi) * 16 + 4 * lg + r) * LDK1 + ni * 16 + lr] = (unsigned char)(__builtin_amdgcn_cvt_pk_fp8_f32(v32, v32, 0, false) & 0xff);
          }
    }
  }
}

DEV unsigned enc_e2m3(float x) {
  const float a = fabsf(x);
  float c;
  if (a < 2.f) c = a * 8.f;
  else if (a < 4.f) c = 16.f + (a - 2.f) * 4.f;
  else c = 24.f + (a - 4.f) * 2.f;
  unsigned code = (unsigned)__builtin_rintf(c);
  code = code > 31u ? 31u : code;
  return code | (x < 0.f ? 32u : 0u);
}
struct __attribute__((packed, aligned(4))) U3 { unsigned a, b, c; };
constexpr int TROW = 768;
typedef float f32x32_t __attribute__((ext_vector_type(32)));
typedef unsigned u32x6_t __attribute__((ext_vector_type(6)));

__device__ __forceinline__ void phase_tables(int layer, int vbid, int vnb) {
  const KP PP = get_params();
  const int tid = TID(), lane = tid & 63;
  const int gw = vbid * 4 + (tid >> 6), nw = vnb * 4;
  const float* su = PP->peer_u + (size_t)layer * NEXP * 1024;
  const float* sv = PP->peer_v + (size_t)layer * NEXP * 1024;
  for (int r0 = gw * 2; r0 < 2 * NEXP; r0 += nw * 2) {
    float4 v[2][4];
#pragma unroll
    for (int q = 0; q < 2; ++q) {
      const int r = r0 + q;
      const float* src = (r < NEXP ? su + (size_t)r * 1024 : sv + (size_t)(r - NEXP) * 1024);
#pragma unroll
      for (int i = 0; i < 4; ++i) v[q][i] = *(const float4*)(src + (lane + 64 * i) * 4);
    }
#pragma unroll
    for (int q = 0; q < 2; ++q) {
      const int r = r0 + q;
      float am = 0.f;
#pragma unroll
      for (int i = 0; i < 4; ++i)
        am = fmaxf(am, fmaxf(fmaxf(fabsf(v[q][i].x), fabsf(v[q][i].y)), fmaxf(fabsf(v[q][i].z), fabsf(v[q][i].w))));
      am = wave_max(am);
      const float scale = fmaxf(am, 1e-30f) * (1.f / 7.5f);
      const float inv = 1.f / scale;
      unsigned long long lo = 0ull;
      unsigned hi = 0u;
#pragma unroll
      for (int i = 0; i < 4; ++i) {
        const float vv[4] = {v[q][i].x * inv, v[q][i].y * inv, v[q][i].z * inv, v[q][i].w * inv};
#pragma unroll
        for (int j = 0; j < 4; ++j) {
          const int k = 4 * i + j;
          const unsigned cde = enc_e2m3(vv[j]);
          if (k < 10) lo |= (unsigned long long)cde << (6 * k);
          else if (k == 10) { lo |= (unsigned long long)cde << 60; hi |= cde >> 4; }
          else hi |= cde << (6 * k - 64);
        }
      }
      unsigned char* dst = (r < NEXP ? PP->tab8U + (size_t)r * TROW : PP->tab8V + (size_t)(r - NEXP) * TROW);
      U3 pk3;
      pk3.a = (unsigned)lo; pk3.b = (unsigned)(lo >> 32); pk3.c = hi;
      *(U3*)(dst + lane * 12) = pk3;
      if (lane == 0) { if (r < NEXP) PP->scU[r] = scale; else PP->scV[r - NEXP] = scale; }
    }
  }
}

__device__ __forceinline__ void phase_norm(int layer, int which) {
  const KP PP = get_params();
  const int lane = TID() & 63;
  const int gw = BID() * 4 + (TID() >> 6), nw = gridDim.x * 4;
  const float* nwt = (which == 1 ? PP->norm_mix : PP->norm_ffn) + layer * 1024;
  const int rlim = (which == 2 && layer == DEPTH - 1) ? NLAT : R;
  for (int r = gw; r < rlim; r += nw) {
    const float* xr;
    if (r < NLAT) xr = ((which == 1 && layer == 0) ? PP->x : PP->out) + (size_t)r * 1024;
    else xr = ((which == 1 && layer == 0) ? PP->ctx : PP->xc) + (size_t)(r - NLAT) * 1024;
    const float* md = PP->mod + (size_t)(layer * 3 + modsel(r)) * 6144 + (which == 1 ? 0 : 3072);
    float4 v[4];
    float ss = 0.f;
#pragma unroll
    for (int i = 0; i < 4; ++i) {
      v[i] = *(const float4*)(xr + (lane + 64 * i) * 4);
      ss += v[i].x * v[i].x + v[i].y * v[i].y + v[i].z * v[i].z + v[i].w * v[i].w;
    }
    ss = wave_sum(ss);
    const float rs = rsqrtf(ss * (1.f / 1024.f) + EPS);
#pragma unroll
    for (int i = 0; i < 4; ++i) {
      const int col = (lane + 64 * i) * 4;
      const float4 w = *(const float4*)(nwt + col);
      const float4 sh = *(const float4*)(md + col);
      const float4 sc = *(const float4*)(md + 1024 + col);
      const float y0 = v[i].x * rs * w.x * (1.f + sc.x) + sh.x;
      const float y1 = v[i].y * rs * w.y * (1.f + sc.y) + sh.y;
      const float y2 = v[i].z * rs * w.z * (1.f + sc.z) + sh.z;
      const float y3 = v[i].w * rs * w.w * (1.f + sc.w) + sh.w;
      if (which == 1) {
        int pk = __builtin_amdgcn_cvt_pk_fp8_f32(y0, y1, 0, false);
        pk = __builtin_amdgcn_cvt_pk_fp8_f32(y2, y3, pk, true);
        *(int*)((char*)PP->h + (size_t)r * (LDK1 * 2) + col) = pk;
      } else {
        *(uint2*)(PP->h + (size_t)r * LDK1 + col) = make_uint2(pack_bf16(y0, y1), pack_bf16(y2, y3));
        int pk = __builtin_amdgcn_cvt_pk_fp8_f32(y0, y1, 0, false);
        pk = __builtin_amdgcn_cvt_pk_fp8_f32(y2, y3, pk, true);
        *(int*)(PP->h8 + (size_t)r * LDK1 + col) = pk;
      }
    }
  }
}

template <bool PRIO>
DEV void gemm_mainloop_t(const u16* __restrict__ A, int lda, const u16* __restrict__ B, int ldb, int K, int m0, int n0,
                         char* smem, f32x4 (&acc)[4][4]) {
  const int tid = TID();
  const int l = tid & 63, w = tid >> 6, wm = w >> 1, wn = w & 1, lr = l & 15, lg = l >> 4;
  uint4 ga0[4], gb0[4], ga1[4], gb1[4];
#pragma unroll
  for (int i = 0; i < 4; ++i) { ga0[i] = make_uint4(0u, 0u, 0u, 0u); gb0[i] = ga0[i]; ga1[i] = ga0[i]; gb1[i] = ga0[i]; }
  const int KT = K >> 6;
#define GLOAD(GA, GB, KT_)                                                                     \
  _Pragma("unroll") for (int i = 0; i < 4; ++i) {                                              \
    const int id = tid + 256 * i, row = id >> 3, c = id & 7;                                   \
    GA[i] = *(const uint4*)(A + (size_t)(m0 + row) * lda + (KT_) * 64 + c * 8);                \
    GB[i] = *(const uint4*)(B + (size_t)(n0 + row) * ldb + (KT_) * 64 + c * 8);                \
  }
#define LSTORE(GA, GB, BUF)                                                                    \
  {                                                                                            \
    char* as_ = smem + (BUF) * 32768;                                                          \
    char* bs_ = as_ + 16384;                                                                   \
    _Pragma("unroll") for (int i = 0; i < 4; ++i) {                                            \
      const int id = tid + 256 * i, row = id >> 3, c = id & 7;                                 \
      const int off = row * 128 + ((c ^ (row & 7)) << 4);                                      \
      *(uint4*)(as_ + off) = GA[i];                                                            \
      *(uint4*)(bs_ + off) = GB[i];                                                            \
    }                                                                                          \
  }
#define COMPUTE(BUF)                                                                                                      \
  {                                                                                                                       \
    const char* as_ = smem + (BUF) * 32768;                                                                               \
    const char* bs_ = as_ + 16384;                                                                                        \
    if (PRIO) __builtin_amdgcn_s_setprio(1);      \
    _Pragma("unroll") for (int ks = 0; ks < 2; ++ks) {                                                                    \
      bf16x8 a[4], b[4];                                                                                                  \
      const int c = ks * 4 + lg;                                                                                          \
      const int sw = ((c ^ (lr & 7)) << 4);                                                                               \
      _Pragma("unroll") for (int mi = 0; mi < 4; ++mi) a[mi] = *(const bf16x8*)(as_ + (wm * 64 + mi * 16 + lr) * 128 + sw); \
      _Pragma("unroll") for (int ni = 0; ni < 4; ++ni) b[ni] = *(const bf16x8*)(bs_ + (wn * 64 + ni * 16 + lr) * 128 + sw); \
      _Pragma("unroll") for (int mi = 0; mi < 4; ++mi)                                                                    \
        _Pragma("unroll") for (int ni = 0; ni < 4; ++ni)                                                                  \
          acc[mi][ni] = __builtin_amdgcn_mfma_f32_16x16x32_bf16(a[mi], b[ni], acc[mi][ni], 0, 0, 0);                      \
    }                                                                                                                     \
    if (PRIO) __builtin_amdgcn_s_setprio(0);                                                                              \
  }
  __syncthreads();
  GLOAD(ga0, gb0, 0);
  GLOAD(ga1, gb1, 1);
  LSTORE(ga0, gb0, 0);
  __syncthreads();
  for (int kt = 0; kt < KT; kt += 2) {
    if (kt + 2 < KT) { GLOAD(ga0, gb0, kt + 2); }
    COMPUTE(0);
    LSTORE(ga1, gb1, 1);
    __syncthreads();
    if (kt + 3 < KT) { GLOAD(ga1, gb1, kt + 3); }
    COMPUTE(1);
    if (kt + 2 < KT) { LSTORE(ga0, gb0, 0); }
    __syncthreads();
  }
#undef GLOAD
#undef LSTORE
#undef COMPUTE
}

DEV void gemm_mainloop(const u16* __restrict__ A, int lda, const u16* __restrict__ B, int ldb, int K, int m0, int n0,
                       char* smem, f32x4 (&acc)[4][4]) {
  gemm_mainloop_t<false>(A, lda, B, ldb, K, m0, n0, smem, acc);
}
DEV void gemm_mainloop1(const u16* __restrict__ A, int lda, const u16* __restrict__ B, int ldb, int K, int m0, int n0,
                       char* smem, f32x4 (&acc)[4][4]) {
  const int tid = TID();
  const int l = tid & 63, w = tid >> 6, wm = w >> 1, wn = w & 1, lr = l & 15, lg = l >> 4;
  uint4 ga[4], gb[4];
  const int KT = K >> 6;
  auto gload = [&](int kt) {
#pragma unroll
    for (int i = 0; i < 4; ++i) {
      const int id = tid + 256 * i, row = id >> 3, c = id & 7;
      ga[i] = *(const uint4*)(A + (size_t)(m0 + row) * lda + kt * 64 + c * 8);
      gb[i] = *(const uint4*)(B + (size_t)(n0 + row) * ldb + kt * 64 + c * 8);
    }
  };
  auto lstore = [&](int buf) {
    char* as = smem + buf * 32768;
    char* bs = as + 16384;
#pragma unroll
    for (int i = 0; i < 4; ++i) {
      const int id = tid + 256 * i, row = id >> 3, c = id & 7;
      const int off = row * 128 + ((c ^ (row & 7)) << 4);
      *(uint4*)(as + off) = ga[i];
      *(uint4*)(bs + off) = gb[i];
    }
  };
  __syncthreads();
  gload(0);
  lstore(0);
  __syncthreads();
  for (int kt = 0; kt < KT; ++kt) {
    if (kt + 1 < KT) gload(kt + 1);
    const char* as = smem + (kt & 1) * 32768;
    const char* bs = as + 16384;
#pragma unroll
    for (int ks = 0; ks < 2; ++ks) {
      bf16x8 a[4], b[4];
      const int c = ks * 4 + lg;
      const int sw = ((c ^ (lr & 7)) << 4);
#pragma unroll
      for (int mi = 0; mi < 4; ++mi) a[mi] = *(const bf16x8*)(as + (wm * 64 + mi * 16 + lr) * 128 + sw);
#pragma unroll
      for (int ni = 0; ni < 4; ++ni) b[ni] = *(const bf16x8*)(bs + (wn * 64 + ni * 16 + lr) * 128 + sw);
#pragma unroll
      for (int mi = 0; mi < 4; ++mi)
#pragma unroll
        for (int ni = 0; ni < 4; ++ni) acc[mi][ni] = __builtin_amdgcn_mfma_f32_16x16x32_bf16(a[mi], b[ni], acc[mi][ni], 0, 0, 0);
    }
    if (kt + 1 < KT) lstore((kt + 1) & 1);
    __syncthreads();
  }
}

DEV void zero_acc(f32x4 (&acc)[4][4]) {
#pragma unroll
  for (int i = 0; i < 4; ++i)
#pragma unroll
    for (int j = 0; j < 4; ++j) acc[i][j] = (f32x4){0.f, 0.f, 0.f, 0.f};
}

DEV void stage_half(const f32x4 (&acc)[4][4], int hsel, char* smem, float4 (&v)[8]) {
  const int tid = TID();
  const int l = tid & 63, w = tid >> 6, wm = w >> 1, wn = w & 1, lr = l & 15, lg = l >> 4;
  float* Cs = (float*)smem;
  __syncthreads();
  if (wm == hsel) {
#pragma unroll
    for (int mi = 0; mi < 4; ++mi)
#pragma unroll
      for (int ni = 0; ni < 4; ++ni)
#pragma unroll
        for (int r = 0; r < 4; ++r) Cs[(mi * 16 + lg * 4 + r) * 132 + wn * 64 + ni * 16 + lr] = acc[mi][ni][r];
  }
  __syncthreads();
#pragma unroll
  for (int j = 0; j < 8; ++j) {
    const int idx = tid + 256 * j, row = idx >> 5, c4 = idx & 31;
    v[j] = *(const float4*)&Cs[row * 132 + c4 * 4];
  }
}

DEV bool tile_map(int it, int MT, int NTl, int& mt, int& nt) {
  const int nb = gridDim.x, bid = BID();
  const int x = bid & 7, vl = bid >> 3, per = nb >> 3;
  const int T = MT * NTl;
  const int g_begin = (int)(((long long)x * T) >> 3), g_end = (int)(((long long)(x + 1) * T) >> 3);
  const int g = g_begin + vl + it * per;
  if (g >= g_end) return false;
  const int full = MT >> 3;
  const int sr = g / (8 * NTl);
  const int srow = sr < full ? sr : full;
  const int rows_in_sr = sr < full ? 8 : (MT & 7);
  const int tt = g - srow * 8 * NTl;
  nt = tt / rows_in_sr;
  mt = srow * 8 + tt % rows_in_sr;
  return true;
}

#define SG_LOCALS                                                                              \
  const int tid = TID();                                                                       \
  const int l = tid & 63, w = tid >> 6, wm = w >> 1, wn = w & 1, lr = l & 15, lg = l >> 4;     \
  uint4 ga0[4], gb0[4], ga1[4], gb1[4];                                                        \
  _Pragma("unroll") for (int i = 0; i < 4; ++i) {                                              \
    ga0[i] = make_uint4(0u, 0u, 0u, 0u); gb0[i] = ga0[i]; ga1[i] = ga0[i]; gb1[i] = ga0[i];    \
  }                                                                                            \
  const int r0 = tid >> 3, c0 = tid & 7;                                                       \
  const int pr0 = 8 * ((r0 & 15) >> 2) + 4 * (r0 >> 4) + (r0 & 3);
#define SG_LOAD(GA, GB, AP, BP, LD, M0_, N0_, KT_)                                             \
  _Pragma("unroll") for (int i = 0; i < 4; ++i) {                                              \
    GA[i] = *(const uint4*)((AP) + (size_t)((M0_) + 32 * i + r0) * (LD) + c0 * 8 + (KT_) * 64);  \
    GB[i] = *(const uint4*)((BP) + (size_t)((N0_) + 32 * i + pr0) * (LD) + c0 * 8 + (KT_) * 64); \
  }
#define SG_LSTORE(GA, GB, BUF)                                                                 \
  {                                                                                            \
    char* as_ = smem + (BUF) * 32768;                                                          \
    char* bs_ = as_ + 16384;                                                                   \
    _Pragma("unroll") for (int i = 0; i < 4; ++i) {                                            \
      const int id = tid + 256 * i, row = id >> 3, c = id & 7;                                 \
      const int off = row * 128 + ((c ^ (row & 7)) << 4);                                      \
      *(uint4*)(as_ + off) = GA[i];                                                            \
      *(uint4*)(bs_ + off) = GB[i];                                                            \
    }                                                                                          \
  }
#define SG_COMPUTE(ACC, BUF, PRIO)                                                                                        \
  {                                                                                                                       \
    const char* as_ = smem + (BUF) * 32768;                                                                               \
    const char* bs_ = as_ + 16384;                                                                                        \
    if (PRIO) __builtin_amdgcn_s_setprio(1);                                                                              \
    _Pragma("unroll") for (int ks = 0; ks < 2; ++ks) {                                                                    \
      bf16x8 a[4], b[4];                                                                                                  \
      const int c = ks * 4 + lg;                                                                                          \
      const int sw = ((c ^ (lr & 7)) << 4);                                                                               \
      _Pragma("unroll") for (int mi = 0; mi < 4; ++mi) a[mi] = *(const bf16x8*)(as_ + (wm * 64 + mi * 16 + lr) * 128 + sw); \
      _Pragma("unroll") for (int ni = 0; ni < 4; ++ni) b[ni] = *(const bf16x8*)(bs_ + (wn * 64 + ni * 16 + lr) * 128 + sw); \
      _Pragma("unroll") for (int mi = 0; mi < 4; ++mi)                                                                    \
        _Pragma("unroll") for (int ni = 0; ni < 4; ++ni)                                                                  \
          ACC[mi][ni] = __builtin_amdgcn_mfma_f32_16x16x32_bf16(b[ni], a[mi], ACC[mi][ni], 0, 0, 0);                      \
    }                                                                                                                     \
    if (PRIO) __builtin_amdgcn_s_setprio(0);                                                                              \
  }

typedef int i32x8 __attribute__((ext_vector_type(8)));
typedef int i32x4 __attribute__((ext_vector_type(4)));
#define F8_LOCALS                                                                              \
  const int tid = TID();                                                                       \
  const int l = tid & 63, w = tid >> 6, wm = w >> 1, wn = w & 1, lr = l & 15, lg = l >> 4;     \
  uint4 ga0[4], gb0[4], ga1[4], gb1[4];                                                        \
  _Pragma("unroll") for (int i = 0; i < 4; ++i) {                                              \
    ga0[i] = make_uint4(0u, 0u, 0u, 0u); gb0[i] = ga0[i]; ga1[i] = ga0[i]; gb1[i] = ga0[i];    \
  }                                                                                            \
  const int r0 = tid >> 3, c0 = tid & 7;                                                       \
  const int pr0 = 8 * ((r0 & 15) >> 2) + 4 * (r0 >> 4) + (r0 & 3);
#define F8_GLOAD(GA, GB, AP, LDA, BP, LDB, M0_, N0_, KT_)                                      \
  _Pragma("unroll") for (int i = 0; i < 4; ++i) {                                              \
    GA[i] = *(const uint4*)((AP) + (size_t)((M0_) + 32 * i + r0) * (LDA) + c0 * 16 + (KT_) * 128);   \
    GB[i] = *(const uint4*)((BP) + (size_t)((N0_) + 32 * i + pr0) * (LDB) + c0 * 16 + (KT_) * 128);  \
  }
#define F8_LSTORE(GA, GB, BUF)                                                                 \
  {                                                                                            \
    char* as_ = smem + (BUF) * 32768;                                                          \
    char* bs_ = as_ + 16384;                                                                   \
    _Pragma("unroll") for (int i = 0; i < 4; ++i) {                                            \
      const int id = tid + 256 * i, row = id >> 3, c = id & 7;                                 \
      const int off = row * 128 + ((c ^ (row & 7)) << 4);                                      \
      *(uint4*)(as_ + off) = GA[i];                                                            \
      *(uint4*)(bs_ + off) = GB[i];                                                            \
    }                                                                                          \
  }
#define F8_COMPUTE(BUF)                                                                                                   \
  {                                                                                                                       \
    const char* as_ = smem + (BUF) * 32768;                                                                               \
    const char* bs_ = as_ + 16384;                                                                                        \
    i32x8 a[4], b[4];                                                                                                     \
    const int sw0 = ((lg ^ (lr & 7)) << 4), sw1 = (((4 + lg) ^ (lr & 7)) << 4);                                           \
    _Pragma("unroll") for (int mi = 0; mi < 4; ++mi) {                                                                    \
      const char* p_ = as_ + (wm * 64 + mi * 16 + lr) * 128;                                                              \
      const i32x4 lo_ = *(const i32x4*)(p_ + sw0), hi_ = *(const i32x4*)(p_ + sw1);                                       \
      a[mi] = __builtin_shufflevector(lo_, hi_, 0, 1, 2, 3, 4, 5, 6, 7);                                                  \
    }                                                                                                                     \
    _Pragma("unroll") for (int ni = 0; ni < 4; ++ni) {                                                                    \
      const char* p_ = bs_ + (wn * 64 + ni * 16 + lr) * 128;                                                              \
      const i32x4 lo_ = *(const i32x4*)(p_ + sw0), hi_ = *(const i32x4*)(p_ + sw1);                                       \
      b[ni] = __builtin_shufflevector(lo_, hi_, 0, 1, 2, 3, 4, 5, 6, 7);                                                  \
    }                                                                                                                     \
    __builtin_amdgcn_s_setprio(1);                                                                                        \
    _Pragma("unroll") for (int mi = 0; mi < 4; ++mi)                                                                      \
      _Pragma("unroll") for (int ni = 0; ni < 4; ++ni)                                                                    \
        acc[mi][ni] = __builtin_amdgcn_mfma_scale_f32_16x16x128_f8f6f4(b[ni], a[mi], acc[mi][ni], 0, 0, 0, 0, 0, 0);      \
    __builtin_amdgcn_s_setprio(0);                                                                                        \
  }
#define F8_KLOOP(AP, LDA, BP, LDB, KT_)                                                        \
  for (int kt = 0; kt < (KT_); kt += 2) {                                                      \
    const bool wrap = (kt + 2 >= (KT_));                                                       \
    const int ml = wrap ? m0n : m0, nl = wrap ? n0n : n0, kl = wrap ? kt + 2 - (KT_) : kt + 2; \
    if (!wrap || hasn) { F8_GLOAD(ga0, gb0, AP, LDA, BP, LDB, ml, nl, kl); }                   \
    F8_COMPUTE(0);                                                                             \
    F8_LSTORE(ga1, gb1, 1);                                                                    \
    __syncthreads();                                                                           \
    if (!wrap || hasn) { F8_GLOAD(ga1, gb1, AP, LDA, BP, LDB, ml, nl, kl + 1); }               \
    F8_COMPUTE(1);                                                                             \
    if (!wrap || hasn) { F8_LSTORE(ga0, gb0, 0); }                                             \
    __syncthreads();                                                                           \
  }
#define F8_PROLOGUE(AP, LDA, BP, LDB)                                                          \
  __syncthreads();                           \
  F8_GLOAD(ga0, gb0, AP, LDA, BP, LDB, m0, n0, 0);                                             \
  F8_GLOAD(ga1, gb1, AP, LDA, BP, LDB, m0, n0, 1);                                             \
  F8_LSTORE(ga0, gb0, 0);                                                                      \
  __syncthreads();

__device__ __forceinline__ void phase_gemm_win(int layer, char* smem) {
  const KP PP = get_params();
  const char* Bt = (const char*)(PP->WinT + (size_t)layer * NPAD * LDK1);
  const char* A = (const char*)PP->h;
  F8_LOCALS
  int it = 0, mt, nt;
  if (!tile_map(it, R / 128, NPAD / 128, mt, nt)) return;
  int m0 = mt * 128, n0 = nt * 128;
  F8_PROLOGUE(A, LDK1 * 2, Bt, LDK1)
  for (;;) {
    int mtn = 0, ntn = 0;
    const bool hasn = tile_map(it + 1, R / 128, NPAD / 128, mtn, ntn);
    const int m0n = mtn * 128, n0n = ntn * 128;
    f32x4 acc[4][4];
    zero_acc(acc);
    F8_KLOOP(A, LDK1 * 2, Bt, LDK1, 8)
#pragma unroll
    for (int mi = 0; mi < 4; ++mi) {
      const size_t gr = (size_t)(m0 + wm * 64 + mi * 16 + lr);
#pragma unroll
      for (int g = 0; g < 2; ++g) {
        const int gc = n0 + wn * 64 + g * 32 + 8 * lg;
        const f32x4 t0 = acc[mi][2 * g] * (1.f / 32.f), t1 = acc[mi][2 * g + 1] * (1.f / 32.f);
        if (n0 < 1536) {
          int p0 = __builtin_amdgcn_cvt_pk_fp8_f32(t0[0], t0[1], 0, false);
          p0 = __builtin_amdgcn_cvt_pk_fp8_f32(t0[2], t0[3], p0, true);
          int p1 = __builtin_amdgcn_cvt_pk_fp8_f32(t1[0], t1[1], 0, false);
          p1 = __builtin_amdgcn_cvt_pk_fp8_f32(t1[2], t1[3], p1, true);
          *(int2*)((char*)PP->qkv_pre + gr * 1536 + gc) = make_int2(p0, p1);
        } else if (n0 < 2048) {
          *(uint4*)(PP->z + gr * 512 + (gc - 1536)) =
              make_uint4(pack_bf16(t0[0], t0[1]), pack_bf16(t0[2], t0[3]), pack_bf16(t1[0], t1[1]), pack_bf16(t1[2], t1[3]));
        } else if (n0 < 2560) {
          *(uint4*)(PP->pin + gr * 512 + (gc - 2048)) =
              make_uint4(pack_bf16(t0[0], t0[1]), pack_bf16(t0[2], t0[3]), pack_bf16(t1[0], t1[1]), pack_bf16(t1[2], t1[3]));
        } else if (n0 < 4608) {
          unsigned q0 = 0u, q1 = 0u;
#pragma unroll
          for (int e = 0; e < 4; ++e) {
            q0 = __builtin_amdgcn_cvt_pk_u8_f32(sigmoidf_(t0[e]) * 255.f, e, q0);
            q1 = __builtin_amdgcn_cvt_pk_u8_f32(sigmoidf_(t1[e]) * 255.f, e, q1);
          }
          unsigned char* gdst = (n0 < 3584) ? (unsigned char*)PP->sgd + gr * 1024 + (gc - 2560)
                                            : (unsigned char*)PP->sgp + gr * 1024 + (gc - 3584);
          *(uint2*)gdst = make_uint2(q0, q1);
        } else {
          if (gc - 4608 < 16) {
            *(float4*)(PP->ba + gr * 16 + (gc - 4608)) = make_float4(t0[0], t0[1], t0[2], t0[3]);
            *(float4*)(PP->ba + gr * 16 + (gc - 4608) + 4) = make_float4(t1[0], t1[1], t1[2], t1[3]);
          }
        }
      }
    }
    if (!hasn) break;
    m0 = m0n; n0 = n0n; ++it;
  }
}

__device__ __forceinline__ void phase_conv(int layer) {
  const KP PP = get_params();
  const int lane = TID() & 63;
  const int gw = BID() * 4 + (TID() >> 6), nw = gridDim.x * 4;
  const float* cw = PP->conv_w + (size_t)layer * 4 * 1536;
  float wr[3][4][8];
#pragma unroll
  for (int part = 0; part < 3; ++part)
#pragma unroll
    for (int j = 0; j < 4; ++j) {
      const float4 w0 = *(const float4*)(cw + j * 1536 + part * 512 + lane * 8);
      const float4 w1 = *(const float4*)(cw + j * 1536 + part * 512 + lane * 8 + 4);
      wr[part][j][0] = w0.x; wr[part][j][1] = w0.y; wr[part][j][2] = w0.z; wr[part][j][3] = w0.w;
      wr[part][j][4] = w1.x; wr[part][j][5] = w1.y; wr[part][j][6] = w1.z; wr[part][j][7] = w1.w;
    }
  for (int r = gw; r < R; r += nw) {
    int t, T;
    if (r < NLAT) { t = r & (SEQ - 1); T = SEQ; } else { t = (r - NLAT) & (CTX - 1); T = CTX; }
    const int base = r - t;
    uint2 xv[3][4];
#pragma unroll
    for (int j = 0; j < 4; ++j) {
      const int tt = t + j - 2;
      const bool ok = (tt >= 0 && tt < T);
      const unsigned char* src = (const unsigned char*)PP->qkv_pre + (size_t)(base + (ok ? tt : t)) * 1536 + lane * 8;
#pragma unroll
      for (int part = 0; part < 3; ++part) {
        xv[part][j] = *(const uint2*)(src + part * 512);
        if (!ok) xv[part][j] = make_uint2(0u, 0u);
      }
    }
#pragma unroll
    for (int part = 0; part < 3; ++part) {
      const int ch0 = part * 512 + lane * 8;
      float y[8];
#pragma unroll
      for (int e = 0; e < 8; ++e) y[e] = 0.f;
#pragma unroll
      for (int j = 0; j < 4; ++j) {
        float xf[8];
        {
          const f32x2 a0 = __builtin_amdgcn_cvt_pk_f32_fp8(xv[part][j].x, false), a1 = __builtin_amdgcn_cvt_pk_f32_fp8(xv[part][j].x, true);
          const f32x2 a2 = __builtin_amdgcn_cvt_pk_f32_fp8(xv[part][j].y, false), a3 = __builtin_amdgcn_cvt_pk_f32_fp8(xv[part][j].y, true);
          xf[0] = a0[0]; xf[1] = a0[1]; xf[2] = a1[0]; xf[3] = a1[1]; xf[4] = a2[0]; xf[5] = a2[1]; xf[6] = a3[0]; xf[7] = a3[1];
        }
#pragma unroll
        for (int e = 0; e < 8; ++e) y[e] += wr[part][j][e] * xf[e];
      }
      float ss = 0.f;
#pragma unroll
      for (int e = 0; e < 8; ++e) { y[e] = siluf_(y[e]); ss += y[e] * y[e]; }
      if (part < 2) {
        ss = group16_sum(ss);
        const float sc = rsqrtf(ss + EPS) * (part == 0 ? 0.08838834764831845f : 1.f);
#pragma unroll
        for (int e = 0; e < 8; ++e) y[e] *= sc;
      }
      *(uint4*)(PP->qkvn + (size_t)r * 1536 + ch0) = pack8(y);
    }
    if (lane < 16) {
      const float raw = PP->ba[(size_t)r * 16 + lane];
      float o;
      if (lane < 8) {
        o = sigmoidf_(raw);
      } else {
        const int jj = lane - 8;
        const float xx = raw + PP->dt_bias[layer * 8 + jj];
        const float ee = __expf(xx);
        const float sp = xx > 20.f ? xx : (ee < 0.03125f ? ee * (1.f - ee * (0.5f - ee * (0.33333334f - 0.25f * ee))) : __logf(1.f + ee));
        o = -__expf(PP->a_log[layer * 8 + jj]) * sp;
      }
      PP->bg[(size_t)r * 16 + lane] = o;
    }
  }
}

DEV int seq_row(int b, int dir, int pos) {
  if (dir == 0) return pos < CTX ? NLAT + b * CTX + pos : b * SEQ + (pos - CTX);
  return pos < CTX ? NLAT + b * CTX + (CTX - 1 - pos) : b * SEQ + (SEQ - 1 - (pos - CTX));
}
constexpr int NCHUNK = (CTX + SEQ) / 64;
constexpr int NUNIT = BATCH * DNH * 2 * NCHUNK;

DEV int kperm(int s, int g, int e) { return 32 * s + 16 * (e >> 2) + 4 * g + (e & 3); }

DEV uint4 pack_tiles(const f32x4& a, const f32x4& b) {
  return make_uint4(pack_bf16(a[0], a[1]), pack_bf16(a[2], a[3]), pack_bf16(b[0], b[1]), pack_bf16(b[2], b[3]));
}
DEV bf16x8 as_frag(const uint4& v) { return *(const bf16x8*)&v; }

DEV void conv8_silu(const unsigned char* __restrict__ qkv_pre8, const float* __restrict__ cw, int r, int ch0, float (&y)[8]) {
  int t, T;
  if (r < NLAT) { t = r & (SEQ - 1); T = SEQ; } else { t = (r - NLAT) & (CTX - 1); T = CTX; }
  const int base = r - t;
  uint2 xv[4];
#pragma unroll
  for (int j = 0; j < 4; ++j) {
    const int tt = t + j - 2;
    const bool ok = (tt >= 0 && tt < T);
    xv[j] = *(const uint2*)(qkv_pre8 + (size_t)(base + (ok ? tt : t)) * 1536 + ch0);
    if (!ok) xv[j] = make_uint2(0u, 0u);
  }
#pragma unroll
  for (int e = 0; e < 8; ++e) y[e] = 0.f;
#pragma unroll
  for (int j = 0; j < 4; ++j) {
    const float4 w0 = *(const float4*)(cw + j * 1536 + ch0), w1 = *(const float4*)(cw + j * 1536 + ch0 + 4);
    const f32x2 a0 = __builtin_amdgcn_cvt_pk_f32_fp8(xv[j].x, false), a1 = __builtin_amdgcn_cvt_pk_f32_fp8(xv[j].x, true);
    const f32x2 a2 = __builtin_amdgcn_cvt_pk_f32_fp8(xv[j].y, false), a3 = __builtin_amdgcn_cvt_pk_f32_fp8(xv[j].y, true);
    y[0] += w0.x * a0[0]; y[1] += w0.y * a0[1]; y[2] += w0.z * a1[0]; y[3] += w0.w * a1[1];
    y[4] += w1.x * a2[0]; y[5] += w1.y * a2[1]; y[6] += w1.z * a3[0]; y[7] += w1.w * a3[1];
  }
#pragma unroll
  for (int e = 0; e < 8; ++e) y[e] = siluf_(y[e]);
}

__device__ __forceinline__ void phase_prep(int layer, char* smem) {
  const KP PP = get_params();
  const int tid0 = TID();
  const int w = __builtin_amdgcn_readfirstlane(tid0 >> 6);
  char* Kt = smem;
  char* Vt = smem + 16384;
  float* Ld = (float*)(smem + 32768);
  u16* LN = (u16*)(smem + 32768 + 5120);
  float* gcs = (float*)(smem + 32768 + 5120 + 9216);
  float* bts = gcs + 64;
  char* wpriv = smem + 32768 + 5120 + 9216 + 512 + w * 6144;
  float* Tt = (float*)wpriv;
  u16* Xb = (u16*)(wpriv + 4096);
  for (int j_ = BID() >> 3; j_ < 2 * NCHUNK; j_ += (gridDim.x >> 3)) {
    const int c = NCHUNK - 1 - (j_ >> 1), u16i = (BID() & 7) * 2 + (j_ & 1);
    const int unit = u16i * NCHUNK + c;
    const int dir = u16i & 1, hd = (u16i >> 1) & 3, b = u16i >> 3;
    int tid = tid0;
    asm volatile("" : "+v"(tid));
    const int l = tid & 63, lr = l & 15, lg = l >> 4;
    __syncthreads();
    if (tid < 64) {
      const int rr = seq_row(b, dir, c * 64 + tid);
      const int jj = dir * 4 + hd;
      bts[tid] = sigmoidf_(PP->ba[(size_t)rr * 16 + jj]);
      float g;
      {
        const float xx = PP->ba[(size_t)rr * 16 + 8 + jj] + PP->dt_bias[layer * 8 + jj];
        const float ee = __expf(xx);
        const float sp = xx > 20.f ? xx : (ee < 0.03125f ? ee * (1.f - ee * (0.5f - ee * (0.33333334f - 0.25f * ee))) : __logf(1.f + ee));
        g = -__expf(PP->a_log[layer * 8 + jj]) * sp;
      }
#pragma unroll
      for (int o = 1; o < 64; o <<= 1) {
        const float t = __builtin_bit_cast(float, __builtin_amdgcn_ds_bpermute(((tid - o) & 63) << 2, __builtin_bit_cast(int, g)));
        if (tid >= o) g += t;
      }
      gcs[tid] = g;
      PP->gc[(size_t)unit * 64 + tid] = g;
    }
    {
      const unsigned char* pre8 = (const unsigned char*)PP->qkv_pre;
      const float* cw = PP->conv_w + (size_t)layer * 4 * 1536;
      const int ch = tid & 15, rg = tid >> 4;
      const int r_first = seq_row(b, dir, c * 64 + 4 * rg);
      int t0, T;
      if (r_first < NLAT) { t0 = r_first & (SEQ - 1); T = SEQ; } else { t0 = (r_first - NLAT) & (CTX - 1); T = CTX; }
      const int base = r_first - t0;
      const int tl = dir ? t0 - 3 : t0;
      const int nparts = dir == 0 ? 3 : 2;
      for (int part = 0; part < nparts; ++part) {
        const int chofs = (part == 0 ? 512 : (part == 1 ? 1024 : 0)) + hd * 128 + ch * 8;
        f32x2 wv[4][4];
#pragma unroll
        for (int j = 0; j < 4; ++j) {
          const float4 w0 = *(const float4*)(cw + j * 1536 + chofs), w1 = *(const float4*)(cw + j * 1536 + chofs + 4);
          wv[j][0] = (f32x2){w0.x, w0.y}; wv[j][1] = (f32x2){w0.z, w0.w};
          wv[j][2] = (f32x2){w1.x, w1.y}; wv[j][3] = (f32x2){w1.z, w1.w};
        }
        uint2 xr[7];
#pragma unroll
        for (int m = 0; m < 7; ++m) {
          const int tt = tl - 2 + m;
          const bool ok = (tt >= 0 && tt < T);
          xr[m] = *(const uint2*)(pre8 + (size_t)(base + (ok ? tt : t0)) * 1536 + chofs);
          if (!ok) xr[m] = make_uint2(0u, 0u);
        }
        f32x2 xf[7][4];
#pragma unroll
        for (int m = 0; m < 7; ++m) {
          xf[m][0] = __builtin_amdgcn_cvt_pk_f32_fp8(xr[m].x, false); xf[m][1] = __builtin_amdgcn_cvt_pk_f32_fp8(xr[m].x, true);
          xf[m][2] = __builtin_amdgcn_cvt_pk_f32_fp8(xr[m].y, false); xf[m][3] = __builtin_amdgcn_cvt_pk_f32_fp8(xr[m].y, true);
        }
        f32x2 acc2[4][4];
        if (dir == 0) {
#pragma unroll
          for (int s4 = 0; s4 < 4; ++s4)
#pragma unroll
            for (int p = 0; p < 4; ++p) {
              f32x2 a = wv[0][p] * xf[s4][p];
#pragma unroll
              for (int j = 1; j < 4; ++j) a += wv[j][p] * xf[s4 + j][p];
              acc2[s4][p] = a;
            }
        } else {
#pragma unroll
          for (int s4 = 0; s4 < 4; ++s4)
#pragma unroll
            for (int p = 0; p < 4; ++p) {
              f32x2 a = wv[0][p] * xf[3 - s4][p];
#pragma unroll
              for (int j = 1; j < 4; ++j) a += wv[j][p] * xf[3 - s4 + j][p];
              acc2[s4][p] = a;
            }
        }
        float y[4][8], ss[4];
#pragma unroll
        for (int s4 = 0; s4 < 4; ++s4) {
          float t = 0.f;
#pragma unroll
          for (int p = 0; p < 4; ++p) {
            const float a0 = siluf_(acc2[s4][p][0]), a1 = siluf_(acc2[s4][p][1]);
            y[s4][2 * p] = a0; y[s4][2 * p + 1] = a1;
            t += a0 * a0 + a1 * a1;
          }
          ss[s4] = t;
        }
        if (part != 1) {
#pragma unroll
          for (int s4 = 0; s4 < 4; ++s4) ss[s4] += swz_xor<8>(ss[s4]);
#pragma unroll
          for (int s4 = 0; s4 < 4; ++s4) ss[s4] += swz_xor<4>(ss[s4]);
#pragma unroll
          for (int s4 = 0; s4 < 4; ++s4) ss[s4] += swz_xor<2>(ss[s4]);
#pragma unroll
          for (int s4 = 0; s4 < 4; ++s4) ss[s4] += swz_xor<1>(ss[s4]);
#pragma unroll
          for (int s4 = 0; s4 < 4; ++s4) {
            const float sc = rsqrtf(ss[s4] + EPS) * (part == 2 ? 0.08838834764831845f : 1.f);
#pragma unroll
            for (int e2 = 0; e2 < 8; ++e2) y[s4][e2] *= sc;
          }
        }
#pragma unroll
        for (int s4 = 0; s4 < 4; ++s4) {
          const int m0_ = dir ? 3 - s4 : s4;
          const uint4 pk = pack8(y[s4]);
          const int i = 4 * rg + s4;
          if (part < 2) *(uint4*)((part == 0 ? Kt : Vt) + i * 256 + ((ch ^ (i & 15)) << 4)) = pk;
          if (dir == 0 && part != 1) *(uint4*)(PP->qkvn + (size_t)(base + tl + m0_) * 1536 + chofs) = pk;
        }
      }
    }
    __syncthreads();
    {
      f32x4 acc[4];
#pragma unroll
      for (int nt = 0; nt < 4; ++nt) acc[nt] = (f32x4){0.f, 0.f, 0.f, 0.f};
#pragma unroll
      for (int s = 0; s < 4; ++s) {
        const int ch = s * 4 + lg;
        const bf16x8 a = *(const bf16x8*)(Kt + (16 * w + lr) * 256 + ((ch ^ lr) << 4));
#pragma unroll
        for (int nt = 0; nt < 4; ++nt) {
          const bf16x8 bb = *(const bf16x8*)(Kt + (16 * nt + lr) * 256 + ((ch ^ lr) << 4));
          acc[nt] = __builtin_amdgcn_mfma_f32_16x16x32_bf16(a, bb, acc[nt], 0, 0, 0);
        }
      }
#pragma unroll
      for (int nt = 0; nt < 4; ++nt)
#pragma unroll
        for (int r = 0; r < 4; ++r) {
          const int i = 16 * w + 4 * lg + r, j = 16 * nt + lr;
          const float val = (j < i) ? bts[i] * acc[nt][r] * __expf(fminf(gcs[i] - gcs[j], 0.f)) : 0.f;
          LN[i * 72 + j] = f2bf(-val);
          if (nt == w) Ld[(w * 16 + lr) * 20 + 4 * lg + r] = val;
        }
    }
    {
      const float glast = gcs[63];
      if (tid == 0) PP->glast[unit] = glast;
#pragma unroll
      for (int q4 = 0; q4 < 4; ++q4) {
        const int fid = tid + 256 * q4;
        const int mt = fid >> 7, s2 = (fid >> 6) & 1, ln = fid & 63, llr = ln & 15, llg = ln >> 4;
        const int d = 16 * mt + llr;
        float f[8];
#pragma unroll
        for (int e = 0; e < 8; ++e) {
          const int pos = kperm(s2, llg, e);
          const float kv = bf2f(*(const u16*)(Kt + pos * 256 + (((d >> 3) ^ (pos & 15)) << 4) + (d & 7) * 2));
          f[e] = kv * __expf(glast - gcs[pos]);
        }
        *(uint4*)(PP->KdT + ((size_t)unit * 1024 + fid) * 8) = pack8(f);
      }
    }
    f32x4 X[4][4];
    {
      const bool isU = w >= 2;
      const char* tile = isU ? Vt : Kt;
#pragma unroll
      for (int mt = 0; mt < 4; ++mt)
#pragma unroll
        for (int nt = 0; nt < 4; ++nt)
#pragma unroll
          for (int r = 0; r < 4; ++r) {
            const int i = 16 * mt + 4 * lg + r, cc = 64 * (w & 1) + 16 * nt + lr;
            const float val = bf2f(*(const u16*)(tile + i * 256 + (((cc >> 3) ^ (i & 15)) << 4) + (cc & 7) * 2));
            X[mt][nt][r] = bts[i] * val * (isU ? 1.f : __expf(gcs[i]));
          }
    }
    __syncthreads();
    u16* Wst = (u16*)smem;
    u16* Ust = (u16*)(smem + 16384);
#pragma unroll
    for (int bk = 0; bk < 4; ++bk) {
#pragma unroll
      for (int nt = 0; nt < 4; ++nt)
#pragma unroll
        for (int r = 0; r < 4; ++r) Tt[(4 * lg + r) * 64 + 16 * nt + lr] = X[bk][nt][r];
      __builtin_amdgcn_wave_barrier();
      asm volatile("s_waitcnt lgkmcnt(0)" ::: "memory");
      float xb[16];
#pragma unroll
      for (int i = 0; i < 16; ++i) xb[i] = Tt[i * 64 + l];
#pragma unroll
      for (int j = 0; j < 15; ++j) {
        const float xj = xb[j];
#pragma unroll
        for (int i4 = (j + 1) / 4; i4 < 4; ++i4) {
          const float4 lv = *(const float4*)&Ld[(bk * 16 + j) * 20 + i4 * 4];
          if (i4 * 4 + 0 > j) xb[i4 * 4 + 0] -= lv.x * xj;
          if (i4 * 4 + 1 > j) xb[i4 * 4 + 1] -= lv.y * xj;
          if (i4 * 4 + 2 > j) xb[i4 * 4 + 2] -= lv.z * xj;
          if (i4 * 4 + 3 > j) xb[i4 * 4 + 3] -= lv.w * xj;
        }
      }
      {
        const int cc = 64 * (w & 1) + l;
        if (w < 2) {
          const int d = cc, s = d >> 5, e = ((d >> 4) & 1) * 4 + (d & 3), g = (d >> 2) & 3;
#pragma unroll
          for (int ii = 0; ii < 16; ++ii) Wst[(((bk * 4 + s) * 64 + g * 16 + ii) << 3) + e] = f2bf(-xb[ii]);
        } else {
          const int slice = cc >> 4, lr_ = cc & 15;
#pragma unroll
          for (int ii = 0; ii < 16; ++ii) Ust[(((slice * 4 + bk) * 64 + ((ii >> 2) & 3) * 16 + lr_) << 2) + (ii & 3)] = f2bf(xb[ii]);
        }
        if (bk < 3) {
          *(uint4*)(Xb + l * 16) = pack8(xb);
          *(uint4*)(Xb + l * 16 + 8) = pack8(xb + 8);
        }
      }
      if (bk < 3) {
        __builtin_amdgcn_wave_barrier();
        asm volatile("s_waitcnt lgkmcnt(0)" ::: "memory");
        uint4 bfr[4];
#pragma unroll
        for (int nt = 0; nt < 4; ++nt)
          bfr[nt] = (lg < 2) ? *(const uint4*)(Xb + (16 * nt + lr) * 16 + 8 * lg) : make_uint4(0u, 0u, 0u, 0u);
#pragma unroll
        for (int mt = bk + 1; mt < 4; ++mt) {
          const uint4 afr = (lg < 2) ? *(const uint4*)(LN + (16 * mt + lr) * 72 + 16 * bk + 8 * lg) : make_uint4(0u, 0u, 0u, 0u);
#pragma unroll
          for (int nt = 0; nt < 4; ++nt)
            X[mt][nt] = __builtin_amdgcn_mfma_f32_16x16x32_bf16(as_frag(afr), as_frag(bfr[nt]), X[mt][nt], 0, 0, 0);
        }
        __builtin_amdgcn_wave_barrier();
      }
    }
    __syncthreads();
#pragma unroll
    for (int q = 0; q < 4; ++q) {
      const int id = tid + 256 * q;
      *(uint4*)(PP->Wfrag + ((size_t)unit * 1024 + id) * 8) = *(const uint4*)(smem + id * 16);
      *(uint4*)(PP->Ufrag + ((size_t)unit * 1024 + id) * 8) = *(const uint4*)(smem + 16384 + id * 16);
    }
  }
}


__device__ __forceinline__ void phase_scan(char* smem) {
  const KP PP = get_params();
  const int tid = TID(), lane = tid & 63, wv = tid >> 6;
  __builtin_amdgcn_s_setprio(3);
  for (int item = BID(); item < 128; item += gridDim.x) {
    const int u16i = (item & 7) * 2 + (item >> 6), slice = (item >> 3) & 7;
    const size_t ubase = (size_t)u16i * NCHUNK;
    const uint4* Wg = (const uint4*)PP->Wfrag;
    const uint4* Kg = (const uint4*)PP->KdT;
    __syncthreads();
    if (wv != 0) {
      const int j0 = wv - 1;
      uint4 st0[11], st1[11], st2[11];
#pragma unroll
      for (int i = 0; i < 11; ++i) { st0[i] = make_uint4(0u, 0u, 0u, 0u); st1[i] = st0[i]; st2[i] = st0[i]; }
#define LLOAD(ST, UNIT)                                                                                      \
  _Pragma("unroll") for (int i = 0; i < 11; ++i) {                                                           \
    const int q = (j0 + 3 * i) < 32 ? (j0 + 3 * i) : 31;                                                     \
    ST[i] = *((q < 16 ? Wg + (UNIT) * 1024 + q * 64 : Kg + (UNIT) * 1024 + (q - 16) * 64) + lane);           \
  }
#define LWRITE(ST, SLOT)                                                                                     \
  _Pragma("unroll") for (int i = 0; i < 11; ++i) {                                                           \
    const int q = (j0 + 3 * i) < 32 ? (j0 + 3 * i) : 31;                                                     \
    *(uint4*)((SLOT) + q * 1024 + lane * 16) = ST[i];                                                        \
  }
      LLOAD(st0, ubase);
      LLOAD(st1, ubase + 1);
      LLOAD(st2, ubase + 2);
      LWRITE(st0, smem);
      LLOAD(st0, ubase + 3);
      __syncthreads();
#define LSTEP(ST, C)                                                                   \
  {                                                                                    \
    LWRITE(ST, smem + (((C) + 1) & 1) * 32768);                                        \
    LLOAD(ST, ubase + (size_t)(((C) + 4 < NCHUNK) ? (C) + 4 : NCHUNK - 1));            \
    __syncthreads();                                                                   \
  }
      for (int c0 = 0; c0 < NCHUNK; c0 += 3) {
        LSTEP(st1, c0);
        LSTEP(st2, c0 + 1);
        LSTEP(st0, c0 + 2);
      }
#undef LSTEP
#undef LLOAD
#undef LWRITE
    } else {
      f32x4 S[8];
#pragma unroll
      for (int t = 0; t < 8; ++t) S[t] = (f32x4){0.f, 0.f, 0.f, 0.f};
      uint2 uf0[5], uf1[5], uf2[5];
#pragma unroll
      for (int i = 0; i < 5; ++i) { uf0[i] = make_uint2(0u, 0u); uf1[i] = uf0[i]; uf2[i] = uf0[i]; }
      const uint2* Ug = (const uint2*)PP->Ufrag + lane;
      const float* Gl = PP->glast;
#define ULOAD(UF, UNIT) { _Pragma("unroll") for (int i = 0; i < 4; ++i) UF[i] = Ug[((UNIT) * 8 + slice) * 256 + i * 64]; UF[4].x = __float_as_uint(Gl[UNIT]); }
      ULOAD(uf0, ubase);
      ULOAD(uf1, ubase + 1);
      ULOAD(uf2, ubase + 2);
#define CSTEP(UF, C)                                                                                                   \
  {                                                                                                                    \
    const int c = (C);                                                                                                 \
    const size_t unit = ubase + c;                                                                                     \
    const char* slot = smem + (c & 1) * 32768;                                                                         \
    const float el = __expf(__uint_as_float(UF[4].x));                                                                 \
    uint4 sb[4];                                                                                                       \
    _Pragma("unroll") for (int s2 = 0; s2 < 4; ++s2) sb[s2] = pack_tiles(S[2 * s2], S[2 * s2 + 1]);                    \
    {                                                                                                                  \
      uint4* sp = (uint4*)PP->Sfrag + (unit * 8 + slice) * 256 + lane;                                                 \
      _Pragma("unroll") for (int s2 = 0; s2 < 4; ++s2) sp[s2 * 64] = sb[s2];                                           \
    }                                                                                                                  \
    f32x4 vn[4];                                                                                                       \
    _Pragma("unroll") for (int mt = 0; mt < 4; ++mt) {                                                                 \
      vn[mt] = (f32x4){bf_lo(UF[mt].x), bf_hi(UF[mt].x), bf_lo(UF[mt].y), bf_hi(UF[mt].y)};                            \
      _Pragma("unroll") for (int s2 = 0; s2 < 4; ++s2) {                                                               \
        const uint4 wfr = *(const uint4*)(slot + (mt * 4 + s2) * 1024 + lane * 16);                                    \
        vn[mt] = __builtin_amdgcn_mfma_f32_16x16x32_bf16(as_frag(wfr), as_frag(sb[s2]), vn[mt], 0, 0, 0);              \
      }                                                                                                                \
    }                                                                                                                  \
    ULOAD(UF, ubase + (size_t)((c + 3 < NCHUNK) ? c + 3 : NCHUNK - 1));                                                \
    uint4 vb[2];                                                                                                       \
    vb[0] = pack_tiles(vn[0], vn[1]);                                                                                  \
    vb[1] = pack_tiles(vn[2], vn[3]);                                                                                  \
    {                                                                                                                  \
      uint4* vp = (uint4*)PP->Vfrag + (unit * 8 + slice) * 128 + lane;                                                 \
      vp[0] = vb[0];                                                                                                   \
      vp[64] = vb[1];                                                                                                  \
    }                                                                                                                  \
    _Pragma("unroll") for (int t = 0; t < 8; ++t) {                                                                    \
      S[t] *= el;                                                                                                      \
      const uint4 k0 = *(const uint4*)(slot + 16384 + (t * 2 + 0) * 1024 + lane * 16);                                 \
      const uint4 k1 = *(const uint4*)(slot + 16384 + (t * 2 + 1) * 1024 + lane * 16);                                 \
      S[t] = __builtin_amdgcn_mfma_f32_16x16x32_bf16(as_frag(k0), as_frag(vb[0]), S[t], 0, 0, 0);                      \
      S[t] = __builtin_amdgcn_mfma_f32_16x16x32_bf16(as_frag(k1), as_frag(vb[1]), S[t], 0, 0, 0);                      \
    }                                                                                                                  \
    __syncthreads();                                                                                                   \
  }
      __syncthreads();
      for (int c0 = 0; c0 < NCHUNK; c0 += 3) {
        CSTEP(uf0, c0);
        CSTEP(uf1, c0 + 1);
        CSTEP(uf2, c0 + 2);
      }
#undef CSTEP
#undef ULOAD
    }
  }
  __builtin_amdgcn_s_setprio(0);
}

__device__ __forceinline__ void phase_o(int layer, char* smem) {
  const KP PP = get_params();
  const int tid = TID(), l = tid & 63, w = tid >> 6, lr = l & 15, lg = l >> 4;
  char* Qt = smem;
  char* Kt = smem + 16384;
  u16* If = (u16*)(smem + 32768);
  u16* Ib = (u16*)(smem + 41984);
  float* gcf = (float*)(smem + 51200);
  float* gcb = gcf + 64;
  float* rowss = gcb + 64;
  float* Os = (float*)smem;
  const int nper = (layer == DEPTH - 1) ? 128 : 132;
  const int xq = BID() & 7, vl0 = BID() >> 3, vstep = gridDim.x >> 3;
  for (int vi = vl0; vi < nper; vi += vstep) {
    int b = xq >> 2, hd = xq & 3, tok0, cf, cb;
    if (vi < 128) {
      const int n = vi;
      tok0 = b * SEQ + 64 * n; cf = 4 + n; cb = 4 + 127 - n;
    } else {
      const int n = vi - 128;
      tok0 = NLAT + b * CTX + 64 * n; cf = n; cb = 3 - n;
    }
    const size_t unit_f = (size_t)((b * 4 + hd) * 2 + 0) * NCHUNK + cf;
    const size_t unit_b = (size_t)((b * 4 + hd) * 2 + 1) * NCHUNK + cb;
    uint4 pSF[4][2], pSB[4][2], pVF[2][2], pVB[2][2];
#pragma unroll
    for (int q = 0; q < 2; ++q) {
      const int sl = 2 * w + q;
#pragma unroll
      for (int s = 0; s < 4; ++s) {
        pSF[s][q] = *((const uint4*)PP->Sfrag + ((unit_f * 8 + sl) * 4 + s) * 64 + l);
        pSB[s][q] = *((const uint4*)PP->Sfrag + ((unit_b * 8 + sl) * 4 + s) * 64 + l);
      }
#pragma unroll
      for (int s2 = 0; s2 < 2; ++s2) {
        pVF[s2][q] = *((const uint4*)PP->Vfrag + ((unit_f * 8 + sl) * 2 + s2) * 64 + l);
        pVB[s2][q] = *((const uint4*)PP->Vfrag + ((unit_b * 8 + sl) * 2 + s2) * 64 + l);
      }
    }
    __syncthreads();
    for (int idx = tid; idx < 2048; idx += NTHR) {
      const int arr = idx >> 10, i = (idx >> 4) & 63, ch = idx & 15;
      const uint4 v = *(const uint4*)(PP->qkvn + (size_t)(tok0 + i) * 1536 + (arr == 0 ? 0 : 512) + hd * 128 + ch * 8);
      *(uint4*)((arr == 0 ? Qt : Kt) + i * 256 + ((ch ^ (i & 15)) << 4)) = v;
    }
    if (tid < 64) gcf[tid] = PP->gc[unit_f * 64 + tid];
    else if (tid < 128) gcb[tid - 64] = PP->gc[unit_b * 64 + (tid - 64)];
    __syncthreads();
    {
      f32x4 acc[4];
#pragma unroll
      for (int nt = 0; nt < 4; ++nt) acc[nt] = (f32x4){0.f, 0.f, 0.f, 0.f};
#pragma unroll
      for (int s = 0; s < 4; ++s) {
        const int ch = s * 4 + lg;
        const bf16x8 a = *(const bf16x8*)(Qt + (16 * w + lr) * 256 + ((ch ^ lr) << 4));
#pragma unroll
        for (int nt = 0; nt < 4; ++nt) {
          const bf16x8 bb = *(const bf16x8*)(Kt + (16 * nt + lr) * 256 + ((ch ^ lr) << 4));
          acc[nt] = __builtin_amdgcn_mfma_f32_16x16x32_bf16(a, bb, acc[nt], 0, 0, 0);
        }
      }
#pragma unroll
      for (int nt = 0; nt < 4; ++nt)
#pragma unroll
        for (int r = 0; r < 4; ++r) {
          const int i = 16 * w + 4 * lg + r, j = 16 * nt + lr;
          const float vf = (j <= i) ? acc[nt][r] * __expf(fminf(gcf[i] - gcf[j], 0.f)) : 0.f;
          const float vb = (j >= i) ? acc[nt][r] * __expf(fminf(gcb[63 - i] - gcb[63 - j], 0.f)) : 0.f;
          If[i * 72 + j] = f2bf(vf);
          Ib[i * 72 + (63 - j)] = f2bf(vb);
        }
    }
    __syncthreads();
    f32x4 accF[4][2], accB[4][2], accI[4][2];
#pragma unroll
    for (int mt = 0; mt < 4; ++mt)
#pragma unroll
      for (int q = 0; q < 2; ++q) {
        accF[mt][q] = (f32x4){0.f, 0.f, 0.f, 0.f};
        accB[mt][q] = (f32x4){0.f, 0.f, 0.f, 0.f};
        accI[mt][q] = (f32x4){0.f, 0.f, 0.f, 0.f};
      }
#pragma unroll
    for (int s = 0; s < 4; ++s) {
      bf16x8 qa[4];
#pragma unroll
      for (int mt = 0; mt < 4; ++mt) {
        const int row = 16 * mt + lr;
        const int c0 = 4 * s + (lg >> 1), c1 = c0 + 2;
        const uint2 lo = *(const uint2*)(Qt + row * 256 + ((c0 ^ lr) << 4) + (lg & 1) * 8);
        const uint2 hi = *(const uint2*)(Qt + row * 256 + ((c1 ^ lr) << 4) + (lg & 1) * 8);
        const uint4 t = make_uint4(lo.x, lo.y, hi.x, hi.y);
        qa[mt] = as_frag(t);
      }
#pragma unroll
      for (int q = 0; q < 2; ++q) {
        const int sl = 2 * w + q;
        const uint4 bF = pSF[s][q], bB = pSB[s][q];
#pragma unroll
        for (int mt = 0; mt < 4; ++mt) {
          accF[mt][q] = __builtin_amdgcn_mfma_f32_16x16x32_bf16(qa[mt], as_frag(bF), accF[mt][q], 0, 0, 0);
          accB[mt][q] = __builtin_amdgcn_mfma_f32_16x16x32_bf16(qa[mt], as_frag(bB), accB[mt][q], 0, 0, 0);
        }
      }
    }
#pragma unroll
    for (int s2 = 0; s2 < 2; ++s2) {
      bf16x8 ia[4], ib[4];
#pragma unroll
      for (int mt = 0; mt < 4; ++mt) {
        const int row = 16 * mt + lr;
        const int col = 32 * s2 + 4 * lg;
        const uint2 flo = *(const uint2*)(If + row * 72 + col);
        const uint2 fhi = *(const uint2*)(If + row * 72 + col + 16);
        const uint2 blo = *(const uint2*)(Ib + row * 72 + col);
        const uint2 bhi = *(const uint2*)(Ib + row * 72 + col + 16);
        const uint4 tf = make_uint4(flo.x, flo.y, fhi.x, fhi.y);
        const uint4 tb = make_uint4(blo.x, blo.y, bhi.x, bhi.y);
        ia[mt] = as_frag(tf);
        ib[mt] = as_frag(tb);
      }
#pragma unroll
      for (int q = 0; q < 2; ++q) {
        const int sl = 2 * w + q;
        const uint4 vF = pVF[s2][q], vB = pVB[s2][q];
#pragma unroll
        for (int mt = 0; mt < 4; ++mt) {
          accI[mt][q] = __builtin_amdgcn_mfma_f32_16x16x32_bf16(ia[mt], as_frag(vF), accI[mt][q], 0, 0, 0);
          accI[mt][q] = __builtin_amdgcn_mfma_f32_16x16x32_bf16(ib[mt], as_frag(vB), accI[mt][q], 0, 0, 0);
        }
      }
    }
    float o[4][2][4];
#pragma unroll
    for (int mt = 0; mt < 4; ++mt)
#pragma unroll
      for (int r = 0; r < 4; ++r) {
        const int i = 16 * mt + 4 * lg + r;
        const float ef = __expf(gcf[i]), eb = __expf(gcb[63 - i]);
        float ss = 0.f;
#pragma unroll
        for (int q = 0; q < 2; ++q) {
          const float v = ef * accF[mt][q][r] + eb * accB[mt][q][r] + accI[mt][q][r];
          o[mt][q][r] = v;
          ss += v * v;
        }
        ss = group16_sum(ss);
        if (lr == 0) rowss[w * 64 + i] = ss;
      }
    __syncthreads();
#pragma unroll
    for (int mt = 0; mt < 4; ++mt)
#pragma unroll
      for (int q = 0; q < 2; ++q)
#pragma unroll
        for (int r = 0; r < 4; ++r) Os[(16 * mt + 4 * lg + r) * 132 + 16 * (2 * w + q) + lr] = o[mt][q][r];
    __syncthreads();
#pragma unroll
    for (int q4 = 0; q4 < 4; ++q4) {
      const int idx = tid + 256 * q4, i = idx >> 4, ch = idx & 15;
      const float ss = rowss[i] + rowss[64 + i] + rowss[128 + i] + rowss[192 + i];
      const float rs = rsqrtf(ss * (1.f / 128.f) + EPS);
      const float4 o0 = *(const float4*)&Os[i * 132 + ch * 8];
      const float4 o1 = *(const float4*)&Os[i * 132 + ch * 8 + 4];
      const float4 n0 = *(const float4*)(PP->dn_out_norm + layer * 128 + ch * 8);
      const float4 n1 = *(const float4*)(PP->dn_out_norm + layer * 128 + ch * 8 + 4);
      float zf[8];
      unpack8(*(const uint4*)(PP->z + (size_t)(tok0 + i) * 512 + hd * 128 + ch * 8), zf);
      float y[8];
      y[0] = o0.x * rs * n0.x * siluf_(zf[0]); y[1] = o0.y * rs * n0.y * siluf_(zf[1]);
      y[2] = o0.z * rs * n0.z * siluf_(zf[2]); y[3] = o0.w * rs * n0.w * siluf_(zf[3]);
      y[4] = o1.x * rs * n1.x * siluf_(zf[4]); y[5] = o1.y * rs * n1.y * siluf_(zf[5]);
      y[6] = o1.z * rs * n1.z * siluf_(zf[6]); y[7] = o1.w * rs * n1.w * siluf_(zf[7]);
      {
        int p0 = __builtin_amdgcn_cvt_pk_fp8_f32(y[0], y[1], 0, false);
        p0 = __builtin_amdgcn_cvt_pk_fp8_f32(y[2], y[3], p0, true);
        int p1 = __builtin_amdgcn_cvt_pk_fp8_f32(y[4], y[5], 0, false);
        p1 = __builtin_amdgcn_cvt_pk_fp8_f32(y[6], y[7], p1, true);
        *(int2*)((char*)PP->ydn + (size_t)(tok0 + i) * (LDK5 * 2) + hd * 128 + ch * 8) = make_int2(p0, p1);
      }
    }
  }
}

template <int HALF>
DEV void pool_window(const u16* xin, char* Ap, int t0, int L, int tid) {
#pragma unroll
  for (int q = 0; q < 4; ++q) {
    const int idx = tid + 256 * q, i = idx >> 4, c = idx & 15;
    const int t = t0 + i;
    const int lo = (t - HALF) > 0 ? (t - HALF) : 0;
    const int hi = (t + HALF) < L ? (t + HALF) : L;
    float s[8];
#pragma unroll
    for (int e = 0; e < 8; ++e) s[e] = 0.f;
#pragma unroll
    for (int k = 0; k < 2 * HALF; ++k) {
      float f[8];
      unpack8(*(const uint4*)(xin + (i + 8 - HALF + k) * 128 + c * 8), f);
#pragma unroll
      for (int e = 0; e < 8; ++e) s[e] += f[e];
    }
    float xs[8];
    unpack8(*(const uint4*)(xin + (i + 8) * 128 + c * 8), xs);
    const float inv = 1.f / (float)(hi - lo);
#pragma unroll
    for (int e = 0; e < 8; ++e) s[e] = s[e] * inv - xs[e];
    *(uint4*)(Ap + i * 256 + ((c ^ (i & 15)) << 4)) = pack8(s);
  }
}

__device__ __forceinline__ void phase_pool(int layer, char* smem, int vbid, int vnb) {
  const KP PP = get_params();
  const int tid = TID(), l = tid & 63, w = tid >> 6, lr = l & 15, lg = l >> 4;
  u16* xin = (u16*)smem;
  char* Ap = smem + 20480;
  char* Bs = smem + 36864;
  const int ntile = (layer == DEPTH - 1) ? NLAT / 64 : R / 64;
  for (int it = vbid; it < ntile * 4; it += vnb) {
    const int ti = it >> 2, g = it & 3;
    int L, t0, rowbase;
    if (ti < NLAT / 64) { L = 64; t0 = 0; rowbase = ti * 64; }
    else { const int ci = ti - NLAT / 64; L = CTX; t0 = (ci & 3) * 64; rowbase = NLAT + (ci >> 2) * CTX; }
    const int r0 = rowbase + t0;
    __syncthreads();
#pragma unroll
    for (int q = 0; q < 5; ++q) {
      const int idx = tid + 256 * q, i = idx >> 4, c = idx & 15;
      const int pos = t0 - 8 + i;
      uint4 v = make_uint4(0, 0, 0, 0);
      if (pos >= 0 && pos < L) v = *(const uint4*)(PP->pin + (size_t)(rowbase + pos) * 512 + g * 128 + c * 8);
      *(uint4*)(xin + i * 128 + c * 8) = v;
    }
    {
      const u16* Bw = PP->PwT + (size_t)(layer * 4 + g) * 128 * 128;
#pragma unroll
      for (int q = 0; q < 8; ++q) {
        const int idx = tid + 256 * q, n = idx >> 4, c = idx & 15;
        *(uint4*)(Bs + n * 256 + ((c ^ (n & 15)) << 4)) = *(const uint4*)(Bw + (size_t)n * 128 + c * 8);
      }
    }
    __syncthreads();
    if (g == 0) pool_window<1>(xin, Ap, t0, L, tid);
    else if (g == 1) pool_window<2>(xin, Ap, t0, L, tid);
    else if (g == 2) pool_window<4>(xin, Ap, t0, L, tid);
    else pool_window<8>(xin, Ap, t0, L, tid);
    __syncthreads();
    f32x4 acc[8];
#pragma unroll
    for (int ni = 0; ni < 8; ++ni) acc[ni] = (f32x4){0.f, 0.f, 0.f, 0.f};
#pragma unroll
    for (int ks = 0; ks < 4; ++ks) {
      const int row = w * 16 + lr, c = ks * 4 + lg;
      const bf16x8 a = *(const bf16x8*)(Ap + row * 256 + ((c ^ lr) << 4));
#pragma unroll
      for (int ni = 0; ni < 8; ++ni) {
        const bf16x8 bb = *(const bf16x8*)(Bs + (ni * 16 + lr) * 256 + ((c ^ lr) << 4));
        acc[ni] = __builtin_amdgcn_mfma_f32_16x16x32_bf16(bb, a, acc[ni], 0, 0, 0);
      }
    }
    unsigned char* ot = (unsigned char*)smem;
#pragma unroll
    for (int ni = 0; ni < 8; ++ni) {
      const int dcol = ni * 16 + 4 * lg;
      const float4 psc = *(const float4*)(PP->pool_scale + layer * 512 + g * 128 + dcol);
      int pk = __builtin_amdgcn_cvt_pk_fp8_f32(acc[ni][0] * psc.x, acc[ni][1] * psc.y, 0, false);
      pk = __builtin_amdgcn_cvt_pk_fp8_f32(acc[ni][2] * psc.z, acc[ni][3] * psc.w, pk, true);
      *(int*)(ot + (w * 16 + lr) * 128 + dcol) = pk;
    }
    __syncthreads();
    {
      const int row = tid >> 2, seg = tid & 3;
      const uint4 o0 = *(const uint4*)(ot + row * 128 + seg * 32), o1 = *(const uint4*)(ot + row * 128 + seg * 32 + 16);
      unsigned char* dst = (unsigned char*)PP->ypool + (size_t)(r0 + row) * (LDK5 * 2) + g * 128 + seg * 32;
      *(uint4*)dst = o0;
      *(uint4*)(dst + 16) = o1;
    }
  }
}

__device__ __forceinline__ void phase_merge(int layer, char* smem) {
  const KP PP = get_params();
  const char* Bd = (const char*)(PP->WdT + (size_t)layer * 1024 * LDK5);
  const char* Bp = (const char*)(PP->WpT + (size_t)layer * 1024 * LDK5);
  const char* Ad = (const char*)PP->ydn;
  const char* Ap = (const char*)PP->ypool;
  const int tid = TID();
  const int l = tid & 63, w = tid >> 6, wm = w >> 1, wn = w & 1, lr = l & 15, lg = l >> 4;
  uint4 ga[4], gb[4];
#pragma unroll
  for (int i = 0; i < 4; ++i) { ga[i] = make_uint4(0u, 0u, 0u, 0u); gb[i] = ga[i]; }
  const int r0 = tid >> 3, c0 = tid & 7;
#define MG_GLOAD(AP, BP, KT_)                                                                  \
  _Pragma("unroll") for (int i = 0; i < 4; ++i) {                                              \
    ga[i] = *(const uint4*)((AP) + (size_t)(m0 + 32 * i + r0) * (LDK5 * 2) + c0 * 16 + (KT_) * 128);  \
    gb[i] = *(const uint4*)((BP) + (size_t)(n0 + 32 * i + r0) * LDK5 + c0 * 16 + (KT_) * 128);        \
  }
#define MG_LSTORE(BUF)                                                                         \
  {                                                                                            \
    char* as_ = smem + (BUF) * 32768;                                                          \
    char* bs_ = as_ + 16384;                                                                   \
    _Pragma("unroll") for (int i = 0; i < 4; ++i) {                                            \
      const int id = tid + 256 * i, row = id >> 3, c = id & 7;                                 \
      const int off = row * 128 + ((c ^ (row & 7)) << 4);                                      \
      *(uint4*)(as_ + off) = ga[i];                                                            \
      *(uint4*)(bs_ + off) = gb[i];                                                            \
    }                                                                                          \
  }
#define MG_COMPUTE(ACC, BUF)                                                                                              \
  {                                                                                                                       \
    const char* as_ = smem + (BUF) * 32768;                                                                               \
    const char* bs_ = as_ + 16384;                                                                                        \
    i32x8 a[4], b[4];                                                                                                     \
    const int sw0 = ((lg ^ (lr & 7)) << 4), sw1 = (((4 + lg) ^ (lr & 7)) << 4);                                           \
    _Pragma("unroll") for (int mi = 0; mi < 4; ++mi) {                                                                    \
      const char* p_ = as_ + (wm * 64 + mi * 16 + lr) * 128;                                                              \
      const i32x4 lo_ = *(const i32x4*)(p_ + sw0), hi_ = *(const i32x4*)(p_ + sw1);                                       \
      a[mi] = __builtin_shufflevector(lo_, hi_, 0, 1, 2, 3, 4, 5, 6, 7);                                                  \
    }                                                                                                                     \
    _Pragma("unroll") for (int ni = 0; ni < 4; ++ni) {                                                                    \
      const char* p_ = bs_ + (wn * 64 + ni * 16 + lr) * 128;                                                              \
      const i32x4 lo_ = *(const i32x4*)(p_ + sw0), hi_ = *(const i32x4*)(p_ + sw1);                                       \
      b[ni] = __builtin_shufflevector(lo_, hi_, 0, 1, 2, 3, 4, 5, 6, 7);                                                  \
    }                                                                                                                     \
    _Pragma("unroll") for (int mi = 0; mi < 4; ++mi)                                                                      \
      _Pragma("unroll") for (int ni = 0; ni < 4; ++ni)                                                                    \
        ACC[mi][ni] = __builtin_amdgcn_mfma_scale_f32_16x16x128_f8f6f4(a[mi], b[ni], ACC[mi][ni], 0, 0, 0, 0, 0, 0);      \
  }
  const int MT = (layer == DEPTH - 1) ? NLAT / 128 : R / 128;
  for (int it = 0;; ++it) {
    int mt, nt;
    if (!tile_map(it, MT, 8, mt, nt)) break;
    const int m0 = mt * 128, n0 = nt * 128;
    f32x4 acc[4][4];
    zero_acc(acc);
    __syncthreads();
    MG_GLOAD(Ad, Bd, 0);
    MG_LSTORE(0);
    __syncthreads();
#pragma unroll
    for (int kt = 0; kt < 4; ++kt) {
      if (kt + 1 < 4) { MG_GLOAD(Ad, Bd, kt + 1); } else { MG_GLOAD(Ap, Bp, 0); }
      MG_COMPUTE(acc, kt & 1);
      MG_LSTORE((kt + 1) & 1);
      __syncthreads();
    }
    uint2 tq[2][8];
#pragma unroll
    for (int hs = 0; hs < 2; ++hs)
#pragma unroll
      for (int j = 0; j < 8; ++j) tq[hs][j] = make_uint2(0u, 0u);
#pragma unroll
    for (int hs = 0; hs < 2; ++hs) {
      float4 v1[8];
      stage_half(acc, hs, smem + 32768, v1);
#pragma unroll
      for (int j = 0; j < 8; ++j) tq[hs][j] = make_uint2(pack_bf16(v1[j].x, v1[j].y), pack_bf16(v1[j].z, v1[j].w));
    }
    __builtin_amdgcn_sched_barrier(0);
    zero_acc(acc);
    __syncthreads();
#pragma unroll
    for (int kt = 0; kt < 4; ++kt) {
      if (kt + 1 < 4) { MG_GLOAD(Ap, Bp, kt + 1); }
      MG_COMPUTE(acc, kt & 1);
      if (kt + 1 < 4) { MG_LSTORE((kt + 1) & 1); }
      __syncthreads();
    }
#pragma unroll
    for (int hs = 0; hs < 2; ++hs) {
      float4 v2[8];
      stage_half(acc, hs, smem, v2);
      const int tid2 = TID();
#pragma unroll
      for (int j = 0; j < 8; ++j) {
        const int idx = tid2 + 256 * j, row = idx >> 5, c4 = idx & 31;
        const size_t gr = (size_t)(m0 + hs * 64 + row);
        const int gc = n0 + c4 * 4;
        const unsigned gd = *(const unsigned*)((const unsigned char*)PP->sgd + gr * 1024 + gc);
        const unsigned gp = *(const unsigned*)((const unsigned char*)PP->sgp + gr * 1024 + gc);
        const uint2 t = tq[hs][j];
        constexpr float GS = 1.f / (255.f * 32.f);
        const float o0 = ((float)(gd & 0xffu) * bf_lo(t.x) + (float)(gp & 0xffu) * v2[j].x) * GS;
        const float o1 = ((float)((gd >> 8) & 0xffu) * bf_hi(t.x) + (float)((gp >> 8) & 0xffu) * v2[j].y) * GS;
        const float o2 = ((float)((gd >> 16) & 0xffu) * bf_lo(t.y) + (float)((gp >> 16) & 0xffu) * v2[j].z) * GS;
        const float o3 = ((float)(gd >> 24) * bf_hi(t.y) + (float)(gp >> 24) * v2[j].w) * GS;
        int pk = __builtin_amdgcn_cvt_pk_fp8_f32(o0, o1, 0, false);
        pk = __builtin_amdgcn_cvt_pk_fp8_f32(o2, o3, pk, true);
        *(int*)((char*)PP->m + gr * (LDK1 * 2) + gc) = pk;
        if ((j & 1) == 1) __builtin_amdgcn_sched_barrier(0);
      }
    }
  }
#undef MG_GLOAD
#undef MG_LSTORE
#undef MG_COMPUTE
}

__device__ __forceinline__ void phase_outproj(int layer, char* smem) {
  const KP PP = get_params();
  const char* Bt = (const char*)(PP->WoT + (size_t)layer * 1024 * LDK1);
  const char* A = (const char*)PP->m;
  F8_LOCALS
  const int MT = (layer == DEPTH - 1) ? NLAT / 128 : R / 128;
  int it = 0, mt, nt;
  if (!tile_map(it, MT, 8, mt, nt)) return;
  int m0 = mt * 128, n0 = nt * 128;
  F8_PROLOGUE(A, LDK1 * 2, Bt, LDK1)
  for (;;) {
    int mtn = 0, ntn = 0;
    const bool hasn = tile_map(it + 1, MT, 8, mtn, ntn);
    const int m0n = mtn * 128, n0n = ntn * 128;
    f32x4 acc[4][4];
    zero_acc(acc);
    F8_KLOOP(A, LDK1 * 2, Bt, LDK1, 8)
#pragma unroll
    for (int mi = 0; mi < 4; ++mi) {
      const int gr = m0 + wm * 64 + mi * 16 + lr;
      const float* modp = PP->mod + (size_t)(layer * 3 + modsel(gr)) * 6144 + 2048;
      const float* xin;
      float* xo;
      if (gr < NLAT) {
        xin = (layer == 0 ? PP->x : PP->out) + (size_t)gr * 1024;
        xo = PP->out + (size_t)gr * 1024;
      } else {
        xin = (layer == 0 ? PP->ctx : PP->xc) + (size_t)(gr - NLAT) * 1024;
        xo = PP->xc + (size_t)(gr - NLAT) * 1024;
      }
#pragma unroll
      for (int g = 0; g < 2; ++g) {
        const int gc = n0 + wn * 64 + g * 32 + 8 * lg;
#pragma unroll
        for (int n = 0; n < 2; ++n) {
          const f32x4 t = acc[mi][2 * g + n] * (1.f / 32.f);
          const float4 gt = *(const float4*)(modp + gc + 4 * n);
          const float4 xi = *(const float4*)(xin + gc + 4 * n);
          *(float4*)(xo + gc + 4 * n) = make_float4(xi.x + gt.x * t[0], xi.y + gt.y * t[1], xi.z + gt.z * t[2], xi.w + gt.w * t[3]);
        }
      }
    }
    if (!hasn) break;
    m0 = m0n; n0 = n0n; ++it;
  }
}

DEV void gemm_mainloop_f8(const char* __restrict__ A, int lda, const char* __restrict__ B, int ldb, int KT, int m0, int n0,
                          char* smem, f32x4 (&acc)[4][4]) {
  const int tid = TID();
  const int l = tid & 63, w = tid >> 6, wm = w >> 1, wn = w & 1, lr = l & 15, lg = l >> 4;
  uint4 ga0[4], gb0[4], ga1[4], gb1[4];
#pragma unroll
  for (int i = 0; i < 4; ++i) { ga0[i] = make_uint4(0u, 0u, 0u, 0u); gb0[i] = ga0[i]; ga1[i] = ga0[i]; gb1[i] = ga0[i]; }
  const int r0 = tid >> 3, c0 = tid & 7;
#define Q8_GLOAD(GA, GB, KT_)                                                                  \
  _Pragma("unroll") for (int i = 0; i < 4; ++i) {                                              \
    GA[i] = *(const uint4*)(A + (size_t)(m0 + 32 * i + r0) * lda + c0 * 16 + (KT_) * 128);     \
    GB[i] = *(const uint4*)(B + (size_t)(n0 + 32 * i + r0) * ldb + c0 * 16 + (KT_) * 128);     \
  }
#define Q8_LSTORE(GA, GB, BUF)                                                                 \
  {                                                                                            \
    char* as_ = smem + (BUF) * 32768;                                                          \
    char* bs_ = as_ + 16384;                                                                   \
    _Pragma("unroll") for (int i = 0; i < 4; ++i) {                                            \
      const int id = tid + 256 * i, row = id >> 3, c = id & 7;                                 \
      const int off = row * 128 + ((c ^ (row & 7)) << 4);                                      \
      *(uint4*)(as_ + off) = GA[i];                                                            \
      *(uint4*)(bs_ + off) = GB[i];                                                            \
    }                                                                                          \
  }
#define Q8_COMPUTE(BUF)                                                                                                   \
  {                                                                                                                       \
    const char* as_ = smem + (BUF) * 32768;                                                                               \
    const char* bs_ = as_ + 16384;                                                                                        \
    i32x8 a[4], b[4];                                                                                                     \
    const int sw0 = ((lg ^ (lr & 7)) << 4), sw1 = (((4 + lg) ^ (lr & 7)) << 4);                                           \
    _Pragma("unroll") for (int mi = 0; mi < 4; ++mi) {                                                                    \
      const char* p_ = as_ + (wm * 64 + mi * 16 + lr) * 128;                                                              \
      const i32x4 lo_ = *(const i32x4*)(p_ + sw0), hi_ = *(const i32x4*)(p_ + sw1);                                       \
      a[mi] = __builtin_shufflevector(lo_, hi_, 0, 1, 2, 3, 4, 5, 6, 7);                                                  \
    }                                                                                                                     \
    _Pragma("unroll") for (int ni = 0; ni < 4; ++ni) {                                                                    \
      const char* p_ = bs_ + (wn * 64 + ni * 16 + lr) * 128;                                                              \
      const i32x4 lo_ = *(const i32x4*)(p_ + sw0), hi_ = *(const i32x4*)(p_ + sw1);                                       \
      b[ni] = __builtin_shufflevector(lo_, hi_, 0, 1, 2, 3, 4, 5, 6, 7);                                                  \
    }                                                                                                                     \
    _Pragma("unroll") for (int mi = 0; mi < 4; ++mi)                                                                      \
      _Pragma("unroll") for (int ni = 0; ni < 4; ++ni)                                                                    \
        acc[mi][ni] = __builtin_amdgcn_mfma_scale_f32_16x16x128_f8f6f4(a[mi], b[ni], acc[mi][ni], 0, 0, 0, 0, 0, 0);      \
  }
  __syncthreads();
  Q8_GLOAD(ga0, gb0, 0);
  Q8_GLOAD(ga1, gb1, 1);
  Q8_LSTORE(ga0, gb0, 0);
  __syncthreads();
  for (int kt = 0; kt < KT; kt += 2) {
    if (kt + 2 < KT) { Q8_GLOAD(ga0, gb0, kt + 2); }
    Q8_COMPUTE(0);
    Q8_LSTORE(ga1, gb1, 1);
    __syncthreads();
    if (kt + 3 < KT) { Q8_GLOAD(ga1, gb1, kt + 3); }
    Q8_COMPUTE(1);
    if (kt + 2 < KT) { Q8_LSTORE(ga0, gb0, 0); }
    __syncthreads();
  }
#undef Q8_GLOAD
#undef Q8_LSTORE
#undef Q8_COMPUTE
}

__device__ __forceinline__ void phase_peerq(int layer, char* smem) {
  const KP PP = get_params();
  const char* Bt = (const char*)PP->WkT + (size_t)layer * 2048 * LDK1;
  const int tid = TID();
  const int l = tid & 63, w = tid >> 6, wm = w >> 1, wn = w & 1, lr = l & 15, lg = l >> 4;
  const int MT = (layer == DEPTH - 1) ? NLAT / 128 : R / 128;
  for (int it = 0;; ++it) {
    int mt, nt;
    if (!tile_map(it, MT, 16, mt, nt)) break;
    const int m0 = mt * 128, n0 = nt * 128;
    f32x4 sc[4][4];
    zero_acc(sc);
    gemm_mainloop_f8((const char*)PP->h8, LDK1, Bt, LDK1, 8, m0, n0, smem, sc);
    __syncthreads();
    float* Sc = (float*)smem;
#pragma unroll
    for (int mi = 0; mi < 4; ++mi)
#pragma unroll
      for (int ni = 0; ni < 4; ++ni)
#pragma unroll
        for (int r = 0; r < 4; ++r) Sc[(wm * 64 + mi * 16 + lg * 4 + r) * 129 + wn * 64 + ni * 16 + lr] = sc[mi][ni][r] * (1.f / 32.f);
    __syncthreads();
    {
      const int row = tid >> 1, half = tid & 1;
      const float* rowp = Sc + row * 129;
      unsigned key[64];
#pragma unroll
      for (int i = 0; i < 64; ++i) {
        unsigned u = __float_as_uint(rowp[half * 64 + i]);
        u = (u & 0x80000000u) ? ~u : (u | 0x80000000u);
        key[i] = (u & ~127u) | (unsigned)(127 - (half * 64 + i));
      }
#define CMPX(X, Y, DESC) { const unsigned hi_ = (X) > (Y) ? (X) : (Y), lo_ = (X) > (Y) ? (Y) : (X); X = (DESC) ? hi_ : lo_; Y = (DESC) ? lo_ : hi_; }
#pragma unroll
      for (int g0 = 0; g0 < 64; g0 += 16) {
#pragma unroll
        for (int k = 2; k <= 16; k <<= 1)
#pragma unroll
          for (int j = k >> 1; j > 0; j >>= 1)
#pragma unroll
            for (int i = 0; i < 16; ++i) {
              const int l2 = i ^ j;
              if (l2 > i) CMPX(key[g0 + i], key[g0 + l2], ((i & k) == 0));
            }
      }
#define TOPMERGE(AOFF, BOFF)                                                                         \
  {                                                                                                  \
    _Pragma("unroll") for (int i = 0; i < 16; ++i)                                                   \
      key[(AOFF) + i] = key[(AOFF) + i] > key[(BOFF) + 15 - i] ? key[(AOFF) + i] : key[(BOFF) + 15 - i]; \
    _Pragma("unroll") for (int j = 8; j > 0; j >>= 1)                                                \
      _Pragma("unroll") for (int i = 0; i < 16; ++i) {                                               \
        const int l2 = i ^ j;                                                                        \
        if (l2 > i) CMPX(key[(AOFF) + i], key[(AOFF) + l2], true);                                   \
      }                                                                                              \
  }
      TOPMERGE(0, 16);
      TOPMERGE(32, 48);
      TOPMERGE(0, 32);
      {
        unsigned oth[16];
#pragma unroll
        for (int i = 0; i < 16; ++i) oth[i] = swz_xor_u<1>(key[i]);
#pragma unroll
        for (int i = 0; i < 16; ++i) key[i] = key[i] > oth[15 - i] ? key[i] : oth[15 - i];
#pragma unroll
        for (int j = 8; j > 0; j >>= 1)
#pragma unroll
          for (int i = 0; i < 16; ++i) {
            const int l2 = i ^ j;
            if (l2 > i) CMPX(key[i], key[l2], true);
          }
      }
#undef TOPMERGE
#undef CMPX
      unsigned res[16];
#pragma unroll
      for (int j = 0; j < 16; ++j) {
        const int idx = 127 - (int)(key[j] & 127u);
        res[j] = half ? (unsigned)idx : __float_as_uint(rowp[idx]);
      }
      const size_t ob = ((size_t)(m0 + row) * 16 + nt) * 16;
      uint4* dst = half ? (uint4*)(PP->topI + ob) : (uint4*)(PP->topS + ob);
      dst[0] = make_uint4(res[0], res[1], res[2], res[3]);
      dst[1] = make_uint4(res[4], res[5], res[6], res[7]);
      dst[2] = make_uint4(res[8], res[9], res[10], res[11]);
      dst[3] = make_uint4(res[12], res[13], res[14], res[15]);
    }
  }
}

DEV void pair_of_lane(int l, int& a, int& b) {
  if (l < 16) { a = 0; b = l; }
  else if (l < 24) { a = 1; b = l - 16; }
  else if (l < 29) { a = 2; b = l - 24; }
  else if (l < 33) { a = 3; b = l - 29; }
  else if (l < 36) { a = 4; b = l - 33; }
  else if (l < 38) { a = 5; b = l - 36; }
  else if (l < 40) { a = 6; b = l - 38; }
  else if (l < 42) { a = 7; b = l - 40; }
  else if (l < 50) { a = l - 34; b = 0; }
  else { a = 0; b = 0; }
}

DEV float peer_butterfly(const float (&part)[8], int lane) {
  const bool h32 = (lane & 32) != 0, h16 = (lane & 16) != 0, h8 = (lane & 8) != 0;
  const int a32 = (lane ^ 32) << 2;
  float q4[4], q2[2];
#pragma unroll
  for (int i = 0; i < 4; ++i) {
    const float keep = h32 ? part[i + 4] : part[i], send = h32 ? part[i] : part[i + 4];
    q4[i] = keep + __builtin_bit_cast(float, __builtin_amdgcn_ds_bpermute(a32, __builtin_bit_cast(int, send)));
  }
#pragma unroll
  for (int i = 0; i < 2; ++i) {
    const float keep = h16 ? q4[i + 2] : q4[i], send = h16 ? q4[i] : q4[i + 2];
    q2[i] = keep + swz_xor<16>(send);
  }
  const float keep = h8 ? q2[1] : q2[0], send = h8 ? q2[0] : q2[1];
  float q1 = keep + swz_xor<8>(send);
  q1 += swz_xor<4>(q1);
  q1 += swz_xor<2>(q1);
  q1 += swz_xor<1>(q1);
  return q1;
}

__device__ __forceinline__ void phase_peer(int layer, char* smem) {
  const KP PP = get_params();
  const int tid = TID(), lane = tid & 63, wv = tid >> 6;
  const int gw = BID() * 4 + wv, nw = gridDim.x * 4;
  int* elist = (int*)(smem + wv * 2048);
  float* glist = (float*)(elist + 128);
  const bool last = (layer == DEPTH - 1);
  const int rlim = last ? NLAT : R;
  int pa, pb;
  pair_of_lane(lane, pa, pb);
  for (int r = gw; r < rlim; r += nw) {
    f32x2 hp[8];
#pragma unroll
    for (int i = 0; i < 4; ++i) {
      const uint2 hv = *(const uint2*)(PP->h + (size_t)r * LDK1 + 4 * lane + 256 * i);
      hp[2 * i] = (f32x2){bf_lo(hv.x), bf_hi(hv.x)};
      hp[2 * i + 1] = (f32x2){bf_lo(hv.y), bf_hi(hv.y)};
    }
#ifndef PEER_REP
#define PEER_REP 1
#endif
    f32x2 out[8];
#pragma unroll
    for (int i = 0; i < 8; ++i) out[i] = (f32x2){0.f, 0.f};
#pragma nounroll
    for (int rep_ = 0; rep_ < PEER_REP; ++rep_) {
    float sreg[8];
    int ireg[8];
#pragma unroll
    for (int hh = 0; hh < 8; ++hh) {
      const size_t o = (size_t)r * 256 + hh * 32 + (lane & 31);
      sreg[hh] = PP->topS[o];
      ireg[hh] = PP->topI[o];
    }
#pragma unroll 2
    for (int hh = 0; hh < 8; ++hh) {
      float cs = __builtin_bit_cast(float, __builtin_amdgcn_ds_bpermute(pa << 2, __builtin_bit_cast(int, sreg[hh]))) +
                 __builtin_bit_cast(float, __builtin_amdgcn_ds_bpermute((16 + pb) << 2, __builtin_bit_cast(int, sreg[hh])));
      const int e = __builtin_amdgcn_ds_bpermute(pa << 2, ireg[hh]) * 128 + __builtin_amdgcn_ds_bpermute((16 + pb) << 2, ireg[hh]);
      if (lane >= 50) cs = -__builtin_inff();
      unsigned ku = __float_as_uint(cs);
      ku = (ku & 0x80000000u) ? ~ku : (ku | 0x80000000u);
      ku = (ku & ~63u) | (unsigned)(63 - lane);
      int rank = 0;
#pragma unroll
      for (int l2 = 0; l2 < 50; ++l2) {
        const unsigned kv = (unsigned)__builtin_amdgcn_readlane((int)ku, l2);
        rank += (kv > ku) ? 1 : 0;
      }
      const bool sel = (lane < 50) && (rank < 16);
      const float mx = __builtin_bit_cast(float, __builtin_amdgcn_readlane(__builtin_bit_cast(int, cs), 0));
      const float ex = sel ? __expf(cs - mx) : 0.f;
      const float sum = wave_sum(ex);
      const unsigned long long mask = __ballot(sel);
      if (sel) {
        const int pos = __builtin_popcountll(mask & ((1ull << lane) - 1ull));
        elist[hh * 16 + pos] = e;
        glist[hh * 16 + pos] = ex / sum;
      }
    }
    __builtin_amdgcn_wave_barrier();
    asm volatile("s_waitcnt lgkmcnt(0)" ::: "memory");
    for (int k0 = 0; k0 < 128; k0 += 8) {
      U3 ua[8], va[8];
#pragma unroll
      for (int b = 0; b < 8; ++b) {
        const int ek = __builtin_amdgcn_readfirstlane(elist[k0 + b]);
        ua[b] = *(const U3*)(PP->tab8U + (size_t)ek * TROW + lane * 12);
        va[b] = *(const U3*)(PP->tab8V + (size_t)ek * TROW + lane * 12);
      }
      const int eb = elist[k0 + (lane >> 3)];
      const float scu = PP->scU[eb], scv = PP->scV[eb];
      float part[8];
#pragma unroll
      for (int b = 0; b < 8; b += 2) {
        const u32x6_t s6 = {ua[b].a, ua[b].b, ua[b].c, ua[b + 1].a, ua[b + 1].b, ua[b + 1].c};
        const f32x32_t uf = __builtin_amdgcn_cvt_scalef32_pk32_f32_fp6(s6, 1.0f);
        f32x2 d0 = (f32x2){uf[0], uf[1]} * hp[0];
        f32x2 d1 = (f32x2){uf[16], uf[17]} * hp[0];
#pragma unroll
        for (int p = 1; p < 8; ++p) {
          d0 += (f32x2){uf[2 * p], uf[2 * p + 1]} * hp[p];
          d1 += (f32x2){uf[16 + 2 * p], uf[17 + 2 * p]} * hp[p];
        }
        part[b] = d0[0] + d0[1];
        part[b + 1] = d1[0] + d1[1];
      }
      float q1 = peer_butterfly(part, lane);
      q1 *= scu;
      const float act = scv * glist[k0 + (lane >> 3)] * 0.5f * q1 * (1.f + erff(q1 * 0.7071067811865475f));
#pragma unroll
      for (int b = 0; b < 8; b += 2) {
        const float ab0 = __builtin_bit_cast(float, __builtin_amdgcn_readlane(__builtin_bit_cast(int, act), b * 8));
        const float ab1 = __builtin_bit_cast(float, __builtin_amdgcn_readlane(__builtin_bit_cast(int, act), b * 8 + 8));
        const f32x2 a0 = {ab0, ab0}, a1 = {ab1, ab1};
        const u32x6_t s6 = {va[b].a, va[b].b, va[b].c, va[b + 1].a, va[b + 1].b, va[b + 1].c};
        const f32x32_t vf = __builtin_amdgcn_cvt_scalef32_pk32_f32_fp6(s6, 1.0f);
#pragma unroll
        for (int p = 0; p < 8; ++p) {
          out[p] += a0 * (f32x2){vf[2 * p], vf[2 * p + 1]};
          out[p] += a1 * (f32x2){vf[16 + 2 * p], vf[17 + 2 * p]};
        }
      }
    }
    __builtin_amdgcn_wave_barrier();
    }
    if (PEER_REP > 1) {
#pragma unroll
      for (int i = 0; i < 8; ++i) out[i] *= (1.f / PEER_REP);
    }
    const float* md = PP->mod + (size_t)(layer * 3 + modsel(r)) * 6144 + 5 * 1024;
    float* xr = (r < NLAT) ? PP->out + (size_t)r * 1024 : PP->xc + (size_t)(r - NLAT) * 1024;
    float4 x2[4];
    float ss = 0.f;
#pragma unroll
    for (int i = 0; i < 4; ++i) {
      const int col = 4 * lane + 256 * i;
      const float4 xa = *(const float4*)(xr + col);
      const float4 ga = *(const float4*)(md + col);
      x2[i] = make_float4(xa.x + ga.x * out[2 * i][0], xa.y + ga.y * out[2 * i][1], xa.z + ga.z * out[2 * i + 1][0],
                          xa.w + ga.w * out[2 * i + 1][1]);
      ss += x2[i].x * x2[i].x + x2[i].y * x2[i].y + x2[i].z * x2[i].z + x2[i].w * x2[i].w;
    }
    if (last) {
      ss = wave_sum(ss);
      const float rs = rsqrtf(ss * (1.f / 1024.f) + EPS);
#pragma unroll
      for (int i = 0; i < 4; ++i) {
        const float4 fa = *(const float4*)(PP->final_norm + 4 * lane + 256 * i);
        x2[i] = make_float4(x2[i].x * rs * fa.x, x2[i].y * rs * fa.y, x2[i].z * rs * fa.z, x2[i].w * rs * fa.w);
      }
    }
#pragma unroll
    for (int i = 0; i < 4; ++i) *(float4*)(xr + 4 * lane + 256 * i) = x2[i];
    if (!last) {
      ss = wave_sum(ss);
      const float rs = rsqrtf(ss * (1.f / 1024.f) + EPS);
      const float* nwt = PP->norm_mix + (layer + 1) * 1024;
      const float* md1 = PP->mod + (size_t)((layer + 1) * 3 + modsel(r)) * 6144;
#pragma unroll
      for (int i = 0; i < 4; ++i) {
        const int col = 4 * lane + 256 * i;
        const float4 wv = *(const float4*)(nwt + col);
        const float4 sh = *(const float4*)(md1 + col);
        const float4 sc = *(const float4*)(md1 + 1024 + col);
        const float y0 = x2[i].x * rs * wv.x * (1.f + sc.x) + sh.x;
        const float y1 = x2[i].y * rs * wv.y * (1.f + sc.y) + sh.y;
        const float y2 = x2[i].z * rs * wv.z * (1.f + sc.z) + sh.z;
        const float y3 = x2[i].w * rs * wv.w * (1.f + sc.w) + sh.w;
        int pk = __builtin_amdgcn_cvt_pk_fp8_f32(y0, y1, 0, false);
        pk = __builtin_amdgcn_cvt_pk_fp8_f32(y2, y3, pk, true);
        *(int*)((char*)PP->h + (size_t)r * (LDK1 * 2) + col) = pk;
      }
    }
  }
}

namespace cg = cooperative_groups;

#define XB_TMO      128
#define XB_XCNT(j)  (256  + 64 * (j))
#define XB_XSUB(j)  (1280 + 64 * (j))
#define XB_XGEN(j)  (2304 + 64 * (j))
#define XB_TOP      3328
#define XB_TOPGEN   3392
#define XCD_BAR_WORDS 3456
#define XB_SPIN_CAP (1u << 22)
#define LAS __attribute__((address_space(3)))
DEV unsigned xb_ld(unsigned* q) { return __hip_atomic_load(q, __ATOMIC_RELAXED, __HIP_MEMORY_SCOPE_AGENT); }
DEV unsigned xb_add(unsigned* q, unsigned v) { return __hip_atomic_fetch_add(q, v, __ATOMIC_RELAXED, __HIP_MEMORY_SCOPE_AGENT); }
DEV unsigned xb_xcc_id() { return (unsigned)__builtin_amdgcn_s_getreg((3 << 11) | 20) & 0xFu; }
#define XB_SPIN(cond, bar) do { unsigned _sp = 0; while (cond) { __builtin_amdgcn_s_sleep(1); \
    if ((++_sp & 255u) == 0u) { if (xb_ld(&(bar)[XB_TMO])) break; if (_sp > XB_SPIN_CAP) { atomicAdd(&(bar)[XB_TMO], 1u); break; } } } } while (0)
struct XcdBarrier { unsigned* bar; unsigned x; volatile LAS unsigned* st; };
DEV XcdBarrier xcd_barrier_post(unsigned* bar, volatile LAS unsigned* st) {
  XcdBarrier b; b.bar = bar; b.x = xb_xcc_id(); b.st = st;
  if (__builtin_amdgcn_workitem_id_x() == 0) (void)xb_add(&bar[XB_XCNT(b.x)], 1u);
  return b;
}
DEV void xcd_barrier_complete(unsigned* bar, unsigned x, unsigned& nloc, unsigned& nx) {
  const unsigned G = gridDim.x * gridDim.y * gridDim.z;
  unsigned sum, cnt, mine, sp = 0u;
  for (;;) {
    sum = 0u; cnt = 0u; mine = 0u;
#pragma unroll
    for (unsigned j = 0; j < 16; ++j) { const unsigned c = xb_ld(&bar[XB_XCNT(j)]); sum += c; cnt += (c > 0u) ? 1u : 0u; mine = (j == x) ? c : mine; }
    if (sum == G) break;
    __builtin_amdgcn_s_sleep(1);
    if ((++sp & 255u) == 0u) { if (xb_ld(&bar[XB_TMO])) break; if (sp > XB_SPIN_CAP) { atomicAdd(&bar[XB_TMO], 1u); break; } }
  }
  nloc = mine > 0u ? mine : 1u; nx = cnt > 0u ? cnt : 1u;
}
DEV void xcd_barrier(const XcdBarrier& b) {
  asm volatile("s_waitcnt vmcnt(0)" ::: "memory");
  __syncthreads();
  if (__builtin_amdgcn_workitem_id_x() == 0) {
    unsigned* bar = b.bar;
    __builtin_amdgcn_s_waitcnt(0);
    unsigned nloc = b.st[0], nx = b.st[1];
    if (nloc == 0u) { xcd_barrier_complete(bar, b.x, nloc, nx); b.st[0] = nloc; b.st[1] = nx; }
    const unsigned old = xb_add(&bar[XB_XSUB(b.x)], 1u);
    const unsigned gen = old / nloc;
    if (old + 1u == (gen + 1u) * nloc) {
      __builtin_amdgcn_fence(__ATOMIC_RELEASE, "agent");
      asm volatile("s_waitcnt vmcnt(0)" ::: "memory");
      const unsigned og = xb_add(&bar[XB_TOP], 1u);
      const unsigned tg = og / nx;
      if (og + 1u == (tg + 1u) * nx) xb_add(&bar[XB_TOPGEN], 1u);
      else XB_SPIN(xb_ld(&bar[XB_TOPGEN]) == tg, bar);
      __builtin_amdgcn_fence(__ATOMIC_ACQUIRE, "agent");
      xb_add(&bar[XB_XGEN(b.x)], 1u);
      asm volatile("s_waitcnt vmcnt(0)" ::: "memory");
    } else {
      XB_SPIN(xb_ld(&bar[XB_XGEN(b.x)]) == gen, bar);
      __builtin_amdgcn_fence(__ATOMIC_ACQUIRE, "agent");
      asm volatile("s_waitcnt vmcnt(0)" ::: "memory");
    }
  }
  __syncthreads();
}

#define GRID_SYNC() do { XcdBarrier xb_; xb_.bar = get_params()->bar; xb_.x = xb_xcc_id(); xb_.st = (volatile LAS unsigned*)&xb_words; xcd_barrier(xb_); } while (0)

__global__ void __launch_bounds__(NTHR, 2) megakernel(Params p) {
  __shared__ __attribute__((aligned(16))) char smem[SMEM_BYTES];
  __shared__ uint4 xb_words;
  if (__builtin_amdgcn_workitem_id_x() == 0) xb_words = make_uint4(0u, 0u, 0u, 0u);
  __syncthreads();
  (void)xcd_barrier_post(get_params()->bar, (volatile LAS unsigned*)&xb_words);
#ifndef PM
#define PM 0xFFFF
#endif
#ifndef DUP
#define DUP 0
#endif
  if (PM & 1) phase_init(smem);
  if (DUP & 1) phase_init(smem);
  GRID_SYNC();
  for (int layer = 0; layer < DEPTH; ++layer) {
    if (layer == 0) {
      if (PM & 2) phase_norm(layer, 1);
      if (DUP & 2) phase_norm(layer, 1);
      GRID_SYNC();
    }
    if (PM & 4) phase_gemm_win(layer, smem);
    if (DUP & 4) phase_gemm_win(layer, smem);
    GRID_SYNC();
#ifndef PREP_REP
#define PREP_REP 1
#endif
#pragma nounroll
    for (int rep_ = 0; rep_ < PREP_REP; ++rep_) phase_prep(layer, smem);
    GRID_SYNC();
    {
      const int nb_ = gridDim.x;
      if (BID() < 128) { if (PM & 64) phase_scan(smem); }
      else {
        if (PM & 16) phase_pool(layer, smem, BID() - 128, nb_ - 128);
        if (PM & 256) phase_tables(layer, BID() - 128, nb_ - 128);
      }
    }
    GRID_SYNC();
    if (PM & 128) phase_o(layer, smem);
    if (DUP & 128) phase_o(layer, smem);
    GRID_SYNC();
    if (PM & 512) phase_merge(layer, smem);
    if (DUP & 512) phase_merge(layer, smem);
    GRID_SYNC();
    if (PM & 1024) phase_outproj(layer, smem);
    GRID_SYNC();
    if (PM & 2048) phase_norm(layer, 2);
    if (DUP & 2048) phase_norm(layer, 2);
    GRID_SYNC();
    if (PM & 4096) phase_peerq(layer, smem);
    if (DUP & 4096) phase_peerq(layer, smem);
    GRID_SYNC();
    if (PM & 8192) phase_peer(layer, smem);
    if (layer + 1 < DEPTH) GRID_SYNC();
  }
}

static inline size_t align_up(size_t v, size_t a) { return (v + a - 1) / a * a; }

extern "C" void kernel_launch(void* const* d_in, const int* in_sizes, int n_in, void* d_out, int out_size, void* d_ws,
                              size_t ws_size, hipStream_t stream) {
  Params p{};
  p.x = (const float*)d_in[0]; p.c = (const float*)d_in[1]; p.ctx = (const float*)d_in[2]; p.c_ctx = (const float*)d_in[3];
  p.w_mod = (const float*)d_in[4]; p.b_mod = (const float*)d_in[5]; p.norm_mix = (const float*)d_in[6]; p.w_in = (const float*)d_in[7];
  p.conv_w = (const float*)d_in[8]; p.a_log = (const float*)d_in[9]; p.dt_bias = (const float*)d_in[10];
  p.dn_out_norm = (const float*)d_in[11]; p.pool_w = (const float*)d_in[12]; p.pool_scale = (const float*)d_in[13];
  p.w_up_dn = (const float*)d_in[14]; p.w_up_pool = (const float*)d_in[15]; p.w_out = (const float*)d_in[16];
  p.norm_ffn = (const float*)d_in[17]; p.peer_wq = (const float*)d_in[18]; p.peer_keys = (const float*)d_in[19];
  p.peer_u = (const float*)d_in[20]; p.peer_v = (const float*)d_in[21]; p.final_norm = (const float*)d_in[22];
  p.out = (float*)d_out;

  char* ws = (char*)d_ws;
  size_t off = 0;
  auto take = [&](size_t bytes) { char* q = ws + off; off = align_up(off + bytes, 256); return q; };
  p.tab8U = (unsigned char*)take((size_t)NEXP * 1024);
  p.tab8V = (unsigned char*)take((size_t)NEXP * 1024);
  p.scU = (float*)take((size_t)NEXP * 4);
  p.scV = (float*)take((size_t)NEXP * 4);
  p.WinT = (u16*)take((size_t)DEPTH * NPAD * LDK1 * 2);
  p.WdT = (u16*)take((size_t)DEPTH * 1024 * LDK5 * 2);
  p.WpT = (u16*)take((size_t)DEPTH * 1024 * LDK5 * 2);
  p.WoT = (u16*)take((size_t)DEPTH * 1024 * LDK1 * 2);
  p.WkT = (u16*)take((size_t)DEPTH * 2048 * LDK1 * 2);
  p.PwT = (u16*)take((size_t)DEPTH * 4 * 128 * 128 * 2);
  p.mod = (float*)take((size_t)DEPTH * 3 * 6144 * 4);
  p.xc = (float*)take((size_t)NCTX * 1024 * 4);
  p.h = (u16*)take((size_t)R * LDK1 * 2);
  p.h8 = (unsigned char*)take((size_t)R * LDK1);
  p.m = p.h;
  p.qkv_pre = (u16*)take((size_t)R * 1536 * 2);
  p.Vfrag = p.qkv_pre;
  p.z = (u16*)take((size_t)R * 512 * 2);
  p.pin = (u16*)take((size_t)R * 512 * 2);
  p.sgd = (u16*)take((size_t)R * 1024 * 2);
  p.sgp = (u16*)take((size_t)R * 1024 * 2);
  p.ba = (float*)take((size_t)R * 16 * 4);
  p.qkvn = (u16*)take((size_t)R * 1536 * 2);
  p.bg = (float*)take((size_t)R * 16 * 4);
  p.Wfrag = (u16*)take((size_t)NUNIT * 16384);
  p.KdT = (u16*)take((size_t)NUNIT * 16384);
  p.Ufrag = (u16*)take((size_t)NUNIT * 16384);
  p.ydn = p.Ufrag;
  p.Sfrag = (u16*)take((size_t)NUNIT * 32768);
  p.gc = (float*)take((size_t)NUNIT * 64 * 4);
  p.glast = (float*)take((size_t)NUNIT * 4);
  p.ypool = (u16*)take((size_t)R * LDK5 * 2);
  p.bar = (unsigned*)take((size_t)XCD_BAR_WORDS * 4);
  p.topS = (float*)p.qkvn;
  p.topI = (int*)((char*)p.qkvn + (size_t)R * 256 * 4);
  const bool alias_ok = ((size_t)R * 256 * 8 <= (size_t)R * 1536 * 2) && ((size_t)NUNIT * 16384 <= (size_t)R * 1536 * 2) &&
                        ((size_t)R * LDK5 * 2 <= (size_t)NUNIT * 16384);
  if (off > ws_size || !alias_ok) {
    fprintf(stderr, "workspace too small: need %zu have %zu (alias_ok=%d)\n", off, ws_size, (int)alias_ok);
    return;
  }
  static int grid_blocks = 0;
  if (!grid_blocks) {
    int dev = 0, cus = 0, per_cu = 0;
    (void)hipGetDevice(&dev);
    (void)hipDeviceGetAttribute(&cus, hipDeviceAttributeMultiprocessorCount, dev);
    (void)hipOccupancyMaxActiveBlocksPerMultiprocessor(&per_cu, megakernel, NTHR, 0);
    if (per_cu > 2) per_cu = 2;
    if (per_cu < 1) per_cu = 1;
    grid_blocks = cus * per_cu;
    grid_blocks -= grid_blocks % 8;
  }
  if (grid_blocks < 8) { fprintf(stderr, "bad grid %d\n", grid_blocks); return; }
  (void)hipMemsetAsync(p.bar, 0, (size_t)XCD_BAR_WORDS * 4, stream);
  void* args[] = {&p};
  hipError_t e = hipLaunchCooperativeKernel((void*)megakernel, dim3(grid_blocks), dim3(NTHR), args, 0, stream);
  if (e != hipSuccess) fprintf(stderr, "cooperative launch failed: %s (grid %d)\n", hipGetErrorString(e), grid_blocks);
}
```

```cpp
#include <hip/hip_runtime.h>
#include <hip/hip_cooperative_groups.h>
#include <stdint.h>
#include <stdio.h>

typedef unsigned short u16;
typedef __attribute__((ext_vector_type(8))) short bf16x8;
typedef __attribute__((ext_vector_type(4))) float f32x4;
typedef __attribute__((ext_vector_type(2))) float f32x2;
typedef __attribute__((ext_vector_type(2))) __bf16 bf16x2_t;

#define DEV __device__ __forceinline__

constexpr int D = 1024;
constexpr int BATCH = 2;
constexpr int SEQ = 8192;
constexpr int DEPTH = 2;
constexpr int CTX = 256;
constexpr int NLAT = BATCH * SEQ;
constexpr int NCTX = BATCH * CTX;
constexpr int R = NLAT + NCTX;
constexpr int DNH = 4;
constexpr int DK = 128;
constexpr int DNW = 512;
constexpr int INC = 4624;
constexpr int NPAD = 4736;
constexpr int NEXP = 16384;
constexpr float EPS = 1e-6f;
constexpr int NTHR = 256;
constexpr int LDK1 = 1088;
constexpr int LDK5 = 576;
constexpr int SMEM_BYTES = 73728;

struct Params {
  const float *x, *c, *ctx, *c_ctx, *w_mod, *b_mod, *norm_mix, *w_in, *conv_w, *a_log, *dt_bias, *dn_out_norm,
      *pool_w, *pool_scale, *w_up_dn, *w_up_pool, *w_out, *norm_ffn, *peer_wq, *peer_keys, *peer_u, *peer_v, *final_norm;
  float* out;
  unsigned char *tab8U, *tab8V;
  float *scU, *scV;
  u16 *WinT, *WdT, *WpT, *WoT, *WkT, *PwT;
  float *mod, *xc;
  u16 *h, *qkv_pre, *z, *pin, *sgd, *sgp;
  unsigned char* h8;
  float* ba;
  u16* qkvn;
  float* bg;
  u16 *Wfrag, *KdT, *Ufrag, *Sfrag, *Vfrag;
  float *gc, *glast;
  u16 *ydn, *ypool, *m;
  float* topS;
  int* topI;
  unsigned* bar;
};

typedef const __attribute__((address_space(4))) Params* KP;
DEV KP get_params() {
  KP k = (KP)__builtin_amdgcn_kernarg_segment_ptr();
  asm volatile("" : "+s"(k));
  return k;
}
DEV int TID() { int t = __builtin_amdgcn_workitem_id_x(); asm volatile("" : "+v"(t)); return t; }
DEV int BID() { int t = __builtin_amdgcn_workgroup_id_x(); asm volatile("" : "+s"(t)); return t; }
DEV unsigned pack_bf16(float a, float b) {
  f32x2 v = {a, b};
  bf16x2_t r = __builtin_convertvector(v, bf16x2_t);
  return *(unsigned*)&r;
}
DEV u16 f2bf(float a) { return (u16)(pack_bf16(a, 0.f) & 0xffffu); }
DEV float bf_lo(unsigned u) { return __uint_as_float(u << 16); }
DEV float bf_hi(unsigned u) { return __uint_as_float(u & 0xffff0000u); }
DEV float bf2f(u16 h) { return __uint_as_float(((unsigned)h) << 16); }
DEV void unpack8(const uint4& v, float* f) {
  f[0] = bf_lo(v.x); f[1] = bf_hi(v.x); f[2] = bf_lo(v.y); f[3] = bf_hi(v.y);
  f[4] = bf_lo(v.z); f[5] = bf_hi(v.z); f[6] = bf_lo(v.w); f[7] = bf_hi(v.w);
}
DEV uint4 pack8(const float* f) {
  uint4 v;
  v.x = pack_bf16(f[0], f[1]); v.y = pack_bf16(f[2], f[3]); v.z = pack_bf16(f[4], f[5]); v.w = pack_bf16(f[6], f[7]);
  return v;
}
template <int O> DEV float swz_xor(float v) {
  return __builtin_bit_cast(float, __builtin_amdgcn_ds_swizzle(__builtin_bit_cast(int, v), (O << 10) | 0x1F));
}
template <int O> DEV unsigned swz_xor_u(unsigned v) {
  return (unsigned)__builtin_amdgcn_ds_swizzle((int)v, (O << 10) | 0x1F);
}
DEV float xor32_f(float v) {
  const int a = ((TID() & 63) ^ 32) << 2;
  return __builtin_bit_cast(float, __builtin_amdgcn_ds_bpermute(a, __builtin_bit_cast(int, v)));
}
DEV float wave_sum(float v) {
  v += xor32_f(v);
  v += swz_xor<16>(v); v += swz_xor<8>(v); v += swz_xor<4>(v); v += swz_xor<2>(v); v += swz_xor<1>(v);
  return v;
}
DEV float wave_max(float v) {
  v = fmaxf(v, xor32_f(v));
  v = fmaxf(v, swz_xor<16>(v)); v = fmaxf(v, swz_xor<8>(v)); v = fmaxf(v, swz_xor<4>(v));
  v = fmaxf(v, swz_xor<2>(v)); v = fmaxf(v, swz_xor<1>(v));
  return v;
}
DEV float group16_sum(float v) {
  v += swz_xor<8>(v); v += swz_xor<4>(v); v += swz_xor<2>(v); v += swz_xor<1>(v);
  return v;
}
DEV float sigmoidf_(float x) { return __builtin_amdgcn_rcpf(1.f + __expf(-x)); }
DEV float siluf_(float x) { return x * __builtin_amdgcn_rcpf(1.f + __expf(-x)); }
DEV int modsel(int r) { return r < NLAT ? (r >> 13) : 2; }

DEV void transpose_tile(const float* __restrict__ src, int Nsrc, int ldd, u16* __restrict__ dst, int kt, int nt, int mode,
                        float* tile) {
  const int tid = TID();
  const int cl = tid & 63, rg = tid >> 6;
  const int nd = nt * 64 + cl;
  int ns = nd;
  bool valid = true;
  if (mode & 1) {
    if (nd < 2560) ns = nd;
    else if (nd < 4608) ns = nd + 16;
    else if (nd < 4624) ns = nd - 4608 + 2560;
    else { valid = false; ns = 0; }
  }
#pragma unroll
  for (int i = 0; i < 16; ++i) {
    const int kr = i * 4 + rg;
    float v = valid ? src[(size_t)(kt * 64 + kr) * Nsrc + ns] : 0.f;
    tile[kr * 65 + cl] = v;
  }
  __syncthreads();
  const int nr = tid >> 2, kc = (tid & 3) * 16;
  if (mode & 2) {
    int q4[4];
#pragma unroll
    for (int q = 0; q < 4; ++q) {
      int pk = __builtin_amdgcn_cvt_pk_fp8_f32(32.f * tile[(kc + 4 * q) * 65 + nr], 32.f * tile[(kc + 4 * q + 1) * 65 + nr], 0, false);
      q4[q] = __builtin_amdgcn_cvt_pk_fp8_f32(32.f * tile[(kc + 4 * q + 2) * 65 + nr], 32.f * tile[(kc + 4 * q + 3) * 65 + nr], pk, true);
    }
    *(int4*)((char*)dst + (size_t)(nt * 64 + nr) * ldd + kt * 64 + kc) = make_int4(q4[0], q4[1], q4[2], q4[3]);
    __syncthreads();
    return;
  }
  unsigned w[8];
#pragma unroll
  for (int q = 0; q < 8; ++q) w[q] = pack_bf16(tile[(kc + 2 * q) * 65 + nr], tile[(kc + 2 * q + 1) * 65 + nr]);
  uint4* d = (uint4*)(dst + (size_t)(nt * 64 + nr) * ldd + kt * 64 + kc);
  d[0] = make_uint4(w[0], w[1], w[2], w[3]);
  d[1] = make_uint4(w[4], w[5], w[6], w[7]);
  __syncthreads();
}

__device__ __forceinline__ void phase_init(char* smem) {
  const KP PP = get_params();
  const int tid = TID(), nb = gridDim.x, bid = BID();
  float* fs = (float*)smem;
  for (int u = bid; u < 192; u += nb) {
    const int layer = u / 96, col0 = (u % 96) * 64;
    float* sv = fs;
    float* red = fs + 3072;
    for (int i = tid; i < 3072; i += NTHR) {
      const int v = i >> 10, k = i & 1023;
      const float cv = (v < 2) ? PP->c[v * 1024 + k] : PP->c_ctx[k];
      sv[i] = siluf_(cv);
    }
    __syncthreads();
    const int cq = tid & 15, ks = tid >> 4;
    float acc[3][4];
#pragma unroll
    for (int v = 0; v < 3; ++v)
#pragma unroll
      for (int i = 0; i < 4; ++i) acc[v][i] = 0.f;
    const float* wb = PP->w_mod + ((size_t)layer * 1024 + ks * 64) * 6144 + col0 + cq * 4;
#pragma unroll 8
    for (int kk = 0; kk < 64; ++kk) {
      const float4 w4 = *(const float4*)(wb + (size_t)kk * 6144);
      const int k = ks * 64 + kk;
#pragma unroll
      for (int v = 0; v < 3; ++v) {
        const float s = sv[v * 1024 + k];
        acc[v][0] += s * w4.x; acc[v][1] += s * w4.y; acc[v][2] += s * w4.z; acc[v][3] += s * w4.w;
      }
    }
#pragma unroll
    for (int v = 0; v < 3; ++v)
#pragma unroll
      for (int i = 0; i < 4; ++i) red[(ks * 3 + v) * 64 + cq * 4 + i] = acc[v][i];
    __syncthreads();
    if (tid < 192) {
      const int v = tid >> 6, cc = tid & 63;
      float s = PP->b_mod[layer * 6144 + col0 + cc];
#pragma unroll
      for (int k2 = 0; k2 < 16; ++k2) s += red[(k2 * 3 + v) * 64 + cc];
      PP->mod[(size_t)(layer * 3 + v) * 6144 + col0 + cc] = s;
    }
    __syncthreads();
  }
  constexpr int NTL = 1184 + 128 + 128 + 256 + 16;
  for (int j = bid; j < NTL * DEPTH; j += nb) {
    const int layer = j / NTL;
    int jj = j % NTL;
    if (jj < 1184) {
      transpose_tile(PP->w_in + (size_t)layer * 1024 * INC, INC, LDK1, PP->WinT + (size_t)layer * NPAD * LDK1, jj / 74, jj % 74, 3, fs);
    } else if ((jj -= 1184) < 128) {
      transpose_tile(PP->w_up_dn + (size_t)layer * 512 * 1024, 1024, LDK5, PP->WdT + (size_t)layer * 1024 * LDK5, jj / 16, jj % 16, 2, fs);
    } else if ((jj -= 128) < 128) {
      transpose_tile(PP->w_up_pool + (size_t)layer * 512 * 1024, 1024, LDK5, PP->WpT + (size_t)layer * 1024 * LDK5, jj / 16, jj % 16, 2, fs);
    } else if ((jj -= 128) < 256) {
      transpose_tile(PP->w_out + (size_t)layer * 1024 * 1024, 1024, LDK1, PP->WoT + (size_t)layer * 1024 * LDK1, jj / 16, jj % 16, 2, fs);
    } else {
      jj -= 256;
      const int g = jj >> 2;
      transpose_tile(PP->pool_w + (size_t)(layer * 4 + g) * 128 * 128, 128, 128, PP->PwT + (size_t)(layer * 4 + g) * 128 * 128,
                     (jj & 3) >> 1, jj & 1, 0, fs);
    }
  }
  {
    const int tid2 = TID();
    const int l = tid2 & 63, w = tid2 >> 6, lr = l & 15, lg = l >> 4;
    char* Ks = smem;
    char* Ws = smem + 32768;
    for (int item = bid; item < DEPTH * 256; item += nb) {
      const int layer = item >> 8, hp = (item >> 4) & 15, ct = item & 15;
      __syncthreads();
      const float* ksrc = PP->peer_keys + (size_t)(layer * 16 + hp) * 128 * 128;
      for (int idx = tid2; idx < 128 * 16; idx += NTHR) {
        const int row = idx >> 4, ch = idx & 15;
        const float4 a = *(const float4*)(ksrc + row * 128 + ch * 8);
        const float4 c4 = *(const float4*)(ksrc + row * 128 + ch * 8 + 4);
        *(uint4*)(Ks + row * 256 + ((ch ^ (row & 15)) << 4)) =
            make_uint4(pack_bf16(a.x, a.y), pack_bf16(a.z, a.w), pack_bf16(c4.x, c4.y), pack_bf16(c4.z, c4.w));
      }
      const float* wsrc = PP->peer_wq + (size_t)layer * 1024 * 2048 + (size_t)(ct * 64) * 2048 + hp * 128;
      for (int idx = tid2; idx < 64 * 16; idx += NTHR) {
        const int row = idx >> 4, ch = idx & 15;
        const float4 a = *(const float4*)(wsrc + (size_t)row * 2048 + ch * 8);
        const float4 c4 = *(const float4*)(wsrc + (size_t)row * 2048 + ch * 8 + 4);
        *(uint4*)(Ws + row * 256 + ((ch ^ (row & 15)) << 4)) =
            make_uint4(pack_bf16(a.x, a.y), pack_bf16(a.z, a.w), pack_bf16(c4.x, c4.y), pack_bf16(c4.z, c4.w));
      }
      __syncthreads();
      f32x4 acc[2][4];
#pragma unroll
      for (int mi = 0; mi < 2; ++mi)
#pragma unroll
        for (int ni = 0; ni < 4; ++ni) acc[mi][ni] = (f32x4){0.f, 0.f, 0.f, 0.f};
#pragma unroll
      for (int ks = 0; ks < 4; ++ks) {
        const int ch = ks * 4 + lg;
        bf16x8 a[2], bb[4];
#pragma unroll
        for (int mi = 0; mi < 2; ++mi) a[mi] = *(const bf16x8*)(Ks + ((2 * w + mi) * 16 + lr) * 256 + ((ch ^ lr) << 4));
#pragma unroll
        for (int ni = 0; ni < 4; ++ni) bb[ni] = *(const bf16x8*)(Ws + (ni * 16 + lr) * 256 + ((ch ^ lr) << 4));
#pragma unroll
        for (int mi = 0; mi < 2; ++mi)
#pragma unroll
          for (int ni = 0; ni < 4; ++ni) acc[mi][ni] = __builtin_amdgcn_mfma_f32_16x16x32_bf16(a[mi], bb[ni], acc[mi][ni], 0, 0, 0);
      }
      unsigned char* dst = (unsigned char*)PP->WkT + ((size_t)layer * 2048 + hp * 128) * LDK1 + ct * 64;
#pragma unroll
      for (int mi = 0; mi < 2; ++mi)
#pragma unroll
        for (int ni = 0; ni < 4; ++ni)
#pragma unroll
          for (int r = 0; r < 4; ++r) {
            const float v32 = 32.f * acc[mi][ni][r];
            dst[(size_t)((2 * w + mi) * 16 + 4 * lg + r) * LDK1 + ni * 16 + lr] = (unsigned char)(__builtin_amdgcn_cvt_pk_fp8_f32(v32, v32, 0, false) & 0xff);
          }
    }
  }
}

DEV unsigned enc_e2m3(float x) {
  const float a = fabsf(x);
  float c;
  if (a < 2.f) c = a * 8.f;
  else if (a < 4.f) c = 16.f + (a - 2.f) * 4.f;
  else c = 24.f + (a - 4.f) * 2.f;
  unsigned code = (unsigned)__builtin_rintf(c);
  code = code > 31u ? 31u : code;
  return code | (x < 0.f ? 32u : 0u);
}
struct __attribute__((packed, aligned(4))) U3 { unsigned a, b, c; };
constexpr int TROW = 768;
typedef float f32x32_t __attribute__((ext_vector_type(32)));
typedef unsigned u32x6_t __attribute__((ext_vector_type(6)));

__device__ __forceinline__ void phase_tables(int layer, int vbid, int vnb) {
  const KP PP = get_params();
  const int tid = TID(), lane = tid & 63;
  const int gw = vbid * 4 + (tid >> 6), nw = vnb * 4;
  const float* su = PP->peer_u + (size_t)layer * NEXP * 1024;
  const float* sv = PP->peer_v + (size_t)layer * NEXP * 1024;
  for (int r0 = gw * 2; r0 < 2 * NEXP; r0 += nw * 2) {
    float4 v[2][4];
#pragma unroll
    for (int q = 0; q < 2; ++q) {
      const int r = r0 + q;
      const float* src = (r < NEXP ? su + (size_t)r * 1024 : sv + (size_t)(r - NEXP) * 1024);
#pragma unroll
      for (int i = 0; i < 4; ++i) v[q][i] = *(const float4*)(src + (lane + 64 * i) * 4);
    }
#pragma unroll
    for (int q = 0; q < 2; ++q) {
      const int r = r0 + q;
      float am = 0.f;
#pragma unroll
      for (int i = 0; i < 4; ++i)
        am = fmaxf(am, fmaxf(fmaxf(fabsf(v[q][i].x), fabsf(v[q][i].y)), fmaxf(fabsf(v[q][i].z), fabsf(v[q][i].w))));
      am = wave_max(am);
      const float scale = fmaxf(am, 1e-30f) * (1.f / 7.5f);
      const float inv = 1.f / scale;
      unsigned long long lo = 0ull;
      unsigned hi = 0u;
#pragma unroll
      for (int i = 0; i < 4; ++i) {
        const float vv[4] = {v[q][i].x * inv, v[q][i].y * inv, v[q][i].z * inv, v[q][i].w * inv};
#pragma unroll
        for (int j = 0; j < 4; ++j) {
          const int k = 4 * i + j;
          const unsigned cde = enc_e2m3(vv[j]);
          if (k < 10) lo |= (unsigned long long)cde << (6 * k);
          else if (k == 10) { lo |= (unsigned long long)cde << 60; hi |= cde >> 4; }
          else hi |= cde << (6 * k - 64);
        }
      }
      unsigned char* dst = (r < NEXP ? PP->tab8U + (size_t)r * TROW : PP->tab8V + (size_t)(r - NEXP) * TROW);
      U3 pk3;
      pk3.a = (unsigned)lo; pk3.b = (unsigned)(lo >> 32); pk3.c = hi;
      *(U3*)(dst + lane * 12) = pk3;
      if (lane == 0) { if (r < NEXP) PP->scU[r] = scale; else PP->scV[r - NEXP] = scale; }
    }
  }
}

__device__ __forceinline__ void phase_norm(int layer, int which) {
  const KP PP = get_params();
  const int lane = TID() & 63;
  const int gw = BID() * 4 + (TID() >> 6), nw = gridDim.x * 4;
  const float* nwt = (which == 1 ? PP->norm_mix : PP->norm_ffn) + layer * 1024;
  const int rlim = (which == 2 && layer == DEPTH - 1) ? NLAT : R;
  for (int r = gw; r < rlim; r += nw) {
    const float* xr;
    if (r < NLAT) xr = ((which == 1 && layer == 0) ? PP->x : PP->out) + (size_t)r * 1024;
    else xr = ((which == 1 && layer == 0) ? PP->ctx : PP->xc) + (size_t)(r - NLAT) * 1024;
    const float* md = PP->mod + (size_t)(layer * 3 + modsel(r)) * 6144 + (which == 1 ? 0 : 3072);
    float4 v[4];
    float ss = 0.f;
#pragma unroll
    for (int i = 0; i < 4; ++i) {
      v[i] = *(const float4*)(xr + (lane + 64 * i) * 4);
      ss += v[i].x * v[i].x + v[i].y * v[i].y + v[i].z * v[i].z + v[i].w * v[i].w;
    }
    ss = wave_sum(ss);
    const float rs = rsqrtf(ss * (1.f / 1024.f) + EPS);
#pragma unroll
    for (int i = 0; i < 4; ++i) {
      const int col = (lane + 64 * i) * 4;
      const float4 w = *(const float4*)(nwt + col);
      const float4 sh = *(const float4*)(md + col);
      const float4 sc = *(const float4*)(md + 1024 + col);
      const float y0 = v[i].x * rs * w.x * (1.f + sc.x) + sh.x;
      const float y1 = v[i].y * rs * w.y * (1.f + sc.y) + sh.y;
      const float y2 = v[i].z * rs * w.z * (1.f + sc.z) + sh.z;
      const float y3 = v[i].w * rs * w.w * (1.f + sc.w) + sh.w;
      if (which == 1) {
        int pk = __builtin_amdgcn_cvt_pk_fp8_f32(y0, y1, 0, false);
        pk = __builtin_amdgcn_cvt_pk_fp8_f32(y2, y3, pk, true);
        *(int*)((char*)PP->h + (size_t)r * (LDK1 * 2) + col) = pk;
      } else {
        *(uint2*)(PP->h + (size_t)r * LDK1 + col) = make_uint2(pack_bf16(y0, y1), pack_bf16(y2, y3));
        int pk = __builtin_amdgcn_cvt_pk_fp8_f32(y0, y1, 0, false);
        pk = __builtin_amdgcn_cvt_pk_fp8_f32(y2, y3, pk, true);
        *(int*)(PP->h8 + (size_t)r * LDK1 + col) = pk;
      }
    }
  }
}

template <bool PRIO>
DEV void gemm_mainloop_t(const u16* __restrict__ A, int lda, const u16* __restrict__ B, int ldb, int K, int m0, int n0,
                         char* smem, f32x4 (&acc)[4][4]) {
  const int tid = TID();
  const int l = tid & 63, w = tid >> 6, wm = w >> 1, wn = w & 1, lr = l & 15, lg = l >> 4;
  uint4 ga0[4], gb0[4], ga1[4], gb1[4];
#pragma unroll
  for (int i = 0; i < 4; ++i) { ga0[i] = make_uint4(0u, 0u, 0u, 0u); gb0[i] = ga0[i]; ga1[i] = ga0[i]; gb1[i] = ga0[i]; }
  const int KT = K >> 6;
#define GLOAD(GA, GB, KT_)                                                                     \
  _Pragma("unroll") for (int i = 0; i < 4; ++i) {                                              \
    const int id = tid + 256 * i, row = id >> 3, c = id & 7;                                   \
    GA[i] = *(const uint4*)(A + (size_t)(m0 + row) * lda + (KT_) * 64 + c * 8);                \
    GB[i] = *(const uint4*)(B + (size_t)(n0 + row) * ldb + (KT_) * 64 + c * 8);                \
  }
#define LSTORE(GA, GB, BUF)                                                                    \
  {                                                                                            \
    char* as_ = smem + (BUF) * 32768;                                                          \
    char* bs_ = as_ + 16384;                                                                   \
    _Pragma("unroll") for (int i = 0; i < 4; ++i) {                                            \
      const int id = tid + 256 * i, row = id >> 3, c = id & 7;                                 \
      const int off = row * 128 + ((c ^ (row & 7)) << 4);                                      \
      *(uint4*)(as_ + off) = GA[i];                                                            \
      *(uint4*)(bs_ + off) = GB[i];                                                            \
    }                                                                                          \
  }
#define COMPUTE(BUF)                                                                                                      \
  {                                                                                                                       \
    const char* as_ = smem + (BUF) * 32768;                                                                               \
    const char* bs_ = as_ + 16384;                                                                                        \
    if (PRIO) __builtin_amdgcn_s_setprio(1);      \
    _Pragma("unroll") for (int ks = 0; ks < 2; ++ks) {                                                                    \
      bf16x8 a[4], b[4];                                                                                                  \
      const int c = ks * 4 + lg;                                                                                          \
      const int sw = ((c ^ (lr & 7)) << 4);                                                                               \
      _Pragma("unroll") for (int mi = 0; mi < 4; ++mi) a[mi] = *(const bf16x8*)(as_ + (wm * 64 + mi * 16 + lr) * 128 + sw); \
      _Pragma("unroll") for (int ni = 0; ni < 4; ++ni) b[ni] = *(const bf16x8*)(bs_ + (wn * 64 + ni * 16 + lr) * 128 + sw); \
      _Pragma("unroll") for (int mi = 0; mi < 4; ++mi)                                                                    \
        _Pragma("unroll") for (int ni = 0; ni < 4; ++ni)                                                                  \
          acc[mi][ni] = __builtin_amdgcn_mfma_f32_16x16x32_bf16(a[mi], b[ni], acc[mi][ni], 0, 0, 0);                      \
    }                                                                                                                     \
    if (PRIO) __builtin_amdgcn_s_setprio(0);                                                                              \
  }
  __syncthreads();
  GLOAD(ga0, gb0, 0);
  GLOAD(ga1, gb1, 1);
  LSTORE(ga0, gb0, 0);
  __syncthreads();
  for (int kt = 0; kt < KT; kt += 2) {
    if (kt + 2 < KT) { GLOAD(ga0, gb0, kt + 2); }
    COMPUTE(0);
    LSTORE(ga1, gb1, 1);
    __syncthreads();
    if (kt + 3 < KT) { GLOAD(ga1, gb1, kt + 3); }
    COMPUTE(1);
    if (kt + 2 < KT) { LSTORE(ga0, gb0, 0); }
    __syncthreads();
  }
#undef GLOAD
#undef LSTORE
#undef COMPUTE
}

DEV void gemm_mainloop(const u16* __restrict__ A, int lda, const u16* __restrict__ B, int ldb, int K, int m0, int n0,
                       char* smem, f32x4 (&acc)[4][4]) {
  gemm_mainloop_t<false>(A, lda, B, ldb, K, m0, n0, smem, acc);
}
DEV void gemm_mainloop1(const u16* __restrict__ A, int lda, const u16* __restrict__ B, int ldb, int K, int m0, int n0,
                       char* smem, f32x4 (&acc)[4][4]) {
  const int tid = TID();
  const int l = tid & 63, w = tid >> 6, wm = w >> 1, wn = w & 1, lr = l & 15, lg = l >> 4;
  uint4 ga[4], gb[4];
  const int KT = K >> 6;
  auto gload = [&](int kt) {
#pragma unroll
    for (int i = 0; i < 4; ++i) {
      const int id = tid + 256 * i, row = id >> 3, c = id & 7;
      ga[i] = *(const uint4*)(A + (size_t)(m0 + row) * lda + kt * 64 + c * 8);
      gb[i] = *(const uint4*)(B + (size_t)(n0 + row) * ldb + kt * 64 + c * 8);
    }
  };
  auto lstore = [&](int buf) {
    char* as = smem + buf * 32768;
    char* bs = as + 16384;
#pragma unroll
    for (int i = 0; i < 4; ++i) {
      const int id = tid + 256 * i, row = id >> 3, c = id & 7;
      const int off = row * 128 + ((c ^ (row & 7)) << 4);
      *(uint4*)(as + off) = ga[i];
      *(uint4*)(bs + off) = gb[i];
    }
  };
  __syncthreads();
  gload(0);
  lstore(0);
  __syncthreads();
  for (int kt = 0; kt < KT; ++kt) {
    if (kt + 1 < KT) gload(kt + 1);
    const char* as = smem + (kt & 1) * 32768;
    const char* bs = as + 16384;
#pragma unroll
    for (int ks = 0; ks < 2; ++ks) {
      bf16x8 a[4], b[4];
      const int c = ks * 4 + lg;
      const int sw = ((c ^ (lr & 7)) << 4);
#pragma unroll
      for (int mi = 0; mi < 4; ++mi) a[mi] = *(const bf16x8*)(as + (wm * 64 + mi * 16 + lr) * 128 + sw);
#pragma unroll
      for (int ni = 0; ni < 4; ++ni) b[ni] = *(const bf16x8*)(bs + (wn * 64 + ni * 16 + lr) * 128 + sw);
#pragma unroll
      for (int mi = 0; mi < 4; ++mi)
#pragma unroll
        for (int ni = 0; ni < 4; ++ni) acc[mi][ni] = __builtin_amdgcn_mfma_f32_16x16x32_bf16(a[mi], b[ni], acc[mi][ni], 0, 0, 0);
    }
    if (kt + 1 < KT) lstore((kt + 1) & 1);
    __syncthreads();
  }
}

DEV void zero_acc(f32x4 (&acc)[4][4]) {
#pragma unroll
  for (int i = 0; i < 4; ++i)
#pragma unroll
    for (int j = 0; j < 4; ++j) acc[i][j] = (f32x4){0.f, 0.f, 0.f, 0.f};
}

DEV void stage_half(const f32x4 (&acc)[4][4], int hsel, char* smem, float4 (&v)[8]) {
  const int tid = TID();
  const int l = tid & 63, w = tid >> 6, wm = w >> 1, wn = w & 1, lr = l & 15, lg = l >> 4;
  float* Cs = (float*)smem;
  __syncthreads();
  if (wm == hsel) {
#pragma unroll
    for (int mi = 0; mi < 4; ++mi)
#pragma unroll
      for (int ni = 0; ni < 4; ++ni)
#pragma unroll
        for (int r = 0; r < 4; ++r) Cs[(mi * 16 + lg * 4 + r) * 132 + wn * 64 + ni * 16 + lr] = acc[mi][ni][r];
  }
  __syncthreads();
#pragma unroll
  for (int j = 0; j < 8; ++j) {
    const int idx = tid + 256 * j, row = idx >> 5, c4 = idx & 31;
    v[j] = *(const float4*)&Cs[row * 132 + c4 * 4];
  }
}

DEV bool tile_map(int it, int MT, int NTl, int& mt, int& nt) {
  const int nb = gridDim.x, bid = BID();
  const int x = bid & 7, vl = bid >> 3, per = nb >> 3;
  const int T = MT * NTl;
  const int g_begin = (int)(((long long)x * T) >> 3), g_end = (int)(((long long)(x + 1) * T) >> 3);
  const int g = g_begin + vl + it * per;
  if (g >= g_end) return false;
  const int full = MT >> 3;
  const int sr = g / (8 * NTl);
  const int srow = sr < full ? sr : full;
  const int rows_in_sr = sr < full ? 8 : (MT & 7);
  const int tt = g - srow * 8 * NTl;
  nt = tt / rows_in_sr;
  mt = srow * 8 + tt % rows_in_sr;
  return true;
}

#define SG_LOCALS                                                                              \
  const int tid = TID();                                                                       \
  const int l = tid & 63, w = tid >> 6, wm = w >> 1, wn = w & 1, lr = l & 15, lg = l >> 4;     \
  uint4 ga0[4], gb0[4], ga1[4], gb1[4];                                                        \
  _Pragma("unroll") for (int i = 0; i < 4; ++i) {                                              \
    ga0[i] = make_uint4(0u, 0u, 0u, 0u); gb0[i] = ga0[i]; ga1[i] = ga0[i]; gb1[i] = ga0[i];    \
  }                                                                                            \
  const int r0 = tid >> 3, c0 = tid & 7;                                                       \
  const int pr0 = 8 * ((r0 & 15) >> 2) + 4 * (r0 >> 4) + (r0 & 3);
#define SG_LOAD(GA, GB, AP, BP, LD, M0_, N0_, KT_)                                             \
  _Pragma("unroll") for (int i = 0; i < 4; ++i) {                                              \
    GA[i] = *(const uint4*)((AP) + (size_t)((M0_) + 32 * i + r0) * (LD) + c0 * 8 + (KT_) * 64);  \
    GB[i] = *(const uint4*)((BP) + (size_t)((N0_) + 32 * i + pr0) * (LD) + c0 * 8 + (KT_) * 64); \
  }
#define SG_LSTORE(GA, GB, BUF)                                                                 \
  {                                                                                            \
    char* as_ = smem + (BUF) * 32768;                                                          \
    char* bs_ = as_ + 16384;                                                                   \
    _Pragma("unroll") for (int i = 0; i < 4; ++i) {                                            \
      const int id = tid + 256 * i, row = id >> 3, c = id & 7;                                 \
      const int off = row * 128 + ((c ^ (row & 7)) << 4);                                      \
      *(uint4*)(as_ + off) = GA[i];                                                            \
      *(uint4*)(bs_ + off) = GB[i];                                                            \
    }                                                                                          \
  }
#define SG_COMPUTE(ACC, BUF, PRIO)                                                                                        \
  {                                                                                                                       \
    const char* as_ = smem + (BUF) * 32768;                                                                               \
    const char* bs_ = as_ + 16384;                                                                                        \
    if (PRIO) __builtin_amdgcn_s_setprio(1);                                                                              \
    _Pragma("unroll") for (int ks = 0; ks < 2; ++ks) {                                                                    \
      bf16x8 a[4], b[4];                                                                                                  \
      const int c = ks * 4 + lg;                                                                                          \
      const int sw = ((c ^ (lr & 7)) << 4);                                                                               \
      _Pragma("unroll") for (int mi = 0; mi < 4; ++mi) a[mi] = *(const bf16x8*)(as_ + (wm * 64 + mi * 16 + lr) * 128 + sw); \
      _Pragma("unroll") for (int ni = 0; ni < 4; ++ni) b[ni] = *(const bf16x8*)(bs_ + (wn * 64 + ni * 16 + lr) * 128 + sw); \
      _Pragma("unroll") for (int mi = 0; mi < 4; ++mi)                                                                    \
        _Pragma("unroll") for (int ni = 0; ni < 4; ++ni)                                                                  \
          ACC[mi][ni] = __builtin_amdgcn_mfma_f32_16x16x32_bf16(b[ni], a[mi], ACC[mi][ni], 0, 0, 0);                      \
    }                                                                                                                     \
    if (PRIO) __builtin_amdgcn_s_setprio(0);                                                                              \
  }

typedef int i32x8 __attribute__((ext_vector_type(8)));
typedef int i32x4 __attribute__((ext_vector_type(4)));
#define F8_LOCALS                                                                              \
  const int tid = TID();                                                                       \
  const int l = tid & 63, w = tid >> 6, wm = w >> 1, wn = w & 1, lr = l & 15, lg = l >> 4;     \
  uint4 ga0[4], gb0[4], ga1[4], gb1[4];                                                        \
  _Pragma("unroll") for (int i = 0; i < 4; ++i) {                                              \
    ga0[i] = make_uint4(0u, 0u, 0u, 0u); gb0[i] = ga0[i]; ga1[i] = ga0[i]; gb1[i] = ga0[i];    \
  }                                                                                            \
  const int r0 = tid >> 3, c0 = tid & 7;                                                       \
  const int pr0 = 8 * ((r0 & 15) >> 2) + 4 * (r0 >> 4) + (r0 & 3);
#define F8_GLOAD(GA, GB, AP, LDA, BP, LDB, M0_, N0_, KT_)                                      \
  _Pragma("unroll") for (int i = 0; i < 4; ++i) {                                              \
    GA[i] = *(const uint4*)((AP) + (size_t)((M0_) + 32 * i + r0) * (LDA) + c0 * 16 + (KT_) * 128);   \
    GB[i] = *(const uint4*)((BP) + (size_t)((N0_) + 32 * i + pr0) * (LDB) + c0 * 16 + (KT_) * 128);  \
  }
#define F8_LSTORE(GA, GB, BUF)                                                                 \
  {                                                                                            \
    char* as_ = smem + (BUF) * 32768;                                                          \
    char* bs_ = as_ + 16384;                                                                   \
    _Pragma("unroll") for (int i = 0; i < 4; ++i) {                                            \
      const int id = tid + 256 * i, row = id >> 3, c = id & 7;                                 \
      const int off = row * 128 + ((c ^ (row & 7)) << 4);                                      \
      *(uint4*)(as_ + off) = GA[i];                                                            \
      *(uint4*)(bs_ + off) = GB[i];                                                            \
    }                                                                                          \
  }
#define F8_COMPUTE(BUF)                                                                                                   \
  {                                                                                                                       \
    const char* as_ = smem + (BUF) * 32768;                                                                               \
    const char* bs_ = as_ + 16384;                                                                                        \
    i32x8 a[4], b[4];                                                                                                     \
    const int sw0 = ((lg ^ (lr & 7)) << 4), sw1 = (((4 + lg) ^ (lr & 7)) << 4);                                           \
    _Pragma("unroll") for (int mi = 0; mi < 4; ++mi) {                                                                    \
      const char* p_ = as_ + (wm * 64 + mi * 16 + lr) * 128;                                                              \
      const i32x4 lo_ = *(const i32x4*)(p_ + sw0), hi_ = *(const i32x4*)(p_ + sw1);                                       \
      a[mi] = __builtin_shufflevector(lo_, hi_, 0, 1, 2, 3, 4, 5, 6, 7);                                                  \
    }                                                                                                                     \
    _Pragma("unroll") for (int ni = 0; ni < 4; ++ni) {                                                                    \
      const char* p_ = bs_ + (wn * 64 + ni * 16 + lr) * 128;                                                              \
      const i32x4 lo_ = *(const i32x4*)(p_ + sw0), hi_ = *(const i32x4*)(p_ + sw1);                                       \
      b[ni] = __builtin_shufflevector(lo_, hi_, 0, 1, 2, 3, 4, 5, 6, 7);                                                  \
    }                                                                                                                     \
    __builtin_amdgcn_s_setprio(1);                                                                                        \
    _Pragma("unroll") for (int mi = 0; mi < 4; ++mi)                                                                      \
      _Pragma("unroll") for (int ni = 0; ni < 4; ++ni)                                                                    \
        acc[mi][ni] = __builtin_amdgcn_mfma_scale_f32_16x16x128_f8f6f4(b[ni], a[mi], acc[mi][ni], 0, 0, 0, 0, 0, 0);      \
    __builtin_amdgcn_s_setprio(0);                                                                                        \
  }
#define F8_KLOOP(AP, LDA, BP, LDB, KT_)                                                        \
  for (int kt = 0; kt < (KT_); kt += 2) {                                                      \
    const bool wrap = (kt + 2 >= (KT_));                                                       \
    const int ml = wrap ? m0n : m0, nl = wrap ? n0n : n0, kl = wrap ? kt + 2 - (KT_) : kt + 2; \
    if (!wrap || hasn) { F8_GLOAD(ga0, gb0, AP, LDA, BP, LDB, ml, nl, kl); }                   \
    F8_COMPUTE(0);                                                                             \
    F8_LSTORE(ga1, gb1, 1);                                                                    \
    __syncthreads();                                                                           \
    if (!wrap || hasn) { F8_GLOAD(ga1, gb1, AP, LDA, BP, LDB, ml, nl, kl + 1); }               \
    F8_COMPUTE(1);                                                                             \
    if (!wrap || hasn) { F8_LSTORE(ga0, gb0, 0); }                                             \
    __syncthreads();                                                                           \
  }
#define F8_PROLOGUE(AP, LDA, BP, LDB)                                                          \
  __syncthreads();                           \
  F8_GLOAD(ga0, gb0, AP, LDA, BP, LDB, m0, n0, 0);                                             \
  F8_GLOAD(ga1, gb1, AP, LDA, BP, LDB, m0, n0, 1);                                             \
  F8_LSTORE(ga0, gb0, 0);                                                                      \
  __syncthreads();

__device__ __forceinline__ void phase_gemm_win(int layer, char* smem) {
  const KP PP = get_params();
  const char* Bt = (const char*)(PP->WinT + (size_t)layer * NPAD * LDK1);
  const char* A = (const char*)PP->h;
  F8_LOCALS
  int it = 0, mt, nt;
  if (!tile_map(it, R / 128, NPAD / 128, mt, nt)) return;
  int m0 = mt * 128, n0 = nt * 128;
  F8_PROLOGUE(A, LDK1 * 2, Bt, LDK1)
  for (;;) {
    int mtn = 0, ntn = 0;
    const bool hasn = tile_map(it + 1, R / 128, NPAD / 128, mtn, ntn);
    const int m0n = mtn * 128, n0n = ntn * 128;
    f32x4 acc[4][4];
    zero_acc(acc);
    F8_KLOOP(A, LDK1 * 2, Bt, LDK1, 8)
#pragma unroll
    for (int mi = 0; mi < 4; ++mi) {
      const size_t gr = (size_t)(m0 + wm * 64 + mi * 16 + lr);
#pragma unroll
      for (int g = 0; g < 2; ++g) {
        const int gc = n0 + wn * 64 + g * 32 + 8 * lg;
        const f32x4 t0 = acc[mi][2 * g] * (1.f / 32.f), t1 = acc[mi][2 * g + 1] * (1.f / 32.f);
        if (n0 < 1536) {
          int p0 = __builtin_amdgcn_cvt_pk_fp8_f32(t0[0], t0[1], 0, false);
          p0 = __builtin_amdgcn_cvt_pk_fp8_f32(t0[2], t0[3], p0, true);
          int p1 = __builtin_amdgcn_cvt_pk_fp8_f32(t1[0], t1[1], 0, false);
          p1 = __builtin_amdgcn_cvt_pk_fp8_f32(t1[2], t1[3], p1, true);
          *(int2*)((char*)PP->qkv_pre + gr * 1536 + gc) = make_int2(p0, p1);
        } else if (n0 < 2048) {
          *(uint4*)(PP->z + gr * 512 + (gc - 1536)) =
              make_uint4(pack_bf16(t0[0], t0[1]), pack_bf16(t0[2], t0[3]), pack_bf16(t1[0], t1[1]), pack_bf16(t1[2], t1[3]));
        } else if (n0 < 2560) {
          *(uint4*)(PP->pin + gr * 512 + (gc - 2048)) =
              make_uint4(pack_bf16(t0[0], t0[1]), pack_bf16(t0[2], t0[3]), pack_bf16(t1[0], t1[1]), pack_bf16(t1[2], t1[3]));
        } else if (n0 < 4608) {
          unsigned q0 = 0u, q1 = 0u;
#pragma unroll
          for (int e = 0; e < 4; ++e) {
            q0 = __builtin_amdgcn_cvt_pk_u8_f32(sigmoidf_(t0[e]) * 255.f, e, q0);
            q1 = __builtin_amdgcn_cvt_pk_u8_f32(sigmoidf_(t1[e]) * 255.f, e, q1);
          }
          unsigned char* gdst = (n0 < 3584) ? (unsigned char*)PP->sgd + gr * 1024 + (gc - 2560)
                                            : (unsigned char*)PP->sgp + gr * 1024 + (gc - 3584);
          *(uint2*)gdst = make_uint2(q0, q1);
        } else {
          if (gc - 4608 < 16) {
            *(float4*)(PP->ba + gr * 16 + (gc - 4608)) = make_float4(t0[0], t0[1], t0[2], t0[3]);
            *(float4*)(PP->ba + gr * 16 + (gc - 4608) + 4) = make_float4(t1[0], t1[1], t1[2], t1[3]);
          }
        }
      }
    }
    if (!hasn) break;
    m0 = m0n; n0 = n0n; ++it;
  }
}

__device__ __forceinline__ void phase_conv(int layer) {
  const KP PP = get_params();
  const int lane = TID() & 63;
  const int gw = BID() * 4 + (TID() >> 6), nw = gridDim.x * 4;
  const float* cw = PP->conv_w + (size_t)layer * 4 * 1536;
  float wr[3][4][8];
#pragma unroll
  for (int part = 0; part < 3; ++part)
#pragma unroll
    for (int j = 0; j < 4; ++j) {
      const float4 w0 = *(const float4*)(cw + j * 1536 + part * 512 + lane * 8);
      const float4 w1 = *(const float4*)(cw + j * 1536 + part * 512 + lane * 8 + 4);
      wr[part][j][0] = w0.x; wr[part][j][1] = w0.y; wr[part][j][2] = w0.z; wr[part][j][3] = w0.w;
      wr[part][j][4] = w1.x; wr[part][j][5] = w1.y; wr[part][j][6] = w1.z; wr[part][j][7] = w1.w;
    }
  for (int r = gw; r < R; r += nw) {
    int t, T;
    if (r < NLAT) { t = r & (SEQ - 1); T = SEQ; } else { t = (r - NLAT) & (CTX - 1); T = CTX; }
    const int base = r - t;
    uint2 xv[3][4];
#pragma unroll
    for (int j = 0; j < 4; ++j) {
      const int tt = t + j - 2;
      const bool ok = (tt >= 0 && tt < T);
      const unsigned char* src = (const unsigned char*)PP->qkv_pre + (size_t)(base + (ok ? tt : t)) * 1536 + lane * 8;
#pragma unroll
      for (int part = 0; part < 3; ++part) {
        xv[part][j] = *(const uint2*)(src + part * 512);
        if (!ok) xv[part][j] = make_uint2(0u, 0u);
      }
    }
#pragma unroll
    for (int part = 0; part < 3; ++part) {
      const int ch0 = part * 512 + lane * 8;
      float y[8];
#pragma unroll
      for (int e = 0; e < 8; ++e) y[e] = 0.f;
#pragma unroll
      for (int j = 0; j < 4; ++j) {
        float xf[8];
        {
          const f32x2 a0 = __builtin_amdgcn_cvt_pk_f32_fp8(xv[part][j].x, false), a1 = __builtin_amdgcn_cvt_pk_f32_fp8(xv[part][j].x, true);
          const f32x2 a2 = __builtin_amdgcn_cvt_pk_f32_fp8(xv[part][j].y, false), a3 = __builtin_amdgcn_cvt_pk_f32_fp8(xv[part][j].y, true);
          xf[0] = a0[0]; xf[1] = a0[1]; xf[2] = a1[0]; xf[3] = a1[1]; xf[4] = a2[0]; xf[5] = a2[1]; xf[6] = a3[0]; xf[7] = a3[1];
        }
#pragma unroll
        for (int e = 0; e < 8; ++e) y[e] += wr[part][j][e] * xf[e];
      }
      float ss = 0.f;
#pragma unroll
      for (int e = 0; e < 8; ++e) { y[e] = siluf_(y[e]); ss += y[e] * y[e]; }
      if (part < 2) {
        ss = group16_sum(ss);
        const float sc = rsqrtf(ss + EPS) * (part == 0 ? 0.08838834764831845f : 1.f);
#pragma unroll
        for (int e = 0; e < 8; ++e) y[e] *= sc;
      }
      *(uint4*)(PP->qkvn + (size_t)r * 1536 + ch0) = pack8(y);
    }
    if (lane < 16) {
      const float raw = PP->ba[(size_t)r * 16 + lane];
      float o;
      if (lane < 8) {
        o = sigmoidf_(raw);
      } else {
        const int jj = lane - 8;
        const float xx = raw + PP->dt_bias[layer * 8 + jj];
        const float ee = __expf(xx);
        const float sp = xx > 20.f ? xx : (ee < 0.03125f ? ee * (1.f - ee * (0.5f - ee * (0.33333334f - 0.25f * ee))) : __logf(1.f + ee));
        o = -__expf(PP->a_log[layer * 8 + jj]) * sp;
      }
      PP->bg[(size_t)r * 16 + lane] = o;
    }
  }
}

DEV int seq_row(int b, int dir, int pos) {
  if (dir == 0) return pos < CTX ? NLAT + b * CTX + pos : b * SEQ + (pos - CTX);
  return pos < CTX ? NLAT + b * CTX + (CTX - 1 - pos) : b * SEQ + (SEQ - 1 - (pos - CTX));
}
constexpr int NCHUNK = (CTX + SEQ) / 64;
constexpr int NUNIT = BATCH * DNH * 2 * NCHUNK;

DEV int kperm(int s, int g, int e) { return 32 * s + 16 * (e >> 2) + 4 * g + (e & 3); }

DEV uint4 pack_tiles(const f32x4& a, const f32x4& b) {
  return make_uint4(pack_bf16(a[0], a[1]), pack_bf16(a[2], a[3]), pack_bf16(b[0], b[1]), pack_bf16(b[2], b[3]));
}
DEV bf16x8 as_frag(const uint4& v) { return *(const bf16x8*)&v; }

DEV void conv8_silu(const unsigned char* __restrict__ qkv_pre8, const float* __restrict__ cw, int r, int ch0, float (&y)[8]) {
  int t, T;
  if (r < NLAT) { t = r & (SEQ - 1); T = SEQ; } else { t = (r - NLAT) & (CTX - 1); T = CTX; }
  const int base = r - t;
  uint2 xv[4];
#pragma unroll
  for (int j = 0; j < 4; ++j) {
    const int tt = t + j - 2;
    const bool ok = (tt >= 0 && tt < T);
    xv[j] = *(const uint2*)(qkv_pre8 + (size_t)(base + (ok ? tt : t)) * 1536 + ch0);
    if (!ok) xv[j] = make_uint2(0u, 0u);
  }
#pragma unroll
  for (int e = 0; e < 8; ++e) y[e] = 0.f;
#pragma unroll
  for (int j = 0; j < 4; ++j) {
    const float4 w0 = *(const float4*)(cw + j * 1536 + ch0), w1 = *(const float4*)(cw + j * 1536 + ch0 + 4);
    const f32x2 a0 = __builtin_amdgcn_cvt_pk_f32_fp8(xv[j].x, false), a1 = __builtin_amdgcn_cvt_pk_f32_fp8(xv[j].x, true);
    const f32x2 a2 = __builtin_amdgcn_cvt_pk_f32_fp8(xv[j].y, false), a3 = __builtin_amdgcn_cvt_pk_f32_fp8(xv[j].y, true);
    y[0] += w0.x * a0[0]; y[1] += w0.y * a0[1]; y[2] += w0.z * a1[0]; y[3] += w0.w * a1[1];
    y[4] += w1.x * a2[0]; y[5] += w1.y * a2[1]; y[6] += w1.z * a3[0]; y[7] += w1.w * a3[1];
  }
#pragma unroll
  for (int e = 0; e < 8; ++e) y[e] = siluf_(y[e]);
}

__device__ __forceinline__ void phase_prep(int layer, char* smem) {
  const KP PP = get_params();
  const int tid0 = TID();
  const int w = __builtin_amdgcn_readfirstlane(tid0 >> 6);
  char* Kt = smem;
  char* Vt = smem + 16384;
  float* Ld = (float*)(smem + 32768);
  u16* LN = (u16*)(smem + 32768 + 5120);
  float* gcs = (float*)(smem + 32768 + 5120 + 9216);
  float* bts = gcs + 64;
  char* wpriv = smem + 32768 + 5120 + 9216 + 512 + w * 6144;
  float* Tt = (float*)wpriv;
  u16* Xb = (u16*)(wpriv + 4096);
  for (int j_ = BID() >> 3; j_ < 2 * NCHUNK; j_ += (gridDim.x >> 3)) {
    const int c = NCHUNK - 1 - (j_ >> 1), u16i = (BID() & 7) * 2 + (j_ & 1);
    const int unit = u16i * NCHUNK + c;
    const int dir = u16i & 1, hd = (u16i >> 1) & 3, b = u16i >> 3;
    int tid = tid0;
    asm volatile("" : "+v"(tid));
    const int l = tid & 63, lr = l & 15, lg = l >> 4;
    __syncthreads();
    if (tid < 64) {
      const int rr = seq_row(b, dir, c * 64 + tid);
      const int jj = dir * 4 + hd;
      bts[tid] = sigmoidf_(PP->ba[(size_t)rr * 16 + jj]);
      float g;
      {
        const float xx = PP->ba[(size_t)rr * 16 + 8 + jj] + PP->dt_bias[layer * 8 + jj];
        const float ee = __expf(xx);
        const float sp = xx > 20.f ? xx : (ee < 0.03125f ? ee * (1.f - ee * (0.5f - ee * (0.33333334f - 0.25f * ee))) : __logf(1.f + ee));
        g = -__expf(PP->a_log[layer * 8 + jj]) * sp;
      }
#pragma unroll
      for (int o = 1; o < 64; o <<= 1) {
        const float t = __builtin_bit_cast(float, __builtin_amdgcn_ds_bpermute(((tid - o) & 63) << 2, __builtin_bit_cast(int, g)));
        if (tid >= o) g += t;
      }
      gcs[tid] = g;
      PP->gc[(size_t)unit * 64 + tid] = g;
    }
    {
      const unsigned char* pre8 = (const unsigned char*)PP->qkv_pre;
      const float* cw = PP->conv_w + (size_t)layer * 4 * 1536;
      const int ch = tid & 15, rg = tid >> 4;
      const int r_first = seq_row(b, dir, c * 64 + 4 * rg);
      int t0, T;
      if (r_first < NLAT) { t0 = r_first & (SEQ - 1); T = SEQ; } else { t0 = (r_first - NLAT) & (CTX - 1); T = CTX; }
      const int base = r_first - t0;
      const int tl = dir ? t0 - 3 : t0;
      const int nparts = dir == 0 ? 3 : 2;
      for (int part = 0; part < nparts; ++part) {
        const int chofs = (part == 0 ? 512 : (part == 1 ? 1024 : 0)) + hd * 128 + ch * 8;
        f32x2 wv[4][4];
#pragma unroll
        for (int j = 0; j < 4; ++j) {
          const float4 w0 = *(const float4*)(cw + j * 1536 + chofs), w1 = *(const float4*)(cw + j * 1536 + chofs + 4);
          wv[j][0] = (f32x2){w0.x, w0.y}; wv[j][1] = (f32x2){w0.z, w0.w};
          wv[j][2] = (f32x2){w1.x, w1.y}; wv[j][3] = (f32x2){w1.z, w1.w};
        }
        uint2 xr[7];
#pragma unroll
        for (int m = 0; m < 7; ++m) {
          const int tt = tl - 2 + m;
          const bool ok = (tt >= 0 && tt < T);
          xr[m] = *(const uint2*)(pre8 + (size_t)(base + (ok ? tt : t0)) * 1536 + chofs);
          if (!ok) xr[m] = make_uint2(0u, 0u);
        }
        f32x2 xf[7][4];
#pragma unroll
        for (int m = 0; m < 7; ++m) {
          xf[m][0] = __builtin_amdgcn_cvt_pk_f32_fp8(xr[m].x, false); xf[m][1] = __builtin_amdgcn_cvt_pk_f32_fp8(xr[m].x, true);
          xf[m][2] = __builtin_amdgcn_cvt_pk_f32_fp8(xr[m].y, false); xf[m][3] = __builtin_amdgcn_cvt_pk_f32_fp8(xr[m].y, true);
        }
        f32x2 acc2[4][4];
        if (dir == 0) {
#pragma unroll
          for (int s4 = 0; s4 < 4; ++s4)
#pragma unroll
            for (int p = 0; p < 4; ++p) {
              f32x2 a = wv[0][p] * xf[s4][p];
#pragma unroll
              for (int j = 1; j < 4; ++j) a += wv[j][p] * xf[s4 + j][p];
              acc2[s4][p] = a;
            }
        } else {
#pragma unroll
          for (int s4 = 0; s4 < 4; ++s4)
#pragma unroll
            for (int p = 0; p < 4; ++p) {
              f32x2 a = wv[0][p] * xf[3 - s4][p];
#pragma unroll
              for (int j = 1; j < 4; ++j) a += wv[j][p] * xf[3 - s4 + j][p];
              acc2[s4][p] = a;
            }
        }
        float y[4][8], ss[4];
#pragma unroll
        for (int s4 = 0; s4 < 4; ++s4) {
          float t = 0.f;
#pragma unroll
          for (int p = 0; p < 4; ++p) {
            const float a0 = siluf_(acc2[s4][p][0]), a1 = siluf_(acc2[s4][p][1]);
            y[s4][2 * p] = a0; y[s4][2 * p + 1] = a1;
            t += a0 * a0 + a1 * a1;
          }
          ss[s4] = t;
        }
        if (part != 1) {
#pragma unroll
          for (int s4 = 0; s4 < 4; ++s4) ss[s4] += swz_xor<8>(ss[s4]);
#pragma unroll
          for (int s4 = 0; s4 < 4; ++s4) ss[s4] += swz_xor<4>(ss[s4]);
#pragma unroll
          for (int s4 = 0; s4 < 4; ++s4) ss[s4] += swz_xor<2>(ss[s4]);
#pragma unroll
          for (int s4 = 0; s4 < 4; ++s4) ss[s4] += swz_xor<1>(ss[s4]);
#pragma unroll
          for (int s4 = 0; s4 < 4; ++s4) {
            const float sc = rsqrtf(ss[s4] + EPS) * (part == 2 ? 0.08838834764831845f : 1.f);
#pragma unroll
            for (int e2 = 0; e2 < 8; ++e2) y[s4][e2] *= sc;
          }
        }
#pragma unroll
        for (int s4 = 0; s4 < 4; ++s4) {
          const int m0_ = dir ? 3 - s4 : s4;
          const uint4 pk = pack8(y[s4]);
          const int i = 4 * rg + s4;
          if (part < 2) *(uint4*)((part == 0 ? Kt : Vt) + i * 256 + ((ch ^ (i & 15)) << 4)) = pk;
          if (dir == 0 && part != 1) *(uint4*)(PP->qkvn + (size_t)(base + tl + m0_) * 1536 + chofs) = pk;
        }
      }
    }
    __syncthreads();
    {
      f32x4 acc[4];
#pragma unroll
      for (int nt = 0; nt < 4; ++nt) acc[nt] = (f32x4){0.f, 0.f, 0.f, 0.f};
#pragma unroll
      for (int s = 0; s < 4; ++s) {
        const int ch = s * 4 + lg;
        const bf16x8 a = *(const bf16x8*)(Kt + (16 * w + lr) * 256 + ((ch ^ lr) << 4));
#pragma unroll
        for (int nt = 0; nt < 4; ++nt) {
          const bf16x8 bb = *(const bf16x8*)(Kt + (16 * nt + lr) * 256 + ((ch ^ lr) << 4));
          acc[nt] = __builtin_amdgcn_mfma_f32_16x16x32_bf16(a, bb, acc[nt], 0, 0, 0);
        }
      }
#pragma unroll
      for (int nt = 0; nt < 4; ++nt)
#pragma unroll
        for (int r = 0; r < 4; ++r) {
          const int i = 16 * w + 4 * lg + r, j = 16 * nt + lr;
          const float val = (j < i) ? bts[i] * acc[nt][r] * __expf(fminf(gcs[i] - gcs[j], 0.f)) : 0.f;
          LN[i * 72 + j] = f2bf(-val);
          if (nt == w) Ld[(w * 16 + lr) * 20 + 4 * lg + r] = val;
        }
    }
    {
      const float glast = gcs[63];
      if (tid == 0) PP->glast[unit] = glast;
#pragma unroll
      for (int q4 = 0; q4 < 4; ++q4) {
        const int fid = tid + 256 * q4;
        const int mt = fid >> 7, s2 = (fid >> 6) & 1, ln = fid & 63, llr = ln & 15, llg = ln >> 4;
        const int d = 16 * mt + llr;
        float f[8];
#pragma unroll
        for (int e = 0; e < 8; ++e) {
          const int pos = kperm(s2, llg, e);
          const float kv = bf2f(*(const u16*)(Kt + pos * 256 + (((d >> 3) ^ (pos & 15)) << 4) + (d & 7) * 2));
          f[e] = kv * __expf(glast - gcs[pos]);
        }
        *(uint4*)(PP->KdT + ((size_t)unit * 1024 + fid) * 8) = pack8(f);
      }
    }
    f32x4 X[4][4];
    {
      const bool isU = w >= 2;
      const char* tile = isU ? Vt : Kt;
#pragma unroll
      for (int mt = 0; mt < 4; ++mt)
#pragma unroll
        for (int nt = 0; nt < 4; ++nt)
#pragma unroll
          for (int r = 0; r < 4; ++r) {
            const int i = 16 * mt + 4 * lg + r, cc = 64 * (w & 1) + 16 * nt + lr;
            const float val = bf2f(*(const u16*)(tile + i * 256 + (((cc >> 3) ^ (i & 15)) << 4) + (cc & 7) * 2));
            X[mt][nt][r] = bts[i] * val * (isU ? 1.f : __expf(gcs[i]));
          }
    }
    __syncthreads();
    u16* Wst = (u16*)smem;
    u16* Ust = (u16*)(smem + 16384);
#pragma unroll
    for (int bk = 0; bk < 4; ++bk) {
#pragma unroll
      for (int nt = 0; nt < 4; ++nt)
#pragma unroll
        for (int r = 0; r < 4; ++r) Tt[(4 * lg + r) * 64 + 16 * nt + lr] = X[bk][nt][r];
      __builtin_amdgcn_wave_barrier();
      asm volatile("s_waitcnt lgkmcnt(0)" ::: "memory");
      float xb[16];
#pragma unroll
      for (int i = 0; i < 16; ++i) xb[i] = Tt[i * 64 + l];
#pragma unroll
      for (int j = 0; j < 15; ++j) {
        const float xj = xb[j];
#pragma unroll
        for (int i4 = (j + 1) / 4; i4 < 4; ++i4) {
          const float4 lv = *(const float4*)&Ld[(bk * 16 + j) * 20 + i4 * 4];
          if (i4 * 4 + 0 > j) xb[i4 * 4 + 0] -= lv.x * xj;
          if (i4 * 4 + 1 > j) xb[i4 * 4 + 1] -= lv.y * xj;
          if (i4 * 4 + 2 > j) xb[i4 * 4 + 2] -= lv.z * xj;
          if (i4 * 4 + 3 > j) xb[i4 * 4 + 3] -= lv.w * xj;
        }
      }
      {
        const int cc = 64 * (w & 1) + l;
        if (w < 2) {
          const int d = cc, s = d >> 5, e = ((d >> 4) & 1) * 4 + (d & 3), g = (d >> 2) & 3;
#pragma unroll
          for (int ii = 0; ii < 16; ++ii) Wst[(((bk * 4 + s) * 64 + g * 16 + ii) << 3) + e] = f2bf(-xb[ii]);
        } else {
          const int slice = cc >> 4, lr_ = cc & 15;
#pragma unroll
          for (int ii = 0; ii < 16; ++ii) Ust[(((slice * 4 + bk) * 64 + ((ii >> 2) & 3) * 16 + lr_) << 2) + (ii & 3)] = f2bf(xb[ii]);
        }
        if (bk < 3) {
          *(uint4*)(Xb + l * 16) = pack8(xb);
          *(uint4*)(Xb + l * 16 + 8) = pack8(xb + 8);
        }
      }
      if (bk < 3) {
        __builtin_amdgcn_wave_barrier();
        asm volatile("s_waitcnt lgkmcnt(0)" ::: "memory");
        uint4 bfr[4];
#pragma unroll
        for (int nt = 0; nt < 4; ++nt)
          bfr[nt] = (lg < 2) ? *(const uint4*)(Xb + (16 * nt + lr) * 16 + 8 * lg) : make_uint4(0u, 0u, 0u, 0u);
#pragma unroll
        for (int mt = bk + 1; mt < 4; ++mt) {
          const uint4 afr = (lg < 2) ? *(const uint4*)(LN + (16 * mt + lr) * 72 + 16 * bk + 8 * lg) : make_uint4(0u, 0u, 0u, 0u);
#pragma unroll
          for (int nt = 0; nt < 4; ++nt)
            X[mt][nt] = __builtin_amdgcn_mfma_f32_16x16x32_bf16(as_frag(afr), as_frag(bfr[nt]), X[mt][nt], 0, 0, 0);
        }
        __builtin_amdgcn_wave_barrier();
      }
    }
    __syncthreads();
#pragma unroll
    for (int q = 0; q < 4; ++q) {
      const int id = tid + 256 * q;
      *(uint4*)(PP->Wfrag + ((size_t)unit * 1024 + id) * 8) = *(const uint4*)(smem + id * 16);
      *(uint4*)(PP->Ufrag + ((size_t)unit * 1024 + id) * 8) = *(const uint4*)(smem + 16384 + id * 16);
    }
  }
}


__device__ __forceinline__ void phase_scan(char* smem) {
  const KP PP = get_params();
  const int tid = TID(), lane = tid & 63, wv = tid >> 6;
  __builtin_amdgcn_s_setprio(3);
  for (int item = BID(); item < 128; item += gridDim.x) {
    const int u16i = (item & 7) * 2 + (item >> 6), slice = (item >> 3) & 7;
    const size_t ubase = (size_t)u16i * NCHUNK;
    const uint4* Wg = (const uint4*)PP->Wfrag;
    const uint4* Kg = (const uint4*)PP->KdT;
    __syncthreads();
    if (wv != 0) {
      const int j0 = wv - 1;
      uint4 st0[11], st1[11], st2[11];
#pragma unroll
      for (int i = 0; i < 11; ++i) { st0[i] = make_uint4(0u, 0u, 0u, 0u); st1[i] = st0[i]; st2[i] = st0[i]; }
#define LLOAD(ST, UNIT)                                                                                      \
  _Pragma("unroll") for (int i = 0; i < 11; ++i) {                                                           \
    const int q = (j0 + 3 * i) < 32 ? (j0 + 3 * i) : 31;                                                     \
    ST[i] = *((q < 16 ? Wg + (UNIT) * 1024 + q * 64 : Kg + (UNIT) * 1024 + (q - 16) * 64) + lane);           \
  }
#define LWRITE(ST, SLOT)                                                                                     \
  _Pragma("unroll") for (int i = 0; i < 11; ++i) {                                                           \
    const int q = (j0 + 3 * i) < 32 ? (j0 + 3 * i) : 31;                                                     \
    *(uint4*)((SLOT) + q * 1024 + lane * 16) = ST[i];                                                        \
  }
      LLOAD(st0, ubase);
      LLOAD(st1, ubase + 1);
      LLOAD(st2, ubase + 2);
      LWRITE(st0, smem);
      LLOAD(st0, ubase + 3);
      __syncthreads();
#define LSTEP(ST, C)                                                                   \
  {                                                                                    \
    LWRITE(ST, smem + (((C) + 1) & 1) * 32768);                                        \
    LLOAD(ST, ubase + (size_t)(((C) + 4 < NCHUNK) ? (C) + 4 : NCHUNK - 1));            \
    __syncthreads();                                                                   \
  }
      for (int c0 = 0; c0 < NCHUNK; c0 += 3) {
        LSTEP(st1, c0);
        LSTEP(st2, c0 + 1);
        LSTEP(st0, c0 + 2);
      }
#undef LSTEP
#undef LLOAD
#undef LWRITE
    } else {
      f32x4 S[8];
#pragma unroll
      for (int t = 0; t < 8; ++t) S[t] = (f32x4){0.f, 0.f, 0.f, 0.f};
      uint2 uf0[5], uf1[5], uf2[5];
#pragma unroll
      for (int i = 0; i < 5; ++i) { uf0[i] = make_uint2(0u, 0u); uf1[i] = uf0[i]; uf2[i] = uf0[i]; }
      const uint2* Ug = (const uint2*)PP->Ufrag + lane;
      const float* Gl = PP->glast;
#define ULOAD(UF, UNIT) { _Pragma("unroll") for (int i = 0; i < 4; ++i) UF[i] = Ug[((UNIT) * 8 + slice) * 256 + i * 64]; UF[4].x = __float_as_uint(Gl[UNIT]); }
      ULOAD(uf0, ubase);
      ULOAD(uf1, ubase + 1);
      ULOAD(uf2, ubase + 2);
#define CSTEP(UF, C)                                                                                                   \
  {                                                                                                                    \
    const int c = (C);                                                                                                 \
    const size_t unit = ubase + c;                                                                                     \
    const char* slot = smem + (c & 1) * 32768;                                                                         \
    const float el = __expf(__uint_as_float(UF[4].x));                                                                 \
    uint4 sb[4];                                                                                                       \
    _Pragma("unroll") for (int s2 = 0; s2 < 4; ++s2) sb[s2] = pack_tiles(S[2 * s2], S[2 * s2 + 1]);                    \
    {                                                                                                                  \
      uint4* sp = (uint4*)PP->Sfrag + (unit * 8 + slice) * 256 + lane;                                                 \
      _Pragma("unroll") for (int s2 = 0; s2 < 4; ++s2) sp[s2 * 64] = sb[s2];                                           \
    }                                                                                                                  \
    f32x4 vn[4];                                                                                                       \
    _Pragma("unroll") for (int mt = 0; mt < 4; ++mt) {                                                                 \
      vn[mt] = (f32x4){bf_lo(UF[mt].x), bf_hi(UF[mt].x), bf_lo(UF[mt].y), bf_hi(UF[mt].y)};                            \
      _Pragma("unroll") for (int s2 = 0; s2 < 4; ++s2) {                                                               \
        const uint4 wfr = *(const uint4*)(slot + (mt * 4 + s2) * 1024 + lane * 16);                                    \
        vn[mt] = __builtin_amdgcn_mfma_f32_16x16x32_bf16(as_frag(wfr), as_frag(sb[s2]), vn[mt], 0, 0, 0);              \
      }                                                                                                                \
    }                                                                                                                  \
    ULOAD(UF, ubase + (size_t)((c + 3 < NCHUNK) ? c + 3 : NCHUNK - 1));                                                \
    uint4 vb[2];                                                                                                       \
    vb[0] = pack_tiles(vn[0], vn[1]);                                                                                  \
    vb[1] = pack_tiles(vn[2], vn[3]);                                                                                  \
    {                                                                                                                  \
      uint4* vp = (uint4*)PP->Vfrag + (unit * 8 + slice) * 128 + lane;                                                 \
      vp[0] = vb[0];                                                                                                   \
      vp[64] = vb[1];                                                                                                  \
    }                                                                                                                  \
    _Pragma("unroll") for (int t = 0; t < 8; ++t) {                                                                    \
      S[t] *= el;                                                                                                      \
      const uint4 k0 = *(const uint4*)(slot + 16384 + (t * 2 + 0) * 1024 + lane * 16);                                 \
      const uint4 k1 = *(const uint4*)(slot + 16384 + (t * 2 + 1) * 1024 + lane * 16);                                 \
      S[t] = __builtin_amdgcn_mfma_f32_16x16x32_bf16(as_frag(k0), as_frag(vb[0]), S[t], 0, 0, 0);                      \
      S[t] = __builtin_amdgcn_mfma_f32_16x16x32_bf16(as_frag(k1), as_frag(vb[1]), S[t], 0, 0, 0);                      \
    }                                                                                                                  \
    __syncthreads();                                                                                                   \
  }
      __syncthreads();
      for (int c0 = 0; c0 < NCHUNK; c0 += 3) {
        CSTEP(uf0, c0);
        CSTEP(uf1, c0 + 1);
        CSTEP(uf2, c0 + 2);
      }
#undef CSTEP
#undef ULOAD
    }
  }
  __builtin_amdgcn_s_setprio(0);
}

__device__ __forceinline__ void phase_o(int layer, char* smem) {
  const KP PP = get_params();
  const int tid = TID(), l = tid & 63, w = tid >> 6, lr = l & 15, lg = l >> 4;
  char* Qt = smem;
  char* Kt = smem + 16384;
  u16* If = (u16*)(smem + 32768);
  u16* Ib = (u16*)(smem + 41984);
  float* gcf = (float*)(smem + 51200);
  float* gcb = gcf + 64;
  float* rowss = gcb + 64;
  float* Os = (float*)smem;
  const int nper = (layer == DEPTH - 1) ? 128 : 132;
  const int xq = BID() & 7, vl0 = BID() >> 3, vstep = gridDim.x >> 3;
  for (int vi = vl0; vi < nper; vi += vstep) {
    int b = xq >> 2, hd = xq & 3, tok0, cf, cb;
    if (vi < 128) {
      const int n = vi;
      tok0 = b * SEQ + 64 * n; cf = 4 + n; cb = 4 + 127 - n;
    } else {
      const int n = vi - 128;
      tok0 = NLAT + b * CTX + 64 * n; cf = n; cb = 3 - n;
    }
    const size_t unit_f = (size_t)((b * 4 + hd) * 2 + 0) * NCHUNK + cf;
    const size_t unit_b = (size_t)((b * 4 + hd) * 2 + 1) * NCHUNK + cb;
    uint4 pSF[4][2], pSB[4][2], pVF[2][2], pVB[2][2];
#pragma unroll
    for (int q = 0; q < 2; ++q) {
      const int sl = 2 * w + q;
#pragma unroll
      for (int s = 0; s < 4; ++s) {
        pSF[s][q] = *((const uint4*)PP->Sfrag + ((unit_f * 8 + sl) * 4 + s) * 64 + l);
        pSB[s][q] = *((const uint4*)PP->Sfrag + ((unit_b * 8 + sl) * 4 + s) * 64 + l);
      }
#pragma unroll
      for (int s2 = 0; s2 < 2; ++s2) {
        pVF[s2][q] = *((const uint4*)PP->Vfrag + ((unit_f * 8 + sl) * 2 + s2) * 64 + l);
        pVB[s2][q] = *((const uint4*)PP->Vfrag + ((unit_b * 8 + sl) * 2 + s2) * 64 + l);
      }
    }
    __syncthreads();
    for (int idx = tid; idx < 2048; idx += NTHR) {
      const int arr = idx >> 10, i = (idx >> 4) & 63, ch = idx & 15;
      const uint4 v = *(const uint4*)(PP->qkvn + (size_t)(tok0 + i) * 1536 + (arr == 0 ? 0 : 512) + hd * 128 + ch * 8);
      *(uint4*)((arr == 0 ? Qt : Kt) + i * 256 + ((ch ^ (i & 15)) << 4)) = v;
    }
    if (tid < 64) gcf[tid] = PP->gc[unit_f * 64 + tid];
    else if (tid < 128) gcb[tid - 64] = PP->gc[unit_b * 64 + (tid - 64)];
    __syncthreads();
    {
      f32x4 acc[4];
#pragma unroll
      for (int nt = 0; nt < 4; ++nt) acc[nt] = (f32x4){0.f, 0.f, 0.f, 0.f};
#pragma unroll
      for (int s = 0; s < 4; ++s) {
        const int ch = s * 4 + lg;
        const bf16x8 a = *(const bf16x8*)(Qt + (16 * w + lr) * 256 + ((ch ^ lr) << 4));
#pragma unroll
        for (int nt = 0; nt < 4; ++nt) {
          const bf16x8 bb = *(const bf16x8*)(Kt + (16 * nt + lr) * 256 + ((ch ^ lr) << 4));
          acc[nt] = __builtin_amdgcn_mfma_f32_16x16x32_bf16(a, bb, acc[nt], 0, 0, 0);
        }
      }
#pragma unroll
      for (int nt = 0; nt < 4; ++nt)
#pragma unroll
        for (int r = 0; r < 4; ++r) {
          const int i = 16 * w + 4 * lg + r, j = 16 * nt + lr;
          const float vf = (j <= i) ? acc[nt][r] * __expf(fminf(gcf[i] - gcf[j], 0.f)) : 0.f;
          const float vb = (j >= i) ? acc[nt][r] * __expf(fminf(gcb[63 - i] - gcb[63 - j], 0.f)) : 0.f;
          If[i * 72 + j] = f2bf(vf);
          Ib[i * 72 + (63 - j)] = f2bf(vb);
        }
    }
    __syncthreads();
    f32x4 accF[4][2], accB[4][2], accI[4][2];
#pragma unroll
    for (int mt = 0; mt < 4; ++mt)
#pragma unroll
      for (int q = 0; q < 2; ++q) {
        accF[mt][q] = (f32x4){0.f, 0.f, 0.f, 0.f};
        accB[mt][q] = (f32x4){0.f, 0.f, 0.f, 0.f};
        accI[mt][q] = (f32x4){0.f, 0.f, 0.f, 0.f};
      }
#pragma unroll
    for (int s = 0; s < 4; ++s) {
      bf16x8 qa[4];
#pragma unroll
      for (int mt = 0; mt < 4; ++mt) {
        const int row = 16 * mt + lr;
        const int c0 = 4 * s + (lg >> 1), c1 = c0 + 2;
        const uint2 lo = *(const uint2*)(Qt + row * 256 + ((c0 ^ lr) << 4) + (lg & 1) * 8);
        const uint2 hi = *(const uint2*)(Qt + row * 256 + ((c1 ^ lr) << 4) + (lg & 1) * 8);
        const uint4 t = make_uint4(lo.x, lo.y, hi.x, hi.y);
        qa[mt] = as_frag(t);
      }
#pragma unroll
      for (int q = 0; q < 2; ++q) {
        const int sl = 2 * w + q;
        const uint4 bF = pSF[s][q], bB = pSB[s][q];
#pragma unroll
        for (int mt = 0; mt < 4; ++mt) {
          accF[mt][q] = __builtin_amdgcn_mfma_f32_16x16x32_bf16(qa[mt], as_frag(bF), accF[mt][q], 0, 0, 0);
          accB[mt][q] = __builtin_amdgcn_mfma_f32_16x16x32_bf16(qa[mt], as_frag(bB), accB[mt][q], 0, 0, 0);
        }
      }
    }
#pragma unroll
    for (int s2 = 0; s2 < 2; ++s2) {
      bf16x8 ia[4], ib[4];
#pragma unroll
      for (int mt = 0; mt < 4; ++mt) {
        const int row = 16 * mt + lr;
        const int col = 32 * s2 + 4 * lg;
        const uint2 flo = *(const uint2*)(If + row * 72 + col);
        const uint2 fhi = *(const uint2*)(If + row * 72 + col + 16);
        const uint2 blo = *(const uint2*)(Ib + row * 72 + col);
        const uint2 bhi = *(const uint2*)(Ib + row * 72 + col + 16);
        const uint4 tf = make_uint4(flo.x, flo.y, fhi.x, fhi.y);
        const uint4 tb = make_uint4(blo.x, blo.y, bhi.x, bhi.y);
        ia[mt] = as_frag(tf);
        ib[mt] = as_frag(tb);
      }
#pragma unroll
      for (int q = 0; q < 2; ++q) {
        const int sl = 2 * w + q;
        const uint4 vF = pVF[s2][q], vB = pVB[s2][q];
#pragma unroll
        for (int mt = 0; mt < 4; ++mt) {
          accI[mt][q] = __builtin_amdgcn_mfma_f32_16x16x32_bf16(ia[mt], as_frag(vF), accI[mt][q], 0, 0, 0);
          accI[mt][q] = __builtin_amdgcn_mfma_f32_16x16x32_bf16(ib[mt], as_frag(vB), accI[mt][q], 0, 0, 0);
        }
      }
    }
    float o[4][2][4];
#pragma unroll
    for (int mt = 0; mt < 4; ++mt)
#pragma unroll
      for (int r = 0; r < 4; ++r) {
        const int i = 16 * mt + 4 * lg + r;
        const float ef = __expf(gcf[i]), eb = __expf(gcb[63 - i]);
        float ss = 0.f;
#pragma unroll
        for (int q = 0; q < 2; ++q) {
          const float v = ef * accF[mt][q][r] + eb * accB[mt][q][r] + accI[mt][q][r];
          o[mt][q][r] = v;
          ss += v * v;
        }
        ss = group16_sum(ss);
        if (lr == 0) rowss[w * 64 + i] = ss;
      }
    __syncthreads();
#pragma unroll
    for (int mt = 0; mt < 4; ++mt)
#pragma unroll
      for (int q = 0; q < 2; ++q)
#pragma unroll
        for (int r = 0; r < 4; ++r) Os[(16 * mt + 4 * lg + r) * 132 + 16 * (2 * w + q) + lr] = o[mt][q][r];
    __syncthreads();
#pragma unroll
    for (int q4 = 0; q4 < 4; ++q4) {
      const int idx = tid + 256 * q4, i = idx >> 4, ch = idx & 15;
      const float ss = rowss[i] + rowss[64 + i] + rowss[128 + i] + rowss[192 + i];
      const float rs = rsqrtf(ss * (1.f / 128.f) + EPS);
      const float4 o0 = *(const float4*)&Os[i * 132 + ch * 8];
      const float4 o1 = *(const float4*)&Os[i * 132 + ch * 8 + 4];
      const float4 n0 = *(const float4*)(PP->dn_out_norm + layer * 128 + ch * 8);
      const float4 n1 = *(const float4*)(PP->dn_out_norm + layer * 128 + ch * 8 + 4);
      float zf[8];
      unpack8(*(const uint4*)(PP->z + (size_t)(tok0 + i) * 512 + hd * 128 + ch * 8), zf);
      float y[8];
      y[0] = o0.x * rs * n0.x * siluf_(zf[0]); y[1] = o0.y * rs * n0.y * siluf_(zf[1]);
      y[2] = o0.z * rs * n0.z * siluf_(zf[2]); y[3] = o0.w * rs * n0.w * siluf_(zf[3]);
      y[4] = o1.x * rs * n1.x * siluf_(zf[4]); y[5] = o1.y * rs * n1.y * siluf_(zf[5]);
      y[6] = o1.z * rs * n1.z * siluf_(zf[6]); y[7] = o1.w * rs * n1.w * siluf_(zf[7]);
      {
        int p0 = __builtin_amdgcn_cvt_pk_fp8_f32(y[0], y[1], 0, false);
        p0 = __builtin_amdgcn_cvt_pk_fp8_f32(y[2], y[3], p0, true);
        int p1 = __builtin_amdgcn_cvt_pk_fp8_f32(y[4], y[5], 0, false);
        p1 = __builtin_amdgcn_cvt_pk_fp8_f32(y[6], y[7], p1, true);
        *(int2*)((char*)PP->ydn + (size_t)(tok0 + i) * (LDK5 * 2) + hd * 128 + ch * 8) = make_int2(p0, p1);
      }
    }
  }
}

template <int HALF>
DEV void pool_window(const u16* xin, char* Ap, int t0, int L, int tid) {
#pragma unroll
  for (int q = 0; q < 4; ++q) {
    const int idx = tid + 256 * q, i = idx >> 4, c = idx & 15;
    const int t = t0 + i;
    const int lo = (t - HALF) > 0 ? (t - HALF) : 0;
    const int hi = (t + HALF) < L ? (t + HALF) : L;
    float s[8];
#pragma unroll
    for (int e = 0; e < 8; ++e) s[e] = 0.f;
#pragma unroll
    for (int k = 0; k < 2 * HALF; ++k) {
      float f[8];
      unpack8(*(const uint4*)(xin + (i + 8 - HALF + k) * 128 + c * 8), f);
#pragma unroll
      for (int e = 0; e < 8; ++e) s[e] += f[e];
    }
    float xs[8];
    unpack8(*(const uint4*)(xin + (i + 8) * 128 + c * 8), xs);
    const float inv = 1.f / (float)(hi - lo);
#pragma unroll
    for (int e = 0; e < 8; ++e) s[e] = s[e] * inv - xs[e];
    *(uint4*)(Ap + i * 256 + ((c ^ (i & 15)) << 4)) = pack8(s);
  }
}

__device__ __forceinline__ void phase_pool(int layer, char* smem, int vbid, int vnb) {
  const KP PP = get_params();
  const int tid = TID(), l = tid & 63, w = tid >> 6, lr = l & 15, lg = l >> 4;
  u16* xin = (u16*)smem;
  char* Ap = smem + 20480;
  char* Bs = smem + 36864;
  const int ntile = (layer == DEPTH - 1) ? NLAT / 64 : R / 64;
  for (int it = vbid; it < ntile * 4; it += vnb) {
    const int ti = it >> 2, g = it & 3;
    int L, t0, rowbase;
    if (ti < NLAT / 64) { L = 64; t0 = 0; rowbase = ti * 64; }
    else { const int ci = ti - NLAT / 64; L = CTX; t0 = (ci & 3) * 64; rowbase = NLAT + (ci >> 2) * CTX; }
    const int r0 = rowbase + t0;
    __syncthreads();
#pragma unroll
    for (int q = 0; q < 5; ++q) {
      const int idx = tid + 256 * q, i = idx >> 4, c = idx & 15;
      const int pos = t0 - 8 + i;
      uint4 v = make_uint4(0, 0, 0, 0);
      if (pos >= 0 && pos < L) v = *(const uint4*)(PP->pin + (size_t)(rowbase + pos) * 512 + g * 128 + c * 8);
      *(uint4*)(xin + i * 128 + c * 8) = v;
    }
    {
      const u16* Bw = PP->PwT + (size_t)(layer * 4 + g) * 128 * 128;
#pragma unroll
      for (int q = 0; q < 8; ++q) {
        const int idx = tid + 256 * q, n = idx >> 4, c = idx & 15;
        *(uint4*)(Bs + n * 256 + ((c ^ (n & 15)) << 4)) = *(const uint4*)(Bw + (size_t)n * 128 + c * 8);
      }
    }
    __syncthreads();
    if (g == 0) pool_window<1>(xin, Ap, t0, L, tid);
    else if (g == 1) pool_window<2>(xin, Ap, t0, L, tid);
    else if (g == 2) pool_window<4>(xin, Ap, t0, L, tid);
    else pool_window<8>(xin, Ap, t0, L, tid);
    __syncthreads();
    f32x4 acc[8];
#pragma unroll
    for (int ni = 0; ni < 8; ++ni) acc[ni] = (f32x4){0.f, 0.f, 0.f, 0.f};
#pragma unroll
    for (int ks = 0; ks < 4; ++ks) {
      const int row = w * 16 + lr, c = ks * 4 + lg;
      const bf16x8 a = *(const bf16x8*)(Ap + row * 256 + ((c ^ lr) << 4));
#pragma unroll
      for (int ni = 0; ni < 8; ++ni) {
        const bf16x8 bb = *(const bf16x8*)(Bs + (ni * 16 + lr) * 256 + ((c ^ lr) << 4));
        acc[ni] = __builtin_amdgcn_mfma_f32_16x16x32_bf16(bb, a, acc[ni], 0, 0, 0);
      }
    }
    unsigned char* ot = (unsigned char*)smem;
#pragma unroll
    for (int ni = 0; ni < 8; ++ni) {
      const int dcol = ni * 16 + 4 * lg;
      const float4 psc = *(const float4*)(PP->pool_scale + layer * 512 + g * 128 + dcol);
      int pk = __builtin_amdgcn_cvt_pk_fp8_f32(acc[ni][0] * psc.x, acc[ni][1] * psc.y, 0, false);
      pk = __builtin_amdgcn_cvt_pk_fp8_f32(acc[ni][2] * psc.z, acc[ni][3] * psc.w, pk, true);
      *(int*)(ot + (w * 16 + lr) * 128 + dcol) = pk;
    }
    __syncthreads();
    {
      const int row = tid >> 2, seg = tid & 3;
      const uint4 o0 = *(const uint4*)(ot + row * 128 + seg * 32), o1 = *(const uint4*)(ot + row * 128 + seg * 32 + 16);
      unsigned char* dst = (unsigned char*)PP->ypool + (size_t)(r0 + row) * (LDK5 * 2) + g * 128 + seg * 32;
      *(uint4*)dst = o0;
      *(uint4*)(dst + 16) = o1;
    }
  }
}

__device__ __forceinline__ void phase_merge(int layer, char* smem) {
  const KP PP = get_params();
  const char* Bd = (const char*)(PP->WdT + (size_t)layer * 1024 * LDK5);
  const char* Bp = (const char*)(PP->WpT + (size_t)layer * 1024 * LDK5);
  const char* Ad = (const char*)PP->ydn;
  const char* Ap = (const char*)PP->ypool;
  const int tid = TID();
  const int l = tid & 63, w = tid >> 6, wm = w >> 1, wn = w & 1, lr = l & 15, lg = l >> 4;
  uint4 ga[4], gb[4];
#pragma unroll
  for (int i = 0; i < 4; ++i) { ga[i] = make_uint4(0u, 0u, 0u, 0u); gb[i] = ga[i]; }
  const int r0 = tid >> 3, c0 = tid & 7;
#define MG_GLOAD(AP, BP, KT_)                                                                  \
  _Pragma("unroll") for (int i = 0; i < 4; ++i) {                                              \
    ga[i] = *(const uint4*)((AP) + (size_t)(m0 + 32 * i + r0) * (LDK5 * 2) + c0 * 16 + (KT_) * 128);  \
    gb[i] = *(const uint4*)((BP) + (size_t)(n0 + 32 * i + r0) * LDK5 + c0 * 16 + (KT_) * 128);        \
  }
#define MG_LSTORE(BUF)                                                                         \
  {                                                                                            \
    char* as_ = smem + (BUF) * 32768;                                                          \
    char* bs_ = as_ + 16384;                                                                   \
    _Pragma("unroll") for (int i = 0; i < 4; ++i) {                                            \
      const int id = tid + 256 * i, row = id >> 3, c = id & 7;                                 \
      const int off = row * 128 + ((c ^ (row & 7)) << 4);                                      \
      *(uint4*)(as_ + off) = ga[i];                                                            \
      *(uint4*)(bs_ + off) = gb[i];                                                            \
    }                                                                                          \
  }
#define MG_COMPUTE(ACC, BUF)                                                                                              \
  {                                                                                                                       \
    const char* as_ = smem + (BUF) * 32768;                                                                               \
    const char* bs_ = as_ + 16384;                                                                                        \
    i32x8 a[4], b[4];                                                                                                     \
    const int sw0 = ((lg ^ (lr & 7)) << 4), sw1 = (((4 + lg) ^ (lr & 7)) << 4);                                           \
    _Pragma("unroll") for (int mi = 0; mi < 4; ++mi) {                                                                    \
      const char* p_ = as_ + (wm * 64 + mi * 16 + lr) * 128;                                                              \
      const i32x4 lo_ = *(const i32x4*)(p_ + sw0), hi_ = *(const i32x4*)(p_ + sw1);                                       \
      a[mi] = __builtin_shufflevector(lo_, hi_, 0, 1, 2, 3, 4, 5, 6, 7);                                                  \
    }                                                                                                                     \
    _Pragma("unroll") for (int ni = 0; ni < 4; ++ni) {                                                                    \
      const char* p_ = bs_ + (wn * 64 + ni * 16 + lr) * 128;                                                              \
      const i32x4 lo_ = *(const i32x4*)(p_ + sw0), hi_ = *(const i32x4*)(p_ + sw1);                                       \
      b[ni] = __builtin_shufflevector(lo_, hi_, 0, 1, 2, 3, 4, 5, 6, 7);                                                  \
    }                                                                                                                     \
    _Pragma("unroll") for (int mi = 0; mi < 4; ++mi)                                                                      \
      _Pragma("unroll") for (int ni = 0; ni < 4; ++ni)                                                                    \
        ACC[mi][ni] = __builtin_amdgcn_mfma_scale_f32_16x16x128_f8f6f4(a[mi], b[ni], ACC[mi][ni], 0, 0, 0, 0, 0, 0);      \
  }
  const int MT = (layer == DEPTH - 1) ? NLAT / 128 : R / 128;
  for (int it = 0;; ++it) {
    int mt, nt;
    if (!tile_map(it, MT, 8, mt, nt)) break;
    const int m0 = mt * 128, n0 = nt * 128;
    f32x4 acc[4][4];
    zero_acc(acc);
    __syncthreads();
    MG_GLOAD(Ad, Bd, 0);
    MG_LSTORE(0);
    __syncthreads();
#pragma unroll
    for (int kt = 0; kt < 4; ++kt) {
      if (kt + 1 < 4) { MG_GLOAD(Ad, Bd, kt + 1); } else { MG_GLOAD(Ap, Bp, 0); }
      MG_COMPUTE(acc, kt & 1);
      MG_LSTORE((kt + 1) & 1);
      __syncthreads();
    }
    uint2 tq[2][8];
#pragma unroll
    for (int hs = 0; hs < 2; ++hs)
#pragma unroll
      for (int j = 0; j < 8; ++j) tq[hs][j] = make_uint2(0u, 0u);
#pragma unroll
    for (int hs = 0; hs < 2; ++hs) {
      float4 v1[8];
      stage_half(acc, hs, smem + 32768, v1);
#pragma unroll
      for (int j = 0; j < 8; ++j) tq[hs][j] = make_uint2(pack_bf16(v1[j].x, v1[j].y), pack_bf16(v1[j].z, v1[j].w));
    }
    __builtin_amdgcn_sched_barrier(0);
    zero_acc(acc);
    __syncthreads();
#pragma unroll
    for (int kt = 0; kt < 4; ++kt) {
      if (kt + 1 < 4) { MG_GLOAD(Ap, Bp, kt + 1); }
      MG_COMPUTE(acc, kt & 1);
      if (kt + 1 < 4) { MG_LSTORE((kt + 1) & 1); }
      __syncthreads();
    }
#pragma unroll
    for (int hs = 0; hs < 2; ++hs) {
      float4 v2[8];
      stage_half(acc, hs, smem, v2);
      const int tid2 = TID();
#pragma unroll
      for (int j = 0; j < 8; ++j) {
        const int idx = tid2 + 256 * j, row = idx >> 5, c4 = idx & 31;
        const size_t gr = (size_t)(m0 + hs * 64 + row);
        const int gc = n0 + c4 * 4;
        const unsigned gd = *(const unsigned*)((const unsigned char*)PP->sgd + gr * 1024 + gc);
        const unsigned gp = *(const unsigned*)((const unsigned char*)PP->sgp + gr * 1024 + gc);
        const uint2 t = tq[hs][j];
        constexpr float GS = 1.f / (255.f * 32.f);
        const float o0 = ((float)(gd & 0xffu) * bf_lo(t.x) + (float)(gp & 0xffu) * v2[j].x) * GS;
        const float o1 = ((float)((gd >> 8) & 0xffu) * bf_hi(t.x) + (float)((gp >> 8) & 0xffu) * v2[j].y) * GS;
        const float o2 = ((float)((gd >> 16) & 0xffu) * bf_lo(t.y) + (float)((gp >> 16) & 0xffu) * v2[j].z) * GS;
        const float o3 = ((float)(gd >> 24) * bf_hi(t.y) + (float)(gp >> 24) * v2[j].w) * GS;
        int pk = __builtin_amdgcn_cvt_pk_fp8_f32(o0, o1, 0, false);
        pk = __builtin_amdgcn_cvt_pk_fp8_f32(o2, o3, pk, true);
        *(int*)((char*)PP->m + gr * (LDK1 * 2) + gc) = pk;
        if ((j & 1) == 1) __builtin_amdgcn_sched_barrier(0);
      }
    }
  }
#undef MG_GLOAD
#undef MG_LSTORE
#undef MG_COMPUTE
}

__device__ __forceinline__ void phase_outproj(int layer, char* smem) {
  const KP PP = get_params();
  const char* Bt = (const char*)(PP->WoT + (size_t)layer * 1024 * LDK1);
  const char* A = (const char*)PP->m;
  F8_LOCALS
  const int MT = (layer == DEPTH - 1) ? NLAT / 128 : R / 128;
  int it = 0, mt, nt;
  if (!tile_map(it, MT, 8, mt, nt)) return;
  int m0 = mt * 128, n0 = nt * 128;
  F8_PROLOGUE(A, LDK1 * 2, Bt, LDK1)
  for (;;) {
    int mtn = 0, ntn = 0;
    const bool hasn = tile_map(it + 1, MT, 8, mtn, ntn);
    const int m0n = mtn * 128, n0n = ntn * 128;
    f32x4 acc[4][4];
    zero_acc(acc);
    F8_KLOOP(A, LDK1 * 2, Bt, LDK1, 8)
#pragma unroll
    for (int mi = 0; mi < 4; ++mi) {
      const int gr = m0 + wm * 64 + mi * 16 + lr;
      const float* modp = PP->mod + (size_t)(layer * 3 + modsel(gr)) * 6144 + 2048;
      const float* xin;
      float* xo;
      if (gr < NLAT) {
        xin = (layer == 0 ? PP->x : PP->out) + (size_t)gr * 1024;
        xo = PP->out + (size_t)gr * 1024;
      } else {
        xin = (layer == 0 ? PP->ctx : PP->xc) + (size_t)(gr - NLAT) * 1024;
        xo = PP->xc + (size_t)(gr - NLAT) * 1024;
      }
#pragma unroll
      for (int g = 0; g < 2; ++g) {
        const int gc = n0 + wn * 64 + g * 32 + 8 * lg;
#pragma unroll
        for (int n = 0; n < 2; ++n) {
          const f32x4 t = acc[mi][2 * g + n] * (1.f / 32.f);
          const float4 gt = *(const float4*)(modp + gc + 4 * n);
          const float4 xi = *(const float4*)(xin + gc + 4 * n);
          *(float4*)(xo + gc + 4 * n) = make_float4(xi.x + gt.x * t[0], xi.y + gt.y * t[1], xi.z + gt.z * t[2], xi.w + gt.w * t[3]);
        }
      }
    }
    if (!hasn) break;
    m0 = m0n; n0 = n0n; ++it;
  }
}

DEV void gemm_mainloop_f8(const char* __restrict__ A, int lda, const char* __restrict__ B, int ldb, int KT, int m0, int n0,
                          char* smem, f32x4 (&acc)[4][4]) {
  const int tid = TID();
  const int l = tid & 63, w = tid >> 6, wm = w >> 1, wn = w & 1, lr = l & 15, lg = l >> 4;
  uint4 ga0[4], gb0[4], ga1[4], gb1[4];
#pragma unroll
  for (int i = 0; i < 4; ++i) { ga0[i] = make_uint4(0u, 0u, 0u, 0u); gb0[i] = ga0[i]; ga1[i] = ga0[i]; gb1[i] = ga0[i]; }
  const int r0 = tid >> 3, c0 = tid & 7;
#define Q8_GLOAD(GA, GB, KT_)                                                                  \
  _Pragma("unroll") for (int i = 0; i < 4; ++i) {                                              \
    GA[i] = *(const uint4*)(A + (size_t)(m0 + 32 * i + r0) * lda + c0 * 16 + (KT_) * 128);     \
    GB[i] = *(const uint4*)(B + (size_t)(n0 + 32 * i + r0) * ldb + c0 * 16 + (KT_) * 128);     \
  }
#define Q8_LSTORE(GA, GB, BUF)                                                                 \
  {                                                                                            \
    char* as_ = smem + (BUF) * 32768;                                                          \
    char* bs_ = as_ + 16384;                                                                   \
    _Pragma("unroll") for (int i = 0; i < 4; ++i) {                                            \
      const int id = tid + 256 * i, row = id >> 3, c = id & 7;                                 \
      const int off = row * 128 + ((c ^ (row & 7)) << 4);                                      \
      *(uint4*)(as_ + off) = GA[i];                                                            \
      *(uint4*)(bs_ + off) = GB[i];                                                            \
    }                                                                                          \
  }
#define Q8_COMPUTE(BUF)                                                                                                   \
  {                                                                                                                       \
    const char* as_ = smem + (BUF) * 32768;                                                                               \
    const char* bs_ = as_ + 16384;                                                                                        \
    i32x8 a[4], b[4];                                                                                                     \
    const int sw0 = ((lg ^ (lr & 7)) << 4), sw1 = (((4 + lg) ^ (lr & 7)) << 4);                                           \
    _Pragma("unroll") for (int mi = 0; mi < 4; ++mi) {                                                                    \
      const char* p_ = as_ + (wm * 64 + mi * 16 + lr) * 128;                                                              \
      const i32x4 lo_ = *(const i32x4*)(p_ + sw0), hi_ = *(const i32x4*)(p_ + sw1);                                       \
      a[mi] = __builtin_shufflevector(lo_, hi_, 0, 1, 2, 3, 4, 5, 6, 7);                                                  \
    }                                                                                                                     \
    _Pragma("unroll") for (int ni = 0; ni < 4; ++ni) {                                                                    \
      const char* p_ = bs_ + (wn * 64 + ni * 16 + lr) * 128;                                                              \
      const i32x4 lo_ = *(const i32x4*)(p_ + sw0), hi_ = *(const i32x4*)(p_ + sw1);                                       \
      b[ni] = __builtin_shufflevector(lo_, hi_, 0, 1, 2, 3, 4, 5, 6, 7);                                                  \
    }                                                                                                                     \
    _Pragma("unroll") for (int mi = 0; mi < 4; ++mi)                                                                      \
      _Pragma("unroll") for (int ni = 0; ni < 4; ++ni)                                                                    \
        acc[mi][ni] = __builtin_amdgcn_mfma_scale_f32_16x16x128_f8f6f4(a[mi], b[ni], acc[mi][ni], 0, 0, 0, 0, 0, 0);      \
  }
  __syncthreads();
  Q8_GLOAD(ga0, gb0, 0);
  Q8_GLOAD(ga1, gb1, 1);
  Q8_LSTORE(ga0, gb0, 0);
  __syncthreads();
  for (int kt = 0; kt < KT; kt += 2) {
    if (kt + 2 < KT) { Q8_GLOAD(ga0, gb0, kt + 2); }
    Q8_COMPUTE(0);
    Q8_LSTORE(ga1, gb1, 1);
    __syncthreads();
    if (kt + 3 < KT) { Q8_GLOAD(ga1, gb1, kt + 3); }
    Q8_COMPUTE(1);
    if (kt + 2 < KT) { Q8_LSTORE(ga0, gb0, 0); }
    __syncthreads();
  }
#undef Q8_GLOAD
#undef Q8_LSTORE
#undef Q8_COMPUTE
}

__device__ __forceinline__ void phase_peerq(int layer, char* smem) {
  const KP PP = get_params();
  const char* Bt = (const char*)PP->WkT + (size_t)layer * 2048 * LDK1;
  const int tid = TID();
  const int l = tid & 63, w = tid >> 6, wm = w >> 1, wn = w & 1, lr = l & 15, lg = l >> 4;
  const int MT = (layer == DEPTH - 1) ? NLAT / 128 : R / 128;
  for (int it = 0;; ++it) {
    int mt, nt;
    if (!tile_map(it, MT, 16, mt, nt)) break;
    const int m0 = mt * 128, n0 = nt * 128;
    f32x4 sc[4][4];
    zero_acc(sc);
    gemm_mainloop_f8((const char*)PP->h8, LDK1, Bt, LDK1, 8, m0, n0, smem, sc);
    __syncthreads();
    float* Sc = (float*)smem;
#pragma unroll
    for (int mi = 0; mi < 4; ++mi)
#pragma unroll
      for (int ni = 0; ni < 4; ++ni)
#pragma unroll
        for (int r = 0; r < 4; ++r) Sc[(wm * 64 + mi * 16 + lg * 4 + r) * 129 + wn * 64 + ni * 16 + lr] = sc[mi][ni][r] * (1.f / 32.f);
    __syncthreads();
    {
      const int row = tid >> 1, half = tid & 1;
      const float* rowp = Sc + row * 129;
      unsigned key[64];
#pragma unroll
      for (int i = 0; i < 64; ++i) {
        unsigned u = __float_as_uint(rowp[half * 64 + i]);
        u = (u & 0x80000000u) ? ~u : (u | 0x80000000u);
        key[i] = (u & ~127u) | (unsigned)(127 - (half * 64 + i));
      }
#define CMPX(X, Y, DESC) { const unsigned hi_ = (X) > (Y) ? (X) : (Y), lo_ = (X) > (Y) ? (Y) : (X); X = (DESC) ? hi_ : lo_; Y = (DESC) ? lo_ : hi_; }
#pragma unroll
      for (int g0 = 0; g0 < 64; g0 += 16) {
#pragma unroll
        for (int k = 2; k <= 16; k <<= 1)
#pragma unroll
          for (int j = k >> 1; j > 0; j >>= 1)
#pragma unroll
            for (int i = 0; i < 16; ++i) {
              const int l2 = i ^ j;
              if (l2 > i) CMPX(key[g0 + i], key[g0 + l2], ((i & k) == 0));
            }
      }
#define TOPMERGE(AOFF, BOFF)                                                                         \
  {                                                                                                  \
    _Pragma("unroll") for (int i = 0; i < 16; ++i)                                                   \
      key[(AOFF) + i] = key[(AOFF) + i] > key[(BOFF) + 15 - i] ? key[(AOFF) + i] : key[(BOFF) + 15 - i]; \
    _Pragma("unroll") for (int j = 8; j > 0; j >>= 1)                                                \
      _Pragma("unroll") for (int i = 0; i < 16; ++i) {                                               \
        const int l2 = i ^ j;                                                                        \
        if (l2 > i) CMPX(key[(AOFF) + i], key[(AOFF) + l2], true);                                   \
      }                                                                                              \
  }
      TOPMERGE(0, 16);
      TOPMERGE(32, 48);
      TOPMERGE(0, 32);
      {
        unsigned oth[16];
#pragma unroll
        for (int i = 0; i < 16; ++i) oth[i] = swz_xor_u<1>(key[i]);
#pragma unroll
        for (int i = 0; i < 16; ++i) key[i] = key[i] > oth[15 - i] ? key[i] : oth[15 - i];
#pragma unroll
        for (int j = 8; j > 0; j >>= 1)
#pragma unroll
          for (int i = 0; i < 16; ++i) {
            const int l2 = i ^ j;
            if (l2 > i) CMPX(key[i], key[l2], true);
          }
      }
#undef TOPMERGE
#undef CMPX
      unsigned res[16];
#pragma unroll
      for (int j = 0; j < 16; ++j) {
        const int idx = 127 - (int)(key[j] & 127u);
        res[j] = half ? (unsigned)idx : __float_as_uint(rowp[idx]);
      }
      const size_t ob = ((size_t)(m0 + row) * 16 + nt) * 16;
      uint4* dst = half ? (uint4*)(PP->topI + ob) : (uint4*)(PP->topS + ob);
      dst[0] = make_uint4(res[0], res[1], res[2], res[3]);
      dst[1] = make_uint4(res[4], res[5], res[6], res[7]);
      dst[2] = make_uint4(res[8], res[9], res[10], res[11]);
      dst[3] = make_uint4(res[12], res[13], res[14], res[15]);
    }
  }
}

DEV void pair_of_lane(int l, int& a, int& b) {
  if (l < 16) { a = 0; b = l; }
  else if (l < 24) { a = 1; b = l - 16; }
  else if (l < 29) { a = 2; b = l - 24; }
  else if (l < 33) { a = 3; b = l - 29; }
  else if (l < 36) { a = 4; b = l - 33; }
  else if (l < 38) { a = 5; b = l - 36; }
  else if (l < 40) { a = 6; b = l - 38; }
  else if (l < 42) { a = 7; b = l - 40; }
  else if (l < 50) { a = l - 34; b = 0; }
  else { a = 0; b = 0; }
}

DEV float peer_butterfly(const float (&part)[8], int lane) {
  const bool h32 = (lane & 32) != 0, h16 = (lane & 16) != 0, h8 = (lane & 8) != 0;
  const int a32 = (lane ^ 32) << 2;
  float q4[4], q2[2];
#pragma unroll
  for (int i = 0; i < 4; ++i) {
    const float keep = h32 ? part[i + 4] : part[i], send = h32 ? part[i] : part[i + 4];
    q4[i] = keep + __builtin_bit_cast(float, __builtin_amdgcn_ds_bpermute(a32, __builtin_bit_cast(int, send)));
  }
#pragma unroll
  for (int i = 0; i < 2; ++i) {
    const float keep = h16 ? q4[i + 2] : q4[i], send = h16 ? q4[i] : q4[i + 2];
    q2[i] = keep + swz_xor<16>(send);
  }
  const float keep = h8 ? q2[1] : q2[0], send = h8 ? q2[0] : q2[1];
  float q1 = keep + swz_xor<8>(send);
  q1 += swz_xor<4>(q1);
  q1 += swz_xor<2>(q1);
  q1 += swz_xor<1>(q1);
  return q1;
}

__device__ __forceinline__ void phase_peer(int layer, char* smem) {
  const KP PP = get_params();
  const int tid = TID(), lane = tid & 63, wv = tid >> 6;
  const int gw = BID() * 4 + wv, nw = gridDim.x * 4;
  int* elist = (int*)(smem + wv * 2048);
  float* glist = (float*)(elist + 128);
  const bool last = (layer == DEPTH - 1);
  const int rlim = last ? NLAT : R;
  int pa, pb;
  pair_of_lane(lane, pa, pb);
  for (int r = gw; r < rlim; r += nw) {
    f32x2 hp[8];
#pragma unroll
    for (int i = 0; i < 4; ++i) {
      const uint2 hv = *(const uint2*)(PP->h + (size_t)r * LDK1 + 4 * lane + 256 * i);
      hp[2 * i] = (f32x2){bf_lo(hv.x), bf_hi(hv.x)};
      hp[2 * i + 1] = (f32x2){bf_lo(hv.y), bf_hi(hv.y)};
    }
#ifndef PEER_REP
#define PEER_REP 1
#endif
    f32x2 out[8];
#pragma unroll
    for (int i = 0; i < 8; ++i) out[i] = (f32x2){0.f, 0.f};
#pragma nounroll
    for (int rep_ = 0; rep_ < PEER_REP; ++rep_) {
    float sreg[8];
    int ireg[8];
#pragma unroll
    for (int hh = 0; hh < 8; ++hh) {
      const size_t o = (size_t)r * 256 + hh * 32 + (lane & 31);
      sreg[hh] = PP->topS[o];
      ireg[hh] = PP->topI[o];
    }
#pragma unroll 2
    for (int hh = 0; hh < 8; ++hh) {
      float cs = __builtin_bit_cast(float, __builtin_amdgcn_ds_bpermute(pa << 2, __builtin_bit_cast(int, sreg[hh]))) +
                 __builtin_bit_cast(float, __builtin_amdgcn_ds_bpermute((16 + pb) << 2, __builtin_bit_cast(int, sreg[hh])));
      const int e = __builtin_amdgcn_ds_bpermute(pa << 2, ireg[hh]) * 128 + __builtin_amdgcn_ds_bpermute((16 + pb) << 2, ireg[hh]);
      if (lane >= 50) cs = -__builtin_inff();
      unsigned ku = __float_as_uint(cs);
      ku = (ku & 0x80000000u) ? ~ku : (ku | 0x80000000u);
      ku = (ku & ~63u) | (unsigned)(63 - lane);
      int rank = 0;
#pragma unroll
      for (int l2 = 0; l2 < 50; ++l2) {
        const unsigned kv = (unsigned)__builtin_amdgcn_readlane((int)ku, l2);
        rank += (kv > ku) ? 1 : 0;
      }
      const bool sel = (lane < 50) && (rank < 16);
      const float mx = __builtin_bit_cast(float, __builtin_amdgcn_readlane(__builtin_bit_cast(int, cs), 0));
      const float ex = sel ? __expf(cs - mx) : 0.f;
      const float sum = wave_sum(ex);
      const unsigned long long mask = __ballot(sel);
      if (sel) {
        const int pos = __builtin_popcountll(mask & ((1ull << lane) - 1ull));
        elist[hh * 16 + pos] = e;
        glist[hh * 16 + pos] = ex / sum;
      }
    }
    __builtin_amdgcn_wave_barrier();
    asm volatile("s_waitcnt lgkmcnt(0)" ::: "memory");
    for (int k0 = 0; k0 < 128; k0 += 8) {
      U3 ua[8], va[8];
#pragma unroll
      for (int b = 0; b < 8; ++b) {
        const int ek = __builtin_amdgcn_readfirstlane(elist[k0 + b]);
        ua[b] = *(const U3*)(PP->tab8U + (size_t)ek * TROW + lane * 12);
        va[b] = *(const U3*)(PP->tab8V + (size_t)ek * TROW + lane * 12);
      }
      const int eb = elist[k0 + (lane >> 3)];
      const float scu = PP->scU[eb], scv = PP->scV[eb];
      float part[8];
#pragma unroll
      for (int b = 0; b < 8; b += 2) {
        const u32x6_t s6 = {ua[b].a, ua[b].b, ua[b].c, ua[b + 1].a, ua[b + 1].b, ua[b + 1].c};
        const f32x32_t uf = __builtin_amdgcn_cvt_scalef32_pk32_f32_fp6(s6, 1.0f);
        f32x2 d0 = (f32x2){uf[0], uf[1]} * hp[0];
        f32x2 d1 = (f32x2){uf[16], uf[17]} * hp[0];
#pragma unroll
        for (int p = 1; p < 8; ++p) {
          d0 += (f32x2){uf[2 * p], uf[2 * p + 1]} * hp[p];
          d1 += (f32x2){uf[16 + 2 * p], uf[17 + 2 * p]} * hp[p];
        }
        part[b] = d0[0] + d0[1];
        part[b + 1] = d1[0] + d1[1];
      }
      float q1 = peer_butterfly(part, lane);
      q1 *= scu;
      const float act = scv * glist[k0 + (lane >> 3)] * 0.5f * q1 * (1.f + erff(q1 * 0.7071067811865475f));
#pragma unroll
      for (int b = 0; b < 8; b += 2) {
        const float ab0 = __builtin_bit_cast(float, __builtin_amdgcn_readlane(__builtin_bit_cast(int, act), b * 8));
        const float ab1 = __builtin_bit_cast(float, __builtin_amdgcn_readlane(__builtin_bit_cast(int, act), b * 8 + 8));
        const f32x2 a0 = {ab0, ab0}, a1 = {ab1, ab1};
        const u32x6_t s6 = {va[b].a, va[b].b, va[b].c, va[b + 1].a, va[b + 1].b, va[b + 1].c};
        const f32x32_t vf = __builtin_amdgcn_cvt_scalef32_pk32_f32_fp6(s6, 1.0f);
#pragma unroll
        for (int p = 0; p < 8; ++p) {
          out[p] += a0 * (f32x2){vf[2 * p], vf[2 * p + 1]};
          out[p] += a1 * (f32x2){vf[16 + 2 * p], vf[17 + 2 * p]};
        }
      }
    }
    __builtin_amdgcn_wave_barrier();
    }
    if (PEER_REP > 1) {
#pragma unroll
      for (int i = 0; i < 8; ++i) out[i] *= (1.f / PEER_REP);
    }
    const float* md = PP->mod + (size_t)(layer * 3 + modsel(r)) * 6144 + 5 * 1024;
    float* xr = (r < NLAT) ? PP->out + (size_t)r * 1024 : PP->xc + (size_t)(r - NLAT) * 1024;
    float4 x2[4];
    float ss = 0.f;
#pragma unroll
    for (int i = 0; i < 4; ++i) {
      const int col = 4 * lane + 256 * i;
      const float4 xa = *(const float4*)(xr + col);
      const float4 ga = *(const float4*)(md + col);
      x2[i] = make_float4(xa.x + ga.x * out[2 * i][0], xa.y + ga.y * out[2 * i][1], xa.z + ga.z * out[2 * i + 1][0],
                          xa.w + ga.w * out[2 * i + 1][1]);
      ss += x2[i].x * x2[i].x + x2[i].y * x2[i].y + x2[i].z * x2[i].z + x2[i].w * x2[i].w;
    }
    if (last) {
      ss = wave_sum(ss);
      const float rs = rsqrtf(ss * (1.f / 1024.f) + EPS);
#pragma unroll
      for (int i = 0; i < 4; ++i) {
        const float4 fa = *(const float4*)(PP->final_norm + 4 * lane + 256 * i);
        x2[i] = make_float4(x2[i].x * rs * fa.x, x2[i].y * rs * fa.y, x2[i].z * rs * fa.z, x2[i].w * rs * fa.w);
      }
    }
#pragma unroll
    for (int i = 0; i < 4; ++i) *(float4*)(xr + 4 * lane + 256 * i) = x2[i];
    if (!last) {
      ss = wave_sum(ss);
      const float rs = rsqrtf(ss * (1.f / 1024.f) + EPS);
      const float* nwt = PP->norm_mix + (layer + 1) * 1024;
      const float* md1 = PP->mod + (size_t)((layer + 1) * 3 + modsel(r)) * 6144;
#pragma unroll
      for (int i = 0; i < 4; ++i) {
        const int col = 4 * lane + 256 * i;
        const float4 wv = *(const float4*)(nwt + col);
        const float4 sh = *(const float4*)(md1 + col);
        const float4 sc = *(const float4*)(md1 + 1024 + col);
        const float y0 = x2[i].x * rs * wv.x * (1.f + sc.x) + sh.x;
        const float y1 = x2[i].y * rs * wv.y * (1.f + sc.y) + sh.y;
        const float y2 = x2[i].z * rs * wv.z * (1.f + sc.z) + sh.z;
        const float y3 = x2[i].w * rs * wv.w * (1.f + sc.w) + sh.w;
        int pk = __builtin_amdgcn_cvt_pk_fp8_f32(y0, y1, 0, false);
        pk = __builtin_amdgcn_cvt_pk_fp8_f32(y2, y3, pk, true);
        *(int*)((char*)PP->h + (size_t)r * (LDK1 * 2) + col) = pk;
      }
    }
  }
}

namespace cg = cooperative_groups;

#define XB_TMO      128
#define XB_XCNT(j)  (256  + 64 * (j))
#define XB_XSUB(j)  (1280 + 64 * (j))
#define XB_XGEN(j)  (2304 + 64 * (j))
#define XB_TOP      3328
#define XB_TOPGEN   3392
#define XCD_BAR_WORDS 3456
#define XB_SPIN_CAP (1u << 22)
#define LAS __attribute__((address_space(3)))
DEV unsigned xb_ld(unsigned* q) { return __hip_atomic_load(q, __ATOMIC_RELAXED, __HIP_MEMORY_SCOPE_AGENT); }
DEV unsigned xb_add(unsigned* q, unsigned v) { return __hip_atomic_fetch_add(q, v, __ATOMIC_RELAXED, __HIP_MEMORY_SCOPE_AGENT); }
DEV unsigned xb_xcc_id() { return (unsigned)__builtin_amdgcn_s_getreg((3 << 11) | 20) & 0xFu; }
#define XB_SPIN(cond, bar) do { unsigned _sp = 0; while (cond) { __builtin_amdgcn_s_sleep(1); \
    if ((++_sp & 255u) == 0u) { if (xb_ld(&(bar)[XB_TMO])) break; if (_sp > XB_SPIN_CAP) { atomicAdd(&(bar)[XB_TMO], 1u); break; } } } } while (0)
struct XcdBarrier { unsigned* bar; unsigned x; volatile LAS unsigned* st; };
DEV XcdBarrier xcd_barrier_post(unsigned* bar, volatile LAS unsigned* st) {
  XcdBarrier b; b.bar = bar; b.x = xb_xcc_id(); b.st = st;
  if (__builtin_amdgcn_workitem_id_x() == 0) (void)xb_add(&bar[XB_XCNT(b.x)], 1u);
  return b;
}
DEV void xcd_barrier_complete(unsigned* bar, unsigned x, unsigned& nloc, unsigned& nx) {
  const unsigned G = gridDim.x * gridDim.y * gridDim.z;
  unsigned sum, cnt, mine, sp = 0u;
  for (;;) {
    sum = 0u; cnt = 0u; mine = 0u;
#pragma unroll
    for (unsigned j = 0; j < 16; ++j) { const unsigned c = xb_ld(&bar[XB_XCNT(j)]); sum += c; cnt += (c > 0u) ? 1u : 0u; mine = (j == x) ? c : mine; }
    if (sum == G) break;
    __builtin_amdgcn_s_sleep(1);
    if ((++sp & 255u) == 0u) { if (xb_ld(&bar[XB_TMO])) break; if (sp > XB_SPIN_CAP) { atomicAdd(&bar[XB_TMO], 1u); break; } }
  }
  nloc = mine > 0u ? mine : 1u; nx = cnt > 0u ? cnt : 1u;
}
DEV void xcd_barrier(const XcdBarrier& b) {
  asm volatile("s_waitcnt vmcnt(0)" ::: "memory");
  __syncthreads();
  if (__builtin_amdgcn_workitem_id_x() == 0) {
    unsigned* bar = b.bar;
    __builtin_amdgcn_s_waitcnt(0);
    unsigned nloc = b.st[0], nx = b.st[1];
    if (nloc == 0u) { xcd_barrier_complete(bar, b.x, nloc, nx); b.st[0] = nloc; b.st[1] = nx; }
    const unsigned old = xb_add(&bar[XB_XSUB(b.x)], 1u);
    const unsigned gen = old / nloc;
    if (old + 1u == (gen + 1u) * nloc) {
      __builtin_amdgcn_fence(__ATOMIC_RELEASE, "agent");
      asm volatile("s_waitcnt vmcnt(0)" ::: "memory");
      const unsigned og = xb_add(&bar[XB_TOP], 1u);
      const unsigned tg = og / nx;
      if (og + 1u == (tg + 1u) * nx) xb_add(&bar[XB_TOPGEN], 1u);
      else XB_SPIN(xb_ld(&bar[XB_TOPGEN]) == tg, bar);
      __builtin_amdgcn_fence(__ATOMIC_ACQUIRE, "agent");
      xb_add(&bar[XB_XGEN(b.x)], 1u);
      asm volatile("s_waitcnt vmcnt(0)" ::: "memory");
    } else {
      XB_SPIN(xb_ld(&bar[XB_XGEN(b.x)]) == gen, bar);
      __builtin_amdgcn_fence(__ATOMIC_ACQUIRE, "agent");
      asm volatile("s_waitcnt vmcnt(0)" ::: "memory");
    }
  }
  __syncthreads();
}

#define GRID_SYNC() do { XcdBarrier xb_; xb_.bar = get_params()->bar; xb_.x = xb_xcc_id(); xb_.st = (volatile LAS unsigned*)&xb_words; xcd_barrier(xb_); } while (0)

__global__ void __launch_bounds__(NTHR, 2) megakernel(Params p) {
  __shared__ __attribute__((aligned(16))) char smem[SMEM_BYTES];
  __shared__ uint4 xb_words;
  if (__builtin_amdgcn_workitem_id_x() == 0) xb_words = make_uint4(0u, 0u, 0u, 0u);
  __syncthreads();
  (void)xcd_barrier_post(get_params()->bar, (volatile LAS unsigned*)&xb_words);
#ifndef PM
#define PM 0xFFFF
#endif
#ifndef DUP
#define DUP 0
#endif
  if (PM & 1) phase_init(smem);
  if (DUP & 1) phase_init(smem);
  GRID_SYNC();
  for (int layer = 0; layer < DEPTH; ++layer) {
    if (layer == 0) {
      if (PM & 2) phase_norm(layer, 1);
      if (DUP & 2) phase_norm(layer, 1);
      GRID_SYNC();
    }
    if (PM & 4) phase_gemm_win(layer, smem);
    if (DUP & 4) phase_gemm_win(layer, smem);
    GRID_SYNC();
#ifndef PREP_REP
#define PREP_REP 1
#endif
#pragma nounroll
    for (int rep_ = 0; rep_ < PREP_REP; ++rep_) phase_prep(layer, smem);
    GRID_SYNC();
    {
      const int nb_ = gridDim.x;
      if (BID() < 128) { if (PM & 64) phase_scan(smem); }
      else {
        if (PM & 16) phase_pool(layer, smem, BID() - 128, nb_ - 128);
        if (PM & 256) phase_tables(layer, BID() - 128, nb_ - 128);
      }
    }
    GRID_SYNC();
    if (PM & 128) phase_o(layer, smem);
    if (DUP & 128) phase_o(layer, smem);
    GRID_SYNC();
    if (PM & 512) phase_merge(layer, smem);
    if (DUP & 512) phase_merge(layer, smem);
    GRID_SYNC();
    if (PM & 1024) phase_outproj(layer, smem);
    GRID_SYNC();
    if (PM & 2048) phase_norm(layer, 2);
    if (DUP & 2048) phase_norm(layer, 2);
    GRID_SYNC();
    if (PM & 4096) phase_peerq(layer, smem);
    if (DUP & 4096) phase_peerq(layer, smem);
    GRID_SYNC();
    if (PM & 8192) phase_peer(layer, smem);
    if (layer + 1 < DEPTH) GRID_SYNC();
  }
}

static inline size_t align_up(size_t v, size_t a) { return (v + a - 1) / a * a; }

extern "C" void kernel_launch(void* const* d_in, const int* in_sizes, int n_in, void* d_out, int out_size, void* d_ws,
                              size_t ws_size, hipStream_t stream) {
  Params p{};
  p.x = (const float*)d_in[0]; p.c = (const float*)d_in[1]; p.ctx = (const float*)d_in[2]; p.c_ctx = (const float*)d_in[3];
  p.w_mod = (const float*)d_in[4]; p.b_mod = (const float*)d_in[5]; p.norm_mix = (const float*)d_in[6]; p.w_in = (const float*)d_in[7];
  p.conv_w = (const float*)d_in[8]; p.a_log = (const float*)d_in[9]; p.dt_bias = (const float*)d_in[10];
  p.dn_out_norm = (const float*)d_in[11]; p.pool_w = (const float*)d_in[12]; p.pool_scale = (const float*)d_in[13];
  p.w_up_dn = (const float*)d_in[14]; p.w_up_pool = (const float*)d_in[15]; p.w_out = (const float*)d_in[16];
  p.norm_ffn = (const float*)d_in[17]; p.peer_wq = (const float*)d_in[18]; p.peer_keys = (const float*)d_in[19];
  p.peer_u = (const float*)d_in[20]; p.peer_v = (const float*)d_in[21]; p.final_norm = (const float*)d_in[22];
  p.out = (float*)d_out;

  char* ws = (char*)d_ws;
  size_t off = 0;
  auto take = [&](size_t bytes) { char* q = ws + off; off = align_up(off + bytes, 256); return q; };
  p.tab8U = (unsigned char*)take((size_t)NEXP * 1024);
  p.tab8V = (unsigned char*)take((size_t)NEXP * 1024);
  p.scU = (float*)take((size_t)NEXP * 4);
  p.scV = (float*)take((size_t)NEXP * 4);
  p.WinT = (u16*)take((size_t)DEPTH * NPAD * LDK1 * 2);
  p.WdT = (u16*)take((size_t)DEPTH * 1024 * LDK5 * 2);
  p.WpT = (u16*)take((size_t)DEPTH * 1024 * LDK5 * 2);
  p.WoT = (u16*)take((size_t)DEPTH * 1024 * LDK1 * 2);
  p.WkT = (u16*)take((size_t)DEPTH * 2048 * LDK1 * 2);
  p.PwT = (u16*)take((size_t)DEPTH * 4 * 128 * 128 * 2);
  p.mod = (float*)take((size_t)DEPTH * 3 * 6144 * 4);
  p.xc = (float*)take((size_t)NCTX * 1024 * 4);
  p.h = (u16*)take((size_t)R * LDK1 * 2);
  p.h8 = (unsigned char*)take((size_t)R * LDK1);
  p.m = p.h;
  p.qkv_pre = (u16*)take((size_t)R * 1536 * 2);
  p.Vfrag = p.qkv_pre;
  p.z = (u16*)take((size_t)R * 512 * 2);
  p.pin = (u16*)take((size_t)R * 512 * 2);
  p.sgd = (u16*)take((size_t)R * 1024 * 2);
  p.sgp = (u16*)take((size_t)R * 1024 * 2);
  p.ba = (float*)take((size_t)R * 16 * 4);
  p.qkvn = (u16*)take((size_t)R * 1536 * 2);
  p.bg = (float*)take((size_t)R * 16 * 4);
  p.Wfrag = (u16*)take((size_t)NUNIT * 16384);
  p.KdT = (u16*)take((size_t)NUNIT * 16384);
  p.Ufrag = (u16*)take((size_t)NUNIT * 16384);
  p.ydn = p.Ufrag;
  p.Sfrag = (u16*)take((size_t)NUNIT * 32768);
  p.gc = (float*)take((size_t)NUNIT * 64 * 4);
  p.glast = (float*)take((size_t)NUNIT * 4);
  p.ypool = (u16*)take((size_t)R * LDK5 * 2);
  p.bar = (unsigned*)take((size_t)XCD_BAR_WORDS * 4);
  p.topS = (float*)p.qkvn;
  p.topI = (int*)((char*)p.qkvn + (size_t)R * 256 * 4);
  const bool alias_ok = ((size_t)R * 256 * 8 <= (size_t)R * 1536 * 2) && ((size_t)NUNIT * 16384 <= (size_t)R * 1536 * 2) &&
                        ((size_t)R * LDK5 * 2 <= (size_t)NUNIT * 16384);
  if (off > ws_size || !alias_ok) {
    fprintf(stderr, "workspace too small: need %zu have %zu (alias_ok=%d)\n", off, ws_size, (int)alias_ok);
    return;
  }
  static int grid_blocks = 0;
  if (!grid_blocks) {
    int dev = 0, cus = 0, per_cu = 0;
    (void)hipGetDevice(&dev);
    (void)hipDeviceGetAttribute(&cus, hipDeviceAttributeMultiprocessorCount, dev);
    (void)hipOccupancyMaxActiveBlocksPerMultiprocessor(&per_cu, megakernel, NTHR, 0);
    if (per_cu > 2) per_cu = 2;
    if (per_cu < 1) per_cu = 1;
    grid_blocks = cus * per_cu;
    grid_blocks -= grid_blocks % 8;
  }
  if (grid_blocks < 8) { fprintf(stderr, "bad grid %d\n", grid_blocks); return; }
  (void)hipMemsetAsync(p.bar, 0, (size_t)XCD_BAR_WORDS * 4, stream);
  void* args[] = {&p};
  hipError_t e = hipLaunchCooperativeKernel((void*)megakernel, dim3(grid_blocks), dim3(NTHR), args, 0, stream);
  if (e != hipSuccess) fprintf(stderr, "cooperative launch failed: %s (grid %d)\n", hipGetErrorString(e), grid_blocks);
}
```

```cpp
#include <hip/hip_runtime.h>
#include <hip/hip_cooperative_groups.h>
#include <stdint.h>
#include <stdio.h>

typedef unsigned short u16;
typedef __attribute__((ext_vector_type(8))) short bf16x8;
typedef __attribute__((ext_vector_type(4))) float f32x4;
typedef __attribute__((ext_vector_type(2))) float f32x2;
typedef __attribute__((ext_vector_type(2))) __bf16 bf16x2_t;

#define DEV __device__ __forceinline__

constexpr int D = 1024;
constexpr int BATCH = 2;
constexpr int SEQ = 8192;
constexpr int DEPTH = 2;
constexpr int CTX = 256;
constexpr int NLAT = BATCH * SEQ;
constexpr int NCTX = BATCH * CTX;
constexpr int R = NLAT + NCTX;
constexpr int DNH = 4;
constexpr int DK = 128;
constexpr int DNW = 512;
constexpr int INC = 4624;
constexpr int NPAD = 4736;
constexpr int NEXP = 16384;
constexpr float EPS = 1e-6f;
constexpr int NTHR = 256;
constexpr int LDK1 = 1088;
constexpr int LDK5 = 576;
constexpr int SMEM_BYTES = 73728;

struct Params {
  const float *x, *c, *ctx, *c_ctx, *w_mod, *b_mod, *norm_mix, *w_in, *conv_w, *a_log, *dt_bias, *dn_out_norm,
      *pool_w, *pool_scale, *w_up_dn, *w_up_pool, *w_out, *norm_ffn, *peer_wq, *peer_keys, *peer_u, *peer_v, *final_norm;
  float* out;
  unsigned char *tab8U, *tab8V;
  float *scU, *scV;
  u16 *WinT, *WdT, *WpT, *WoT, *WkT, *PwT;
  float *mod, *xc;
  u16 *h, *qkv_pre, *z, *pin, *sgd, *sgp;
  unsigned char* h8;
  float* ba;
  u16* qkvn;
  float* bg;
  u16 *Wfrag, *KdT, *Ufrag, *Sfrag, *Vfrag;
  float *gc, *glast;
  u16 *ydn, *ypool, *m;
  float* topS;
  int* topI;
  unsigned* bar;
};

typedef const __attribute__((address_space(4))) Params* KP;
DEV KP get_params() {
  KP k = (KP)__builtin_amdgcn_kernarg_segment_ptr();
  asm volatile("" : "+s"(k));
  return k;
}
DEV int TID() { int t = __builtin_amdgcn_workitem_id_x(); asm volatile("" : "+v"(t)); return t; }
DEV int BID() { int t = __builtin_amdgcn_workgroup_id_x(); asm volatile("" : "+s"(t)); return t; }
DEV unsigned pack_bf16(float a, float b) {
  f32x2 v = {a, b};
  bf16x2_t r = __builtin_convertvector(v, bf16x2_t);
  return *(unsigned*)&r;
}
DEV u16 f2bf(float a) { return (u16)(pack_bf16(a, 0.f) & 0xffffu); }
DEV float bf_lo(unsigned u) { return __uint_as_float(u << 16); }
DEV float bf_hi(unsigned u) { return __uint_as_float(u & 0xffff0000u); }
DEV float bf2f(u16 h) { return __uint_as_float(((unsigned)h) << 16); }
DEV void unpack8(const uint4& v, float* f) {
  f[0] = bf_lo(v.x); f[1] = bf_hi(v.x); f[2] = bf_lo(v.y); f[3] = bf_hi(v.y);
  f[4] = bf_lo(v.z); f[5] = bf_hi(v.z); f[6] = bf_lo(v.w); f[7] = bf_hi(v.w);
}
DEV uint4 pack8(const float* f) {
  uint4 v;
  v.x = pack_bf16(f[0], f[1]); v.y = pack_bf16(f[2], f[3]); v.z = pack_bf16(f[4], f[5]); v.w = pack_bf16(f[6], f[7]);
  return v;
}
template <int O> DEV float swz_xor(float v) {
  return __builtin_bit_cast(float, __builtin_amdgcn_ds_swizzle(__builtin_bit_cast(int, v), (O << 10) | 0x1F));
}
template <int O> DEV unsigned swz_xor_u(unsigned v) {
  return (unsigned)__builtin_amdgcn_ds_swizzle((int)v, (O << 10) | 0x1F);
}
DEV float xor32_f(float v) {
  const int a = ((TID() & 63) ^ 32) << 2;
  return __builtin_bit_cast(float, __builtin_amdgcn_ds_bpermute(a, __builtin_bit_cast(int, v)));
}
DEV float wave_sum(float v) {
  v += xor32_f(v);
  v += swz_xor<16>(v); v += swz_xor<8>(v); v += swz_xor<4>(v); v += swz_xor<2>(v); v += swz_xor<1>(v);
  return v;
}
DEV float wave_max(float v) {
  v = fmaxf(v, xor32_f(v));
  v = fmaxf(v, swz_xor<16>(v)); v = fmaxf(v, swz_xor<8>(v)); v = fmaxf(v, swz_xor<4>(v));
  v = fmaxf(v, swz_xor<2>(v)); v = fmaxf(v, swz_xor<1>(v));
  return v;
}
DEV float group16_sum(float v) {
  v += swz_xor<8>(v); v += swz_xor<4>(v); v += swz_xor<2>(v); v += swz_xor<1>(v);
  return v;
}
DEV float sigmoidf_(float x) { return __builtin_amdgcn_rcpf(1.f + __expf(-x)); }
DEV float siluf_(float x) { return x * __builtin_amdgcn_rcpf(1.f + __expf(-x)); }
DEV int modsel(int r) { return r < NLAT ? (r >> 13) : 2; }

DEV void transpose_tile(const float* __restrict__ src, int Nsrc, int ldd, u16* __restrict__ dst, int kt, int nt, int mode,
                        float* tile) {
  const int tid = TID();
  const int cl = tid & 63, rg = tid >> 6;
  const int nd = nt * 64 + cl;
  int ns = nd;
  bool valid = true;
  if (mode & 1) {
    if (nd < 2560) ns = nd;
    else if (nd < 4608) ns = nd + 16;
    else if (nd < 4624) ns = nd - 4608 + 2560;
    else { valid = false; ns = 0; }
  }
#pragma unroll
  for (int i = 0; i < 16; ++i) {
    const int kr = i * 4 + rg;
    float v = valid ? src[(size_t)(kt * 64 + kr) * Nsrc + ns] : 0.f;
    tile[kr * 65 + cl] = v;
  }
  __syncthreads();
  const int nr = tid >> 2, kc = (tid & 3) * 16;
  if (mode & 2) {
    int q4[4];
#pragma unroll
    for (int q = 0; q < 4; ++q) {
      int pk = __builtin_amdgcn_cvt_pk_fp8_f32(32.f * tile[(kc + 4 * q) * 65 + nr], 32.f * tile[(kc + 4 * q + 1) * 65 + nr], 0, false);
      q4[q] = __builtin_amdgcn_cvt_pk_fp8_f32(32.f * tile[(kc + 4 * q + 2) * 65 + nr], 32.f * tile[(kc + 4 * q + 3) * 65 + nr], pk, true);
    }
    *(int4*)((char*)dst + (size_t)(nt * 64 + nr) * ldd + kt * 64 + kc) = make_int4(q4[0], q4[1], q4[2], q4[3]);
    __syncthreads();
    return;
  }
  unsigned w[8];
#pragma unroll
  for (int q = 0; q < 8; ++q) w[q] = pack_bf16(tile[(kc + 2 * q) * 65 + nr], tile[(kc + 2 * q + 1) * 65 + nr]);
  uint4* d = (uint4*)(dst + (size_t)(nt * 64 + nr) * ldd + kt * 64 + kc);
  d[0] = make_uint4(w[0], w[1], w[2], w[3]);
  d[1] = make_uint4(w[4], w[5], w[6], w[7]);
  __syncthreads();
}

__device__ __forceinline__ void phase_init(char* smem) {
  const KP PP = get_params();
  const int tid = TID(), nb = gridDim.x, bid = BID();
  float* fs = (float*)smem;
  for (int u = bid; u < 192; u += nb) {
    const int layer = u / 96, col0 = (u % 96) * 64;
    float* sv = fs;
    float* red = fs + 3072;
    for (int i = tid; i < 3072; i += NTHR) {
      const int v = i >> 10, k = i & 1023;
      const float cv = (v < 2) ? PP->c[v * 1024 + k] : PP->c_ctx[k];
      sv[i] = siluf_(cv);
    }
    __syncthreads();
    const int cq = tid & 15, ks = tid >> 4;
    float acc[3][4];
#pragma unroll
    for (int v = 0; v < 3; ++v)
#pragma unroll
      for (int i = 0; i < 4; ++i) acc[v][i] = 0.f;
    const float* wb = PP->w_mod + ((size_t)layer * 1024 + ks * 64) * 6144 + col0 + cq * 4;
#pragma unroll 8
    for (int kk = 0; kk < 64; ++kk) {
      const float4 w4 = *(const float4*)(wb + (size_t)kk * 6144);
      const int k = ks * 64 + kk;
#pragma unroll
      for (int v = 0; v < 3; ++v) {
        const float s = sv[v * 1024 + k];
        acc[v][0] += s * w4.x; acc[v][1] += s * w4.y; acc[v][2] += s * w4.z; acc[v][3] += s * w4.w;
      }
    }
#pragma unroll
    for (int v = 0; v < 3; ++v)
#pragma unroll
      for (int i = 0; i < 4; ++i) red[(ks * 3 + v) * 64 + cq * 4 + i] = acc[v][i];
    __syncthreads();
    if (tid < 192) {
      const int v = tid >> 6, cc = tid & 63;
      float s = PP->b_mod[layer * 6144 + col0 + cc];
#pragma unroll
      for (int k2 = 0; k2 < 16; ++k2) s += red[(k2 * 3 + v) * 64 + cc];
      PP->mod[(size_t)(layer * 3 + v) * 6144 + col0 + cc] = s;
    }
    __syncthreads();
  }
  constexpr int NTL = 1184 + 128 + 128 + 256 + 16;
  for (int j = bid; j < NTL * DEPTH; j += nb) {
    const int layer = j / NTL;
    int jj = j % NTL;
    if (jj < 1184) {
      transpose_tile(PP->w_in + (size_t)layer * 1024 * INC, INC, LDK1, PP->WinT + (size_t)layer * NPAD * LDK1, jj / 74, jj % 74, 3, fs);
    } else if ((jj -= 1184) < 128) {
      transpose_tile(PP->w_up_dn + (size_t)layer * 512 * 1024, 1024, LDK5, PP->WdT + (size_t)layer * 1024 * LDK5, jj / 16, jj % 16, 2, fs);
    } else if ((jj -= 128) < 128) {
      transpose_tile(PP->w_up_pool + (size_t)layer * 512 * 1024, 1024, LDK5, PP->WpT + (size_t)layer * 1024 * LDK5, jj / 16, jj % 16, 2, fs);
    } else if ((jj -= 128) < 256) {
      transpose_tile(PP->w_out + (size_t)layer * 1024 * 1024, 1024, LDK1, PP->WoT + (size_t)layer * 1024 * LDK1, jj / 16, jj % 16, 2, fs);
    } else {
      jj -= 256;
      const int g = jj >> 2;
      transpose_tile(PP->pool_w + (size_t)(layer * 4 + g) * 128 * 128, 128, 128, PP->PwT + (size_t)(layer * 4 + g) * 128 * 128,
                     (jj & 3) >> 1, jj & 1, 0, fs);
    }
  }
  {
    const int tid2 = TID();
    const int l = tid2 & 63, w = tid2 >> 6, lr = l & 15, lg = l >> 4;
    char* Ks = smem;
    char* Ws = smem + 32768;
    for (int item = bid; item < DEPTH * 256; item += nb) {
      const int layer = item >> 8, hp = (item >> 4) & 15, ct = item & 15;
      __syncthreads();
      const float* ksrc = PP->peer_keys + (size_t)(layer * 16 + hp) * 128 * 128;
      for (int idx = tid2; idx < 128 * 16; idx += NTHR) {
        const int row = idx >> 4, ch = idx & 15;
        const float4 a = *(const float4*)(ksrc + row * 128 + ch * 8);
        const float4 c4 = *(const float4*)(ksrc + row * 128 + ch * 8 + 4);
        *(uint4*)(Ks + row * 256 + ((ch ^ (row & 15)) << 4)) =
            make_uint4(pack_bf16(a.x, a.y), pack_bf16(a.z, a.w), pack_bf16(c4.x, c4.y), pack_bf16(c4.z, c4.w));
      }
      const float* wsrc = PP->peer_wq + (size_t)layer * 1024 * 2048 + (size_t)(ct * 64) * 2048 + hp * 128;
      for (int idx = tid2; idx < 64 * 16; idx += NTHR) {
        const int row = idx >> 4, ch = idx & 15;
        const float4 a = *(const float4*)(wsrc + (size_t)row * 2048 + ch * 8);
        const float4 c4 = *(const float4*)(wsrc + (size_t)row * 2048 + ch * 8 + 4);
        *(uint4*)(Ws + row * 256 + ((ch ^ (row & 15)) << 4)) =
            make_uint4(pack_bf16(a.x, a.y), pack_bf16(a.z, a.w), pack_bf16(c4.x, c4.y), pack_bf16(c4.z, c4.w));
      }
      __syncthreads();
      f32x4 acc[2][4];
#pragma unroll
      for (int mi = 0; mi < 2; ++mi)
#pragma unroll
        for (int ni = 0; ni < 4; ++ni) acc[mi][ni] = (f32x4){0.f, 0.f, 0.f, 0.f};
#pragma unroll
      for (int ks = 0; ks < 4; ++ks) {
        const int ch = ks * 4 + lg;
        bf16x8 a[2], bb[4];
#pragma unroll
        for (int mi = 0; mi < 2; ++mi) a[mi] = *(const bf16x8*)(Ks + ((2 * w + mi) * 16 + lr) * 256 + ((ch ^ lr) << 4));
#pragma unroll
        for (int ni = 0; ni < 4; ++ni) bb[ni] = *(const bf16x8*)(Ws + (ni * 16 + lr) * 256 + ((ch ^ lr) << 4));
#pragma unroll
        for (int mi = 0; mi < 2; ++mi)
#pragma unroll
          for (int ni = 0; ni < 4; ++ni) acc[mi][ni] = __builtin_amdgcn_mfma_f32_16x16x32_bf16(a[mi], bb[ni], acc[mi][ni], 0, 0, 0);
      }
      unsigned char* dst = (unsigned char*)PP->WkT + ((size_t)layer * 2048 + hp * 128) * LDK1 + ct * 64;
#pragma unroll
      for (int mi = 0; mi < 2; ++mi)
#pragma unroll
        for (int ni = 0; ni < 4; ++ni)
#pragma unroll
          for (int r = 0; r < 4; ++r) {
            const float v32 = 32.f * acc[mi][ni][r];
            dst[(size_t)((2 * w + mi) * 16 + 4 * lg + r) * LDK1 + ni * 16 + lr] = (unsigned char)(__builtin_amdgcn_cvt_pk_fp8_f32(v32, v32, 0, false) & 0xff);
          }
    }
  }
}

DEV unsigned enc_e2m3(float x) {
  const float a = fabsf(x);
  float c;
  if (a < 2.f) c = a * 8.f;
  else if (a < 4.f) c = 16.f + (a - 2.f) * 4.f;
  else c = 24.f + (a - 4.f) * 2.f;
  unsigned code = (unsigned)__builtin_rintf(c);
  code = code > 31u ? 31u : code;
  return code | (x < 0.f ? 32u : 0u);
}
struct __attribute__((packed, aligned(4))) U3 { unsigned a, b, c; };
constexpr int TROW = 768;
typedef float f32x32_t __attribute__((ext_vector_type(32)));
typedef unsigned u32x6_t __attribute__((ext_vector_type(6)));

__device__ __forceinline__ void phase_tables(int layer, int vbid, int vnb) {
  const KP PP = get_params();
  const int tid = TID(), lane = tid & 63;
  const int gw = vbid * 4 + (tid >> 6), nw = vnb * 4;
  const float* su = PP->peer_u + (size_t)layer * NEXP * 1024;
  const float* sv = PP->peer_v + (size_t)layer * NEXP * 1024;
  for (int r0 = gw * 2; r0 < 2 * NEXP; r0 += nw * 2) {
    float4 v[2][4];
#pragma unroll
    for (int q = 0; q < 2; ++q) {
      const int r = r0 + q;
      const float* src = (r < NEXP ? su + (size_t)r * 1024 : sv + (size_t)(r - NEXP) * 1024);
#pragma unroll
      for (int i = 0; i < 4; ++i) v[q][i] = *(const float4*)(src + (lane + 64 * i) * 4);
    }
#pragma unroll
    for (int q = 0; q < 2; ++q) {
      const int r = r0 + q;
      float am = 0.f;
#pragma unroll
      for (int i = 0; i < 4; ++i)
        am = fmaxf(am, fmaxf(fmaxf(fabsf(v[q][i].x), fabsf(v[q][i].y)), fmaxf(fabsf(v[q][i].z), fabsf(v[q][i].w))));
      am = wave_max(am);
      const float scale = fmaxf(am, 1e-30f) * (1.f / 7.5f);
      const float inv = 1.f / scale;
      unsigned long long lo = 0ull;
      unsigned hi = 0u;
#pragma unroll
      for (int i = 0; i < 4; ++i) {
        const float vv[4] = {v[q][i].x * inv, v[q][i].y * inv, v[q][i].z * inv, v[q][i].w * inv};
#pragma unroll
        for (int j = 0; j < 4; ++j) {
          const int k = 4 * i + j;
          const unsigned cde = enc_e2m3(vv[j]);
          if (k < 10) lo |= (unsigned long long)cde << (6 * k);
          else if (k == 10) { lo |= (unsigned long long)cde << 60; hi |= cde >> 4; }
          else hi |= cde << (6 * k - 64);
        }
      }
      unsigned char* dst = (r < NEXP ? PP->tab8U + (size_t)r * TROW : PP->tab8V + (size_t)(r - NEXP) * TROW);
      U3 pk3;
      pk3.a = (unsigned)lo; pk3.b = (unsigned)(lo >> 32); pk3.c = hi;
      *(U3*)(dst + lane * 12) = pk3;
      if (lane == 0) { if (r < NEXP) PP->scU[r] = scale; else PP->scV[r - NEXP] = scale; }
    }
  }
}

__device__ __forceinline__ void phase_norm(int layer, int which) {
  const KP PP = get_params();
  const int lane = TID() & 63;
  const int gw = BID() * 4 + (TID() >> 6), nw = gridDim.x * 4;
  const float* nwt = (which == 1 ? PP->norm_mix : PP->norm_ffn) + layer * 1024;
  const int rlim = (which == 2 && layer == DEPTH - 1) ? NLAT : R;
  for (int r = gw; r < rlim; r += nw) {
    const float* xr;
    if (r < NLAT) xr = ((which == 1 && layer == 0) ? PP->x : PP->out) + (size_t)r * 1024;
    else xr = ((which == 1 && layer == 0) ? PP->ctx : PP->xc) + (size_t)(r - NLAT) * 1024;
    const float* md = PP->mod + (size_t)(layer * 3 + modsel(r)) * 6144 + (which == 1 ? 0 : 3072);
    float4 v[4];
    float ss = 0.f;
#pragma unroll
    for (int i = 0; i < 4; ++i) {
      v[i] = *(const float4*)(xr + (lane + 64 * i) * 4);
      ss += v[i].x * v[i].x + v[i].y * v[i].y + v[i].z * v[i].z + v[i].w * v[i].w;
    }
    ss = wave_sum(ss);
    const float rs = rsqrtf(ss * (1.f / 1024.f) + EPS);
#pragma unroll
    for (int i = 0; i < 4; ++i) {
      const int col = (lane + 64 * i) * 4;
      const float4 w = *(const float4*)(nwt + col);
      const float4 sh = *(const float4*)(md + col);
      const float4 sc = *(const float4*)(md + 1024 + col);
      const float y0 = v[i].x * rs * w.x * (1.f + sc.x) + sh.x;
      const float y1 = v[i].y * rs * w.y * (1.f + sc.y) + sh.y;
      const float y2 = v[i].z * rs * w.z * (1.f + sc.z) + sh.z;
      const float y3 = v[i].w * rs * w.w * (1.f + sc.w) + sh.w;
      if (which == 1) {
        int pk = __builtin_amdgcn_cvt_pk_fp8_f32(y0, y1, 0, false);
        pk = __builtin_amdgcn_cvt_pk_fp8_f32(y2, y3, pk, true);
        *(int*)((char*)PP->h + (size_t)r * (LDK1 * 2) + col) = pk;
      } else {
        *(uint2*)(PP->h + (size_t)r * LDK1 + col) = make_uint2(pack_bf16(y0, y1), pack_bf16(y2, y3));
        int pk = __builtin_amdgcn_cvt_pk_fp8_f32(y0, y1, 0, false);
        pk = __builtin_amdgcn_cvt_pk_fp8_f32(y2, y3, pk, true);
        *(int*)(PP->h8 + (size_t)r * LDK1 + col) = pk;
      }
    }
  }
}

template <bool PRIO>
DEV void gemm_mainloop_t(const u16* __restrict__ A, int lda, const u16* __restrict__ B, int ldb, int K, int m0, int n0,
                         char* smem, f32x4 (&acc)[4][4]) {
  const int tid = TID();
  const int l = tid & 63, w = tid >> 6, wm = w >> 1, wn = w & 1, lr = l & 15, lg = l >> 4;
  uint4 ga0[4], gb0[4], ga1[4], gb1[4];
#pragma unroll
  for (int i = 0; i < 4; ++i) { ga0[i] = make_uint4(0u, 0u, 0u, 0u); gb0[i] = ga0[i]; ga1[i] = ga0[i]; gb1[i] = ga0[i]; }
  const int KT = K >> 6;
#define GLOAD(GA, GB, KT_)                                                                     \
  _Pragma("unroll") for (int i = 0; i < 4; ++i) {                                              \
    const int id = tid + 256 * i, row = id >> 3, c = id & 7;                                   \
    GA[i] = *(const uint4*)(A + (size_t)(m0 + row) * lda + (KT_) * 64 + c * 8);                \
    GB[i] = *(const uint4*)(B + (size_t)(n0 + row) * ldb + (KT_) * 64 + c * 8);                \
  }
#define LSTORE(GA, GB, BUF)                                                                    \
  {                                                                                            \
    char* as_ = smem + (BUF) * 32768;                                                          \
    char* bs_ = as_ + 16384;                                                                   \
    _Pragma("unroll") for (int i = 0; i < 4; ++i) {                                            \
      const int id = tid + 256 * i, row = id >> 3, c = id & 7;                                 \
      const int off = row * 128 + ((c ^ (row & 7)) << 4);                                      \
      *(uint4*)(as_ + off) = GA[i];                                                            \
      *(uint4*)(bs_ + off) = GB[i];                                                            \
    }                                                                                          \
  }
#define COMPUTE(BUF)                                                                                                      \
  {                                                                                                                       \
    const char* as_ = smem + (BUF) * 32768;                                                                               \
    const char* bs_ = as_ + 16384;                                                                                        \
    if (PRIO) __builtin_amdgcn_s_setprio(1);      \
    _Pragma("unroll") for (int ks = 0; ks < 2; ++ks) {                                                                    \
      bf16x8 a[4], b[4];                                                                                                  \
      const int c = ks * 4 + lg;                                                                                          \
      const int sw = ((c ^ (lr & 7)) << 4);                                                                               \
      _Pragma("unroll") for (int mi = 0; mi < 4; ++mi) a[mi] = *(const bf16x8*)(as_ + (wm * 64 + mi * 16 + lr) * 128 + sw); \
      _Pragma("unroll") for (int ni = 0; ni < 4; ++ni) b[ni] = *(const bf16x8*)(bs_ + (wn * 64 + ni * 16 + lr) * 128 + sw); \
      _Pragma("unroll") for (int mi = 0; mi < 4; ++mi)                                                                    \
        _Pragma("unroll") for (int ni = 0; ni < 4; ++ni)                                                                  \
          acc[mi][ni] = __builtin_amdgcn_mfma_f32_16x16x32_bf16(a[mi], b[ni], acc[mi][ni], 0, 0, 0);                      \
    }                                                                                                                     \
    if (PRIO) __builtin_amdgcn_s_setprio(0);                                                                              \
  }
  __syncthreads();
  GLOAD(ga0, gb0, 0);
  GLOAD(ga1, gb1, 1);
  LSTORE(ga0, gb0, 0);
  __syncthreads();
  for (int kt = 0; kt < KT; kt += 2) {
    if (kt + 2 < KT) { GLOAD(ga0, gb0, kt + 2); }
    COMPUTE(0);
    LSTORE(ga1, gb1, 1);
    __syncthreads();
    if (kt + 3 < KT) { GLOAD(ga1, gb1, kt + 3); }
    COMPUTE(1);
    if (kt + 2 < KT) { LSTORE(ga0, gb0, 0); }
    __syncthreads();
  }
#undef GLOAD
#undef LSTORE
#undef COMPUTE
}

DEV void gemm_mainloop(const u16* __restrict__ A, int lda, const u16* __restrict__ B, int ldb, int K, int m0, int n0,
                       char* smem, f32x4 (&acc)[4][4]) {
  gemm_mainloop_t<false>(A, lda, B, ldb, K, m0, n0, smem, acc);
}
DEV void gemm_mainloop1(const u16* __restrict__ A, int lda, const u16* __restrict__ B, int ldb, int K, int m0, int n0,
                       char* smem, f32x4 (&acc)[4][4]) {
  const int tid = TID();
  const int l = tid & 63, w = tid >> 6, wm = w >> 1, wn = w & 1, lr = l & 15, lg = l >> 4;
  uint4 ga[4], gb[4];
  const int KT = K >> 6;
  auto gload = [&](int kt) {
#pragma unroll
    for (int i = 0; i < 4; ++i) {
      const int id = tid + 256 * i, row = id >> 3, c = id & 7;
      ga[i] = *(const uint4*)(A + (size_t)(m0 + row) * lda + kt * 64 + c * 8);
      gb[i] = *(const uint4*)(B + (size_t)(n0 + row) * ldb + kt * 64 + c * 8);
    }
  };
  auto lstore = [&](int buf) {
    char* as = smem + buf * 32768;
    char* bs = as + 16384;
#pragma unroll
    for (int i = 0; i < 4; ++i) {
      const int id = tid + 256 * i, row = id >> 3, c = id & 7;
      const int off = row * 128 + ((c ^ (row & 7)) << 4);
      *(uint4*)(as + off) = ga[i];
      *(uint4*)(bs + off) = gb[i];
    }
  };
  __syncthreads();
  gload(0);
  lstore(0);
  __syncthreads();
  for (int kt = 0; kt < KT; ++kt) {
    if (kt + 1 < KT) gload(kt + 1);
    const char* as = smem + (kt & 1) * 32768;
    const char* bs = as + 16384;
#pragma unroll
    for (int ks = 0; ks < 2; ++ks) {
      bf16x8 a[4], b[4];
      const int c = ks * 4 + lg;
      const int sw = ((c ^ (lr & 7)) << 4);
#pragma unroll
      for (int mi = 0; mi < 4; ++mi) a[mi] = *(const bf16x8*)(as + (wm * 64 + mi * 16 + lr) * 128 + sw);
#pragma unroll
      for (int ni = 0; ni < 4; ++ni) b[ni] = *(const bf16x8*)(bs + (wn * 64 + ni * 16 + lr) * 128 + sw);
#pragma unroll
      for (int mi = 0; mi < 4; ++mi)
#pragma unroll
        for (int ni = 0; ni < 4; ++ni) acc[mi][ni] = __builtin_amdgcn_mfma_f32_16x16x32_bf16(a[mi], b[ni], acc[mi][ni], 0, 0, 0);
    }
    if (kt + 1 < KT) lstore((kt + 1) & 1);
    __syncthreads();
  }
}

DEV void zero_acc(f32x4 (&acc)[4][4]) {
#pragma unroll
  for (int i = 0; i < 4; ++i)
#pragma unroll
    for (int j = 0; j < 4; ++j) acc[i][j] = (f32x4){0.f, 0.f, 0.f, 0.f};
}

DEV void stage_half(const f32x4 (&acc)[4][4], int hsel, char* smem, float4 (&v)[8]) {
  const int tid = TID();
  const int l = tid & 63, w = tid >> 6, wm = w >> 1, wn = w & 1, lr = l & 15, lg = l >> 4;
  float* Cs = (float*)smem;
  __syncthreads();
  if (wm == hsel) {
#pragma unroll
    for (int mi = 0; mi < 4; ++mi)
#pragma unroll
      for (int ni = 0; ni < 4; ++ni)
#pragma unroll
        for (int r = 0; r < 4; ++r) Cs[(mi * 16 + lg * 4 + r) * 132 + wn * 64 + ni * 16 + lr] = acc[mi][ni][r];
  }
  __syncthreads();
#pragma unroll
  for (int j = 0; j < 8; ++j) {
    const int idx = tid + 256 * j, row = idx >> 5, c4 = idx & 31;
    v[j] = *(const float4*)&Cs[row * 132 + c4 * 4];
  }
}

DEV bool tile_map(int it, int MT, int NTl, int& mt, int& nt) {
  const int nb = gridDim.x, bid = BID();
  const int x = bid & 7, vl = bid >> 3, per = nb >> 3;
  const int T = MT * NTl;
  const int g_begin = (int)(((long long)x * T) >> 3), g_end = (int)(((long long)(x + 1) * T) >> 3);
  const int g = g_begin + vl + it * per;
  if (g >= g_end) return false;
  const int full = MT >> 3;
  const int sr = g / (8 * NTl);
  const int srow = sr < full ? sr : full;
  const int rows_in_sr = sr < full ? 8 : (MT & 7);
  const int tt = g - srow * 8 * NTl;
  nt = tt / rows_in_sr;
  mt = srow * 8 + tt % rows_in_sr;
  return true;
}

#define SG_LOCALS                                                                              \
  const int tid = TID();                                                                       \
  const int l = tid & 63, w = tid >> 6, wm = w >> 1, wn = w & 1, lr = l & 15, lg = l >> 4;     \
  uint4 ga0[4], gb0[4], ga1[4], gb1[4];                                                        \
  _Pragma("unroll") for (int i = 0; i < 4; ++i) {                                              \
    ga0[i] = make_uint4(0u, 0u, 0u, 0u); gb0[i] = ga0[i]; ga1[i] = ga0[i]; gb1[i] = ga0[i];    \
  }                                                                                            \
  const int r0 = tid >> 3, c0 = tid & 7;                                                       \
  const int pr0 = 8 * ((r0 & 15) >> 2) + 4 * (r0 >> 4) + (r0 & 3);
#define SG_LOAD(GA, GB, AP, BP, LD, M0_, N0_, KT_)                                             \
  _Pragma("unroll") for (int i = 0; i < 4; ++i) {                                              \
    GA[i] = *(const uint4*)((AP) + (size_t)((M0_) + 32 * i + r0) * (LD) + c0 * 8 + (KT_) * 64);  \
    GB[i] = *(const uint4*)((BP) + (size_t)((N0_) + 32 * i + pr0) * (LD) + c0 * 8 + (KT_) * 64); \
  }
#define SG_LSTORE(GA, GB, BUF)                                                                 \
  {                                                                                            \
    char* as_ = smem + (BUF) * 32768;                                                          \
    char* bs_ = as_ + 16384;                                                                   \
    _Pragma("unroll") for (int i = 0; i < 4; ++i) {                                            \
      const int id = tid + 256 * i, row = id >> 3, c = id & 7;                                 \
      const int off = row * 128 + ((c ^ (row & 7)) << 4);                                      \
      *(uint4*)(as_ + off) = GA[i];                                                            \
      *(uint4*)(bs_ + off) = GB[i];                                                            \
    }                                                                                          \
  }
#define SG_COMPUTE(ACC, BUF, PRIO)                                                                                        \
  {                                                                                                                       \
    const char* as_ = smem + (BUF) * 32768;                                                                               \
    const char* bs_ = as_ + 16384;                                                                                        \
    if (PRIO) __builtin_amdgcn_s_setprio(1);                                                                              \
    _Pragma("unroll") for (int ks = 0; ks < 2; ++ks) {                                                                    \
      bf16x8 a[4], b[4];                                                                                                  \
      const int c = ks * 4 + lg;                                                                                          \
      const int sw = ((c ^ (lr & 7)) << 4);                                                                               \
      _Pragma("unroll") for (int mi = 0; mi < 4; ++mi) a[mi] = *(const bf16x8*)(as_ + (wm * 64 + mi * 16 + lr) * 128 + sw); \
      _Pragma("unroll") for (int ni = 0; ni < 4; ++ni) b[ni] = *(const bf16x8*)(bs_ + (wn * 64 + ni * 16 + lr) * 128 + sw); \
      _Pragma("unroll") for (int mi = 0; mi < 4; ++mi)                                                                    \
        _Pragma("unroll") for (int ni = 0; ni < 4; ++ni)                                                                  \
          ACC[mi][ni] = __builtin_amdgcn_mfma_f32_16x16x32_bf16(b[ni], a[mi], ACC[mi][ni], 0, 0, 0);                      \
    }                                                                                                                     \
    if (PRIO) __builtin_amdgcn_s_setprio(0);                                                                              \
  }

typedef int i32x8 __attribute__((ext_vector_type(8)));
typedef int i32x4 __attribute__((ext_vector_type(4)));
#define F8_LOCALS                                                                              \
  const int tid = TID();                                                                       \
  const int l = tid & 63, w = tid >> 6, wm = w >> 1, wn = w & 1, lr = l & 15, lg = l >> 4;     \
  uint4 ga0[4], gb0[4], ga1[4], gb1[4];                                                        \
  _Pragma("unroll") for (int i = 0; i < 4; ++i) {                                              \
    ga0[i] = make_uint4(0u, 0u, 0u, 0u); gb0[i] = ga0[i]; ga1[i] = ga0[i]; gb1[i] = ga0[i];    \
  }                                                                                            \
  const int r0 = tid >> 3, c0 = tid & 7;                                                       \
  const int pr0 = 8 * ((r0 & 15) >> 2) + 4 * (r0 >> 4) + (r0 & 3);
#define F8_GLOAD(GA, GB, AP, LDA, BP, LDB, M0_, N0_, KT_)                                      \
  _Pragma("unroll") for (int i = 0; i < 4; ++i) {                                              \
    GA[i] = *(const uint4*)((AP) + (size_t)((M0_) + 32 * i + r0) * (LDA) + c0 * 16 + (KT_) * 128);   \
    GB[i] = *(const uint4*)((BP) + (size_t)((N0_) + 32 * i + pr0) * (LDB) + c0 * 16 + (KT_) * 128);  \
  }
#define F8_LSTORE(GA, GB, BUF)                                                                 \
  {                                                                                            \
    char* as_ = smem + (BUF) * 32768;                                                          \
    char* bs_ = as_ + 16384;                                                                   \
    _Pragma("unroll") for (int i = 0; i < 4; ++i) {                                            \
      const int id = tid + 256 * i, row = id >> 3, c = id & 7;                                 \
      const int off = row * 128 + ((c ^ (row & 7)) << 4);                                      \
      *(uint4*)(as_ + off) = GA[i];                                                            \
      *(uint4*)(bs_ + off) = GB[i];                                                            \
    }                                                                                          \
  }
#define F8_COMPUTE(BUF)                                                                                                   \
  {                                                                                                                       \
    const char* as_ = smem + (BUF) * 32768;                                                                               \
    const char* bs_ = as_ + 16384;                                                                                        \
    i32x8 a[4], b[4];                                                                                                     \
    const int sw0 = ((lg ^ (lr & 7)) << 4), sw1 = (((4 + lg) ^ (lr & 7)) << 4);                                           \
    _Pragma("unroll") for (int mi = 0; mi < 4; ++mi) {                                                                    \
      const char* p_ = as_ + (wm * 64 + mi * 16 + lr) * 128;                                                              \
      const i32x4 lo_ = *(const i32x4*)(p_ + sw0), hi_ = *(const i32x4*)(p_ + sw1);                                       \
      a[mi] = __builtin_shufflevector(lo_, hi_, 0, 1, 2, 3, 4, 5, 6, 7);                                                  \
    }                                                                                                                     \
    _Pragma("unroll") for (int ni = 0; ni < 4; ++ni) {                                                                    \
      const char* p_ = bs_ + (wn * 64 + ni * 16 + lr) * 128;                                                              \
      const i32x4 lo_ = *(const i32x4*)(p_ + sw0), hi_ = *(const i32x4*)(p_ + sw1);                                       \
      b[ni] = __builtin_shufflevector(lo_, hi_, 0, 1, 2, 3, 4, 5, 6, 7);                                                  \
    }                                                                                                                     \
    __builtin_amdgcn_s_setprio(1);                                                                                        \
    _Pragma("unroll") for (int mi = 0; mi < 4; ++mi)                                                                      \
      _Pragma("unroll") for (int ni = 0; ni < 4; ++ni)                                                                    \
        acc[mi][ni] = __builtin_amdgcn_mfma_scale_f32_16x16x128_f8f6f4(b[ni], a[mi], acc[mi][ni], 0, 0, 0, 0, 0, 0);      \
    __builtin_amdgcn_s_setprio(0);                                                                                        \
  }
#define F8_KLOOP(AP, LDA, BP, LDB, KT_)                                                        \
  for (int kt = 0; kt < (KT_); kt += 2) {                                                      \
    const bool wrap = (kt + 2 >= (KT_));                                                       \
    const int ml = wrap ? m0n : m0, nl = wrap ? n0n : n0, kl = wrap ? kt + 2 - (KT_) : kt + 2; \
    if (!wrap || hasn) { F8_GLOAD(ga0, gb0, AP, LDA, BP, LDB, ml, nl, kl); }                   \
    F8_COMPUTE(0);                                                                             \
    F8_LSTORE(ga1, gb1, 1);                                                                    \
    __syncthreads();                                                                           \
    if (!wrap || hasn) { F8_GLOAD(ga1, gb1, AP, LDA, BP, LDB, ml, nl, kl + 1); }               \
    F8_COMPUTE(1);                                                                             \
    if (!wrap || hasn) { F8_LSTORE(ga0, gb0, 0); }                                             \
    __syncthreads();                                                                           \
  }
#define F8_PROLOGUE(AP, LDA, BP, LDB)                                                          \
  __syncthreads();                           \
  F8_GLOAD(ga0, gb0, AP, LDA, BP, LDB, m0, n0, 0);                                             \
  F8_GLOAD(ga1, gb1, AP, LDA, BP, LDB, m0, n0, 1);                                             \
  F8_LSTORE(ga0, gb0, 0);                                                                      \
  __syncthreads();

__device__ __forceinline__ void phase_gemm_win(int layer, char* smem) {
  const KP PP = get_params();
  const char* Bt = (const char*)(PP->WinT + (size_t)layer * NPAD * LDK1);
  const char* A = (const char*)PP->h;
  F8_LOCALS
  int it = 0, mt, nt;
  if (!tile_map(it, R / 128, NPAD / 128, mt, nt)) return;
  int m0 = mt * 128, n0 = nt * 128;
  F8_PROLOGUE(A, LDK1 * 2, Bt, LDK1)
  for (;;) {
    int mtn = 0, ntn = 0;
    const bool hasn = tile_map(it + 1, R / 128, NPAD / 128, mtn, ntn);
    const int m0n = mtn * 128, n0n = ntn * 128;
    f32x4 acc[4][4];
    zero_acc(acc);
    F8_KLOOP(A, LDK1 * 2, Bt, LDK1, 8)
#pragma unroll
    for (int mi = 0; mi < 4; ++mi) {
      const size_t gr = (size_t)(m0 + wm * 64 + mi * 16 + lr);
#pragma unroll
      for (int g = 0; g < 2; ++g) {
        const int gc = n0 + wn * 64 + g * 32 + 8 * lg;
        const f32x4 t0 = acc[mi][2 * g] * (1.f / 32.f), t1 = acc[mi][2 * g + 1] * (1.f / 32.f);
        if (n0 < 1536) {
          int p0 = __builtin_amdgcn_cvt_pk_fp8_f32(t0[0], t0[1], 0, false);
          p0 = __builtin_amdgcn_cvt_pk_fp8_f32(t0[2], t0[3], p0, true);
          int p1 = __builtin_amdgcn_cvt_pk_fp8_f32(t1[0], t1[1], 0, false);
          p1 = __builtin_amdgcn_cvt_pk_fp8_f32(t1[2], t1[3], p1, true);
          *(int2*)((char*)PP->qkv_pre + gr * 1536 + gc) = make_int2(p0, p1);
        } else if (n0 < 2048) {
          *(uint4*)(PP->z + gr * 512 + (gc - 1536)) =
              make_uint4(pack_bf16(t0[0], t0[1]), pack_bf16(t0[2], t0[3]), pack_bf16(t1[0], t1[1]), pack_bf16(t1[2], t1[3]));
        } else if (n0 < 2560) {
          *(uint4*)(PP->pin + gr * 512 + (gc - 2048)) =
              make_uint4(pack_bf16(t0[0], t0[1]), pack_bf16(t0[2], t0[3]), pack_bf16(t1[0], t1[1]), pack_bf16(t1[2], t1[3]));
        } else if (n0 < 4608) {
          unsigned q0 = 0u, q1 = 0u;
#pragma unroll
          for (int e = 0; e < 4; ++e) {
            q0 = __builtin_amdgcn_cvt_pk_u8_f32(sigmoidf_(t0[e]) * 255.f, e, q0);
            q1 = __builtin_amdgcn_cvt_pk_u8_f32(sigmoidf_(t1[e]) * 255.f, e, q1);
          }
          unsigned char* gdst = (n0 < 3584) ? (unsigned char*)PP->sgd + gr * 1024 + (gc - 2560)
                                            : (unsigned char*)PP->sgp + gr * 1024 + (gc - 3584);
          *(uint2*)gdst = make_uint2(q0, q1);
        } else {
          if (gc - 4608 < 16) {
            *(float4*)(PP->ba + gr * 16 + (gc - 4608)) = make_float4(t0[0], t0[1], t0[2], t0[3]);
            *(float4*)(PP->ba + gr * 16 + (gc - 4608) + 4) = make_float4(t1[0], t1[1], t1[2], t1[3]);
          }
        }
      }
    }
    if (!hasn) break;
    m0 = m0n; n0 = n0n; ++it;
  }
}

__device__ __forceinline__ void phase_conv(int layer) {
  const KP PP = get_params();
  const int lane = TID() & 63;
  const int gw = BID() * 4 + (TID() >> 6), nw = gridDim.x * 4;
  const float* cw = PP->conv_w + (size_t)layer * 4 * 1536;
  float wr[3][4][8];
#pragma unroll
  for (int part = 0; part < 3; ++part)
#pragma unroll
    for (int j = 0; j < 4; ++j) {
      const float4 w0 = *(const float4*)(cw + j * 1536 + part * 512 + lane * 8);
      const float4 w1 = *(const float4*)(cw + j * 1536 + part * 512 + lane * 8 + 4);
      wr[part][j][0] = w0.x; wr[part][j][1] = w0.y; wr[part][j][2] = w0.z; wr[part][j][3] = w0.w;
      wr[part][j][4] = w1.x; wr[part][j][5] = w1.y; wr[part][j][6] = w1.z; wr[part][j][7] = w1.w;
    }
  for (int r = gw; r < R; r += nw) {
    int t, T;
    if (r < NLAT) { t = r & (SEQ - 1); T = SEQ; } else { t = (r - NLAT) & (CTX - 1); T = CTX; }
    const int base = r - t;
    uint2 xv[3][4];
#pragma unroll
    for (int j = 0; j < 4; ++j) {
      const int tt = t + j - 2;
      const bool ok = (tt >= 0 && tt < T);
      const unsigned char* src = (const unsigned char*)PP->qkv_pre + (size_t)(base + (ok ? tt : t)) * 1536 + lane * 8;
#pragma unroll
      for (int part = 0; part < 3; ++part) {
        xv[part][j] = *(const uint2*)(src + part * 512);
        if (!ok) xv[part][j] = make_uint2(0u, 0u);
      }
    }
#pragma unroll
    for (int part = 0; part < 3; ++part) {
      const int ch0 = part * 512 + lane * 8;
      float y[8];
#pragma unroll
      for (int e = 0; e < 8; ++e) y[e] = 0.f;
#pragma unroll
      for (int j = 0; j < 4; ++j) {
        float xf[8];
        {
          const f32x2 a0 = __builtin_amdgcn_cvt_pk_f32_fp8(xv[part][j].x, false), a1 = __builtin_amdgcn_cvt_pk_f32_fp8(xv[part][j].x, true);
          const f32x2 a2 = __builtin_amdgcn_cvt_pk_f32_fp8(xv[part][j].y, false), a3 = __builtin_amdgcn_cvt_pk_f32_fp8(xv[part][j].y, true);
          xf[0] = a0[0]; xf[1] = a0[1]; xf[2] = a1[0]; xf[3] = a1[1]; xf[4] = a2[0]; xf[5] = a2[1]; xf[6] = a3[0]; xf[7] = a3[1];
        }
#pragma unroll
        for (int e = 0; e < 8; ++e) y[e] += wr[part][j][e] * xf[e];
      }
      float ss = 0.f;
#pragma unroll
      for (int e = 0; e < 8; ++e) { y[e] = siluf_(y[e]); ss += y[e] * y[e]; }
      if (part < 2) {
        ss = group16_sum(ss);
        const float sc = rsqrtf(ss + EPS) * (part == 0 ? 0.08838834764831845f : 1.f);
#pragma unroll
        for (int e = 0; e < 8; ++e) y[e] *= sc;
      }
      *(uint4*)(PP->qkvn + (size_t)r * 1536 + ch0) = pack8(y);
    }
    if (lane < 16) {
      const float raw = PP->ba[(size_t)r * 16 + lane];
      float o;
      if (lane < 8) {
        o = sigmoidf_(raw);
      } else {
        const int jj = lane - 8;
        const float xx = raw + PP->dt_bias[layer * 8 + jj];
        const float ee = __expf(xx);
        const float sp = xx > 20.f ? xx : (ee < 0.03125f ? ee * (1.f - ee * (0.5f - ee * (0.33333334f - 0.25f * ee))) : __logf(1.f + ee));
        o = -__expf(PP->a_log[layer * 8 + jj]) * sp;
      }
      PP->bg[(size_t)r * 16 + lane] = o;
    }
  }
}

DEV int seq_row(int b, int dir, int pos) {
  if (dir == 0) return pos < CTX ? NLAT + b * CTX + pos : b * SEQ + (pos - CTX);
  return pos < CTX ? NLAT + b * CTX + (CTX - 1 - pos) : b * SEQ + (SEQ - 1 - (pos - CTX));
}
constexpr int NCHUNK = (CTX + SEQ) / 64;
constexpr int NUNIT = BATCH * DNH * 2 * NCHUNK;

DEV int kperm(int s, int g, int e) { return 32 * s + 16 * (e >> 2) + 4 * g + (e & 3); }

DEV uint4 pack_tiles(const f32x4& a, const f32x4& b) {
  return make_uint4(pack_bf16(a[0], a[1]), pack_bf16(a[2], a[3]), pack_bf16(b[0], b[1]), pack_bf16(b[2], b[3]));
}
DEV bf16x8 as_frag(const uint4& v) { return *(const bf16x8*)&v; }

DEV void conv8_silu(const unsigned char* __restrict__ qkv_pre8, const float* __restrict__ cw, int r, int ch0, float (&y)[8]) {
  int t, T;
  if (r < NLAT) { t = r & (SEQ - 1); T = SEQ; } else { t = (r - NLAT) & (CTX - 1); T = CTX; }
  const int base = r - t;
  uint2 xv[4];
#pragma unroll
  for (int j = 0; j < 4; ++j) {
    const int tt = t + j - 2;
    const bool ok = (tt >= 0 && tt < T);
    xv[j] = *(const uint2*)(qkv_pre8 + (size_t)(base + (ok ? tt : t)) * 1536 + ch0);
    if (!ok) xv[j] = make_uint2(0u, 0u);
  }
#pragma unroll
  for (int e = 0; e < 8; ++e) y[e] = 0.f;
#pragma unroll
  for (int j = 0; j < 4; ++j) {
    const float4 w0 = *(const float4*)(cw + j * 1536 + ch0), w1 = *(const float4*)(cw + j * 1536 + ch0 + 4);
    const f32x2 a0 = __builtin_amdgcn_cvt_pk_f32_fp8(xv[j].x, false), a1 = __builtin_amdgcn_cvt_pk_f32_fp8(xv[j].x, true);
    const f32x2 a2 = __builtin_amdgcn_cvt_pk_f32_fp8(xv[j].y, false), a3 = __builtin_amdgcn_cvt_pk_f32_fp8(xv[j].y, true);
    y[0] += w0.x * a0[0]; y[1] += w0.y * a0[1]; y[2] += w0.z * a1[0]; y[3] += w0.w * a1[1];
    y[4] += w1.x * a2[0]; y[5] += w1.y * a2[1]; y[6] += w1.z * a3[0]; y[7] += w1.w * a3[1];
  }
#pragma unroll
  for (int e = 0; e < 8; ++e) y[e] = siluf_(y[e]);
}

__device__ __forceinline__ void phase_prep(int layer, char* smem) {
  const KP PP = get_params();
  const int tid0 = TID();
  const int w = __builtin_amdgcn_readfirstlane(tid0 >> 6);
  char* Kt = smem;
  char* Vt = smem + 16384;
  float* Ld = (float*)(smem + 32768);
  u16* LN = (u16*)(smem + 32768 + 5120);
  float* gcs = (float*)(smem + 32768 + 5120 + 9216);
  float* bts = gcs + 64;
  char* wpriv = smem + 32768 + 5120 + 9216 + 512 + w * 6144;
  float* Tt = (float*)wpriv;
  u16* Xb = (u16*)(wpriv + 4096);
  float* egc = (float*)(smem + 72192);
  float* egl = egc + 64;
  const int per_ = gridDim.x >> 3, s_ = BID() >> 3;
  const int nfull_ = (2 * NCHUNK) / per_, nrem_ = (2 * NCHUNK) % per_;
  const bool altx_ = (2 * nrem_ <= per_);
  for (int ki_ = 0; ki_ <= nfull_; ++ki_) {
    int j_;
    if (ki_ < nfull_) j_ = s_ + per_ * ki_;
    else if (altx_) { if (!(s_ & 1) || (s_ >> 1) >= nrem_) break; j_ = nfull_ * per_ + (s_ >> 1); }
    else { if (s_ >= nrem_) break; j_ = nfull_ * per_ + s_; }
    const int c = NCHUNK - 1 - (j_ >> 1), u16i = (BID() & 7) * 2 + (j_ & 1);
    const int unit = u16i * NCHUNK + c;
    const int dir = u16i & 1, hd = (u16i >> 1) & 3, b = u16i >> 3;
    int tid = tid0;
    asm volatile("" : "+v"(tid));
    const int l = tid & 63, lr = l & 15, lg = l >> 4;
    __syncthreads();
    if (tid < 64) {
      const int rr = seq_row(b, dir, c * 64 + tid);
      const int jj = dir * 4 + hd;
      bts[tid] = sigmoidf_(PP->ba[(size_t)rr * 16 + jj]);
      float g;
      {
        const float xx = PP->ba[(size_t)rr * 16 + 8 + jj] + PP->dt_bias[layer * 8 + jj];
        const float ee = __expf(xx);
        const float sp = xx > 20.f ? xx : (ee < 0.03125f ? ee * (1.f - ee * (0.5f - ee * (0.33333334f - 0.25f * ee))) : __logf(1.f + ee));
        g = -__expf(PP->a_log[layer * 8 + jj]) * sp;
      }
#pragma unroll
      for (int o = 1; o < 64; o <<= 1) {
        const float t = __builtin_bit_cast(float, __builtin_amdgcn_ds_bpermute(((tid - o) & 63) << 2, __builtin_bit_cast(int, g)));
        if (tid >= o) g += t;
      }
      gcs[tid] = g;
      egc[tid] = __expf(g);
      egl[tid] = __expf(__builtin_bit_cast(float, __builtin_amdgcn_readlane(__builtin_bit_cast(int, g), 63)) - g);
      PP->gc[(size_t)unit * 64 + tid] = g;
    }
    {
      const unsigned char* pre8 = (const unsigned char*)PP->qkv_pre;
      const float* cw = PP->conv_w + (size_t)layer * 4 * 1536;
      const int ch = tid & 15, rg = tid >> 4;
      const int r_first = seq_row(b, dir, c * 64 + 4 * rg);
      int t0, T;
      if (r_first < NLAT) { t0 = r_first & (SEQ - 1); T = SEQ; } else { t0 = (r_first - NLAT) & (CTX - 1); T = CTX; }
      const int base = r_first - t0;
      const int tl = dir ? t0 - 3 : t0;
      const int nparts = dir == 0 ? 3 : 2;
      for (int part = 0; part < nparts; ++part) {
        const int chofs = (part == 0 ? 512 : (part == 1 ? 1024 : 0)) + hd * 128 + ch * 8;
        f32x2 wv[4][4];
#pragma unroll
        for (int j = 0; j < 4; ++j) {
          const float4 w0 = *(const float4*)(cw + j * 1536 + chofs), w1 = *(const float4*)(cw + j * 1536 + chofs + 4);
          wv[j][0] = (f32x2){w0.x, w0.y}; wv[j][1] = (f32x2){w0.z, w0.w};
          wv[j][2] = (f32x2){w1.x, w1.y}; wv[j][3] = (f32x2){w1.z, w1.w};
        }
        uint2 xr[7];
#pragma unroll
        for (int m = 0; m < 7; ++m) {
          const int tt = tl - 2 + m;
          const bool ok = (tt >= 0 && tt < T);
          xr[m] = *(const uint2*)(pre8 + (size_t)(base + (ok ? tt : t0)) * 1536 + chofs);
          if (!ok) xr[m] = make_uint2(0u, 0u);
        }
        f32x2 xf[7][4];
#pragma unroll
        for (int m = 0; m < 7; ++m) {
          xf[m][0] = __builtin_amdgcn_cvt_pk_f32_fp8(xr[m].x, false); xf[m][1] = __builtin_amdgcn_cvt_pk_f32_fp8(xr[m].x, true);
          xf[m][2] = __builtin_amdgcn_cvt_pk_f32_fp8(xr[m].y, false); xf[m][3] = __builtin_amdgcn_cvt_pk_f32_fp8(xr[m].y, true);
        }
        f32x2 acc2[4][4];
        if (dir == 0) {
#pragma unroll
          for (int s4 = 0; s4 < 4; ++s4)
#pragma unroll
            for (int p = 0; p < 4; ++p) {
              f32x2 a = wv[0][p] * xf[s4][p];
#pragma unroll
              for (int j = 1; j < 4; ++j) a += wv[j][p] * xf[s4 + j][p];
              acc2[s4][p] = a;
            }
        } else {
#pragma unroll
          for (int s4 = 0; s4 < 4; ++s4)
#pragma unroll
            for (int p = 0; p < 4; ++p) {
              f32x2 a = wv[0][p] * xf[3 - s4][p];
#pragma unroll
              for (int j = 1; j < 4; ++j) a += wv[j][p] * xf[3 - s4 + j][p];
              acc2[s4][p] = a;
            }
        }
        float y[4][8], ss[4];
#pragma unroll
        for (int s4 = 0; s4 < 4; ++s4) {
          float t = 0.f;
#pragma unroll
          for (int p = 0; p < 4; ++p) {
            const float a0 = siluf_(acc2[s4][p][0]), a1 = siluf_(acc2[s4][p][1]);
            y[s4][2 * p] = a0; y[s4][2 * p + 1] = a1;
            t += a0 * a0 + a1 * a1;
          }
          ss[s4] = t;
        }
        if (part != 1) {
#pragma unroll
          for (int s4 = 0; s4 < 4; ++s4) ss[s4] += swz_xor<8>(ss[s4]);
#pragma unroll
          for (int s4 = 0; s4 < 4; ++s4) ss[s4] += swz_xor<4>(ss[s4]);
#pragma unroll
          for (int s4 = 0; s4 < 4; ++s4) ss[s4] += swz_xor<2>(ss[s4]);
#pragma unroll
          for (int s4 = 0; s4 < 4; ++s4) ss[s4] += swz_xor<1>(ss[s4]);
#pragma unroll
          for (int s4 = 0; s4 < 4; ++s4) {
            const float sc = rsqrtf(ss[s4] + EPS) * (part == 2 ? 0.08838834764831845f : 1.f);
#pragma unroll
            for (int e2 = 0; e2 < 8; ++e2) y[s4][e2] *= sc;
          }
        }
#pragma unroll
        for (int s4 = 0; s4 < 4; ++s4) {
          const int m0_ = dir ? 3 - s4 : s4;
          const uint4 pk = pack8(y[s4]);
          const int i = 4 * rg + s4;
          if (part < 2) *(uint4*)((part == 0 ? Kt : Vt) + i * 256 + ((ch ^ (i & 15)) << 4)) = pk;
          if (dir == 0 && part != 1) *(uint4*)(PP->qkvn + (size_t)(base + tl + m0_) * 1536 + chofs) = pk;
        }
      }
    }
    __syncthreads();
    {
      f32x4 acc[4];
#pragma unroll
      for (int nt = 0; nt < 4; ++nt) acc[nt] = (f32x4){0.f, 0.f, 0.f, 0.f};
#pragma unroll
      for (int s = 0; s < 4; ++s) {
        const int ch = s * 4 + lg;
        const bf16x8 a = *(const bf16x8*)(Kt + (16 * w + lr) * 256 + ((ch ^ lr) << 4));
#pragma unroll
        for (int nt = 0; nt < 4; ++nt) {
          const bf16x8 bb = *(const bf16x8*)(Kt + (16 * nt + lr) * 256 + ((ch ^ lr) << 4));
          acc[nt] = __builtin_amdgcn_mfma_f32_16x16x32_bf16(a, bb, acc[nt], 0, 0, 0);
        }
      }
#pragma unroll
      for (int nt = 0; nt < 4; ++nt)
#pragma unroll
        for (int r = 0; r < 4; ++r) {
          const int i = 16 * w + 4 * lg + r, j = 16 * nt + lr;
          const float val = (j < i) ? bts[i] * acc[nt][r] * __expf(fminf(gcs[i] - gcs[j], 0.f)) : 0.f;
          LN[i * 72 + j] = f2bf(-val);
          if (nt == w) Ld[(w * 16 + lr) * 20 + 4 * lg + r] = val;
        }
    }
    {
      const float glast = gcs[63];
      if (tid == 0) PP->glast[unit] = glast;
#pragma unroll
      for (int q4 = 0; q4 < 4; ++q4) {
        const int fid = tid + 256 * q4;
        const int mt = fid >> 7, s2 = (fid >> 6) & 1, ln = fid & 63, llr = ln & 15, llg = ln >> 4;
        const int d = 16 * mt + llr;
        float f[8];
#pragma unroll
        for (int e = 0; e < 8; ++e) {
          const int pos = kperm(s2, llg, e);
          const float kv = bf2f(*(const u16*)(Kt + pos * 256 + (((d >> 3) ^ (pos & 15)) << 4) + (d & 7) * 2));
          f[e] = kv * egl[pos];
        }
        *(uint4*)(PP->KdT + ((size_t)unit * 1024 + fid) * 8) = pack8(f);
      }
    }
    f32x4 X[4][4];
    {
      const bool isU = w >= 2;
      const char* tile = isU ? Vt : Kt;
#pragma unroll
      for (int mt = 0; mt < 4; ++mt)
#pragma unroll
        for (int nt = 0; nt < 4; ++nt)
#pragma unroll
          for (int r = 0; r < 4; ++r) {
            const int i = 16 * mt + 4 * lg + r, cc = 64 * (w & 1) + 16 * nt + lr;
            const float val = bf2f(*(const u16*)(tile + i * 256 + (((cc >> 3) ^ (i & 15)) << 4) + (cc & 7) * 2));
            X[mt][nt][r] = bts[i] * val * (isU ? 1.f : egc[i]);
          }
    }
    __syncthreads();
    u16* Wst = (u16*)smem;
    u16* Ust = (u16*)(smem + 16384);
#pragma unroll
    for (int bk = 0; bk < 4; ++bk) {
#pragma unroll
      for (int nt = 0; nt < 4; ++nt)
#pragma unroll
        for (int r = 0; r < 4; ++r) Tt[(4 * lg + r) * 64 + 16 * nt + lr] = X[bk][nt][r];
      __builtin_amdgcn_wave_barrier();
      asm volatile("s_waitcnt lgkmcnt(0)" ::: "memory");
      float xb[16];
#pragma unroll
      for (int i = 0; i < 16; ++i) xb[i] = Tt[i * 64 + l];
#pragma unroll
      for (int j = 0; j < 15; ++j) {
        const float xj = xb[j];
#pragma unroll
        for (int i4 = (j + 1) / 4; i4 < 4; ++i4) {
          const float4 lv = *(const float4*)&Ld[(bk * 16 + j) * 20 + i4 * 4];
          if (i4 * 4 + 0 > j) xb[i4 * 4 + 0] -= lv.x * xj;
          if (i4 * 4 + 1 > j) xb[i4 * 4 + 1] -= lv.y * xj;
          if (i4 * 4 + 2 > j) xb[i4 * 4 + 2] -= lv.z * xj;
          if (i4 * 4 + 3 > j) xb[i4 * 4 + 3] -= lv.w * xj;
        }
      }
      {
        const int cc = 64 * (w & 1) + l;
        if (w < 2) {
          const int d = cc, s = d >> 5, e = ((d >> 4) & 1) * 4 + (d & 3), g = (d >> 2) & 3;
#pragma unroll
          for (int ii = 0; ii < 16; ++ii) Wst[(((bk * 4 + s) * 64 + g * 16 + ii) << 3) + e] = f2bf(-xb[ii]);
        } else {
          const int slice = cc >> 4, lr_ = cc & 15;
#pragma unroll
          for (int ii = 0; ii < 16; ++ii) Ust[(((slice * 4 + bk) * 64 + ((ii >> 2) & 3) * 16 + lr_) << 2) + (ii & 3)] = f2bf(xb[ii]);
        }
        if (bk < 3) {
          *(uint4*)(Xb + l * 16) = pack8(xb);
          *(uint4*)(Xb + l * 16 + 8) = pack8(xb + 8);
        }
      }
      if (bk < 3) {
        __builtin_amdgcn_wave_barrier();
        asm volatile("s_waitcnt lgkmcnt(0)" ::: "memory");
        uint4 bfr[4];
#pragma unroll
        for (int nt = 0; nt < 4; ++nt)
          bfr[nt] = (lg < 2) ? *(const uint4*)(Xb + (16 * nt + lr) * 16 + 8 * lg) : make_uint4(0u, 0u, 0u, 0u);
#pragma unroll
        for (int mt = bk + 1; mt < 4; ++mt) {
          const uint4 afr = (lg < 2) ? *(const uint4*)(LN + (16 * mt + lr) * 72 + 16 * bk + 8 * lg) : make_uint4(0u, 0u, 0u, 0u);
#pragma unroll
          for (int nt = 0; nt < 4; ++nt)
            X[mt][nt] = __builtin_amdgcn_mfma_f32_16x16x32_bf16(as_frag(afr), as_frag(bfr[nt]), X[mt][nt], 0, 0, 0);
        }
        __builtin_amdgcn_wave_barrier();
      }
    }
    __syncthreads();
#pragma unroll
    for (int q = 0; q < 4; ++q) {
      const int id = tid + 256 * q;
      *(uint4*)(PP->Wfrag + ((size_t)unit * 1024 + id) * 8) = *(const uint4*)(smem + id * 16);
      *(uint4*)(PP->Ufrag + ((size_t)unit * 1024 + id) * 8) = *(const uint4*)(smem + 16384 + id * 16);
    }
  }
}


__device__ __forceinline__ void phase_scan(char* smem) {
  const KP PP = get_params();
  const int tid = TID(), lane = tid & 63, wv = tid >> 6;
  __builtin_amdgcn_s_setprio(3);
  for (int item = BID(); item < 128; item += gridDim.x) {
    const int u16i = (item & 7) * 2 + (item >> 6), slice = (item >> 3) & 7;
    const size_t ubase = (size_t)u16i * NCHUNK;
    const uint4* Wg = (const uint4*)PP->Wfrag;
    const uint4* Kg = (const uint4*)PP->KdT;
    __syncthreads();
    if (wv != 0) {
      const int j0 = wv - 1;
      uint4 st0[11], st1[11], st2[11];
#pragma unroll
      for (int i = 0; i < 11; ++i) { st0[i] = make_uint4(0u, 0u, 0u, 0u); st1[i] = st0[i]; st2[i] = st0[i]; }
#define LLOAD(ST, UNIT)                                                                                      \
  _Pragma("unroll") for (int i = 0; i < 11; ++i) {                                                           \
    const int q = (j0 + 3 * i) < 32 ? (j0 + 3 * i) : 31;                                                     \
    ST[i] = *((q < 16 ? Wg + (UNIT) * 1024 + q * 64 : Kg + (UNIT) * 1024 + (q - 16) * 64) + lane);           \
  }
#define LWRITE(ST, SLOT)                                                                                     \
  _Pragma("unroll") for (int i = 0; i < 11; ++i) {                                                           \
    const int q = (j0 + 3 * i) < 32 ? (j0 + 3 * i) : 31;                                                     \
    *(uint4*)((SLOT) + q * 1024 + lane * 16) = ST[i];                                                        \
  }
      LLOAD(st0, ubase);
      LLOAD(st1, ubase + 1);
      LLOAD(st2, ubase + 2);
      LWRITE(st0, smem);
      LLOAD(st0, ubase + 3);
      __syncthreads();
#define LSTEP(ST, C)                                                                   \
  {                                                                                    \
    LWRITE(ST, smem + (((C) + 1) & 1) * 32768);                                        \
    LLOAD(ST, ubase + (size_t)(((C) + 4 < NCHUNK) ? (C) + 4 : NCHUNK - 1));            \
    __syncthreads();                                                                   \
  }
      for (int c0 = 0; c0 < NCHUNK; c0 += 3) {
        LSTEP(st1, c0);
        LSTEP(st2, c0 + 1);
        LSTEP(st0, c0 + 2);
      }
#undef LSTEP
#undef LLOAD
#undef LWRITE
    } else {
      f32x4 S[8];
#pragma unroll
      for (int t = 0; t < 8; ++t) S[t] = (f32x4){0.f, 0.f, 0.f, 0.f};
      uint2 uf0[5], uf1[5], uf2[5];
#pragma unroll
      for (int i = 0; i < 5; ++i) { uf0[i] = make_uint2(0u, 0u); uf1[i] = uf0[i]; uf2[i] = uf0[i]; }
      const uint2* Ug = (const uint2*)PP->Ufrag + lane;
      const float* Gl = PP->glast;
#define ULOAD(UF, UNIT) { _Pragma("unroll") for (int i = 0; i < 4; ++i) UF[i] = Ug[((UNIT) * 8 + slice) * 256 + i * 64]; UF[4].x = __float_as_uint(Gl[UNIT]); }
      ULOAD(uf0, ubase);
      ULOAD(uf1, ubase + 1);
      ULOAD(uf2, ubase + 2);
#define CSTEP(UF, C)                                                                                                   \
  {                                                                                                                    \
    const int c = (C);                                                                                                 \
    const size_t unit = ubase + c;                                                                                     \
    const char* slot = smem + (c & 1) * 32768;                                                                         \
    const float el = __expf(__uint_as_float(UF[4].x));                                                                 \
    uint4 sb[4];                                                                                                       \
    _Pragma("unroll") for (int s2 = 0; s2 < 4; ++s2) sb[s2] = pack_tiles(S[2 * s2], S[2 * s2 + 1]);                    \
    {                                                                                                                  \
      uint4* sp = (uint4*)PP->Sfrag + (unit * 8 + slice) * 256 + lane;                                                 \
      _Pragma("unroll") for (int s2 = 0; s2 < 4; ++s2) sp[s2 * 64] = sb[s2];                                           \
    }                                                                                                                  \
    f32x4 vn[4];                                                                                                       \
    _Pragma("unroll") for (int mt = 0; mt < 4; ++mt) {                                                                 \
      vn[mt] = (f32x4){bf_lo(UF[mt].x), bf_hi(UF[mt].x), bf_lo(UF[mt].y), bf_hi(UF[mt].y)};                            \
      _Pragma("unroll") for (int s2 = 0; s2 < 4; ++s2) {                                                               \
        const uint4 wfr = *(const uint4*)(slot + (mt * 4 + s2) * 1024 + lane * 16);                                    \
        vn[mt] = __builtin_amdgcn_mfma_f32_16x16x32_bf16(as_frag(wfr), as_frag(sb[s2]), vn[mt], 0, 0, 0);              \
      }                                                                                                                \
    }                                                                                                                  \
    ULOAD(UF, ubase + (size_t)((c + 3 < NCHUNK) ? c + 3 : NCHUNK - 1));                                                \
    uint4 vb[2];                                                                                                       \
    vb[0] = pack_tiles(vn[0], vn[1]);                                                                                  \
    vb[1] = pack_tiles(vn[2], vn[3]);                                                                                  \
    {                                                                                                                  \
      uint4* vp = (uint4*)PP->Vfrag + (unit * 8 + slice) * 128 + lane;                                                 \
      vp[0] = vb[0];                                                                                                   \
      vp[64] = vb[1];                                                                                                  \
    }                                                                                                                  \
    _Pragma("unroll") for (int t = 0; t < 8; ++t) {                                                                    \
      S[t] *= el;                                                                                                      \
      const uint4 k0 = *(const uint4*)(slot + 16384 + (t * 2 + 0) * 1024 + lane * 16);                                 \
      const uint4 k1 = *(const uint4*)(slot + 16384 + (t * 2 + 1) * 1024 + lane * 16);                                 \
      S[t] = __builtin_amdgcn_mfma_f32_16x16x32_bf16(as_frag(k0), as_frag(vb[0]), S[t], 0, 0, 0);                      \
      S[t] = __builtin_amdgcn_mfma_f32_16x16x32_bf16(as_frag(k1), as_frag(vb[1]), S[t], 0, 0, 0);                      \
    }                                                                                                                  \
    __syncthreads();                                                                                                   \
  }
      __syncthreads();
      for (int c0 = 0; c0 < NCHUNK; c0 += 3) {
        CSTEP(uf0, c0);
        CSTEP(uf1, c0 + 1);
        CSTEP(uf2, c0 + 2);
      }
#undef CSTEP
#undef ULOAD
    }
  }
  __builtin_amdgcn_s_setprio(0);
}

__device__ __forceinline__ void phase_o(int layer, char* smem) {
  const KP PP = get_params();
  const int tid = TID(), l = tid & 63, w = tid >> 6, lr = l & 15, lg = l >> 4;
  char* Qt = smem;
  char* Kt = smem + 16384;
  u16* If = (u16*)(smem + 32768);
  u16* Ib = (u16*)(smem + 41984);
  float* gcf = (float*)(smem + 51200);
  float* gcb = gcf + 64;
  float* rowss = gcb + 64;
  float* Os = (float*)smem;
  const int nper = (layer == DEPTH - 1) ? 128 : 132;
  const int xq = BID() & 7, vl0 = BID() >> 3, vstep = gridDim.x >> 3;
  for (int vi = vl0; vi < nper; vi += vstep) {
    int b = xq >> 2, hd = xq & 3, tok0, cf, cb;
    if (vi < 128) {
      const int n = vi;
      tok0 = b * SEQ + 64 * n; cf = 4 + n; cb = 4 + 127 - n;
    } else {
      const int n = vi - 128;
      tok0 = NLAT + b * CTX + 64 * n; cf = n; cb = 3 - n;
    }
    const size_t unit_f = (size_t)((b * 4 + hd) * 2 + 0) * NCHUNK + cf;
    const size_t unit_b = (size_t)((b * 4 + hd) * 2 + 1) * NCHUNK + cb;
    uint4 pSF[4][2], pSB[4][2], pVF[2][2], pVB[2][2];
#pragma unroll
    for (int q = 0; q < 2; ++q) {
      const int sl = 2 * w + q;
#pragma unroll
      for (int s = 0; s < 4; ++s) {
        pSF[s][q] = *((const uint4*)PP->Sfrag + ((unit_f * 8 + sl) * 4 + s) * 64 + l);
        pSB[s][q] = *((const uint4*)PP->Sfrag + ((unit_b * 8 + sl) * 4 + s) * 64 + l);
      }
#pragma unroll
      for (int s2 = 0; s2 < 2; ++s2) {
        pVF[s2][q] = *((const uint4*)PP->Vfrag + ((unit_f * 8 + sl) * 2 + s2) * 64 + l);
        pVB[s2][q] = *((const uint4*)PP->Vfrag + ((unit_b * 8 + sl) * 2 + s2) * 64 + l);
      }
    }
    __syncthreads();
    for (int idx = tid; idx < 2048; idx += NTHR) {
      const int arr = idx >> 10, i = (idx >> 4) & 63, ch = idx & 15;
      const uint4 v = *(const uint4*)(PP->qkvn + (size_t)(tok0 + i) * 1536 + (arr == 0 ? 0 : 512) + hd * 128 + ch * 8);
      *(uint4*)((arr == 0 ? Qt : Kt) + i * 256 + ((ch ^ (i & 15)) << 4)) = v;
    }
    if (tid < 64) gcf[tid] = PP->gc[unit_f * 64 + tid];
    else if (tid < 128) gcb[tid - 64] = PP->gc[unit_b * 64 + (tid - 64)];
    __syncthreads();
    {
      f32x4 acc[4];
#pragma unroll
      for (int nt = 0; nt < 4; ++nt) acc[nt] = (f32x4){0.f, 0.f, 0.f, 0.f};
#pragma unroll
      for (int s = 0; s < 4; ++s) {
        const int ch = s * 4 + lg;
        const bf16x8 a = *(const bf16x8*)(Qt + (16 * w + lr) * 256 + ((ch ^ lr) << 4));
#pragma unroll
        for (int nt = 0; nt < 4; ++nt) {
          const bf16x8 bb = *(const bf16x8*)(Kt + (16 * nt + lr) * 256 + ((ch ^ lr) << 4));
          acc[nt] = __builtin_amdgcn_mfma_f32_16x16x32_bf16(a, bb, acc[nt], 0, 0, 0);
        }
      }
#pragma unroll
      for (int nt = 0; nt < 4; ++nt)
#pragma unroll
        for (int r = 0; r < 4; ++r) {
          const int i = 16 * w + 4 * lg + r, j = 16 * nt + lr;
          const float vf = (j <= i) ? acc[nt][r] * __expf(fminf(gcf[i] - gcf[j], 0.f)) : 0.f;
          const float vb = (j >= i) ? acc[nt][r] * __expf(fminf(gcb[63 - i] - gcb[63 - j], 0.f)) : 0.f;
          If[i * 72 + j] = f2bf(vf);
          Ib[i * 72 + (63 - j)] = f2bf(vb);
        }
    }
    __syncthreads();
    f32x4 accF[4][2], accB[4][2], accI[4][2];
#pragma unroll
    for (int mt = 0; mt < 4; ++mt)
#pragma unroll
      for (int q = 0; q < 2; ++q) {
        accF[mt][q] = (f32x4){0.f, 0.f, 0.f, 0.f};
        accB[mt][q] = (f32x4){0.f, 0.f, 0.f, 0.f};
        accI[mt][q] = (f32x4){0.f, 0.f, 0.f, 0.f};
      }
#pragma unroll
    for (int s = 0; s < 4; ++s) {
      bf16x8 qa[4];
#pragma unroll
      for (int mt = 0; mt < 4; ++mt) {
        const int row = 16 * mt + lr;
        const int c0 = 4 * s + (lg >> 1), c1 = c0 + 2;
        const uint2 lo = *(const uint2*)(Qt + row * 256 + ((c0 ^ lr) << 4) + (lg & 1) * 8);
        const uint2 hi = *(const uint2*)(Qt + row * 256 + ((c1 ^ lr) << 4) + (lg & 1) * 8);
        const uint4 t = make_uint4(lo.x, lo.y, hi.x, hi.y);
        qa[mt] = as_frag(t);
      }
#pragma unroll
      for (int q = 0; q < 2; ++q) {
        const int sl = 2 * w + q;
        const uint4 bF = pSF[s][q], bB = pSB[s][q];
#pragma unroll
        for (int mt = 0; mt < 4; ++mt) {
          accF[mt][q] = __builtin_amdgcn_mfma_f32_16x16x32_bf16(qa[mt], as_frag(bF), accF[mt][q], 0, 0, 0);
          accB[mt][q] = __builtin_amdgcn_mfma_f32_16x16x32_bf16(qa[mt], as_frag(bB), accB[mt][q], 0, 0, 0);
        }
      }
    }
#pragma unroll
    for (int s2 = 0; s2 < 2; ++s2) {
      bf16x8 ia[4], ib[4];
#pragma unroll
      for (int mt = 0; mt < 4; ++mt) {
        const int row = 16 * mt + lr;
        const int col = 32 * s2 + 4 * lg;
        const uint2 flo = *(const uint2*)(If + row * 72 + col);
        const uint2 fhi = *(const uint2*)(If + row * 72 + col + 16);
        const uint2 blo = *(const uint2*)(Ib + row * 72 + col);
        const uint2 bhi = *(const uint2*)(Ib + row * 72 + col + 16);
        const uint4 tf = make_uint4(flo.x, flo.y, fhi.x, fhi.y);
        const uint4 tb = make_uint4(blo.x, blo.y, bhi.x, bhi.y);
        ia[mt] = as_frag(tf);
        ib[mt] = as_frag(tb);
      }
#pragma unroll
      for (int q = 0; q < 2; ++q) {
        const int sl = 2 * w + q;
        const uint4 vF = pVF[s2][q], vB = pVB[s2][q];
#pragma unroll
        for (int mt = 0; mt < 4; ++mt) {
          accI[mt][q] = __builtin_amdgcn_mfma_f32_16x16x32_bf16(ia[mt], as_frag(vF), accI[mt][q], 0, 0, 0);
          accI[mt][q] = __builtin_amdgcn_mfma_f32_16x16x32_bf16(ib[mt], as_frag(vB), accI[mt][q], 0, 0, 0);
        }
      }
    }
    float o[4][2][4];
#pragma unroll
    for (int mt = 0; mt < 4; ++mt)
#pragma unroll
      for (int r = 0; r < 4; ++r) {
        const int i = 16 * mt + 4 * lg + r;
        const float ef = __expf(gcf[i]), eb = __expf(gcb[63 - i]);
        float ss = 0.f;
#pragma unroll
        for (int q = 0; q < 2; ++q) {
          const float v = ef * accF[mt][q][r] + eb * accB[mt][q][r] + accI[mt][q][r];
          o[mt][q][r] = v;
          ss += v * v;
        }
        ss = group16_sum(ss);
        if (lr == 0) rowss[w * 64 + i] = ss;
      }
    __syncthreads();
#pragma unroll
    for (int mt = 0; mt < 4; ++mt)
#pragma unroll
      for (int q = 0; q < 2; ++q)
#pragma unroll
        for (int r = 0; r < 4; ++r) Os[(16 * mt + 4 * lg + r) * 132 + 16 * (2 * w + q) + lr] = o[mt][q][r];
    __syncthreads();
#pragma unroll
    for (int q4 = 0; q4 < 4; ++q4) {
      const int idx = tid + 256 * q4, i = idx >> 4, ch = idx & 15;
      const float ss = rowss[i] + rowss[64 + i] + rowss[128 + i] + rowss[192 + i];
      const float rs = rsqrtf(ss * (1.f / 128.f) + EPS);
      const float4 o0 = *(const float4*)&Os[i * 132 + ch * 8];
      const float4 o1 = *(const float4*)&Os[i * 132 + ch * 8 + 4];
      const float4 n0 = *(const float4*)(PP->dn_out_norm + layer * 128 + ch * 8);
      const float4 n1 = *(const float4*)(PP->dn_out_norm + layer * 128 + ch * 8 + 4);
      float zf[8];
      unpack8(*(const uint4*)(PP->z + (size_t)(tok0 + i) * 512 + hd * 128 + ch * 8), zf);
      float y[8];
      y[0] = o0.x * rs * n0.x * siluf_(zf[0]); y[1] = o0.y * rs * n0.y * siluf_(zf[1]);
      y[2] = o0.z * rs * n0.z * siluf_(zf[2]); y[3] = o0.w * rs * n0.w * siluf_(zf[3]);
      y[4] = o1.x * rs * n1.x * siluf_(zf[4]); y[5] = o1.y * rs * n1.y * siluf_(zf[5]);
      y[6] = o1.z * rs * n1.z * siluf_(zf[6]); y[7] = o1.w * rs * n1.w * siluf_(zf[7]);
      {
        int p0 = __builtin_amdgcn_cvt_pk_fp8_f32(y[0], y[1], 0, false);
        p0 = __builtin_amdgcn_cvt_pk_fp8_f32(y[2], y[3], p0, true);
        int p1 = __builtin_amdgcn_cvt_pk_fp8_f32(y[4], y[5], 0, false);
        p1 = __builtin_amdgcn_cvt_pk_fp8_f32(y[6], y[7], p1, true);
        *(int2*)((char*)PP->ydn + (size_t)(tok0 + i) * (LDK5 * 2) + hd * 128 + ch * 8) = make_int2(p0, p1);
      }
    }
  }
}

template <int HALF>
DEV void pool_window(const u16* xin, char* Ap, int t0, int L, int tid) {
#pragma unroll
  for (int q = 0; q < 4; ++q) {
    const int idx = tid + 256 * q, i = idx >> 4, c = idx & 15;
    const int t = t0 + i;
    const int lo = (t - HALF) > 0 ? (t - HALF) : 0;
    const int hi = (t + HALF) < L ? (t + HALF) : L;
    float s[8];
#pragma unroll
    for (int e = 0; e < 8; ++e) s[e] = 0.f;
#pragma unroll
    for (int k = 0; k < 2 * HALF; ++k) {
      float f[8];
      unpack8(*(const uint4*)(xin + (i + 8 - HALF + k) * 128 + c * 8), f);
#pragma unroll
      for (int e = 0; e < 8; ++e) s[e] += f[e];
    }
    float xs[8];
    unpack8(*(const uint4*)(xin + (i + 8) * 128 + c * 8), xs);
    const float inv = 1.f / (float)(hi - lo);
#pragma unroll
    for (int e = 0; e < 8; ++e) s[e] = s[e] * inv - xs[e];
    *(uint4*)(Ap + i * 256 + ((c ^ (i & 15)) << 4)) = pack8(s);
  }
}

__device__ __forceinline__ void phase_pool(int layer, char* smem, int vbid, int vnb) {
  const KP PP = get_params();
  const int tid = TID(), l = tid & 63, w = tid >> 6, lr = l & 15, lg = l >> 4;
  u16* xin = (u16*)smem;
  char* Ap = smem + 20480;
  char* Bs = smem + 36864;
  const int ntile = (layer == DEPTH - 1) ? NLAT / 64 : R / 64;
  for (int it = vbid; it < ntile * 4; it += vnb) {
    const int ti = it >> 2, g = it & 3;
    int L, t0, rowbase;
    if (ti < NLAT / 64) { L = 64; t0 = 0; rowbase = ti * 64; }
    else { const int ci = ti - NLAT / 64; L = CTX; t0 = (ci & 3) * 64; rowbase = NLAT + (ci >> 2) * CTX; }
    const int r0 = rowbase + t0;
    __syncthreads();
#pragma unroll
    for (int q = 0; q < 5; ++q) {
      const int idx = tid + 256 * q, i = idx >> 4, c = idx & 15;
      const int pos = t0 - 8 + i;
      uint4 v = make_uint4(0, 0, 0, 0);
      if (pos >= 0 && pos < L) v = *(const uint4*)(PP->pin + (size_t)(rowbase + pos) * 512 + g * 128 + c * 8);
      *(uint4*)(xin + i * 128 + c * 8) = v;
    }
    {
      const u16* Bw = PP->PwT + (size_t)(layer * 4 + g) * 128 * 128;
#pragma unroll
      for (int q = 0; q < 8; ++q) {
        const int idx = tid + 256 * q, n = idx >> 4, c = idx & 15;
        *(uint4*)(Bs + n * 256 + ((c ^ (n & 15)) << 4)) = *(const uint4*)(Bw + (size_t)n * 128 + c * 8);
      }
    }
    __syncthreads();
    if (g == 0) pool_window<1>(xin, Ap, t0, L, tid);
    else if (g == 1) pool_window<2>(xin, Ap, t0, L, tid);
    else if (g == 2) pool_window<4>(xin, Ap, t0, L, tid);
    else pool_window<8>(xin, Ap, t0, L, tid);
    __syncthreads();
    f32x4 acc[8];
#pragma unroll
    for (int ni = 0; ni < 8; ++ni) acc[ni] = (f32x4){0.f, 0.f, 0.f, 0.f};
#pragma unroll
    for (int ks = 0; ks < 4; ++ks) {
      const int row = w * 16 + lr, c = ks * 4 + lg;
      const bf16x8 a = *(const bf16x8*)(Ap + row * 256 + ((c ^ lr) << 4));
#pragma unroll
      for (int ni = 0; ni < 8; ++ni) {
        const bf16x8 bb = *(const bf16x8*)(Bs + (ni * 16 + lr) * 256 + ((c ^ lr) << 4));
        acc[ni] = __builtin_amdgcn_mfma_f32_16x16x32_bf16(bb, a, acc[ni], 0, 0, 0);
      }
    }
    unsigned char* ot = (unsigned char*)smem;
#pragma unroll
    for (int ni = 0; ni < 8; ++ni) {
      const int dcol = ni * 16 + 4 * lg;
      const float4 psc = *(const float4*)(PP->pool_scale + layer * 512 + g * 128 + dcol);
      int pk = __builtin_amdgcn_cvt_pk_fp8_f32(acc[ni][0] * psc.x, acc[ni][1] * psc.y, 0, false);
      pk = __builtin_amdgcn_cvt_pk_fp8_f32(acc[ni][2] * psc.z, acc[ni][3] * psc.w, pk, true);
      *(int*)(ot + (w * 16 + lr) * 128 + dcol) = pk;
    }
    __syncthreads();
    {
      const int row = tid >> 2, seg = tid & 3;
      const uint4 o0 = *(const uint4*)(ot + row * 128 + seg * 32), o1 = *(const uint4*)(ot + row * 128 + seg * 32 + 16);
      unsigned char* dst = (unsigned char*)PP->ypool + (size_t)(r0 + row) * (LDK5 * 2) + g * 128 + seg * 32;
      *(uint4*)dst = o0;
      *(uint4*)(dst + 16) = o1;
    }
  }
}

__device__ __forceinline__ void phase_merge(int layer, char* smem) {
  const KP PP = get_params();
  const char* Bd = (const char*)(PP->WdT + (size_t)layer * 1024 * LDK5);
  const char* Bp = (const char*)(PP->WpT + (size_t)layer * 1024 * LDK5);
  const char* Ad = (const char*)PP->ydn;
  const char* Ap = (const char*)PP->ypool;
  const int tid = TID();
  const int l = tid & 63, w = tid >> 6, wm = w >> 1, wn = w & 1, lr = l & 15, lg = l >> 4;
  uint4 ga[4], gb[4];
#pragma unroll
  for (int i = 0; i < 4; ++i) { ga[i] = make_uint4(0u, 0u, 0u, 0u); gb[i] = ga[i]; }
  const int r0 = tid >> 3, c0 = tid & 7;
#define MG_GLOAD(AP, BP, KT_)                                                                  \
  _Pragma("unroll") for (int i = 0; i < 4; ++i) {                                              \
    ga[i] = *(const uint4*)((AP) + (size_t)(m0 + 32 * i + r0) * (LDK5 * 2) + c0 * 16 + (KT_) * 128);  \
    gb[i] = *(const uint4*)((BP) + (size_t)(n0 + 32 * i + r0) * LDK5 + c0 * 16 + (KT_) * 128);        \
  }
#define MG_LSTORE(BUF)                                                                         \
  {                                                                                            \
    char* as_ = smem + (BUF) * 32768;                                                          \
    char* bs_ = as_ + 16384;                                                                   \
    _Pragma("unroll") for (int i = 0; i < 4; ++i) {                                            \
      const int id = tid + 256 * i, row = id >> 3, c = id & 7;                                 \
      const int off = row * 128 + ((c ^ (row & 7)) << 4);                                      \
      *(uint4*)(as_ + off) = ga[i];                                                            \
      *(uint4*)(bs_ + off) = gb[i];                                                            \
    }                                                                                          \
  }
#define MG_COMPUTE(ACC, BUF)                                                                                              \
  {                                                                                                                       \
    const char* as_ = smem + (BUF) * 32768;                                                                               \
    const char* bs_ = as_ + 16384;                                                                                        \
    i32x8 a[4], b[4];                                                                                                     \
    const int sw0 = ((lg ^ (lr & 7)) << 4), sw1 = (((4 + lg) ^ (lr & 7)) << 4);                                           \
    _Pragma("unroll") for (int mi = 0; mi < 4; ++mi) {                                                                    \
      const char* p_ = as_ + (wm * 64 + mi * 16 + lr) * 128;                                                              \
      const i32x4 lo_ = *(const i32x4*)(p_ + sw0), hi_ = *(const i32x4*)(p_ + sw1);                                       \
      a[mi] = __builtin_shufflevector(lo_, hi_, 0, 1, 2, 3, 4, 5, 6, 7);                                                  \
    }                                                                                                                     \
    _Pragma("unroll") for (int ni = 0; ni < 4; ++ni) {                                                                    \
      const char* p_ = bs_ + (wn * 64 + ni * 16 + lr) * 128;                                                              \
      const i32x4 lo_ = *(const i32x4*)(p_ + sw0), hi_ = *(const i32x4*)(p_ + sw1);                                       \
      b[ni] = __builtin_shufflevector(lo_, hi_, 0, 1, 2, 3, 4, 5, 6, 7);                                                  \
    }                                                                                                                     \
    _Pragma("unroll") for (int mi = 0; mi < 4; ++mi)                                                                      \
      _Pragma("unroll") for (int ni = 0; ni < 4; ++ni)                                                                    \
        ACC[mi][ni] = __builtin_amdgcn_mfma_scale_f32_16x16x128_f8f6f4(a[mi], b[ni], ACC[mi][ni], 0, 0, 0, 0, 0, 0);      \
  }
  const int MT = (layer == DEPTH - 1) ? NLAT / 128 : R / 128;
  for (int it = 0;; ++it) {
    int mt, nt;
    if (!tile_map(it, MT, 8, mt, nt)) break;
    const int m0 = mt * 128, n0 = nt * 128;
    f32x4 acc[4][4];
    zero_acc(acc);
    __syncthreads();
    MG_GLOAD(Ad, Bd, 0);
    MG_LSTORE(0);
    __syncthreads();
#pragma unroll
    for (int kt = 0; kt < 4; ++kt) {
      if (kt + 1 < 4) { MG_GLOAD(Ad, Bd, kt + 1); } else { MG_GLOAD(Ap, Bp, 0); }
      MG_COMPUTE(acc, kt & 1);
      MG_LSTORE((kt + 1) & 1);
      __syncthreads();
    }
    uint2 tq[2][8];
#pragma unroll
    for (int hs = 0; hs < 2; ++hs)
#pragma unroll
      for (int j = 0; j < 8; ++j) tq[hs][j] = make_uint2(0u, 0u);
#pragma unroll
    for (int hs = 0; hs < 2; ++hs) {
      float4 v1[8];
      stage_half(acc, hs, smem + 32768, v1);
#pragma unroll
      for (int j = 0; j < 8; ++j) tq[hs][j] = make_uint2(pack_bf16(v1[j].x, v1[j].y), pack_bf16(v1[j].z, v1[j].w));
    }
    __builtin_amdgcn_sched_barrier(0);
    zero_acc(acc);
    __syncthreads();
#pragma unroll
    for (int kt = 0; kt < 4; ++kt) {
      if (kt + 1 < 4) { MG_GLOAD(Ap, Bp, kt + 1); }
      MG_COMPUTE(acc, kt & 1);
      if (kt + 1 < 4) { MG_LSTORE((kt + 1) & 1); }
      __syncthreads();
    }
#pragma unroll
    for (int hs = 0; hs < 2; ++hs) {
      float4 v2[8];
      stage_half(acc, hs, smem, v2);
      const int tid2 = TID();
#pragma unroll
      for (int j = 0; j < 8; ++j) {
        const int idx = tid2 + 256 * j, row = idx >> 5, c4 = idx & 31;
        const size_t gr = (size_t)(m0 + hs * 64 + row);
        const int gc = n0 + c4 * 4;
        const unsigned gd = *(const unsigned*)((const unsigned char*)PP->sgd + gr * 1024 + gc);
        const unsigned gp = *(const unsigned*)((const unsigned char*)PP->sgp + gr * 1024 + gc);
        const uint2 t = tq[hs][j];
        constexpr float GS = 1.f / (255.f * 32.f);
        const float o0 = ((float)(gd & 0xffu) * bf_lo(t.x) + (float)(gp & 0xffu) * v2[j].x) * GS;
        const float o1 = ((float)((gd >> 8) & 0xffu) * bf_hi(t.x) + (float)((gp >> 8) & 0xffu) * v2[j].y) * GS;
        const float o2 = ((float)((gd >> 16) & 0xffu) * bf_lo(t.y) + (float)((gp >> 16) & 0xffu) * v2[j].z) * GS;
        const float o3 = ((float)(gd >> 24) * bf_hi(t.y) + (float)(gp >> 24) * v2[j].w) * GS;
        int pk = __builtin_amdgcn_cvt_pk_fp8_f32(o0, o1, 0, false);
        pk = __builtin_amdgcn_cvt_pk_fp8_f32(o2, o3, pk, true);
        *(int*)((char*)PP->m + gr * (LDK1 * 2) + gc) = pk;
        if ((j & 1) == 1) __builtin_amdgcn_sched_barrier(0);
      }
    }
  }
#undef MG_GLOAD
#undef MG_LSTORE
#undef MG_COMPUTE
}

__device__ __forceinline__ void phase_outproj(int layer, char* smem) {
  const KP PP = get_params();
  const char* Bt = (const char*)(PP->WoT + (size_t)layer * 1024 * LDK1);
  const char* A = (const char*)PP->m;
  F8_LOCALS
  const int MT = (layer == DEPTH - 1) ? NLAT / 128 : R / 128;
  int it = 0, mt, nt;
  if (!tile_map(it, MT, 8, mt, nt)) return;
  int m0 = mt * 128, n0 = nt * 128;
  F8_PROLOGUE(A, LDK1 * 2, Bt, LDK1)
  for (;;) {
    int mtn = 0, ntn = 0;
    const bool hasn = tile_map(it + 1, MT, 8, mtn, ntn);
    const int m0n = mtn * 128, n0n = ntn * 128;
    f32x4 acc[4][4];
    zero_acc(acc);
    F8_KLOOP(A, LDK1 * 2, Bt, LDK1, 8)
#pragma unroll
    for (int mi = 0; mi < 4; ++mi) {
      const int gr = m0 + wm * 64 + mi * 16 + lr;
      const float* modp = PP->mod + (size_t)(layer * 3 + modsel(gr)) * 6144 + 2048;
      const float* xin;
      float* xo;
      if (gr < NLAT) {
        xin = (layer == 0 ? PP->x : PP->out) + (size_t)gr * 1024;
        xo = PP->out + (size_t)gr * 1024;
      } else {
        xin = (layer == 0 ? PP->ctx : PP->xc) + (size_t)(gr - NLAT) * 1024;
        xo = PP->xc + (size_t)(gr - NLAT) * 1024;
      }
#pragma unroll
      for (int g = 0; g < 2; ++g) {
        const int gc = n0 + wn * 64 + g * 32 + 8 * lg;
#pragma unroll
        for (int n = 0; n < 2; ++n) {
          const f32x4 t = acc[mi][2 * g + n] * (1.f / 32.f);
          const float4 gt = *(const float4*)(modp + gc + 4 * n);
          const float4 xi = *(const float4*)(xin + gc + 4 * n);
          *(float4*)(xo + gc + 4 * n) = make_float4(xi.x + gt.x * t[0], xi.y + gt.y * t[1], xi.z + gt.z * t[2], xi.w + gt.w * t[3]);
        }
      }
    }
    if (!hasn) break;
    m0 = m0n; n0 = n0n; ++it;
  }
}

DEV void gemm_mainloop_f8(const char* __restrict__ A, int lda, const char* __restrict__ B, int ldb, int KT, int m0, int n0,
                          char* smem, f32x4 (&acc)[4][4]) {
  const int tid = TID();
  const int l = tid & 63, w = tid >> 6, wm = w >> 1, wn = w & 1, lr = l & 15, lg = l >> 4;
  uint4 ga0[4], gb0[4], ga1[4], gb1[4];
#pragma unroll
  for (int i = 0; i < 4; ++i) { ga0[i] = make_uint4(0u, 0u, 0u, 0u); gb0[i] = ga0[i]; ga1[i] = ga0[i]; gb1[i] = ga0[i]; }
  const int r0 = tid >> 3, c0 = tid & 7;
#define Q8_GLOAD(GA, GB, KT_)                                                                  \
  _Pragma("unroll") for (int i = 0; i < 4; ++i) {                                              \
    GA[i] = *(const uint4*)(A + (size_t)(m0 + 32 * i + r0) * lda + c0 * 16 + (KT_) * 128);     \
    GB[i] = *(const uint4*)(B + (size_t)(n0 + 32 * i + r0) * ldb + c0 * 16 + (KT_) * 128);     \
  }
#define Q8_LSTORE(GA, GB, BUF)                                                                 \
  {                                                                                            \
    char* as_ = smem + (BUF) * 32768;                                                          \
    char* bs_ = as_ + 16384;                                                                   \
    _Pragma("unroll") for (int i = 0; i < 4; ++i) {                                            \
      const int id = tid + 256 * i, row = id >> 3, c = id & 7;                                 \
      const int off = row * 128 + ((c ^ (row & 7)) << 4);                                      \
      *(uint4*)(as_ + off) = GA[i];                                                            \
      *(uint4*)(bs_ + off) = GB[i];                                                            \
    }                                                                                          \
  }
#define Q8_COMPUTE(BUF)                                                                                                   \
  {                                                                                                                       \
    const char* as_ = smem + (BUF) * 32768;                                                                               \
    const char* bs_ = as_ + 16384;                                                                                        \
    i32x8 a[4], b[4];                                                                                                     \
    const int sw0 = ((lg ^ (lr & 7)) << 4), sw1 = (((4 + lg) ^ (lr & 7)) << 4);                                           \
    _Pragma("unroll") for (int mi = 0; mi < 4; ++mi) {                                                                    \
      const char* p_ = as_ + (wm * 64 + mi * 16 + lr) * 128;                                                              \
      const i32x4 lo_ = *(const i32x4*)(p_ + sw0), hi_ = *(const i32x4*)(p_ + sw1);                                       \
      a[mi] = __builtin_shufflevector(lo_, hi_, 0, 1, 2, 3, 4, 5, 6, 7);                                                  \
    }                                                                                                                     \
    _Pragma("unroll") for (int ni = 0; ni < 4; ++ni) {                                                                    \
      const char* p_ = bs_ + (wn * 64 + ni * 16 + lr) * 128;                                                              \
      const i32x4 lo_ = *(const i32x4*)(p_ + sw0), hi_ = *(const i32x4*)(p_ + sw1);                                       \
      b[ni] = __builtin_shufflevector(lo_, hi_, 0, 1, 2, 3, 4, 5, 6, 7);                                                  \
    }                                                                                                                     \
    _Pragma("unroll") for (int mi = 0; mi < 4; ++mi)                                                                      \
      _Pragma("unroll") for (int ni = 0; ni < 4; ++ni)                                                                    \
        acc[mi][ni] = __builtin_amdgcn_mfma_scale_f32_16x16x128_f8f6f4(a[mi], b[ni], acc[mi][ni], 0, 0, 0, 0, 0, 0);      \
  }
  __syncthreads();
  Q8_GLOAD(ga0, gb0, 0);
  Q8_GLOAD(ga1, gb1, 1);
  Q8_LSTORE(ga0, gb0, 0);
  __syncthreads();
  for (int kt = 0; kt < KT; kt += 2) {
    if (kt + 2 < KT) { Q8_GLOAD(ga0, gb0, kt + 2); }
    Q8_COMPUTE(0);
    Q8_LSTORE(ga1, gb1, 1);
    __syncthreads();
    if (kt + 3 < KT) { Q8_GLOAD(ga1, gb1, kt + 3); }
    Q8_COMPUTE(1);
    if (kt + 2 < KT) { Q8_LSTORE(ga0, gb0, 0); }
    __syncthreads();
  }
#undef Q8_GLOAD
#undef Q8_LSTORE
#undef Q8_COMPUTE
}

__device__ __forceinline__ void phase_peerq(int layer, char* smem) {
  const KP PP = get_params();
  const char* Bt = (const char*)PP->WkT + (size_t)layer * 2048 * LDK1;
  const int tid = TID();
  const int l = tid & 63, w = tid >> 6, wm = w >> 1, wn = w & 1, lr = l & 15, lg = l >> 4;
  const int MT = (layer == DEPTH - 1) ? NLAT / 128 : R / 128;
  for (int it = 0;; ++it) {
    int mt, nt;
    if (!tile_map(it, MT, 16, mt, nt)) break;
    const int m0 = mt * 128, n0 = nt * 128;
    f32x4 sc[4][4];
    zero_acc(sc);
    gemm_mainloop_f8((const char*)PP->h8, LDK1, Bt, LDK1, 8, m0, n0, smem, sc);
    __syncthreads();
    float* Sc = (float*)smem;
#pragma unroll
    for (int mi = 0; mi < 4; ++mi)
#pragma unroll
      for (int ni = 0; ni < 4; ++ni)
#pragma unroll
        for (int r = 0; r < 4; ++r) Sc[(wm * 64 + mi * 16 + lg * 4 + r) * 129 + wn * 64 + ni * 16 + lr] = sc[mi][ni][r] * (1.f / 32.f);
    __syncthreads();
    {
      const int row = tid >> 1, half = tid & 1;
      const float* rowp = Sc + row * 129;
      unsigned key[64];
#pragma unroll
      for (int i = 0; i < 64; ++i) {
        unsigned u = __float_as_uint(rowp[half * 64 + i]);
        u = (u & 0x80000000u) ? ~u : (u | 0x80000000u);
        key[i] = (u & ~127u) | (unsigned)(127 - (half * 64 + i));
      }
#define CMPX(X, Y, DESC) { const unsigned hi_ = (X) > (Y) ? (X) : (Y), lo_ = (X) > (Y) ? (Y) : (X); X = (DESC) ? hi_ : lo_; Y = (DESC) ? lo_ : hi_; }
#pragma unroll
      for (int g0 = 0; g0 < 64; g0 += 16) {
#pragma unroll
        for (int k = 2; k <= 16; k <<= 1)
#pragma unroll
          for (int j = k >> 1; j > 0; j >>= 1)
#pragma unroll
            for (int i = 0; i < 16; ++i) {
              const int l2 = i ^ j;
              if (l2 > i) CMPX(key[g0 + i], key[g0 + l2], ((i & k) == 0));
            }
      }
#define TOPMERGE(AOFF, BOFF)                                                                         \
  {                                                                                                  \
    _Pragma("unroll") for (int i = 0; i < 16; ++i)                                                   \
      key[(AOFF) + i] = key[(AOFF) + i] > key[(BOFF) + 15 - i] ? key[(AOFF) + i] : key[(BOFF) + 15 - i]; \
    _Pragma("unroll") for (int j = 8; j > 0; j >>= 1)                                                \
      _Pragma("unroll") for (int i = 0; i < 16; ++i) {                                               \
        const int l2 = i ^ j;                                                                        \
        if (l2 > i) CMPX(key[(AOFF) + i], key[(AOFF) + l2], true);                                   \
      }                                                                                              \
  }
      TOPMERGE(0, 16);
      TOPMERGE(32, 48);
      TOPMERGE(0, 32);
      {
        unsigned oth[16];
#pragma unroll
        for (int i = 0; i < 16; ++i) oth[i] = swz_xor_u<1>(key[i]);
#pragma unroll
        for (int i = 0; i < 16; ++i) key[i] = key[i] > oth[15 - i] ? key[i] : oth[15 - i];
#pragma unroll
        for (int j = 8; j > 0; j >>= 1)
#pragma unroll
          for (int i = 0; i < 16; ++i) {
            const int l2 = i ^ j;
            if (l2 > i) CMPX(key[i], key[l2], true);
          }
      }
#undef TOPMERGE
#undef CMPX
      unsigned res[16];
#pragma unroll
      for (int j = 0; j < 16; ++j) {
        const int idx = 127 - (int)(key[j] & 127u);
        res[j] = half ? (unsigned)idx : __float_as_uint(rowp[idx]);
      }
      const size_t ob = ((size_t)(m0 + row) * 16 + nt) * 16;
      uint4* dst = half ? (uint4*)(PP->topI + ob) : (uint4*)(PP->topS + ob);
      dst[0] = make_uint4(res[0], res[1], res[2], res[3]);
      dst[1] = make_uint4(res[4], res[5], res[6], res[7]);
      dst[2] = make_uint4(res[8], res[9], res[10], res[11]);
      dst[3] = make_uint4(res[12], res[13], res[14], res[15]);
    }
  }
}

DEV void pair_of_lane(int l, int& a, int& b) {
  if (l < 16) { a = 0; b = l; }
  else if (l < 24) { a = 1; b = l - 16; }
  else if (l < 29) { a = 2; b = l - 24; }
  else if (l < 33) { a = 3; b = l - 29; }
  else if (l < 36) { a = 4; b = l - 33; }
  else if (l < 38) { a = 5; b = l - 36; }
  else if (l < 40) { a = 6; b = l - 38; }
  else if (l < 42) { a = 7; b = l - 40; }
  else if (l < 50) { a = l - 34; b = 0; }
  else { a = 0; b = 0; }
}

DEV float peer_butterfly(const float (&part)[8], int lane) {
  const bool h32 = (lane & 32) != 0, h16 = (lane & 16) != 0, h8 = (lane & 8) != 0;
  const int a32 = (lane ^ 32) << 2;
  float q4[4], q2[2];
#pragma unroll
  for (int i = 0; i < 4; ++i) {
    const float keep = h32 ? part[i + 4] : part[i], send = h32 ? part[i] : part[i + 4];
    q4[i] = keep + __builtin_bit_cast(float, __builtin_amdgcn_ds_bpermute(a32, __builtin_bit_cast(int, send)));
  }
#pragma unroll
  for (int i = 0; i < 2; ++i) {
    const float keep = h16 ? q4[i + 2] : q4[i], send = h16 ? q4[i] : q4[i + 2];
    q2[i] = keep + swz_xor<16>(send);
  }
  const float keep = h8 ? q2[1] : q2[0], send = h8 ? q2[0] : q2[1];
  float q1 = keep + swz_xor<8>(send);
  q1 += swz_xor<4>(q1);
  q1 += swz_xor<2>(q1);
  q1 += swz_xor<1>(q1);
  return q1;
}

__device__ __forceinline__ void phase_peer(int layer, char* smem) {
  const KP PP = get_params();
  const int tid = TID(), lane = tid & 63, wv = tid >> 6;
  const int gw = BID() * 4 + wv, nw = gridDim.x * 4;
  int* elist = (int*)(smem + wv * 2048);
  float* glist = (float*)(elist + 128);
  const bool last = (layer == DEPTH - 1);
  const int rlim = last ? NLAT : R;
  int pa, pb;
  pair_of_lane(lane, pa, pb);
  for (int r = gw; r < rlim; r += nw) {
    f32x2 hp[8];
#pragma unroll
    for (int i = 0; i < 4; ++i) {
      const uint2 hv = *(const uint2*)(PP->h + (size_t)r * LDK1 + 4 * lane + 256 * i);
      hp[2 * i] = (f32x2){bf_lo(hv.x), bf_hi(hv.x)};
      hp[2 * i + 1] = (f32x2){bf_lo(hv.y), bf_hi(hv.y)};
    }
#ifndef PEER_REP
#define PEER_REP 1
#endif
    f32x2 out[8];
#pragma unroll
    for (int i = 0; i < 8; ++i) out[i] = (f32x2){0.f, 0.f};
#pragma nounroll
    for (int rep_ = 0; rep_ < PEER_REP; ++rep_) {
    float sreg[8];
    int ireg[8];
#pragma unroll
    for (int hh = 0; hh < 8; ++hh) {
      const size_t o = (size_t)r * 256 + hh * 32 + (lane & 31);
      sreg[hh] = PP->topS[o];
      ireg[hh] = PP->topI[o];
    }
#pragma unroll 2
    for (int hh = 0; hh < 8; ++hh) {
      float cs = __builtin_bit_cast(float, __builtin_amdgcn_ds_bpermute(pa << 2, __builtin_bit_cast(int, sreg[hh]))) +
                 __builtin_bit_cast(float, __builtin_amdgcn_ds_bpermute((16 + pb) << 2, __builtin_bit_cast(int, sreg[hh])));
      const int e = __builtin_amdgcn_ds_bpermute(pa << 2, ireg[hh]) * 128 + __builtin_amdgcn_ds_bpermute((16 + pb) << 2, ireg[hh]);
      if (lane >= 50) cs = -__builtin_inff();
      unsigned ku = __float_as_uint(cs);
      ku = (ku & 0x80000000u) ? ~ku : (ku | 0x80000000u);
      ku = (ku & ~63u) | (unsigned)(63 - lane);
      int rank = 0;
#pragma unroll
      for (int l2 = 0; l2 < 50; ++l2) {
        const unsigned kv = (unsigned)__builtin_amdgcn_readlane((int)ku, l2);
        rank += (kv > ku) ? 1 : 0;
      }
      const bool sel = (lane < 50) && (rank < 16);
      const float mx = __builtin_bit_cast(float, __builtin_amdgcn_readlane(__builtin_bit_cast(int, cs), 0));
      const float ex = sel ? __expf(cs - mx) : 0.f;
      const float sum = wave_sum(ex);
      const unsigned long long mask = __ballot(sel);
      if (sel) {
        const int pos = __builtin_popcountll(mask & ((1ull << lane) - 1ull));
        elist[hh * 16 + pos] = e;
        glist[hh * 16 + pos] = ex / sum;
      }
    }
    __builtin_amdgcn_wave_barrier();
    asm volatile("s_waitcnt lgkmcnt(0)" ::: "memory");
    for (int k0 = 0; k0 < 128; k0 += 8) {
      U3 ua[8], va[8];
#pragma unroll
      for (int b = 0; b < 8; ++b) {
        const int ek = __builtin_amdgcn_readfirstlane(elist[k0 + b]);
        ua[b] = *(const U3*)(PP->tab8U + (size_t)ek * TROW + lane * 12);
        va[b] = *(const U3*)(PP->tab8V + (size_t)ek * TROW + lane * 12);
      }
      const int eb = elist[k0 + (lane >> 3)];
      const float scu = PP->scU[eb], scv = PP->scV[eb];
      float part[8];
#pragma unroll
      for (int b = 0; b < 8; b += 2) {
        const u32x6_t s6 = {ua[b].a, ua[b].b, ua[b].c, ua[b + 1].a, ua[b + 1].b, ua[b + 1].c};
        const f32x32_t uf = __builtin_amdgcn_cvt_scalef32_pk32_f32_fp6(s6, 1.0f);
        f32x2 d0 = (f32x2){uf[0], uf[1]} * hp[0];
        f32x2 d1 = (f32x2){uf[16], uf[17]} * hp[0];
#pragma unroll
        for (int p = 1; p < 8; ++p) {
          d0 += (f32x2){uf[2 * p], uf[2 * p + 1]} * hp[p];
          d1 += (f32x2){uf[16 + 2 * p], uf[17 + 2 * p]} * hp[p];
        }
        part[b] = d0[0] + d0[1];
        part[b + 1] = d1[0] + d1[1];
      }
      float q1 = peer_butterfly(part, lane);
      q1 *= scu;
      const float act = scv * glist[k0 + (lane >> 3)] * 0.5f * q1 * (1.f + erff(q1 * 0.7071067811865475f));
#pragma unroll
      for (int b = 0; b < 8; b += 2) {
        const float ab0 = __builtin_bit_cast(float, __builtin_amdgcn_readlane(__builtin_bit_cast(int, act), b * 8));
        const float ab1 = __builtin_bit_cast(float, __builtin_amdgcn_readlane(__builtin_bit_cast(int, act), b * 8 + 8));
        const f32x2 a0 = {ab0, ab0}, a1 = {ab1, ab1};
        const u32x6_t s6 = {va[b].a, va[b].b, va[b].c, va[b + 1].a, va[b + 1].b, va[b + 1].c};
        const f32x32_t vf = __builtin_amdgcn_cvt_scalef32_pk32_f32_fp6(s6, 1.0f);
#pragma unroll
        for (int p = 0; p < 8; ++p) {
          out[p] += a0 * (f32x2){vf[2 * p], vf[2 * p + 1]};
          out[p] += a1 * (f32x2){vf[16 + 2 * p], vf[17 + 2 * p]};
        }
      }
    }
    __builtin_amdgcn_wave_barrier();
    }
    if (PEER_REP > 1) {
#pragma unroll
      for (int i = 0; i < 8; ++i) out[i] *= (1.f / PEER_REP);
    }
    const float* md = PP->mod + (size_t)(layer * 3 + modsel(r)) * 6144 + 5 * 1024;
    float* xr = (r < NLAT) ? PP->out + (size_t)r * 1024 : PP->xc + (size_t)(r - NLAT) * 1024;
    float4 x2[4];
    float ss = 0.f;
#pragma unroll
    for (int i = 0; i < 4; ++i) {
      const int col = 4 * lane + 256 * i;
      const float4 xa = *(const float4*)(xr + col);
      const float4 ga = *(const float4*)(md + col);
      x2[i] = make_float4(xa.x + ga.x * out[2 * i][0], xa.y + ga.y * out[2 * i][1], xa.z + ga.z * out[2 * i + 1][0],
                          xa.w + ga.w * out[2 * i + 1][1]);
      ss += x2[i].x * x2[i].x + x2[i].y * x2[i].y + x2[i].z * x2[i].z + x2[i].w * x2[i].w;
    }
    if (last) {
      ss = wave_sum(ss);
      const float rs = rsqrtf(ss * (1.f / 1024.f) + EPS);
#pragma unroll
      for (int i = 0; i < 4; ++i) {
        const float4 fa = *(const float4*)(PP->final_norm + 4 * lane + 256 * i);
        x2[i] = make_float4(x2[i].x * rs * fa.x, x2[i].y * rs * fa.y, x2[i].z * rs * fa.z, x2[i].w * rs * fa.w);
      }
    }
#pragma unroll
    for (int i = 0; i < 4; ++i) *(float4*)(xr + 4 * lane + 256 * i) = x2[i];
    if (!last) {
      ss = wave_sum(ss);
      const float rs = rsqrtf(ss * (1.f / 1024.f) + EPS);
      const float* nwt = PP->norm_mix + (layer + 1) * 1024;
      const float* md1 = PP->mod + (size_t)((layer + 1) * 3 + modsel(r)) * 6144;
#pragma unroll
      for (int i = 0; i < 4; ++i) {
        const int col = 4 * lane + 256 * i;
        const float4 wv = *(const float4*)(nwt + col);
        const float4 sh = *(const float4*)(md1 + col);
        const float4 sc = *(const float4*)(md1 + 1024 + col);
        const float y0 = x2[i].x * rs * wv.x * (1.f + sc.x) + sh.x;
        const float y1 = x2[i].y * rs * wv.y * (1.f + sc.y) + sh.y;
        const float y2 = x2[i].z * rs * wv.z * (1.f + sc.z) + sh.z;
        const float y3 = x2[i].w * rs * wv.w * (1.f + sc.w) + sh.w;
        int pk = __builtin_amdgcn_cvt_pk_fp8_f32(y0, y1, 0, false);
        pk = __builtin_amdgcn_cvt_pk_fp8_f32(y2, y3, pk, true);
        *(int*)((char*)PP->h + (size_t)r * (LDK1 * 2) + col) = pk;
      }
    }
  }
}

namespace cg = cooperative_groups;

#define XB_TMO      128
#define XB_XCNT(j)  (256  + 64 * (j))
#define XB_XSUB(j)  (1280 + 64 * (j))
#define XB_XGEN(j)  (2304 + 64 * (j))
#define XB_TOP      3328
#define XB_TOPGEN   3392
#define XCD_BAR_WORDS 3456
#define XB_SPIN_CAP (1u << 22)
#define LAS __attribute__((address_space(3)))
DEV unsigned xb_ld(unsigned* q) { return __hip_atomic_load(q, __ATOMIC_RELAXED, __HIP_MEMORY_SCOPE_AGENT); }
DEV unsigned xb_add(unsigned* q, unsigned v) { return __hip_atomic_fetch_add(q, v, __ATOMIC_RELAXED, __HIP_MEMORY_SCOPE_AGENT); }
DEV unsigned xb_xcc_id() { return (unsigned)__builtin_amdgcn_s_getreg((3 << 11) | 20) & 0xFu; }
#define XB_SPIN(cond, bar) do { unsigned _sp = 0; while (cond) { __builtin_amdgcn_s_sleep(1); \
    if ((++_sp & 255u) == 0u) { if (xb_ld(&(bar)[XB_TMO])) break; if (_sp > XB_SPIN_CAP) { atomicAdd(&(bar)[XB_TMO], 1u); break; } } } } while (0)
struct XcdBarrier { unsigned* bar; unsigned x; volatile LAS unsigned* st; };
DEV XcdBarrier xcd_barrier_post(unsigned* bar, volatile LAS unsigned* st) {
  XcdBarrier b; b.bar = bar; b.x = xb_xcc_id(); b.st = st;
  if (__builtin_amdgcn_workitem_id_x() == 0) (void)xb_add(&bar[XB_XCNT(b.x)], 1u);
  return b;
}
DEV void xcd_barrier_complete(unsigned* bar, unsigned x, unsigned& nloc, unsigned& nx) {
  const unsigned G = gridDim.x * gridDim.y * gridDim.z;
  unsigned sum, cnt, mine, sp = 0u;
  for (;;) {
    sum = 0u; cnt = 0u; mine = 0u;
#pragma unroll
    for (unsigned j = 0; j < 16; ++j) { const unsigned c = xb_ld(&bar[XB_XCNT(j)]); sum += c; cnt += (c > 0u) ? 1u : 0u; mine = (j == x) ? c : mine; }
    if (sum == G) break;
    __builtin_amdgcn_s_sleep(1);
    if ((++sp & 255u) == 0u) { if (xb_ld(&bar[XB_TMO])) break; if (sp > XB_SPIN_CAP) { atomicAdd(&bar[XB_TMO], 1u); break; } }
  }
  nloc = mine > 0u ? mine : 1u; nx = cnt > 0u ? cnt : 1u;
}
DEV void xcd_barrier(const XcdBarrier& b) {
  asm volatile("s_waitcnt vmcnt(0)" ::: "memory");
  __syncthreads();
  if (__builtin_amdgcn_workitem_id_x() == 0) {
    unsigned* bar = b.bar;
    __builtin_amdgcn_s_waitcnt(0);
    unsigned nloc = b.st[0], nx = b.st[1];
    if (nloc == 0u) { xcd_barrier_complete(bar, b.x, nloc, nx); b.st[0] = nloc; b.st[1] = nx; }
    const unsigned old = xb_add(&bar[XB_XSUB(b.x)], 1u);
    const unsigned gen = old / nloc;
    if (old + 1u == (gen + 1u) * nloc) {
      __builtin_amdgcn_fence(__ATOMIC_RELEASE, "agent");
      asm volatile("s_waitcnt vmcnt(0)" ::: "memory");
      const unsigned og = xb_add(&bar[XB_TOP], 1u);
      const unsigned tg = og / nx;
      if (og + 1u == (tg + 1u) * nx) xb_add(&bar[XB_TOPGEN], 1u);
      else XB_SPIN(xb_ld(&bar[XB_TOPGEN]) == tg, bar);
      __builtin_amdgcn_fence(__ATOMIC_ACQUIRE, "agent");
      xb_add(&bar[XB_XGEN(b.x)], 1u);
      asm volatile("s_waitcnt vmcnt(0)" ::: "memory");
    } else {
      XB_SPIN(xb_ld(&bar[XB_XGEN(b.x)]) == gen, bar);
      __builtin_amdgcn_fence(__ATOMIC_ACQUIRE, "agent");
      asm volatile("s_waitcnt vmcnt(0)" ::: "memory");
    }
  }
  __syncthreads();
}

#define GRID_SYNC() do { XcdBarrier xb_; xb_.bar = get_params()->bar; xb_.x = xb_xcc_id(); xb_.st = (volatile LAS unsigned*)&xb_words; xcd_barrier(xb_); } while (0)

__global__ void __launch_bounds__(NTHR, 2) megakernel(Params p) {
  __shared__ __attribute__((aligned(16))) char smem[SMEM_BYTES];
  __shared__ uint4 xb_words;
  if (__builtin_amdgcn_workitem_id_x() == 0) xb_words = make_uint4(0u, 0u, 0u, 0u);
  __syncthreads();
  (void)xcd_barrier_post(get_params()->bar, (volatile LAS unsigned*)&xb_words);
#ifndef PM
#define PM 0xFFFF
#endif
#ifndef DUP
#define DUP 0
#endif
  if (PM & 1) phase_init(smem);
  if (DUP & 1) phase_init(smem);
  GRID_SYNC();
  for (int layer = 0; layer < DEPTH; ++layer) {
    if (layer == 0) {
      if (PM & 2) phase_norm(layer, 1);
      if (DUP & 2) phase_norm(layer, 1);
      GRID_SYNC();
    }
    if (PM & 4) phase_gemm_win(layer, smem);
    if (DUP & 4) phase_gemm_win(layer, smem);
    GRID_SYNC();
#ifndef PREP_REP
#define PREP_REP 1
#endif
#pragma nounroll
    for (int rep_ = 0; rep_ < PREP_REP; ++rep_) phase_prep(layer, smem);
    GRID_SYNC();
    {
      const int nb_ = gridDim.x;
      if (BID() < 128) { if (PM & 64) phase_scan(smem); }
      else {
        if (PM & 16) phase_pool(layer, smem, BID() - 128, nb_ - 128);
        if (PM & 256) phase_tables(layer, BID() - 128, nb_ - 128);
      }
    }
    GRID_SYNC();
    if (PM & 128) phase_o(layer, smem);
    if (DUP & 128) phase_o(layer, smem);
    GRID_SYNC();
    if (PM & 512) phase_merge(layer, smem);
    if (DUP & 512) phase_merge(layer, smem);
    GRID_SYNC();
    if (PM & 1024) phase_outproj(layer, smem);
    GRID_SYNC();
    if (PM & 2048) phase_norm(layer, 2);
    if (DUP & 2048) phase_norm(layer, 2);
    GRID_SYNC();
    if (PM & 4096) phase_peerq(layer, smem);
    if (DUP & 4096) phase_peerq(layer, smem);
    GRID_SYNC();
    if (PM & 8192) phase_peer(layer, smem);
    if (layer + 1 < DEPTH) GRID_SYNC();
  }
}

static inline size_t align_up(size_t v, size_t a) { return (v + a - 1) / a * a; }

extern "C" void kernel_launch(void* const* d_in, const int* in_sizes, int n_in, void* d_out, int out_size, void* d_ws,
                              size_t ws_size, hipStream_t stream) {
  Params p{};
  p.x = (const float*)d_in[0]; p.c = (const float*)d_in[1]; p.ctx = (const float*)d_in[2]; p.c_ctx = (const float*)d_in[3];
  p.w_mod = (const float*)d_in[4]; p.b_mod = (const float*)d_in[5]; p.norm_mix = (const float*)d_in[6]; p.w_in = (const float*)d_in[7];
  p.conv_w = (const float*)d_in[8]; p.a_log = (const float*)d_in[9]; p.dt_bias = (const float*)d_in[10];
  p.dn_out_norm = (const float*)d_in[11]; p.pool_w = (const float*)d_in[12]; p.pool_scale = (const float*)d_in[13];
  p.w_up_dn = (const float*)d_in[14]; p.w_up_pool = (const float*)d_in[15]; p.w_out = (const float*)d_in[16];
  p.norm_ffn = (const float*)d_in[17]; p.peer_wq = (const float*)d_in[18]; p.peer_keys = (const float*)d_in[19];
  p.peer_u = (const float*)d_in[20]; p.peer_v = (const float*)d_in[21]; p.final_norm = (const float*)d_in[22];
  p.out = (float*)d_out;

  char* ws = (char*)d_ws;
  size_t off = 0;
  auto take = [&](size_t bytes) { char* q = ws + off; off = align_up(off + bytes, 256); return q; };
  p.tab8U = (unsigned char*)take((size_t)NEXP * 1024);
  p.tab8V = (unsigned char*)take((size_t)NEXP * 1024);
  p.scU = (float*)take((size_t)NEXP * 4);
  p.scV = (float*)take((size_t)NEXP * 4);
  p.WinT = (u16*)take((size_t)DEPTH * NPAD * LDK1 * 2);
  p.WdT = (u16*)take((size_t)DEPTH * 1024 * LDK5 * 2);
  p.WpT = (u16*)take((size_t)DEPTH * 1024 * LDK5 * 2);
  p.WoT = (u16*)take((size_t)DEPTH * 1024 * LDK1 * 2);
  p.WkT = (u16*)take((size_t)DEPTH * 2048 * LDK1 * 2);
  p.PwT = (u16*)take((size_t)DEPTH * 4 * 128 * 128 * 2);
  p.mod = (float*)take((size_t)DEPTH * 3 * 6144 * 4);
  p.xc = (float*)take((size_t)NCTX * 1024 * 4);
  p.h = (u16*)take((size_t)R * LDK1 * 2);
  p.h8 = (unsigned char*)take((size_t)R * LDK1);
  p.m = p.h;
  p.qkv_pre = (u16*)take((size_t)R * 1536 * 2);
  p.Vfrag = p.qkv_pre;
  p.z = (u16*)take((size_t)R * 512 * 2);
  p.pin = (u16*)take((size_t)R * 512 * 2);
  p.sgd = (u16*)take((size_t)R * 1024 * 2);
  p.sgp = (u16*)take((size_t)R * 1024 * 2);
  p.ba = (float*)take((size_t)R * 16 * 4);
  p.qkvn = (u16*)take((size_t)R * 1536 * 2);
  p.bg = (float*)take((size_t)R * 16 * 4);
  p.Wfrag = (u16*)take((size_t)NUNIT * 16384);
  p.KdT = (u16*)take((size_t)NUNIT * 16384);
  p.Ufrag = (u16*)take((size_t)NUNIT * 16384);
  p.ydn = p.Ufrag;
  p.Sfrag = (u16*)take((size_t)NUNIT * 32768);
  p.gc = (float*)take((size_t)NUNIT * 64 * 4);
  p.glast = (float*)take((size_t)NUNIT * 4);
  p.ypool = (u16*)take((size_t)R * LDK5 * 2);
  p.bar = (unsigned*)take((size_t)XCD_BAR_WORDS * 4);
  p.topS = (float*)p.qkvn;
  p.topI = (int*)((char*)p.qkvn + (size_t)R * 256 * 4);
  const bool alias_ok = ((size_t)R * 256 * 8 <= (size_t)R * 1536 * 2) && ((size_t)NUNIT * 16384 <= (size_t)R * 1536 * 2) &&
                        ((size_t)R * LDK5 * 2 <= (size_t)NUNIT * 16384);
  if (off > ws_size || !alias_ok) {
    fprintf(stderr, "workspace too small: need %zu have %zu (alias_ok=%d)\n", off, ws_size, (int)alias_ok);
    return;
  }
  static int grid_blocks = 0;
  if (!grid_blocks) {
    int dev = 0, cus = 0, per_cu = 0;
    (void)hipGetDevice(&dev);
    (void)hipDeviceGetAttribute(&cus, hipDeviceAttributeMultiprocessorCount, dev);
    (void)hipOccupancyMaxActiveBlocksPerMultiprocessor(&per_cu, megakernel, NTHR, 0);
    if (per_cu > 2) per_cu = 2;
    if (per_cu < 1) per_cu = 1;
    grid_blocks = cus * per_cu;
    grid_blocks -= grid_blocks % 8;
  }
  if (grid_blocks < 8) { fprintf(stderr, "bad grid %d\n", grid_blocks); return; }
  (void)hipMemsetAsync(p.bar, 0, (size_t)XCD_BAR_WORDS * 4, stream);
  void* args[] = {&p};
  hipError_t e = hipLaunchCooperativeKernel((void*)megakernel, dim3(grid_blocks), dim3(NTHR), args, 0, stream);
  if (e != hipSuccess) fprintf(stderr, "cooperative launch failed: %s (grid %d)\n", hipGetErrorString(e), grid_blocks);
}
```

```cpp
#include <hip/hip_runtime.h>
#include <hip/hip_cooperative_groups.h>
#include <stdint.h>
#include <stdio.h>

typedef unsigned short u16;
typedef __attribute__((ext_vector_type(8))) short bf16x8;
typedef __attribute__((ext_vector_type(4))) float f32x4;
typedef __attribute__((ext_vector_type(2))) float f32x2;
typedef __attribute__((ext_vector_type(2))) __bf16 bf16x2_t;

#define DEV __device__ __forceinline__

constexpr int D = 1024;
constexpr int BATCH = 2;
constexpr int SEQ = 8192;
constexpr int DEPTH = 2;
constexpr int CTX = 256;
constexpr int NLAT = BATCH * SEQ;
constexpr int NCTX = BATCH * CTX;
constexpr int R = NLAT + NCTX;
constexpr int DNH = 4;
constexpr int DK = 128;
constexpr int DNW = 512;
constexpr int INC = 4624;
constexpr int NPAD = 4736;
constexpr int NEXP = 16384;
constexpr float EPS = 1e-6f;
constexpr int NTHR = 256;
constexpr int LDK1 = 1088;
constexpr int LDK5 = 576;
constexpr int SMEM_BYTES = 73728;

struct Params {
  const float *x, *c, *ctx, *c_ctx, *w_mod, *b_mod, *norm_mix, *w_in, *conv_w, *a_log, *dt_bias, *dn_out_norm,
      *pool_w, *pool_scale, *w_up_dn, *w_up_pool, *w_out, *norm_ffn, *peer_wq, *peer_keys, *peer_u, *peer_v, *final_norm;
  float* out;
  unsigned char *tab8U, *tab8V;
  float *scU, *scV;
  u16 *WinT, *WdT, *WpT, *WoT, *WkT, *PwT;
  float *mod, *xc;
  u16 *h, *qkv_pre, *z, *pin, *sgd, *sgp;
  unsigned char* h8;
  float* ba;
  u16* qkvn;
  float* bg;
  u16 *Wfrag, *KdT, *Ufrag, *Sfrag, *Vfrag;
  float *gc, *glast;
  u16 *ydn, *ypool, *m;
  float* topS;
  int* topI;
  unsigned* bar;
};

typedef const __attribute__((address_space(4))) Params* KP;
DEV KP get_params() {
  KP k = (KP)__builtin_amdgcn_kernarg_segment_ptr();
  asm volatile("" : "+s"(k));
  return k;
}
DEV int TID() { int t = __builtin_amdgcn_workitem_id_x(); asm volatile("" : "+v"(t)); return t; }
DEV int BID() { int t = __builtin_amdgcn_workgroup_id_x(); asm volatile("" : "+s"(t)); return t; }
DEV unsigned pack_bf16(float a, float b) {
  f32x2 v = {a, b};
  bf16x2_t r = __builtin_convertvector(v, bf16x2_t);
  return *(unsigned*)&r;
}
DEV u16 f2bf(float a) { return (u16)(pack_bf16(a, 0.f) & 0xffffu); }
DEV float bf_lo(unsigned u) { return __uint_as_float(u << 16); }
DEV float bf_hi(unsigned u) { return __uint_as_float(u & 0xffff0000u); }
DEV float bf2f(u16 h) { return __uint_as_float(((unsigned)h) << 16); }
DEV void unpack8(const uint4& v, float* f) {
  f[0] = bf_lo(v.x); f[1] = bf_hi(v.x); f[2] = bf_lo(v.y); f[3] = bf_hi(v.y);
  f[4] = bf_lo(v.z); f[5] = bf_hi(v.z); f[6] = bf_lo(v.w); f[7] = bf_hi(v.w);
}
DEV uint4 pack8(const float* f) {
  uint4 v;
  v.x = pack_bf16(f[0], f[1]); v.y = pack_bf16(f[2], f[3]); v.z = pack_bf16(f[4], f[5]); v.w = pack_bf16(f[6], f[7]);
  return v;
}
template <int O> DEV float swz_xor(float v) {
  return __builtin_bit_cast(float, __builtin_amdgcn_ds_swizzle(__builtin_bit_cast(int, v), (O << 10) | 0x1F));
}
template <int O> DEV unsigned swz_xor_u(unsigned v) {
  return (unsigned)__builtin_amdgcn_ds_swizzle((int)v, (O << 10) | 0x1F);
}
DEV float xor32_f(float v) {
  const int a = ((TID() & 63) ^ 32) << 2;
  return __builtin_bit_cast(float, __builtin_amdgcn_ds_bpermute(a, __builtin_bit_cast(int, v)));
}
DEV float wave_sum(float v) {
  v += xor32_f(v);
  v += swz_xor<16>(v); v += swz_xor<8>(v); v += swz_xor<4>(v); v += swz_xor<2>(v); v += swz_xor<1>(v);
  return v;
}
DEV float wave_max(float v) {
  v = fmaxf(v, xor32_f(v));
  v = fmaxf(v, swz_xor<16>(v)); v = fmaxf(v, swz_xor<8>(v)); v = fmaxf(v, swz_xor<4>(v));
  v = fmaxf(v, swz_xor<2>(v)); v = fmaxf(v, swz_xor<1>(v));
  return v;
}
DEV float group16_sum(float v) {
  v += swz_xor<8>(v); v += swz_xor<4>(v); v += swz_xor<2>(v); v += swz_xor<1>(v);
  return v;
}
DEV float sigmoidf_(float x) { return __builtin_amdgcn_rcpf(1.f + __expf(-x)); }
DEV float siluf_(float x) { return x * __builtin_amdgcn_rcpf(1.f + __expf(-x)); }
DEV int modsel(int r) { return r < NLAT ? (r >> 13) : 2; }

DEV void transpose_tile(const float* __restrict__ src, int Nsrc, int ldd, u16* __restrict__ dst, int kt, int nt, int mode,
                        float* tile) {
  const int tid = TID();
  const int cl = tid & 63, rg = tid >> 6;
  const int nd = nt * 64 + cl;
  int ns = nd;
  bool valid = true;
  if (mode & 1) {
    if (nd < 2560) ns = nd;
    else if (nd < 4608) ns = nd + 16;
    else if (nd < 4624) ns = nd - 4608 + 2560;
    else { valid = false; ns = 0; }
  }
#pragma unroll
  for (int i = 0; i < 16; ++i) {
    const int kr = i * 4 + rg;
    float v = valid ? src[(size_t)(kt * 64 + kr) * Nsrc + ns] : 0.f;
    tile[kr * 65 + cl] = v;
  }
  __syncthreads();
  const int nr = tid >> 2, kc = (tid & 3) * 16;
  if (mode & 2) {
    int q4[4];
#pragma unroll
    for (int q = 0; q < 4; ++q) {
      int pk = __builtin_amdgcn_cvt_pk_fp8_f32(32.f * tile[(kc + 4 * q) * 65 + nr], 32.f * tile[(kc + 4 * q + 1) * 65 + nr], 0, false);
      q4[q] = __builtin_amdgcn_cvt_pk_fp8_f32(32.f * tile[(kc + 4 * q + 2) * 65 + nr], 32.f * tile[(kc + 4 * q + 3) * 65 + nr], pk, true);
    }
    *(int4*)((char*)dst + (size_t)(nt * 64 + nr) * ldd + kt * 64 + kc) = make_int4(q4[0], q4[1], q4[2], q4[3]);
    __syncthreads();
    return;
  }
  unsigned w[8];
#pragma unroll
  for (int q = 0; q < 8; ++q) w[q] = pack_bf16(tile[(kc + 2 * q) * 65 + nr], tile[(kc + 2 * q + 1) * 65 + nr]);
  uint4* d = (uint4*)(dst + (size_t)(nt * 64 + nr) * ldd + kt * 64 + kc);
  d[0] = make_uint4(w[0], w[1], w[2], w[3]);
  d[1] = make_uint4(w[4], w[5], w[6], w[7]);
  __syncthreads();
}

__device__ __forceinline__ void phase_init(char* smem) {
  const KP PP = get_params();
  const int tid = TID(), nb = gridDim.x, bid = BID();
  float* fs = (float*)smem;
  for (int u = bid; u < 192; u += nb) {
    const int layer = u / 96, col0 = (u % 96) * 64;
    float* sv = fs;
    float* red = fs + 3072;
    for (int i = tid; i < 3072; i += NTHR) {
      const int v = i >> 10, k = i & 1023;
      const float cv = (v < 2) ? PP->c[v * 1024 + k] : PP->c_ctx[k];
      sv[i] = siluf_(cv);
    }
    __syncthreads();
    const int cq = tid & 15, ks = tid >> 4;
    float acc[3][4];
#pragma unroll
    for (int v = 0; v < 3; ++v)
#pragma unroll
      for (int i = 0; i < 4; ++i) acc[v][i] = 0.f;
    const float* wb = PP->w_mod + ((size_t)layer * 1024 + ks * 64) * 6144 + col0 + cq * 4;
#pragma unroll 8
    for (int kk = 0; kk < 64; ++kk) {
      const float4 w4 = *(const float4*)(wb + (size_t)kk * 6144);
      const int k = ks * 64 + kk;
#pragma unroll
      for (int v = 0; v < 3; ++v) {
        const float s = sv[v * 1024 + k];
        acc[v][0] += s * w4.x; acc[v][1] += s * w4.y; acc[v][2] += s * w4.z; acc[v][3] += s * w4.w;
      }
    }
#pragma unroll
    for (int v = 0; v < 3; ++v)
#pragma unroll
      for (int i = 0; i < 4; ++i) red[(ks * 3 + v) * 64 + cq * 4 + i] = acc[v][i];
    __syncthreads();
    if (tid < 192) {
      const int v = tid >> 6, cc = tid & 63;
      float s = PP->b_mod[layer * 6144 + col0 + cc];
#pragma unroll
      for (int k2 = 0; k2 < 16; ++k2) s += red[(k2 * 3 + v) * 64 + cc];
      PP->mod[(size_t)(layer * 3 + v) * 6144 + col0 + cc] = s;
    }
    __syncthreads();
  }
  constexpr int NTL = 1184 + 128 + 128 + 256 + 16;
  for (int j = bid; j < NTL * DEPTH; j += nb) {
    const int layer = j / NTL;
    int jj = j % NTL;
    if (jj < 1184) {
      transpose_tile(PP->w_in + (size_t)layer * 1024 * INC, INC, LDK1, PP->WinT + (size_t)layer * NPAD * LDK1, jj / 74, jj % 74, 3, fs);
    } else if ((jj -= 1184) < 128) {
      transpose_tile(PP->w_up_dn + (size_t)layer * 512 * 1024, 1024, LDK5, PP->WdT + (size_t)layer * 1024 * LDK5, jj / 16, jj % 16, 2, fs);
    } else if ((jj -= 128) < 128) {
      transpose_tile(PP->w_up_pool + (size_t)layer * 512 * 1024, 1024, LDK5, PP->WpT + (size_t)layer * 1024 * LDK5, jj / 16, jj % 16, 2, fs);
    } else if ((jj -= 128) < 256) {
      transpose_tile(PP->w_out + (size_t)layer * 1024 * 1024, 1024, LDK1, PP->WoT + (size_t)layer * 1024 * LDK1, jj / 16, jj % 16, 2, fs);
    } else {
      jj -= 256;
      const int g = jj >> 2;
      transpose_tile(PP->pool_w + (size_t)(layer * 4 + g) * 128 * 128, 128, 128, PP->PwT + (size_t)(layer * 4 + g) * 128 * 128,
                     (jj & 3) >> 1, jj & 1, 0, fs);
    }
  }
  {
    const int tid2 = TID();
    const int l = tid2 & 63, w = tid2 >> 6, lr = l & 15, lg = l >> 4;
    char* Ks = smem;
    char* Ws = smem + 32768;
    for (int item = bid; item < DEPTH * 256; item += nb) {
      const int layer = item >> 8, hp = (item >> 4) & 15, ct = item & 15;
      __syncthreads();
      const float* ksrc = PP->peer_keys + (size_t)(layer * 16 + hp) * 128 * 128;
      for (int idx = tid2; idx < 128 * 16; idx += NTHR) {
        const int row = idx >> 4, ch = idx & 15;
        const float4 a = *(const float4*)(ksrc + row * 128 + ch * 8);
        const float4 c4 = *(const float4*)(ksrc + row * 128 + ch * 8 + 4);
        *(uint4*)(Ks + row * 256 + ((ch ^ (row & 15)) << 4)) =
            make_uint4(pack_bf16(a.x, a.y), pack_bf16(a.z, a.w), pack_bf16(c4.x, c4.y), pack_bf16(c4.z, c4.w));
      }
      const float* wsrc = PP->peer_wq + (size_t)layer * 1024 * 2048 + (size_t)(ct * 64) * 2048 + hp * 128;
      for (int idx = tid2; idx < 64 * 16; idx += NTHR) {
        const int row = idx >> 4, ch = idx & 15;
        const float4 a = *(const float4*)(wsrc + (size_t)row * 2048 + ch * 8);
        const float4 c4 = *(const float4*)(wsrc + (size_t)row * 2048 + ch * 8 + 4);
        *(uint4*)(Ws + row * 256 + ((ch ^ (row & 15)) << 4)) =
            make_uint4(pack_bf16(a.x, a.y), pack_bf16(a.z, a.w), pack_bf16(c4.x, c4.y), pack_bf16(c4.z, c4.w));
      }
      __syncthreads();
      f32x4 acc[2][4];
#pragma unroll
      for (int mi = 0; mi < 2; ++mi)
#pragma unroll
        for (int ni = 0; ni < 4; ++ni) acc[mi][ni] = (f32x4){0.f, 0.f, 0.f, 0.f};
#pragma unroll
      for (int ks = 0; ks < 4; ++ks) {
        const int ch = ks * 4 + lg;
        bf16x8 a[2], bb[4];
#pragma unroll
        for (int mi = 0; mi < 2; ++mi) a[mi] = *(const bf16x8*)(Ks + ((2 * w + mi) * 16 + lr) * 256 + ((ch ^ lr) << 4));
#pragma unroll
        for (int ni = 0; ni < 4; ++ni) bb[ni] = *(const bf16x8*)(Ws + (ni * 16 + lr) * 256 + ((ch ^ lr) << 4));
#pragma unroll
        for (int mi = 0; mi < 2; ++mi)
#pragma unroll
          for (int ni = 0; ni < 4; ++ni) acc[mi][ni] = __builtin_amdgcn_mfma_f32_16x16x32_bf16(a[mi], bb[ni], acc[mi][ni], 0, 0, 0);
      }
      unsigned char* dst = (unsigned char*)PP->WkT + ((size_t)layer * 2048 + hp * 128) * LDK1 + ct * 64;
#pragma unroll
      for (int mi = 0; mi < 2; ++mi)
#pragma unroll
        for (int ni = 0; ni < 4; ++ni)
#pragma unroll
          for (int r = 0; r < 4; ++r) {
            const float v32 = 32.f * acc[mi][ni][r];
            dst[(size_t)((2 * w + mi) * 16 + 4 * lg + r) * LDK1 + ni * 16 + lr] = (unsigned char)(__builtin_amdgcn_cvt_pk_fp8_f32(v32, v32, 0, false) & 0xff);
          }
    }
  }
}

DEV unsigned enc_e2m3(float x) {
  const float a = fabsf(x);
  float c;
  if (a < 2.f) c = a * 8.f;
  else if (a < 4.f) c = 16.f + (a - 2.f) * 4.f;
  else c = 24.f + (a - 4.f) * 2.f;
  unsigned code = (unsigned)__builtin_rintf(c);
  code = code > 31u ? 31u : code;
  return code | (x < 0.f ? 32u : 0u);
}
struct __attribute__((packed, aligned(4))) U3 { unsigned a, b, c; };
constexpr int TROW = 768;
typedef float f32x32_t __attribute__((ext_vector_type(32)));
typedef unsigned u32x6_t __attribute__((ext_vector_type(6)));

__device__ __forceinline__ void phase_tables(int layer, int vbid, int vnb) {
  const KP PP = get_params();
  const int tid = TID(), lane = tid & 63;
  const int gw = vbid * 4 + (tid >> 6), nw = vnb * 4;
  const float* su = PP->peer_u + (size_t)layer * NEXP * 1024;
  const float* sv = PP->peer_v + (size_t)layer * NEXP * 1024;
  for (int r0 = gw * 2; r0 < 2 * NEXP; r0 += nw * 2) {
    float4 v[2][4];
#pragma unroll
    for (int q = 0; q < 2; ++q) {
      const int r = r0 + q;
      const float* src = (r < NEXP ? su + (size_t)r * 1024 : sv + (size_t)(r - NEXP) * 1024);
#pragma unroll
      for (int i = 0; i < 4; ++i) v[q][i] = *(const float4*)(src + (lane + 64 * i) * 4);
    }
#pragma unroll
    for (int q = 0; q < 2; ++q) {
      const int r = r0 + q;
      float am = 0.f;
#pragma unroll
      for (int i = 0; i < 4; ++i)
        am = fmaxf(am, fmaxf(fmaxf(fabsf(v[q][i].x), fabsf(v[q][i].y)), fmaxf(fabsf(v[q][i].z), fabsf(v[q][i].w))));
      am = wave_max(am);
      const float scale = fmaxf(am, 1e-30f) * (1.f / 7.5f);
      const float inv = 1.f / scale;
      unsigned long long lo = 0ull;
      unsigned hi = 0u;
#pragma unroll
      for (int i = 0; i < 4; ++i) {
        const float vv[4] = {v[q][i].x * inv, v[q][i].y * inv, v[q][i].z * inv, v[q][i].w * inv};
#pragma unroll
        for (int j = 0; j < 4; ++j) {
          const int k = 4 * i + j;
          const unsigned cde = enc_e2m3(vv[j]);
          if (k < 10) lo |= (unsigned long long)cde << (6 * k);
          else if (k == 10) { lo |= (unsigned long long)cde << 60; hi |= cde >> 4; }
          else hi |= cde << (6 * k - 64);
        }
      }
      unsigned char* dst = (r < NEXP ? PP->tab8U + (size_t)r * TROW : PP->tab8V + (size_t)(r - NEXP) * TROW);
      U3 pk3;
      pk3.a = (unsigned)lo; pk3.b = (unsigned)(lo >> 32); pk3.c = hi;
      *(U3*)(dst + lane * 12) = pk3;
      if (lane == 0) { if (r < NEXP) PP->scU[r] = scale; else PP->scV[r - NEXP] = scale; }
    }
  }
}

__device__ __forceinline__ void phase_norm(int layer, int which) {
  const KP PP = get_params();
  const int lane = TID() & 63;
  const int gw = BID() * 4 + (TID() >> 6), nw = gridDim.x * 4;
  const float* nwt = (which == 1 ? PP->norm_mix : PP->norm_ffn) + layer * 1024;
  const int rlim = (which == 2 && layer == DEPTH - 1) ? NLAT : R;
  for (int r = gw; r < rlim; r += nw) {
    const float* xr;
    if (r < NLAT) xr = ((which == 1 && layer == 0) ? PP->x : PP->out) + (size_t)r * 1024;
    else xr = ((which == 1 && layer == 0) ? PP->ctx : PP->xc) + (size_t)(r - NLAT) * 1024;
    const float* md = PP->mod + (size_t)(layer * 3 + modsel(r)) * 6144 + (which == 1 ? 0 : 3072);
    float4 v[4];
    float ss = 0.f;
#pragma unroll
    for (int i = 0; i < 4; ++i) {
      v[i] = *(const float4*)(xr + (lane + 64 * i) * 4);
      ss += v[i].x * v[i].x + v[i].y * v[i].y + v[i].z * v[i].z + v[i].w * v[i].w;
    }
    ss = wave_sum(ss);
    const float rs = rsqrtf(ss * (1.f / 1024.f) + EPS);
#pragma unroll
    for (int i = 0; i < 4; ++i) {
      const int col = (lane + 64 * i) * 4;
      const float4 w = *(const float4*)(nwt + col);
      const float4 sh = *(const float4*)(md + col);
      const float4 sc = *(const float4*)(md + 1024 + col);
      const float y0 = v[i].x * rs * w.x * (1.f + sc.x) + sh.x;
      const float y1 = v[i].y * rs * w.y * (1.f + sc.y) + sh.y;
      const float y2 = v[i].z * rs * w.z * (1.f + sc.z) + sh.z;
      const float y3 = v[i].w * rs * w.w * (1.f + sc.w) + sh.w;
      if (which == 1) {
        int pk = __builtin_amdgcn_cvt_pk_fp8_f32(y0, y1, 0, false);
        pk = __builtin_amdgcn_cvt_pk_fp8_f32(y2, y3, pk, true);
        *(int*)((char*)PP->h + (size_t)r * (LDK1 * 2) + col) = pk;
      } else {
        *(uint2*)(PP->h + (size_t)r * LDK1 + col) = make_uint2(pack_bf16(y0, y1), pack_bf16(y2, y3));
        int pk = __builtin_amdgcn_cvt_pk_fp8_f32(y0, y1, 0, false);
        pk = __builtin_amdgcn_cvt_pk_fp8_f32(y2, y3, pk, true);
        *(int*)(PP->h8 + (size_t)r * LDK1 + col) = pk;
      }
    }
  }
}

template <bool PRIO>
DEV void gemm_mainloop_t(const u16* __restrict__ A, int lda, const u16* __restrict__ B, int ldb, int K, int m0, int n0,
                         char* smem, f32x4 (&acc)[4][4]) {
  const int tid = TID();
  const int l = tid & 63, w = tid >> 6, wm = w >> 1, wn = w & 1, lr = l & 15, lg = l >> 4;
  uint4 ga0[4], gb0[4], ga1[4], gb1[4];
#pragma unroll
  for (int i = 0; i < 4; ++i) { ga0[i] = make_uint4(0u, 0u, 0u, 0u); gb0[i] = ga0[i]; ga1[i] = ga0[i]; gb1[i] = ga0[i]; }
  const int KT = K >> 6;
#define GLOAD(GA, GB, KT_)                                                                     \
  _Pragma("unroll") for (int i = 0; i < 4; ++i) {                                              \
    const int id = tid + 256 * i, row = id >> 3, c = id & 7;                                   \
    GA[i] = *(const uint4*)(A + (size_t)(m0 + row) * lda + (KT_) * 64 + c * 8);                \
    GB[i] = *(const uint4*)(B + (size_t)(n0 + row) * ldb + (KT_) * 64 + c * 8);                \
  }
#define LSTORE(GA, GB, BUF)                                                                    \
  {                                                                                            \
    char* as_ = smem + (BUF) * 32768;                                                          \
    char* bs_ = as_ + 16384;                                                                   \
    _Pragma("unroll") for (int i = 0; i < 4; ++i) {                                            \
      const int id = tid + 256 * i, row = id >> 3, c = id & 7;                                 \
      const int off = row * 128 + ((c ^ (row & 7)) << 4);                                      \
      *(uint4*)(as_ + off) = GA[i];                                                            \
      *(uint4*)(bs_ + off) = GB[i];                                                            \
    }                                                                                          \
  }
#define COMPUTE(BUF)                                                                                                      \
  {                                                                                                                       \
    const char* as_ = smem + (BUF) * 32768;                                                                               \
    const char* bs_ = as_ + 16384;                                                                                        \
    if (PRIO) __builtin_amdgcn_s_setprio(1);      \
    _Pragma("unroll") for (int ks = 0; ks < 2; ++ks) {                                                                    \
      bf16x8 a[4], b[4];                                                                                                  \
      const int c = ks * 4 + lg;                                                                                          \
      const int sw = ((c ^ (lr & 7)) << 4);                                                                               \
      _Pragma("unroll") for (int mi = 0; mi < 4; ++mi) a[mi] = *(const bf16x8*)(as_ + (wm * 64 + mi * 16 + lr) * 128 + sw); \
      _Pragma("unroll") for (int ni = 0; ni < 4; ++ni) b[ni] = *(const bf16x8*)(bs_ + (wn * 64 + ni * 16 + lr) * 128 + sw); \
      _Pragma("unroll") for (int mi = 0; mi < 4; ++mi)                                                                    \
        _Pragma("unroll") for (int ni = 0; ni < 4; ++ni)                                                                  \
          acc[mi][ni] = __builtin_amdgcn_mfma_f32_16x16x32_bf16(a[mi], b[ni], acc[mi][ni], 0, 0, 0);                      \
    }                                                                                                                     \
    if (PRIO) __builtin_amdgcn_s_setprio(0);                                                                              \
  }
  __syncthreads();
  GLOAD(ga0, gb0, 0);
  GLOAD(ga1, gb1, 1);
  LSTORE(ga0, gb0, 0);
  __syncthreads();
  for (int kt = 0; kt < KT; kt += 2) {
    if (kt + 2 < KT) { GLOAD(ga0, gb0, kt + 2); }
    COMPUTE(0);
    LSTORE(ga1, gb1, 1);
    __syncthreads();
    if (kt + 3 < KT) { GLOAD(ga1, gb1, kt + 3); }
    COMPUTE(1);
    if (kt + 2 < KT) { LSTORE(ga0, gb0, 0); }
    __syncthreads();
  }
#undef GLOAD
#undef LSTORE
#undef COMPUTE
}

DEV void gemm_mainloop(const u16* __restrict__ A, int lda, const u16* __restrict__ B, int ldb, int K, int m0, int n0,
                       char* smem, f32x4 (&acc)[4][4]) {
  gemm_mainloop_t<false>(A, lda, B, ldb, K, m0, n0, smem, acc);
}
DEV void gemm_mainloop1(const u16* __restrict__ A, int lda, const u16* __restrict__ B, int ldb, int K, int m0, int n0,
                       char* smem, f32x4 (&acc)[4][4]) {
  const int tid = TID();
  const int l = tid & 63, w = tid >> 6, wm = w >> 1, wn = w & 1, lr = l & 15, lg = l >> 4;
  uint4 ga[4], gb[4];
  const int KT = K >> 6;
  auto gload = [&](int kt) {
#pragma unroll
    for (int i = 0; i < 4; ++i) {
      const int id = tid + 256 * i, row = id >> 3, c = id & 7;
      ga[i] = *(const uint4*)(A + (size_t)(m0 + row) * lda + kt * 64 + c * 8);
      gb[i] = *(const uint4*)(B + (size_t)(n0 + row) * ldb + kt * 64 + c * 8);
    }
  };
  auto lstore = [&](int buf) {
    char* as = smem + buf * 32768;
    char* bs = as + 16384;
#pragma unroll
    for (int i = 0; i < 4; ++i) {
      const int id = tid + 256 * i, row = id >> 3, c = id & 7;
      const int off = row * 128 + ((c ^ (row & 7)) << 4);
      *(uint4*)(as + off) = ga[i];
      *(uint4*)(bs + off) = gb[i];
    }
  };
  __syncthreads();
  gload(0);
  lstore(0);
  __syncthreads();
  for (int kt = 0; kt < KT; ++kt) {
    if (kt + 1 < KT) gload(kt + 1);
    const char* as = smem + (kt & 1) * 32768;
    const char* bs = as + 16384;
#pragma unroll
    for (int ks = 0; ks < 2; ++ks) {
      bf16x8 a[4], b[4];
      const int c = ks * 4 + lg;
      const int sw = ((c ^ (lr & 7)) << 4);
#pragma unroll
      for (int mi = 0; mi < 4; ++mi) a[mi] = *(const bf16x8*)(as + (wm * 64 + mi * 16 + lr) * 128 + sw);
#pragma unroll
      for (int ni = 0; ni < 4; ++ni) b[ni] = *(const bf16x8*)(bs + (wn * 64 + ni * 16 + lr) * 128 + sw);
#pragma unroll
      for (int mi = 0; mi < 4; ++mi)
#pragma unroll
        for (int ni = 0; ni < 4; ++ni) acc[mi][ni] = __builtin_amdgcn_mfma_f32_16x16x32_bf16(a[mi], b[ni], acc[mi][ni], 0, 0, 0);
    }
    if (kt + 1 < KT) lstore((kt + 1) & 1);
    __syncthreads();
  }
}

DEV void zero_acc(f32x4 (&acc)[4][4]) {
#pragma unroll
  for (int i = 0; i < 4; ++i)
#pragma unroll
    for (int j = 0; j < 4; ++j) acc[i][j] = (f32x4){0.f, 0.f, 0.f, 0.f};
}

DEV void stage_half(const f32x4 (&acc)[4][4], int hsel, char* smem, float4 (&v)[8]) {
  const int tid = TID();
  const int l = tid & 63, w = tid >> 6, wm = w >> 1, wn = w & 1, lr = l & 15, lg = l >> 4;
  float* Cs = (float*)smem;
  __syncthreads();
  if (wm == hsel) {
#pragma unroll
    for (int mi = 0; mi < 4; ++mi)
#pragma unroll
      for (int ni = 0; ni < 4; ++ni)
#pragma unroll
        for (int r = 0; r < 4; ++r) Cs[(mi * 16 + lg * 4 + r) * 132 + wn * 64 + ni * 16 + lr] = acc[mi][ni][r];
  }
  __syncthreads();
#pragma unroll
  for (int j = 0; j < 8; ++j) {
    const int idx = tid + 256 * j, row = idx >> 5, c4 = idx & 31;
    v[j] = *(const float4*)&Cs[row * 132 + c4 * 4];
  }
}

DEV bool tile_map(int it, int MT, int NTl, int& mt, int& nt) {
  const int nb = gridDim.x, bid = BID();
  const int x = bid & 7, vl = bid >> 3, per = nb >> 3;
  const int T = MT * NTl;
  const int g_begin = (int)(((long long)x * T) >> 3), g_end = (int)(((long long)(x + 1) * T) >> 3);
  const int g = g_begin + vl + it * per;
  if (g >= g_end) return false;
  const int full = MT >> 3;
  const int sr = g / (8 * NTl);
  const int srow = sr < full ? sr : full;
  const int rows_in_sr = sr < full ? 8 : (MT & 7);
  const int tt = g - srow * 8 * NTl;
  nt = tt / rows_in_sr;
  mt = srow * 8 + tt % rows_in_sr;
  return true;
}

#define SG_LOCALS                                                                              \
  const int tid = TID();                                                                       \
  const int l = tid & 63, w = tid >> 6, wm = w >> 1, wn = w & 1, lr = l & 15, lg = l >> 4;     \
  uint4 ga0[4], gb0[4], ga1[4], gb1[4];                                                        \
  _Pragma("unroll") for (int i = 0; i < 4; ++i) {                                              \
    ga0[i] = make_uint4(0u, 0u, 0u, 0u); gb0[i] = ga0[i]; ga1[i] = ga0[i]; gb1[i] = ga0[i];    \
  }                                                                                            \
  const int r0 = tid >> 3, c0 = tid & 7;                                                       \
  const int pr0 = 8 * ((r0 & 15) >> 2) + 4 * (r0 >> 4) + (r0 & 3);
#define SG_LOAD(GA, GB, AP, BP, LD, M0_, N0_, KT_)                                             \
  _Pragma("unroll") for (int i = 0; i < 4; ++i) {                                              \
    GA[i] = *(const uint4*)((AP) + (size_t)((M0_) + 32 * i + r0) * (LD) + c0 * 8 + (KT_) * 64);  \
    GB[i] = *(const uint4*)((BP) + (size_t)((N0_) + 32 * i + pr0) * (LD) + c0 * 8 + (KT_) * 64); \
  }
#define SG_LSTORE(GA, GB, BUF)                                                                 \
  {                                                                                            \
    char* as_ = smem + (BUF) * 32768;                                                          \
    char* bs_ = as_ + 16384;                                                                   \
    _Pragma("unroll") for (int i = 0; i < 4; ++i) {                                            \
      const int id = tid + 256 * i, row = id >> 3, c = id & 7;                                 \
      const int off = row * 128 + ((c ^ (row & 7)) << 4);                                      \
      *(uint4*)(as_ + off) = GA[i];                                                            \
      *(uint4*)(bs_ + off) = GB[i];                                                            \
    }                                                                                          \
  }
#define SG_COMPUTE(ACC, BUF, PRIO)                                                                                        \
  {                                                                                                                       \
    const char* as_ = smem + (BUF) * 32768;                                                                               \
    const char* bs_ = as_ + 16384;                                                                                        \
    if (PRIO) __builtin_amdgcn_s_setprio(1);                                                                              \
    _Pragma("unroll") for (int ks = 0; ks < 2; ++ks) {                                                                    \
      bf16x8 a[4], b[4];                                                                                                  \
      const int c = ks * 4 + lg;                                                                                          \
      const int sw = ((c ^ (lr & 7)) << 4);                                                                               \
      _Pragma("unroll") for (int mi = 0; mi < 4; ++mi) a[mi] = *(const bf16x8*)(as_ + (wm * 64 + mi * 16 + lr) * 128 + sw); \
      _Pragma("unroll") for (int ni = 0; ni < 4; ++ni) b[ni] = *(const bf16x8*)(bs_ + (wn * 64 + ni * 16 + lr) * 128 + sw); \
      _Pragma("unroll") for (int mi = 0; mi < 4; ++mi)                                                                    \
        _Pragma("unroll") for (int ni = 0; ni < 4; ++ni)                                                                  \
          ACC[mi][ni] = __builtin_amdgcn_mfma_f32_16x16x32_bf16(b[ni], a[mi], ACC[mi][ni], 0, 0, 0);                      \
    }                                                                                                                     \
    if (PRIO) __builtin_amdgcn_s_setprio(0);                                                                              \
  }

typedef int i32x8 __attribute__((ext_vector_type(8)));
typedef int i32x4 __attribute__((ext_vector_type(4)));
#define F8_LOCALS                                                                              \
  const int tid = TID();                                                                       \
  const int l = tid & 63, w = tid >> 6, wm = w >> 1, wn = w & 1, lr = l & 15, lg = l >> 4;     \
  uint4 ga0[4], gb0[4], ga1[4], gb1[4];                                                        \
  _Pragma("unroll") for (int i = 0; i < 4; ++i) {                                              \
    ga0[i] = make_uint4(0u, 0u, 0u, 0u); gb0[i] = ga0[i]; ga1[i] = ga0[i]; gb1[i] = ga0[i];    \
  }                                                                                            \
  const int r0 = tid >> 3, c0 = tid & 7;                                                       \
  const int pr0 = 8 * ((r0 & 15) >> 2) + 4 * (r0 >> 4) + (r0 & 3);
#define F8_GLOAD(GA, GB, AP, LDA, BP, LDB, M0_, N0_, KT_)                                      \
  _Pragma("unroll") for (int i = 0; i < 4; ++i) {                                              \
    GA[i] = *(const uint4*)((AP) + (size_t)((M0_) + 32 * i + r0) * (LDA) + c0 * 16 + (KT_) * 128);   \
    GB[i] = *(const uint4*)((BP) + (size_t)((N0_) + 32 * i + pr0) * (LDB) + c0 * 16 + (KT_) * 128);  \
  }
#define F8_LSTORE(GA, GB, BUF)                                                                 \
  {                                                                                            \
    char* as_ = smem + (BUF) * 32768;                                                          \
    char* bs_ = as_ + 16384;                                                                   \
    _Pragma("unroll") for (int i = 0; i < 4; ++i) {                                            \
      const int id = tid + 256 * i, row = id >> 3, c = id & 7;                                 \
      const int off = row * 128 + ((c ^ (row & 7)) << 4);                                      \
      *(uint4*)(as_ + off) = GA[i];                                                            \
      *(uint4*)(bs_ + off) = GB[i];                                                            \
    }                                                                                          \
  }
#define F8_COMPUTE(BUF)                                                                                                   \
  {                                                                                                                       \
    const char* as_ = smem + (BUF) * 32768;                                                                               \
    const char* bs_ = as_ + 16384;                                                                                        \
    i32x8 a[4], b[4];                                                                                                     \
    const int sw0 = ((lg ^ (lr & 7)) << 4), sw1 = (((4 + lg) ^ (lr & 7)) << 4);                                           \
    _Pragma("unroll") for (int mi = 0; mi < 4; ++mi) {                                                                    \
      const char* p_ = as_ + (wm * 64 + mi * 16 + lr) * 128;                                                              \
      const i32x4 lo_ = *(const i32x4*)(p_ + sw0), hi_ = *(const i32x4*)(p_ + sw1);                                       \
      a[mi] = __builtin_shufflevector(lo_, hi_, 0, 1, 2, 3, 4, 5, 6, 7);                                                  \
    }                                                                                                                     \
    _Pragma("unroll") for (int ni = 0; ni < 4; ++ni) {                                                                    \
      const char* p_ = bs_ + (wn * 64 + ni * 16 + lr) * 128;                                                              \
      const i32x4 lo_ = *(const i32x4*)(p_ + sw0), hi_ = *(const i32x4*)(p_ + sw1);                                       \
      b[ni] = __builtin_shufflevector(lo_, hi_, 0, 1, 2, 3, 4, 5, 6, 7);                                                  \
    }                                                                                                                     \
    __builtin_amdgcn_s_setprio(1);                                                                                        \
    _Pragma("unroll") for (int mi = 0; mi < 4; ++mi)                                                                      \
      _Pragma("unroll") for (int ni = 0; ni < 4; ++ni)                                                                    \
        acc[mi][ni] = __builtin_amdgcn_mfma_scale_f32_16x16x128_f8f6f4(b[ni], a[mi], acc[mi][ni], 0, 0, 0, 0, 0, 0);      \
    __builtin_amdgcn_s_setprio(0);                                                                                        \
  }
#define F8_KLOOP(AP, LDA, BP, LDB, KT_)                                                        \
  for (int kt = 0; kt < (KT_); kt += 2) {                                                      \
    const bool wrap = (kt + 2 >= (KT_));                                                       \
    const int ml = wrap ? m0n : m0, nl = wrap ? n0n : n0, kl = wrap ? kt + 2 - (KT_) : kt + 2; \
    if (!wrap || hasn) { F8_GLOAD(ga0, gb0, AP, LDA, BP, LDB, ml, nl, kl); }                   \
    F8_COMPUTE(0);                                                                             \
    F8_LSTORE(ga1, gb1, 1);                                                                    \
    __syncthreads();                                                                           \
    if (!wrap || hasn) { F8_GLOAD(ga1, gb1, AP, LDA, BP, LDB, ml, nl, kl + 1); }               \
    F8_COMPUTE(1);                                                                             \
    if (!wrap || hasn) { F8_LSTORE(ga0, gb0, 0); }                                             \
    __syncthreads();                                                                           \
  }
#define F8_PROLOGUE(AP, LDA, BP, LDB)                                                          \
  __syncthreads();                           \
  F8_GLOAD(ga0, gb0, AP, LDA, BP, LDB, m0, n0, 0);                                             \
  F8_GLOAD(ga1, gb1, AP, LDA, BP, LDB, m0, n0, 1);                                             \
  F8_LSTORE(ga0, gb0, 0);                                                                      \
  __syncthreads();

__device__ __forceinline__ void phase_gemm_win(int layer, char* smem) {
  const KP PP = get_params();
  const char* Bt = (const char*)(PP->WinT + (size_t)layer * NPAD * LDK1);
  const char* A = (const char*)PP->h;
  F8_LOCALS
  int it = 0, mt, nt;
  if (!tile_map(it, R / 128, NPAD / 128, mt, nt)) return;
  int m0 = mt * 128, n0 = nt * 128;
  F8_PROLOGUE(A, LDK1 * 2, Bt, LDK1)
  for (;;) {
    int mtn = 0, ntn = 0;
    const bool hasn = tile_map(it + 1, R / 128, NPAD / 128, mtn, ntn);
    const int m0n = mtn * 128, n0n = ntn * 128;
    f32x4 acc[4][4];
    zero_acc(acc);
    F8_KLOOP(A, LDK1 * 2, Bt, LDK1, 8)
#pragma unroll
    for (int mi = 0; mi < 4; ++mi) {
      const size_t gr = (size_t)(m0 + wm * 64 + mi * 16 + lr);
#pragma unroll
      for (int g = 0; g < 2; ++g) {
        const int gc = n0 + wn * 64 + g * 32 + 8 * lg;
        const f32x4 t0 = acc[mi][2 * g] * (1.f / 32.f), t1 = acc[mi][2 * g + 1] * (1.f / 32.f);
        if (n0 < 1536) {
          int p0 = __builtin_amdgcn_cvt_pk_fp8_f32(t0[0], t0[1], 0, false);
          p0 = __builtin_amdgcn_cvt_pk_fp8_f32(t0[2], t0[3], p0, true);
          int p1 = __builtin_amdgcn_cvt_pk_fp8_f32(t1[0], t1[1], 0, false);
          p1 = __builtin_amdgcn_cvt_pk_fp8_f32(t1[2], t1[3], p1, true);
          *(int2*)((char*)PP->qkv_pre + gr * 1536 + gc) = make_int2(p0, p1);
        } else if (n0 < 2048) {
          *(uint4*)(PP->z + gr * 512 + (gc - 1536)) =
              make_uint4(pack_bf16(t0[0], t0[1]), pack_bf16(t0[2], t0[3]), pack_bf16(t1[0], t1[1]), pack_bf16(t1[2], t1[3]));
        } else if (n0 < 2560) {
          *(uint4*)(PP->pin + gr * 512 + (gc - 2048)) =
              make_uint4(pack_bf16(t0[0], t0[1]), pack_bf16(t0[2], t0[3]), pack_bf16(t1[0], t1[1]), pack_bf16(t1[2], t1[3]));
        } else if (n0 < 4608) {
          unsigned q0 = 0u, q1 = 0u;
#pragma unroll
          for (int e = 0; e < 4; ++e) {
            q0 = __builtin_amdgcn_cvt_pk_u8_f32(sigmoidf_(t0[e]) * 255.f, e, q0);
            q1 = __builtin_amdgcn_cvt_pk_u8_f32(sigmoidf_(t1[e]) * 255.f, e, q1);
          }
          unsigned char* gdst = (n0 < 3584) ? (unsigned char*)PP->sgd + gr * 1024 + (gc - 2560)
                                            : (unsigned char*)PP->sgp + gr * 1024 + (gc - 3584);
          *(uint2*)gdst = make_uint2(q0, q1);
        } else {
          if (gc - 4608 < 16) {
            *(float4*)(PP->ba + gr * 16 + (gc - 4608)) = make_float4(t0[0], t0[1], t0[2], t0[3]);
            *(float4*)(PP->ba + gr * 16 + (gc - 4608) + 4) = make_float4(t1[0], t1[1], t1[2], t1[3]);
          }
        }
      }
    }
    if (!hasn) break;
    m0 = m0n; n0 = n0n; ++it;
  }
}

__device__ __forceinline__ void phase_conv(int layer) {
  const KP PP = get_params();
  const int lane = TID() & 63;
  const int gw = BID() * 4 + (TID() >> 6), nw = gridDim.x * 4;
  const float* cw = PP->conv_w + (size_t)layer * 4 * 1536;
  float wr[3][4][8];
#pragma unroll
  for (int part = 0; part < 3; ++part)
#pragma unroll
    for (int j = 0; j < 4; ++j) {
      const float4 w0 = *(const float4*)(cw + j * 1536 + part * 512 + lane * 8);
      const float4 w1 = *(const float4*)(cw + j * 1536 + part * 512 + lane * 8 + 4);
      wr[part][j][0] = w0.x; wr[part][j][1] = w0.y; wr[part][j][2] = w0.z; wr[part][j][3] = w0.w;
      wr[part][j][4] = w1.x; wr[part][j][5] = w1.y; wr[part][j][6] = w1.z; wr[part][j][7] = w1.w;
    }
  for (int r = gw; r < R; r += nw) {
    int t, T;
    if (r < NLAT) { t = r & (SEQ - 1); T = SEQ; } else { t = (r - NLAT) & (CTX - 1); T = CTX; }
    const int base = r - t;
    uint2 xv[3][4];
#pragma unroll
    for (int j = 0; j < 4; ++j) {
      const int tt = t + j - 2;
      const bool ok = (tt >= 0 && tt < T);
      const unsigned char* src = (const unsigned char*)PP->qkv_pre + (size_t)(base + (ok ? tt : t)) * 1536 + lane * 8;
#pragma unroll
      for (int part = 0; part < 3; ++part) {
        xv[part][j] = *(const uint2*)(src + part * 512);
        if (!ok) xv[part][j] = make_uint2(0u, 0u);
      }
    }
#pragma unroll
    for (int part = 0; part < 3; ++part) {
      const int ch0 = part * 512 + lane * 8;
      float y[8];
#pragma unroll
      for (int e = 0; e < 8; ++e) y[e] = 0.f;
#pragma unroll
      for (int j = 0; j < 4; ++j) {
        float xf[8];
        {
          const f32x2 a0 = __builtin_amdgcn_cvt_pk_f32_fp8(xv[part][j].x, false), a1 = __builtin_amdgcn_cvt_pk_f32_fp8(xv[part][j].x, true);
          const f32x2 a2 = __builtin_amdgcn_cvt_pk_f32_fp8(xv[part][j].y, false), a3 = __builtin_amdgcn_cvt_pk_f32_fp8(xv[part][j].y, true);
          xf[0] = a0[0]; xf[1] = a0[1]; xf[2] = a1[0]; xf[3] = a1[1]; xf[4] = a2[0]; xf[5] = a2[1]; xf[6] = a3[0]; xf[7] = a3[1];
        }
#pragma unroll
        for (int e = 0; e < 8; ++e) y[e] += wr[part][j][e] * xf[e];
      }
      float ss = 0.f;
#pragma unroll
      for (int e = 0; e < 8; ++e) { y[e] = siluf_(y[e]); ss += y[e] * y[e]; }
      if (part < 2) {
        ss = group16_sum(ss);
        const float sc = rsqrtf(ss + EPS) * (part == 0 ? 0.08838834764831845f : 1.f);
#pragma unroll
        for (int e = 0; e < 8; ++e) y[e] *= sc;
      }
      *(uint4*)(PP->qkvn + (size_t)r * 1536 + ch0) = pack8(y);
    }
    if (lane < 16) {
      const float raw = PP->ba[(size_t)r * 16 + lane];
      float o;
      if (lane < 8) {
        o = sigmoidf_(raw);
      } else {
        const int jj = lane - 8;
        const float xx = raw + PP->dt_bias[layer * 8 + jj];
        const float ee = __expf(xx);
        const float sp = xx > 20.f ? xx : (ee < 0.03125f ? ee * (1.f - ee * (0.5f - ee * (0.33333334f - 0.25f * ee))) : __logf(1.f + ee));
        o = -__expf(PP->a_log[layer * 8 + jj]) * sp;
      }
      PP->bg[(size_t)r * 16 + lane] = o;
    }
  }
}

DEV int seq_row(int b, int dir, int pos) {
  if (dir == 0) return pos < CTX ? NLAT + b * CTX + pos : b * SEQ + (pos - CTX);
  return pos < CTX ? NLAT + b * CTX + (CTX - 1 - pos) : b * SEQ + (SEQ - 1 - (pos - CTX));
}
constexpr int NCHUNK = (CTX + SEQ) / 64;
constexpr int NUNIT = BATCH * DNH * 2 * NCHUNK;

DEV int kperm(int s, int g, int e) { return 32 * s + 16 * (e >> 2) + 4 * g + (e & 3); }

DEV uint4 pack_tiles(const f32x4& a, const f32x4& b) {
  return make_uint4(pack_bf16(a[0], a[1]), pack_bf16(a[2], a[3]), pack_bf16(b[0], b[1]), pack_bf16(b[2], b[3]));
}
DEV bf16x8 as_frag(const uint4& v) { return *(const bf16x8*)&v; }

DEV void conv8_silu(const unsigned char* __restrict__ qkv_pre8, const float* __restrict__ cw, int r, int ch0, float (&y)[8]) {
  int t, T;
  if (r < NLAT) { t = r & (SEQ - 1); T = SEQ; } else { t = (r - NLAT) & (CTX - 1); T = CTX; }
  const int base = r - t;
  uint2 xv[4];
#pragma unroll
  for (int j = 0; j < 4; ++j) {
    const int tt = t + j - 2;
    const bool ok = (tt >= 0 && tt < T);
    xv[j] = *(const uint2*)(qkv_pre8 + (size_t)(base + (ok ? tt : t)) * 1536 + ch0);
    if (!ok) xv[j] = make_uint2(0u, 0u);
  }
#pragma unroll
  for (int e = 0; e < 8; ++e) y[e] = 0.f;
#pragma unroll
  for (int j = 0; j < 4; ++j) {
    const float4 w0 = *(const float4*)(cw + j * 1536 + ch0), w1 = *(const float4*)(cw + j * 1536 + ch0 + 4);
    const f32x2 a0 = __builtin_amdgcn_cvt_pk_f32_fp8(xv[j].x, false), a1 = __builtin_amdgcn_cvt_pk_f32_fp8(xv[j].x, true);
    const f32x2 a2 = __builtin_amdgcn_cvt_pk_f32_fp8(xv[j].y, false), a3 = __builtin_amdgcn_cvt_pk_f32_fp8(xv[j].y, true);
    y[0] += w0.x * a0[0]; y[1] += w0.y * a0[1]; y[2] += w0.z * a1[0]; y[3] += w0.w * a1[1];
    y[4] += w1.x * a2[0]; y[5] += w1.y * a2[1]; y[6] += w1.z * a3[0]; y[7] += w1.w * a3[1];
  }
#pragma unroll
  for (int e = 0; e < 8; ++e) y[e] = siluf_(y[e]);
}

__device__ __forceinline__ void phase_prep(int layer, char* smem) {
  const KP PP = get_params();
  const int tid0 = TID();
  const int w = __builtin_amdgcn_readfirstlane(tid0 >> 6);
  char* Kt = smem;
  char* Vt = smem + 16384;
  float* Ld = (float*)(smem + 32768);
  u16* LN = (u16*)(smem + 32768 + 5120);
  float* gcs = (float*)(smem + 32768 + 5120 + 9216);
  float* bts = gcs + 64;
  char* wpriv = smem + 32768 + 5120 + 9216 + 512 + w * 6144;
  float* Tt = (float*)wpriv;
  u16* Xb = (u16*)(wpriv + 4096);
  float* egc = (float*)(smem + 72192);
  float* egl = egc + 64;
  const int per_ = gridDim.x >> 3, s_ = BID() >> 3;
  const int nfull_ = (2 * NCHUNK) / per_, nrem_ = (2 * NCHUNK) % per_;
  const bool altx_ = (2 * nrem_ <= per_);
  for (int ki_ = 0; ki_ <= nfull_; ++ki_) {
    int j_;
    if (ki_ < nfull_) j_ = s_ + per_ * ki_;
    else if (altx_) { if (!(s_ & 1) || (s_ >> 1) >= nrem_) break; j_ = nfull_ * per_ + (s_ >> 1); }
    else { if (s_ >= nrem_) break; j_ = nfull_ * per_ + s_; }
    const int c = NCHUNK - 1 - (j_ >> 1), u16i = (BID() & 7) * 2 + (j_ & 1);
    const int unit = u16i * NCHUNK + c;
    const int dir = u16i & 1, hd = (u16i >> 1) & 3, b = u16i >> 3;
    int tid = tid0;
    asm volatile("" : "+v"(tid));
    const int l = tid & 63, lr = l & 15, lg = l >> 4;
    __syncthreads();
    if (tid < 64) {
      const int rr = seq_row(b, dir, c * 64 + tid);
      const int jj = dir * 4 + hd;
      bts[tid] = sigmoidf_(PP->ba[(size_t)rr * 16 + jj]);
      float g;
      {
        const float xx = PP->ba[(size_t)rr * 16 + 8 + jj] + PP->dt_bias[layer * 8 + jj];
        const float ee = __expf(xx);
        const float sp = xx > 20.f ? xx : (ee < 0.03125f ? ee * (1.f - ee * (0.5f - ee * (0.33333334f - 0.25f * ee))) : __logf(1.f + ee));
        g = -__expf(PP->a_log[layer * 8 + jj]) * sp;
      }
#pragma unroll
      for (int o = 1; o < 64; o <<= 1) {
        const float t = __builtin_bit_cast(float, __builtin_amdgcn_ds_bpermute(((tid - o) & 63) << 2, __builtin_bit_cast(int, g)));
        if (tid >= o) g += t;
      }
      gcs[tid] = g;
      egc[tid] = __expf(g);
      egl[tid] = __expf(__builtin_bit_cast(float, __builtin_amdgcn_readlane(__builtin_bit_cast(int, g), 63)) - g);
      PP->gc[(size_t)unit * 64 + tid] = g;
    }
    {
      const unsigned char* pre8 = (const unsigned char*)PP->qkv_pre;
      const float* cw = PP->conv_w + (size_t)layer * 4 * 1536;
      const int ch = tid & 15, rg = tid >> 4;
      const int r_first = seq_row(b, dir, c * 64 + 4 * rg);
      int t0, T;
      if (r_first < NLAT) { t0 = r_first & (SEQ - 1); T = SEQ; } else { t0 = (r_first - NLAT) & (CTX - 1); T = CTX; }
      const int base = r_first - t0;
      const int tl = dir ? t0 - 3 : t0;
      const int nparts = dir == 0 ? 3 : 2;
      for (int part = 0; part < nparts; ++part) {
        const int chofs = (part == 0 ? 512 : (part == 1 ? 1024 : 0)) + hd * 128 + ch * 8;
        f32x2 wv[4][4];
#pragma unroll
        for (int j = 0; j < 4; ++j) {
          const float4 w0 = *(const float4*)(cw + j * 1536 + chofs), w1 = *(const float4*)(cw + j * 1536 + chofs + 4);
          wv[j][0] = (f32x2){w0.x, w0.y}; wv[j][1] = (f32x2){w0.z, w0.w};
          wv[j][2] = (f32x2){w1.x, w1.y}; wv[j][3] = (f32x2){w1.z, w1.w};
        }
        uint2 xr[7];
#pragma unroll
        for (int m = 0; m < 7; ++m) {
          const int tt = tl - 2 + m;
          const bool ok = (tt >= 0 && tt < T);
          xr[m] = *(const uint2*)(pre8 + (size_t)(base + (ok ? tt : t0)) * 1536 + chofs);
          if (!ok) xr[m] = make_uint2(0u, 0u);
        }
        f32x2 xf[7][4];
#pragma unroll
        for (int m = 0; m < 7; ++m) {
          xf[m][0] = __builtin_amdgcn_cvt_pk_f32_fp8(xr[m].x, false); xf[m][1] = __builtin_amdgcn_cvt_pk_f32_fp8(xr[m].x, true);
          xf[m][2] = __builtin_amdgcn_cvt_pk_f32_fp8(xr[m].y, false); xf[m][3] = __builtin_amdgcn_cvt_pk_f32_fp8(xr[m].y, true);
        }
        f32x2 acc2[4][4];
        if (dir == 0) {
#pragma unroll
          for (int s4 = 0; s4 < 4; ++s4)
#pragma unroll
            for (int p = 0; p < 4; ++p) {
              f32x2 a = wv[0][p] * xf[s4][p];
#pragma unroll
              for (int j = 1; j < 4; ++j) a += wv[j][p] * xf[s4 + j][p];
              acc2[s4][p] = a;
            }
        } else {
#pragma unroll
          for (int s4 = 0; s4 < 4; ++s4)
#pragma unroll
            for (int p = 0; p < 4; ++p) {
              f32x2 a = wv[0][p] * xf[3 - s4][p];
#pragma unroll
              for (int j = 1; j < 4; ++j) a += wv[j][p] * xf[3 - s4 + j][p];
              acc2[s4][p] = a;
            }
        }
        float y[4][8], ss[4];
#pragma unroll
        for (int s4 = 0; s4 < 4; ++s4) {
          float t = 0.f;
#pragma unroll
          for (int p = 0; p < 4; ++p) {
            const float a0 = siluf_(acc2[s4][p][0]), a1 = siluf_(acc2[s4][p][1]);
            y[s4][2 * p] = a0; y[s4][2 * p + 1] = a1;
            t += a0 * a0 + a1 * a1;
          }
          ss[s4] = t;
        }
        if (part != 1) {
#pragma unroll
          for (int s4 = 0; s4 < 4; ++s4) ss[s4] += swz_xor<8>(ss[s4]);
#pragma unroll
          for (int s4 = 0; s4 < 4; ++s4) ss[s4] += swz_xor<4>(ss[s4]);
#pragma unroll
          for (int s4 = 0; s4 < 4; ++s4) ss[s4] += swz_xor<2>(ss[s4]);
#pragma unroll
          for (int s4 = 0; s4 < 4; ++s4) ss[s4] += swz_xor<1>(ss[s4]);
#pragma unroll
          for (int s4 = 0; s4 < 4; ++s4) {
            const float sc = rsqrtf(ss[s4] + EPS) * (part == 2 ? 0.08838834764831845f : 1.f);
#pragma unroll
            for (int e2 = 0; e2 < 8; ++e2) y[s4][e2] *= sc;
          }
        }
#pragma unroll
        for (int s4 = 0; s4 < 4; ++s4) {
          const int m0_ = dir ? 3 - s4 : s4;
          const uint4 pk = pack8(y[s4]);
          const int i = 4 * rg + s4;
          if (part < 2) *(uint4*)((part == 0 ? Kt : Vt) + i * 256 + ((ch ^ (i & 15)) << 4)) = pk;
          if (dir == 0 && part != 1) *(uint4*)(PP->qkvn + (size_t)(base + tl + m0_) * 1536 + chofs) = pk;
        }
      }
    }
    __syncthreads();
    {
      f32x4 acc[4];
#pragma unroll
      for (int nt = 0; nt < 4; ++nt) acc[nt] = (f32x4){0.f, 0.f, 0.f, 0.f};
#pragma unroll
      for (int s = 0; s < 4; ++s) {
        const int ch = s * 4 + lg;
        const bf16x8 a = *(const bf16x8*)(Kt + (16 * w + lr) * 256 + ((ch ^ lr) << 4));
#pragma unroll
        for (int nt = 0; nt < 4; ++nt) {
          const bf16x8 bb = *(const bf16x8*)(Kt + (16 * nt + lr) * 256 + ((ch ^ lr) << 4));
          acc[nt] = __builtin_amdgcn_mfma_f32_16x16x32_bf16(a, bb, acc[nt], 0, 0, 0);
        }
      }
#pragma unroll
      for (int nt = 0; nt < 4; ++nt)
#pragma unroll
        for (int r = 0; r < 4; ++r) {
          const int i = 16 * w + 4 * lg + r, j = 16 * nt + lr;
          const float val = (j < i) ? bts[i] * acc[nt][r] * __expf(fminf(gcs[i] - gcs[j], 0.f)) : 0.f;
          LN[i * 72 + j] = f2bf(-val);
          if (nt == w) Ld[(w * 16 + lr) * 20 + 4 * lg + r] = val;
        }
    }
    {
      const float glast = gcs[63];
      if (tid == 0) PP->glast[unit] = glast;
#pragma unroll
      for (int q4 = 0; q4 < 4; ++q4) {
        const int fid = tid + 256 * q4;
        const int mt = fid >> 7, s2 = (fid >> 6) & 1, ln = fid & 63, llr = ln & 15, llg = ln >> 4;
        const int d = 16 * mt + llr;
        float f[8];
#pragma unroll
        for (int e = 0; e < 8; ++e) {
          const int pos = kperm(s2, llg, e);
          const float kv = bf2f(*(const u16*)(Kt + pos * 256 + (((d >> 3) ^ (pos & 15)) << 4) + (d & 7) * 2));
          f[e] = kv * egl[pos];
        }
        *(uint4*)(PP->KdT + ((size_t)unit * 1024 + fid) * 8) = pack8(f);
      }
    }
    f32x4 X[4][4];
    {
      const bool isU = w >= 2;
      const char* tile = isU ? Vt : Kt;
#pragma unroll
      for (int mt = 0; mt < 4; ++mt)
#pragma unroll
        for (int nt = 0; nt < 4; ++nt)
#pragma unroll
          for (int r = 0; r < 4; ++r) {
            const int i = 16 * mt + 4 * lg + r, cc = 64 * (w & 1) + 16 * nt + lr;
            const float val = bf2f(*(const u16*)(tile + i * 256 + (((cc >> 3) ^ (i & 15)) << 4) + (cc & 7) * 2));
            X[mt][nt][r] = bts[i] * val * (isU ? 1.f : egc[i]);
          }
    }
    __syncthreads();
    u16* Wst = (u16*)smem;
    u16* Ust = (u16*)(smem + 16384);
#pragma unroll
    for (int bk = 0; bk < 4; ++bk) {
#pragma unroll
      for (int nt = 0; nt < 4; ++nt)
#pragma unroll
        for (int r = 0; r < 4; ++r) Tt[(4 * lg + r) * 64 + 16 * nt + lr] = X[bk][nt][r];
      __builtin_amdgcn_wave_barrier();
      asm volatile("s_waitcnt lgkmcnt(0)" ::: "memory");
      float xb[16];
#pragma unroll
      for (int i = 0; i < 16; ++i) xb[i] = Tt[i * 64 + l];
#pragma unroll
      for (int j = 0; j < 15; ++j) {
        const float xj = xb[j];
#pragma unroll
        for (int i4 = (j + 1) / 4; i4 < 4; ++i4) {
          const float4 lv = *(const float4*)&Ld[(bk * 16 + j) * 20 + i4 * 4];
          if (i4 * 4 + 0 > j) xb[i4 * 4 + 0] -= lv.x * xj;
          if (i4 * 4 + 1 > j) xb[i4 * 4 + 1] -= lv.y * xj;
          if (i4 * 4 + 2 > j) xb[i4 * 4 + 2] -= lv.z * xj;
          if (i4 * 4 + 3 > j) xb[i4 * 4 + 3] -= lv.w * xj;
        }
      }
      {
        const int cc = 64 * (w & 1) + l;
        if (w < 2) {
          const int d = cc, s = d >> 5, e = ((d >> 4) & 1) * 4 + (d & 3), g = (d >> 2) & 3;
#pragma unroll
          for (int ii = 0; ii < 16; ++ii) Wst[(((bk * 4 + s) * 64 + g * 16 + ii) << 3) + e] = f2bf(-xb[ii]);
        } else {
          const int slice = cc >> 4, lr_ = cc & 15;
#pragma unroll
          for (int ii = 0; ii < 16; ++ii) Ust[(((slice * 4 + bk) * 64 + ((ii >> 2) & 3) * 16 + lr_) << 2) + (ii & 3)] = f2bf(xb[ii]);
        }
        if (bk < 3) {
          *(uint4*)(Xb + l * 16) = pack8(xb);
          *(uint4*)(Xb + l * 16 + 8) = pack8(xb + 8);
        }
      }
      if (bk < 3) {
        __builtin_amdgcn_wave_barrier();
        asm volatile("s_waitcnt lgkmcnt(0)" ::: "memory");
        uint4 bfr[4];
#pragma unroll
        for (int nt = 0; nt < 4; ++nt)
          bfr[nt] = (lg < 2) ? *(const uint4*)(Xb + (16 * nt + lr) * 16 + 8 * lg) : make_uint4(0u, 0u, 0u, 0u);
#pragma unroll
        for (int mt = bk + 1; mt < 4; ++mt) {
          const uint4 afr = (lg < 2) ? *(const uint4*)(LN + (16 * mt + lr) * 72 + 16 * bk + 8 * lg) : make_uint4(0u, 0u, 0u, 0u);
#pragma unroll
          for (int nt = 0; nt < 4; ++nt)
            X[mt][nt] = __builtin_amdgcn_mfma_f32_16x16x32_bf16(as_frag(afr), as_frag(bfr[nt]), X[mt][nt], 0, 0, 0);
        }
        __builtin_amdgcn_wave_barrier();
      }
    }
    __syncthreads();
#pragma unroll
    for (int q = 0; q < 4; ++q) {
      const int id = tid + 256 * q;
      *(uint4*)(PP->Wfrag + ((size_t)unit * 1024 + id) * 8) = *(const uint4*)(smem + id * 16);
      *(uint4*)(PP->Ufrag + ((size_t)unit * 1024 + id) * 8) = *(const uint4*)(smem + 16384 + id * 16);
    }
  }
}


__device__ __forceinline__ void phase_scan(char* smem) {
  const KP PP = get_params();
  const int tid = TID(), lane = tid & 63, wv = tid >> 6;
  __builtin_amdgcn_s_setprio(3);
  for (int item = BID(); item < 128; item += gridDim.x) {
    const int u16i = (item & 7) * 2 + (item >> 6), slice = (item >> 3) & 7;
    const size_t ubase = (size_t)u16i * NCHUNK;
    const uint4* Wg = (const uint4*)PP->Wfrag;
    const uint4* Kg = (const uint4*)PP->KdT;
    __syncthreads();
    if (wv != 0) {
      const int j0 = wv - 1;
      uint4 st0[11], st1[11], st2[11];
#pragma unroll
      for (int i = 0; i < 11; ++i) { st0[i] = make_uint4(0u, 0u, 0u, 0u); st1[i] = st0[i]; st2[i] = st0[i]; }
#define LLOAD(ST, UNIT)                                                                                      \
  _Pragma("unroll") for (int i = 0; i < 11; ++i) {                                                           \
    const int q = (j0 + 3 * i) < 32 ? (j0 + 3 * i) : 31;                                                     \
    ST[i] = *((q < 16 ? Wg + (UNIT) * 1024 + q * 64 : Kg + (UNIT) * 1024 + (q - 16) * 64) + lane);           \
  }
#define LWRITE(ST, SLOT)                                                                                     \
  _Pragma("unroll") for (int i = 0; i < 11; ++i) {                                                           \
    const int q = (j0 + 3 * i) < 32 ? (j0 + 3 * i) : 31;                                                     \
    *(uint4*)((SLOT) + q * 1024 + lane * 16) = ST[i];                                                        \
  }
      LLOAD(st0, ubase);
      LLOAD(st1, ubase + 1);
      LLOAD(st2, ubase + 2);
      LWRITE(st0, smem);
      LLOAD(st0, ubase + 3);
      __syncthreads();
#define LSTEP(ST, C)                                                                   \
  {                                                                                    \
    LWRITE(ST, smem + (((C) + 1) & 1) * 32768);                                        \
    LLOAD(ST, ubase + (size_t)(((C) + 4 < NCHUNK) ? (C) + 4 : NCHUNK - 1));            \
    __syncthreads();                                                                   \
  }
      for (int c0 = 0; c0 < NCHUNK; c0 += 3) {
        LSTEP(st1, c0);
        LSTEP(st2, c0 + 1);
        LSTEP(st0, c0 + 2);
      }
#undef LSTEP
#undef LLOAD
#undef LWRITE
    } else {
      f32x4 S[8];
#pragma unroll
      for (int t = 0; t < 8; ++t) S[t] = (f32x4){0.f, 0.f, 0.f, 0.f};
      uint2 uf0[5], uf1[5], uf2[5];
#pragma unroll
      for (int i = 0; i < 5; ++i) { uf0[i] = make_uint2(0u, 0u); uf1[i] = uf0[i]; uf2[i] = uf0[i]; }
      const uint2* Ug = (const uint2*)PP->Ufrag + lane;
      const float* Gl = PP->glast;
#define ULOAD(UF, UNIT) { _Pragma("unroll") for (int i = 0; i < 4; ++i) UF[i] = Ug[((UNIT) * 8 + slice) * 256 + i * 64]; UF[4].x = __float_as_uint(Gl[UNIT]); }
      ULOAD(uf0, ubase);
      ULOAD(uf1, ubase + 1);
      ULOAD(uf2, ubase + 2);
#define CSTEP(UF, C)                                                                                                   \
  {                                                                                                                    \
    const int c = (C);                                                                                                 \
    const size_t unit = ubase + c;                                                                                     \
    const char* slot = smem + (c & 1) * 32768;                                                                         \
    const float el = __expf(__uint_as_float(UF[4].x));                                                                 \
    uint4 sb[4];                                                                                                       \
    _Pragma("unroll") for (int s2 = 0; s2 < 4; ++s2) sb[s2] = pack_tiles(S[2 * s2], S[2 * s2 + 1]);                    \
    {                                                                                                                  \
      uint4* sp = (uint4*)PP->Sfrag + (unit * 8 + slice) * 256 + lane;                                                 \
      _Pragma("unroll") for (int s2 = 0; s2 < 4; ++s2) sp[s2 * 64] = sb[s2];                                           \
    }                                                                                                                  \
    f32x4 vn[4];                                                                                                       \
    _Pragma("unroll") for (int mt = 0; mt < 4; ++mt) {                                                                 \
      vn[mt] = (f32x4){bf_lo(UF[mt].x), bf_hi(UF[mt].x), bf_lo(UF[mt].y), bf_hi(UF[mt].y)};                            \
      _Pragma("unroll") for (int s2 = 0; s2 < 4; ++s2) {                                                               \
        const uint4 wfr = *(const uint4*)(slot + (mt * 4 + s2) * 1024 + lane * 16);                                    \
        vn[mt] = __builtin_amdgcn_mfma_f32_16x16x32_bf16(as_frag(wfr), as_frag(sb[s2]), vn[mt], 0, 0, 0);              \
      }                                                                                                                \
    }                                                                                                                  \
    ULOAD(UF, ubase + (size_t)((c + 3 < NCHUNK) ? c + 3 : NCHUNK - 1));                                                \
    uint4 vb[2];                                                                                                       \
    vb[0] = pack_tiles(vn[0], vn[1]);                                                                                  \
    vb[1] = pack_tiles(vn[2], vn[3]);                                                                                  \
    {                                                                                                                  \
      uint4* vp = (uint4*)PP->Vfrag + (unit * 8 + slice) * 128 + lane;                                                 \
      vp[0] = vb[0];                                                                                                   \
      vp[64] = vb[1];                                                                                                  \
    }                                                                                                                  \
    _Pragma("unroll") for (int t = 0; t < 8; ++t) {                                                                    \
      S[t] *= el;                                                                                                      \
      const uint4 k0 = *(const uint4*)(slot + 16384 + (t * 2 + 0) * 1024 + lane * 16);                                 \
      const uint4 k1 = *(const uint4*)(slot + 16384 + (t * 2 + 1) * 1024 + lane * 16);                                 \
      S[t] = __builtin_amdgcn_mfma_f32_16x16x32_bf16(as_frag(k0), as_frag(vb[0]), S[t], 0, 0, 0);                      \
      S[t] = __builtin_amdgcn_mfma_f32_16x16x32_bf16(as_frag(k1), as_frag(vb[1]), S[t], 0, 0, 0);                      \
    }                                                                                                                  \
    __syncthreads();                                                                                                   \
  }
      __syncthreads();
      for (int c0 = 0; c0 < NCHUNK; c0 += 3) {
        CSTEP(uf0, c0);
        CSTEP(uf1, c0 + 1);
        CSTEP(uf2, c0 + 2);
      }
#undef CSTEP
#undef ULOAD
    }
  }
  __builtin_amdgcn_s_setprio(0);
}

__device__ __forceinline__ void phase_o(int layer, char* smem) {
  const KP PP = get_params();
  const int tid = TID(), l = tid & 63, w = tid >> 6, lr = l & 15, lg = l >> 4;
  char* Qt = smem;
  char* Kt = smem + 16384;
  u16* If = (u16*)(smem + 32768);
  u16* Ib = (u16*)(smem + 41984);
  float* gcf = (float*)(smem + 51200);
  float* gcb = gcf + 64;
  float* rowss = gcb + 64;
  float* Os = (float*)smem;
  const int nper = (layer == DEPTH - 1) ? 128 : 132;
  const int xq = BID() & 7, vl0 = BID() >> 3, vstep = gridDim.x >> 3;
  for (int vi = vl0; vi < nper; vi += vstep) {
    int b = xq >> 2, hd = xq & 3, tok0, cf, cb;
    if (vi < 128) {
      const int n = vi;
      tok0 = b * SEQ + 64 * n; cf = 4 + n; cb = 4 + 127 - n;
    } else {
      const int n = vi - 128;
      tok0 = NLAT + b * CTX + 64 * n; cf = n; cb = 3 - n;
    }
    const size_t unit_f = (size_t)((b * 4 + hd) * 2 + 0) * NCHUNK + cf;
    const size_t unit_b = (size_t)((b * 4 + hd) * 2 + 1) * NCHUNK + cb;
    uint4 pSF[4][2], pSB[4][2], pVF[2][2], pVB[2][2];
#pragma unroll
    for (int q = 0; q < 2; ++q) {
      const int sl = 2 * w + q;
#pragma unroll
      for (int s = 0; s < 4; ++s) {
        pSF[s][q] = *((const uint4*)PP->Sfrag + ((unit_f * 8 + sl) * 4 + s) * 64 + l);
        pSB[s][q] = *((const uint4*)PP->Sfrag + ((unit_b * 8 + sl) * 4 + s) * 64 + l);
      }
#pragma unroll
      for (int s2 = 0; s2 < 2; ++s2) {
        pVF[s2][q] = *((const uint4*)PP->Vfrag + ((unit_f * 8 + sl) * 2 + s2) * 64 + l);
        pVB[s2][q] = *((const uint4*)PP->Vfrag + ((unit_b * 8 + sl) * 2 + s2) * 64 + l);
      }
    }
    __syncthreads();
    for (int idx = tid; idx < 2048; idx += NTHR) {
      const int arr = idx >> 10, i = (idx >> 4) & 63, ch = idx & 15;
      const uint4 v = *(const uint4*)(PP->qkvn + (size_t)(tok0 + i) * 1536 + (arr == 0 ? 0 : 512) + hd * 128 + ch * 8);
      *(uint4*)((arr == 0 ? Qt : Kt) + i * 256 + ((ch ^ (i & 15)) << 4)) = v;
    }
    if (tid < 64) gcf[tid] = PP->gc[unit_f * 64 + tid];
    else if (tid < 128) gcb[tid - 64] = PP->gc[unit_b * 64 + (tid - 64)];
    __syncthreads();
    {
      f32x4 acc[4];
#pragma unroll
      for (int nt = 0; nt < 4; ++nt) acc[nt] = (f32x4){0.f, 0.f, 0.f, 0.f};
#pragma unroll
      for (int s = 0; s < 4; ++s) {
        const int ch = s * 4 + lg;
        const bf16x8 a = *(const bf16x8*)(Qt + (16 * w + lr) * 256 + ((ch ^ lr) << 4));
#pragma unroll
        for (int nt = 0; nt < 4; ++nt) {
          const bf16x8 bb = *(const bf16x8*)(Kt + (16 * nt + lr) * 256 + ((ch ^ lr) << 4));
          acc[nt] = __builtin_amdgcn_mfma_f32_16x16x32_bf16(a, bb, acc[nt], 0, 0, 0);
        }
      }
#pragma unroll
      for (int nt = 0; nt < 4; ++nt)
#pragma unroll
        for (int r = 0; r < 4; ++r) {
          const int i = 16 * w + 4 * lg + r, j = 16 * nt + lr;
          const float vf = (j <= i) ? acc[nt][r] * __expf(fminf(gcf[i] - gcf[j], 0.f)) : 0.f;
          const float vb = (j >= i) ? acc[nt][r] * __expf(fminf(gcb[63 - i] - gcb[63 - j], 0.f)) : 0.f;
          If[i * 72 + j] = f2bf(vf);
          Ib[i * 72 + (63 - j)] = f2bf(vb);
        }
    }
    __syncthreads();
    f32x4 accF[4][2], accB[4][2], accI[4][2];
#pragma unroll
    for (int mt = 0; mt < 4; ++mt)
#pragma unroll
      for (int q = 0; q < 2; ++q) {
        accF[mt][q] = (f32x4){0.f, 0.f, 0.f, 0.f};
        accB[mt][q] = (f32x4){0.f, 0.f, 0.f, 0.f};
        accI[mt][q] = (f32x4){0.f, 0.f, 0.f, 0.f};
      }
#pragma unroll
    for (int s = 0; s < 4; ++s) {
      bf16x8 qa[4];
#pragma unroll
      for (int mt = 0; mt < 4; ++mt) {
        const int row = 16 * mt + lr;
        const int c0 = 4 * s + (lg >> 1), c1 = c0 + 2;
        const uint2 lo = *(const uint2*)(Qt + row * 256 + ((c0 ^ lr) << 4) + (lg & 1) * 8);
        const uint2 hi = *(const uint2*)(Qt + row * 256 + ((c1 ^ lr) << 4) + (lg & 1) * 8);
        const uint4 t = make_uint4(lo.x, lo.y, hi.x, hi.y);
        qa[mt] = as_frag(t);
      }
#pragma unroll
      for (int q = 0; q < 2; ++q) {
        const int sl = 2 * w + q;
        const uint4 bF = pSF[s][q], bB = pSB[s][q];
#pragma unroll
        for (int mt = 0; mt < 4; ++mt) {
          accF[mt][q] = __builtin_amdgcn_mfma_f32_16x16x32_bf16(qa[mt], as_frag(bF), accF[mt][q], 0, 0, 0);
          accB[mt][q] = __builtin_amdgcn_mfma_f32_16x16x32_bf16(qa[mt], as_frag(bB), accB[mt][q], 0, 0, 0);
        }
      }
    }
#pragma unroll
    for (int s2 = 0; s2 < 2; ++s2) {
      bf16x8 ia[4], ib[4];
#pragma unroll
      for (int mt = 0; mt < 4; ++mt) {
        const int row = 16 * mt + lr;
        const int col = 32 * s2 + 4 * lg;
        const uint2 flo = *(const uint2*)(If + row * 72 + col);
        const uint2 fhi = *(const uint2*)(If + row * 72 + col + 16);
        const uint2 blo = *(const uint2*)(Ib + row * 72 + col);
        const uint2 bhi = *(const uint2*)(Ib + row * 72 + col + 16);
        const uint4 tf = make_uint4(flo.x, flo.y, fhi.x, fhi.y);
        const uint4 tb = make_uint4(blo.x, blo.y, bhi.x, bhi.y);
        ia[mt] = as_frag(tf);
        ib[mt] = as_frag(tb);
      }
#pragma unroll
      for (int q = 0; q < 2; ++q) {
        const int sl = 2 * w + q;
        const uint4 vF = pVF[s2][q], vB = pVB[s2][q];
#pragma unroll
        for (int mt = 0; mt < 4; ++mt) {
          accI[mt][q] = __builtin_amdgcn_mfma_f32_16x16x32_bf16(ia[mt], as_frag(vF), accI[mt][q], 0, 0, 0);
          accI[mt][q] = __builtin_amdgcn_mfma_f32_16x16x32_bf16(ib[mt], as_frag(vB), accI[mt][q], 0, 0, 0);
        }
      }
    }
    float o[4][2][4], ssr[4][4];
#pragma unroll
    for (int mt = 0; mt < 4; ++mt)
#pragma unroll
      for (int r = 0; r < 4; ++r) {
        const int i = 16 * mt + 4 * lg + r;
        const float ef = __expf(gcf[i]), eb = __expf(gcb[63 - i]);
        float ss = 0.f;
#pragma unroll
        for (int q = 0; q < 2; ++q) {
          const float v = ef * accF[mt][q][r] + eb * accB[mt][q][r] + accI[mt][q][r];
          o[mt][q][r] = v;
          ss += v * v;
        }
        ssr[mt][r] = ss;
      }
#define O_RED(O_)                                                                  \
    _Pragma("unroll") for (int mt = 0; mt < 4; ++mt)                               \
      _Pragma("unroll") for (int r = 0; r < 4; ++r) ssr[mt][r] += swz_xor<O_>(ssr[mt][r]);
    O_RED(8) O_RED(4) O_RED(2) O_RED(1)
#undef O_RED
    if (lr == 0) {
#pragma unroll
      for (int mt = 0; mt < 4; ++mt)
#pragma unroll
        for (int r = 0; r < 4; ++r) rowss[w * 64 + 16 * mt + 4 * lg + r] = ssr[mt][r];
    }
    __syncthreads();
#pragma unroll
    for (int mt = 0; mt < 4; ++mt)
#pragma unroll
      for (int q = 0; q < 2; ++q)
#pragma unroll
        for (int r = 0; r < 4; ++r) Os[(16 * mt + 4 * lg + r) * 132 + 16 * (2 * w + q) + lr] = o[mt][q][r];
    __syncthreads();
#pragma unroll
    for (int q4 = 0; q4 < 4; ++q4) {
      const int idx = tid + 256 * q4, i = idx >> 4, ch = idx & 15;
      const float ss = rowss[i] + rowss[64 + i] + rowss[128 + i] + rowss[192 + i];
      const float rs = rsqrtf(ss * (1.f / 128.f) + EPS);
      const float4 o0 = *(const float4*)&Os[i * 132 + ch * 8];
      const float4 o1 = *(const float4*)&Os[i * 132 + ch * 8 + 4];
      const float4 n0 = *(const float4*)(PP->dn_out_norm + layer * 128 + ch * 8);
      const float4 n1 = *(const float4*)(PP->dn_out_norm + layer * 128 + ch * 8 + 4);
      float zf[8];
      unpack8(*(const uint4*)(PP->z + (size_t)(tok0 + i) * 512 + hd * 128 + ch * 8), zf);
      float y[8];
      y[0] = o0.x * rs * n0.x * siluf_(zf[0]); y[1] = o0.y * rs * n0.y * siluf_(zf[1]);
      y[2] = o0.z * rs * n0.z * siluf_(zf[2]); y[3] = o0.w * rs * n0.w * siluf_(zf[3]);
      y[4] = o1.x * rs * n1.x * siluf_(zf[4]); y[5] = o1.y * rs * n1.y * siluf_(zf[5]);
      y[6] = o1.z * rs * n1.z * siluf_(zf[6]); y[7] = o1.w * rs * n1.w * siluf_(zf[7]);
      {
        int p0 = __builtin_amdgcn_cvt_pk_fp8_f32(y[0], y[1], 0, false);
        p0 = __builtin_amdgcn_cvt_pk_fp8_f32(y[2], y[3], p0, true);
        int p1 = __builtin_amdgcn_cvt_pk_fp8_f32(y[4], y[5], 0, false);
        p1 = __builtin_amdgcn_cvt_pk_fp8_f32(y[6], y[7], p1, true);
        *(int2*)((char*)PP->ydn + (size_t)(tok0 + i) * (LDK5 * 2) + hd * 128 + ch * 8) = make_int2(p0, p1);
      }
    }
  }
}

template <int HALF>
DEV void pool_window(const u16* xin, char* Ap, int t0, int L, int tid) {
#pragma unroll
  for (int q = 0; q < 4; ++q) {
    const int idx = tid + 256 * q, i = idx >> 4, c = idx & 15;
    const int t = t0 + i;
    const int lo = (t - HALF) > 0 ? (t - HALF) : 0;
    const int hi = (t + HALF) < L ? (t + HALF) : L;
    float s[8];
#pragma unroll
    for (int e = 0; e < 8; ++e) s[e] = 0.f;
#pragma unroll
    for (int k = 0; k < 2 * HALF; ++k) {
      float f[8];
      unpack8(*(const uint4*)(xin + (i + 8 - HALF + k) * 128 + c * 8), f);
#pragma unroll
      for (int e = 0; e < 8; ++e) s[e] += f[e];
    }
    float xs[8];
    unpack8(*(const uint4*)(xin + (i + 8) * 128 + c * 8), xs);
    const float inv = 1.f / (float)(hi - lo);
#pragma unroll
    for (int e = 0; e < 8; ++e) s[e] = s[e] * inv - xs[e];
    *(uint4*)(Ap + i * 256 + ((c ^ (i & 15)) << 4)) = pack8(s);
  }
}

__device__ __forceinline__ void phase_pool(int layer, char* smem, int vbid, int vnb) {
  const KP PP = get_params();
  const int tid = TID(), l = tid & 63, w = tid >> 6, lr = l & 15, lg = l >> 4;
  u16* xin = (u16*)smem;
  char* Ap = smem + 20480;
  char* Bs = smem + 36864;
  const int ntile = (layer == DEPTH - 1) ? NLAT / 64 : R / 64;
  for (int it = vbid; it < ntile * 4; it += vnb) {
    const int ti = it >> 2, g = it & 3;
    int L, t0, rowbase;
    if (ti < NLAT / 64) { L = 64; t0 = 0; rowbase = ti * 64; }
    else { const int ci = ti - NLAT / 64; L = CTX; t0 = (ci & 3) * 64; rowbase = NLAT + (ci >> 2) * CTX; }
    const int r0 = rowbase + t0;
    __syncthreads();
#pragma unroll
    for (int q = 0; q < 5; ++q) {
      const int idx = tid + 256 * q, i = idx >> 4, c = idx & 15;
      const int pos = t0 - 8 + i;
      uint4 v = make_uint4(0, 0, 0, 0);
      if (pos >= 0 && pos < L) v = *(const uint4*)(PP->pin + (size_t)(rowbase + pos) * 512 + g * 128 + c * 8);
      *(uint4*)(xin + i * 128 + c * 8) = v;
    }
    {
      const u16* Bw = PP->PwT + (size_t)(layer * 4 + g) * 128 * 128;
#pragma unroll
      for (int q = 0; q < 8; ++q) {
        const int idx = tid + 256 * q, n = idx >> 4, c = idx & 15;
        *(uint4*)(Bs + n * 256 + ((c ^ (n & 15)) << 4)) = *(const uint4*)(Bw + (size_t)n * 128 + c * 8);
      }
    }
    __syncthreads();
    if (g == 0) pool_window<1>(xin, Ap, t0, L, tid);
    else if (g == 1) pool_window<2>(xin, Ap, t0, L, tid);
    else if (g == 2) pool_window<4>(xin, Ap, t0, L, tid);
    else pool_window<8>(xin, Ap, t0, L, tid);
    __syncthreads();
    f32x4 acc[8];
#pragma unroll
    for (int ni = 0; ni < 8; ++ni) acc[ni] = (f32x4){0.f, 0.f, 0.f, 0.f};
#pragma unroll
    for (int ks = 0; ks < 4; ++ks) {
      const int row = w * 16 + lr, c = ks * 4 + lg;
      const bf16x8 a = *(const bf16x8*)(Ap + row * 256 + ((c ^ lr) << 4));
#pragma unroll
      for (int ni = 0; ni < 8; ++ni) {
        const bf16x8 bb = *(const bf16x8*)(Bs + (ni * 16 + lr) * 256 + ((c ^ lr) << 4));
        acc[ni] = __builtin_amdgcn_mfma_f32_16x16x32_bf16(bb, a, acc[ni], 0, 0, 0);
      }
    }
    unsigned char* ot = (unsigned char*)smem;
#pragma unroll
    for (int ni = 0; ni < 8; ++ni) {
      const int dcol = ni * 16 + 4 * lg;
      const float4 psc = *(const float4*)(PP->pool_scale + layer * 512 + g * 128 + dcol);
      int pk = __builtin_amdgcn_cvt_pk_fp8_f32(acc[ni][0] * psc.x, acc[ni][1] * psc.y, 0, false);
      pk = __builtin_amdgcn_cvt_pk_fp8_f32(acc[ni][2] * psc.z, acc[ni][3] * psc.w, pk, true);
      *(int*)(ot + (w * 16 + lr) * 128 + dcol) = pk;
    }
    __syncthreads();
    {
      const int row = tid >> 2, seg = tid & 3;
      const uint4 o0 = *(const uint4*)(ot + row * 128 + seg * 32), o1 = *(const uint4*)(ot + row * 128 + seg * 32 + 16);
      unsigned char* dst = (unsigned char*)PP->ypool + (size_t)(r0 + row) * (LDK5 * 2) + g * 128 + seg * 32;
      *(uint4*)dst = o0;
      *(uint4*)(dst + 16) = o1;
    }
  }
}

__device__ __forceinline__ void phase_merge(int layer, char* smem) {
  const KP PP = get_params();
  const char* Bd = (const char*)(PP->WdT + (size_t)layer * 1024 * LDK5);
  const char* Bp = (const char*)(PP->WpT + (size_t)layer * 1024 * LDK5);
  const char* Ad = (const char*)PP->ydn;
  const char* Ap = (const char*)PP->ypool;
  const int tid = TID();
  const int l = tid & 63, w = tid >> 6, wm = w >> 1, wn = w & 1, lr = l & 15, lg = l >> 4;
  uint4 ga[4], gb[4];
#pragma unroll
  for (int i = 0; i < 4; ++i) { ga[i] = make_uint4(0u, 0u, 0u, 0u); gb[i] = ga[i]; }
  const int r0 = tid >> 3, c0 = tid & 7;
#define MG_GLOAD(AP, BP, KT_)                                                                  \
  _Pragma("unroll") for (int i = 0; i < 4; ++i) {                                              \
    ga[i] = *(const uint4*)((AP) + (size_t)(m0 + 32 * i + r0) * (LDK5 * 2) + c0 * 16 + (KT_) * 128);  \
    gb[i] = *(const uint4*)((BP) + (size_t)(n0 + 32 * i + r0) * LDK5 + c0 * 16 + (KT_) * 128);        \
  }
#define MG_LSTORE(BUF)                                                                         \
  {                                                                                            \
    char* as_ = smem + (BUF) * 32768;                                                          \
    char* bs_ = as_ + 16384;                                                                   \
    _Pragma("unroll") for (int i = 0; i < 4; ++i) {                                            \
      const int id = tid + 256 * i, row = id >> 3, c = id & 7;                                 \
      const int off = row * 128 + ((c ^ (row & 7)) << 4);                                      \
      *(uint4*)(as_ + off) = ga[i];                                                            \
      *(uint4*)(bs_ + off) = gb[i];                                                            \
    }                                                                                          \
  }
#define MG_COMPUTE(ACC, BUF)                                                                                              \
  {                                                                                                                       \
    const char* as_ = smem + (BUF) * 32768;                                                                               \
    const char* bs_ = as_ + 16384;                                                                                        \
    i32x8 a[4], b[4];                                                                                                     \
    const int sw0 = ((lg ^ (lr & 7)) << 4), sw1 = (((4 + lg) ^ (lr & 7)) << 4);                                           \
    _Pragma("unroll") for (int mi = 0; mi < 4; ++mi) {                                                                    \
      const char* p_ = as_ + (wm * 64 + mi * 16 + lr) * 128;                                                              \
      const i32x4 lo_ = *(const i32x4*)(p_ + sw0), hi_ = *(const i32x4*)(p_ + sw1);                                       \
      a[mi] = __builtin_shufflevector(lo_, hi_, 0, 1, 2, 3, 4, 5, 6, 7);                                                  \
    }                                                                                                                     \
    _Pragma("unroll") for (int ni = 0; ni < 4; ++ni) {                                                                    \
      const char* p_ = bs_ + (wn * 64 + ni * 16 + lr) * 128;                                                              \
      const i32x4 lo_ = *(const i32x4*)(p_ + sw0), hi_ = *(const i32x4*)(p_ + sw1);                                       \
      b[ni] = __builtin_shufflevector(lo_, hi_, 0, 1, 2, 3, 4, 5, 6, 7);                                                  \
    }                                                                                                                     \
    _Pragma("unroll") for (int mi = 0; mi < 4; ++mi)                                                                      \
      _Pragma("unroll") for (int ni = 0; ni < 4; ++ni)                                                                    \
        ACC[mi][ni] = __builtin_amdgcn_mfma_scale_f32_16x16x128_f8f6f4(a[mi], b[ni], ACC[mi][ni], 0, 0, 0, 0, 0, 0);      \
  }
  const int MT = (layer == DEPTH - 1) ? NLAT / 128 : R / 128;
  for (int it = 0;; ++it) {
    int mt, nt;
    if (!tile_map(it, MT, 8, mt, nt)) break;
    const int m0 = mt * 128, n0 = nt * 128;
    f32x4 acc[4][4];
    zero_acc(acc);
    __syncthreads();
    MG_GLOAD(Ad, Bd, 0);
    MG_LSTORE(0);
    __syncthreads();
#pragma unroll
    for (int kt = 0; kt < 4; ++kt) {
      if (kt + 1 < 4) { MG_GLOAD(Ad, Bd, kt + 1); } else { MG_GLOAD(Ap, Bp, 0); }
      MG_COMPUTE(acc, kt & 1);
      MG_LSTORE((kt + 1) & 1);
      __syncthreads();
    }
    uint2 tq[2][8];
#pragma unroll
    for (int hs = 0; hs < 2; ++hs)
#pragma unroll
      for (int j = 0; j < 8; ++j) tq[hs][j] = make_uint2(0u, 0u);
#pragma unroll
    for (int hs = 0; hs < 2; ++hs) {
      float4 v1[8];
      stage_half(acc, hs, smem + 32768, v1);
#pragma unroll
      for (int j = 0; j < 8; ++j) tq[hs][j] = make_uint2(pack_bf16(v1[j].x, v1[j].y), pack_bf16(v1[j].z, v1[j].w));
    }
    __builtin_amdgcn_sched_barrier(0);
    zero_acc(acc);
    __syncthreads();
#pragma unroll
    for (int kt = 0; kt < 4; ++kt) {
      if (kt + 1 < 4) { MG_GLOAD(Ap, Bp, kt + 1); }
      MG_COMPUTE(acc, kt & 1);
      if (kt + 1 < 4) { MG_LSTORE((kt + 1) & 1); }
      __syncthreads();
    }
#pragma unroll
    for (int hs = 0; hs < 2; ++hs) {
      float4 v2[8];
      stage_half(acc, hs, smem, v2);
      const int tid2 = TID();
#pragma unroll
      for (int j = 0; j < 8; ++j) {
        const int idx = tid2 + 256 * j, row = idx >> 5, c4 = idx & 31;
        const size_t gr = (size_t)(m0 + hs * 64 + row);
        const int gc = n0 + c4 * 4;
        const unsigned gd = *(const unsigned*)((const unsigned char*)PP->sgd + gr * 1024 + gc);
        const unsigned gp = *(const unsigned*)((const unsigned char*)PP->sgp + gr * 1024 + gc);
        const uint2 t = tq[hs][j];
        constexpr float GS = 1.f / (255.f * 32.f);
        const float o0 = ((float)(gd & 0xffu) * bf_lo(t.x) + (float)(gp & 0xffu) * v2[j].x) * GS;
        const float o1 = ((float)((gd >> 8) & 0xffu) * bf_hi(t.x) + (float)((gp >> 8) & 0xffu) * v2[j].y) * GS;
        const float o2 = ((float)((gd >> 16) & 0xffu) * bf_lo(t.y) + (float)((gp >> 16) & 0xffu) * v2[j].z) * GS;
        const float o3 = ((float)(gd >> 24) * bf_hi(t.y) + (float)(gp >> 24) * v2[j].w) * GS;
        int pk = __builtin_amdgcn_cvt_pk_fp8_f32(o0, o1, 0, false);
        pk = __builtin_amdgcn_cvt_pk_fp8_f32(o2, o3, pk, true);
        *(int*)((char*)PP->m + gr * (LDK1 * 2) + gc) = pk;
        if ((j & 1) == 1) __builtin_amdgcn_sched_barrier(0);
      }
    }
  }
#undef MG_GLOAD
#undef MG_LSTORE
#undef MG_COMPUTE
}

__device__ __forceinline__ void phase_outproj(int layer, char* smem) {
  const KP PP = get_params();
  const char* Bt = (const char*)(PP->WoT + (size_t)layer * 1024 * LDK1);
  const char* A = (const char*)PP->m;
  F8_LOCALS
  const int MT = (layer == DEPTH - 1) ? NLAT / 128 : R / 128;
  int it = 0, mt, nt;
  if (!tile_map(it, MT, 8, mt, nt)) return;
  int m0 = mt * 128, n0 = nt * 128;
  F8_PROLOGUE(A, LDK1 * 2, Bt, LDK1)
  for (;;) {
    int mtn = 0, ntn = 0;
    const bool hasn = tile_map(it + 1, MT, 8, mtn, ntn);
    const int m0n = mtn * 128, n0n = ntn * 128;
    f32x4 acc[4][4];
    zero_acc(acc);
    F8_KLOOP(A, LDK1 * 2, Bt, LDK1, 8)
#pragma unroll
    for (int mi = 0; mi < 4; ++mi) {
      const int gr = m0 + wm * 64 + mi * 16 + lr;
      const float* modp = PP->mod + (size_t)(layer * 3 + modsel(gr)) * 6144 + 2048;
      const float* xin;
      float* xo;
      if (gr < NLAT) {
        xin = (layer == 0 ? PP->x : PP->out) + (size_t)gr * 1024;
        xo = PP->out + (size_t)gr * 1024;
      } else {
        xin = (layer == 0 ? PP->ctx : PP->xc) + (size_t)(gr - NLAT) * 1024;
        xo = PP->xc + (size_t)(gr - NLAT) * 1024;
      }
#pragma unroll
      for (int g = 0; g < 2; ++g) {
        const int gc = n0 + wn * 64 + g * 32 + 8 * lg;
#pragma unroll
        for (int n = 0; n < 2; ++n) {
          const f32x4 t = acc[mi][2 * g + n] * (1.f / 32.f);
          const float4 gt = *(const float4*)(modp + gc + 4 * n);
          const float4 xi = *(const float4*)(xin + gc + 4 * n);
          *(float4*)(xo + gc + 4 * n) = make_float4(xi.x + gt.x * t[0], xi.y + gt.y * t[1], xi.z + gt.z * t[2], xi.w + gt.w * t[3]);
        }
      }
    }
    if (!hasn) break;
    m0 = m0n; n0 = n0n; ++it;
  }
}

DEV void gemm_mainloop_f8(const char* __restrict__ A, int lda, const char* __restrict__ B, int ldb, int KT, int m0, int n0,
                          char* smem, f32x4 (&acc)[4][4]) {
  const int tid = TID();
  const int l = tid & 63, w = tid >> 6, wm = w >> 1, wn = w & 1, lr = l & 15, lg = l >> 4;
  uint4 ga0[4], gb0[4], ga1[4], gb1[4];
#pragma unroll
  for (int i = 0; i < 4; ++i) { ga0[i] = make_uint4(0u, 0u, 0u, 0u); gb0[i] = ga0[i]; ga1[i] = ga0[i]; gb1[i] = ga0[i]; }
  const int r0 = tid >> 3, c0 = tid & 7;
#define Q8_GLOAD(GA, GB, KT_)                                                                  \
  _Pragma("unroll") for (int i = 0; i < 4; ++i) {                                              \
    GA[i] = *(const uint4*)(A + (size_t)(m0 + 32 * i + r0) * lda + c0 * 16 + (KT_) * 128);     \
    GB[i] = *(const uint4*)(B + (size_t)(n0 + 32 * i + r0) * ldb + c0 * 16 + (KT_) * 128);     \
  }
#define Q8_LSTORE(GA, GB, BUF)                                                                 \
  {                                                                                            \
    char* as_ = smem + (BUF) * 32768;                                                          \
    char* bs_ = as_ + 16384;                                                                   \
    _Pragma("unroll") for (int i = 0; i < 4; ++i) {                                            \
      const int id = tid + 256 * i, row = id >> 3, c = id & 7;                                 \
      const int off = row * 128 + ((c ^ (row & 7)) << 4);                                      \
      *(uint4*)(as_ + off) = GA[i];                                                            \
      *(uint4*)(bs_ + off) = GB[i];                                                            \
    }                                                                                          \
  }
#define Q8_COMPUTE(BUF)                                                                                                   \
  {                                                                                                                       \
    const char* as_ = smem + (BUF) * 32768;                                                                               \
    const char* bs_ = as_ + 16384;                                                                                        \
    i32x8 a[4], b[4];                                                                                                     \
    const int sw0 = ((lg ^ (lr & 7)) << 4), sw1 = (((4 + lg) ^ (lr & 7)) << 4);                                           \
    _Pragma("unroll") for (int mi = 0; mi < 4; ++mi) {                                                                    \
      const char* p_ = as_ + (wm * 64 + mi * 16 + lr) * 128;                                                              \
      const i32x4 lo_ = *(const i32x4*)(p_ + sw0), hi_ = *(const i32x4*)(p_ + sw1);                                       \
      a[mi] = __builtin_shufflevector(lo_, hi_, 0, 1, 2, 3, 4, 5, 6, 7);                                                  \
    }                                                                                                                     \
    _Pragma("unroll") for (int ni = 0; ni < 4; ++ni) {                                                                    \
      const char* p_ = bs_ + (wn * 64 + ni * 16 + lr) * 128;                                                              \
      const i32x4 lo_ = *(const i32x4*)(p_ + sw0), hi_ = *(const i32x4*)(p_ + sw1);                                       \
      b[ni] = __builtin_shufflevector(lo_, hi_, 0, 1, 2, 3, 4, 5, 6, 7);                                                  \
    }                                                                                                                     \
    _Pragma("unroll") for (int mi = 0; mi < 4; ++mi)                                                                      \
      _Pragma("unroll") for (int ni = 0; ni < 4; ++ni)                                                                    \
        acc[mi][ni] = __builtin_amdgcn_mfma_scale_f32_16x16x128_f8f6f4(a[mi], b[ni], acc[mi][ni], 0, 0, 0, 0, 0, 0);      \
  }
  __syncthreads();
  Q8_GLOAD(ga0, gb0, 0);
  Q8_GLOAD(ga1, gb1, 1);
  Q8_LSTORE(ga0, gb0, 0);
  __syncthreads();
  for (int kt = 0; kt < KT; kt += 2) {
    if (kt + 2 < KT) { Q8_GLOAD(ga0, gb0, kt + 2); }
    Q8_COMPUTE(0);
    Q8_LSTORE(ga1, gb1, 1);
    __syncthreads();
    if (kt + 3 < KT) { Q8_GLOAD(ga1, gb1, kt + 3); }
    Q8_COMPUTE(1);
    if (kt + 2 < KT) { Q8_LSTORE(ga0, gb0, 0); }
    __syncthreads();
  }
#undef Q8_GLOAD
#undef Q8_LSTORE
#undef Q8_COMPUTE
}

__device__ __forceinline__ void phase_peerq(int layer, char* smem) {
  const KP PP = get_params();
  const char* Bt = (const char*)PP->WkT + (size_t)layer * 2048 * LDK1;
  const int tid = TID();
  const int l = tid & 63, w = tid >> 6, wm = w >> 1, wn = w & 1, lr = l & 15, lg = l >> 4;
  const int MT = (layer == DEPTH - 1) ? NLAT / 128 : R / 128;
  for (int it = 0;; ++it) {
    int mt, nt;
    if (!tile_map(it, MT, 16, mt, nt)) break;
    const int m0 = mt * 128, n0 = nt * 128;
    f32x4 sc[4][4];
    zero_acc(sc);
    gemm_mainloop_f8((const char*)PP->h8, LDK1, Bt, LDK1, 8, m0, n0, smem, sc);
    __syncthreads();
    float* Sc = (float*)smem;
#pragma unroll
    for (int mi = 0; mi < 4; ++mi)
#pragma unroll
      for (int ni = 0; ni < 4; ++ni)
#pragma unroll
        for (int r = 0; r < 4; ++r) Sc[(wm * 64 + mi * 16 + lg * 4 + r) * 129 + wn * 64 + ni * 16 + lr] = sc[mi][ni][r] * (1.f / 32.f);
    __syncthreads();
    {
      const int row = tid >> 1, half = tid & 1;
      const float* rowp = Sc + row * 129;
      unsigned key[64];
#pragma unroll
      for (int i = 0; i < 64; ++i) {
        unsigned u = __float_as_uint(rowp[half * 64 + i]);
        u = (u & 0x80000000u) ? ~u : (u | 0x80000000u);
        key[i] = (u & ~127u) | (unsigned)(127 - (half * 64 + i));
      }
#define CMPX(X, Y, DESC) { const unsigned hi_ = (X) > (Y) ? (X) : (Y), lo_ = (X) > (Y) ? (Y) : (X); X = (DESC) ? hi_ : lo_; Y = (DESC) ? lo_ : hi_; }
#pragma unroll
      for (int g0 = 0; g0 < 64; g0 += 16) {
#pragma unroll
        for (int k = 2; k <= 16; k <<= 1)
#pragma unroll
          for (int j = k >> 1; j > 0; j >>= 1)
#pragma unroll
            for (int i = 0; i < 16; ++i) {
              const int l2 = i ^ j;
              if (l2 > i) CMPX(key[g0 + i], key[g0 + l2], ((i & k) == 0));
            }
      }
#define TOPMERGE(AOFF, BOFF)                                                                         \
  {                                                                                                  \
    _Pragma("unroll") for (int i = 0; i < 16; ++i)                                                   \
      key[(AOFF) + i] = key[(AOFF) + i] > key[(BOFF) + 15 - i] ? key[(AOFF) + i] : key[(BOFF) + 15 - i]; \
    _Pragma("unroll") for (int j = 8; j > 0; j >>= 1)                                                \
      _Pragma("unroll") for (int i = 0; i < 16; ++i) {                                               \
        const int l2 = i ^ j;                                                                        \
        if (l2 > i) CMPX(key[(AOFF) + i], key[(AOFF) + l2], true);                                   \
      }                                                                                              \
  }
      TOPMERGE(0, 16);
      TOPMERGE(32, 48);
      TOPMERGE(0, 32);
      {
        unsigned oth[16];
#pragma unroll
        for (int i = 0; i < 16; ++i) oth[i] = swz_xor_u<1>(key[i]);
#pragma unroll
        for (int i = 0; i < 16; ++i) key[i] = key[i] > oth[15 - i] ? key[i] : oth[15 - i];
#pragma unroll
        for (int j = 8; j > 0; j >>= 1)
#pragma unroll
          for (int i = 0; i < 16; ++i) {
            const int l2 = i ^ j;
            if (l2 > i) CMPX(key[i], key[l2], true);
          }
      }
#undef TOPMERGE
#undef CMPX
      unsigned res[16];
#pragma unroll
      for (int j = 0; j < 16; ++j) {
        const int idx = 127 - (int)(key[j] & 127u);
        res[j] = half ? (unsigned)idx : __float_as_uint(rowp[idx]);
      }
      const size_t ob = ((size_t)(m0 + row) * 16 + nt) * 16;
      uint4* dst = half ? (uint4*)(PP->topI + ob) : (uint4*)(PP->topS + ob);
      dst[0] = make_uint4(res[0], res[1], res[2], res[3]);
      dst[1] = make_uint4(res[4], res[5], res[6], res[7]);
      dst[2] = make_uint4(res[8], res[9], res[10], res[11]);
      dst[3] = make_uint4(res[12], res[13], res[14], res[15]);
    }
  }
}

DEV void pair_of_lane(int l, int& a, int& b) {
  if (l < 16) { a = 0; b = l; }
  else if (l < 24) { a = 1; b = l - 16; }
  else if (l < 29) { a = 2; b = l - 24; }
  else if (l < 33) { a = 3; b = l - 29; }
  else if (l < 36) { a = 4; b = l - 33; }
  else if (l < 38) { a = 5; b = l - 36; }
  else if (l < 40) { a = 6; b = l - 38; }
  else if (l < 42) { a = 7; b = l - 40; }
  else if (l < 50) { a = l - 34; b = 0; }
  else { a = 0; b = 0; }
}

DEV float peer_butterfly(const float (&part)[8], int lane) {
  const bool h32 = (lane & 32) != 0, h16 = (lane & 16) != 0, h8 = (lane & 8) != 0;
  const int a32 = (lane ^ 32) << 2;
  float q4[4], q2[2];
#pragma unroll
  for (int i = 0; i < 4; ++i) {
    const float keep = h32 ? part[i + 4] : part[i], send = h32 ? part[i] : part[i + 4];
    q4[i] = keep + __builtin_bit_cast(float, __builtin_amdgcn_ds_bpermute(a32, __builtin_bit_cast(int, send)));
  }
#pragma unroll
  for (int i = 0; i < 2; ++i) {
    const float keep = h16 ? q4[i + 2] : q4[i], send = h16 ? q4[i] : q4[i + 2];
    q2[i] = keep + swz_xor<16>(send);
  }
  const float keep = h8 ? q2[1] : q2[0], send = h8 ? q2[0] : q2[1];
  float q1 = keep + swz_xor<8>(send);
  q1 += swz_xor<4>(q1);
  q1 += swz_xor<2>(q1);
  q1 += swz_xor<1>(q1);
  return q1;
}

__device__ __forceinline__ void phase_peer(int layer, char* smem) {
  const KP PP = get_params();
  const int tid = TID(), lane = tid & 63, wv = tid >> 6;
  const int gw = BID() * 4 + wv, nw = gridDim.x * 4;
  int* elist = (int*)(smem + wv * 2048);
  float* glist = (float*)(elist + 128);
  const bool last = (layer == DEPTH - 1);
  const int rlim = last ? NLAT : R;
  int pa, pb;
  pair_of_lane(lane, pa, pb);
  for (int r = gw; r < rlim; r += nw) {
    f32x2 hp[8];
#pragma unroll
    for (int i = 0; i < 4; ++i) {
      const uint2 hv = *(const uint2*)(PP->h + (size_t)r * LDK1 + 4 * lane + 256 * i);
      hp[2 * i] = (f32x2){bf_lo(hv.x), bf_hi(hv.x)};
      hp[2 * i + 1] = (f32x2){bf_lo(hv.y), bf_hi(hv.y)};
    }
#ifndef PEER_REP
#define PEER_REP 1
#endif
    f32x2 out[8];
#pragma unroll
    for (int i = 0; i < 8; ++i) out[i] = (f32x2){0.f, 0.f};
#pragma nounroll
    for (int rep_ = 0; rep_ < PEER_REP; ++rep_) {
    float sreg[8];
    int ireg[8];
#pragma unroll
    for (int hh = 0; hh < 8; ++hh) {
      const size_t o = (size_t)r * 256 + hh * 32 + (lane & 31);
      sreg[hh] = PP->topS[o];
      ireg[hh] = PP->topI[o];
    }
#pragma unroll 2
    for (int hh = 0; hh < 8; ++hh) {
      float cs = __builtin_bit_cast(float, __builtin_amdgcn_ds_bpermute(pa << 2, __builtin_bit_cast(int, sreg[hh]))) +
                 __builtin_bit_cast(float, __builtin_amdgcn_ds_bpermute((16 + pb) << 2, __builtin_bit_cast(int, sreg[hh])));
      const int e = __builtin_amdgcn_ds_bpermute(pa << 2, ireg[hh]) * 128 + __builtin_amdgcn_ds_bpermute((16 + pb) << 2, ireg[hh]);
      if (lane >= 50) cs = -__builtin_inff();
      unsigned ku = __float_as_uint(cs);
      ku = (ku & 0x80000000u) ? ~ku : (ku | 0x80000000u);
      ku = (ku & ~63u) | (unsigned)(63 - lane);
      int rank = 0;
#pragma unroll
      for (int l2 = 0; l2 < 50; ++l2) {
        const unsigned kv = (unsigned)__builtin_amdgcn_readlane((int)ku, l2);
        rank += (kv > ku) ? 1 : 0;
      }
      const bool sel = (lane < 50) && (rank < 16);
      const float mx = __builtin_bit_cast(float, __builtin_amdgcn_readlane(__builtin_bit_cast(int, cs), 0));
      const float ex = sel ? __expf(cs - mx) : 0.f;
      const float sum = wave_sum(ex);
      const unsigned long long mask = __ballot(sel);
      if (sel) {
        const int pos = __builtin_popcountll(mask & ((1ull << lane) - 1ull));
        elist[hh * 16 + pos] = e;
        glist[hh * 16 + pos] = ex / sum;
      }
    }
    __builtin_amdgcn_wave_barrier();
    asm volatile("s_waitcnt lgkmcnt(0)" ::: "memory");
    for (int k0 = 0; k0 < 128; k0 += 8) {
      U3 ua[8], va[8];
#pragma unroll
      for (int b = 0; b < 8; ++b) {
        const int ek = __builtin_amdgcn_readfirstlane(elist[k0 + b]);
        ua[b] = *(const U3*)(PP->tab8U + (size_t)ek * TROW + lane * 12);
        va[b] = *(const U3*)(PP->tab8V + (size_t)ek * TROW + lane * 12);
      }
      const int eb = elist[k0 + (lane >> 3)];
      const float scu = PP->scU[eb], scv = PP->scV[eb];
      float part[8];
#pragma unroll
      for (int b = 0; b < 8; b += 2) {
        const u32x6_t s6 = {ua[b].a, ua[b].b, ua[b].c, ua[b + 1].a, ua[b + 1].b, ua[b + 1].c};
        const f32x32_t uf = __builtin_amdgcn_cvt_scalef32_pk32_f32_fp6(s6, 1.0f);
        f32x2 d0 = (f32x2){uf[0], uf[1]} * hp[0];
        f32x2 d1 = (f32x2){uf[16], uf[17]} * hp[0];
#pragma unroll
        for (int p = 1; p < 8; ++p) {
          d0 += (f32x2){uf[2 * p], uf[2 * p + 1]} * hp[p];
          d1 += (f32x2){uf[16 + 2 * p], uf[17 + 2 * p]} * hp[p];
        }
        part[b] = d0[0] + d0[1];
        part[b + 1] = d1[0] + d1[1];
      }
      float q1 = peer_butterfly(part, lane);
      q1 *= scu;
      const float act = scv * glist[k0 + (lane >> 3)] * 0.5f * q1 * (1.f + erff(q1 * 0.7071067811865475f));
#pragma unroll
      for (int b = 0; b < 8; b += 2) {
        const float ab0 = __builtin_bit_cast(float, __builtin_amdgcn_readlane(__builtin_bit_cast(int, act), b * 8));
        const float ab1 = __builtin_bit_cast(float, __builtin_amdgcn_readlane(__builtin_bit_cast(int, act), b * 8 + 8));
        const f32x2 a0 = {ab0, ab0}, a1 = {ab1, ab1};
        const u32x6_t s6 = {va[b].a, va[b].b, va[b].c, va[b + 1].a, va[b + 1].b, va[b + 1].c};
        const f32x32_t vf = __builtin_amdgcn_cvt_scalef32_pk32_f32_fp6(s6, 1.0f);
#pragma unroll
        for (int p = 0; p < 8; ++p) {
          out[p] += a0 * (f32x2){vf[2 * p], vf[2 * p + 1]};
          out[p] += a1 * (f32x2){vf[16 + 2 * p], vf[17 + 2 * p]};
        }
      }
    }
    __builtin_amdgcn_wave_barrier();
    }
    if (PEER_REP > 1) {
#pragma unroll
      for (int i = 0; i < 8; ++i) out[i] *= (1.f / PEER_REP);
    }
    const float* md = PP->mod + (size_t)(layer * 3 + modsel(r)) * 6144 + 5 * 1024;
    float* xr = (r < NLAT) ? PP->out + (size_t)r * 1024 : PP->xc + (size_t)(r - NLAT) * 1024;
    float4 x2[4];
    float ss = 0.f;
#pragma unroll
    for (int i = 0; i < 4; ++i) {
      const int col = 4 * lane + 256 * i;
      const float4 xa = *(const float4*)(xr + col);
      const float4 ga = *(const float4*)(md + col);
      x2[i] = make_float4(xa.x + ga.x * out[2 * i][0], xa.y + ga.y * out[2 * i][1], xa.z + ga.z * out[2 * i + 1][0],
                          xa.w + ga.w * out[2 * i + 1][1]);
      ss += x2[i].x * x2[i].x + x2[i].y * x2[i].y + x2[i].z * x2[i].z + x2[i].w * x2[i].w;
    }
    if (last) {
      ss = wave_sum(ss);
      const float rs = rsqrtf(ss * (1.f / 1024.f) + EPS);
#pragma unroll
      for (int i = 0; i < 4; ++i) {
        const float4 fa = *(const float4*)(PP->final_norm + 4 * lane + 256 * i);
        x2[i] = make_float4(x2[i].x * rs * fa.x, x2[i].y * rs * fa.y, x2[i].z * rs * fa.z, x2[i].w * rs * fa.w);
      }
    }
#pragma unroll
    for (int i = 0; i < 4; ++i) *(float4*)(xr + 4 * lane + 256 * i) = x2[i];
    if (!last) {
      ss = wave_sum(ss);
      const float rs = rsqrtf(ss * (1.f / 1024.f) + EPS);
      const float* nwt = PP->norm_mix + (layer + 1) * 1024;
      const float* md1 = PP->mod + (size_t)((layer + 1) * 3 + modsel(r)) * 6144;
#pragma unroll
      for (int i = 0; i < 4; ++i) {
        const int col = 4 * lane + 256 * i;
        const float4 wv = *(const float4*)(nwt + col);
        const float4 sh = *(const float4*)(md1 + col);
        const float4 sc = *(const float4*)(md1 + 1024 + col);
        const float y0 = x2[i].x * rs * wv.x * (1.f + sc.x) + sh.x;
        const float y1 = x2[i].y * rs * wv.y * (1.f + sc.y) + sh.y;
        const float y2 = x2[i].z * rs * wv.z * (1.f + sc.z) + sh.z;
        const float y3 = x2[i].w * rs * wv.w * (1.f + sc.w) + sh.w;
        int pk = __builtin_amdgcn_cvt_pk_fp8_f32(y0, y1, 0, false);
        pk = __builtin_amdgcn_cvt_pk_fp8_f32(y2, y3, pk, true);
        *(int*)((char*)PP->h + (size_t)r * (LDK1 * 2) + col) = pk;
      }
    }
  }
}

namespace cg = cooperative_groups;

#define XB_TMO      128
#define XB_XCNT(j)  (256  + 64 * (j))
#define XB_XSUB(j)  (1280 + 64 * (j))
#define XB_XGEN(j)  (2304 + 64 * (j))
#define XB_TOP      3328
#define XB_TOPGEN   3392
#define XCD_BAR_WORDS 3456
#define XB_SPIN_CAP (1u << 22)
#define LAS __attribute__((address_space(3)))
DEV unsigned xb_ld(unsigned* q) { return __hip_atomic_load(q, __ATOMIC_RELAXED, __HIP_MEMORY_SCOPE_AGENT); }
DEV unsigned xb_add(unsigned* q, unsigned v) { return __hip_atomic_fetch_add(q, v, __ATOMIC_RELAXED, __HIP_MEMORY_SCOPE_AGENT); }
DEV unsigned xb_xcc_id() { return (unsigned)__builtin_amdgcn_s_getreg((3 << 11) | 20) & 0xFu; }
#define XB_SPIN(cond, bar) do { unsigned _sp = 0; while (cond) { __builtin_amdgcn_s_sleep(1); \
    if ((++_sp & 255u) == 0u) { if (xb_ld(&(bar)[XB_TMO])) break; if (_sp > XB_SPIN_CAP) { atomicAdd(&(bar)[XB_TMO], 1u); break; } } } } while (0)
struct XcdBarrier { unsigned* bar; unsigned x; volatile LAS unsigned* st; };
DEV XcdBarrier xcd_barrier_post(unsigned* bar, volatile LAS unsigned* st) {
  XcdBarrier b; b.bar = bar; b.x = xb_xcc_id(); b.st = st;
  if (__builtin_amdgcn_workitem_id_x() == 0) (void)xb_add(&bar[XB_XCNT(b.x)], 1u);
  return b;
}
DEV void xcd_barrier_complete(unsigned* bar, unsigned x, unsigned& nloc, unsigned& nx) {
  const unsigned G = gridDim.x * gridDim.y * gridDim.z;
  unsigned sum, cnt, mine, sp = 0u;
  for (;;) {
    sum = 0u; cnt = 0u; mine = 0u;
#pragma unroll
    for (unsigned j = 0; j < 16; ++j) { const unsigned c = xb_ld(&bar[XB_XCNT(j)]); sum += c; cnt += (c > 0u) ? 1u : 0u; mine = (j == x) ? c : mine; }
    if (sum == G) break;
    __builtin_amdgcn_s_sleep(1);
    if ((++sp & 255u) == 0u) { if (xb_ld(&bar[XB_TMO])) break; if (sp > XB_SPIN_CAP) { atomicAdd(&bar[XB_TMO], 1u); break; } }
  }
  nloc = mine > 0u ? mine : 1u; nx = cnt > 0u ? cnt : 1u;
}
DEV void xcd_barrier(const XcdBarrier& b) {
  asm volatile("s_waitcnt vmcnt(0)" ::: "memory");
  __syncthreads();
  if (__builtin_amdgcn_workitem_id_x() == 0) {
    unsigned* bar = b.bar;
    __builtin_amdgcn_s_waitcnt(0);
    unsigned nloc = b.st[0], nx = b.st[1];
    if (nloc == 0u) { xcd_barrier_complete(bar, b.x, nloc, nx); b.st[0] = nloc; b.st[1] = nx; }
    const unsigned old = xb_add(&bar[XB_XSUB(b.x)], 1u);
    const unsigned gen = old / nloc;
    if (old + 1u == (gen + 1u) * nloc) {
      __builtin_amdgcn_fence(__ATOMIC_RELEASE, "agent");
      asm volatile("s_waitcnt vmcnt(0)" ::: "memory");
      const unsigned og = xb_add(&bar[XB_TOP], 1u);
      const unsigned tg = og / nx;
      if (og + 1u == (tg + 1u) * nx) xb_add(&bar[XB_TOPGEN], 1u);
      else XB_SPIN(xb_ld(&bar[XB_TOPGEN]) == tg, bar);
      __builtin_amdgcn_fence(__ATOMIC_ACQUIRE, "agent");
      xb_add(&bar[XB_XGEN(b.x)], 1u);
      asm volatile("s_waitcnt vmcnt(0)" ::: "memory");
    } else {
      XB_SPIN(xb_ld(&bar[XB_XGEN(b.x)]) == gen, bar);
      __builtin_amdgcn_fence(__ATOMIC_ACQUIRE, "agent");
      asm volatile("s_waitcnt vmcnt(0)" ::: "memory");
    }
  }
  __syncthreads();
}

#define GRID_SYNC() do { XcdBarrier xb_; xb_.bar = get_params()->bar; xb_.x = xb_xcc_id(); xb_.st = (volatile LAS unsigned*)&xb_words; xcd_barrier(xb_); } while (0)

__global__ void __launch_bounds__(NTHR, 2) megakernel(Params p) {
  __shared__ __attribute__((aligned(16))) char smem[SMEM_BYTES];
  __shared__ uint4 xb_words;
  if (__builtin_amdgcn_workitem_id_x() == 0) xb_words = make_uint4(0u, 0u, 0u, 0u);
  __syncthreads();
  (void)xcd_barrier_post(get_params()->bar, (volatile LAS unsigned*)&xb_words);
#ifndef PM
#define PM 0xFFFF
#endif
#ifndef DUP
#define DUP 0
#endif
  if (PM & 1) phase_init(smem);
  if (DUP & 1) phase_init(smem);
  GRID_SYNC();
  for (int layer = 0; layer < DEPTH; ++layer) {
    if (layer == 0) {
      if (PM & 2) phase_norm(layer, 1);
      if (DUP & 2) phase_norm(layer, 1);
      GRID_SYNC();
    }
    if (PM & 4) phase_gemm_win(layer, smem);
    if (DUP & 4) phase_gemm_win(layer, smem);
    GRID_SYNC();
#ifndef PREP_REP
#define PREP_REP 1
#endif
#pragma nounroll
    for (int rep_ = 0; rep_ < PREP_REP; ++rep_) phase_prep(layer, smem);
    GRID_SYNC();
    {
      const int nb_ = gridDim.x;
      if (BID() < 128) { if (PM & 64) phase_scan(smem); }
      else {
        if (PM & 16) phase_pool(layer, smem, BID() - 128, nb_ - 128);
        if (PM & 256) phase_tables(layer, BID() - 128, nb_ - 128);
      }
    }
    GRID_SYNC();
    if (PM & 128) phase_o(layer, smem);
    if (DUP & 128) phase_o(layer, smem);
    GRID_SYNC();
    if (PM & 512) phase_merge(layer, smem);
    if (DUP & 512) phase_merge(layer, smem);
    GRID_SYNC();
    if (PM & 1024) phase_outproj(layer, smem);
    GRID_SYNC();
    if (PM & 2048) phase_norm(layer, 2);
    if (DUP & 2048) phase_norm(layer, 2);
    GRID_SYNC();
    if (PM & 4096) phase_peerq(layer, smem);
    if (DUP & 4096) phase_peerq(layer, smem);
    GRID_SYNC();
    if (PM & 8192) phase_peer(layer, smem);
    if (layer + 1 < DEPTH) GRID_SYNC();
  }
}

static inline size_t align_up(size_t v, size_t a) { return (v + a - 1) / a * a; }

extern "C" void kernel_launch(void* const* d_in, const int* in_sizes, int n_in, void* d_out, int out_size, void* d_ws,
                              size_t ws_size, hipStream_t stream) {
  Params p{};
  p.x = (const float*)d_in[0]; p.c = (const float*)d_in[1]; p.ctx = (const float*)d_in[2]; p.c_ctx = (const float*)d_in[3];
  p.w_mod = (const float*)d_in[4]; p.b_mod = (const float*)d_in[5]; p.norm_mix = (const float*)d_in[6]; p.w_in = (const float*)d_in[7];
  p.conv_w = (const float*)d_in[8]; p.a_log = (const float*)d_in[9]; p.dt_bias = (const float*)d_in[10];
  p.dn_out_norm = (const float*)d_in[11]; p.pool_w = (const float*)d_in[12]; p.pool_scale = (const float*)d_in[13];
  p.w_up_dn = (const float*)d_in[14]; p.w_up_pool = (const float*)d_in[15]; p.w_out = (const float*)d_in[16];
  p.norm_ffn = (const float*)d_in[17]; p.peer_wq = (const float*)d_in[18]; p.peer_keys = (const float*)d_in[19];
  p.peer_u = (const float*)d_in[20]; p.peer_v = (const float*)d_in[21]; p.final_norm = (const float*)d_in[22];
  p.out = (float*)d_out;

  char* ws = (char*)d_ws;
  size_t off = 0;
  auto take = [&](size_t bytes) { char* q = ws + off; off = align_up(off + bytes, 256); return q; };
  p.tab8U = (unsigned char*)take((size_t)NEXP * 1024);
  p.tab8V = (unsigned char*)take((size_t)NEXP * 1024);
  p.scU = (float*)take((size_t)NEXP * 4);
  p.scV = (float*)take((size_t)NEXP * 4);
  p.WinT = (u16*)take((size_t)DEPTH * NPAD * LDK1 * 2);
  p.WdT = (u16*)take((size_t)DEPTH * 1024 * LDK5 * 2);
  p.WpT = (u16*)take((size_t)DEPTH * 1024 * LDK5 * 2);
  p.WoT = (u16*)take((size_t)DEPTH * 1024 * LDK1 * 2);
  p.WkT = (u16*)take((size_t)DEPTH * 2048 * LDK1 * 2);
  p.PwT = (u16*)take((size_t)DEPTH * 4 * 128 * 128 * 2);
  p.mod = (float*)take((size_t)DEPTH * 3 * 6144 * 4);
  p.xc = (float*)take((size_t)NCTX * 1024 * 4);
  p.h = (u16*)take((size_t)R * LDK1 * 2);
  p.h8 = (unsigned char*)take((size_t)R * LDK1);
  p.m = p.h;
  p.qkv_pre = (u16*)take((size_t)R * 1536 * 2);
  p.Vfrag = p.qkv_pre;
  p.z = (u16*)take((size_t)R * 512 * 2);
  p.pin = (u16*)take((size_t)R * 512 * 2);
  p.sgd = (u16*)take((size_t)R * 1024 * 2);
  p.sgp = (u16*)take((size_t)R * 1024 * 2);
  p.ba = (float*)take((size_t)R * 16 * 4);
  p.qkvn = (u16*)take((size_t)R * 1536 * 2);
  p.bg = (float*)take((size_t)R * 16 * 4);
  p.Wfrag = (u16*)take((size_t)NUNIT * 16384);
  p.KdT = (u16*)take((size_t)NUNIT * 16384);
  p.Ufrag = (u16*)take((size_t)NUNIT * 16384);
  p.ydn = p.Ufrag;
  p.Sfrag = (u16*)take((size_t)NUNIT * 32768);
  p.gc = (float*)take((size_t)NUNIT * 64 * 4);
  p.glast = (float*)take((size_t)NUNIT * 4);
  p.ypool = (u16*)take((size_t)R * LDK5 * 2);
  p.bar = (unsigned*)take((size_t)XCD_BAR_WORDS * 4);
  p.topS = (float*)p.qkvn;
  p.topI = (int*)((char*)p.qkvn + (size_t)R * 256 * 4);
  const bool alias_ok = ((size_t)R * 256 * 8 <= (size_t)R * 1536 * 2) && ((size_t)NUNIT * 16384 <= (size_t)R * 1536 * 2) &&
                        ((size_t)R * LDK5 * 2 <= (size_t)NUNIT * 16384);
  if (off > ws_size || !alias_ok) {
    fprintf(stderr, "workspace too small: need %zu have %zu (alias_ok=%d)\n", off, ws_size, (int)alias_ok);
    return;
  }
  static int grid_blocks = 0;
  if (!grid_blocks) {
    int dev = 0, cus = 0, per_cu = 0;
    (void)hipGetDevice(&dev);
    (void)hipDeviceGetAttribute(&cus, hipDeviceAttributeMultiprocessorCount, dev);
    (void)hipOccupancyMaxActiveBlocksPerMultiprocessor(&per_cu, megakernel, NTHR, 0);
    if (per_cu > 2) per_cu = 2;
    if (per_cu < 1) per_cu = 1;
    grid_blocks = cus * per_cu;
    grid_blocks -= grid_blocks % 8;
  }
  if (grid_blocks < 8) { fprintf(stderr, "bad grid %d\n", grid_blocks); return; }
  (void)hipMemsetAsync(p.bar, 0, (size_t)XCD_BAR_WORDS * 4, stream);
  void* args[] = {&p};
  hipError_t e = hipLaunchCooperativeKernel((void*)megakernel, dim3(grid_blocks), dim3(NTHR), args, 0, stream);
  if (e != hipSuccess) fprintf(stderr, "cooperative launch failed: %s (grid %d)\n", hipGetErrorString(e), grid_blocks);
}
```

```cpp
#include <hip/hip_runtime.h>
#include <hip/hip_cooperative_groups.h>
#include <stdint.h>
#include <stdio.h>

typedef unsigned short u16;
typedef __attribute__((ext_vector_type(8))) short bf16x8;
typedef __attribute__((ext_vector_type(4))) float f32x4;
typedef __attribute__((ext_vector_type(2))) float f32x2;
typedef __attribute__((ext_vector_type(2))) __bf16 bf16x2_t;

#define DEV __device__ __forceinline__

constexpr int D = 1024;
constexpr int BATCH = 2;
constexpr int SEQ = 8192;
constexpr int DEPTH = 2;
constexpr int CTX = 256;
constexpr int NLAT = BATCH * SEQ;
constexpr int NCTX = BATCH * CTX;
constexpr int R = NLAT + NCTX;
constexpr int DNH = 4;
constexpr int DK = 128;
constexpr int DNW = 512;
constexpr int INC = 4624;
constexpr int NPAD = 4736;
constexpr int NEXP = 16384;
constexpr float EPS = 1e-6f;
constexpr int NTHR = 256;
constexpr int LDK1 = 1088;
constexpr int LDK5 = 576;
constexpr int SMEM_BYTES = 73728;

struct Params {
  const float *x, *c, *ctx, *c_ctx, *w_mod, *b_mod, *norm_mix, *w_in, *conv_w, *a_log, *dt_bias, *dn_out_norm,
      *pool_w, *pool_scale, *w_up_dn, *w_up_pool, *w_out, *norm_ffn, *peer_wq, *peer_keys, *peer_u, *peer_v, *final_norm;
  float* out;
  unsigned char *tab8U, *tab8V;
  float *scU, *scV;
  u16 *WinT, *WdT, *WpT, *WoT, *WkT, *PwT;
  float *mod, *xc;
  u16 *h, *qkv_pre, *z, *pin, *sgd, *sgp;
  unsigned char* h8;
  float* ba;
  u16* qkvn;
  float* bg;
  u16 *Wfrag, *KdT, *Ufrag, *Sfrag, *Vfrag;
  float *gc, *glast;
  u16 *ydn, *ypool, *m;
  float* topS;
  int* topI;
  unsigned* bar;
};

typedef const __attribute__((address_space(4))) Params* KP;
DEV KP get_params() {
  KP k = (KP)__builtin_amdgcn_kernarg_segment_ptr();
  asm volatile("" : "+s"(k));
  return k;
}
DEV int TID() { int t = __builtin_amdgcn_workitem_id_x(); asm volatile("" : "+v"(t)); return t; }
DEV int BID() { int t = __builtin_amdgcn_workgroup_id_x(); asm volatile("" : "+s"(t)); return t; }
DEV unsigned pack_bf16(float a, float b) {
  f32x2 v = {a, b};
  bf16x2_t r = __builtin_convertvector(v, bf16x2_t);
  return *(unsigned*)&r;
}
DEV u16 f2bf(float a) { return (u16)(pack_bf16(a, 0.f) & 0xffffu); }
DEV float bf_lo(unsigned u) { return __uint_as_float(u << 16); }
DEV float bf_hi(unsigned u) { return __uint_as_float(u & 0xffff0000u); }
DEV float bf2f(u16 h) { return __uint_as_float(((unsigned)h) << 16); }
DEV void unpack8(const uint4& v, float* f) {
  f[0] = bf_lo(v.x); f[1] = bf_hi(v.x); f[2] = bf_lo(v.y); f[3] = bf_hi(v.y);
  f[4] = bf_lo(v.z); f[5] = bf_hi(v.z); f[6] = bf_lo(v.w); f[7] = bf_hi(v.w);
}
DEV uint4 pack8(const float* f) {
  uint4 v;
  v.x = pack_bf16(f[0], f[1]); v.y = pack_bf16(f[2], f[3]); v.z = pack_bf16(f[4], f[5]); v.w = pack_bf16(f[6], f[7]);
  return v;
}
template <int O> DEV float swz_xor(float v) {
  return __builtin_bit_cast(float, __builtin_amdgcn_ds_swizzle(__builtin_bit_cast(int, v), (O << 10) | 0x1F));
}
template <int O> DEV unsigned swz_xor_u(unsigned v) {
  return (unsigned)__builtin_amdgcn_ds_swizzle((int)v, (O << 10) | 0x1F);
}
DEV float xor32_f(float v) {
  const int a = ((TID() & 63) ^ 32) << 2;
  return __builtin_bit_cast(float, __builtin_amdgcn_ds_bpermute(a, __builtin_bit_cast(int, v)));
}
DEV float wave_sum(float v) {
  v += xor32_f(v);
  v += swz_xor<16>(v); v += swz_xor<8>(v); v += swz_xor<4>(v); v += swz_xor<2>(v); v += swz_xor<1>(v);
  return v;
}
DEV float wave_max(float v) {
  v = fmaxf(v, xor32_f(v));
  v = fmaxf(v, swz_xor<16>(v)); v = fmaxf(v, swz_xor<8>(v)); v = fmaxf(v, swz_xor<4>(v));
  v = fmaxf(v, swz_xor<2>(v)); v = fmaxf(v, swz_xor<1>(v));
  return v;
}
DEV float group16_sum(float v) {
  v += swz_xor<8>(v); v += swz_xor<4>(v); v += swz_xor<2>(v); v += swz_xor<1>(v);
  return v;
}
DEV float sigmoidf_(float x) { return __builtin_amdgcn_rcpf(1.f + __expf(-x)); }
DEV float siluf_(float x) { return x * __builtin_amdgcn_rcpf(1.f + __expf(-x)); }
DEV int modsel(int r) { return r < NLAT ? (r >> 13) : 2; }

DEV void transpose_tile(const float* __restrict__ src, int Nsrc, int ldd, u16* __restrict__ dst, int kt, int nt, int mode,
                        float* tile) {
  const int tid = TID();
  const int cl = tid & 63, rg = tid >> 6;
  const int nd = nt * 64 + cl;
  int ns = nd;
  bool valid = true;
  if (mode & 1) {
    if (nd < 2560) ns = nd;
    else if (nd < 4608) ns = nd + 16;
    else if (nd < 4624) ns = nd - 4608 + 2560;
    else { valid = false; ns = 0; }
  }
#pragma unroll
  for (int i = 0; i < 16; ++i) {
    const int kr = i * 4 + rg;
    float v = valid ? src[(size_t)(kt * 64 + kr) * Nsrc + ns] : 0.f;
    tile[kr * 65 + cl] = v;
  }
  __syncthreads();
  const int nr = tid >> 2, kc = (tid & 3) * 16;
  if (mode & 2) {
    int q4[4];
#pragma unroll
    for (int q = 0; q < 4; ++q) {
      int pk = __builtin_amdgcn_cvt_pk_fp8_f32(32.f * tile[(kc + 4 * q) * 65 + nr], 32.f * tile[(kc + 4 * q + 1) * 65 + nr], 0, false);
      q4[q] = __builtin_amdgcn_cvt_pk_fp8_f32(32.f * tile[(kc + 4 * q + 2) * 65 + nr], 32.f * tile[(kc + 4 * q + 3) * 65 + nr], pk, true);
    }
    *(int4*)((char*)dst + (size_t)(nt * 64 + nr) * ldd + kt * 64 + kc) = make_int4(q4[0], q4[1], q4[2], q4[3]);
    __syncthreads();
    return;
  }
  unsigned w[8];
#pragma unroll
  for (int q = 0; q < 8; ++q) w[q] = pack_bf16(tile[(kc + 2 * q) * 65 + nr], tile[(kc + 2 * q + 1) * 65 + nr]);
  uint4* d = (uint4*)(dst + (size_t)(nt * 64 + nr) * ldd + kt * 64 + kc);
  d[0] = make_uint4(w[0], w[1], w[2], w[3]);
  d[1] = make_uint4(w[4], w[5], w[6], w[7]);
  __syncthreads();
}

__device__ __forceinline__ void phase_init(char* smem) {
  const KP PP = get_params();
  const int tid = TID(), nb = gridDim.x, bid = BID();
  float* fs = (float*)smem;
  for (int u = bid; u < 192; u += nb) {
    const int layer = u / 96, col0 = (u % 96) * 64;
    float* sv = fs;
    float* red = fs + 3072;
    for (int i = tid; i < 3072; i += NTHR) {
      const int v = i >> 10, k = i & 1023;
      const float cv = (v < 2) ? PP->c[v * 1024 + k] : PP->c_ctx[k];
      sv[i] = siluf_(cv);
    }
    __syncthreads();
    const int cq = tid & 15, ks = tid >> 4;
    float acc[3][4];
#pragma unroll
    for (int v = 0; v < 3; ++v)
#pragma unroll
      for (int i = 0; i < 4; ++i) acc[v][i] = 0.f;
    const float* wb = PP->w_mod + ((size_t)layer * 1024 + ks * 64) * 6144 + col0 + cq * 4;
#pragma unroll 8
    for (int kk = 0; kk < 64; ++kk) {
      const float4 w4 = *(const float4*)(wb + (size_t)kk * 6144);
      const int k = ks * 64 + kk;
#pragma unroll
      for (int v = 0; v < 3; ++v) {
        const float s = sv[v * 1024 + k];
        acc[v][0] += s * w4.x; acc[v][1] += s * w4.y; acc[v][2] += s * w4.z; acc[v][3] += s * w4.w;
      }
    }
#pragma unroll
    for (int v = 0; v < 3; ++v)
#pragma unroll
      for (int i = 0; i < 4; ++i) red[(ks * 3 + v) * 64 + cq * 4 + i] = acc[v][i];
    __syncthreads();
    if (tid < 192) {
      const int v = tid >> 6, cc = tid & 63;
      float s = PP->b_mod[layer * 6144 + col0 + cc];
#pragma unroll
      for (int k2 = 0; k2 < 16; ++k2) s += red[(k2 * 3 + v) * 64 + cc];
      PP->mod[(size_t)(layer * 3 + v) * 6144 + col0 + cc] = s;
    }
    __syncthreads();
  }
  constexpr int NTL = 1184 + 128 + 128 + 256 + 16;
  for (int j = bid; j < NTL * DEPTH; j += nb) {
    const int layer = j / NTL;
    int jj = j % NTL;
    if (jj < 1184) {
      transpose_tile(PP->w_in + (size_t)layer * 1024 * INC, INC, LDK1, PP->WinT + (size_t)layer * NPAD * LDK1, jj / 74, jj % 74, 3, fs);
    } else if ((jj -= 1184) < 128) {
      transpose_tile(PP->w_up_dn + (size_t)layer * 512 * 1024, 1024, LDK5, PP->WdT + (size_t)layer * 1024 * LDK5, jj / 16, jj % 16, 2, fs);
    } else if ((jj -= 128) < 128) {
      transpose_tile(PP->w_up_pool + (size_t)layer * 512 * 1024, 1024, LDK5, PP->WpT + (size_t)layer * 1024 * LDK5, jj / 16, jj % 16, 2, fs);
    } else if ((jj -= 128) < 256) {
      transpose_tile(PP->w_out + (size_t)layer * 1024 * 1024, 1024, LDK1, PP->WoT + (size_t)layer * 1024 * LDK1, jj / 16, jj % 16, 2, fs);
    } else {
      jj -= 256;
      const int g = jj >> 2;
      transpose_tile(PP->pool_w + (size_t)(layer * 4 + g) * 128 * 128, 128, 128, PP->PwT + (size_t)(layer * 4 + g) * 128 * 128,
                     (jj & 3) >> 1, jj & 1, 0, fs);
    }
  }
  {
    const int tid2 = TID();
    const int l = tid2 & 63, w = tid2 >> 6, lr = l & 15, lg = l >> 4;
    char* Ks = smem;
    char* Ws = smem + 32768;
    for (int item = bid; item < DEPTH * 256; item += nb) {
      const int layer = item >> 8, hp = (item >> 4) & 15, ct = item & 15;
      __syncthreads();
      const float* ksrc = PP->peer_keys + (size_t)(layer * 16 + hp) * 128 * 128;
      for (int idx = tid2; idx < 128 * 16; idx += NTHR) {
        const int row = idx >> 4, ch = idx & 15;
        const float4 a = *(const float4*)(ksrc + row * 128 + ch * 8);
        const float4 c4 = *(const float4*)(ksrc + row * 128 + ch * 8 + 4);
        *(uint4*)(Ks + row * 256 + ((ch ^ (row & 15)) << 4)) =
            make_uint4(pack_bf16(a.x, a.y), pack_bf16(a.z, a.w), pack_bf16(c4.x, c4.y), pack_bf16(c4.z, c4.w));
      }
      const float* wsrc = PP->peer_wq + (size_t)layer * 1024 * 2048 + (size_t)(ct * 64) * 2048 + hp * 128;
      for (int idx = tid2; idx < 64 * 16; idx += NTHR) {
        const int row = idx >> 4, ch = idx & 15;
        const float4 a = *(const float4*)(wsrc + (size_t)row * 2048 + ch * 8);
        const float4 c4 = *(const float4*)(wsrc + (size_t)row * 2048 + ch * 8 + 4);
        *(uint4*)(Ws + row * 256 + ((ch ^ (row & 15)) << 4)) =
            make_uint4(pack_bf16(a.x, a.y), pack_bf16(a.z, a.w), pack_bf16(c4.x, c4.y), pack_bf16(c4.z, c4.w));
      }
      __syncthreads();
      f32x4 acc[2][4];
#pragma unroll
      for (int mi = 0; mi < 2; ++mi)
#pragma unroll
        for (int ni = 0; ni < 4; ++ni) acc[mi][ni] = (f32x4){0.f, 0.f, 0.f, 0.f};
#pragma unroll
      for (int ks = 0; ks < 4; ++ks) {
        const int ch = ks * 4 + lg;
        bf16x8 a[2], bb[4];
#pragma unroll
        for (int mi = 0; mi < 2; ++mi) a[mi] = *(const bf16x8*)(Ks + ((2 * w + mi) * 16 + lr) * 256 + ((ch ^ lr) << 4));
#pragma unroll
        for (int ni = 0; ni < 4; ++ni) bb[ni] = *(const bf16x8*)(Ws + (ni * 16 + lr) * 256 + ((ch ^ lr) << 4));
#pragma unroll
        for (int mi = 0; mi < 2; ++mi)
#pragma unroll
          for (int ni = 0; ni < 4; ++ni) acc[mi][ni] = __builtin_amdgcn_mfma_f32_16x16x32_bf16(a[mi], bb[ni], acc[mi][ni], 0, 0, 0);
      }
      unsigned char* dst = (unsigned char*)PP->WkT + ((size_t)layer * 2048 + hp * 128) * LDK1 + ct * 64;
#pragma unroll
      for (int mi = 0; mi < 2; ++mi)
#pragma unroll
        for (int ni = 0; ni < 4; ++ni)
#pragma unroll
          for (int r = 0; r < 4; ++r) {
            const float v32 = 32.f * acc[mi][ni][r];
            dst[(size_t)((2 * w + mi) * 16 + 4 * lg + r) * LDK1 + ni * 16 + lr] = (unsigned char)(__builtin_amdgcn_cvt_pk_fp8_f32(v32, v32, 0, false) & 0xff);
          }
    }
  }
}

DEV unsigned enc_e2m3(float x) {
  const float a = fabsf(x);
  float c;
  if (a < 2.f) c = a * 8.f;
  else if (a < 4.f) c = 16.f + (a - 2.f) * 4.f;
  else c = 24.f + (a - 4.f) * 2.f;
  unsigned code = (unsigned)__builtin_rintf(c);
  code = code > 31u ? 31u : code;
  return code | (x < 0.f ? 32u : 0u);
}
struct __attribute__((packed, aligned(4))) U3 { unsigned a, b, c; };
constexpr int TROW = 768;
typedef float f32x32_t __attribute__((ext_vector_type(32)));
typedef unsigned u32x6_t __attribute__((ext_vector_type(6)));

__device__ __forceinline__ void phase_tables(int layer, int vbid, int vnb) {
  const KP PP = get_params();
  const int tid = TID(), lane = tid & 63;
  const int gw = vbid * 4 + (tid >> 6), nw = vnb * 4;
  const float* su = PP->peer_u + (size_t)layer * NEXP * 1024;
  const float* sv = PP->peer_v + (size_t)layer * NEXP * 1024;
  for (int r0 = gw * 2; r0 < 2 * NEXP; r0 += nw * 2) {
    float4 v[2][4];
#pragma unroll
    for (int q = 0; q < 2; ++q) {
      const int r = r0 + q;
      const float* src = (r < NEXP ? su + (size_t)r * 1024 : sv + (size_t)(r - NEXP) * 1024);
#pragma unroll
      for (int i = 0; i < 4; ++i) v[q][i] = *(const float4*)(src + (lane + 64 * i) * 4);
    }
#pragma unroll
    for (int q = 0; q < 2; ++q) {
      const int r = r0 + q;
      float am = 0.f;
#pragma unroll
      for (int i = 0; i < 4; ++i)
        am = fmaxf(am, fmaxf(fmaxf(fabsf(v[q][i].x), fabsf(v[q][i].y)), fmaxf(fabsf(v[q][i].z), fabsf(v[q][i].w))));
      am = wave_max(am);
      const float scale = fmaxf(am, 1e-30f) * (1.f / 7.5f);
      const float inv = 1.f / scale;
      unsigned long long lo = 0ull;
      unsigned hi = 0u;
#pragma unroll
      for (int i = 0; i < 4; ++i) {
        const float vv[4] = {v[q][i].x * inv, v[q][i].y * inv, v[q][i].z * inv, v[q][i].w * inv};
#pragma unroll
        for (int j = 0; j < 4; ++j) {
          const int k = 4 * i + j;
          const unsigned cde = enc_e2m3(vv[j]);
          if (k < 10) lo |= (unsigned long long)cde << (6 * k);
          else if (k == 10) { lo |= (unsigned long long)cde << 60; hi |= cde >> 4; }
          else hi |= cde << (6 * k - 64);
        }
      }
      unsigned char* dst = (r < NEXP ? PP->tab8U + (size_t)r * TROW : PP->tab8V + (size_t)(r - NEXP) * TROW);
      U3 pk3;
      pk3.a = (unsigned)lo; pk3.b = (unsigned)(lo >> 32); pk3.c = hi;
      *(U3*)(dst + lane * 12) = pk3;
      if (lane == 0) { if (r < NEXP) PP->scU[r] = scale; else PP->scV[r - NEXP] = scale; }
    }
  }
}

__device__ __forceinline__ void phase_norm(int layer, int which) {
  const KP PP = get_params();
  const int lane = TID() & 63;
  const int gw = BID() * 4 + (TID() >> 6), nw = gridDim.x * 4;
  const float* nwt = (which == 1 ? PP->norm_mix : PP->norm_ffn) + layer * 1024;
  const int rlim = (which == 2 && layer == DEPTH - 1) ? NLAT : R;
  for (int r = gw; r < rlim; r += nw) {
    const float* xr;
    if (r < NLAT) xr = ((which == 1 && layer == 0) ? PP->x : PP->out) + (size_t)r * 1024;
    else xr = ((which == 1 && layer == 0) ? PP->ctx : PP->xc) + (size_t)(r - NLAT) * 1024;
    const float* md = PP->mod + (size_t)(layer * 3 + modsel(r)) * 6144 + (which == 1 ? 0 : 3072);
    float4 v[4];
    float ss = 0.f;
#pragma unroll
    for (int i = 0; i < 4; ++i) {
      v[i] = *(const float4*)(xr + (lane + 64 * i) * 4);
      ss += v[i].x * v[i].x + v[i].y * v[i].y + v[i].z * v[i].z + v[i].w * v[i].w;
    }
    ss = wave_sum(ss);
    const float rs = rsqrtf(ss * (1.f / 1024.f) + EPS);
#pragma unroll
    for (int i = 0; i < 4; ++i) {
      const int col = (lane + 64 * i) * 4;
      const float4 w = *(const float4*)(nwt + col);
      const float4 sh = *(const float4*)(md + col);
      const float4 sc = *(const float4*)(md + 1024 + col);
      const float y0 = v[i].x * rs * w.x * (1.f + sc.x) + sh.x;
      const float y1 = v[i].y * rs * w.y * (1.f + sc.y) + sh.y;
      const float y2 = v[i].z * rs * w.z * (1.f + sc.z) + sh.z;
      const float y3 = v[i].w * rs * w.w * (1.f + sc.w) + sh.w;
      if (which == 1) {
        int pk = __builtin_amdgcn_cvt_pk_fp8_f32(y0, y1, 0, false);
        pk = __builtin_amdgcn_cvt_pk_fp8_f32(y2, y3, pk, true);
        *(int*)((char*)PP->h + (size_t)r * (LDK1 * 2) + col) = pk;
      } else {
        *(uint2*)(PP->h + (size_t)r * LDK1 + col) = make_uint2(pack_bf16(y0, y1), pack_bf16(y2, y3));
        int pk = __builtin_amdgcn_cvt_pk_fp8_f32(y0, y1, 0, false);
        pk = __builtin_amdgcn_cvt_pk_fp8_f32(y2, y3, pk, true);
        *(int*)(PP->h8 + (size_t)r * LDK1 + col) = pk;
      }
    }
  }
}

template <bool PRIO>
DEV void gemm_mainloop_t(const u16* __restrict__ A, int lda, const u16* __restrict__ B, int ldb, int K, int m0, int n0,
                         char* smem, f32x4 (&acc)[4][4]) {
  const int tid = TID();
  const int l = tid & 63, w = tid >> 6, wm = w >> 1, wn = w & 1, lr = l & 15, lg = l >> 4;
  uint4 ga0[4], gb0[4], ga1[4], gb1[4];
#pragma unroll
  for (int i = 0; i < 4; ++i) { ga0[i] = make_uint4(0u, 0u, 0u, 0u); gb0[i] = ga0[i]; ga1[i] = ga0[i]; gb1[i] = ga0[i]; }
  const int KT = K >> 6;
#define GLOAD(GA, GB, KT_)                                                                     \
  _Pragma("unroll") for (int i = 0; i < 4; ++i) {                                              \
    const int id = tid + 256 * i, row = id >> 3, c = id & 7;                                   \
    GA[i] = *(const uint4*)(A + (size_t)(m0 + row) * lda + (KT_) * 64 + c * 8);                \
    GB[i] = *(const uint4*)(B + (size_t)(n0 + row) * ldb + (KT_) * 64 + c * 8);                \
  }
#define LSTORE(GA, GB, BUF)                                                                    \
  {                                                                                            \
    char* as_ = smem + (BUF) * 32768;                                                          \
    char* bs_ = as_ + 16384;                                                                   \
    _Pragma("unroll") for (int i = 0; i < 4; ++i) {                                            \
      const int id = tid + 256 * i, row = id >> 3, c = id & 7;                                 \
      const int off = row * 128 + ((c ^ (row & 7)) << 4);                                      \
      *(uint4*)(as_ + off) = GA[i];                                                            \
      *(uint4*)(bs_ + off) = GB[i];                                                            \
    }                                                                                          \
  }
#define COMPUTE(BUF)                                                                                                      \
  {                                                                                                                       \
    const char* as_ = smem + (BUF) * 32768;                                                                               \
    const char* bs_ = as_ + 16384;                                                                                        \
    if (PRIO) __builtin_amdgcn_s_setprio(1);      \
    _Pragma("unroll") for (int ks = 0; ks < 2; ++ks) {                                                                    \
      bf16x8 a[4], b[4];                                                                                                  \
      const int c = ks * 4 + lg;                                                                                          \
      const int sw = ((c ^ (lr & 7)) << 4);                                                                               \
      _Pragma("unroll") for (int mi = 0; mi < 4; ++mi) a[mi] = *(const bf16x8*)(as_ + (wm * 64 + mi * 16 + lr) * 128 + sw); \
      _Pragma("unroll") for (int ni = 0; ni < 4; ++ni) b[ni] = *(const bf16x8*)(bs_ + (wn * 64 + ni * 16 + lr) * 128 + sw); \
      _Pragma("unroll") for (int mi = 0; mi < 4; ++mi)                                                                    \
        _Pragma("unroll") for (int ni = 0; ni < 4; ++ni)                                                                  \
          acc[mi][ni] = __builtin_amdgcn_mfma_f32_16x16x32_bf16(a[mi], b[ni], acc[mi][ni], 0, 0, 0);                      \
    }                                                                                                                     \
    if (PRIO) __builtin_amdgcn_s_setprio(0);                                                                              \
  }
  __syncthreads();
  GLOAD(ga0, gb0, 0);
  GLOAD(ga1, gb1, 1);
  LSTORE(ga0, gb0, 0);
  __syncthreads();
  for (int kt = 0; kt < KT; kt += 2) {
    if (kt + 2 < KT) { GLOAD(ga0, gb0, kt + 2); }
    COMPUTE(0);
    LSTORE(ga1, gb1, 1);
    __syncthreads();
    if (kt + 3 < KT) { GLOAD(ga1, gb1, kt + 3); }
    COMPUTE(1);
    if (kt + 2 < KT) { LSTORE(ga0, gb0, 0); }
    __syncthreads();
  }
#undef GLOAD
#undef LSTORE
#undef COMPUTE
}

DEV void gemm_mainloop(const u16* __restrict__ A, int lda, const u16* __restrict__ B, int ldb, int K, int m0, int n0,
                       char* smem, f32x4 (&acc)[4][4]) {
  gemm_mainloop_t<false>(A, lda, B, ldb, K, m0, n0, smem, acc);
}
DEV void gemm_mainloop1(const u16* __restrict__ A, int lda, const u16* __restrict__ B, int ldb, int K, int m0, int n0,
                       char* smem, f32x4 (&acc)[4][4]) {
  const int tid = TID();
  const int l = tid & 63, w = tid >> 6, wm = w >> 1, wn = w & 1, lr = l & 15, lg = l >> 4;
  uint4 ga[4], gb[4];
  const int KT = K >> 6;
  auto gload = [&](int kt) {
#pragma unroll
    for (int i = 0; i < 4; ++i) {
      const int id = tid + 256 * i, row = id >> 3, c = id & 7;
      ga[i] = *(const uint4*)(A + (size_t)(m0 + row) * lda + kt * 64 + c * 8);
      gb[i] = *(const uint4*)(B + (size_t)(n0 + row) * ldb + kt * 64 + c * 8);
    }
  };
  auto lstore = [&](int buf) {
    char* as = smem + buf * 32768;
    char* bs = as + 16384;
#pragma unroll
    for (int i = 0; i < 4; ++i) {
      const int id = tid + 256 * i, row = id >> 3, c = id & 7;
      const int off = row * 128 + ((c ^ (row & 7)) << 4);
      *(uint4*)(as + off) = ga[i];
      *(uint4*)(bs + off) = gb[i];
    }
  };
  __syncthreads();
  gload(0);
  lstore(0);
  __syncthreads();
  for (int kt = 0; kt < KT; ++kt) {
    if (kt + 1 < KT) gload(kt + 1);
    const char* as = smem + (kt & 1) * 32768;
    const char* bs = as + 16384;
#pragma unroll
    for (int ks = 0; ks < 2; ++ks) {
      bf16x8 a[4], b[4];
      const int c = ks * 4 + lg;
      const int sw = ((c ^ (lr & 7)) << 4);
#pragma unroll
      for (int mi = 0; mi < 4; ++mi) a[mi] = *(const bf16x8*)(as + (wm * 64 + mi * 16 + lr) * 128 + sw);
#pragma unroll
      for (int ni = 0; ni < 4; ++ni) b[ni] = *(const bf16x8*)(bs + (wn * 64 + ni * 16 + lr) * 128 + sw);
#pragma unroll
      for (int mi = 0; mi < 4; ++mi)
#pragma unroll
        for (int ni = 0; ni < 4; ++ni) acc[mi][ni] = __builtin_amdgcn_mfma_f32_16x16x32_bf16(a[mi], b[ni], acc[mi][ni], 0, 0, 0);
    }
    if (kt + 1 < KT) lstore((kt + 1) & 1);
    __syncthreads();
  }
}

DEV void zero_acc(f32x4 (&acc)[4][4]) {
#pragma unroll
  for (int i = 0; i < 4; ++i)
#pragma unroll
    for (int j = 0; j < 4; ++j) acc[i][j] = (f32x4){0.f, 0.f, 0.f, 0.f};
}

DEV void stage_half(const f32x4 (&acc)[4][4], int hsel, char* smem, float4 (&v)[8]) {
  const int tid = TID();
  const int l = tid & 63, w = tid >> 6, wm = w >> 1, wn = w & 1, lr = l & 15, lg = l >> 4;
  float* Cs = (float*)smem;
  __syncthreads();
  if (wm == hsel) {
#pragma unroll
    for (int mi = 0; mi < 4; ++mi)
#pragma unroll
      for (int ni = 0; ni < 4; ++ni)
#pragma unroll
        for (int r = 0; r < 4; ++r) Cs[(mi * 16 + lg * 4 + r) * 132 + wn * 64 + ni * 16 + lr] = acc[mi][ni][r];
  }
  __syncthreads();
#pragma unroll
  for (int j = 0; j < 8; ++j) {
    const int idx = tid + 256 * j, row = idx >> 5, c4 = idx & 31;
    v[j] = *(const float4*)&Cs[row * 132 + c4 * 4];
  }
}

DEV bool tile_map(int it, int MT, int NTl, int& mt, int& nt) {
  const int nb = gridDim.x, bid = BID();
  const int x = bid & 7, vl = bid >> 3, per = nb >> 3;
  const int T = MT * NTl;
  const int g_begin = (int)(((long long)x * T) >> 3), g_end = (int)(((long long)(x + 1) * T) >> 3);
  const int g = g_begin + vl + it * per;
  if (g >= g_end) return false;
  const int full = MT >> 3;
  const int sr = g / (8 * NTl);
  const int srow = sr < full ? sr : full;
  const int rows_in_sr = sr < full ? 8 : (MT & 7);
  const int tt = g - srow * 8 * NTl;
  nt = tt / rows_in_sr;
  mt = srow * 8 + tt % rows_in_sr;
  return true;
}

#define SG_LOCALS                                                                              \
  const int tid = TID();                                                                       \
  const int l = tid & 63, w = tid >> 6, wm = w >> 1, wn = w & 1, lr = l & 15, lg = l >> 4;     \
  uint4 ga0[4], gb0[4], ga1[4], gb1[4];                                                        \
  _Pragma("unroll") for (int i = 0; i < 4; ++i) {                                              \
    ga0[i] = make_uint4(0u, 0u, 0u, 0u); gb0[i] = ga0[i]; ga1[i] = ga0[i]; gb1[i] = ga0[i];    \
  }                                                                                            \
  const int r0 = tid >> 3, c0 = tid & 7;                                                       \
  const int pr0 = 8 * ((r0 & 15) >> 2) + 4 * (r0 >> 4) + (r0 & 3);
#define SG_LOAD(GA, GB, AP, BP, LD, M0_, N0_, KT_)                                             \
  _Pragma("unroll") for (int i = 0; i < 4; ++i) {                                              \
    GA[i] = *(const uint4*)((AP) + (size_t)((M0_) + 32 * i + r0) * (LD) + c0 * 8 + (KT_) * 64);  \
    GB[i] = *(const uint4*)((BP) + (size_t)((N0_) + 32 * i + pr0) * (LD) + c0 * 8 + (KT_) * 64); \
  }
#define SG_LSTORE(GA, GB, BUF)                                                                 \
  {                                                                                            \
    char* as_ = smem + (BUF) * 32768;                                                          \
    char* bs_ = as_ + 16384;                                                                   \
    _Pragma("unroll") for (int i = 0; i < 4; ++i) {                                            \
      const int id = tid + 256 * i, row = id >> 3, c = id & 7;                                 \
      const int off = row * 128 + ((c ^ (row & 7)) << 4);                                      \
      *(uint4*)(as_ + off) = GA[i];                                                            \
      *(uint4*)(bs_ + off) = GB[i];                                                            \
    }                                                                                          \
  }
#define SG_COMPUTE(ACC, BUF, PRIO)                                                                                        \
  {                                                                                                                       \
    const char* as_ = smem + (BUF) * 32768;                                                                               \
    const char* bs_ = as_ + 16384;                                                                                        \
    if (PRIO) __builtin_amdgcn_s_setprio(1);                                                                              \
    _Pragma("unroll") for (int ks = 0; ks < 2; ++ks) {                                                                    \
      bf16x8 a[4], b[4];                                                                                                  \
      const int c = ks * 4 + lg;                                                                                          \
      const int sw = ((c ^ (lr & 7)) << 4);                                                                               \
      _Pragma("unroll") for (int mi = 0; mi < 4; ++mi) a[mi] = *(const bf16x8*)(as_ + (wm * 64 + mi * 16 + lr) * 128 + sw); \
      _Pragma("unroll") for (int ni = 0; ni < 4; ++ni) b[ni] = *(const bf16x8*)(bs_ + (wn * 64 + ni * 16 + lr) * 128 + sw); \
      _Pragma("unroll") for (int mi = 0; mi < 4; ++mi)                                                                    \
        _Pragma("unroll") for (int ni = 0; ni < 4; ++ni)                                                                  \
          ACC[mi][ni] = __builtin_amdgcn_mfma_f32_16x16x32_bf16(b[ni], a[mi], ACC[mi][ni], 0, 0, 0);                      \
    }                                                                                                                     \
    if (PRIO) __builtin_amdgcn_s_setprio(0);                                                                              \
  }

typedef int i32x8 __attribute__((ext_vector_type(8)));
typedef int i32x4 __attribute__((ext_vector_type(4)));
#define F8_LOCALS                                                                              \
  const int tid = TID();                                                                       \
  const int l = tid & 63, w = tid >> 6, wm = w >> 1, wn = w & 1, lr = l & 15, lg = l >> 4;     \
  uint4 ga0[4], gb0[4], ga1[4], gb1[4];                                                        \
  _Pragma("unroll") for (int i = 0; i < 4; ++i) {                                              \
    ga0[i] = make_uint4(0u, 0u, 0u, 0u); gb0[i] = ga0[i]; ga1[i] = ga0[i]; gb1[i] = ga0[i];    \
  }                                                                                            \
  const int r0 = tid >> 3, c0 = tid & 7;                                                       \
  const int pr0 = 8 * ((r0 & 15) >> 2) + 4 * (r0 >> 4) + (r0 & 3);
#define F8_GLOAD(GA, GB, AP, LDA, BP, LDB, M0_, N0_, KT_)                                      \
  _Pragma("unroll") for (int i = 0; i < 4; ++i) {                                              \
    GA[i] = *(const uint4*)((AP) + (size_t)((M0_) + 32 * i + r0) * (LDA) + c0 * 16 + (KT_) * 128);   \
    GB[i] = *(const uint4*)((BP) + (size_t)((N0_) + 32 * i + pr0) * (LDB) + c0 * 16 + (KT_) * 128);  \
  }
#define F8_LSTORE(GA, GB, BUF)                                                                 \
  {                                                                                            \
    char* as_ = smem + (BUF) * 32768;                                                          \
    char* bs_ = as_ + 16384;                                                                   \
    _Pragma("unroll") for (int i = 0; i < 4; ++i) {                                            \
      const int id = tid + 256 * i, row = id >> 3, c = id & 7;                                 \
      const int off = row * 128 + ((c ^ (row & 7)) << 4);                                      \
      *(uint4*)(as_ + off) = GA[i];                                                            \
      *(uint4*)(bs_ + off) = GB[i];                                                            \
    }                                                                                          \
  }
#define F8_COMPUTE(BUF)                                                                                                   \
  {                                                                                                                       \
    const char* as_ = smem + (BUF) * 32768;                                                                               \
    const char* bs_ = as_ + 16384;                                                                                        \
    i32x8 a[4], b[4];                                                                                                     \
    const int sw0 = ((lg ^ (lr & 7)) << 4), sw1 = (((4 + lg) ^ (lr & 7)) << 4);                                           \
    _Pragma("unroll") for (int mi = 0; mi < 4; ++mi) {                                                                    \
      const char* p_ = as_ + (wm * 64 + mi * 16 + lr) * 128;                                                              \
      const i32x4 lo_ = *(const i32x4*)(p_ + sw0), hi_ = *(const i32x4*)(p_ + sw1);                                       \
      a[mi] = __builtin_shufflevector(lo_, hi_, 0, 1, 2, 3, 4, 5, 6, 7);                                                  \
    }                                                                                                                     \
    _Pragma("unroll") for (int ni = 0; ni < 4; ++ni) {                                                                    \
      const char* p_ = bs_ + (wn * 64 + ni * 16 + lr) * 128;                                                              \
      const i32x4 lo_ = *(const i32x4*)(p_ + sw0), hi_ = *(const i32x4*)(p_ + sw1);                                       \
      b[ni] = __builtin_shufflevector(lo_, hi_, 0, 1, 2, 3, 4, 5, 6, 7);                                                  \
    }                                                                                                                     \
    __builtin_amdgcn_s_setprio(1);                                                                                        \
    _Pragma("unroll") for (int mi = 0; mi < 4; ++mi)                                                                      \
      _Pragma("unroll") for (int ni = 0; ni < 4; ++ni)                                                                    \
        acc[mi][ni] = __builtin_amdgcn_mfma_scale_f32_16x16x128_f8f6f4(b[ni], a[mi], acc[mi][ni], 0, 0, 0, 0, 0, 0);      \
    __builtin_amdgcn_s_setprio(0);                                                                                        \
  }
#define F8_KLOOP(AP, LDA, BP, LDB, KT_)                                                        \
  for (int kt = 0; kt < (KT_); kt += 2) {                                                      \
    const bool wrap = (kt + 2 >= (KT_));                                                       \
    const int ml = wrap ? m0n : m0, nl = wrap ? n0n : n0, kl = wrap ? kt + 2 - (KT_) : kt + 2; \
    if (!wrap || hasn) { F8_GLOAD(ga0, gb0, AP, LDA, BP, LDB, ml, nl, kl); }                   \
    F8_COMPUTE(0);                                                                             \
    F8_LSTORE(ga1, gb1, 1);                                                                    \
    __syncthreads();                                                                           \
    if (!wrap || hasn) { F8_GLOAD(ga1, gb1, AP, LDA, BP, LDB, ml, nl, kl + 1); }               \
    F8_COMPUTE(1);                                                                             \
    if (!wrap || hasn) { F8_LSTORE(ga0, gb0, 0); }                                             \
    __syncthreads();                                                                           \
  }
#define F8_PROLOGUE(AP, LDA, BP, LDB)                                                          \
  __syncthreads();                           \
  F8_GLOAD(ga0, gb0, AP, LDA, BP, LDB, m0, n0, 0);                                             \
  F8_GLOAD(ga1, gb1, AP, LDA, BP, LDB, m0, n0, 1);                                             \
  F8_LSTORE(ga0, gb0, 0);                                                                      \
  __syncthreads();

__device__ __forceinline__ void phase_gemm_win(int layer, char* smem) {
  const KP PP = get_params();
  const char* Bt = (const char*)(PP->WinT + (size_t)layer * NPAD * LDK1);
  const char* A = (const char*)PP->h;
  F8_LOCALS
  int it = 0, mt, nt;
  if (!tile_map(it, R / 128, NPAD / 128, mt, nt)) return;
  int m0 = mt * 128, n0 = nt * 128;
  F8_PROLOGUE(A, LDK1 * 2, Bt, LDK1)
  for (;;) {
    int mtn = 0, ntn = 0;
    const bool hasn = tile_map(it + 1, R / 128, NPAD / 128, mtn, ntn);
    const int m0n = mtn * 128, n0n = ntn * 128;
    f32x4 acc[4][4];
    zero_acc(acc);
    F8_KLOOP(A, LDK1 * 2, Bt, LDK1, 8)
#pragma unroll
    for (int mi = 0; mi < 4; ++mi) {
      const size_t gr = (size_t)(m0 + wm * 64 + mi * 16 + lr);
#pragma unroll
      for (int g = 0; g < 2; ++g) {
        const int gc = n0 + wn * 64 + g * 32 + 8 * lg;
        const f32x4 t0 = acc[mi][2 * g] * (1.f / 32.f), t1 = acc[mi][2 * g + 1] * (1.f / 32.f);
        if (n0 < 1536) {
          int p0 = __builtin_amdgcn_cvt_pk_fp8_f32(t0[0], t0[1], 0, false);
          p0 = __builtin_amdgcn_cvt_pk_fp8_f32(t0[2], t0[3], p0, true);
          int p1 = __builtin_amdgcn_cvt_pk_fp8_f32(t1[0], t1[1], 0, false);
          p1 = __builtin_amdgcn_cvt_pk_fp8_f32(t1[2], t1[3], p1, true);
          *(int2*)((char*)PP->qkv_pre + gr * 1536 + gc) = make_int2(p0, p1);
        } else if (n0 < 2048) {
          *(uint4*)(PP->z + gr * 512 + (gc - 1536)) =
              make_uint4(pack_bf16(t0[0], t0[1]), pack_bf16(t0[2], t0[3]), pack_bf16(t1[0], t1[1]), pack_bf16(t1[2], t1[3]));
        } else if (n0 < 2560) {
          *(uint4*)(PP->pin + gr * 512 + (gc - 2048)) =
              make_uint4(pack_bf16(t0[0], t0[1]), pack_bf16(t0[2], t0[3]), pack_bf16(t1[0], t1[1]), pack_bf16(t1[2], t1[3]));
        } else if (n0 < 4608) {
          unsigned q0 = 0u, q1 = 0u;
#pragma unroll
          for (int e = 0; e < 4; ++e) {
            q0 = __builtin_amdgcn_cvt_pk_u8_f32(sigmoidf_(t0[e]) * 255.f, e, q0);
            q1 = __builtin_amdgcn_cvt_pk_u8_f32(sigmoidf_(t1[e]) * 255.f, e, q1);
          }
          unsigned char* gdst = (n0 < 3584) ? (unsigned char*)PP->sgd + gr * 1024 + (gc - 2560)
                                            : (unsigned char*)PP->sgp + gr * 1024 + (gc - 3584);
          *(uint2*)gdst = make_uint2(q0, q1);
        } else {
          if (gc - 4608 < 16) {
            *(float4*)(PP->ba + gr * 16 + (gc - 4608)) = make_float4(t0[0], t0[1], t0[2], t0[3]);
            *(float4*)(PP->ba + gr * 16 + (gc - 4608) + 4) = make_float4(t1[0], t1[1], t1[2], t1[3]);
          }
        }
      }
    }
    if (!hasn) break;
    m0 = m0n; n0 = n0n; ++it;
  }
}

__device__ __forceinline__ void phase_conv(int layer) {
  const KP PP = get_params();
  const int lane = TID() & 63;
  const int gw = BID() * 4 + (TID() >> 6), nw = gridDim.x * 4;
  const float* cw = PP->conv_w + (size_t)layer * 4 * 1536;
  float wr[3][4][8];
#pragma unroll
  for (int part = 0; part < 3; ++part)
#pragma unroll
    for (int j = 0; j < 4; ++j) {
      const float4 w0 = *(const float4*)(cw + j * 1536 + part * 512 + lane * 8);
      const float4 w1 = *(const float4*)(cw + j * 1536 + part * 512 + lane * 8 + 4);
      wr[part][j][0] = w0.x; wr[part][j][1] = w0.y; wr[part][j][2] = w0.z; wr[part][j][3] = w0.w;
      wr[part][j][4] = w1.x; wr[part][j][5] = w1.y; wr[part][j][6] = w1.z; wr[part][j][7] = w1.w;
    }
  for (int r = gw; r < R; r += nw) {
    int t, T;
    if (r < NLAT) { t = r & (SEQ - 1); T = SEQ; } else { t = (r - NLAT) & (CTX - 1); T = CTX; }
    const int base = r - t;
    uint2 xv[3][4];
#pragma unroll
    for (int j = 0; j < 4; ++j) {
      const int tt = t + j - 2;
      const bool ok = (tt >= 0 && tt < T);
      const unsigned char* src = (const unsigned char*)PP->qkv_pre + (size_t)(base + (ok ? tt : t)) * 1536 + lane * 8;
#pragma unroll
      for (int part = 0; part < 3; ++part) {
        xv[part][j] = *(const uint2*)(src + part * 512);
        if (!ok) xv[part][j] = make_uint2(0u, 0u);
      }
    }
#pragma unroll
    for (int part = 0; part < 3; ++part) {
      const int ch0 = part * 512 + lane * 8;
      float y[8];
#pragma unroll
      for (int e = 0; e < 8; ++e) y[e] = 0.f;
#pragma unroll
      for (int j = 0; j < 4; ++j) {
        float xf[8];
        {
          const f32x2 a0 = __builtin_amdgcn_cvt_pk_f32_fp8(xv[part][j].x, false), a1 = __builtin_amdgcn_cvt_pk_f32_fp8(xv[part][j].x, true);
          const f32x2 a2 = __builtin_amdgcn_cvt_pk_f32_fp8(xv[part][j].y, false), a3 = __builtin_amdgcn_cvt_pk_f32_fp8(xv[part][j].y, true);
          xf[0] = a0[0]; xf[1] = a0[1]; xf[2] = a1[0]; xf[3] = a1[1]; xf[4] = a2[0]; xf[5] = a2[1]; xf[6] = a3[0]; xf[7] = a3[1];
        }
#pragma unroll
        for (int e = 0; e < 8; ++e) y[e] += wr[part][j][e] * xf[e];
      }
      float ss = 0.f;
#pragma unroll
      for (int e = 0; e < 8; ++e) { y[e] = siluf_(y[e]); ss += y[e] * y[e]; }
      if (part < 2) {
        ss = group16_sum(ss);
        const float sc = rsqrtf(ss + EPS) * (part == 0 ? 0.08838834764831845f : 1.f);
#pragma unroll
        for (int e = 0; e < 8; ++e) y[e] *= sc;
      }
      *(uint4*)(PP->qkvn + (size_t)r * 1536 + ch0) = pack8(y);
    }
    if (lane < 16) {
      const float raw = PP->ba[(size_t)r * 16 + lane];
      float o;
      if (lane < 8) {
        o = sigmoidf_(raw);
      } else {
        const int jj = lane - 8;
        const float xx = raw + PP->dt_bias[layer * 8 + jj];
        const float ee = __expf(xx);
        const float sp = xx > 20.f ? xx : (ee < 0.03125f ? ee * (1.f - ee * (0.5f - ee * (0.33333334f - 0.25f * ee))) : __logf(1.f + ee));
        o = -__expf(PP->a_log[layer * 8 + jj]) * sp;
      }
      PP->bg[(size_t)r * 16 + lane] = o;
    }
  }
}

DEV int seq_row(int b, int dir, int pos) {
  if (dir == 0) return pos < CTX ? NLAT + b * CTX + pos : b * SEQ + (pos - CTX);
  return pos < CTX ? NLAT + b * CTX + (CTX - 1 - pos) : b * SEQ + (SEQ - 1 - (pos - CTX));
}
constexpr int NCHUNK = (CTX + SEQ) / 64;
constexpr int NUNIT = BATCH * DNH * 2 * NCHUNK;

DEV int kperm(int s, int g, int e) { return 32 * s + 16 * (e >> 2) + 4 * g + (e & 3); }

DEV uint4 pack_tiles(const f32x4& a, const f32x4& b) {
  return make_uint4(pack_bf16(a[0], a[1]), pack_bf16(a[2], a[3]), pack_bf16(b[0], b[1]), pack_bf16(b[2], b[3]));
}
DEV bf16x8 as_frag(const uint4& v) { return *(const bf16x8*)&v; }

DEV void conv8_silu(const unsigned char* __restrict__ qkv_pre8, const float* __restrict__ cw, int r, int ch0, float (&y)[8]) {
  int t, T;
  if (r < NLAT) { t = r & (SEQ - 1); T = SEQ; } else { t = (r - NLAT) & (CTX - 1); T = CTX; }
  const int base = r - t;
  uint2 xv[4];
#pragma unroll
  for (int j = 0; j < 4; ++j) {
    const int tt = t + j - 2;
    const bool ok = (tt >= 0 && tt < T);
    xv[j] = *(const uint2*)(qkv_pre8 + (size_t)(base + (ok ? tt : t)) * 1536 + ch0);
    if (!ok) xv[j] = make_uint2(0u, 0u);
  }
#pragma unroll
  for (int e = 0; e < 8; ++e) y[e] = 0.f;
#pragma unroll
  for (int j = 0; j < 4; ++j) {
    const float4 w0 = *(const float4*)(cw + j * 1536 + ch0), w1 = *(const float4*)(cw + j * 1536 + ch0 + 4);
    const f32x2 a0 = __builtin_amdgcn_cvt_pk_f32_fp8(xv[j].x, false), a1 = __builtin_amdgcn_cvt_pk_f32_fp8(xv[j].x, true);
    const f32x2 a2 = __builtin_amdgcn_cvt_pk_f32_fp8(xv[j].y, false), a3 = __builtin_amdgcn_cvt_pk_f32_fp8(xv[j].y, true);
    y[0] += w0.x * a0[0]; y[1] += w0.y * a0[1]; y[2] += w0.z * a1[0]; y[3] += w0.w * a1[1];
    y[4] += w1.x * a2[0]; y[5] += w1.y * a2[1]; y[6] += w1.z * a3[0]; y[7] += w1.w * a3[1];
  }
#pragma unroll
  for (int e = 0; e < 8; ++e) y[e] = siluf_(y[e]);
}

__device__ __forceinline__ void phase_prep(int layer, char* smem) {
  const KP PP = get_params();
  const int tid0 = TID();
  const int w = __builtin_amdgcn_readfirstlane(tid0 >> 6);
  char* Kt = smem;
  char* Vt = smem + 16384;
  float* Ld = (float*)(smem + 32768);
  u16* LN = (u16*)(smem + 32768 + 5120);
  float* gcs = (float*)(smem + 32768 + 5120 + 9216);
  float* bts = gcs + 64;
  char* wpriv = smem + 32768 + 5120 + 9216 + 512 + w * 6144;
  float* Tt = (float*)wpriv;
  u16* Xb = (u16*)(wpriv + 4096);
  float* egc = (float*)(smem + 72192);
  float* egl = egc + 64;
  const int per_ = gridDim.x >> 3, s_ = BID() >> 3;
  const int nfull_ = (2 * NCHUNK) / per_, nrem_ = (2 * NCHUNK) % per_;
  const bool altx_ = (2 * nrem_ <= per_);
  for (int ki_ = 0; ki_ <= nfull_; ++ki_) {
    int j_;
    if (ki_ < nfull_) j_ = s_ + per_ * ki_;
    else if (altx_) { if (!(s_ & 1) || (s_ >> 1) >= nrem_) break; j_ = nfull_ * per_ + (s_ >> 1); }
    else { if (s_ >= nrem_) break; j_ = nfull_ * per_ + s_; }
    const int c = NCHUNK - 1 - (j_ >> 1), u16i = (BID() & 7) * 2 + (j_ & 1);
    const int unit = u16i * NCHUNK + c;
    const int dir = u16i & 1, hd = (u16i >> 1) & 3, b = u16i >> 3;
    int tid = tid0;
    asm volatile("" : "+v"(tid));
    const int l = tid & 63, lr = l & 15, lg = l >> 4;
    __syncthreads();
    if (tid < 64) {
      const int rr = seq_row(b, dir, c * 64 + tid);
      const int jj = dir * 4 + hd;
      bts[tid] = sigmoidf_(PP->ba[(size_t)rr * 16 + jj]);
      float g;
      {
        const float xx = PP->ba[(size_t)rr * 16 + 8 + jj] + PP->dt_bias[layer * 8 + jj];
        const float ee = __expf(xx);
        const float sp = xx > 20.f ? xx : (ee < 0.03125f ? ee * (1.f - ee * (0.5f - ee * (0.33333334f - 0.25f * ee))) : __logf(1.f + ee));
        g = -__expf(PP->a_log[layer * 8 + jj]) * sp;
      }
#pragma unroll
      for (int o = 1; o < 64; o <<= 1) {
        const float t = __builtin_bit_cast(float, __builtin_amdgcn_ds_bpermute(((tid - o) & 63) << 2, __builtin_bit_cast(int, g)));
        if (tid >= o) g += t;
      }
      gcs[tid] = g;
      egc[tid] = __expf(g);
      egl[tid] = __expf(__builtin_bit_cast(float, __builtin_amdgcn_readlane(__builtin_bit_cast(int, g), 63)) - g);
      PP->gc[(size_t)unit * 64 + tid] = g;
    }
    {
      const unsigned char* pre8 = (const unsigned char*)PP->qkv_pre;
      const float* cw = PP->conv_w + (size_t)layer * 4 * 1536;
      const int ch = tid & 15, rg = tid >> 4;
      const int r_first = seq_row(b, dir, c * 64 + 4 * rg);
      int t0, T;
      if (r_first < NLAT) { t0 = r_first & (SEQ - 1); T = SEQ; } else { t0 = (r_first - NLAT) & (CTX - 1); T = CTX; }
      const int base = r_first - t0;
      const int tl = dir ? t0 - 3 : t0;
      const int nparts = dir == 0 ? 3 : 2;
      uint2 xr_all[3][7];
#pragma unroll
      for (int part = 0; part < 3; ++part) {
#pragma unroll
        for (int m = 0; m < 7; ++m) xr_all[part][m] = make_uint2(0u, 0u);
      }
#pragma unroll
      for (int part = 0; part < 3; ++part) {
        if (part < nparts) {
          const int chofs = (part == 0 ? 512 : (part == 1 ? 1024 : 0)) + hd * 128 + ch * 8;
#pragma unroll
          for (int m = 0; m < 7; ++m) {
            const int tt = tl - 2 + m;
            const bool ok = (tt >= 0 && tt < T);
            const uint2 v = *(const uint2*)(pre8 + (size_t)(base + (ok ? tt : t0)) * 1536 + chofs);
            xr_all[part][m] = ok ? v : make_uint2(0u, 0u);
          }
        }
      }
#pragma unroll
      for (int part = 0; part < 3; ++part) {
        if (part >= nparts) continue;
        const int chofs = (part == 0 ? 512 : (part == 1 ? 1024 : 0)) + hd * 128 + ch * 8;
        f32x2 wv[4][4];
#pragma unroll
        for (int j = 0; j < 4; ++j) {
          const float4 w0 = *(const float4*)(cw + j * 1536 + chofs), w1 = *(const float4*)(cw + j * 1536 + chofs + 4);
          wv[j][0] = (f32x2){w0.x, w0.y}; wv[j][1] = (f32x2){w0.z, w0.w};
          wv[j][2] = (f32x2){w1.x, w1.y}; wv[j][3] = (f32x2){w1.z, w1.w};
        }
        uint2 xr[7];
#pragma unroll
        for (int m = 0; m < 7; ++m) xr[m] = xr_all[part][m];
        f32x2 xf[7][4];
#pragma unroll
        for (int m = 0; m < 7; ++m) {
          xf[m][0] = __builtin_amdgcn_cvt_pk_f32_fp8(xr[m].x, false); xf[m][1] = __builtin_amdgcn_cvt_pk_f32_fp8(xr[m].x, true);
          xf[m][2] = __builtin_amdgcn_cvt_pk_f32_fp8(xr[m].y, false); xf[m][3] = __builtin_amdgcn_cvt_pk_f32_fp8(xr[m].y, true);
        }
        f32x2 acc2[4][4];
        if (dir == 0) {
#pragma unroll
          for (int s4 = 0; s4 < 4; ++s4)
#pragma unroll
            for (int p = 0; p < 4; ++p) {
              f32x2 a = wv[0][p] * xf[s4][p];
#pragma unroll
              for (int j = 1; j < 4; ++j) a += wv[j][p] * xf[s4 + j][p];
              acc2[s4][p] = a;
            }
        } else {
#pragma unroll
          for (int s4 = 0; s4 < 4; ++s4)
#pragma unroll
            for (int p = 0; p < 4; ++p) {
              f32x2 a = wv[0][p] * xf[3 - s4][p];
#pragma unroll
              for (int j = 1; j < 4; ++j) a += wv[j][p] * xf[3 - s4 + j][p];
              acc2[s4][p] = a;
            }
        }
        float y[4][8], ss[4];
#pragma unroll
        for (int s4 = 0; s4 < 4; ++s4) {
          float t = 0.f;
#pragma unroll
          for (int p = 0; p < 4; ++p) {
            const float a0 = siluf_(acc2[s4][p][0]), a1 = siluf_(acc2[s4][p][1]);
            y[s4][2 * p] = a0; y[s4][2 * p + 1] = a1;
            t += a0 * a0 + a1 * a1;
          }
          ss[s4] = t;
        }
        if (part != 1) {
#pragma unroll
          for (int s4 = 0; s4 < 4; ++s4) ss[s4] += swz_xor<8>(ss[s4]);
#pragma unroll
          for (int s4 = 0; s4 < 4; ++s4) ss[s4] += swz_xor<4>(ss[s4]);
#pragma unroll
          for (int s4 = 0; s4 < 4; ++s4) ss[s4] += swz_xor<2>(ss[s4]);
#pragma unroll
          for (int s4 = 0; s4 < 4; ++s4) ss[s4] += swz_xor<1>(ss[s4]);
#pragma unroll
          for (int s4 = 0; s4 < 4; ++s4) {
            const float sc = rsqrtf(ss[s4] + EPS) * (part == 2 ? 0.08838834764831845f : 1.f);
#pragma unroll
            for (int e2 = 0; e2 < 8; ++e2) y[s4][e2] *= sc;
          }
        }
#pragma unroll
        for (int s4 = 0; s4 < 4; ++s4) {
          const int m0_ = dir ? 3 - s4 : s4;
          const uint4 pk = pack8(y[s4]);
          const int i = 4 * rg + s4;
          if (part < 2) *(uint4*)((part == 0 ? Kt : Vt) + i * 256 + ((ch ^ (i & 15)) << 4)) = pk;
          if (dir == 0 && part != 1) *(uint4*)(PP->qkvn + (size_t)(base + tl + m0_) * 1536 + chofs) = pk;
        }
      }
    }
    __syncthreads();
    {
      f32x4 acc[4];
#pragma unroll
      for (int nt = 0; nt < 4; ++nt) acc[nt] = (f32x4){0.f, 0.f, 0.f, 0.f};
#pragma unroll
      for (int s = 0; s < 4; ++s) {
        const int ch = s * 4 + lg;
        const bf16x8 a = *(const bf16x8*)(Kt + (16 * w + lr) * 256 + ((ch ^ lr) << 4));
#pragma unroll
        for (int nt = 0; nt < 4; ++nt) {
          const bf16x8 bb = *(const bf16x8*)(Kt + (16 * nt + lr) * 256 + ((ch ^ lr) << 4));
          acc[nt] = __builtin_amdgcn_mfma_f32_16x16x32_bf16(a, bb, acc[nt], 0, 0, 0);
        }
      }
#pragma unroll
      for (int nt = 0; nt < 4; ++nt)
#pragma unroll
        for (int r = 0; r < 4; ++r) {
          const int i = 16 * w + 4 * lg + r, j = 16 * nt + lr;
          const float val = (j < i) ? bts[i] * acc[nt][r] * __expf(fminf(gcs[i] - gcs[j], 0.f)) : 0.f;
          LN[i * 72 + j] = f2bf(-val);
          if (nt == w) Ld[(w * 16 + lr) * 20 + 4 * lg + r] = val;
        }
    }
    {
      const float glast = gcs[63];
      if (tid == 0) PP->glast[unit] = glast;
#pragma unroll
      for (int q4 = 0; q4 < 4; ++q4) {
        const int fid = tid + 256 * q4;
        const int mt = fid >> 7, s2 = (fid >> 6) & 1, ln = fid & 63, llr = ln & 15, llg = ln >> 4;
        const int d = 16 * mt + llr;
        float f[8];
#pragma unroll
        for (int e = 0; e < 8; ++e) {
          const int pos = kperm(s2, llg, e);
          const float kv = bf2f(*(const u16*)(Kt + pos * 256 + (((d >> 3) ^ (pos & 15)) << 4) + (d & 7) * 2));
          f[e] = kv * egl[pos];
        }
        *(uint4*)(PP->KdT + ((size_t)unit * 1024 + fid) * 8) = pack8(f);
      }
    }
    f32x4 X[4][4];
    {
      const bool isU = w >= 2;
      const char* tile = isU ? Vt : Kt;
#pragma unroll
      for (int mt = 0; mt < 4; ++mt)
#pragma unroll
        for (int nt = 0; nt < 4; ++nt)
#pragma unroll
          for (int r = 0; r < 4; ++r) {
            const int i = 16 * mt + 4 * lg + r, cc = 64 * (w & 1) + 16 * nt + lr;
            const float val = bf2f(*(const u16*)(tile + i * 256 + (((cc >> 3) ^ (i & 15)) << 4) + (cc & 7) * 2));
            X[mt][nt][r] = bts[i] * val * (isU ? 1.f : egc[i]);
          }
    }
    __syncthreads();
    u16* Wst = (u16*)smem;
    u16* Ust = (u16*)(smem + 16384);
#pragma unroll
    for (int bk = 0; bk < 4; ++bk) {
#pragma unroll
      for (int nt = 0; nt < 4; ++nt)
#pragma unroll
        for (int r = 0; r < 4; ++r) Tt[(4 * lg + r) * 64 + 16 * nt + lr] = X[bk][nt][r];
      __builtin_amdgcn_wave_barrier();
      asm volatile("s_waitcnt lgkmcnt(0)" ::: "memory");
      float xb[16];
#pragma unroll
      for (int i = 0; i < 16; ++i) xb[i] = Tt[i * 64 + l];
#pragma unroll
      for (int j = 0; j < 15; ++j) {
        const float xj = xb[j];
#pragma unroll
        for (int i4 = (j + 1) / 4; i4 < 4; ++i4) {
          const float4 lv = *(const float4*)&Ld[(bk * 16 + j) * 20 + i4 * 4];
          if (i4 * 4 + 0 > j) xb[i4 * 4 + 0] -= lv.x * xj;
          if (i4 * 4 + 1 > j) xb[i4 * 4 + 1] -= lv.y * xj;
          if (i4 * 4 + 2 > j) xb[i4 * 4 + 2] -= lv.z * xj;
          if (i4 * 4 + 3 > j) xb[i4 * 4 + 3] -= lv.w * xj;
        }
      }
      {
        const int cc = 64 * (w & 1) + l;
        if (w < 2) {
          const int d = cc, s = d >> 5, e = ((d >> 4) & 1) * 4 + (d & 3), g = (d >> 2) & 3;
#pragma unroll
          for (int ii = 0; ii < 16; ++ii) Wst[(((bk * 4 + s) * 64 + g * 16 + ii) << 3) + e] = f2bf(-xb[ii]);
        } else {
          const int slice = cc >> 4, lr_ = cc & 15;
#pragma unroll
          for (int ii = 0; ii < 16; ++ii) Ust[(((slice * 4 + bk) * 64 + ((ii >> 2) & 3) * 16 + lr_) << 2) + (ii & 3)] = f2bf(xb[ii]);
        }
        if (bk < 3) {
          *(uint4*)(Xb + l * 16) = pack8(xb);
          *(uint4*)(Xb + l * 16 + 8) = pack8(xb + 8);
        }
      }
      if (bk < 3) {
        __builtin_amdgcn_wave_barrier();
        asm volatile("s_waitcnt lgkmcnt(0)" ::: "memory");
        uint4 bfr[4];
#pragma unroll
        for (int nt = 0; nt < 4; ++nt)
          bfr[nt] = (lg < 2) ? *(const uint4*)(Xb + (16 * nt + lr) * 16 + 8 * lg) : make_uint4(0u, 0u, 0u, 0u);
#pragma unroll
        for (int mt = bk + 1; mt < 4; ++mt) {
          const uint4 afr = (lg < 2) ? *(const uint4*)(LN + (16 * mt + lr) * 72 + 16 * bk + 8 * lg) : make_uint4(0u, 0u, 0u, 0u);
#pragma unroll
          for (int nt = 0; nt < 4; ++nt)
            X[mt][nt] = __builtin_amdgcn_mfma_f32_16x16x32_bf16(as_frag(afr), as_frag(bfr[nt]), X[mt][nt], 0, 0, 0);
        }
        __builtin_amdgcn_wave_barrier();
      }
    }
    __syncthreads();
#pragma unroll
    for (int q = 0; q < 4; ++q) {
      const int id = tid + 256 * q;
      *(uint4*)(PP->Wfrag + ((size_t)unit * 1024 + id) * 8) = *(const uint4*)(smem + id * 16);
      *(uint4*)(PP->Ufrag + ((size_t)unit * 1024 + id) * 8) = *(const uint4*)(smem + 16384 + id * 16);
    }
  }
}


__device__ __forceinline__ void phase_scan(char* smem) {
  const KP PP = get_params();
  const int tid = TID(), lane = tid & 63, wv = tid >> 6;
  __builtin_amdgcn_s_setprio(3);
  for (int item = BID(); item < 128; item += gridDim.x) {
    const int u16i = (item & 7) * 2 + (item >> 6), slice = (item >> 3) & 7;
    const size_t ubase = (size_t)u16i * NCHUNK;
    const uint4* Wg = (const uint4*)PP->Wfrag;
    const uint4* Kg = (const uint4*)PP->KdT;
    __syncthreads();
    if (wv != 0) {
      const int j0 = wv - 1;
      uint4 st0[11], st1[11], st2[11];
#pragma unroll
      for (int i = 0; i < 11; ++i) { st0[i] = make_uint4(0u, 0u, 0u, 0u); st1[i] = st0[i]; st2[i] = st0[i]; }
#define LLOAD(ST, UNIT)                                                                                      \
  _Pragma("unroll") for (int i = 0; i < 11; ++i) {                                                           \
    const int q = (j0 + 3 * i) < 32 ? (j0 + 3 * i) : 31;                                                     \
    ST[i] = *((q < 16 ? Wg + (UNIT) * 1024 + q * 64 : Kg + (UNIT) * 1024 + (q - 16) * 64) + lane);           \
  }
#define LWRITE(ST, SLOT)                                                                                     \
  _Pragma("unroll") for (int i = 0; i < 11; ++i) {                                                           \
    const int q = (j0 + 3 * i) < 32 ? (j0 + 3 * i) : 31;                                                     \
    *(uint4*)((SLOT) + q * 1024 + lane * 16) = ST[i];                                                        \
  }
      LLOAD(st0, ubase);
      LLOAD(st1, ubase + 1);
      LLOAD(st2, ubase + 2);
      LWRITE(st0, smem);
      LLOAD(st0, ubase + 3);
      __syncthreads();
#define LSTEP(ST, C)                                                                   \
  {                                                                                    \
    LWRITE(ST, smem + (((C) + 1) & 1) * 32768);                                        \
    LLOAD(ST, ubase + (size_t)(((C) + 4 < NCHUNK) ? (C) + 4 : NCHUNK - 1));            \
    __syncthreads();                                                                   \
  }
      for (int c0 = 0; c0 < NCHUNK; c0 += 3) {
        LSTEP(st1, c0);
        LSTEP(st2, c0 + 1);
        LSTEP(st0, c0 + 2);
      }
#undef LSTEP
#undef LLOAD
#undef LWRITE
    } else {
      f32x4 S[8];
#pragma unroll
      for (int t = 0; t < 8; ++t) S[t] = (f32x4){0.f, 0.f, 0.f, 0.f};
      uint2 uf0[5], uf1[5], uf2[5];
#pragma unroll
      for (int i = 0; i < 5; ++i) { uf0[i] = make_uint2(0u, 0u); uf1[i] = uf0[i]; uf2[i] = uf0[i]; }
      const uint2* Ug = (const uint2*)PP->Ufrag + lane;
      const float* Gl = PP->glast;
#define ULOAD(UF, UNIT) { _Pragma("unroll") for (int i = 0; i < 4; ++i) UF[i] = Ug[((UNIT) * 8 + slice) * 256 + i * 64]; UF[4].x = __float_as_uint(Gl[UNIT]); }
      ULOAD(uf0, ubase);
      ULOAD(uf1, ubase + 1);
      ULOAD(uf2, ubase + 2);
#define CSTEP(UF, C)                                                                                                   \
  {                                                                                                                    \
    const int c = (C);                                                                                                 \
    const size_t unit = ubase + c;                                                                                     \
    const char* slot = smem + (c & 1) * 32768;                                                                         \
    const float el = __expf(__uint_as_float(UF[4].x));                                                                 \
    uint4 sb[4];                                                                                                       \
    _Pragma("unroll") for (int s2 = 0; s2 < 4; ++s2) sb[s2] = pack_tiles(S[2 * s2], S[2 * s2 + 1]);                    \
    {                                                                                                                  \
      uint4* sp = (uint4*)PP->Sfrag + (unit * 8 + slice) * 256 + lane;                                                 \
      _Pragma("unroll") for (int s2 = 0; s2 < 4; ++s2) sp[s2 * 64] = sb[s2];                                           \
    }                                                                                                                  \
    f32x4 vn[4];                                                                                                       \
    _Pragma("unroll") for (int mt = 0; mt < 4; ++mt) {                                                                 \
      vn[mt] = (f32x4){bf_lo(UF[mt].x), bf_hi(UF[mt].x), bf_lo(UF[mt].y), bf_hi(UF[mt].y)};                            \
      _Pragma("unroll") for (int s2 = 0; s2 < 4; ++s2) {                                                               \
        const uint4 wfr = *(const uint4*)(slot + (mt * 4 + s2) * 1024 + lane * 16);                                    \
        vn[mt] = __builtin_amdgcn_mfma_f32_16x16x32_bf16(as_frag(wfr), as_frag(sb[s2]), vn[mt], 0, 0, 0);              \
      }                                                                                                                \
    }                                                                                                                  \
    ULOAD(UF, ubase + (size_t)((c + 3 < NCHUNK) ? c + 3 : NCHUNK - 1));                                                \
    uint4 vb[2];                                                                                                       \
    vb[0] = pack_tiles(vn[0], vn[1]);                                                                                  \
    vb[1] = pack_tiles(vn[2], vn[3]);                                                                                  \
    {                                                                                                                  \
      uint4* vp = (uint4*)PP->Vfrag + (unit * 8 + slice) * 128 + lane;                                                 \
      vp[0] = vb[0];                                                                                                   \
      vp[64] = vb[1];                                                                                                  \
    }                                                                                                                  \
    _Pragma("unroll") for (int t = 0; t < 8; ++t) {                                                                    \
      S[t] *= el;                                                                                                      \
      const uint4 k0 = *(const uint4*)(slot + 16384 + (t * 2 + 0) * 1024 + lane * 16);                                 \
      const uint4 k1 = *(const uint4*)(slot + 16384 + (t * 2 + 1) * 1024 + lane * 16);                                 \
      S[t] = __builtin_amdgcn_mfma_f32_16x16x32_bf16(as_frag(k0), as_frag(vb[0]), S[t], 0, 0, 0);                      \
      S[t] = __builtin_amdgcn_mfma_f32_16x16x32_bf16(as_frag(k1), as_frag(vb[1]), S[t], 0, 0, 0);                      \
    }                                                                                                                  \
    __syncthreads();                                                                                                   \
  }
      __syncthreads();
      for (int c0 = 0; c0 < NCHUNK; c0 += 3) {
        CSTEP(uf0, c0);
        CSTEP(uf1, c0 + 1);
        CSTEP(uf2, c0 + 2);
      }
#undef CSTEP
#undef ULOAD
    }
  }
  __builtin_amdgcn_s_setprio(0);
}

__device__ __forceinline__ void phase_o(int layer, char* smem) {
  const KP PP = get_params();
  const int tid = TID(), l = tid & 63, w = tid >> 6, lr = l & 15, lg = l >> 4;
  char* Qt = smem;
  char* Kt = smem + 16384;
  u16* If = (u16*)(smem + 32768);
  u16* Ib = (u16*)(smem + 41984);
  float* gcf = (float*)(smem + 51200);
  float* gcb = gcf + 64;
  float* rowss = gcb + 64;
  float* Os = (float*)smem;
  const int nper = (layer == DEPTH - 1) ? 128 : 132;
  const int xq = BID() & 7, vl0 = BID() >> 3, vstep = gridDim.x >> 3;
  for (int vi = vl0; vi < nper; vi += vstep) {
    int b = xq >> 2, hd = xq & 3, tok0, cf, cb;
    if (vi < 128) {
      const int n = vi;
      tok0 = b * SEQ + 64 * n; cf = 4 + n; cb = 4 + 127 - n;
    } else {
      const int n = vi - 128;
      tok0 = NLAT + b * CTX + 64 * n; cf = n; cb = 3 - n;
    }
    const size_t unit_f = (size_t)((b * 4 + hd) * 2 + 0) * NCHUNK + cf;
    const size_t unit_b = (size_t)((b * 4 + hd) * 2 + 1) * NCHUNK + cb;
    uint4 pSF[4][2], pSB[4][2], pVF[2][2], pVB[2][2];
#pragma unroll
    for (int q = 0; q < 2; ++q) {
      const int sl = 2 * w + q;
#pragma unroll
      for (int s = 0; s < 4; ++s) {
        pSF[s][q] = *((const uint4*)PP->Sfrag + ((unit_f * 8 + sl) * 4 + s) * 64 + l);
        pSB[s][q] = *((const uint4*)PP->Sfrag + ((unit_b * 8 + sl) * 4 + s) * 64 + l);
      }
#pragma unroll
      for (int s2 = 0; s2 < 2; ++s2) {
        pVF[s2][q] = *((const uint4*)PP->Vfrag + ((unit_f * 8 + sl) * 2 + s2) * 64 + l);
        pVB[s2][q] = *((const uint4*)PP->Vfrag + ((unit_b * 8 + sl) * 2 + s2) * 64 + l);
      }
    }
    __syncthreads();
    for (int idx = tid; idx < 2048; idx += NTHR) {
      const int arr = idx >> 10, i = (idx >> 4) & 63, ch = idx & 15;
      const uint4 v = *(const uint4*)(PP->qkvn + (size_t)(tok0 + i) * 1536 + (arr == 0 ? 0 : 512) + hd * 128 + ch * 8);
      *(uint4*)((arr == 0 ? Qt : Kt) + i * 256 + ((ch ^ (i & 15)) << 4)) = v;
    }
    if (tid < 64) gcf[tid] = PP->gc[unit_f * 64 + tid];
    else if (tid < 128) gcb[tid - 64] = PP->gc[unit_b * 64 + (tid - 64)];
    __syncthreads();
    {
      f32x4 acc[4];
#pragma unroll
      for (int nt = 0; nt < 4; ++nt) acc[nt] = (f32x4){0.f, 0.f, 0.f, 0.f};
#pragma unroll
      for (int s = 0; s < 4; ++s) {
        const int ch = s * 4 + lg;
        const bf16x8 a = *(const bf16x8*)(Qt + (16 * w + lr) * 256 + ((ch ^ lr) << 4));
#pragma unroll
        for (int nt = 0; nt < 4; ++nt) {
          const bf16x8 bb = *(const bf16x8*)(Kt + (16 * nt + lr) * 256 + ((ch ^ lr) << 4));
          acc[nt] = __builtin_amdgcn_mfma_f32_16x16x32_bf16(a, bb, acc[nt], 0, 0, 0);
        }
      }
#pragma unroll
      for (int nt = 0; nt < 4; ++nt)
#pragma unroll
        for (int r = 0; r < 4; ++r) {
          const int i = 16 * w + 4 * lg + r, j = 16 * nt + lr;
          const float vf = (j <= i) ? acc[nt][r] * __expf(fminf(gcf[i] - gcf[j], 0.f)) : 0.f;
          const float vb = (j >= i) ? acc[nt][r] * __expf(fminf(gcb[63 - i] - gcb[63 - j], 0.f)) : 0.f;
          If[i * 72 + j] = f2bf(vf);
          Ib[i * 72 + (63 - j)] = f2bf(vb);
        }
    }
    __syncthreads();
    f32x4 accF[4][2], accB[4][2], accI[4][2];
#pragma unroll
    for (int mt = 0; mt < 4; ++mt)
#pragma unroll
      for (int q = 0; q < 2; ++q) {
        accF[mt][q] = (f32x4){0.f, 0.f, 0.f, 0.f};
        accB[mt][q] = (f32x4){0.f, 0.f, 0.f, 0.f};
        accI[mt][q] = (f32x4){0.f, 0.f, 0.f, 0.f};
      }
#pragma unroll
    for (int s = 0; s < 4; ++s) {
      bf16x8 qa[4];
#pragma unroll
      for (int mt = 0; mt < 4; ++mt) {
        const int row = 16 * mt + lr;
        const int c0 = 4 * s + (lg >> 1), c1 = c0 + 2;
        const uint2 lo = *(const uint2*)(Qt + row * 256 + ((c0 ^ lr) << 4) + (lg & 1) * 8);
        const uint2 hi = *(const uint2*)(Qt + row * 256 + ((c1 ^ lr) << 4) + (lg & 1) * 8);
        const uint4 t = make_uint4(lo.x, lo.y, hi.x, hi.y);
        qa[mt] = as_frag(t);
      }
#pragma unroll
      for (int q = 0; q < 2; ++q) {
        const int sl = 2 * w + q;
        const uint4 bF = pSF[s][q], bB = pSB[s][q];
#pragma unroll
        for (int mt = 0; mt < 4; ++mt) {
          accF[mt][q] = __builtin_amdgcn_mfma_f32_16x16x32_bf16(qa[mt], as_frag(bF), accF[mt][q], 0, 0, 0);
          accB[mt][q] = __builtin_amdgcn_mfma_f32_16x16x32_bf16(qa[mt], as_frag(bB), accB[mt][q], 0, 0, 0);
        }
      }
    }
#pragma unroll
    for (int s2 = 0; s2 < 2; ++s2) {
      bf16x8 ia[4], ib[4];
#pragma unroll
      for (int mt = 0; mt < 4; ++mt) {
        const int row = 16 * mt + lr;
        const int col = 32 * s2 + 4 * lg;
        const uint2 flo = *(const uint2*)(If + row * 72 + col);
        const uint2 fhi = *(const uint2*)(If + row * 72 + col + 16);
        const uint2 blo = *(const uint2*)(Ib + row * 72 + col);
        const uint2 bhi = *(const uint2*)(Ib + row * 72 + col + 16);
        const uint4 tf = make_uint4(flo.x, flo.y, fhi.x, fhi.y);
        const uint4 tb = make_uint4(blo.x, blo.y, bhi.x, bhi.y);
        ia[mt] = as_frag(tf);
        ib[mt] = as_frag(tb);
      }
#pragma unroll
      for (int q = 0; q < 2; ++q) {
        const int sl = 2 * w + q;
        const uint4 vF = pVF[s2][q], vB = pVB[s2][q];
#pragma unroll
        for (int mt = 0; mt < 4; ++mt) {
          accI[mt][q] = __builtin_amdgcn_mfma_f32_16x16x32_bf16(ia[mt], as_frag(vF), accI[mt][q], 0, 0, 0);
          accI[mt][q] = __builtin_amdgcn_mfma_f32_16x16x32_bf16(ib[mt], as_frag(vB), accI[mt][q], 0, 0, 0);
        }
      }
    }
    float o[4][2][4], ssr[4][4];
#pragma unroll
    for (int mt = 0; mt < 4; ++mt)
#pragma unroll
      for (int r = 0; r < 4; ++r) {
        const int i = 16 * mt + 4 * lg + r;
        const float ef = __expf(gcf[i]), eb = __expf(gcb[63 - i]);
        float ss = 0.f;
#pragma unroll
        for (int q = 0; q < 2; ++q) {
          const float v = ef * accF[mt][q][r] + eb * accB[mt][q][r] + accI[mt][q][r];
          o[mt][q][r] = v;
          ss += v * v;
        }
        ssr[mt][r] = ss;
      }
#define O_RED(O_)                                                                  \
    _Pragma("unroll") for (int mt = 0; mt < 4; ++mt)                               \
      _Pragma("unroll") for (int r = 0; r < 4; ++r) ssr[mt][r] += swz_xor<O_>(ssr[mt][r]);
    O_RED(8) O_RED(4) O_RED(2) O_RED(1)
#undef O_RED
    if (lr == 0) {
#pragma unroll
      for (int mt = 0; mt < 4; ++mt)
#pragma unroll
        for (int r = 0; r < 4; ++r) rowss[w * 64 + 16 * mt + 4 * lg + r] = ssr[mt][r];
    }
    __syncthreads();
#pragma unroll
    for (int mt = 0; mt < 4; ++mt)
#pragma unroll
      for (int q = 0; q < 2; ++q)
#pragma unroll
        for (int r = 0; r < 4; ++r) Os[(16 * mt + 4 * lg + r) * 132 + 16 * (2 * w + q) + lr] = o[mt][q][r];
    __syncthreads();
#pragma unroll
    for (int q4 = 0; q4 < 4; ++q4) {
      const int idx = tid + 256 * q4, i = idx >> 4, ch = idx & 15;
      const float ss = rowss[i] + rowss[64 + i] + rowss[128 + i] + rowss[192 + i];
      const float rs = rsqrtf(ss * (1.f / 128.f) + EPS);
      const float4 o0 = *(const float4*)&Os[i * 132 + ch * 8];
      const float4 o1 = *(const float4*)&Os[i * 132 + ch * 8 + 4];
      const float4 n0 = *(const float4*)(PP->dn_out_norm + layer * 128 + ch * 8);
      const float4 n1 = *(const float4*)(PP->dn_out_norm + layer * 128 + ch * 8 + 4);
      float zf[8];
      unpack8(*(const uint4*)(PP->z + (size_t)(tok0 + i) * 512 + hd * 128 + ch * 8), zf);
      float y[8];
      y[0] = o0.x * rs * n0.x * siluf_(zf[0]); y[1] = o0.y * rs * n0.y * siluf_(zf[1]);
      y[2] = o0.z * rs * n0.z * siluf_(zf[2]); y[3] = o0.w * rs * n0.w * siluf_(zf[3]);
      y[4] = o1.x * rs * n1.x * siluf_(zf[4]); y[5] = o1.y * rs * n1.y * siluf_(zf[5]);
      y[6] = o1.z * rs * n1.z * siluf_(zf[6]); y[7] = o1.w * rs * n1.w * siluf_(zf[7]);
      {
        int p0 = __builtin_amdgcn_cvt_pk_fp8_f32(y[0], y[1], 0, false);
        p0 = __builtin_amdgcn_cvt_pk_fp8_f32(y[2], y[3], p0, true);
        int p1 = __builtin_amdgcn_cvt_pk_fp8_f32(y[4], y[5], 0, false);
        p1 = __builtin_amdgcn_cvt_pk_fp8_f32(y[6], y[7], p1, true);
        *(int2*)((char*)PP->ydn + (size_t)(tok0 + i) * (LDK5 * 2) + hd * 128 + ch * 8) = make_int2(p0, p1);
      }
    }
  }
}

template <int HALF>
DEV void pool_window(const u16* xin, char* Ap, int t0, int L, int tid) {
#pragma unroll
  for (int q = 0; q < 4; ++q) {
    const int idx = tid + 256 * q, i = idx >> 4, c = idx & 15;
    const int t = t0 + i;
    const int lo = (t - HALF) > 0 ? (t - HALF) : 0;
    const int hi = (t + HALF) < L ? (t + HALF) : L;
    float s[8];
#pragma unroll
    for (int e = 0; e < 8; ++e) s[e] = 0.f;
#pragma unroll
    for (int k = 0; k < 2 * HALF; ++k) {
      float f[8];
      unpack8(*(const uint4*)(xin + (i + 8 - HALF + k) * 128 + c * 8), f);
#pragma unroll
      for (int e = 0; e < 8; ++e) s[e] += f[e];
    }
    float xs[8];
    unpack8(*(const uint4*)(xin + (i + 8) * 128 + c * 8), xs);
    const float inv = 1.f / (float)(hi - lo);
#pragma unroll
    for (int e = 0; e < 8; ++e) s[e] = s[e] * inv - xs[e];
    *(uint4*)(Ap + i * 256 + ((c ^ (i & 15)) << 4)) = pack8(s);
  }
}

__device__ __forceinline__ void phase_pool(int layer, char* smem, int vbid, int vnb) {
  const KP PP = get_params();
  const int tid = TID(), l = tid & 63, w = tid >> 6, lr = l & 15, lg = l >> 4;
  u16* xin = (u16*)smem;
  char* Ap = smem + 20480;
  char* Bs = smem + 36864;
  const int ntile = (layer == DEPTH - 1) ? NLAT / 64 : R / 64;
  for (int it = vbid; it < ntile * 4; it += vnb) {
    const int ti = it >> 2, g = it & 3;
    int L, t0, rowbase;
    if (ti < NLAT / 64) { L = 64; t0 = 0; rowbase = ti * 64; }
    else { const int ci = ti - NLAT / 64; L = CTX; t0 = (ci & 3) * 64; rowbase = NLAT + (ci >> 2) * CTX; }
    const int r0 = rowbase + t0;
    __syncthreads();
#pragma unroll
    for (int q = 0; q < 5; ++q) {
      const int idx = tid + 256 * q, i = idx >> 4, c = idx & 15;
      const int pos = t0 - 8 + i;
      uint4 v = make_uint4(0, 0, 0, 0);
      if (pos >= 0 && pos < L) v = *(const uint4*)(PP->pin + (size_t)(rowbase + pos) * 512 + g * 128 + c * 8);
      *(uint4*)(xin + i * 128 + c * 8) = v;
    }
    {
      const u16* Bw = PP->PwT + (size_t)(layer * 4 + g) * 128 * 128;
#pragma unroll
      for (int q = 0; q < 8; ++q) {
        const int idx = tid + 256 * q, n = idx >> 4, c = idx & 15;
        *(uint4*)(Bs + n * 256 + ((c ^ (n & 15)) << 4)) = *(const uint4*)(Bw + (size_t)n * 128 + c * 8);
      }
    }
    __syncthreads();
    if (g == 0) pool_window<1>(xin, Ap, t0, L, tid);
    else if (g == 1) pool_window<2>(xin, Ap, t0, L, tid);
    else if (g == 2) pool_window<4>(xin, Ap, t0, L, tid);
    else pool_window<8>(xin, Ap, t0, L, tid);
    __syncthreads();
    f32x4 acc[8];
#pragma unroll
    for (int ni = 0; ni < 8; ++ni) acc[ni] = (f32x4){0.f, 0.f, 0.f, 0.f};
#pragma unroll
    for (int ks = 0; ks < 4; ++ks) {
      const int row = w * 16 + lr, c = ks * 4 + lg;
      const bf16x8 a = *(const bf16x8*)(Ap + row * 256 + ((c ^ lr) << 4));
#pragma unroll
      for (int ni = 0; ni < 8; ++ni) {
        const bf16x8 bb = *(const bf16x8*)(Bs + (ni * 16 + lr) * 256 + ((c ^ lr) << 4));
        acc[ni] = __builtin_amdgcn_mfma_f32_16x16x32_bf16(bb, a, acc[ni], 0, 0, 0);
      }
    }
    unsigned char* ot = (unsigned char*)smem;
#pragma unroll
    for (int ni = 0; ni < 8; ++ni) {
      const int dcol = ni * 16 + 4 * lg;
      const float4 psc = *(const float4*)(PP->pool_scale + layer * 512 + g * 128 + dcol);
      int pk = __builtin_amdgcn_cvt_pk_fp8_f32(acc[ni][0] * psc.x, acc[ni][1] * psc.y, 0, false);
      pk = __builtin_amdgcn_cvt_pk_fp8_f32(acc[ni][2] * psc.z, acc[ni][3] * psc.w, pk, true);
      *(int*)(ot + (w * 16 + lr) * 128 + dcol) = pk;
    }
    __syncthreads();
    {
      const int row = tid >> 2, seg = tid & 3;
      const uint4 o0 = *(const uint4*)(ot + row * 128 + seg * 32), o1 = *(const uint4*)(ot + row * 128 + seg * 32 + 16);
      unsigned char* dst = (unsigned char*)PP->ypool + (size_t)(r0 + row) * (LDK5 * 2) + g * 128 + seg * 32;
      *(uint4*)dst = o0;
      *(uint4*)(dst + 16) = o1;
    }
  }
}

__device__ __forceinline__ void phase_merge(int layer, char* smem) {
  const KP PP = get_params();
  const char* Bd = (const char*)(PP->WdT + (size_t)layer * 1024 * LDK5);
  const char* Bp = (const char*)(PP->WpT + (size_t)layer * 1024 * LDK5);
  const char* Ad = (const char*)PP->ydn;
  const char* Ap = (const char*)PP->ypool;
  const int tid = TID();
  const int l = tid & 63, w = tid >> 6, wm = w >> 1, wn = w & 1, lr = l & 15, lg = l >> 4;
  uint4 ga[4], gb[4];
#pragma unroll
  for (int i = 0; i < 4; ++i) { ga[i] = make_uint4(0u, 0u, 0u, 0u); gb[i] = ga[i]; }
  const int r0 = tid >> 3, c0 = tid & 7;
#define MG_GLOAD(AP, BP, KT_)                                                                  \
  _Pragma("unroll") for (int i = 0; i < 4; ++i) {                                              \
    ga[i] = *(const uint4*)((AP) + (size_t)(m0 + 32 * i + r0) * (LDK5 * 2) + c0 * 16 + (KT_) * 128);  \
    gb[i] = *(const uint4*)((BP) + (size_t)(n0 + 32 * i + r0) * LDK5 + c0 * 16 + (KT_) * 128);        \
  }
#define MG_LSTORE(BUF)                                                                         \
  {                                                                                            \
    char* as_ = smem + (BUF) * 32768;                                                          \
    char* bs_ = as_ + 16384;                                                                   \
    _Pragma("unroll") for (int i = 0; i < 4; ++i) {                                            \
      const int id = tid + 256 * i, row = id >> 3, c = id & 7;                                 \
      const int off = row * 128 + ((c ^ (row & 7)) << 4);                                      \
      *(uint4*)(as_ + off) = ga[i];                                                            \
      *(uint4*)(bs_ + off) = gb[i];                                                            \
    }                                                                                          \
  }
#define MG_COMPUTE(ACC, BUF)                                                                                              \
  {                                                                                                                       \
    const char* as_ = smem + (BUF) * 32768;                                                                               \
    const char* bs_ = as_ + 16384;                                                                                        \
    i32x8 a[4], b[4];                                                                                                     \
    const int sw0 = ((lg ^ (lr & 7)) << 4), sw1 = (((4 + lg) ^ (lr & 7)) << 4);                                           \
    _Pragma("unroll") for (int mi = 0; mi < 4; ++mi) {                                                                    \
      const char* p_ = as_ + (wm * 64 + mi * 16 + lr) * 128;                                                              \
      const i32x4 lo_ = *(const i32x4*)(p_ + sw0), hi_ = *(const i32x4*)(p_ + sw1);                                       \
      a[mi] = __builtin_shufflevector(lo_, hi_, 0, 1, 2, 3, 4, 5, 6, 7);                                                  \
    }                                                                                                                     \
    _Pragma("unroll") for (int ni = 0; ni < 4; ++ni) {                                                                    \
      const char* p_ = bs_ + (wn * 64 + ni * 16 + lr) * 128;                                                              \
      const i32x4 lo_ = *(const i32x4*)(p_ + sw0), hi_ = *(const i32x4*)(p_ + sw1);                                       \
      b[ni] = __builtin_shufflevector(lo_, hi_, 0, 1, 2, 3, 4, 5, 6, 7);                                                  \
    }                                                                                                                     \
    _Pragma("unroll") for (int mi = 0; mi < 4; ++mi)                                                                      \
      _Pragma("unroll") for (int ni = 0; ni < 4; ++ni)                                                                    \
        ACC[mi][ni] = __builtin_amdgcn_mfma_scale_f32_16x16x128_f8f6f4(a[mi], b[ni], ACC[mi][ni], 0, 0, 0, 0, 0, 0);      \
  }
  const int MT = (layer == DEPTH - 1) ? NLAT / 128 : R / 128;
  for (int it = 0;; ++it) {
    int mt, nt;
    if (!tile_map(it, MT, 8, mt, nt)) break;
    const int m0 = mt * 128, n0 = nt * 128;
    f32x4 acc[4][4];
    zero_acc(acc);
    __syncthreads();
    MG_GLOAD(Ad, Bd, 0);
    MG_LSTORE(0);
    __syncthreads();
#pragma unroll
    for (int kt = 0; kt < 4; ++kt) {
      if (kt + 1 < 4) { MG_GLOAD(Ad, Bd, kt + 1); } else { MG_GLOAD(Ap, Bp, 0); }
      MG_COMPUTE(acc, kt & 1);
      MG_LSTORE((kt + 1) & 1);
      __syncthreads();
    }
    uint2 tq[2][8];
#pragma unroll
    for (int hs = 0; hs < 2; ++hs)
#pragma unroll
      for (int j = 0; j < 8; ++j) tq[hs][j] = make_uint2(0u, 0u);
#pragma unroll
    for (int hs = 0; hs < 2; ++hs) {
      float4 v1[8];
      stage_half(acc, hs, smem + 32768, v1);
#pragma unroll
      for (int j = 0; j < 8; ++j) tq[hs][j] = make_uint2(pack_bf16(v1[j].x, v1[j].y), pack_bf16(v1[j].z, v1[j].w));
    }
    __builtin_amdgcn_sched_barrier(0);
    zero_acc(acc);
    __syncthreads();
#pragma unroll
    for (int kt = 0; kt < 4; ++kt) {
      if (kt + 1 < 4) { MG_GLOAD(Ap, Bp, kt + 1); }
      MG_COMPUTE(acc, kt & 1);
      if (kt + 1 < 4) { MG_LSTORE((kt + 1) & 1); }
      __syncthreads();
    }
#pragma unroll
    for (int hs = 0; hs < 2; ++hs) {
      float4 v2[8];
      stage_half(acc, hs, smem, v2);
      const int tid2 = TID();
#pragma unroll
      for (int j = 0; j < 8; ++j) {
        const int idx = tid2 + 256 * j, row = idx >> 5, c4 = idx & 31;
        const size_t gr = (size_t)(m0 + hs * 64 + row);
        const int gc = n0 + c4 * 4;
        const unsigned gd = *(const unsigned*)((const unsigned char*)PP->sgd + gr * 1024 + gc);
        const unsigned gp = *(const unsigned*)((const unsigned char*)PP->sgp + gr * 1024 + gc);
        const uint2 t = tq[hs][j];
        constexpr float GS = 1.f / (255.f * 32.f);
        const float o0 = ((float)(gd & 0xffu) * bf_lo(t.x) + (float)(gp & 0xffu) * v2[j].x) * GS;
        const float o1 = ((float)((gd >> 8) & 0xffu) * bf_hi(t.x) + (float)((gp >> 8) & 0xffu) * v2[j].y) * GS;
        const float o2 = ((float)((gd >> 16) & 0xffu) * bf_lo(t.y) + (float)((gp >> 16) & 0xffu) * v2[j].z) * GS;
        const float o3 = ((float)(gd >> 24) * bf_hi(t.y) + (float)(gp >> 24) * v2[j].w) * GS;
        int pk = __builtin_amdgcn_cvt_pk_fp8_f32(o0, o1, 0, false);
        pk = __builtin_amdgcn_cvt_pk_fp8_f32(o2, o3, pk, true);
        *(int*)((char*)PP->m + gr * (LDK1 * 2) + gc) = pk;
        if ((j & 1) == 1) __builtin_amdgcn_sched_barrier(0);
      }
    }
  }
#undef MG_GLOAD
#undef MG_LSTORE
#undef MG_COMPUTE
}

__device__ __forceinline__ void phase_outproj(int layer, char* smem) {
  const KP PP = get_params();
  const char* Bt = (const char*)(PP->WoT + (size_t)layer * 1024 * LDK1);
  const char* A = (const char*)PP->m;
  F8_LOCALS
  const int MT = (layer == DEPTH - 1) ? NLAT / 128 : R / 128;
  int it = 0, mt, nt;
  if (!tile_map(it, MT, 8, mt, nt)) return;
  int m0 = mt * 128, n0 = nt * 128;
  F8_PROLOGUE(A, LDK1 * 2, Bt, LDK1)
  for (;;) {
    int mtn = 0, ntn = 0;
    const bool hasn = tile_map(it + 1, MT, 8, mtn, ntn);
    const int m0n = mtn * 128, n0n = ntn * 128;
    f32x4 acc[4][4];
    zero_acc(acc);
    F8_KLOOP(A, LDK1 * 2, Bt, LDK1, 8)
#pragma unroll
    for (int mi = 0; mi < 4; ++mi) {
      const int gr = m0 + wm * 64 + mi * 16 + lr;
      const float* modp = PP->mod + (size_t)(layer * 3 + modsel(gr)) * 6144 + 2048;
      const float* xin;
      float* xo;
      if (gr < NLAT) {
        xin = (layer == 0 ? PP->x : PP->out) + (size_t)gr * 1024;
        xo = PP->out + (size_t)gr * 1024;
      } else {
        xin = (layer == 0 ? PP->ctx : PP->xc) + (size_t)(gr - NLAT) * 1024;
        xo = PP->xc + (size_t)(gr - NLAT) * 1024;
      }
#pragma unroll
      for (int g = 0; g < 2; ++g) {
        const int gc = n0 + wn * 64 + g * 32 + 8 * lg;
#pragma unroll
        for (int n = 0; n < 2; ++n) {
          const f32x4 t = acc[mi][2 * g + n] * (1.f / 32.f);
          const float4 gt = *(const float4*)(modp + gc + 4 * n);
          const float4 xi = *(const float4*)(xin + gc + 4 * n);
          *(float4*)(xo + gc + 4 * n) = make_float4(xi.x + gt.x * t[0], xi.y + gt.y * t[1], xi.z + gt.z * t[2], xi.w + gt.w * t[3]);
        }
      }
    }
    if (!hasn) break;
    m0 = m0n; n0 = n0n; ++it;
  }
}

DEV void gemm_mainloop_f8(const char* __restrict__ A, int lda, const char* __restrict__ B, int ldb, int KT, int m0, int n0,
                          char* smem, f32x4 (&acc)[4][4]) {
  const int tid = TID();
  const int l = tid & 63, w = tid >> 6, wm = w >> 1, wn = w & 1, lr = l & 15, lg = l >> 4;
  uint4 ga0[4], gb0[4], ga1[4], gb1[4];
#pragma unroll
  for (int i = 0; i < 4; ++i) { ga0[i] = make_uint4(0u, 0u, 0u, 0u); gb0[i] = ga0[i]; ga1[i] = ga0[i]; gb1[i] = ga0[i]; }
  const int r0 = tid >> 3, c0 = tid & 7;
#define Q8_GLOAD(GA, GB, KT_)                                                                  \
  _Pragma("unroll") for (int i = 0; i < 4; ++i) {                                              \
    GA[i] = *(const uint4*)(A + (size_t)(m0 + 32 * i + r0) * lda + c0 * 16 + (KT_) * 128);     \
    GB[i] = *(const uint4*)(B + (size_t)(n0 + 32 * i + r0) * ldb + c0 * 16 + (KT_) * 128);     \
  }
#define Q8_LSTORE(GA, GB, BUF)                                                                 \
  {                                                                                            \
    char* as_ = smem + (BUF) * 32768;                                                          \
    char* bs_ = as_ + 16384;                                                                   \
    _Pragma("unroll") for (int i = 0; i < 4; ++i) {                                            \
      const int id = tid + 256 * i, row = id >> 3, c = id & 7;                                 \
      const int off = row * 128 + ((c ^ (row & 7)) << 4);                                      \
      *(uint4*)(as_ + off) = GA[i];                                                            \
      *(uint4*)(bs_ + off) = GB[i];                                                            \
    }                                                                                          \
  }
#define Q8_COMPUTE(BUF)                                                                                                   \
  {                                                                                                                       \
    const char* as_ = smem + (BUF) * 32768;                                                                               \
    const char* bs_ = as_ + 16384;                                                                                        \
    i32x8 a[4], b[4];                                                                                                     \
    const int sw0 = ((lg ^ (lr & 7)) << 4), sw1 = (((4 + lg) ^ (lr & 7)) << 4);                                           \
    _Pragma("unroll") for (int mi = 0; mi < 4; ++mi) {                                                                    \
      const char* p_ = as_ + (wm * 64 + mi * 16 + lr) * 128;                                                              \
      const i32x4 lo_ = *(const i32x4*)(p_ + sw0), hi_ = *(const i32x4*)(p_ + sw1);                                       \
      a[mi] = __builtin_shufflevector(lo_, hi_, 0, 1, 2, 3, 4, 5, 6, 7);                                                  \
    }                                                                                                                     \
    _Pragma("unroll") for (int ni = 0; ni < 4; ++ni) {                                                                    \
      const char* p_ = bs_ + (wn * 64 + ni * 16 + lr) * 128;                                                              \
      const i32x4 lo_ = *(const i32x4*)(p_ + sw0), hi_ = *(const i32x4*)(p_ + sw1);                                       \
      b[ni] = __builtin_shufflevector(lo_, hi_, 0, 1, 2, 3, 4, 5, 6, 7);                                                  \
    }                                                                                                                     \
    _Pragma("unroll") for (int mi = 0; mi < 4; ++mi)                                                                      \
      _Pragma("unroll") for (int ni = 0; ni < 4; ++ni)                                                                    \
        acc[mi][ni] = __builtin_amdgcn_mfma_scale_f32_16x16x128_f8f6f4(a[mi], b[ni], acc[mi][ni], 0, 0, 0, 0, 0, 0);      \
  }
  __syncthreads();
  Q8_GLOAD(ga0, gb0, 0);
  Q8_GLOAD(ga1, gb1, 1);
  Q8_LSTORE(ga0, gb0, 0);
  __syncthreads();
  for (int kt = 0; kt < KT; kt += 2) {
    if (kt + 2 < KT) { Q8_GLOAD(ga0, gb0, kt + 2); }
    Q8_COMPUTE(0);
    Q8_LSTORE(ga1, gb1, 1);
    __syncthreads();
    if (kt + 3 < KT) { Q8_GLOAD(ga1, gb1, kt + 3); }
    Q8_COMPUTE(1);
    if (kt + 2 < KT) { Q8_LSTORE(ga0, gb0, 0); }
    __syncthreads();
  }
#undef Q8_GLOAD
#undef Q8_LSTORE
#undef Q8_COMPUTE
}

__device__ __forceinline__ void phase_peerq(int layer, char* smem) {
  const KP PP = get_params();
  const char* Bt = (const char*)PP->WkT + (size_t)layer * 2048 * LDK1;
  const int tid = TID();
  const int l = tid & 63, w = tid >> 6, wm = w >> 1, wn = w & 1, lr = l & 15, lg = l >> 4;
  const int MT = (layer == DEPTH - 1) ? NLAT / 128 : R / 128;
  for (int it = 0;; ++it) {
    int mt, nt;
    if (!tile_map(it, MT, 16, mt, nt)) break;
    const int m0 = mt * 128, n0 = nt * 128;
    f32x4 sc[4][4];
    zero_acc(sc);
    gemm_mainloop_f8((const char*)PP->h8, LDK1, Bt, LDK1, 8, m0, n0, smem, sc);
    __syncthreads();
    float* Sc = (float*)smem;
#pragma unroll
    for (int mi = 0; mi < 4; ++mi)
#pragma unroll
      for (int ni = 0; ni < 4; ++ni)
#pragma unroll
        for (int r = 0; r < 4; ++r) Sc[(wm * 64 + mi * 16 + lg * 4 + r) * 129 + wn * 64 + ni * 16 + lr] = sc[mi][ni][r] * (1.f / 32.f);
    __syncthreads();
    {
      const int row = tid >> 1, half = tid & 1;
      const float* rowp = Sc + row * 129;
      unsigned key[64];
#pragma unroll
      for (int i = 0; i < 64; ++i) {
        unsigned u = __float_as_uint(rowp[half * 64 + i]);
        u = (u & 0x80000000u) ? ~u : (u | 0x80000000u);
        key[i] = (u & ~127u) | (unsigned)(127 - (half * 64 + i));
      }
#define CMPX(X, Y, DESC) { const unsigned hi_ = (X) > (Y) ? (X) : (Y), lo_ = (X) > (Y) ? (Y) : (X); X = (DESC) ? hi_ : lo_; Y = (DESC) ? lo_ : hi_; }
#pragma unroll
      for (int g0 = 0; g0 < 64; g0 += 16) {
#pragma unroll
        for (int k = 2; k <= 16; k <<= 1)
#pragma unroll
          for (int j = k >> 1; j > 0; j >>= 1)
#pragma unroll
            for (int i = 0; i < 16; ++i) {
              const int l2 = i ^ j;
              if (l2 > i) CMPX(key[g0 + i], key[g0 + l2], ((i & k) == 0));
            }
      }
#define TOPMERGE(AOFF, BOFF)                                                                         \
  {                                                                                                  \
    _Pragma("unroll") for (int i = 0; i < 16; ++i)                                                   \
      key[(AOFF) + i] = key[(AOFF) + i] > key[(BOFF) + 15 - i] ? key[(AOFF) + i] : key[(BOFF) + 15 - i]; \
    _Pragma("unroll") for (int j = 8; j > 0; j >>= 1)                                                \
      _Pragma("unroll") for (int i = 0; i < 16; ++i) {                                               \
        const int l2 = i ^ j;                                                                        \
        if (l2 > i) CMPX(key[(AOFF) + i], key[(AOFF) + l2], true);                                   \
      }                                                                                              \
  }
      TOPMERGE(0, 16);
      TOPMERGE(32, 48);
      TOPMERGE(0, 32);
      {
        unsigned oth[16];
#pragma unroll
        for (int i = 0; i < 16; ++i) oth[i] = swz_xor_u<1>(key[i]);
#pragma unroll
        for (int i = 0; i < 16; ++i) key[i] = key[i] > oth[15 - i] ? key[i] : oth[15 - i];
#pragma unroll
        for (int j = 8; j > 0; j >>= 1)
#pragma unroll
          for (int i = 0; i < 16; ++i) {
            const int l2 = i ^ j;
            if (l2 > i) CMPX(key[i], key[l2], true);
          }
      }
#undef TOPMERGE
#undef CMPX
      unsigned res[16];
#pragma unroll
      for (int j = 0; j < 16; ++j) {
        const int idx = 127 - (int)(key[j] & 127u);
        res[j] = half ? (unsigned)idx : __float_as_uint(rowp[idx]);
      }
      const size_t ob = ((size_t)(m0 + row) * 16 + nt) * 16;
      uint4* dst = half ? (uint4*)(PP->topI + ob) : (uint4*)(PP->topS + ob);
      dst[0] = make_uint4(res[0], res[1], res[2], res[3]);
      dst[1] = make_uint4(res[4], res[5], res[6], res[7]);
      dst[2] = make_uint4(res[8], res[9], res[10], res[11]);
      dst[3] = make_uint4(res[12], res[13], res[14], res[15]);
    }
  }
}

DEV void pair_of_lane(int l, int& a, int& b) {
  if (l < 16) { a = 0; b = l; }
  else if (l < 24) { a = 1; b = l - 16; }
  else if (l < 29) { a = 2; b = l - 24; }
  else if (l < 33) { a = 3; b = l - 29; }
  else if (l < 36) { a = 4; b = l - 33; }
  else if (l < 38) { a = 5; b = l - 36; }
  else if (l < 40) { a = 6; b = l - 38; }
  else if (l < 42) { a = 7; b = l - 40; }
  else if (l < 50) { a = l - 34; b = 0; }
  else { a = 0; b = 0; }
}

DEV float peer_butterfly(const float (&part)[8], int lane) {
  const bool h32 = (lane & 32) != 0, h16 = (lane & 16) != 0, h8 = (lane & 8) != 0;
  const int a32 = (lane ^ 32) << 2;
  float q4[4], q2[2];
#pragma unroll
  for (int i = 0; i < 4; ++i) {
    const float keep = h32 ? part[i + 4] : part[i], send = h32 ? part[i] : part[i + 4];
    q4[i] = keep + __builtin_bit_cast(float, __builtin_amdgcn_ds_bpermute(a32, __builtin_bit_cast(int, send)));
  }
#pragma unroll
  for (int i = 0; i < 2; ++i) {
    const float keep = h16 ? q4[i + 2] : q4[i], send = h16 ? q4[i] : q4[i + 2];
    q2[i] = keep + swz_xor<16>(send);
  }
  const float keep = h8 ? q2[1] : q2[0], send = h8 ? q2[0] : q2[1];
  float q1 = keep + swz_xor<8>(send);
  q1 += swz_xor<4>(q1);
  q1 += swz_xor<2>(q1);
  q1 += swz_xor<1>(q1);
  return q1;
}

__device__ __forceinline__ void phase_peer(int layer, char* smem) {
  const KP PP = get_params();
  const int tid = TID(), lane = tid & 63, wv = tid >> 6;
  const int gw = BID() * 4 + wv, nw = gridDim.x * 4;
  int* elist = (int*)(smem + wv * 2048);
  float* glist = (float*)(elist + 128);
  const bool last = (layer == DEPTH - 1);
  const int rlim = last ? NLAT : R;
  int pa, pb;
  pair_of_lane(lane, pa, pb);
  for (int r = gw; r < rlim; r += nw) {
    f32x2 hp[8];
#pragma unroll
    for (int i = 0; i < 4; ++i) {
      const uint2 hv = *(const uint2*)(PP->h + (size_t)r * LDK1 + 4 * lane + 256 * i);
      hp[2 * i] = (f32x2){bf_lo(hv.x), bf_hi(hv.x)};
      hp[2 * i + 1] = (f32x2){bf_lo(hv.y), bf_hi(hv.y)};
    }
#ifndef PEER_REP
#define PEER_REP 1
#endif
    f32x2 out[8];
#pragma unroll
    for (int i = 0; i < 8; ++i) out[i] = (f32x2){0.f, 0.f};
#pragma nounroll
    for (int rep_ = 0; rep_ < PEER_REP; ++rep_) {
    float sreg[8];
    int ireg[8];
#pragma unroll
    for (int hh = 0; hh < 8; ++hh) {
      const size_t o = (size_t)r * 256 + hh * 32 + (lane & 31);
      sreg[hh] = PP->topS[o];
      ireg[hh] = PP->topI[o];
    }
#pragma unroll 2
    for (int hh = 0; hh < 8; ++hh) {
      float cs = __builtin_bit_cast(float, __builtin_amdgcn_ds_bpermute(pa << 2, __builtin_bit_cast(int, sreg[hh]))) +
                 __builtin_bit_cast(float, __builtin_amdgcn_ds_bpermute((16 + pb) << 2, __builtin_bit_cast(int, sreg[hh])));
      const int e = __builtin_amdgcn_ds_bpermute(pa << 2, ireg[hh]) * 128 + __builtin_amdgcn_ds_bpermute((16 + pb) << 2, ireg[hh]);
      if (lane >= 50) cs = -__builtin_inff();
      unsigned ku = __float_as_uint(cs);
      ku = (ku & 0x80000000u) ? ~ku : (ku | 0x80000000u);
      ku = (ku & ~63u) | (unsigned)(63 - lane);
      int rank = 0;
#pragma unroll
      for (int l2 = 0; l2 < 50; ++l2) {
        const unsigned kv = (unsigned)__builtin_amdgcn_readlane((int)ku, l2);
        rank += (kv > ku) ? 1 : 0;
      }
      const bool sel = (lane < 50) && (rank < 16);
      const float mx = __builtin_bit_cast(float, __builtin_amdgcn_readlane(__builtin_bit_cast(int, cs), 0));
      const float ex = sel ? __expf(cs - mx) : 0.f;
      const float sum = wave_sum(ex);
      const unsigned long long mask = __ballot(sel);
      if (sel) {
        const int pos = __builtin_popcountll(mask & ((1ull << lane) - 1ull));
        elist[hh * 16 + pos] = e;
        glist[hh * 16 + pos] = ex / sum;
      }
    }
    __builtin_amdgcn_wave_barrier();
    asm volatile("s_waitcnt lgkmcnt(0)" ::: "memory");
    for (int k0 = 0; k0 < 128; k0 += 8) {
      U3 ua[8], va[8];
#pragma unroll
      for (int b = 0; b < 8; ++b) {
        const int ek = __builtin_amdgcn_readfirstlane(elist[k0 + b]);
        ua[b] = *(const U3*)(PP->tab8U + (size_t)ek * TROW + lane * 12);
        va[b] = *(const U3*)(PP->tab8V + (size_t)ek * TROW + lane * 12);
      }
      const int eb = elist[k0 + (lane >> 3)];
      const float scu = PP->scU[eb], scv = PP->scV[eb];
      float part[8];
#pragma unroll
      for (int b = 0; b < 8; b += 2) {
        const u32x6_t s6 = {ua[b].a, ua[b].b, ua[b].c, ua[b + 1].a, ua[b + 1].b, ua[b + 1].c};
        const f32x32_t uf = __builtin_amdgcn_cvt_scalef32_pk32_f32_fp6(s6, 1.0f);
        f32x2 d0 = (f32x2){uf[0], uf[1]} * hp[0];
        f32x2 d1 = (f32x2){uf[16], uf[17]} * hp[0];
#pragma unroll
        for (int p = 1; p < 8; ++p) {
          d0 += (f32x2){uf[2 * p], uf[2 * p + 1]} * hp[p];
          d1 += (f32x2){uf[16 + 2 * p], uf[17 + 2 * p]} * hp[p];
        }
        part[b] = d0[0] + d0[1];
        part[b + 1] = d1[0] + d1[1];
      }
      float q1 = peer_butterfly(part, lane);
      q1 *= scu;
      const float act = scv * glist[k0 + (lane >> 3)] * 0.5f * q1 * (1.f + erff(q1 * 0.7071067811865475f));
#pragma unroll
      for (int b = 0; b < 8; b += 2) {
        const float ab0 = __builtin_bit_cast(float, __builtin_amdgcn_readlane(__builtin_bit_cast(int, act), b * 8));
        const float ab1 = __builtin_bit_cast(float, __builtin_amdgcn_readlane(__builtin_bit_cast(int, act), b * 8 + 8));
        const f32x2 a0 = {ab0, ab0}, a1 = {ab1, ab1};
        const u32x6_t s6 = {va[b].a, va[b].b, va[b].c, va[b + 1].a, va[b + 1].b, va[b + 1].c};
        const f32x32_t vf = __builtin_amdgcn_cvt_scalef32_pk32_f32_fp6(s6, 1.0f);
#pragma unroll
        for (int p = 0; p < 8; ++p) {
          out[p] += a0 * (f32x2){vf[2 * p], vf[2 * p + 1]};
          out[p] += a1 * (f32x2){vf[16 + 2 * p], vf[17 + 2 * p]};
        }
      }
    }
    __builtin_amdgcn_wave_barrier();
    }
    if (PEER_REP > 1) {
#pragma unroll
      for (int i = 0; i < 8; ++i) out[i] *= (1.f / PEER_REP);
    }
    const float* md = PP->mod + (size_t)(layer * 3 + modsel(r)) * 6144 + 5 * 1024;
    float* xr = (r < NLAT) ? PP->out + (size_t)r * 1024 : PP->xc + (size_t)(r - NLAT) * 1024;
    float4 x2[4];
    float ss = 0.f;
#pragma unroll
    for (int i = 0; i < 4; ++i) {
      const int col = 4 * lane + 256 * i;
      const float4 xa = *(const float4*)(xr + col);
      const float4 ga = *(const float4*)(md + col);
      x2[i] = make_float4(xa.x + ga.x * out[2 * i][0], xa.y + ga.y * out[2 * i][1], xa.z + ga.z * out[2 * i + 1][0],
                          xa.w + ga.w * out[2 * i + 1][1]);
      ss += x2[i].x * x2[i].x + x2[i].y * x2[i].y + x2[i].z * x2[i].z + x2[i].w * x2[i].w;
    }
    if (last) {
      ss = wave_sum(ss);
      const float rs = rsqrtf(ss * (1.f / 1024.f) + EPS);
#pragma unroll
      for (int i = 0; i < 4; ++i) {
        const float4 fa = *(const float4*)(PP->final_norm + 4 * lane + 256 * i);
        x2[i] = make_float4(x2[i].x * rs * fa.x, x2[i].y * rs * fa.y, x2[i].z * rs * fa.z, x2[i].w * rs * fa.w);
      }
    }
#pragma unroll
    for (int i = 0; i < 4; ++i) *(float4*)(xr + 4 * lane + 256 * i) = x2[i];
    if (!last) {
      ss = wave_sum(ss);
      const float rs = rsqrtf(ss * (1.f / 1024.f) + EPS);
      const float* nwt = PP->norm_mix + (layer + 1) * 1024;
      const float* md1 = PP->mod + (size_t)((layer + 1) * 3 + modsel(r)) * 6144;
#pragma unroll
      for (int i = 0; i < 4; ++i) {
        const int col = 4 * lane + 256 * i;
        const float4 wv = *(const float4*)(nwt + col);
        const float4 sh = *(const float4*)(md1 + col);
        const float4 sc = *(const float4*)(md1 + 1024 + col);
        const float y0 = x2[i].x * rs * wv.x * (1.f + sc.x) + sh.x;
        const float y1 = x2[i].y * rs * wv.y * (1.f + sc.y) + sh.y;
        const float y2 = x2[i].z * rs * wv.z * (1.f + sc.z) + sh.z;
        const float y3 = x2[i].w * rs * wv.w * (1.f + sc.w) + sh.w;
        int pk = __builtin_amdgcn_cvt_pk_fp8_f32(y0, y1, 0, false);
        pk = __builtin_amdgcn_cvt_pk_fp8_f32(y2, y3, pk, true);
        *(int*)((char*)PP->h + (size_t)r * (LDK1 * 2) + col) = pk;
      }
    }
  }
}

namespace cg = cooperative_groups;

#define XB_TMO      128
#define XB_XCNT(j)  (256  + 64 * (j))
#define XB_XSUB(j)  (1280 + 64 * (j))
#define XB_XGEN(j)  (2304 + 64 * (j))
#define XB_TOP      3328
#define XB_TOPGEN   3392
#define XCD_BAR_WORDS 3456
#define XB_SPIN_CAP (1u << 22)
#define LAS __attribute__((address_space(3)))
DEV unsigned xb_ld(unsigned* q) { return __hip_atomic_load(q, __ATOMIC_RELAXED, __HIP_MEMORY_SCOPE_AGENT); }
DEV unsigned xb_add(unsigned* q, unsigned v) { return __hip_atomic_fetch_add(q, v, __ATOMIC_RELAXED, __HIP_MEMORY_SCOPE_AGENT); }
DEV unsigned xb_xcc_id() { return (unsigned)__builtin_amdgcn_s_getreg((3 << 11) | 20) & 0xFu; }
#define XB_SPIN(cond, bar) do { unsigned _sp = 0; while (cond) { __builtin_amdgcn_s_sleep(1); \
    if ((++_sp & 255u) == 0u) { if (xb_ld(&(bar)[XB_TMO])) break; if (_sp > XB_SPIN_CAP) { atomicAdd(&(bar)[XB_TMO], 1u); break; } } } } while (0)
struct XcdBarrier { unsigned* bar; unsigned x; volatile LAS unsigned* st; };
DEV XcdBarrier xcd_barrier_post(unsigned* bar, volatile LAS unsigned* st) {
  XcdBarrier b; b.bar = bar; b.x = xb_xcc_id(); b.st = st;
  if (__builtin_amdgcn_workitem_id_x() == 0) (void)xb_add(&bar[XB_XCNT(b.x)], 1u);
  return b;
}
DEV void xcd_barrier_complete(unsigned* bar, unsigned x, unsigned& nloc, unsigned& nx) {
  const unsigned G = gridDim.x * gridDim.y * gridDim.z;
  unsigned sum, cnt, mine, sp = 0u;
  for (;;) {
    sum = 0u; cnt = 0u; mine = 0u;
#pragma unroll
    for (unsigned j = 0; j < 16; ++j) { const unsigned c = xb_ld(&bar[XB_XCNT(j)]); sum += c; cnt += (c > 0u) ? 1u : 0u; mine = (j == x) ? c : mine; }
    if (sum == G) break;
    __builtin_amdgcn_s_sleep(1);
    if ((++sp & 255u) == 0u) { if (xb_ld(&bar[XB_TMO])) break; if (sp > XB_SPIN_CAP) { atomicAdd(&bar[XB_TMO], 1u); break; } }
  }
  nloc = mine > 0u ? mine : 1u; nx = cnt > 0u ? cnt : 1u;
}
DEV void xcd_barrier(const XcdBarrier& b) {
  asm volatile("s_waitcnt vmcnt(0)" ::: "memory");
  __syncthreads();
  if (__builtin_amdgcn_workitem_id_x() == 0) {
    unsigned* bar = b.bar;
    __builtin_amdgcn_s_waitcnt(0);
    unsigned nloc = b.st[0], nx = b.st[1];
    if (nloc == 0u) { xcd_barrier_complete(bar, b.x, nloc, nx); b.st[0] = nloc; b.st[1] = nx; }
    const unsigned old = xb_add(&bar[XB_XSUB(b.x)], 1u);
    const unsigned gen = old / nloc;
    if (old + 1u == (gen + 1u) * nloc) {
      __builtin_amdgcn_fence(__ATOMIC_RELEASE, "agent");
      asm volatile("s_waitcnt vmcnt(0)" ::: "memory");
      const unsigned og = xb_add(&bar[XB_TOP], 1u);
      const unsigned tg = og / nx;
      if (og + 1u == (tg + 1u) * nx) xb_add(&bar[XB_TOPGEN], 1u);
      else XB_SPIN(xb_ld(&bar[XB_TOPGEN]) == tg, bar);
      __builtin_amdgcn_fence(__ATOMIC_ACQUIRE, "agent");
      xb_add(&bar[XB_XGEN(b.x)], 1u);
      asm volatile("s_waitcnt vmcnt(0)" ::: "memory");
    } else {
      XB_SPIN(xb_ld(&bar[XB_XGEN(b.x)]) == gen, bar);
      __builtin_amdgcn_fence(__ATOMIC_ACQUIRE, "agent");
      asm volatile("s_waitcnt vmcnt(0)" ::: "memory");
    }
  }
  __syncthreads();
}

#define GRID_SYNC() do { XcdBarrier xb_; xb_.bar = get_params()->bar; xb_.x = xb_xcc_id(); xb_.st = (volatile LAS unsigned*)&xb_words; xcd_barrier(xb_); } while (0)

__global__ void __launch_bounds__(NTHR, 2) megakernel(Params p) {
  __shared__ __attribute__((aligned(16))) char smem[SMEM_BYTES];
  __shared__ uint4 xb_words;
  if (__builtin_amdgcn_workitem_id_x() == 0) xb_words = make_uint4(0u, 0u, 0u, 0u);
  __syncthreads();
  (void)xcd_barrier_post(get_params()->bar, (volatile LAS unsigned*)&xb_words);
#ifndef PM
#define PM 0xFFFF
#endif
#ifndef DUP
#define DUP 0
#endif
  if (PM & 1) phase_init(smem);
  if (DUP & 1) phase_init(smem);
  GRID_SYNC();
  for (int layer = 0; layer < DEPTH; ++layer) {
    if (layer == 0) {
      if (PM & 2) phase_norm(layer, 1);
      if (DUP & 2) phase_norm(layer, 1);
      GRID_SYNC();
    }
    if (PM & 4) phase_gemm_win(layer, smem);
    if (DUP & 4) phase_gemm_win(layer, smem);
    GRID_SYNC();
#ifndef PREP_REP
#define PREP_REP 1
#endif
#pragma nounroll
    for (int rep_ = 0; rep_ < PREP_REP; ++rep_) phase_prep(layer, smem);
    GRID_SYNC();
    {
      const int nb_ = gridDim.x;
      if (BID() < 128) { if (PM & 64) phase_scan(smem); }
      else {
        if (PM & 16) phase_pool(layer, smem, BID() - 128, nb_ - 128);
        if (PM & 256) phase_tables(layer, BID() - 128, nb_ - 128);
      }
    }
    GRID_SYNC();
    if (PM & 128) phase_o(layer, smem);
    if (DUP & 128) phase_o(layer, smem);
    GRID_SYNC();
    if (PM & 512) phase_merge(layer, smem);
    if (DUP & 512) phase_merge(layer, smem);
    GRID_SYNC();
    if (PM & 1024) phase_outproj(layer, smem);
    GRID_SYNC();
    if (PM & 2048) phase_norm(layer, 2);
    if (DUP & 2048) phase_norm(layer, 2);
    GRID_SYNC();
    if (PM & 4096) phase_peerq(layer, smem);
    if (DUP & 4096) phase_peerq(layer, smem);
    GRID_SYNC();
    if (PM & 8192) phase_peer(layer, smem);
    if (layer + 1 < DEPTH) GRID_SYNC();
  }
}

static inline size_t align_up(size_t v, size_t a) { return (v + a - 1) / a * a; }

extern "C" void kernel_launch(void* const* d_in, const int* in_sizes, int n_in, void* d_out, int out_size, void* d_ws,
                              size_t ws_size, hipStream_t stream) {
  Params p{};
  p.x = (const float*)d_in[0]; p.c = (const float*)d_in[1]; p.ctx = (const float*)d_in[2]; p.c_ctx = (const float*)d_in[3];
  p.w_mod = (const float*)d_in[4]; p.b_mod = (const float*)d_in[5]; p.norm_mix = (const float*)d_in[6]; p.w_in = (const float*)d_in[7];
  p.conv_w = (const float*)d_in[8]; p.a_log = (const float*)d_in[9]; p.dt_bias = (const float*)d_in[10];
  p.dn_out_norm = (const float*)d_in[11]; p.pool_w = (const float*)d_in[12]; p.pool_scale = (const float*)d_in[13];
  p.w_up_dn = (const float*)d_in[14]; p.w_up_pool = (const float*)d_in[15]; p.w_out = (const float*)d_in[16];
  p.norm_ffn = (const float*)d_in[17]; p.peer_wq = (const float*)d_in[18]; p.peer_keys = (const float*)d_in[19];
  p.peer_u = (const float*)d_in[20]; p.peer_v = (const float*)d_in[21]; p.final_norm = (const float*)d_in[22];
  p.out = (float*)d_out;

  char* ws = (char*)d_ws;
  size_t off = 0;
  auto take = [&](size_t bytes) { char* q = ws + off; off = align_up(off + bytes, 256); return q; };
  p.tab8U = (unsigned char*)take((size_t)NEXP * 1024);
  p.tab8V = (unsigned char*)take((size_t)NEXP * 1024);
  p.scU = (float*)take((size_t)NEXP * 4);
  p.scV = (float*)take((size_t)NEXP * 4);
  p.WinT = (u16*)take((size_t)DEPTH * NPAD * LDK1 * 2);
  p.WdT = (u16*)take((size_t)DEPTH * 1024 * LDK5 * 2);
  p.WpT = (u16*)take((size_t)DEPTH * 1024 * LDK5 * 2);
  p.WoT = (u16*)take((size_t)DEPTH * 1024 * LDK1 * 2);
  p.WkT = (u16*)take((size_t)DEPTH * 2048 * LDK1 * 2);
  p.PwT = (u16*)take((size_t)DEPTH * 4 * 128 * 128 * 2);
  p.mod = (float*)take((size_t)DEPTH * 3 * 6144 * 4);
  p.xc = (float*)take((size_t)NCTX * 1024 * 4);
  p.h = (u16*)take((size_t)R * LDK1 * 2);
  p.h8 = (unsigned char*)take((size_t)R * LDK1);
  p.m = p.h;
  p.qkv_pre = (u16*)take((size_t)R * 1536 * 2);
  p.Vfrag = p.qkv_pre;
  p.z = (u16*)take((size_t)R * 512 * 2);
  p.pin = (u16*)take((size_t)R * 512 * 2);
  p.sgd = (u16*)take((size_t)R * 1024 * 2);
  p.sgp = (u16*)take((size_t)R * 1024 * 2);
  p.ba = (float*)take((size_t)R * 16 * 4);
  p.qkvn = (u16*)take((size_t)R * 1536 * 2);
  p.bg = (float*)take((size_t)R * 16 * 4);
  p.Wfrag = (u16*)take((size_t)NUNIT * 16384);
  p.KdT = (u16*)take((size_t)NUNIT * 16384);
  p.Ufrag = (u16*)take((size_t)NUNIT * 16384);
  p.ydn = p.Ufrag;
  p.Sfrag = (u16*)take((size_t)NUNIT * 32768);
  p.gc = (float*)take((size_t)NUNIT * 64 * 4);
  p.glast = (float*)take((size_t)NUNIT * 4);
  p.ypool = (u16*)take((size_t)R * LDK5 * 2);
  p.bar = (unsigned*)take((size_t)XCD_BAR_WORDS * 4);
  p.topS = (float*)p.qkvn;
  p.topI = (int*)((char*)p.qkvn + (size_t)R * 256 * 4);
  const bool alias_ok = ((size_t)R * 256 * 8 <= (size_t)R * 1536 * 2) && ((size_t)NUNIT * 16384 <= (size_t)R * 1536 * 2) &&
                        ((size_t)R * LDK5 * 2 <= (size_t)NUNIT * 16384);
  if (off > ws_size || !alias_ok) {
    fprintf(stderr, "workspace too small: need %zu have %zu (alias_ok=%d)\n", off, ws_size, (int)alias_ok);
    return;
  }
  static int grid_blocks = 0;
  if (!grid_blocks) {
    int dev = 0, cus = 0, per_cu = 0;
    (void)hipGetDevice(&dev);
    (void)hipDeviceGetAttribute(&cus, hipDeviceAttributeMultiprocessorCount, dev);
    (void)hipOccupancyMaxActiveBlocksPerMultiprocessor(&per_cu, megakernel, NTHR, 0);
    if (per_cu > 2) per_cu = 2;
    if (per_cu < 1) per_cu = 1;
    grid_blocks = cus * per_cu;
    grid_blocks -= grid_blocks % 8;
  }
  if (grid_blocks < 8) { fprintf(stderr, "bad grid %d\n", grid_blocks); return; }
  (void)hipMemsetAsync(p.bar, 0, (size_t)XCD_BAR_WORDS * 4, stream);
  void* args[] = {&p};
  hipError_t e = hipLaunchCooperativeKernel((void*)megakernel, dim3(grid_blocks), dim3(NTHR), args, 0, stream);
  if (e != hipSuccess) fprintf(stderr, "cooperative launch failed: %s (grid %d)\n", hipGetErrorString(e), grid_blocks);
}
```

```cpp
#include <hip/hip_runtime.h>
#include <hip/hip_cooperative_groups.h>
#include <stdint.h>
#include <stdio.h>

typedef unsigned short u16;
typedef __attribute__((ext_vector_type(8))) short bf16x8;
typedef __attribute__((ext_vector_type(4))) float f32x4;
typedef __attribute__((ext_vector_type(2))) float f32x2;
typedef __attribute__((ext_vector_type(2))) __bf16 bf16x2_t;

#define DEV __device__ __forceinline__

constexpr int D = 1024;
constexpr int BATCH = 2;
constexpr int SEQ = 8192;
constexpr int DEPTH = 2;
constexpr int CTX = 256;
constexpr int NLAT = BATCH * SEQ;
constexpr int NCTX = BATCH * CTX;
constexpr int R = NLAT + NCTX;
constexpr int DNH = 4;
constexpr int DK = 128;
constexpr int DNW = 512;
constexpr int INC = 4624;
constexpr int NPAD = 4736;
constexpr int NEXP = 16384;
constexpr float EPS = 1e-6f;
constexpr int NTHR = 256;
constexpr int LDK1 = 1088;
constexpr int LDK5 = 576;
constexpr int SMEM_BYTES = 73728;

struct Params {
  const float *x, *c, *ctx, *c_ctx, *w_mod, *b_mod, *norm_mix, *w_in, *conv_w, *a_log, *dt_bias, *dn_out_norm,
      *pool_w, *pool_scale, *w_up_dn, *w_up_pool, *w_out, *norm_ffn, *peer_wq, *peer_keys, *peer_u, *peer_v, *final_norm;
  float* out;
  unsigned char *tab8U, *tab8V;
  float *scU, *scV;
  u16 *WinT, *WdT, *WpT, *WoT, *WkT, *PwT;
  float *mod, *xc;
  u16 *h, *qkv_pre, *z, *pin, *sgd, *sgp;
  u16* xb;
  unsigned char* h8;
  float* ba;
  u16* qkvn;
  float* bg;
  u16 *Wfrag, *KdT, *Ufrag, *Sfrag, *Vfrag;
  float *gc, *glast;
  u16 *ydn, *ypool, *m;
  float* topS;
  int* topI;
  unsigned* bar;
};

typedef const __attribute__((address_space(4))) Params* KP;
DEV KP get_params() {
  KP k = (KP)__builtin_amdgcn_kernarg_segment_ptr();
  asm volatile("" : "+s"(k));
  return k;
}
DEV int TID() { int t = __builtin_amdgcn_workitem_id_x(); asm volatile("" : "+v"(t)); return t; }
DEV int BID() { int t = __builtin_amdgcn_workgroup_id_x(); asm volatile("" : "+s"(t)); return t; }
DEV unsigned pack_bf16(float a, float b) {
  f32x2 v = {a, b};
  bf16x2_t r = __builtin_convertvector(v, bf16x2_t);
  return *(unsigned*)&r;
}
DEV u16 f2bf(float a) { return (u16)(pack_bf16(a, 0.f) & 0xffffu); }
DEV float bf_lo(unsigned u) { return __uint_as_float(u << 16); }
DEV float bf_hi(unsigned u) { return __uint_as_float(u & 0xffff0000u); }
DEV float bf2f(u16 h) { return __uint_as_float(((unsigned)h) << 16); }
DEV void unpack8(const uint4& v, float* f) {
  f[0] = bf_lo(v.x); f[1] = bf_hi(v.x); f[2] = bf_lo(v.y); f[3] = bf_hi(v.y);
  f[4] = bf_lo(v.z); f[5] = bf_hi(v.z); f[6] = bf_lo(v.w); f[7] = bf_hi(v.w);
}
DEV uint4 pack8(const float* f) {
  uint4 v;
  v.x = pack_bf16(f[0], f[1]); v.y = pack_bf16(f[2], f[3]); v.z = pack_bf16(f[4], f[5]); v.w = pack_bf16(f[6], f[7]);
  return v;
}
typedef unsigned u32x4nt_t __attribute__((ext_vector_type(4)));
#define NT_STORE4(PTR, V) { const uint4 v_ = (V); u32x4nt_t t_ = {v_.x, v_.y, v_.z, v_.w}; __builtin_nontemporal_store(t_, (u32x4nt_t*)(PTR)); }
DEV uint4 nt_load4(const void* p) { const u32x4nt_t t = __builtin_nontemporal_load((const u32x4nt_t*)p); return make_uint4(t[0], t[1], t[2], t[3]); }
template <int O> DEV float swz_xor(float v) {
  return __builtin_bit_cast(float, __builtin_amdgcn_ds_swizzle(__builtin_bit_cast(int, v), (O << 10) | 0x1F));
}
template <int O> DEV unsigned swz_xor_u(unsigned v) {
  return (unsigned)__builtin_amdgcn_ds_swizzle((int)v, (O << 10) | 0x1F);
}
DEV float xor32_f(float v) {
  const int a = ((TID() & 63) ^ 32) << 2;
  return __builtin_bit_cast(float, __builtin_amdgcn_ds_bpermute(a, __builtin_bit_cast(int, v)));
}
DEV float wave_sum(float v) {
  v += xor32_f(v);
  v += swz_xor<16>(v); v += swz_xor<8>(v); v += swz_xor<4>(v); v += swz_xor<2>(v); v += swz_xor<1>(v);
  return v;
}
DEV float wave_max(float v) {
  v = fmaxf(v, xor32_f(v));
  v = fmaxf(v, swz_xor<16>(v)); v = fmaxf(v, swz_xor<8>(v)); v = fmaxf(v, swz_xor<4>(v));
  v = fmaxf(v, swz_xor<2>(v)); v = fmaxf(v, swz_xor<1>(v));
  return v;
}
DEV float group16_sum(float v) {
  v += swz_xor<8>(v); v += swz_xor<4>(v); v += swz_xor<2>(v); v += swz_xor<1>(v);
  return v;
}
DEV float sigmoidf_(float x) { return __builtin_amdgcn_rcpf(1.f + __expf(-x)); }
DEV float siluf_(float x) { return x * __builtin_amdgcn_rcpf(1.f + __expf(-x)); }
DEV int modsel(int r) { return r < NLAT ? (r >> 13) : 2; }

DEV void transpose_tile(const float* __restrict__ src, int Nsrc, int ldd, u16* __restrict__ dst, int kt, int nt, int mode,
                        float* tile) {
  const int tid = TID();
  const int cl = tid & 63, rg = tid >> 6;
  const int nd = nt * 64 + cl;
  int ns = nd;
  bool valid = true;
  if (mode & 1) {
    if (nd < 2560) ns = nd;
    else if (nd < 4608) ns = nd + 16;
    else if (nd < 4624) ns = nd - 4608 + 2560;
    else { valid = false; ns = 0; }
  }
#pragma unroll
  for (int i = 0; i < 16; ++i) {
    const int kr = i * 4 + rg;
    float v = valid ? src[(size_t)(kt * 64 + kr) * Nsrc + ns] : 0.f;
    tile[kr * 65 + cl] = v;
  }
  __syncthreads();
  const int nr = tid >> 2, kc = (tid & 3) * 16;
  if (mode & 2) {
    int q4[4];
#pragma unroll
    for (int q = 0; q < 4; ++q) {
      int pk = __builtin_amdgcn_cvt_pk_fp8_f32(32.f * tile[(kc + 4 * q) * 65 + nr], 32.f * tile[(kc + 4 * q + 1) * 65 + nr], 0, false);
      q4[q] = __builtin_amdgcn_cvt_pk_fp8_f32(32.f * tile[(kc + 4 * q + 2) * 65 + nr], 32.f * tile[(kc + 4 * q + 3) * 65 + nr], pk, true);
    }
    *(int4*)((char*)dst + (size_t)(nt * 64 + nr) * ldd + kt * 64 + kc) = make_int4(q4[0], q4[1], q4[2], q4[3]);
    __syncthreads();
    return;
  }
  unsigned w[8];
#pragma unroll
  for (int q = 0; q < 8; ++q) w[q] = pack_bf16(tile[(kc + 2 * q) * 65 + nr], tile[(kc + 2 * q + 1) * 65 + nr]);
  uint4* d = (uint4*)(dst + (size_t)(nt * 64 + nr) * ldd + kt * 64 + kc);
  d[0] = make_uint4(w[0], w[1], w[2], w[3]);
  d[1] = make_uint4(w[4], w[5], w[6], w[7]);
  __syncthreads();
}

__device__ __forceinline__ void phase_init(char* smem) {
  const KP PP = get_params();
  const int tid = TID(), nb = gridDim.x, bid = BID();
  float* fs = (float*)smem;
  for (int u = bid; u < 192; u += nb) {
    const int layer = u / 96, col0 = (u % 96) * 64;
    float* sv = fs;
    float* red = fs + 3072;
    for (int i = tid; i < 3072; i += NTHR) {
      const int v = i >> 10, k = i & 1023;
      const float cv = (v < 2) ? PP->c[v * 1024 + k] : PP->c_ctx[k];
      sv[i] = siluf_(cv);
    }
    __syncthreads();
    const int cq = tid & 15, ks = tid >> 4;
    float acc[3][4];
#pragma unroll
    for (int v = 0; v < 3; ++v)
#pragma unroll
      for (int i = 0; i < 4; ++i) acc[v][i] = 0.f;
    const float* wb = PP->w_mod + ((size_t)layer * 1024 + ks * 64) * 6144 + col0 + cq * 4;
#pragma unroll 16
    for (int kk = 0; kk < 64; ++kk) {
      const float4 w4 = *(const float4*)(wb + (size_t)kk * 6144);
      const int k = ks * 64 + kk;
#pragma unroll
      for (int v = 0; v < 3; ++v) {
        const float s = sv[v * 1024 + k];
        acc[v][0] += s * w4.x; acc[v][1] += s * w4.y; acc[v][2] += s * w4.z; acc[v][3] += s * w4.w;
      }
    }
#pragma unroll
    for (int v = 0; v < 3; ++v)
#pragma unroll
      for (int i = 0; i < 4; ++i) red[(ks * 3 + v) * 64 + cq * 4 + i] = acc[v][i];
    __syncthreads();
    if (tid < 192) {
      const int v = tid >> 6, cc = tid & 63;
      float s = PP->b_mod[layer * 6144 + col0 + cc];
#pragma unroll
      for (int k2 = 0; k2 < 16; ++k2) s += red[(k2 * 3 + v) * 64 + cc];
      PP->mod[(size_t)(layer * 3 + v) * 6144 + col0 + cc] = s;
    }
    __syncthreads();
  }
  constexpr int NTL = 1184 + 128 + 128 + 256 + 16;
  for (int j = bid; j < NTL * DEPTH; j += nb) {
    const int layer = j / NTL;
    int jj = j % NTL;
    if (jj < 1184) {
      transpose_tile(PP->w_in + (size_t)layer * 1024 * INC, INC, LDK1, PP->WinT + (size_t)layer * NPAD * LDK1, jj / 74, jj % 74, 3, fs);
    } else if ((jj -= 1184) < 128) {
      transpose_tile(PP->w_up_dn + (size_t)layer * 512 * 1024, 1024, LDK5, PP->WdT + (size_t)layer * 1024 * LDK5, jj / 16, jj % 16, 2, fs);
    } else if ((jj -= 128) < 128) {
      transpose_tile(PP->w_up_pool + (size_t)layer * 512 * 1024, 1024, LDK5, PP->WpT + (size_t)layer * 1024 * LDK5, jj / 16, jj % 16, 2, fs);
    } else if ((jj -= 128) < 256) {
      transpose_tile(PP->w_out + (size_t)layer * 1024 * 1024, 1024, LDK1, PP->WoT + (size_t)layer * 1024 * LDK1, jj / 16, jj % 16, 2, fs);
    } else {
      jj -= 256;
      const int g = jj >> 2;
      transpose_tile(PP->pool_w + (size_t)(layer * 4 + g) * 128 * 128, 128, 128, PP->PwT + (size_t)(layer * 4 + g) * 128 * 128,
                     (jj & 3) >> 1, jj & 1, 0, fs);
    }
  }
  {
    const int tid2 = TID();
    const int l = tid2 & 63, w = tid2 >> 6, lr = l & 15, lg = l >> 4;
    char* Ks = smem;
    char* Ws = smem + 32768;
    for (int item = bid; item < DEPTH * 256; item += nb) {
      const int layer = item >> 8, hp = (item >> 4) & 15, ct = item & 15;
      __syncthreads();
      const float* ksrc = PP->peer_keys + (size_t)(layer * 16 + hp) * 128 * 128;
      for (int idx = tid2; idx < 128 * 16; idx += NTHR) {
        const int row = idx >> 4, ch = idx & 15;
        const float4 a = *(const float4*)(ksrc + row * 128 + ch * 8);
        const float4 c4 = *(const float4*)(ksrc + row * 128 + ch * 8 + 4);
        *(uint4*)(Ks + row * 256 + ((ch ^ (row & 15)) << 4)) =
            make_uint4(pack_bf16(a.x, a.y), pack_bf16(a.z, a.w), pack_bf16(c4.x, c4.y), pack_bf16(c4.z, c4.w));
      }
      const float* wsrc = PP->peer_wq + (size_t)layer * 1024 * 2048 + (size_t)(ct * 64) * 2048 + hp * 128;
      for (int idx = tid2; idx < 64 * 16; idx += NTHR) {
        const int row = idx >> 4, ch = idx & 15;
        const float4 a = *(const float4*)(wsrc + (size_t)row * 2048 + ch * 8);
        const float4 c4 = *(const float4*)(wsrc + (size_t)row * 2048 + ch * 8 + 4);
        *(uint4*)(Ws + row * 256 + ((ch ^ (row & 15)) << 4)) =
            make_uint4(pack_bf16(a.x, a.y), pack_bf16(a.z, a.w), pack_bf16(c4.x, c4.y), pack_bf16(c4.z, c4.w));
      }
      __syncthreads();
      f32x4 acc[2][4];
#pragma unroll
      for (int mi = 0; mi < 2; ++mi)
#pragma unroll
        for (int ni = 0; ni < 4; ++ni) acc[mi][ni] = (f32x4){0.f, 0.f, 0.f, 0.f};
#pragma unroll
      for (int ks = 0; ks < 4; ++ks) {
        const int ch = ks * 4 + lg;
        bf16x8 a[2], bb[4];
#pragma unroll
        for (int mi = 0; mi < 2; ++mi) a[mi] = *(const bf16x8*)(Ks + ((2 * w + mi) * 16 + lr) * 256 + ((ch ^ lr) << 4));
#pragma unroll
        for (int ni = 0; ni < 4; ++ni) bb[ni] = *(const bf16x8*)(Ws + (ni * 16 + lr) * 256 + ((ch ^ lr) << 4));
#pragma unroll
        for (int mi = 0; mi < 2; ++mi)
#pragma unroll
          for (int ni = 0; ni < 4; ++ni) acc[mi][ni] = __builtin_amdgcn_mfma_f32_16x16x32_bf16(a[mi], bb[ni], acc[mi][ni], 0, 0, 0);
      }
      unsigned char* dst = (unsigned char*)PP->WkT + ((size_t)layer * 2048 + hp * 128) * LDK1 + ct * 64;
#pragma unroll
      for (int mi = 0; mi < 2; ++mi)
#pragma unroll
        for (int ni = 0; ni < 4; ++ni)
#pragma unroll
          for (int r = 0; r < 4; ++r) {
            const float v32 = 32.f * acc[mi][ni][r];
            dst[(size_t)((2 * w + mi) * 16 + 4 * lg + r) * LDK1 + ni * 16 + lr] = (unsigned char)(__builtin_amdgcn_cvt_pk_fp8_f32(v32, v32, 0, false) & 0xff);
          }
    }
  }
}

DEV unsigned enc_e2m3(float x) {
  const float a = fabsf(x);
  float c;
  if (a < 2.f) c = a * 8.f;
  else if (a < 4.f) c = 16.f + (a - 2.f) * 4.f;
  else c = 24.f + (a - 4.f) * 2.f;
  unsigned code = (unsigned)__builtin_rintf(c);
  code = code > 31u ? 31u : code;
  return code | (x < 0.f ? 32u : 0u);
}
struct __attribute__((packed, aligned(4))) U3 { unsigned a, b, c; };
constexpr int TROW = 768;
typedef float f32x32_t __attribute__((ext_vector_type(32)));
typedef unsigned u32x6_t __attribute__((ext_vector_type(6)));

__device__ __forceinline__ void phase_tables(int layer, int vbid, int vnb) {
  const KP PP = get_params();
  const int tid = TID(), lane = tid & 63;
  const int gw = vbid * 4 + (tid >> 6), nw = vnb * 4;
  const float* su = PP->peer_u + (size_t)layer * NEXP * 1024;
  const float* sv = PP->peer_v + (size_t)layer * NEXP * 1024;
  for (int r0 = gw * 4; r0 < 2 * NEXP; r0 += nw * 4) {
    float4 v[4][4];
#pragma unroll
    for (int q = 0; q < 4; ++q) {
      const int r = r0 + q;
      const float* src = (r < NEXP ? su + (size_t)r * 1024 : sv + (size_t)(r - NEXP) * 1024);
#pragma unroll
      for (int i = 0; i < 4; ++i) {
        const f32x4 t_ = __builtin_nontemporal_load((const f32x4*)(src + (lane + 64 * i) * 4));
        v[q][i] = make_float4(t_[0], t_[1], t_[2], t_[3]);
      }
    }
#pragma unroll
    for (int q = 0; q < 4; ++q) {
      const int r = r0 + q;
      float am = 0.f;
#pragma unroll
      for (int i = 0; i < 4; ++i)
        am = fmaxf(am, fmaxf(fmaxf(fabsf(v[q][i].x), fabsf(v[q][i].y)), fmaxf(fabsf(v[q][i].z), fabsf(v[q][i].w))));
      am = wave_max(am);
      const float scale = fmaxf(am, 1e-30f) * (1.f / 7.5f);
      const float inv = 1.f / scale;
      unsigned long long lo = 0ull;
      unsigned hi = 0u;
#pragma unroll
      for (int i = 0; i < 4; ++i) {
        const float vv[4] = {v[q][i].x * inv, v[q][i].y * inv, v[q][i].z * inv, v[q][i].w * inv};
#pragma unroll
        for (int j = 0; j < 4; ++j) {
          const int k = 4 * i + j;
          const unsigned cde = enc_e2m3(vv[j]);
          if (k < 10) lo |= (unsigned long long)cde << (6 * k);
          else if (k == 10) { lo |= (unsigned long long)cde << 60; hi |= cde >> 4; }
          else hi |= cde << (6 * k - 64);
        }
      }
      unsigned char* dst = (r < NEXP ? PP->tab8U + (size_t)r * TROW : PP->tab8V + (size_t)(r - NEXP) * TROW);
      U3 pk3;
      pk3.a = (unsigned)lo; pk3.b = (unsigned)(lo >> 32); pk3.c = hi;
      *(U3*)(dst + lane * 12) = pk3;
      if (lane == 0) { if (r < NEXP) PP->scU[r] = scale; else PP->scV[r - NEXP] = scale; }
    }
  }
}

__device__ __forceinline__ void phase_norm(int layer, int which) {
  const KP PP = get_params();
  const int lane = TID() & 63;
  const int gw = BID() * 4 + (TID() >> 6), nw = gridDim.x * 4;
  const float* nwt = (which == 1 ? PP->norm_mix : PP->norm_ffn) + layer * 1024;
  const int rlim = (which == 2 && layer == DEPTH - 1) ? NLAT : R;
  for (int r = gw; r < rlim; r += nw) {
    const float* md = PP->mod + (size_t)(layer * 3 + modsel(r)) * 6144 + (which == 1 ? 0 : 3072);
    float4 v[4];
    float ss = 0.f;
    if (which == 1) {
      const float* xr = (r < NLAT) ? PP->x + (size_t)r * 1024 : PP->ctx + (size_t)(r - NLAT) * 1024;
#pragma unroll
      for (int i = 0; i < 4; ++i) v[i] = *(const float4*)(xr + (lane + 64 * i) * 4);
    } else {
      const u16* xr = PP->xb + (size_t)r * 1024;
#pragma unroll
      for (int i = 0; i < 4; ++i) {
        const uint2 t = *(const uint2*)(xr + (lane + 64 * i) * 4);
        v[i] = make_float4(bf_lo(t.x), bf_hi(t.x), bf_lo(t.y), bf_hi(t.y));
      }
    }
#pragma unroll
    for (int i = 0; i < 4; ++i) ss += v[i].x * v[i].x + v[i].y * v[i].y + v[i].z * v[i].z + v[i].w * v[i].w;
    ss = wave_sum(ss);
    const float rs = rsqrtf(ss * (1.f / 1024.f) + EPS);
#pragma unroll
    for (int i = 0; i < 4; ++i) {
      const int col = (lane + 64 * i) * 4;
      const float4 w = *(const float4*)(nwt + col);
      const float4 sh = *(const float4*)(md + col);
      const float4 sc = *(const float4*)(md + 1024 + col);
      const float y0 = v[i].x * rs * w.x * (1.f + sc.x) + sh.x;
      const float y1 = v[i].y * rs * w.y * (1.f + sc.y) + sh.y;
      const float y2 = v[i].z * rs * w.z * (1.f + sc.z) + sh.z;
      const float y3 = v[i].w * rs * w.w * (1.f + sc.w) + sh.w;
      if (which == 1) {
        int pk = __builtin_amdgcn_cvt_pk_fp8_f32(y0, y1, 0, false);
        pk = __builtin_amdgcn_cvt_pk_fp8_f32(y2, y3, pk, true);
        *(int*)((char*)PP->h + (size_t)r * (LDK1 * 2) + col) = pk;
      } else {
        *(uint2*)(PP->h + (size_t)r * LDK1 + col) = make_uint2(pack_bf16(y0, y1), pack_bf16(y2, y3));
        int pk = __builtin_amdgcn_cvt_pk_fp8_f32(y0, y1, 0, false);
        pk = __builtin_amdgcn_cvt_pk_fp8_f32(y2, y3, pk, true);
        *(int*)(PP->h8 + (size_t)r * LDK1 + col) = pk;
      }
    }
  }
}

template <bool PRIO>
DEV void gemm_mainloop_t(const u16* __restrict__ A, int lda, const u16* __restrict__ B, int ldb, int K, int m0, int n0,
                         char* smem, f32x4 (&acc)[4][4]) {
  const int tid = TID();
  const int l = tid & 63, w = tid >> 6, wm = w >> 1, wn = w & 1, lr = l & 15, lg = l >> 4;
  uint4 ga0[4], gb0[4], ga1[4], gb1[4];
#pragma unroll
  for (int i = 0; i < 4; ++i) { ga0[i] = make_uint4(0u, 0u, 0u, 0u); gb0[i] = ga0[i]; ga1[i] = ga0[i]; gb1[i] = ga0[i]; }
  const int KT = K >> 6;
#define GLOAD(GA, GB, KT_)                                                                     \
  _Pragma("unroll") for (int i = 0; i < 4; ++i) {                                              \
    const int id = tid + 256 * i, row = id >> 3, c = id & 7;                                   \
    GA[i] = *(const uint4*)(A + (size_t)(m0 + row) * lda + (KT_) * 64 + c * 8);                \
    GB[i] = *(const uint4*)(B + (size_t)(n0 + row) * ldb + (KT_) * 64 + c * 8);                \
  }
#define LSTORE(GA, GB, BUF)                                                                    \
  {                                                                                            \
    char* as_ = smem + (BUF) * 32768;                                                          \
    char* bs_ = as_ + 16384;                                                                   \
    _Pragma("unroll") for (int i = 0; i < 4; ++i) {                                            \
      const int id = tid + 256 * i, row = id >> 3, c = id & 7;                                 \
      const int off = row * 128 + ((c ^ (row & 7)) << 4);                                      \
      *(uint4*)(as_ + off) = GA[i];                                                            \
      *(uint4*)(bs_ + off) = GB[i];                                                            \
    }                                                                                          \
  }
#define COMPUTE(BUF)                                                                                                      \
  {                                                                                                                       \
    const char* as_ = smem + (BUF) * 32768;                                                                               \
    const char* bs_ = as_ + 16384;                                                                                        \
    if (PRIO) __builtin_amdgcn_s_setprio(1);      \
    _Pragma("unroll") for (int ks = 0; ks < 2; ++ks) {                                                                    \
      bf16x8 a[4], b[4];                                                                                                  \
      const int c = ks * 4 + lg;                                                                                          \
      const int sw = ((c ^ (lr & 7)) << 4);                                                                               \
      _Pragma("unroll") for (int mi = 0; mi < 4; ++mi) a[mi] = *(const bf16x8*)(as_ + (wm * 64 + mi * 16 + lr) * 128 + sw); \
      _Pragma("unroll") for (int ni = 0; ni < 4; ++ni) b[ni] = *(const bf16x8*)(bs_ + (wn * 64 + ni * 16 + lr) * 128 + sw); \
      _Pragma("unroll") for (int mi = 0; mi < 4; ++mi)                                                                    \
        _Pragma("unroll") for (int ni = 0; ni < 4; ++ni)                                                                  \
          acc[mi][ni] = __builtin_amdgcn_mfma_f32_16x16x32_bf16(a[mi], b[ni], acc[mi][ni], 0, 0, 0);                      \
    }                                                                                                                     \
    if (PRIO) __builtin_amdgcn_s_setprio(0);                                                                              \
  }
  __syncthreads();
  GLOAD(ga0, gb0, 0);
  GLOAD(ga1, gb1, 1);
  LSTORE(ga0, gb0, 0);
  __syncthreads();
  for (int kt = 0; kt < KT; kt += 2) {
    if (kt + 2 < KT) { GLOAD(ga0, gb0, kt + 2); }
    COMPUTE(0);
    LSTORE(ga1, gb1, 1);
    __syncthreads();
    if (kt + 3 < KT) { GLOAD(ga1, gb1, kt + 3); }
    COMPUTE(1);
    if (kt + 2 < KT) { LSTORE(ga0, gb0, 0); }
    __syncthreads();
  }
#undef GLOAD
#undef LSTORE
#undef COMPUTE
}

DEV void gemm_mainloop(const u16* __restrict__ A, int lda, const u16* __restrict__ B, int ldb, int K, int m0, int n0,
                       char* smem, f32x4 (&acc)[4][4]) {
  gemm_mainloop_t<false>(A, lda, B, ldb, K, m0, n0, smem, acc);
}
DEV void gemm_mainloop1(const u16* __restrict__ A, int lda, const u16* __restrict__ B, int ldb, int K, int m0, int n0,
                       char* smem, f32x4 (&acc)[4][4]) {
  const int tid = TID();
  const int l = tid & 63, w = tid >> 6, wm = w >> 1, wn = w & 1, lr = l & 15, lg = l >> 4;
  uint4 ga[4], gb[4];
  const int KT = K >> 6;
  auto gload = [&](int kt) {
#pragma unroll
    for (int i = 0; i < 4; ++i) {
      const int id = tid + 256 * i, row = id >> 3, c = id & 7;
      ga[i] = *(const uint4*)(A + (size_t)(m0 + row) * lda + kt * 64 + c * 8);
      gb[i] = *(const uint4*)(B + (size_t)(n0 + row) * ldb + kt * 64 + c * 8);
    }
  };
  auto lstore = [&](int buf) {
    char* as = smem + buf * 32768;
    char* bs = as + 16384;
#pragma unroll
    for (int i = 0; i < 4; ++i) {
      const int id = tid + 256 * i, row = id >> 3, c = id & 7;
      const int off = row * 128 + ((c ^ (row & 7)) << 4);
      *(uint4*)(as + off) = ga[i];
      *(uint4*)(bs + off) = gb[i];
    }
  };
  __syncthreads();
  gload(0);
  lstore(0);
  __syncthreads();
  for (int kt = 0; kt < KT; ++kt) {
    if (kt + 1 < KT) gload(kt + 1);
    const char* as = smem + (kt & 1) * 32768;
    const char* bs = as + 16384;
#pragma unroll
    for (int ks = 0; ks < 2; ++ks) {
      bf16x8 a[4], b[4];
      const int c = ks * 4 + lg;
      const int sw = ((c ^ (lr & 7)) << 4);
#pragma unroll
      for (int mi = 0; mi < 4; ++mi) a[mi] = *(const bf16x8*)(as + (wm * 64 + mi * 16 + lr) * 128 + sw);
#pragma unroll
      for (int ni = 0; ni < 4; ++ni) b[ni] = *(const bf16x8*)(bs + (wn * 64 + ni * 16 + lr) * 128 + sw);
#pragma unroll
      for (int mi = 0; mi < 4; ++mi)
#pragma unroll
        for (int ni = 0; ni < 4; ++ni) acc[mi][ni] = __builtin_amdgcn_mfma_f32_16x16x32_bf16(a[mi], b[ni], acc[mi][ni], 0, 0, 0);
    }
    if (kt + 1 < KT) lstore((kt + 1) & 1);
    __syncthreads();
  }
}

DEV void zero_acc(f32x4 (&acc)[4][4]) {
#pragma unroll
  for (int i = 0; i < 4; ++i)
#pragma unroll
    for (int j = 0; j < 4; ++j) acc[i][j] = (f32x4){0.f, 0.f, 0.f, 0.f};
}

DEV void stage_half(const f32x4 (&acc)[4][4], int hsel, char* smem, float4 (&v)[8]) {
  const int tid = TID();
  const int l = tid & 63, w = tid >> 6, wm = w >> 1, wn = w & 1, lr = l & 15, lg = l >> 4;
  float* Cs = (float*)smem;
  __syncthreads();
  if (wm == hsel) {
#pragma unroll
    for (int mi = 0; mi < 4; ++mi)
#pragma unroll
      for (int ni = 0; ni < 4; ++ni)
#pragma unroll
        for (int r = 0; r < 4; ++r) Cs[(mi * 16 + lg * 4 + r) * 132 + wn * 64 + ni * 16 + lr] = acc[mi][ni][r];
  }
  __syncthreads();
#pragma unroll
  for (int j = 0; j < 8; ++j) {
    const int idx = tid + 256 * j, row = idx >> 5, c4 = idx & 31;
    v[j] = *(const float4*)&Cs[row * 132 + c4 * 4];
  }
}

DEV bool tile_map(int it, int MT, int NTl, int& mt, int& nt) {
  const int nb = gridDim.x, bid = BID();
  const int x = bid & 7, vl = bid >> 3, per = nb >> 3;
  const int T = MT * NTl;
  const int g_begin = (int)(((long long)x * T) >> 3), g_end = (int)(((long long)(x + 1) * T) >> 3);
  const int g = g_begin + vl + it * per;
  if (g >= g_end) return false;
  const int full = MT >> 3;
  const int sr = g / (8 * NTl);
  const int srow = sr < full ? sr : full;
  const int rows_in_sr = sr < full ? 8 : (MT & 7);
  const int tt = g - srow * 8 * NTl;
  nt = tt / rows_in_sr;
  mt = srow * 8 + tt % rows_in_sr;
  return true;
}

#define SG_LOCALS                                                                              \
  const int tid = TID();                                                                       \
  const int l = tid & 63, w = tid >> 6, wm = w >> 1, wn = w & 1, lr = l & 15, lg = l >> 4;     \
  uint4 ga0[4], gb0[4], ga1[4], gb1[4];                                                        \
  _Pragma("unroll") for (int i = 0; i < 4; ++i) {                                              \
    ga0[i] = make_uint4(0u, 0u, 0u, 0u); gb0[i] = ga0[i]; ga1[i] = ga0[i]; gb1[i] = ga0[i];    \
  }                                                                                            \
  const int r0 = tid >> 3, c0 = tid & 7;                                                       \
  const int pr0 = 8 * ((r0 & 15) >> 2) + 4 * (r0 >> 4) + (r0 & 3);
#define SG_LOAD(GA, GB, AP, BP, LD, M0_, N0_, KT_)                                             \
  _Pragma("unroll") for (int i = 0; i < 4; ++i) {                                              \
    GA[i] = *(const uint4*)((AP) + (size_t)((M0_) + 32 * i + r0) * (LD) + c0 * 8 + (KT_) * 64);  \
    GB[i] = *(const uint4*)((BP) + (size_t)((N0_) + 32 * i + pr0) * (LD) + c0 * 8 + (KT_) * 64); \
  }
#define SG_LSTORE(GA, GB, BUF)                                                                 \
  {                                                                                            \
    char* as_ = smem + (BUF) * 32768;                                                          \
    char* bs_ = as_ + 16384;                                                                   \
    _Pragma("unroll") for (int i = 0; i < 4; ++i) {                                            \
      const int id = tid + 256 * i, row = id >> 3, c = id & 7;                                 \
      const int off = row * 128 + ((c ^ (row & 7)) << 4);                                      \
      *(uint4*)(as_ + off) = GA[i];                                                            \
      *(uint4*)(bs_ + off) = GB[i];                                                            \
    }                                                                                          \
  }
#define SG_COMPUTE(ACC, BUF, PRIO)                                                                                        \
  {                                                                                                                       \
    const char* as_ = smem + (BUF) * 32768;                                                                               \
    const char* bs_ = as_ + 16384;                                                                                        \
    if (PRIO) __builtin_amdgcn_s_setprio(1);                                                                              \
    _Pragma("unroll") for (int ks = 0; ks < 2; ++ks) {                                                                    \
      bf16x8 a[4], b[4];                                                                                                  \
      const int c = ks * 4 + lg;                                                                                          \
      const int sw = ((c ^ (lr & 7)) << 4);                                                                               \
      _Pragma("unroll") for (int mi = 0; mi < 4; ++mi) a[mi] = *(const bf16x8*)(as_ + (wm * 64 + mi * 16 + lr) * 128 + sw); \
      _Pragma("unroll") for (int ni = 0; ni < 4; ++ni) b[ni] = *(const bf16x8*)(bs_ + (wn * 64 + ni * 16 + lr) * 128 + sw); \
      _Pragma("unroll") for (int mi = 0; mi < 4; ++mi)                                                                    \
        _Pragma("unroll") for (int ni = 0; ni < 4; ++ni)                                                                  \
          ACC[mi][ni] = __builtin_amdgcn_mfma_f32_16x16x32_bf16(b[ni], a[mi], ACC[mi][ni], 0, 0, 0);                      \
    }                                                                                                                     \
    if (PRIO) __builtin_amdgcn_s_setprio(0);                                                                              \
  }

typedef int i32x8 __attribute__((ext_vector_type(8)));
typedef int i32x4 __attribute__((ext_vector_type(4)));
#define F8_LOCALS                                                                              \
  const int tid = TID();                                                                       \
  const int l = tid & 63, w = tid >> 6, wm = w >> 1, wn = w & 1, lr = l & 15, lg = l >> 4;     \
  uint4 ga0[4], gb0[4], ga1[4], gb1[4];                                                        \
  _Pragma("unroll") for (int i = 0; i < 4; ++i) {                                              \
    ga0[i] = make_uint4(0u, 0u, 0u, 0u); gb0[i] = ga0[i]; ga1[i] = ga0[i]; gb1[i] = ga0[i];    \
  }                                                                                            \
  const int r0 = tid >> 3, c0 = tid & 7;                                                       \
  const int pr0 = 8 * ((r0 & 15) >> 2) + 4 * (r0 >> 4) + (r0 & 3);
#define F8_GLOAD(GA, GB, AP, LDA, BP, LDB, M0_, N0_, KT_)                                      \
  _Pragma("unroll") for (int i = 0; i < 4; ++i) {                                              \
    GA[i] = *(const uint4*)((AP) + (size_t)((M0_) + 32 * i + r0) * (LDA) + c0 * 16 + (KT_) * 128);   \
    GB[i] = *(const uint4*)((BP) + (size_t)((N0_) + 32 * i + pr0) * (LDB) + c0 * 16 + (KT_) * 128);  \
  }
#define F8_LSTORE(GA, GB, BUF)                                                                 \
  {                                                                                            \
    char* as_ = smem + (BUF) * 32768;                                                          \
    char* bs_ = as_ + 16384;                                                                   \
    _Pragma("unroll") for (int i = 0; i < 4; ++i) {                                            \
      const int id = tid + 256 * i, row = id >> 3, c = id & 7;                                 \
      const int off = row * 128 + ((c ^ (row & 7)) << 4);                                      \
      *(uint4*)(as_ + off) = GA[i];                                                            \
      *(uint4*)(bs_ + off) = GB[i];                                                            \
    }                                                                                          \
  }
#define F8_COMPUTE(BUF)                                                                                                   \
  {                                                                                                                       \
    const char* as_ = smem + (BUF) * 32768;                                                                               \
    const char* bs_ = as_ + 16384;                                                                                        \
    i32x8 a[4], b[4];                                                                                                     \
    const int sw0 = ((lg ^ (lr & 7)) << 4), sw1 = (((4 + lg) ^ (lr & 7)) << 4);                                           \
    _Pragma("unroll") for (int mi = 0; mi < 4; ++mi) {                                                                    \
      const char* p_ = as_ + (wm * 64 + mi * 16 + lr) * 128;                                                              \
      const i32x4 lo_ = *(const i32x4*)(p_ + sw0), hi_ = *(const i32x4*)(p_ + sw1);                                       \
      a[mi] = __builtin_shufflevector(lo_, hi_, 0, 1, 2, 3, 4, 5, 6, 7);                                                  \
    }                                                                                                                     \
    _Pragma("unroll") for (int ni = 0; ni < 4; ++ni) {                                                                    \
      const char* p_ = bs_ + (wn * 64 + ni * 16 + lr) * 128;                                                              \
      const i32x4 lo_ = *(const i32x4*)(p_ + sw0), hi_ = *(const i32x4*)(p_ + sw1);                                       \
      b[ni] = __builtin_shufflevector(lo_, hi_, 0, 1, 2, 3, 4, 5, 6, 7);                                                  \
    }                                                                                                                     \
    __builtin_amdgcn_s_setprio(1);                                                                                        \
    _Pragma("unroll") for (int mi = 0; mi < 4; ++mi)                                                                      \
      _Pragma("unroll") for (int ni = 0; ni < 4; ++ni)                                                                    \
        acc[mi][ni] = __builtin_amdgcn_mfma_scale_f32_16x16x128_f8f6f4(b[ni], a[mi], acc[mi][ni], 0, 0, 0, 0, 0, 0);      \
    __builtin_amdgcn_s_setprio(0);                                                                                        \
  }
#define F8_KLOOP(AP, LDA, BP, LDB, KT_)                                                        \
  for (int kt = 0; kt < (KT_); kt += 2) {                                                      \
    const bool wrap = (kt + 2 >= (KT_));                                                       \
    const int ml = wrap ? m0n : m0, nl = wrap ? n0n : n0, kl = wrap ? kt + 2 - (KT_) : kt + 2; \
    if (!wrap || hasn) { F8_GLOAD(ga0, gb0, AP, LDA, BP, LDB, ml, nl, kl); }                   \
    F8_COMPUTE(0);                                                                             \
    F8_LSTORE(ga1, gb1, 1);                                                                    \
    __syncthreads();                                                                           \
    if (!wrap || hasn) { F8_GLOAD(ga1, gb1, AP, LDA, BP, LDB, ml, nl, kl + 1); }               \
    F8_COMPUTE(1);                                                                             \
    if (!wrap || hasn) { F8_LSTORE(ga0, gb0, 0); }                                             \
    __syncthreads();                                                                           \
  }
#define F8_PROLOGUE(AP, LDA, BP, LDB)                                                          \
  __syncthreads();                           \
  F8_GLOAD(ga0, gb0, AP, LDA, BP, LDB, m0, n0, 0);                                             \
  F8_GLOAD(ga1, gb1, AP, LDA, BP, LDB, m0, n0, 1);                                             \
  F8_LSTORE(ga0, gb0, 0);                                                                      \
  __syncthreads();

__device__ __forceinline__ void phase_gemm_win(int layer, char* smem) {
  const KP PP = get_params();
  const char* Bt = (const char*)(PP->WinT + (size_t)layer * NPAD * LDK1);
  const char* A = (const char*)PP->h;
  F8_LOCALS
  int it = 0, mt, nt;
  if (!tile_map(it, R / 128, NPAD / 128, mt, nt)) return;
  int m0 = mt * 128, n0 = nt * 128;
  F8_PROLOGUE(A, LDK1 * 2, Bt, LDK1)
  for (;;) {
    int mtn = 0, ntn = 0;
    const bool hasn = tile_map(it + 1, R / 128, NPAD / 128, mtn, ntn);
    const int m0n = mtn * 128, n0n = ntn * 128;
    f32x4 acc[4][4];
    zero_acc(acc);
    F8_KLOOP(A, LDK1 * 2, Bt, LDK1, 8)
#pragma unroll
    for (int mi = 0; mi < 4; ++mi) {
      const size_t gr = (size_t)(m0 + wm * 64 + mi * 16 + lr);
#pragma unroll
      for (int g = 0; g < 2; ++g) {
        const int gc = n0 + wn * 64 + g * 32 + 8 * lg;
        const f32x4 t0 = acc[mi][2 * g] * (1.f / 32.f), t1 = acc[mi][2 * g + 1] * (1.f / 32.f);
        if (n0 < 1536) {
          int p0 = __builtin_amdgcn_cvt_pk_fp8_f32(t0[0], t0[1], 0, false);
          p0 = __builtin_amdgcn_cvt_pk_fp8_f32(t0[2], t0[3], p0, true);
          int p1 = __builtin_amdgcn_cvt_pk_fp8_f32(t1[0], t1[1], 0, false);
          p1 = __builtin_amdgcn_cvt_pk_fp8_f32(t1[2], t1[3], p1, true);
          *(int2*)((char*)PP->qkv_pre + gr * 1536 + gc) = make_int2(p0, p1);
        } else if (n0 < 2048) {
          *(uint4*)(PP->z + gr * 512 + (gc - 1536)) =
              make_uint4(pack_bf16(t0[0], t0[1]), pack_bf16(t0[2], t0[3]), pack_bf16(t1[0], t1[1]), pack_bf16(t1[2], t1[3]));
        } else if (n0 < 2560) {
          *(uint4*)(PP->pin + gr * 512 + (gc - 2048)) =
              make_uint4(pack_bf16(t0[0], t0[1]), pack_bf16(t0[2], t0[3]), pack_bf16(t1[0], t1[1]), pack_bf16(t1[2], t1[3]));
        } else if (n0 < 4608) {
          unsigned q0 = 0u, q1 = 0u;
#pragma unroll
          for (int e = 0; e < 4; ++e) {
            q0 = __builtin_amdgcn_cvt_pk_u8_f32(sigmoidf_(t0[e]) * 255.f, e, q0);
            q1 = __builtin_amdgcn_cvt_pk_u8_f32(sigmoidf_(t1[e]) * 255.f, e, q1);
          }
          unsigned char* gdst = (n0 < 3584) ? (unsigned char*)PP->sgd + gr * 1024 + (gc - 2560)
                                            : (unsigned char*)PP->sgp + gr * 1024 + (gc - 3584);
          *(uint2*)gdst = make_uint2(q0, q1);
        } else {
          if (gc - 4608 < 16) {
            *(float4*)(PP->ba + gr * 16 + (gc - 4608)) = make_float4(t0[0], t0[1], t0[2], t0[3]);
            *(float4*)(PP->ba + gr * 16 + (gc - 4608) + 4) = make_float4(t1[0], t1[1], t1[2], t1[3]);
          }
        }
      }
    }
    if (!hasn) break;
    m0 = m0n; n0 = n0n; ++it;
  }
}

__device__ __forceinline__ void phase_conv(int layer) {
  const KP PP = get_params();
  const int lane = TID() & 63;
  const int gw = BID() * 4 + (TID() >> 6), nw = gridDim.x * 4;
  const float* cw = PP->conv_w + (size_t)layer * 4 * 1536;
  float wr[3][4][8];
#pragma unroll
  for (int part = 0; part < 3; ++part)
#pragma unroll
    for (int j = 0; j < 4; ++j) {
      const float4 w0 = *(const float4*)(cw + j * 1536 + part * 512 + lane * 8);
      const float4 w1 = *(const float4*)(cw + j * 1536 + part * 512 + lane * 8 + 4);
      wr[part][j][0] = w0.x; wr[part][j][1] = w0.y; wr[part][j][2] = w0.z; wr[part][j][3] = w0.w;
      wr[part][j][4] = w1.x; wr[part][j][5] = w1.y; wr[part][j][6] = w1.z; wr[part][j][7] = w1.w;
    }
  for (int r = gw; r < R; r += nw) {
    int t, T;
    if (r < NLAT) { t = r & (SEQ - 1); T = SEQ; } else { t = (r - NLAT) & (CTX - 1); T = CTX; }
    const int base = r - t;
    uint2 xv[3][4];
#pragma unroll
    for (int j = 0; j < 4; ++j) {
      const int tt = t + j - 2;
      const bool ok = (tt >= 0 && tt < T);
      const unsigned char* src = (const unsigned char*)PP->qkv_pre + (size_t)(base + (ok ? tt : t)) * 1536 + lane * 8;
#pragma unroll
      for (int part = 0; part < 3; ++part) {
        xv[part][j] = *(const uint2*)(src + part * 512);
        if (!ok) xv[part][j] = make_uint2(0u, 0u);
      }
    }
#pragma unroll
    for (int part = 0; part < 3; ++part) {
      const int ch0 = part * 512 + lane * 8;
      float y[8];
#pragma unroll
      for (int e = 0; e < 8; ++e) y[e] = 0.f;
#pragma unroll
      for (int j = 0; j < 4; ++j) {
        float xf[8];
        {
          const f32x2 a0 = __builtin_amdgcn_cvt_pk_f32_fp8(xv[part][j].x, false), a1 = __builtin_amdgcn_cvt_pk_f32_fp8(xv[part][j].x, true);
          const f32x2 a2 = __builtin_amdgcn_cvt_pk_f32_fp8(xv[part][j].y, false), a3 = __builtin_amdgcn_cvt_pk_f32_fp8(xv[part][j].y, true);
          xf[0] = a0[0]; xf[1] = a0[1]; xf[2] = a1[0]; xf[3] = a1[1]; xf[4] = a2[0]; xf[5] = a2[1]; xf[6] = a3[0]; xf[7] = a3[1];
        }
#pragma unroll
        for (int e = 0; e < 8; ++e) y[e] += wr[part][j][e] * xf[e];
      }
      float ss = 0.f;
#pragma unroll
      for (int e = 0; e < 8; ++e) { y[e] = siluf_(y[e]); ss += y[e] * y[e]; }
      if (part < 2) {
        ss = group16_sum(ss);
        const float sc = rsqrtf(ss + EPS) * (part == 0 ? 0.08838834764831845f : 1.f);
#pragma unroll
        for (int e = 0; e < 8; ++e) y[e] *= sc;
      }
      *(uint4*)(PP->qkvn + (size_t)r * 1536 + ch0) = pack8(y);
    }
    if (lane < 16) {
      const float raw = PP->ba[(size_t)r * 16 + lane];
      float o;
      if (lane < 8) {
        o = sigmoidf_(raw);
      } else {
        const int jj = lane - 8;
        const float xx = raw + PP->dt_bias[layer * 8 + jj];
        const float ee = __expf(xx);
        const float sp = xx > 20.f ? xx : (ee < 0.03125f ? ee * (1.f - ee * (0.5f - ee * (0.33333334f - 0.25f * ee))) : __logf(1.f + ee));
        o = -__expf(PP->a_log[layer * 8 + jj]) * sp;
      }
      PP->bg[(size_t)r * 16 + lane] = o;
    }
  }
}

DEV int seq_row(int b, int dir, int pos) {
  if (dir == 0) return pos < CTX ? NLAT + b * CTX + pos : b * SEQ + (pos - CTX);
  return pos < CTX ? NLAT + b * CTX + (CTX - 1 - pos) : b * SEQ + (SEQ - 1 - (pos - CTX));
}
constexpr int NCHUNK = (CTX + SEQ) / 64;
constexpr int NUNIT = BATCH * DNH * 2 * NCHUNK;

DEV int kperm(int s, int g, int e) { return 32 * s + 16 * (e >> 2) + 4 * g + (e & 3); }

DEV uint4 pack_tiles(const f32x4& a, const f32x4& b) {
  return make_uint4(pack_bf16(a[0], a[1]), pack_bf16(a[2], a[3]), pack_bf16(b[0], b[1]), pack_bf16(b[2], b[3]));
}
DEV bf16x8 as_frag(const uint4& v) { return *(const bf16x8*)&v; }

DEV void conv8_silu(const unsigned char* __restrict__ qkv_pre8, const float* __restrict__ cw, int r, int ch0, float (&y)[8]) {
  int t, T;
  if (r < NLAT) { t = r & (SEQ - 1); T = SEQ; } else { t = (r - NLAT) & (CTX - 1); T = CTX; }
  const int base = r - t;
  uint2 xv[4];
#pragma unroll
  for (int j = 0; j < 4; ++j) {
    const int tt = t + j - 2;
    const bool ok = (tt >= 0 && tt < T);
    xv[j] = *(const uint2*)(qkv_pre8 + (size_t)(base + (ok ? tt : t)) * 1536 + ch0);
    if (!ok) xv[j] = make_uint2(0u, 0u);
  }
#pragma unroll
  for (int e = 0; e < 8; ++e) y[e] = 0.f;
#pragma unroll
  for (int j = 0; j < 4; ++j) {
    const float4 w0 = *(const float4*)(cw + j * 1536 + ch0), w1 = *(const float4*)(cw + j * 1536 + ch0 + 4);
    const f32x2 a0 = __builtin_amdgcn_cvt_pk_f32_fp8(xv[j].x, false), a1 = __builtin_amdgcn_cvt_pk_f32_fp8(xv[j].x, true);
    const f32x2 a2 = __builtin_amdgcn_cvt_pk_f32_fp8(xv[j].y, false), a3 = __builtin_amdgcn_cvt_pk_f32_fp8(xv[j].y, true);
    y[0] += w0.x * a0[0]; y[1] += w0.y * a0[1]; y[2] += w0.z * a1[0]; y[3] += w0.w * a1[1];
    y[4] += w1.x * a2[0]; y[5] += w1.y * a2[1]; y[6] += w1.z * a3[0]; y[7] += w1.w * a3[1];
  }
#pragma unroll
  for (int e = 0; e < 8; ++e) y[e] = siluf_(y[e]);
}

__device__ __forceinline__ void phase_prep(int layer, char* smem) {
  const KP PP = get_params();
  const int tid0 = TID();
  const int w = __builtin_amdgcn_readfirstlane(tid0 >> 6);
  char* Kt = smem;
  char* Vt = smem + 16384;
  float* Ld = (float*)(smem + 32768);
  u16* LN = (u16*)(smem + 32768 + 5120);
  float* gcs = (float*)(smem + 32768 + 5120 + 9216);
  float* bts = gcs + 64;
  char* wpriv = smem + 32768 + 5120 + 9216 + 512 + w * 6144;
  float* Tt = (float*)wpriv;
  u16* Xb = (u16*)(wpriv + 4096);
  float* egc = (float*)(smem + 72192);
  float* egl = egc + 64;
  const int per_ = gridDim.x >> 3, s_ = BID() >> 3;
  const int nfull_ = (2 * NCHUNK) / per_, nrem_ = (2 * NCHUNK) % per_;
  const bool altx_ = (2 * nrem_ <= per_);
  for (int ki_ = 0; ki_ <= nfull_; ++ki_) {
    int j_;
    if (ki_ < nfull_) j_ = s_ + per_ * ki_;
    else if (altx_) { if (!(s_ & 1) || (s_ >> 1) >= nrem_) break; j_ = nfull_ * per_ + (s_ >> 1); }
    else { if (s_ >= nrem_) break; j_ = nfull_ * per_ + s_; }
    const int c = NCHUNK - 1 - (j_ >> 1), u16i = (BID() & 7) * 2 + (j_ & 1);
    const int unit = u16i * NCHUNK + c;
    const int dir = u16i & 1, hd = (u16i >> 1) & 3, b = u16i >> 3;
    int tid = tid0;
    asm volatile("" : "+v"(tid));
    const int l = tid & 63, lr = l & 15, lg = l >> 4;
    __syncthreads();
    if (tid < 64) {
      const int rr = seq_row(b, dir, c * 64 + tid);
      const int jj = dir * 4 + hd;
      bts[tid] = sigmoidf_(PP->ba[(size_t)rr * 16 + jj]);
      float g;
      {
        const float xx = PP->ba[(size_t)rr * 16 + 8 + jj] + PP->dt_bias[layer * 8 + jj];
        const float ee = __expf(xx);
        const float sp = xx > 20.f ? xx : (ee < 0.03125f ? ee * (1.f - ee * (0.5f - ee * (0.33333334f - 0.25f * ee))) : __logf(1.f + ee));
        g = -__expf(PP->a_log[layer * 8 + jj]) * sp;
      }
#pragma unroll
      for (int o = 1; o < 64; o <<= 1) {
        const float t = __builtin_bit_cast(float, __builtin_amdgcn_ds_bpermute(((tid - o) & 63) << 2, __builtin_bit_cast(int, g)));
        if (tid >= o) g += t;
      }
      gcs[tid] = g;
      egc[tid] = __expf(g);
      egl[tid] = __expf(__builtin_bit_cast(float, __builtin_amdgcn_readlane(__builtin_bit_cast(int, g), 63)) - g);
      PP->gc[(size_t)unit * 64 + tid] = g;
    }
    {
      const unsigned char* pre8 = (const unsigned char*)PP->qkv_pre;
      const float* cw = PP->conv_w + (size_t)layer * 4 * 1536;
      const int ch = tid & 15, rg = tid >> 4;
      const int r_first = seq_row(b, dir, c * 64 + 4 * rg);
      int t0, T;
      if (r_first < NLAT) { t0 = r_first & (SEQ - 1); T = SEQ; } else { t0 = (r_first - NLAT) & (CTX - 1); T = CTX; }
      const int base = r_first - t0;
      const int tl = dir ? t0 - 3 : t0;
      const int nparts = dir == 0 ? 3 : 2;
      uint2 xr_all[3][7];
#pragma unroll
      for (int part = 0; part < 3; ++part) {
#pragma unroll
        for (int m = 0; m < 7; ++m) xr_all[part][m] = make_uint2(0u, 0u);
      }
#pragma unroll
      for (int part = 0; part < 3; ++part) {
        if (part < nparts) {
          const int chofs = (part == 0 ? 512 : (part == 1 ? 1024 : 0)) + hd * 128 + ch * 8;
#pragma unroll
          for (int m = 0; m < 7; ++m) {
            const int tt = tl - 2 + m;
            const bool ok = (tt >= 0 && tt < T);
            const uint2 v = *(const uint2*)(pre8 + (size_t)(base + (ok ? tt : t0)) * 1536 + chofs);
            xr_all[part][m] = ok ? v : make_uint2(0u, 0u);
          }
        }
      }
#pragma unroll
      for (int part = 0; part < 3; ++part) {
        if (part >= nparts) continue;
        const int chofs = (part == 0 ? 512 : (part == 1 ? 1024 : 0)) + hd * 128 + ch * 8;
        f32x2 wv[4][4];
#pragma unroll
        for (int j = 0; j < 4; ++j) {
          const float4 w0 = *(const float4*)(cw + j * 1536 + chofs), w1 = *(const float4*)(cw + j * 1536 + chofs + 4);
          wv[j][0] = (f32x2){w0.x, w0.y}; wv[j][1] = (f32x2){w0.z, w0.w};
          wv[j][2] = (f32x2){w1.x, w1.y}; wv[j][3] = (f32x2){w1.z, w1.w};
        }
        uint2 xr[7];
#pragma unroll
        for (int m = 0; m < 7; ++m) xr[m] = xr_all[part][m];
        f32x2 xf[7][4];
#pragma unroll
        for (int m = 0; m < 7; ++m) {
          xf[m][0] = __builtin_amdgcn_cvt_pk_f32_fp8(xr[m].x, false); xf[m][1] = __builtin_amdgcn_cvt_pk_f32_fp8(xr[m].x, true);
          xf[m][2] = __builtin_amdgcn_cvt_pk_f32_fp8(xr[m].y, false); xf[m][3] = __builtin_amdgcn_cvt_pk_f32_fp8(xr[m].y, true);
        }
        f32x2 acc2[4][4];
        if (dir == 0) {
#pragma unroll
          for (int s4 = 0; s4 < 4; ++s4)
#pragma unroll
            for (int p = 0; p < 4; ++p) {
              f32x2 a = wv[0][p] * xf[s4][p];
#pragma unroll
              for (int j = 1; j < 4; ++j) a += wv[j][p] * xf[s4 + j][p];
              acc2[s4][p] = a;
            }
        } else {
#pragma unroll
          for (int s4 = 0; s4 < 4; ++s4)
#pragma unroll
            for (int p = 0; p < 4; ++p) {
              f32x2 a = wv[0][p] * xf[3 - s4][p];
#pragma unroll
              for (int j = 1; j < 4; ++j) a += wv[j][p] * xf[3 - s4 + j][p];
              acc2[s4][p] = a;
            }
        }
        float y[4][8], ss[4];
#pragma unroll
        for (int s4 = 0; s4 < 4; ++s4) {
          float t = 0.f;
#pragma unroll
          for (int p = 0; p < 4; ++p) {
            const float a0 = siluf_(acc2[s4][p][0]), a1 = siluf_(acc2[s4][p][1]);
            y[s4][2 * p] = a0; y[s4][2 * p + 1] = a1;
            t += a0 * a0 + a1 * a1;
          }
          ss[s4] = t;
        }
        if (part != 1) {
#pragma unroll
          for (int s4 = 0; s4 < 4; ++s4) ss[s4] += swz_xor<8>(ss[s4]);
#pragma unroll
          for (int s4 = 0; s4 < 4; ++s4) ss[s4] += swz_xor<4>(ss[s4]);
#pragma unroll
          for (int s4 = 0; s4 < 4; ++s4) ss[s4] += swz_xor<2>(ss[s4]);
#pragma unroll
          for (int s4 = 0; s4 < 4; ++s4) ss[s4] += swz_xor<1>(ss[s4]);
#pragma unroll
          for (int s4 = 0; s4 < 4; ++s4) {
            const float sc = rsqrtf(ss[s4] + EPS) * (part == 2 ? 0.08838834764831845f : 1.f);
#pragma unroll
            for (int e2 = 0; e2 < 8; ++e2) y[s4][e2] *= sc;
          }
        }
#pragma unroll
        for (int s4 = 0; s4 < 4; ++s4) {
          const int m0_ = dir ? 3 - s4 : s4;
          const uint4 pk = pack8(y[s4]);
          const int i = 4 * rg + s4;
          if (part < 2) *(uint4*)((part == 0 ? Kt : Vt) + i * 256 + ((ch ^ (i & 15)) << 4)) = pk;
          if (dir == 0 && part != 1) *(uint4*)(PP->qkvn + (size_t)(base + tl + m0_) * 1536 + chofs) = pk;
        }
      }
    }
    __syncthreads();
    {
      f32x4 acc[4];
#pragma unroll
      for (int nt = 0; nt < 4; ++nt) acc[nt] = (f32x4){0.f, 0.f, 0.f, 0.f};
#pragma unroll
      for (int s = 0; s < 4; ++s) {
        const int ch = s * 4 + lg;
        const bf16x8 a = *(const bf16x8*)(Kt + (16 * w + lr) * 256 + ((ch ^ lr) << 4));
#pragma unroll
        for (int nt = 0; nt < 4; ++nt) {
          const bf16x8 bb = *(const bf16x8*)(Kt + (16 * nt + lr) * 256 + ((ch ^ lr) << 4));
          acc[nt] = __builtin_amdgcn_mfma_f32_16x16x32_bf16(a, bb, acc[nt], 0, 0, 0);
        }
      }
#pragma unroll
      for (int nt = 0; nt < 4; ++nt)
#pragma unroll
        for (int r = 0; r < 4; ++r) {
          const int i = 16 * w + 4 * lg + r, j = 16 * nt + lr;
          const float val = (j < i) ? bts[i] * acc[nt][r] * __expf(fminf(gcs[i] - gcs[j], 0.f)) : 0.f;
          LN[i * 72 + j] = f2bf(-val);
          if (nt == w) Ld[(w * 16 + lr) * 20 + 4 * lg + r] = val;
        }
    }
    {
      const float glast = gcs[63];
      if (tid == 0) PP->glast[unit] = glast;
#pragma unroll
      for (int q4 = 0; q4 < 4; ++q4) {
        const int fid = tid + 256 * q4;
        const int mt = fid >> 7, s2 = (fid >> 6) & 1, ln = fid & 63, llr = ln & 15, llg = ln >> 4;
        const int d = 16 * mt + llr;
        float f[8];
#pragma unroll
        for (int e = 0; e < 8; ++e) {
          const int pos = kperm(s2, llg, e);
          const float kv = bf2f(*(const u16*)(Kt + pos * 256 + (((d >> 3) ^ (pos & 15)) << 4) + (d & 7) * 2));
          f[e] = kv * egl[pos];
        }
        *(uint4*)(PP->KdT + ((size_t)unit * 1024 + fid) * 8) = pack8(f);
      }
    }
    f32x4 X[4][4];
    {
      const bool isU = w >= 2;
      const char* tile = isU ? Vt : Kt;
#pragma unroll
      for (int mt = 0; mt < 4; ++mt)
#pragma unroll
        for (int nt = 0; nt < 4; ++nt)
#pragma unroll
          for (int r = 0; r < 4; ++r) {
            const int i = 16 * mt + 4 * lg + r, cc = 64 * (w & 1) + 16 * nt + lr;
            const float val = bf2f(*(const u16*)(tile + i * 256 + (((cc >> 3) ^ (i & 15)) << 4) + (cc & 7) * 2));
            X[mt][nt][r] = bts[i] * val * (isU ? 1.f : egc[i]);
          }
    }
    __syncthreads();
    u16* Wst = (u16*)smem;
    u16* Ust = (u16*)(smem + 16384);
#pragma unroll
    for (int bk = 0; bk < 4; ++bk) {
#pragma unroll
      for (int nt = 0; nt < 4; ++nt)
#pragma unroll
        for (int r = 0; r < 4; ++r) Tt[(4 * lg + r) * 64 + 16 * nt + lr] = X[bk][nt][r];
      __builtin_amdgcn_wave_barrier();
      asm volatile("s_waitcnt lgkmcnt(0)" ::: "memory");
      float xb[16];
#pragma unroll
      for (int i = 0; i < 16; ++i) xb[i] = Tt[i * 64 + l];
#pragma unroll
      for (int j = 0; j < 15; ++j) {
        const float xj = xb[j];
#pragma unroll
        for (int i4 = (j + 1) / 4; i4 < 4; ++i4) {
          const float4 lv = *(const float4*)&Ld[(bk * 16 + j) * 20 + i4 * 4];
          if (i4 * 4 + 0 > j) xb[i4 * 4 + 0] -= lv.x * xj;
          if (i4 * 4 + 1 > j) xb[i4 * 4 + 1] -= lv.y * xj;
          if (i4 * 4 + 2 > j) xb[i4 * 4 + 2] -= lv.z * xj;
          if (i4 * 4 + 3 > j) xb[i4 * 4 + 3] -= lv.w * xj;
        }
      }
      {
        const int cc = 64 * (w & 1) + l;
        if (w < 2) {
          const int d = cc, s = d >> 5, e = ((d >> 4) & 1) * 4 + (d & 3), g = (d >> 2) & 3;
#pragma unroll
          for (int ii = 0; ii < 16; ++ii) Wst[(((bk * 4 + s) * 64 + g * 16 + ii) << 3) + e] = f2bf(-xb[ii]);
        } else {
          const int slice = cc >> 4, lr_ = cc & 15;
#pragma unroll
          for (int g4 = 0; g4 < 4; ++g4) {
            int pk = __builtin_amdgcn_cvt_pk_fp8_f32(xb[4 * g4], xb[4 * g4 + 1], 0, false);
            pk = __builtin_amdgcn_cvt_pk_fp8_f32(xb[4 * g4 + 2], xb[4 * g4 + 3], pk, true);
            *(int*)((char*)Ust + slice * 1024 + (g4 * 16 + lr_) * 16 + bk * 4) = pk;
          }
        }
        if (bk < 3) {
          *(uint4*)(Xb + l * 16) = pack8(xb);
          *(uint4*)(Xb + l * 16 + 8) = pack8(xb + 8);
        }
      }
      if (bk < 3) {
        __builtin_amdgcn_wave_barrier();
        asm volatile("s_waitcnt lgkmcnt(0)" ::: "memory");
        uint4 bfr[4];
#pragma unroll
        for (int nt = 0; nt < 4; ++nt)
          bfr[nt] = (lg < 2) ? *(const uint4*)(Xb + (16 * nt + lr) * 16 + 8 * lg) : make_uint4(0u, 0u, 0u, 0u);
#pragma unroll
        for (int mt = bk + 1; mt < 4; ++mt) {
          const uint4 afr = (lg < 2) ? *(const uint4*)(LN + (16 * mt + lr) * 72 + 16 * bk + 8 * lg) : make_uint4(0u, 0u, 0u, 0u);
#pragma unroll
          for (int nt = 0; nt < 4; ++nt)
            X[mt][nt] = __builtin_amdgcn_mfma_f32_16x16x32_bf16(as_frag(afr), as_frag(bfr[nt]), X[mt][nt], 0, 0, 0);
        }
        __builtin_amdgcn_wave_barrier();
      }
    }
    __syncthreads();
#pragma unroll
    for (int q = 0; q < 4; ++q) {
      const int id = tid + 256 * q;
      *(uint4*)(PP->Wfrag + ((size_t)unit * 1024 + id) * 8) = *(const uint4*)(smem + id * 16);
      if (q < 2) *(uint4*)((char*)PP->Ufrag + (size_t)unit * 8192 + id * 16) = *(const uint4*)(smem + 16384 + id * 16);
    }
  }
}


__device__ __forceinline__ void phase_scan(char* smem) {
  const KP PP = get_params();
  const int tid = TID(), lane = tid & 63, wv = tid >> 6;
  __builtin_amdgcn_s_setprio(3);
  for (int item = BID(); item < 128; item += gridDim.x) {
    const int u16i = (item & 7) * 2 + (item >> 6), slice = (item >> 3) & 7;
    const size_t ubase = (size_t)u16i * NCHUNK;
    const uint4* Wg = (const uint4*)PP->Wfrag;
    const uint4* Kg = (const uint4*)PP->KdT;
    __syncthreads();
    if (wv != 0) {
      const int j0 = wv - 1;
      uint4 st0[11], st1[11], st2[11];
#pragma unroll
      for (int i = 0; i < 11; ++i) { st0[i] = make_uint4(0u, 0u, 0u, 0u); st1[i] = st0[i]; st2[i] = st0[i]; }
      const uint4* U8g = (const uint4*)PP->Ufrag;
      float gl0 = 0.f, gl1 = 0.f, gl2 = 0.f;
#define LLOAD(ST, GL, UNIT)                                                                                  \
  _Pragma("unroll") for (int i = 0; i < 11; ++i) {                                                           \
    const int q = j0 + 3 * i;                                                                                \
    ST[i] = *((q < 16 ? Wg + (UNIT) * 1024 + q * 64                                                          \
                      : (q < 32 ? Kg + (UNIT) * 1024 + (q - 16) * 64 : U8g + ((UNIT) * 8 + slice) * 64)) + lane); \
  }                                                                                                          \
  if (j0 == 2) GL = PP->glast[UNIT];
#define LWRITE(ST, GL, SLOTI)                                                                                \
  _Pragma("unroll") for (int i = 0; i < 11; ++i) {                                                           \
    const int q = j0 + 3 * i;                                                                                \
    char* d_ = (q < 32) ? smem + (SLOTI) * 32768 + q * 1024 : smem + 65536 + (SLOTI) * 1024;                 \
    *(uint4*)(d_ + lane * 16) = ST[i];                                                                       \
  }                                                                                                          \
  if (j0 == 2 && lane == 0) *(float*)(smem + 67584 + (SLOTI) * 4) = GL;
      LLOAD(st0, gl0, ubase);
      LLOAD(st1, gl1, ubase + 1);
      LLOAD(st2, gl2, ubase + 2);
      LWRITE(st0, gl0, 0);
      LLOAD(st0, gl0, ubase + 3);
      __syncthreads();
#define LSTEP(ST, GL, C)                                                               \
  {                                                                                    \
    LWRITE(ST, GL, ((C) + 1) & 1);                                                     \
    LLOAD(ST, GL, ubase + (size_t)(((C) + 4 < NCHUNK) ? (C) + 4 : NCHUNK - 1));        \
    __syncthreads();                                                                   \
  }
      for (int c0 = 0; c0 < NCHUNK; c0 += 3) {
        LSTEP(st1, gl1, c0);
        LSTEP(st2, gl2, c0 + 1);
        LSTEP(st0, gl0, c0 + 2);
      }
#undef LSTEP
#undef LLOAD
#undef LWRITE
    } else {
      f32x4 S[8];
#pragma unroll
      for (int t = 0; t < 8; ++t) S[t] = (f32x4){0.f, 0.f, 0.f, 0.f};
#define CSTEP(C)                                                                                                   \
  {                                                                                                                    \
    const int c = (C);                                                                                                 \
    const size_t unit = ubase + c;                                                                                     \
    const char* slot = smem + (c & 1) * 32768;                                                                         \
      \
    uint4 wf[4][4];                                                                                                    \
    _Pragma("unroll") for (int mt = 0; mt < 4; ++mt)                                                                   \
      _Pragma("unroll") for (int s2 = 0; s2 < 4; ++s2) wf[mt][s2] = *(const uint4*)(slot + (mt * 4 + s2) * 1024 + lane * 16); \
    const uint4 u8 = *(const uint4*)(smem + 65536 + (c & 1) * 1024 + lane * 16);     \
    __builtin_amdgcn_sched_barrier(0);                                                                                 \
    const float el = __expf(*(const float*)(smem + 67584 + (c & 1) * 4));                                              \
    uint4 sb[4];                                                                                                       \
    _Pragma("unroll") for (int s2 = 0; s2 < 4; ++s2) sb[s2] = pack_tiles(S[2 * s2], S[2 * s2 + 1]);                    \
    {                                                                                                                  \
      uint4* sp = (uint4*)PP->Sfrag + (unit * 8 + slice) * 256 + lane;                                                 \
      _Pragma("unroll") for (int s2 = 0; s2 < 4; ++s2) NT_STORE4(sp + s2 * 64, sb[s2]);     \
    }                                                                                                                  \
    f32x4 vn[4];                                                                                                       \
    _Pragma("unroll") for (int mt = 0; mt < 4; ++mt) {                                                                 \
      {                                                                                                                \
        const unsigned uw_ = (mt == 0) ? u8.x : (mt == 1) ? u8.y : (mt == 2) ? u8.z : u8.w;                             \
        const f32x2 lo_ = __builtin_amdgcn_cvt_pk_f32_fp8(uw_, false), hi_ = __builtin_amdgcn_cvt_pk_f32_fp8(uw_, true); \
        vn[mt] = (f32x4){lo_[0], lo_[1], hi_[0], hi_[1]};                                                              \
      }                                                                                                                \
      _Pragma("unroll") for (int s2 = 0; s2 < 4; ++s2) {                                                               \
        vn[mt] = __builtin_amdgcn_mfma_f32_16x16x32_bf16(as_frag(wf[mt][s2]), as_frag(sb[s2]), vn[mt], 0, 0, 0);       \
      }                                                                                                                \
    }                                                                                                                  \
      \
    uint4 kf[8][2];                                                                                                    \
    _Pragma("unroll") for (int t = 0; t < 8; ++t) {                                                                    \
      kf[t][0] = *(const uint4*)(slot + 16384 + (t * 2 + 0) * 1024 + lane * 16);                                       \
      kf[t][1] = *(const uint4*)(slot + 16384 + (t * 2 + 1) * 1024 + lane * 16);                                       \
    }                                                                                                                  \
    __builtin_amdgcn_sched_barrier(0);                                                                                 \
    uint4 vb[2];                                                                                                       \
    vb[0] = pack_tiles(vn[0], vn[1]);                                                                                  \
    vb[1] = pack_tiles(vn[2], vn[3]);                                                                                  \
    {                                                                                                                  \
      uint4* vp = (uint4*)PP->Vfrag + (unit * 8 + slice) * 128 + lane;                                                 \
      NT_STORE4(vp, vb[0]);                                                                                            \
      NT_STORE4(vp + 64, vb[1]);                                                                                       \
    }                                                                                                                  \
    _Pragma("unroll") for (int t = 0; t < 8; ++t) {                                                                    \
      S[t] *= el;                                                                                                      \
      S[t] = __builtin_amdgcn_mfma_f32_16x16x32_bf16(as_frag(kf[t][0]), as_frag(vb[0]), S[t], 0, 0, 0);                \
      S[t] = __builtin_amdgcn_mfma_f32_16x16x32_bf16(as_frag(kf[t][1]), as_frag(vb[1]), S[t], 0, 0, 0);                \
    }                                                                                                                  \
    __syncthreads();                                                                                                   \
  }
      __syncthreads();
      for (int c0 = 0; c0 < NCHUNK; c0 += 3) {
        CSTEP(c0);
        CSTEP(c0 + 1);
        CSTEP(c0 + 2);
      }
#undef CSTEP
    }
  }
  __builtin_amdgcn_s_setprio(0);
}

__device__ __forceinline__ void phase_o(int layer, char* smem) {
  const KP PP = get_params();
  const int tid = TID(), l = tid & 63, w = tid >> 6, lr = l & 15, lg = l >> 4;
  char* Qt = smem;
  char* Kt = smem + 16384;
  u16* If = (u16*)(smem + 32768);
  u16* Ib = (u16*)(smem + 41984);
  float* gcf = (float*)(smem + 51200);
  float* gcb = gcf + 64;
  float* rowss = gcb + 64;
  float* Os = (float*)smem;
  const int nper = (layer == DEPTH - 1) ? 128 : 132;
  const int xq = BID() & 7, vl0 = BID() >> 3, vstep = gridDim.x >> 3;
  for (int vi = vl0; vi < nper; vi += vstep) {
    int b = xq >> 2, hd = xq & 3, tok0, cf, cb;
    if (vi < 128) {
      const int n = vi;
      tok0 = b * SEQ + 64 * n; cf = 4 + n; cb = 4 + 127 - n;
    } else {
      const int n = vi - 128;
      tok0 = NLAT + b * CTX + 64 * n; cf = n; cb = 3 - n;
    }
    const size_t unit_f = (size_t)((b * 4 + hd) * 2 + 0) * NCHUNK + cf;
    const size_t unit_b = (size_t)((b * 4 + hd) * 2 + 1) * NCHUNK + cb;
    uint4 pSF[4][2], pSB[4][2], pVF[2][2], pVB[2][2];
#pragma unroll
    for (int q = 0; q < 2; ++q) {
      const int sl = 2 * w + q;
#pragma unroll
      for (int s = 0; s < 4; ++s) {
        pSF[s][q] = nt_load4((const uint4*)PP->Sfrag + ((unit_f * 8 + sl) * 4 + s) * 64 + l);
        pSB[s][q] = nt_load4((const uint4*)PP->Sfrag + ((unit_b * 8 + sl) * 4 + s) * 64 + l);
      }
#pragma unroll
      for (int s2 = 0; s2 < 2; ++s2) {
        pVF[s2][q] = nt_load4((const uint4*)PP->Vfrag + ((unit_f * 8 + sl) * 2 + s2) * 64 + l);
        pVB[s2][q] = nt_load4((const uint4*)PP->Vfrag + ((unit_b * 8 + sl) * 2 + s2) * 64 + l);
      }
    }
    __syncthreads();
    for (int idx = tid; idx < 2048; idx += NTHR) {
      const int arr = idx >> 10, i = (idx >> 4) & 63, ch = idx & 15;
      const uint4 v = *(const uint4*)(PP->qkvn + (size_t)(tok0 + i) * 1536 + (arr == 0 ? 0 : 512) + hd * 128 + ch * 8);
      *(uint4*)((arr == 0 ? Qt : Kt) + i * 256 + ((ch ^ (i & 15)) << 4)) = v;
    }
    if (tid < 64) gcf[tid] = PP->gc[unit_f * 64 + tid];
    else if (tid < 128) gcb[tid - 64] = PP->gc[unit_b * 64 + (tid - 64)];
    __syncthreads();
    {
      f32x4 acc[4];
#pragma unroll
      for (int nt = 0; nt < 4; ++nt) acc[nt] = (f32x4){0.f, 0.f, 0.f, 0.f};
#pragma unroll
      for (int s = 0; s < 4; ++s) {
        const int ch = s * 4 + lg;
        const bf16x8 a = *(const bf16x8*)(Qt + (16 * w + lr) * 256 + ((ch ^ lr) << 4));
#pragma unroll
        for (int nt = 0; nt < 4; ++nt) {
          const bf16x8 bb = *(const bf16x8*)(Kt + (16 * nt + lr) * 256 + ((ch ^ lr) << 4));
          acc[nt] = __builtin_amdgcn_mfma_f32_16x16x32_bf16(a, bb, acc[nt], 0, 0, 0);
        }
      }
#pragma unroll
      for (int nt = 0; nt < 4; ++nt)
#pragma unroll
        for (int r = 0; r < 4; ++r) {
          const int i = 16 * w + 4 * lg + r, j = 16 * nt + lr;
          const float vf = (j <= i) ? acc[nt][r] * __expf(fminf(gcf[i] - gcf[j], 0.f)) : 0.f;
          const float vb = (j >= i) ? acc[nt][r] * __expf(fminf(gcb[63 - i] - gcb[63 - j], 0.f)) : 0.f;
          If[i * 72 + j] = f2bf(vf);
          Ib[i * 72 + (63 - j)] = f2bf(vb);
        }
    }
    __syncthreads();
    f32x4 accF[4][2], accB[4][2], accI[4][2];
#pragma unroll
    for (int mt = 0; mt < 4; ++mt)
#pragma unroll
      for (int q = 0; q < 2; ++q) {
        accF[mt][q] = (f32x4){0.f, 0.f, 0.f, 0.f};
        accB[mt][q] = (f32x4){0.f, 0.f, 0.f, 0.f};
        accI[mt][q] = (f32x4){0.f, 0.f, 0.f, 0.f};
      }
#pragma unroll
    for (int s = 0; s < 4; ++s) {
      bf16x8 qa[4];
#pragma unroll
      for (int mt = 0; mt < 4; ++mt) {
        const int row = 16 * mt + lr;
        const int c0 = 4 * s + (lg >> 1), c1 = c0 + 2;
        const uint2 lo = *(const uint2*)(Qt + row * 256 + ((c0 ^ lr) << 4) + (lg & 1) * 8);
        const uint2 hi = *(const uint2*)(Qt + row * 256 + ((c1 ^ lr) << 4) + (lg & 1) * 8);
        const uint4 t = make_uint4(lo.x, lo.y, hi.x, hi.y);
        qa[mt] = as_frag(t);
      }
#pragma unroll
      for (int q = 0; q < 2; ++q) {
        const int sl = 2 * w + q;
        const uint4 bF = pSF[s][q], bB = pSB[s][q];
#pragma unroll
        for (int mt = 0; mt < 4; ++mt) {
          accF[mt][q] = __builtin_amdgcn_mfma_f32_16x16x32_bf16(qa[mt], as_frag(bF), accF[mt][q], 0, 0, 0);
          accB[mt][q] = __builtin_amdgcn_mfma_f32_16x16x32_bf16(qa[mt], as_frag(bB), accB[mt][q], 0, 0, 0);
        }
      }
    }
#pragma unroll
    for (int s2 = 0; s2 < 2; ++s2) {
      bf16x8 ia[4], ib[4];
#pragma unroll
      for (int mt = 0; mt < 4; ++mt) {
        const int row = 16 * mt + lr;
        const int col = 32 * s2 + 4 * lg;
        const uint2 flo = *(const uint2*)(If + row * 72 + col);
        const uint2 fhi = *(const uint2*)(If + row * 72 + col + 16);
        const uint2 blo = *(const uint2*)(Ib + row * 72 + col);
        const uint2 bhi = *(const uint2*)(Ib + row * 72 + col + 16);
        const uint4 tf = make_uint4(flo.x, flo.y, fhi.x, fhi.y);
        const uint4 tb = make_uint4(blo.x, blo.y, bhi.x, bhi.y);
        ia[mt] = as_frag(tf);
        ib[mt] = as_frag(tb);
      }
#pragma unroll
      for (int q = 0; q < 2; ++q) {
        const int sl = 2 * w + q;
        const uint4 vF = pVF[s2][q], vB = pVB[s2][q];
#pragma unroll
        for (int mt = 0; mt < 4; ++mt) {
          accI[mt][q] = __builtin_amdgcn_mfma_f32_16x16x32_bf16(ia[mt], as_frag(vF), accI[mt][q], 0, 0, 0);
          accI[mt][q] = __builtin_amdgcn_mfma_f32_16x16x32_bf16(ib[mt], as_frag(vB), accI[mt][q], 0, 0, 0);
        }
      }
    }
    float o[4][2][4], ssr[4][4];
#pragma unroll
    for (int mt = 0; mt < 4; ++mt)
#pragma unroll
      for (int r = 0; r < 4; ++r) {
        const int i = 16 * mt + 4 * lg + r;
        const float ef = __expf(gcf[i]), eb = __expf(gcb[63 - i]);
        float ss = 0.f;
#pragma unroll
        for (int q = 0; q < 2; ++q) {
          const float v = ef * accF[mt][q][r] + eb * accB[mt][q][r] + accI[mt][q][r];
          o[mt][q][r] = v;
          ss += v * v;
        }
        ssr[mt][r] = ss;
      }
#define O_RED(O_)                                                                  \
    _Pragma("unroll") for (int mt = 0; mt < 4; ++mt)                               \
      _Pragma("unroll") for (int r = 0; r < 4; ++r) ssr[mt][r] += swz_xor<O_>(ssr[mt][r]);
    O_RED(8) O_RED(4) O_RED(2) O_RED(1)
#undef O_RED
    if (lr == 0) {
#pragma unroll
      for (int mt = 0; mt < 4; ++mt)
#pragma unroll
        for (int r = 0; r < 4; ++r) rowss[w * 64 + 16 * mt + 4 * lg + r] = ssr[mt][r];
    }
    __syncthreads();
#pragma unroll
    for (int mt = 0; mt < 4; ++mt)
#pragma unroll
      for (int q = 0; q < 2; ++q)
#pragma unroll
        for (int r = 0; r < 4; ++r) Os[(16 * mt + 4 * lg + r) * 132 + 16 * (2 * w + q) + lr] = o[mt][q][r];
    __syncthreads();
#pragma unroll
    for (int q4 = 0; q4 < 4; ++q4) {
      const int idx = tid + 256 * q4, i = idx >> 4, ch = idx & 15;
      const float ss = rowss[i] + rowss[64 + i] + rowss[128 + i] + rowss[192 + i];
      const float rs = rsqrtf(ss * (1.f / 128.f) + EPS);
      const float4 o0 = *(const float4*)&Os[i * 132 + ch * 8];
      const float4 o1 = *(const float4*)&Os[i * 132 + ch * 8 + 4];
      const float4 n0 = *(const float4*)(PP->dn_out_norm + layer * 128 + ch * 8);
      const float4 n1 = *(const float4*)(PP->dn_out_norm + layer * 128 + ch * 8 + 4);
      float zf[8];
      unpack8(*(const uint4*)(PP->z + (size_t)(tok0 + i) * 512 + hd * 128 + ch * 8), zf);
      float y[8];
      y[0] = o0.x * rs * n0.x * siluf_(zf[0]); y[1] = o0.y * rs * n0.y * siluf_(zf[1]);
      y[2] = o0.z * rs * n0.z * siluf_(zf[2]); y[3] = o0.w * rs * n0.w * siluf_(zf[3]);
      y[4] = o1.x * rs * n1.x * siluf_(zf[4]); y[5] = o1.y * rs * n1.y * siluf_(zf[5]);
      y[6] = o1.z * rs * n1.z * siluf_(zf[6]); y[7] = o1.w * rs * n1.w * siluf_(zf[7]);
      {
        int p0 = __builtin_amdgcn_cvt_pk_fp8_f32(y[0], y[1], 0, false);
        p0 = __builtin_amdgcn_cvt_pk_fp8_f32(y[2], y[3], p0, true);
        int p1 = __builtin_amdgcn_cvt_pk_fp8_f32(y[4], y[5], 0, false);
        p1 = __builtin_amdgcn_cvt_pk_fp8_f32(y[6], y[7], p1, true);
        *(int2*)((char*)PP->ydn + (size_t)(tok0 + i) * (LDK5 * 2) + hd * 128 + ch * 8) = make_int2(p0, p1);
      }
    }
  }
}

template <int HALF>
DEV void pool_window(const u16* xin, char* Ap, int t0, int L, int tid) {
#pragma unroll
  for (int q = 0; q < 4; ++q) {
    const int idx = tid + 256 * q, i = idx >> 4, c = idx & 15;
    const int t = t0 + i;
    const int lo = (t - HALF) > 0 ? (t - HALF) : 0;
    const int hi = (t + HALF) < L ? (t + HALF) : L;
    float s[8];
#pragma unroll
    for (int e = 0; e < 8; ++e) s[e] = 0.f;
#pragma unroll
    for (int k = 0; k < 2 * HALF; ++k) {
      float f[8];
      unpack8(*(const uint4*)(xin + (i + 8 - HALF + k) * 128 + c * 8), f);
#pragma unroll
      for (int e = 0; e < 8; ++e) s[e] += f[e];
    }
    float xs[8];
    unpack8(*(const uint4*)(xin + (i + 8) * 128 + c * 8), xs);
    const float inv = 1.f / (float)(hi - lo);
#pragma unroll
    for (int e = 0; e < 8; ++e) s[e] = s[e] * inv - xs[e];
    *(uint4*)(Ap + i * 256 + ((c ^ (i & 15)) << 4)) = pack8(s);
  }
}

__device__ __forceinline__ void phase_pool(int layer, char* smem, int vbid, int vnb) {
  const KP PP = get_params();
  const int tid = TID(), l = tid & 63, w = tid >> 6, lr = l & 15, lg = l >> 4;
  u16* xin = (u16*)smem;
  char* Ap = smem + 20480;
  char* Bs = smem + 36864;
  const int ntile = (layer == DEPTH - 1) ? NLAT / 64 : R / 64;
  for (int it = vbid; it < ntile * 4; it += vnb) {
    const int ti = it >> 2, g = it & 3;
    int L, t0, rowbase;
    if (ti < NLAT / 64) { L = 64; t0 = 0; rowbase = ti * 64; }
    else { const int ci = ti - NLAT / 64; L = CTX; t0 = (ci & 3) * 64; rowbase = NLAT + (ci >> 2) * CTX; }
    const int r0 = rowbase + t0;
    __syncthreads();
#pragma unroll
    for (int q = 0; q < 5; ++q) {
      const int idx = tid + 256 * q, i = idx >> 4, c = idx & 15;
      const int pos = t0 - 8 + i;
      uint4 v = make_uint4(0, 0, 0, 0);
      if (pos >= 0 && pos < L) v = *(const uint4*)(PP->pin + (size_t)(rowbase + pos) * 512 + g * 128 + c * 8);
      *(uint4*)(xin + i * 128 + c * 8) = v;
    }
    {
      const u16* Bw = PP->PwT + (size_t)(layer * 4 + g) * 128 * 128;
#pragma unroll
      for (int q = 0; q < 8; ++q) {
        const int idx = tid + 256 * q, n = idx >> 4, c = idx & 15;
        *(uint4*)(Bs + n * 256 + ((c ^ (n & 15)) << 4)) = *(const uint4*)(Bw + (size_t)n * 128 + c * 8);
      }
    }
    __syncthreads();
    if (g == 0) pool_window<1>(xin, Ap, t0, L, tid);
    else if (g == 1) pool_window<2>(xin, Ap, t0, L, tid);
    else if (g == 2) pool_window<4>(xin, Ap, t0, L, tid);
    else pool_window<8>(xin, Ap, t0, L, tid);
    __syncthreads();
    f32x4 acc[8];
#pragma unroll
    for (int ni = 0; ni < 8; ++ni) acc[ni] = (f32x4){0.f, 0.f, 0.f, 0.f};
#pragma unroll
    for (int ks = 0; ks < 4; ++ks) {
      const int row = w * 16 + lr, c = ks * 4 + lg;
      const bf16x8 a = *(const bf16x8*)(Ap + row * 256 + ((c ^ lr) << 4));
#pragma unroll
      for (int ni = 0; ni < 8; ++ni) {
        const bf16x8 bb = *(const bf16x8*)(Bs + (ni * 16 + lr) * 256 + ((c ^ lr) << 4));
        acc[ni] = __builtin_amdgcn_mfma_f32_16x16x32_bf16(bb, a, acc[ni], 0, 0, 0);
      }
    }
    unsigned char* ot = (unsigned char*)smem;
#pragma unroll
    for (int ni = 0; ni < 8; ++ni) {
      const int dcol = ni * 16 + 4 * lg;
      const float4 psc = *(const float4*)(PP->pool_scale + layer * 512 + g * 128 + dcol);
      int pk = __builtin_amdgcn_cvt_pk_fp8_f32(acc[ni][0] * psc.x, acc[ni][1] * psc.y, 0, false);
      pk = __builtin_amdgcn_cvt_pk_fp8_f32(acc[ni][2] * psc.z, acc[ni][3] * psc.w, pk, true);
      *(int*)(ot + (w * 16 + lr) * 128 + dcol) = pk;
    }
    __syncthreads();
    {
      const int row = tid >> 2, seg = tid & 3;
      const uint4 o0 = *(const uint4*)(ot + row * 128 + seg * 32), o1 = *(const uint4*)(ot + row * 128 + seg * 32 + 16);
      unsigned char* dst = (unsigned char*)PP->ypool + (size_t)(r0 + row) * (LDK5 * 2) + g * 128 + seg * 32;
      *(uint4*)dst = o0;
      *(uint4*)(dst + 16) = o1;
    }
  }
}

__device__ __forceinline__ void phase_merge(int layer, char* smem) {
  const KP PP = get_params();
  const char* Bd = (const char*)(PP->WdT + (size_t)layer * 1024 * LDK5);
  const char* Bp = (const char*)(PP->WpT + (size_t)layer * 1024 * LDK5);
  const char* Ad = (const char*)PP->ydn;
  const char* Ap = (const char*)PP->ypool;
  const int tid = TID();
  const int l = tid & 63, w = tid >> 6, wm = w >> 1, wn = w & 1, lr = l & 15, lg = l >> 4;
  uint4 ga[4], gb[4];
#pragma unroll
  for (int i = 0; i < 4; ++i) { ga[i] = make_uint4(0u, 0u, 0u, 0u); gb[i] = ga[i]; }
  const int r0 = tid >> 3, c0 = tid & 7;
#define MG_GLOAD(AP, BP, KT_)                                                                  \
  _Pragma("unroll") for (int i = 0; i < 4; ++i) {                                              \
    ga[i] = *(const uint4*)((AP) + (size_t)(m0 + 32 * i + r0) * (LDK5 * 2) + c0 * 16 + (KT_) * 128);  \
    gb[i] = *(const uint4*)((BP) + (size_t)(n0 + 32 * i + r0) * LDK5 + c0 * 16 + (KT_) * 128);        \
  }
#define MG_LSTORE(BUF)                                                                         \
  {                                                                                            \
    char* as_ = smem + (BUF) * 32768;                                                          \
    char* bs_ = as_ + 16384;                                                                   \
    _Pragma("unroll") for (int i = 0; i < 4; ++i) {                                            \
      const int id = tid + 256 * i, row = id >> 3, c = id & 7;                                 \
      const int off = row * 128 + ((c ^ (row & 7)) << 4);                                      \
      *(uint4*)(as_ + off) = ga[i];                                                            \
      *(uint4*)(bs_ + off) = gb[i];                                                            \
    }                                                                                          \
  }
#define MG_COMPUTE(ACC, BUF)                                                                                              \
  {                                                                                                                       \
    const char* as_ = smem + (BUF) * 32768;                                                                               \
    const char* bs_ = as_ + 16384;                                                                                        \
    i32x8 a[4], b[4];                                                                                                     \
    const int sw0 = ((lg ^ (lr & 7)) << 4), sw1 = (((4 + lg) ^ (lr & 7)) << 4);                                           \
    _Pragma("unroll") for (int mi = 0; mi < 4; ++mi) {                                                                    \
      const char* p_ = as_ + (wm * 64 + mi * 16 + lr) * 128;                                                              \
      const i32x4 lo_ = *(const i32x4*)(p_ + sw0), hi_ = *(const i32x4*)(p_ + sw1);                                       \
      a[mi] = __builtin_shufflevector(lo_, hi_, 0, 1, 2, 3, 4, 5, 6, 7);                                                  \
    }                                                                                                                     \
    _Pragma("unroll") for (int ni = 0; ni < 4; ++ni) {                                                                    \
      const char* p_ = bs_ + (wn * 64 + ni * 16 + lr) * 128;                                                              \
      const i32x4 lo_ = *(const i32x4*)(p_ + sw0), hi_ = *(const i32x4*)(p_ + sw1);                                       \
      b[ni] = __builtin_shufflevector(lo_, hi_, 0, 1, 2, 3, 4, 5, 6, 7);                                                  \
    }                                                                                                                     \
    _Pragma("unroll") for (int mi = 0; mi < 4; ++mi)                                                                      \
      _Pragma("unroll") for (int ni = 0; ni < 4; ++ni)                                                                    \
        ACC[mi][ni] = __builtin_amdgcn_mfma_scale_f32_16x16x128_f8f6f4(a[mi], b[ni], ACC[mi][ni], 0, 0, 0, 0, 0, 0);      \
  }
  const int MT = (layer == DEPTH - 1) ? NLAT / 128 : R / 128;
  for (int it = 0;; ++it) {
    int mt, nt;
    if (!tile_map(it, MT, 8, mt, nt)) break;
    const int m0 = mt * 128, n0 = nt * 128;
    f32x4 acc[4][4];
    zero_acc(acc);
    __syncthreads();
    MG_GLOAD(Ad, Bd, 0);
    MG_LSTORE(0);
    __syncthreads();
#pragma unroll
    for (int kt = 0; kt < 4; ++kt) {
      if (kt + 1 < 4) { MG_GLOAD(Ad, Bd, kt + 1); } else { MG_GLOAD(Ap, Bp, 0); }
      MG_COMPUTE(acc, kt & 1);
      MG_LSTORE((kt + 1) & 1);
      __syncthreads();
    }
    uint2 tq[2][8];
#pragma unroll
    for (int hs = 0; hs < 2; ++hs)
#pragma unroll
      for (int j = 0; j < 8; ++j) tq[hs][j] = make_uint2(0u, 0u);
#pragma unroll
    for (int hs = 0; hs < 2; ++hs) {
      float4 v1[8];
      stage_half(acc, hs, smem + 32768, v1);
#pragma unroll
      for (int j = 0; j < 8; ++j) tq[hs][j] = make_uint2(pack_bf16(v1[j].x, v1[j].y), pack_bf16(v1[j].z, v1[j].w));
    }
    __builtin_amdgcn_sched_barrier(0);
    zero_acc(acc);
    __syncthreads();
#pragma unroll
    for (int kt = 0; kt < 4; ++kt) {
      if (kt + 1 < 4) { MG_GLOAD(Ap, Bp, kt + 1); }
      MG_COMPUTE(acc, kt & 1);
      if (kt + 1 < 4) { MG_LSTORE((kt + 1) & 1); }
      __syncthreads();
    }
#pragma unroll
    for (int hs = 0; hs < 2; ++hs) {
      float4 v2[8];
      stage_half(acc, hs, smem, v2);
      const int tid2 = TID();
#pragma unroll
      for (int j = 0; j < 8; ++j) {
        const int idx = tid2 + 256 * j, row = idx >> 5, c4 = idx & 31;
        const size_t gr = (size_t)(m0 + hs * 64 + row);
        const int gc = n0 + c4 * 4;
        const unsigned gd = __builtin_nontemporal_load((const unsigned*)((const unsigned char*)PP->sgd + gr * 1024 + gc));
        const unsigned gp = __builtin_nontemporal_load((const unsigned*)((const unsigned char*)PP->sgp + gr * 1024 + gc));
        const uint2 t = tq[hs][j];
        constexpr float GS = 1.f / (255.f * 32.f);
        const float o0 = ((float)(gd & 0xffu) * bf_lo(t.x) + (float)(gp & 0xffu) * v2[j].x) * GS;
        const float o1 = ((float)((gd >> 8) & 0xffu) * bf_hi(t.x) + (float)((gp >> 8) & 0xffu) * v2[j].y) * GS;
        const float o2 = ((float)((gd >> 16) & 0xffu) * bf_lo(t.y) + (float)((gp >> 16) & 0xffu) * v2[j].z) * GS;
        const float o3 = ((float)(gd >> 24) * bf_hi(t.y) + (float)(gp >> 24) * v2[j].w) * GS;
        int pk = __builtin_amdgcn_cvt_pk_fp8_f32(o0, o1, 0, false);
        pk = __builtin_amdgcn_cvt_pk_fp8_f32(o2, o3, pk, true);
        *(int*)((char*)PP->m + gr * (LDK1 * 2) + gc) = pk;
        if ((j & 1) == 1) __builtin_amdgcn_sched_barrier(0);
      }
    }
  }
#undef MG_GLOAD
#undef MG_LSTORE
#undef MG_COMPUTE
}

__device__ __forceinline__ void phase_outproj(int layer, char* smem) {
  const KP PP = get_params();
  const char* Bt = (const char*)(PP->WoT + (size_t)layer * 1024 * LDK1);
  const char* A = (const char*)PP->m;
  F8_LOCALS
  const int MT = (layer == DEPTH - 1) ? NLAT / 128 : R / 128;
  int it = 0, mt, nt;
  if (!tile_map(it, MT, 8, mt, nt)) return;
  int m0 = mt * 128, n0 = nt * 128;
  F8_PROLOGUE(A, LDK1 * 2, Bt, LDK1)
  for (;;) {
    int mtn = 0, ntn = 0;
    const bool hasn = tile_map(it + 1, MT, 8, mtn, ntn);
    const int m0n = mtn * 128, n0n = ntn * 128;
    f32x4 acc[4][4];
    zero_acc(acc);
    F8_KLOOP(A, LDK1 * 2, Bt, LDK1, 8)
#pragma unroll
    for (int mi = 0; mi < 4; ++mi) {
      const int gr = m0 + wm * 64 + mi * 16 + lr;
      const float* modp = PP->mod + (size_t)(layer * 3 + modsel(gr)) * 6144 + 2048;
      const float* xin32 = (gr < NLAT) ? PP->x + (size_t)gr * 1024 : PP->ctx + (size_t)(gr - NLAT) * 1024;
      u16* xrow = PP->xb + (size_t)gr * 1024;
#pragma unroll
      for (int g = 0; g < 2; ++g) {
        const int gc = n0 + wn * 64 + g * 32 + 8 * lg;
        float xi[8];
        if (layer == 0) {
          const float4 a0 = *(const float4*)(xin32 + gc), a1 = *(const float4*)(xin32 + gc + 4);
          xi[0] = a0.x; xi[1] = a0.y; xi[2] = a0.z; xi[3] = a0.w; xi[4] = a1.x; xi[5] = a1.y; xi[6] = a1.z; xi[7] = a1.w;
        } else {
          unpack8(*(const uint4*)(xrow + gc), xi);
        }
        const float4 g0 = *(const float4*)(modp + gc), g1 = *(const float4*)(modp + gc + 4);
        const f32x4 t0 = acc[mi][2 * g] * (1.f / 32.f), t1 = acc[mi][2 * g + 1] * (1.f / 32.f);
        float xo[8];
        xo[0] = xi[0] + g0.x * t0[0]; xo[1] = xi[1] + g0.y * t0[1]; xo[2] = xi[2] + g0.z * t0[2]; xo[3] = xi[3] + g0.w * t0[3];
        xo[4] = xi[4] + g1.x * t1[0]; xo[5] = xi[5] + g1.y * t1[1]; xo[6] = xi[6] + g1.z * t1[2]; xo[7] = xi[7] + g1.w * t1[3];
        *(uint4*)(xrow + gc) = pack8(xo);
      }
    }
    if (!hasn) break;
    m0 = m0n; n0 = n0n; ++it;
  }
}

DEV void gemm_mainloop_f8(const char* __restrict__ A, int lda, const char* __restrict__ B, int ldb, int KT, int m0, int n0,
                          char* smem, f32x4 (&acc)[4][4]) {
  const int tid = TID();
  const int l = tid & 63, w = tid >> 6, wm = w >> 1, wn = w & 1, lr = l & 15, lg = l >> 4;
  uint4 ga0[4], gb0[4], ga1[4], gb1[4];
#pragma unroll
  for (int i = 0; i < 4; ++i) { ga0[i] = make_uint4(0u, 0u, 0u, 0u); gb0[i] = ga0[i]; ga1[i] = ga0[i]; gb1[i] = ga0[i]; }
  const int r0 = tid >> 3, c0 = tid & 7;
#define Q8_GLOAD(GA, GB, KT_)                                                                  \
  _Pragma("unroll") for (int i = 0; i < 4; ++i) {                                              \
    GA[i] = *(const uint4*)(A + (size_t)(m0 + 32 * i + r0) * lda + c0 * 16 + (KT_) * 128);     \
    GB[i] = *(const uint4*)(B + (size_t)(n0 + 32 * i + r0) * ldb + c0 * 16 + (KT_) * 128);     \
  }
#define Q8_LSTORE(GA, GB, BUF)                                                                 \
  {                                                                                            \
    char* as_ = smem + (BUF) * 32768;                                                          \
    char* bs_ = as_ + 16384;                                                                   \
    _Pragma("unroll") for (int i = 0; i < 4; ++i) {                                            \
      const int id = tid + 256 * i, row = id >> 3, c = id & 7;                                 \
      const int off = row * 128 + ((c ^ (row & 7)) << 4);                                      \
      *(uint4*)(as_ + off) = GA[i];                                                            \
      *(uint4*)(bs_ + off) = GB[i];                                                            \
    }                                                                                          \
  }
#define Q8_COMPUTE(BUF)                                                                                                   \
  {                                                                                                                       \
    const char* as_ = smem + (BUF) * 32768;                                                                               \
    const char* bs_ = as_ + 16384;                                                                                        \
    i32x8 a[4], b[4];                                                                                                     \
    const int sw0 = ((lg ^ (lr & 7)) << 4), sw1 = (((4 + lg) ^ (lr & 7)) << 4);                                           \
    _Pragma("unroll") for (int mi = 0; mi < 4; ++mi) {                                                                    \
      const char* p_ = as_ + (wm * 64 + mi * 16 + lr) * 128;                                                              \
      const i32x4 lo_ = *(const i32x4*)(p_ + sw0), hi_ = *(const i32x4*)(p_ + sw1);                                       \
      a[mi] = __builtin_shufflevector(lo_, hi_, 0, 1, 2, 3, 4, 5, 6, 7);                                                  \
    }                                                                                                                     \
    _Pragma("unroll") for (int ni = 0; ni < 4; ++ni) {                                                                    \
      const char* p_ = bs_ + (wn * 64 + ni * 16 + lr) * 128;                                                              \
      const i32x4 lo_ = *(const i32x4*)(p_ + sw0), hi_ = *(const i32x4*)(p_ + sw1);                                       \
      b[ni] = __builtin_shufflevector(lo_, hi_, 0, 1, 2, 3, 4, 5, 6, 7);                                                  \
    }                                                                                                                     \
    _Pragma("unroll") for (int mi = 0; mi < 4; ++mi)                                                                      \
      _Pragma("unroll") for (int ni = 0; ni < 4; ++ni)                                                                    \
        acc[mi][ni] = __builtin_amdgcn_mfma_scale_f32_16x16x128_f8f6f4(a[mi], b[ni], acc[mi][ni], 0, 0, 0, 0, 0, 0);      \
  }
  __syncthreads();
  Q8_GLOAD(ga0, gb0, 0);
  Q8_GLOAD(ga1, gb1, 1);
  Q8_LSTORE(ga0, gb0, 0);
  __syncthreads();
  for (int kt = 0; kt < KT; kt += 2) {
    if (kt + 2 < KT) { Q8_GLOAD(ga0, gb0, kt + 2); }
    Q8_COMPUTE(0);
    Q8_LSTORE(ga1, gb1, 1);
    __syncthreads();
    if (kt + 3 < KT) { Q8_GLOAD(ga1, gb1, kt + 3); }
    Q8_COMPUTE(1);
    if (kt + 2 < KT) { Q8_LSTORE(ga0, gb0, 0); }
    __syncthreads();
  }
#undef Q8_GLOAD
#undef Q8_LSTORE
#undef Q8_COMPUTE
}

__device__ __forceinline__ void phase_peerq(int layer, char* smem) {
  const KP PP = get_params();
  const char* Bt = (const char*)PP->WkT + (size_t)layer * 2048 * LDK1;
  const int tid = TID();
  const int l = tid & 63, w = tid >> 6, wm = w >> 1, wn = w & 1, lr = l & 15, lg = l >> 4;
  const int MT = (layer == DEPTH - 1) ? NLAT / 128 : R / 128;
  for (int it = 0;; ++it) {
    int mt, nt;
    if (!tile_map(it, MT, 16, mt, nt)) break;
    const int m0 = mt * 128, n0 = nt * 128;
    f32x4 sc[4][4];
    zero_acc(sc);
    gemm_mainloop_f8((const char*)PP->h8, LDK1, Bt, LDK1, 8, m0, n0, smem, sc);
    __syncthreads();
    float* Sc = (float*)smem;
#pragma unroll
    for (int mi = 0; mi < 4; ++mi)
#pragma unroll
      for (int ni = 0; ni < 4; ++ni)
#pragma unroll
        for (int r = 0; r < 4; ++r) Sc[(wm * 64 + mi * 16 + lg * 4 + r) * 129 + wn * 64 + ni * 16 + lr] = sc[mi][ni][r] * (1.f / 32.f);
    __syncthreads();
    {
      const int row = tid >> 1, half = tid & 1;
      const float* rowp = Sc + row * 129;
      unsigned key[64];
#pragma unroll
      for (int i = 0; i < 64; ++i) {
        unsigned u = __float_as_uint(rowp[half * 64 + i]);
        u = (u & 0x80000000u) ? ~u : (u | 0x80000000u);
        key[i] = (u & ~127u) | (unsigned)(127 - (half * 64 + i));
      }
#define CMPX(X, Y, DESC) { const unsigned hi_ = (X) > (Y) ? (X) : (Y), lo_ = (X) > (Y) ? (Y) : (X); X = (DESC) ? hi_ : lo_; Y = (DESC) ? lo_ : hi_; }
#pragma unroll
      for (int g0 = 0; g0 < 64; g0 += 16) {
#pragma unroll
        for (int k = 2; k <= 16; k <<= 1)
#pragma unroll
          for (int j = k >> 1; j > 0; j >>= 1)
#pragma unroll
            for (int i = 0; i < 16; ++i) {
              const int l2 = i ^ j;
              if (l2 > i) CMPX(key[g0 + i], key[g0 + l2], ((i & k) == 0));
            }
      }
#define TOPMERGE(AOFF, BOFF)                                                                         \
  {                                                                                                  \
    _Pragma("unroll") for (int i = 0; i < 16; ++i)                                                   \
      key[(AOFF) + i] = key[(AOFF) + i] > key[(BOFF) + 15 - i] ? key[(AOFF) + i] : key[(BOFF) + 15 - i]; \
    _Pragma("unroll") for (int j = 8; j > 0; j >>= 1)                                                \
      _Pragma("unroll") for (int i = 0; i < 16; ++i) {                                               \
        const int l2 = i ^ j;                                                                        \
        if (l2 > i) CMPX(key[(AOFF) + i], key[(AOFF) + l2], true);                                   \
      }                                                                                              \
  }
      TOPMERGE(0, 16);
      TOPMERGE(32, 48);
      TOPMERGE(0, 32);
      {
        unsigned oth[16];
#pragma unroll
        for (int i = 0; i < 16; ++i) oth[i] = swz_xor_u<1>(key[i]);
#pragma unroll
        for (int i = 0; i < 16; ++i) key[i] = key[i] > oth[15 - i] ? key[i] : oth[15 - i];
#pragma unroll
        for (int j = 8; j > 0; j >>= 1)
#pragma unroll
          for (int i = 0; i < 16; ++i) {
            const int l2 = i ^ j;
            if (l2 > i) CMPX(key[i], key[l2], true);
          }
      }
#undef TOPMERGE
#undef CMPX
      unsigned res[16];
#pragma unroll
      for (int j = 0; j < 16; ++j) {
        const int idx = 127 - (int)(key[j] & 127u);
        res[j] = half ? (unsigned)idx : __float_as_uint(rowp[idx]);
      }
      const size_t ob = ((size_t)(m0 + row) * 16 + nt) * 16;
      uint4* dst = half ? (uint4*)(PP->topI + ob) : (uint4*)(PP->topS + ob);
      dst[0] = make_uint4(res[0], res[1], res[2], res[3]);
      dst[1] = make_uint4(res[4], res[5], res[6], res[7]);
      dst[2] = make_uint4(res[8], res[9], res[10], res[11]);
      dst[3] = make_uint4(res[12], res[13], res[14], res[15]);
    }
  }
}

DEV void pair_of_lane(int l, int& a, int& b) {
  if (l < 16) { a = 0; b = l; }
  else if (l < 24) { a = 1; b = l - 16; }
  else if (l < 29) { a = 2; b = l - 24; }
  else if (l < 33) { a = 3; b = l - 29; }
  else if (l < 36) { a = 4; b = l - 33; }
  else if (l < 38) { a = 5; b = l - 36; }
  else if (l < 40) { a = 6; b = l - 38; }
  else if (l < 42) { a = 7; b = l - 40; }
  else if (l < 50) { a = l - 34; b = 0; }
  else { a = 0; b = 0; }
}

DEV float peer_butterfly(const float (&part)[8], int lane) {
  const bool h32 = (lane & 32) != 0, h16 = (lane & 16) != 0, h8 = (lane & 8) != 0;
  const int a32 = (lane ^ 32) << 2;
  float q4[4], q2[2];
#pragma unroll
  for (int i = 0; i < 4; ++i) {
    const float keep = h32 ? part[i + 4] : part[i], send = h32 ? part[i] : part[i + 4];
    q4[i] = keep + __builtin_bit_cast(float, __builtin_amdgcn_ds_bpermute(a32, __builtin_bit_cast(int, send)));
  }
#pragma unroll
  for (int i = 0; i < 2; ++i) {
    const float keep = h16 ? q4[i + 2] : q4[i], send = h16 ? q4[i] : q4[i + 2];
    q2[i] = keep + swz_xor<16>(send);
  }
  const float keep = h8 ? q2[1] : q2[0], send = h8 ? q2[0] : q2[1];
  float q1 = keep + swz_xor<8>(send);
  q1 += swz_xor<4>(q1);
  q1 += swz_xor<2>(q1);
  q1 += swz_xor<1>(q1);
  return q1;
}

__device__ __forceinline__ void phase_peer(int layer, char* smem) {
  const KP PP = get_params();
  const int tid = TID(), lane = tid & 63, wv = tid >> 6;
  const int gw = BID() * 4 + wv, nw = gridDim.x * 4;
  int* elist = (int*)(smem + wv * 2048);
  float* glist = (float*)(elist + 128);
  const bool last = (layer == DEPTH - 1);
  const int rlim = last ? NLAT : R;
  int pa, pb;
  pair_of_lane(lane, pa, pb);
  for (int r = gw; r < rlim; r += nw) {
    f32x2 hp[8];
#pragma unroll
    for (int i = 0; i < 4; ++i) {
      const uint2 hv = *(const uint2*)(PP->h + (size_t)r * LDK1 + 4 * lane + 256 * i);
      hp[2 * i] = (f32x2){bf_lo(hv.x), bf_hi(hv.x)};
      hp[2 * i + 1] = (f32x2){bf_lo(hv.y), bf_hi(hv.y)};
    }
#ifndef PEER_REP
#define PEER_REP 1
#endif
    f32x2 out[8];
#pragma unroll
    for (int i = 0; i < 8; ++i) out[i] = (f32x2){0.f, 0.f};
#pragma nounroll
    for (int rep_ = 0; rep_ < PEER_REP; ++rep_) {
    float sreg[8];
    int ireg[8];
#pragma unroll
    for (int hh = 0; hh < 8; ++hh) {
      const size_t o = (size_t)r * 256 + hh * 32 + (lane & 31);
      sreg[hh] = PP->topS[o];
      ireg[hh] = PP->topI[o];
    }
#pragma unroll 2
    for (int hh = 0; hh < 8; ++hh) {
      float cs = __builtin_bit_cast(float, __builtin_amdgcn_ds_bpermute(pa << 2, __builtin_bit_cast(int, sreg[hh]))) +
                 __builtin_bit_cast(float, __builtin_amdgcn_ds_bpermute((16 + pb) << 2, __builtin_bit_cast(int, sreg[hh])));
      const int e = __builtin_amdgcn_ds_bpermute(pa << 2, ireg[hh]) * 128 + __builtin_amdgcn_ds_bpermute((16 + pb) << 2, ireg[hh]);
      if (lane >= 50) cs = -__builtin_inff();
      unsigned ku = __float_as_uint(cs);
      ku = (ku & 0x80000000u) ? ~ku : (ku | 0x80000000u);
      ku = (ku & ~63u) | (unsigned)(63 - lane);
      int rank = 0;
#pragma unroll
      for (int l2 = 0; l2 < 50; ++l2) {
        const unsigned kv = (unsigned)__builtin_amdgcn_readlane((int)ku, l2);
        rank += (kv > ku) ? 1 : 0;
      }
      const bool sel = (lane < 50) && (rank < 16);
      const float mx = __builtin_bit_cast(float, __builtin_amdgcn_readlane(__builtin_bit_cast(int, cs), 0));
      const float ex = sel ? __expf(cs - mx) : 0.f;
      const float sum = wave_sum(ex);
      const unsigned long long mask = __ballot(sel);
      if (sel) {
        const int pos = __builtin_popcountll(mask & ((1ull << lane) - 1ull));
        elist[hh * 16 + pos] = e;
        glist[hh * 16 + pos] = ex / sum;
      }
    }
    __builtin_amdgcn_wave_barrier();
    asm volatile("s_waitcnt lgkmcnt(0)" ::: "memory");
    for (int k0 = 0; k0 < 128; k0 += 8) {
      U3 ua[8], va[8];
#pragma unroll
      for (int b = 0; b < 8; ++b) {
        const int ek = __builtin_amdgcn_readfirstlane(elist[k0 + b]);
        ua[b] = *(const U3*)(PP->tab8U + (size_t)ek * TROW + lane * 12);
        va[b] = *(const U3*)(PP->tab8V + (size_t)ek * TROW + lane * 12);
      }
      const int eb = elist[k0 + (lane >> 3)];
      const float scu = PP->scU[eb], scv = PP->scV[eb];
      float part[8];
#pragma unroll
      for (int b = 0; b < 8; b += 2) {
        const u32x6_t s6 = {ua[b].a, ua[b].b, ua[b].c, ua[b + 1].a, ua[b + 1].b, ua[b + 1].c};
        const f32x32_t uf = __builtin_amdgcn_cvt_scalef32_pk32_f32_fp6(s6, 1.0f);
        f32x2 d0 = (f32x2){uf[0], uf[1]} * hp[0];
        f32x2 d1 = (f32x2){uf[16], uf[17]} * hp[0];
#pragma unroll
        for (int p = 1; p < 8; ++p) {
          d0 += (f32x2){uf[2 * p], uf[2 * p + 1]} * hp[p];
          d1 += (f32x2){uf[16 + 2 * p], uf[17 + 2 * p]} * hp[p];
        }
        part[b] = d0[0] + d0[1];
        part[b + 1] = d1[0] + d1[1];
      }
      float q1 = peer_butterfly(part, lane);
      q1 *= scu;
      const float act = scv * glist[k0 + (lane >> 3)] * 0.5f * q1 * (1.f + erff(q1 * 0.7071067811865475f));
#pragma unroll
      for (int b = 0; b < 8; b += 2) {
        const float ab0 = __builtin_bit_cast(float, __builtin_amdgcn_readlane(__builtin_bit_cast(int, act), b * 8));
        const float ab1 = __builtin_bit_cast(float, __builtin_amdgcn_readlane(__builtin_bit_cast(int, act), b * 8 + 8));
        const f32x2 a0 = {ab0, ab0}, a1 = {ab1, ab1};
        const u32x6_t s6 = {va[b].a, va[b].b, va[b].c, va[b + 1].a, va[b + 1].b, va[b + 1].c};
        const f32x32_t vf = __builtin_amdgcn_cvt_scalef32_pk32_f32_fp6(s6, 1.0f);
#pragma unroll
        for (int p = 0; p < 8; ++p) {
          out[p] += a0 * (f32x2){vf[2 * p], vf[2 * p + 1]};
          out[p] += a1 * (f32x2){vf[16 + 2 * p], vf[17 + 2 * p]};
        }
      }
    }
    __builtin_amdgcn_wave_barrier();
    }
    if (PEER_REP > 1) {
#pragma unroll
      for (int i = 0; i < 8; ++i) out[i] *= (1.f / PEER_REP);
    }
    const float* md = PP->mod + (size_t)(layer * 3 + modsel(r)) * 6144 + 5 * 1024;
    u16* xr = PP->xb + (size_t)r * 1024;
    float4 x2[4];
    float ss = 0.f;
#pragma unroll
    for (int i = 0; i < 4; ++i) {
      const int col = 4 * lane + 256 * i;
      const uint2 xt = *(const uint2*)(xr + col);
      const float4 xa = make_float4(bf_lo(xt.x), bf_hi(xt.x), bf_lo(xt.y), bf_hi(xt.y));
      const float4 ga = *(const float4*)(md + col);
      x2[i] = make_float4(xa.x + ga.x * out[2 * i][0], xa.y + ga.y * out[2 * i][1], xa.z + ga.z * out[2 * i + 1][0],
                          xa.w + ga.w * out[2 * i + 1][1]);
      ss += x2[i].x * x2[i].x + x2[i].y * x2[i].y + x2[i].z * x2[i].z + x2[i].w * x2[i].w;
    }
    if (last) {
      ss = wave_sum(ss);
      const float rs = rsqrtf(ss * (1.f / 1024.f) + EPS);
#pragma unroll
      for (int i = 0; i < 4; ++i) {
        const float4 fa = *(const float4*)(PP->final_norm + 4 * lane + 256 * i);
        x2[i] = make_float4(x2[i].x * rs * fa.x, x2[i].y * rs * fa.y, x2[i].z * rs * fa.z, x2[i].w * rs * fa.w);
      }
    }
    if (last) {
#pragma unroll
      for (int i = 0; i < 4; ++i) {
        const f32x4 ov = {x2[i].x, x2[i].y, x2[i].z, x2[i].w};
        __builtin_nontemporal_store(ov, (f32x4*)(PP->out + (size_t)r * 1024 + 4 * lane + 256 * i));
      }
    } else {
#pragma unroll
      for (int i = 0; i < 4; ++i) *(uint2*)(xr + 4 * lane + 256 * i) = make_uint2(pack_bf16(x2[i].x, x2[i].y), pack_bf16(x2[i].z, x2[i].w));
    }
    if (!last) {
      ss = wave_sum(ss);
      const float rs = rsqrtf(ss * (1.f / 1024.f) + EPS);
      const float* nwt = PP->norm_mix + (layer + 1) * 1024;
      const float* md1 = PP->mod + (size_t)((layer + 1) * 3 + modsel(r)) * 6144;
#pragma unroll
      for (int i = 0; i < 4; ++i) {
        const int col = 4 * lane + 256 * i;
        const float4 wv = *(const float4*)(nwt + col);
        const float4 sh = *(const float4*)(md1 + col);
        const float4 sc = *(const float4*)(md1 + 1024 + col);
        const float y0 = x2[i].x * rs * wv.x * (1.f + sc.x) + sh.x;
        const float y1 = x2[i].y * rs * wv.y * (1.f + sc.y) + sh.y;
        const float y2 = x2[i].z * rs * wv.z * (1.f + sc.z) + sh.z;
        const float y3 = x2[i].w * rs * wv.w * (1.f + sc.w) + sh.w;
        int pk = __builtin_amdgcn_cvt_pk_fp8_f32(y0, y1, 0, false);
        pk = __builtin_amdgcn_cvt_pk_fp8_f32(y2, y3, pk, true);
        *(int*)((char*)PP->h + (size_t)r * (LDK1 * 2) + col) = pk;
      }
    }
  }
}

namespace cg = cooperative_groups;

#define XB_TMO      128
#define XB_XCNT(j)  (256  + 64 * (j))
#define XB_XSUB(j)  (1280 + 64 * (j))
#define XB_XGEN(j)  (2304 + 64 * (j))
#define XB_TOP      3328
#define XB_TOPGEN   3392
#define XCD_BAR_WORDS 3456
#define XB_SPIN_CAP (1u << 22)
#define LAS __attribute__((address_space(3)))
DEV unsigned xb_ld(unsigned* q) { return __hip_atomic_load(q, __ATOMIC_RELAXED, __HIP_MEMORY_SCOPE_AGENT); }
DEV unsigned xb_add(unsigned* q, unsigned v) { return __hip_atomic_fetch_add(q, v, __ATOMIC_RELAXED, __HIP_MEMORY_SCOPE_AGENT); }
DEV unsigned xb_xcc_id() { return (unsigned)__builtin_amdgcn_s_getreg((3 << 11) | 20) & 0xFu; }
#define XB_SPIN(cond, bar) do { unsigned _sp = 0; while (cond) { __builtin_amdgcn_s_sleep(1); \
    if ((++_sp & 255u) == 0u) { if (xb_ld(&(bar)[XB_TMO])) break; if (_sp > XB_SPIN_CAP) { atomicAdd(&(bar)[XB_TMO], 1u); break; } } } } while (0)
struct XcdBarrier { unsigned* bar; unsigned x; volatile LAS unsigned* st; };
DEV XcdBarrier xcd_barrier_post(unsigned* bar, volatile LAS unsigned* st) {
  XcdBarrier b; b.bar = bar; b.x = xb_xcc_id(); b.st = st;
  if (__builtin_amdgcn_workitem_id_x() == 0) (void)xb_add(&bar[XB_XCNT(b.x)], 1u);
  return b;
}
DEV void xcd_barrier_complete(unsigned* bar, unsigned x, unsigned& nloc, unsigned& nx) {
  const unsigned G = gridDim.x * gridDim.y * gridDim.z;
  unsigned sum, cnt, mine, sp = 0u;
  for (;;) {
    sum = 0u; cnt = 0u; mine = 0u;
#pragma unroll
    for (unsigned j = 0; j < 16; ++j) { const unsigned c = xb_ld(&bar[XB_XCNT(j)]); sum += c; cnt += (c > 0u) ? 1u : 0u; mine = (j == x) ? c : mine; }
    if (sum == G) break;
    __builtin_amdgcn_s_sleep(1);
    if ((++sp & 255u) == 0u) { if (xb_ld(&bar[XB_TMO])) break; if (sp > XB_SPIN_CAP) { atomicAdd(&bar[XB_TMO], 1u); break; } }
  }
  nloc = mine > 0u ? mine : 1u; nx = cnt > 0u ? cnt : 1u;
}
DEV void xcd_barrier(const XcdBarrier& b) {
  asm volatile("s_waitcnt vmcnt(0)" ::: "memory");
  __syncthreads();
  if (__builtin_amdgcn_workitem_id_x() == 0) {
    unsigned* bar = b.bar;
    __builtin_amdgcn_s_waitcnt(0);
    unsigned nloc = b.st[0], nx = b.st[1];
    if (nloc == 0u) { xcd_barrier_complete(bar, b.x, nloc, nx); b.st[0] = nloc; b.st[1] = nx; }
    const unsigned old = xb_add(&bar[XB_XSUB(b.x)], 1u);
    const unsigned gen = old / nloc;
    if (old + 1u == (gen + 1u) * nloc) {
      __builtin_amdgcn_fence(__ATOMIC_RELEASE, "agent");
      asm volatile("s_waitcnt vmcnt(0)" ::: "memory");
      const unsigned og = xb_add(&bar[XB_TOP], 1u);
      const unsigned tg = og / nx;
      if (og + 1u == (tg + 1u) * nx) xb_add(&bar[XB_TOPGEN], 1u);
      else XB_SPIN(xb_ld(&bar[XB_TOPGEN]) == tg, bar);
      __builtin_amdgcn_fence(__ATOMIC_ACQUIRE, "agent");
      xb_add(&bar[XB_XGEN(b.x)], 1u);
      asm volatile("s_waitcnt vmcnt(0)" ::: "memory");
    } else {
      XB_SPIN(xb_ld(&bar[XB_XGEN(b.x)]) == gen, bar);
      __builtin_amdgcn_fence(__ATOMIC_ACQUIRE, "agent");
      asm volatile("s_waitcnt vmcnt(0)" ::: "memory");
    }
  }
  __syncthreads();
}

#define GRID_SYNC() do { XcdBarrier xb_; xb_.bar = get_params()->bar; xb_.x = xb_xcc_id(); xb_.st = (volatile LAS unsigned*)&xb_words; xcd_barrier(xb_); } while (0)

__global__ void __launch_bounds__(NTHR, 2) megakernel(Params p) {
  __shared__ __attribute__((aligned(16))) char smem[SMEM_BYTES];
  __shared__ uint4 xb_words;
  if (__builtin_amdgcn_workitem_id_x() == 0) xb_words = make_uint4(0u, 0u, 0u, 0u);
  __syncthreads();
  (void)xcd_barrier_post(get_params()->bar, (volatile LAS unsigned*)&xb_words);
#ifndef PM
#define PM 0xFFFF
#endif
#ifndef DUP
#define DUP 0
#endif
  if (PM & 1) phase_init(smem);
  if (DUP & 1) phase_init(smem);
  GRID_SYNC();
  for (int layer = 0; layer < DEPTH; ++layer) {
    if (layer == 0) {
      if (PM & 2) phase_norm(layer, 1);
      if (DUP & 2) phase_norm(layer, 1);
      GRID_SYNC();
    }
    if (PM & 4) phase_gemm_win(layer, smem);
    if (DUP & 4) phase_gemm_win(layer, smem);
    GRID_SYNC();
#ifndef PREP_REP
#define PREP_REP 1
#endif
#pragma nounroll
    for (int rep_ = 0; rep_ < PREP_REP; ++rep_) phase_prep(layer, smem);
    GRID_SYNC();
    {
      const int nb_ = gridDim.x;
      if (BID() < 128) { if (PM & 64) phase_scan(smem); }
      else {
        if (PM & 16) phase_pool(layer, smem, BID() - 128, nb_ - 128);
        if (PM & 256) phase_tables(layer, BID() - 128, nb_ - 128);
      }
    }
    GRID_SYNC();
    if (PM & 128) phase_o(layer, smem);
    if (DUP & 128) phase_o(layer, smem);
    GRID_SYNC();
    if (PM & 512) phase_merge(layer, smem);
    if (DUP & 512) phase_merge(layer, smem);
    GRID_SYNC();
    if (PM & 1024) phase_outproj(layer, smem);
    GRID_SYNC();
    if (PM & 2048) phase_norm(layer, 2);
    if (DUP & 2048) phase_norm(layer, 2);
    GRID_SYNC();
    if (PM & 4096) phase_peerq(layer, smem);
    if (DUP & 4096) phase_peerq(layer, smem);
    GRID_SYNC();
    if (PM & 8192) phase_peer(layer, smem);
    if (layer + 1 < DEPTH) GRID_SYNC();
  }
}

static inline size_t align_up(size_t v, size_t a) { return (v + a - 1) / a * a; }

extern "C" void kernel_launch(void* const* d_in, const int* in_sizes, int n_in, void* d_out, int out_size, void* d_ws,
                              size_t ws_size, hipStream_t stream) {
  Params p{};
  p.x = (const float*)d_in[0]; p.c = (const float*)d_in[1]; p.ctx = (const float*)d_in[2]; p.c_ctx = (const float*)d_in[3];
  p.w_mod = (const float*)d_in[4]; p.b_mod = (const float*)d_in[5]; p.norm_mix = (const float*)d_in[6]; p.w_in = (const float*)d_in[7];
  p.conv_w = (const float*)d_in[8]; p.a_log = (const float*)d_in[9]; p.dt_bias = (const float*)d_in[10];
  p.dn_out_norm = (const float*)d_in[11]; p.pool_w = (const float*)d_in[12]; p.pool_scale = (const float*)d_in[13];
  p.w_up_dn = (const float*)d_in[14]; p.w_up_pool = (const float*)d_in[15]; p.w_out = (const float*)d_in[16];
  p.norm_ffn = (const float*)d_in[17]; p.peer_wq = (const float*)d_in[18]; p.peer_keys = (const float*)d_in[19];
  p.peer_u = (const float*)d_in[20]; p.peer_v = (const float*)d_in[21]; p.final_norm = (const float*)d_in[22];
  p.out = (float*)d_out;

  char* ws = (char*)d_ws;
  size_t off = 0;
  auto take = [&](size_t bytes) { char* q = ws + off; off = align_up(off + bytes, 256); return q; };
  p.tab8U = (unsigned char*)take((size_t)NEXP * 1024);
  p.tab8V = (unsigned char*)take((size_t)NEXP * 1024);
  p.scU = (float*)take((size_t)NEXP * 4);
  p.scV = (float*)take((size_t)NEXP * 4);
  p.WinT = (u16*)take((size_t)DEPTH * NPAD * LDK1 * 2);
  p.WdT = (u16*)take((size_t)DEPTH * 1024 * LDK5 * 2);
  p.WpT = (u16*)take((size_t)DEPTH * 1024 * LDK5 * 2);
  p.WoT = (u16*)take((size_t)DEPTH * 1024 * LDK1 * 2);
  p.WkT = (u16*)take((size_t)DEPTH * 2048 * LDK1 * 2);
  p.PwT = (u16*)take((size_t)DEPTH * 4 * 128 * 128 * 2);
  p.mod = (float*)take((size_t)DEPTH * 3 * 6144 * 4);
  p.xc = (float*)take((size_t)NCTX * 1024 * 4);
  p.h = (u16*)take((size_t)R * LDK1 * 2);
  p.h8 = (unsigned char*)take((size_t)R * LDK1);
  p.m = p.h;
  p.qkv_pre = (u16*)take((size_t)R * 1536 * 2);
  p.Vfrag = p.qkv_pre;
  p.z = (u16*)take((size_t)R * 512 * 2);
  p.pin = (u16*)take((size_t)R * 512 * 2);
  p.sgd = (u16*)take((size_t)R * 1024);
  p.sgp = (u16*)take((size_t)R * 1024);
  p.xb = (u16*)take((size_t)R * 1024 * 2);
  p.ba = (float*)take((size_t)R * 16 * 4);
  p.qkvn = (u16*)take((size_t)R * 1536 * 2);
  p.bg = (float*)take((size_t)R * 16 * 4);
  p.Wfrag = (u16*)take((size_t)NUNIT * 16384);
  p.KdT = (u16*)take((size_t)NUNIT * 16384);
  p.Ufrag = (u16*)take((size_t)NUNIT * 16384);
  p.ydn = p.Ufrag;
  p.Sfrag = (u16*)take((size_t)NUNIT * 32768);
  p.gc = (float*)take((size_t)NUNIT * 64 * 4);
  p.glast = (float*)take((size_t)NUNIT * 4);
  p.ypool = (u16*)take((size_t)R * LDK5 * 2);
  p.bar = (unsigned*)take((size_t)XCD_BAR_WORDS * 4);
  p.topS = (float*)p.qkvn;
  p.topI = (int*)((char*)p.qkvn + (size_t)R * 256 * 4);
  const bool alias_ok = ((size_t)R * 256 * 8 <= (size_t)R * 1536 * 2) && ((size_t)NUNIT * 16384 <= (size_t)R * 1536 * 2) &&
                        ((size_t)R * LDK5 * 2 <= (size_t)NUNIT * 16384);
  if (off > ws_size || !alias_ok) {
    fprintf(stderr, "workspace too small: need %zu have %zu (alias_ok=%d)\n", off, ws_size, (int)alias_ok);
    return;
  }
  static int grid_blocks = 0;
  if (!grid_blocks) {
    int dev = 0, cus = 0, per_cu = 0;
    (void)hipGetDevice(&dev);
    (void)hipDeviceGetAttribute(&cus, hipDeviceAttributeMultiprocessorCount, dev);
    (void)hipOccupancyMaxActiveBlocksPerMultiprocessor(&per_cu, megakernel, NTHR, 0);
    if (per_cu > 2) per_cu = 2;
    if (per_cu < 1) per_cu = 1;
    grid_blocks = cus * per_cu;
    grid_blocks -= grid_blocks % 8;
  }
  if (grid_blocks < 8) { fprintf(stderr, "bad grid %d\n", grid_blocks); return; }
  (void)hipMemsetAsync(p.bar, 0, (size_t)XCD_BAR_WORDS * 4, stream);
  void* args[] = {&p};
  hipError_t e = hipLaunchCooperativeKernel((void*)megakernel, dim3(grid_blocks), dim3(NTHR), args, 0, stream);
  if (e != hipSuccess) fprintf(stderr, "cooperative launch failed: %s (grid %d)\n", hipGetErrorString(e), grid_blocks);
}
```
